# Optimizing an MI355X kernel written in HIP

```python
import math
import jax, jax.numpy as jnp
from jax import lax
import numpy as np

D_MODEL = 1024
BATCH = 8
SEQ = 2048
DEPTH = 1
DEC_BATCH = 128
DEC_SEQ = 1
PAST_LEN = 2048
PAGE_SIZE = 128

MIX_A = D_MODEL // 2
H_A = 4
HD_A = MIX_A // H_A
MIX_B = D_MODEL - MIX_A
H_B = 4
DK_B = MIX_B // H_B
DV_B = MIX_B // H_B
MIX_W = MIX_A + MIX_B
CONV_W = 4
CONV_DIM = 2 * H_B * DK_B + H_B * DV_B
GDN_CHUNK = 64
Q_BLOCK = 128
D_FF = 4 * D_MODEL
RMS_EPS = 1e-6
L2_EPS = 1e-6
FGATE_BIAS_MEAN = 2.0
COL_SIZES = (MIX_A, MIX_A, MIX_A, H_A, CONV_DIM, MIX_B, H_B, H_B)
IN_DIM = sum(COL_SIZES)

kernel_name = 'hymba_fox_gdn_decode_step'


def rmsnorm(x, w):
    xf = x.astype(jnp.float32)
    y = xf * lax.rsqrt(jnp.mean(xf * xf, axis=-1, keepdims=True) + RMS_EPS)
    return (y * w.astype(jnp.float32)).astype(x.dtype)


def l2norm(x):
    xf = x.astype(jnp.float32)
    return xf * lax.rsqrt(jnp.sum(xf * xf, axis=-1, keepdims=True) + L2_EPS)


def split_cols(p):
    idx = [int(i) for i in np.cumsum(COL_SIZES)[:-1]]
    return jnp.split(p, idx, axis=-1)


def mixer_inputs(x, ln1, w_in, b_f, a_log, dt_bias):
    B, L = x.shape[0], x.shape[1]
    h = rmsnorm(x, ln1)
    qa, ka, va, fa, qkv_b, z, bb, aa = split_cols(h @ w_in)
    q = qa.reshape(B, L, H_A, HD_A)
    k = ka.reshape(B, L, H_A, HD_A)
    v = va.reshape(B, L, H_A, HD_A)
    lf = jax.nn.log_sigmoid((fa + b_f).astype(jnp.float32))
    beta = jax.nn.sigmoid(bb.astype(jnp.float32))
    g = -jnp.exp(a_log.astype(jnp.float32)) * jax.nn.softplus(
        aa.astype(jnp.float32) + dt_bias.astype(jnp.float32))
    return q, k, v, lf, qkv_b, z, beta, g


def fox_attend(q, k, v, dq, dk, q_pos, k_pos):
    s = jnp.einsum('bqhd,bkhd->bhqk', q, k).astype(jnp.float32) * (HD_A ** -0.5)
    bias = jnp.swapaxes(dq, 1, 2)[:, :, :, None] - jnp.swapaxes(dk, 1, 2)[:, :, None, :]
    causal = k_pos[None, :] <= q_pos[:, None]
    s = jnp.where(causal, s + bias, -jnp.inf)
    p = jax.nn.softmax(s, axis=-1)
    return jnp.einsum('bhqk,bkhd->bqhd', p.astype(v.dtype), v)


def fox_prompt(q, k, v, dcum):
    B, L = q.shape[0], q.shape[1]
    nq = L // Q_BLOCK
    qb = jnp.swapaxes(q.reshape(B, nq, Q_BLOCK, H_A, HD_A), 0, 1)
    db = jnp.swapaxes(dcum.reshape(B, nq, Q_BLOCK, H_A), 0, 1)
    starts = jnp.arange(nq, dtype=jnp.int32) * Q_BLOCK
    k_pos = jnp.arange(L, dtype=jnp.int32)

    def block(args):
        qi, di, st = args
        return fox_attend(qi, k, v, di, dcum, st + jnp.arange(Q_BLOCK, dtype=jnp.int32), k_pos)

    o = lax.map(block, (qb, db, starts))
    return jnp.swapaxes(o, 0, 1).reshape(B, L, H_A, HD_A)


def short_conv(xp, w):
    L = xp.shape[1] - (CONV_W - 1)
    acc = xp[:, 0:L] * w[0]
    for i in range(1, CONV_W):
        acc = acc + xp[:, i:i + L] * w[i]
    return jax.nn.silu(acc)


def gdn_qkv(conv_in, w_conv):
    B = conv_in.shape[0]
    c = short_conv(conv_in, w_conv).astype(jnp.float32)
    L = c.shape[1]
    qb, kb, vb = jnp.split(c, [H_B * DK_B, 2 * H_B * DK_B], axis=-1)
    q = l2norm(qb.reshape(B, L, H_B, DK_B))
    k = l2norm(kb.reshape(B, L, H_B, DK_B))
    v = vb.reshape(B, L, H_B, DV_B)
    return q, k, v


def gdn_chunked(q, k, v, g, beta, s0):
    B, L = q.shape[0], q.shape[1]
    C = GDN_CHUNK
    N = L // C

    def blk(t):
        return jnp.moveaxis(t.reshape((B, N, C) + t.shape[2:]), 3, 1)

    q = blk(q) * (DK_B ** -0.5)
    k = blk(k)
    v = blk(v)
    gc = jnp.cumsum(blk(g), axis=-1)
    bt = blk(beta)
    incl = jnp.tril(jnp.ones((C, C), dtype=bool))
    strict = jnp.tril(jnp.ones((C, C), dtype=bool), -1)
    decay = jnp.exp(jnp.where(incl, gc[..., :, None] - gc[..., None, :], -jnp.inf))
    kk = jnp.einsum('bhnid,bhnjd->bhnij', k, k)
    a = jnp.eye(C, dtype=jnp.float32) + jnp.where(strict, bt[..., :, None] * kk * decay, 0.0)
    rhs = jnp.concatenate([v * bt[..., None], k * (bt * jnp.exp(gc))[..., None]], axis=-1)
    sol = lax.linalg.triangular_solve(a, rhs, left_side=True, lower=True, unit_diagonal=True)
    u, w = sol[..., :DV_B], sol[..., DV_B:]
    qk = jnp.where(incl, jnp.einsum('bhnid,bhnjd->bhnij', q, k) * decay, 0.0)
    qg = q * jnp.exp(gc)[..., None]
    kg = k * jnp.exp(gc[..., -1:] - gc)[..., None]
    gl = jnp.exp(gc[..., -1])

    def step(S, xs):
        u_n, w_n, qk_n, qg_n, kg_n, gl_n = xs
        v_new = u_n - jnp.einsum('bhcd,bhde->bhce', w_n, S)
        o = jnp.einsum('bhcd,bhde->bhce', qg_n, S) + jnp.einsum('bhcs,bhse->bhce', qk_n, v_new)
        S = S * gl_n[..., None, None] + jnp.einsum('bhcd,bhce->bhde', kg_n, v_new)
        return S, o

    xs = tuple(jnp.moveaxis(t, 2, 0) for t in (u, w, qk, qg, kg, gl))
    s_fin, o = lax.scan(step, s0, xs)
    o = jnp.moveaxis(o, 0, 2)
    return jnp.moveaxis(o, 1, 3).reshape(B, L, H_B, DV_B), s_fin


def gdn_recurrent(q, k, v, g, beta, s0):
    q = q * (DK_B ** -0.5)

    def step(S, xs):
        q_t, k_t, v_t, g_t, b_t = xs
        S = S * jnp.exp(g_t)[..., None, None]
        delta = (v_t - jnp.einsum('bhd,bhde->bhe', k_t, S)) * b_t[..., None]
        S = S + jnp.einsum('bhd,bhe->bhde', k_t, delta)
        return S, jnp.einsum('bhd,bhde->bhe', q_t, S)

    xs = tuple(jnp.swapaxes(t, 0, 1) for t in (q, k, v, g, beta))
    s_fin, o = lax.scan(step, s0, xs)
    return jnp.swapaxes(o, 0, 1), s_fin


def layer_output(x, fo, go, z, w_gnorm, w_o, ln2, w_up, w_down):
    B, L = x.shape[0], x.shape[1]
    gz = z.reshape(B, L, H_B, DV_B).astype(jnp.float32)
    go = rmsnorm(go, w_gnorm) * jax.nn.silu(gz)
    mix = jnp.concatenate([fo.reshape(B, L, MIX_A).astype(x.dtype),
                           go.reshape(B, L, MIX_B).astype(x.dtype)], axis=-1)
    h = x + mix @ w_o
    u = jax.nn.relu(rmsnorm(h, ln2) @ w_up)
    return h + (u * u) @ w_down


def prompt_layer(x, ln1, w_in, b_f, w_conv, a_log, dt_bias, w_gnorm, w_o, ln2, w_up, w_down):
    B = x.shape[0]
    q, k, v, lf, qkv_b, z, beta, g = mixer_inputs(x, ln1, w_in, b_f, a_log, dt_bias)
    dcum = jnp.cumsum(lf, axis=1)
    fo = fox_prompt(q, k, v, dcum)
    conv_in = jnp.concatenate([jnp.zeros((B, CONV_W - 1, CONV_DIM), qkv_b.dtype), qkv_b], axis=1)
    qg, kg, vg = gdn_qkv(conv_in, w_conv)
    s0 = jnp.zeros((B, H_B, DK_B, DV_B), jnp.float32)
    go, s_fin = gdn_chunked(qg, kg, vg, g, beta, s0)
    y = layer_output(x, fo, go, z, w_gnorm, w_o, ln2, w_up, w_down)
    return y, k, v, lf.astype(x.dtype), conv_in[:, -(CONV_W - 1):], s_fin.astype(x.dtype)


def sample_layer(x, ck, cv, clf, page_table, conv_state, ssm_state,
                 ln1, w_in, b_f, w_conv, a_log, dt_bias, w_gnorm, w_o, ln2, w_up, w_down):
    DB, T = x.shape[0], x.shape[1]
    P = page_table.shape[1] * ck.shape[1]
    q, k, v, lf, qkv_b, z, beta, g = mixer_inputs(x, ln1, w_in, b_f, a_log, dt_bias)
    k_all = jnp.concatenate([ck[page_table].reshape(DB, P, H_A, HD_A).astype(k.dtype), k], axis=1)
    v_all = jnp.concatenate([cv[page_table].reshape(DB, P, H_A, HD_A).astype(v.dtype), v], axis=1)
    lf_all = jnp.concatenate([clf[page_table].reshape(DB, P, H_A).astype(jnp.float32), lf], axis=1)
    d_all = jnp.cumsum(lf_all, axis=1)
    q_pos = P + jnp.arange(T, dtype=jnp.int32)
    k_pos = jnp.arange(P + T, dtype=jnp.int32)
    fo = fox_attend(q, k_all, v_all, d_all[:, P:], d_all, q_pos, k_pos)
    conv_in = jnp.concatenate([conv_state.astype(qkv_b.dtype), qkv_b], axis=1)
    qg, kg, vg = gdn_qkv(conv_in, w_conv)
    go, s_fin = gdn_recurrent(qg, kg, vg, g, beta, ssm_state.astype(jnp.float32))
    y = layer_output(x, fo, go, z, w_gnorm, w_o, ln2, w_up, w_down)
    return (y, k.astype(ck.dtype), v.astype(cv.dtype), lf.astype(clf.dtype),
            conv_in[:, -(CONV_W - 1):].astype(conv_state.dtype), s_fin.astype(ssm_state.dtype))


def setup_inputs(seed: int = 0) -> dict:
    key = jax.random.key(seed)
    ks = jax.random.split(key, 24)
    f32 = jnp.float32
    n_pages = PAST_LEN // PAGE_SIZE
    used = DEC_BATCH * n_pages
    n_phys = used + max(1, used // 4)

    def nrm(k, shape, scale=1.0):
        return jax.random.normal(k, shape, f32) * scale

    x_prompt = nrm(ks[0], (BATCH, SEQ, D_MODEL))
    x_sample = nrm(ks[1], (DEC_BATCH, DEC_SEQ, D_MODEL))
    cache_k = nrm(ks[2], (DEPTH, n_phys, PAGE_SIZE, H_A, HD_A))
    cache_v = nrm(ks[3], (DEPTH, n_phys, PAGE_SIZE, H_A, HD_A))
    cache_lf = jax.nn.log_sigmoid(nrm(ks[4], (DEPTH, n_phys, PAGE_SIZE, H_A)) + FGATE_BIAS_MEAN)
    page_table = jax.random.permutation(ks[5], n_phys)[:used].reshape(DEC_BATCH, n_pages).astype(jnp.int32)
    state_conv = nrm(ks[6], (DEPTH, DEC_BATCH, CONV_W - 1, CONV_DIM))
    state_ssm = nrm(ks[7], (DEPTH, DEC_BATCH, H_B, DK_B, DV_B), 0.1)
    ln1 = 1.0 + nrm(ks[8], (DEPTH, D_MODEL), 0.02)
    w_in = nrm(ks[9], (DEPTH, D_MODEL, IN_DIM), D_MODEL ** -0.5)
    b_f = FGATE_BIAS_MEAN + nrm(ks[10], (DEPTH, H_A), 0.1)
    w_conv = nrm(ks[11], (DEPTH, CONV_W, CONV_DIM), CONV_W ** -0.5)
    a_log = jnp.log(jax.random.uniform(ks[12], (DEPTH, H_B), f32, 1.0, 16.0))
    dt = jnp.exp(jax.random.uniform(ks[13], (DEPTH, H_B), f32, math.log(1e-3), math.log(1e-1)))
    dt_bias = dt + jnp.log(-jnp.expm1(-dt))
    w_gnorm = 1.0 + nrm(ks[14], (DEPTH, DV_B), 0.02)
    w_o = nrm(ks[15], (DEPTH, MIX_W, D_MODEL), MIX_W ** -0.5)
    ln2 = 1.0 + nrm(ks[16], (DEPTH, D_MODEL), 0.02)
    w_up = nrm(ks[17], (DEPTH, D_MODEL, D_FF), D_MODEL ** -0.5)
    w_down = nrm(ks[18], (DEPTH, D_FF, D_MODEL), D_FF ** -0.5)
    ln_f = 1.0 + nrm(ks[19], (D_MODEL,), 0.02)
    return {'x_prompt': x_prompt, 'x_sample': x_sample, 'cache_k': cache_k, 'cache_v': cache_v,
            'cache_lf': cache_lf, 'page_table': page_table, 'state_conv': state_conv,
            'state_ssm': state_ssm, 'ln1': ln1, 'w_in': w_in, 'b_f': b_f, 'w_conv': w_conv,
            'a_log': a_log, 'dt_bias': dt_bias, 'w_gnorm': w_gnorm, 'w_o': w_o, 'ln2': ln2,
            'w_up': w_up, 'w_down': w_down, 'ln_f': ln_f}


def reference(x_prompt, x_sample, cache_k, cache_v, cache_lf, page_table, state_conv, state_ssm,
              ln1, w_in, b_f, w_conv, a_log, dt_bias, w_gnorm, w_o, ln2, w_up, w_down, ln_f):
    yp, ys = x_prompt, x_sample
    pk, pv, plf, pconv, pssm = [], [], [], [], []
    sk, sv, slf, sconv, sssm = [], [], [], [], []
    for l in range(DEPTH):
        lw = (ln1[l], w_in[l], b_f[l], w_conv[l], a_log[l], dt_bias[l], w_gnorm[l],
              w_o[l], ln2[l], w_up[l], w_down[l])
        yp, k1, v1, lf1, c1, s1 = prompt_layer(yp, *lw)
        ys, k2, v2, lf2, c2, s2 = sample_layer(ys, cache_k[l], cache_v[l], cache_lf[l], page_table,
                                               state_conv[l], state_ssm[l], *lw)
        pk.append(k1); pv.append(v1); plf.append(lf1); pconv.append(c1); pssm.append(s1)
        sk.append(k2); sv.append(v2); slf.append(lf2); sconv.append(c2); sssm.append(s2)
    y_prompt = rmsnorm(yp, ln_f)
    y_sample = rmsnorm(ys, ln_f)
    return (y_prompt, y_sample,
            jnp.stack(pk), jnp.stack(pv), jnp.stack(plf), jnp.stack(pconv), jnp.stack(pssm),
            jnp.stack(sk), jnp.stack(sv), jnp.stack(slf), jnp.stack(sconv), jnp.stack(sssm))
```

```cpp
#include <hip/hip_runtime.h>
#include <hip/hip_bf16.h>
#include <cstdio>
#include <cstdint>

constexpr int DM = 1024, NB = 8, SEQ = 2048, DECB = 128, PAST = 2048, PAGE = 128, NPAGES = 16;
constexpr int NH = 4, HD = 128, CONVD = 1536, FF = 4096, INDIM = 3596, GCH = 64, NCHUNK = SEQ / GCH;
constexpr int MP = NB * SEQ;
constexpr int M_TOT = MP + DECB;
constexpr int M_PAD = 16640;
constexpr int N1 = 3584;
constexpr float RMS_EPS = 1e-6f, L2_EPS = 1e-6f;
constexpr float ATT_SCALE = 0.08838834764831845f;
constexpr size_t OY_P = 0, OY_S = 16777216, OK_P = 16908288, OV_P = 25296896, OLF_P = 33685504, OCONV_P = 33751040, OSSM_P = 33787904,
                 OK_S = 34312192, OV_S = 34377728, OLF_S = 34443264, OCONV_S = 34443776, OSSM_S = 35033600, OUT_TOTAL = 43422208;
constexpr size_t MiB = 1u << 20;
constexpr size_t WS_CTL = 0, CTL_ZERO_BYTES = 1 * MiB;
constexpr size_t WS_W1T = 2 * MiB, WS_WOT = 10 * MiB, WS_WUPT = 12 * MiB, WS_WDNT = 21 * MiB;
constexpr size_t WS_XN = 32 * MiB, WS_QB = 68 * MiB, WS_KB = 84 * MiB, WS_VB = 100 * MiB, WS_CB = 116 * MiB, WS_ZB = 166 * MiB;
constexpr size_t WS_MIX = 184 * MiB, WS_HB = 218 * MiB, WS_UB = 252 * MiB;
constexpr size_t WS_UT = 384 * MiB, WS_WN = 416 * MiB, WS_QG = 432 * MiB, WS_KGT = 448 * MiB, WS_QKM = 464 * MiB;
constexpr size_t WS_LF = 472 * MiB, WS_BETA = 473 * MiB, WS_G = 474 * MiB, WS_KBIAS = 475 * MiB, WS_QS = 476 * MiB, WS_SSQ = 477 * MiB, WS_SSQ2 = 479 * MiB, WS_GL = 481 * MiB;
constexpr size_t WS_END = 482 * MiB;
constexpr int CW_TMO = 0, CW_BAR = 4096;
constexpr size_t QKV_STRIDE = (WS_KB - WS_QB) / 2;
static_assert(WS_VB - WS_KB == WS_KB - WS_QB, "q/k/v copies equally spaced");

namespace pg8 {
#define PG8_LAS __attribute__((address_space(3)))
typedef unsigned short bf16_t;
typedef short bf16x8 __attribute__((ext_vector_type(8)));
typedef float f32x4 __attribute__((ext_vector_type(4)));
typedef unsigned u32x4 __attribute__((ext_vector_type(4)));
constexpr int BM = 256, BK = 64, HALF = 128, HTB = HALF * BK * 2  , STAGE_BYTES = 8 * HTB, NXCD = 8, WGM = 8;

__host__ __device__ __forceinline__ int lds_byte(int r, int c) { const int st = (r >> 4) * 2 + (c >> 5), rr = r & 15, cc = c & 31, ob = rr * 64 + cc * 2; return st * 1024 + (ob ^ (((ob >> 9) & 1) << 5)); }
__host__ __device__ __forceinline__ void stage_rc(int b, int& R, int& C) { const int st = b / 1024, sb = b % 1024, swz = sb ^ (((sb >> 9) & 1) << 5); R = (st >> 1) * 16 + swz / 64; C = (st & 1) * 32 + (swz % 64) / 2; }
__host__ __device__ __forceinline__ int perm32(int rho) { const int n = rho >> 4, i = rho & 15; return 8 * (i >> 2) + 4 * n + (i & 3); }

struct Unit { int pm, pn; };
struct Gemm { const bf16_t* A; const bf16_t* Bt; int M, N, K; };

struct StaticOrder {
    int nM, nN, nwg, G, c;
    __host__ __device__ void init(int M, int N, int G_, int c_) { nM = M / BM; nN = N / BM; nwg = nM * nN; G = G_; c = c_; }
    __host__ __device__ bool next(int i, Unit& u) const {
        const long L = (long)i * G + c; if (L >= nwg) return false;
        int wgid = (int)L; { const int q = nwg / NXCD, r = nwg % NXCD, xcd = wgid % NXCD, off = wgid / NXCD; wgid = (xcd < r ? xcd * (q + 1) : r * (q + 1) + (xcd - r) * q) + off; }
        const int nig = WGM * nN, gid = wgid / nig, fm = gid * WGM, gsz = (nM - fm) < WGM ? (nM - fm) : WGM;
        u.pm = fm + ((wgid % nig) % gsz); u.pn = (wgid % nig) / gsz; return true;
    }
    __device__ __forceinline__ void a_ready(const Unit&) const {}
    __device__ __forceinline__ void done(const Unit&) const {}
};
__device__ __forceinline__ unsigned cvt_pk_bf16(float lo, float hi) { unsigned r; asm volatile("v_cvt_pk_bf16_f32 %0, %1, %2" : "=v"(r) : "v"(lo), "v"(hi)); return r; }
typedef float f32x2 __attribute__((ext_vector_type(2)));
__device__ __forceinline__ u32x4 pack8_bf16(f32x4 v0, f32x4 v1) { u32x4 w; w.x = cvt_pk_bf16(v0[0], v0[1]); w.y = cvt_pk_bf16(v0[2], v0[3]); w.z = cvt_pk_bf16(v1[0], v1[1]); w.w = cvt_pk_bf16(v1[2], v1[3]); return w; }

struct EpiIn {
    static constexpr bool PERM = true, AFTER_DRAIN = false;
    bf16_t* QB;
    float* QS;
    bf16_t* CB;
    bf16_t* ZB;
    float* out;
    __device__ __forceinline__ void operator()(const f32x4 (&acc)[2][2][4][2], const Unit& u, int wr, int wc, int fr, int fq) const {
        const int pn = u.pn;
#pragma unroll
        for (int ai = 0; ai < 2; ++ai)
#pragma unroll
            for (int m = 0; m < 4; ++m) {
                const int row = u.pm * BM + ai * HALF + wr * 64 + m * 16 + fr;
                if (row >= M_TOT) continue;
#pragma unroll
                for (int bj = 0; bj < 2; ++bj) {
                    const int col = pn * BM + bj * HALF + wc * 32 + 8 * fq;
                    const f32x4 v0 = acc[ai][bj][m][0], v1 = acc[ai][bj][m][1];
                    if (pn < 6) {
                        const int seg = pn >> 1, c = col - seg * 512, h = c >> 7, d = c & 127;
                        if (row < MP) {
                            const int b = row >> 11, t = row & 2047;
                            const size_t idx = ((size_t)((b * NH + h) * SEQ + t)) * HD + d;
                            *(u32x4*)(QB + (size_t)seg * QKV_STRIDE + idx) = pack8_bf16(v0, v1);
                            if (seg != 0) { float* o = out + OK_P + (size_t)(seg - 1) * (OV_P - OK_P) + (size_t)row * 512 + c; *(f32x4*)o = v0; *(f32x4*)(o + 4) = v1; }
                        } else {
                            const int db = row - MP;
                            if (seg == 0) { float* o = QS + (size_t)db * 512 + c; *(f32x4*)o = v0; *(f32x4*)(o + 4) = v1; }
                            else { float* o = out + OK_S + (size_t)(seg - 1) * (OV_S - OK_S) + (size_t)db * 512 + c; *(f32x4*)o = v0; *(f32x4*)(o + 4) = v1; }
                        }
                    } else if (pn < 12) {
                        const int c = col - 1536;
                        *(u32x4*)(CB + (size_t)row * CONVD + c) = pack8_bf16(v0, v1);
                        if (row < MP) {
                            const int t = row & 2047;
                            if (t >= SEQ - 3) { float* o = out + OCONV_P + ((size_t)(row >> 11) * 3 + (t - (SEQ - 3))) * CONVD + c; *(f32x4*)o = v0; *(f32x4*)(o + 4) = v1; }
                        } else {
                            float* o = out + OCONV_S + ((size_t)(row - MP) * 3 + 2) * CONVD + c; *(f32x4*)o = v0; *(f32x4*)(o + 4) = v1;
                        }
                    } else {
                        const int c = col - 3072;
                        *(u32x4*)(ZB + (size_t)row * 512 + c) = pack8_bf16(v0, v1);
                    }
                }
            }
    }
};

struct EpiRes {
    static constexpr bool PERM = true, AFTER_DRAIN = false;
    const float *xp, *xs; float* out; bf16_t* HB; float* SSQ;
    __device__ __forceinline__ void operator()(const f32x4 (&acc)[2][2][4][2], const Unit& u, int wr, int wc, int fr, int fq) const {
#pragma unroll
        for (int ai = 0; ai < 2; ++ai)
#pragma unroll
            for (int m = 0; m < 4; ++m) {
                const int row = u.pm * BM + ai * HALF + wr * 64 + m * 16 + fr;
                const bool ok = row < M_TOT;
                const float* xr = row < MP ? xp + (size_t)row * DM : xs + (size_t)(ok ? row - MP : 0) * DM;
                float* hr = row < MP ? out + OY_P + (size_t)row * DM : out + OY_S + (size_t)(ok ? row - MP : 0) * DM;
                float s = 0.f;
#pragma unroll
                for (int bj = 0; bj < 2; ++bj) {
                    const int col = u.pn * BM + bj * HALF + wc * 32 + 8 * fq;
                    if (ok) {
                        const f32x4 v0 = acc[ai][bj][m][0] + *(const f32x4*)(xr + col), v1 = acc[ai][bj][m][1] + *(const f32x4*)(xr + col + 4);
                        *(f32x4*)(hr + col) = v0; *(f32x4*)(hr + col + 4) = v1;
                        *(u32x4*)(HB + (size_t)row * DM + col) = pack8_bf16(v0, v1);
                        s += (v0[0] * v0[0] + v0[1] * v0[1]) + (v0[2] * v0[2] + v0[3] * v0[3]) + (v1[0] * v1[0] + v1[1] * v1[1]) + (v1[2] * v1[2] + v1[3] * v1[3]);
                    }
                }
                s += __shfl_xor(s, 16); s += __shfl_xor(s, 32);
                if (ok && fq == 0) SSQ[(size_t)row * 16 + u.pn * 4 + wc] = s;
            }
    }
};

struct EpiUp {
    static constexpr bool PERM = true, AFTER_DRAIN = false;
    bf16_t* UB; const float* SSQ;
    __device__ __forceinline__ void operator()(const f32x4 (&acc)[2][2][4][2], const Unit& u, int wr, int wc, int fr, int fq) const {
#pragma unroll
        for (int ai = 0; ai < 2; ++ai)
#pragma unroll
            for (int m = 0; m < 4; ++m) {
                const int row = u.pm * BM + ai * HALF + wr * 64 + m * 16 + fr;
                if (row >= M_TOT) continue;
                const f32x4* sp = (const f32x4*)(SSQ + (size_t)row * 16);
                const f32x4 a = sp[0], b = sp[1], c = sp[2], d = sp[3];
                const float ss = ((a[0] + a[1]) + (a[2] + a[3])) + ((b[0] + b[1]) + (b[2] + b[3])) + ((c[0] + c[1]) + (c[2] + c[3])) + ((d[0] + d[1]) + (d[2] + d[3]));
                const float rstd = 1.0f / sqrtf(ss * (1.0f / DM) + RMS_EPS);
#pragma unroll
                for (int bj = 0; bj < 2; ++bj) {
                    const int col = u.pn * BM + bj * HALF + wc * 32 + 8 * fq;
                    f32x4 v0 = acc[ai][bj][m][0] * rstd, v1 = acc[ai][bj][m][1] * rstd;
#pragma unroll
                    for (int j = 0; j < 4; ++j) { const float p = fmaxf(v0[j], 0.f), q = fmaxf(v1[j], 0.f); v0[j] = p * p; v1[j] = q * q; }
                    *(u32x4*)(UB + (size_t)row * FF + col) = pack8_bf16(v0, v1);
                }
            }
    }
};

struct EpiDown {
    static constexpr bool PERM = true, AFTER_DRAIN = false;
    float* out; float* SSQ2;
    __device__ __forceinline__ void operator()(const f32x4 (&acc)[2][2][4][2], const Unit& u, int wr, int wc, int fr, int fq) const {
#pragma unroll
        for (int ai = 0; ai < 2; ++ai)
#pragma unroll
            for (int m = 0; m < 4; ++m) {
                const int row = u.pm * BM + ai * HALF + wr * 64 + m * 16 + fr;
                const bool ok = row < M_TOT;
                float* hr = row < MP ? out + OY_P + (size_t)row * DM : out + OY_S + (size_t)(ok ? row - MP : 0) * DM;
                float s = 0.f;
#pragma unroll
                for (int bj = 0; bj < 2; ++bj) {
                    const int col = u.pn * BM + bj * HALF + wc * 32 + 8 * fq;
                    if (ok) {
                        const f32x4 v0 = acc[ai][bj][m][0] + *(const f32x4*)(hr + col), v1 = acc[ai][bj][m][1] + *(const f32x4*)(hr + col + 4);
                        *(f32x4*)(hr + col) = v0; *(f32x4*)(hr + col + 4) = v1;
                        s += (v0[0] * v0[0] + v0[1] * v0[1]) + (v0[2] * v0[2] + v0[3] * v0[3]) + (v1[0] * v1[0] + v1[1] * v1[1]) + (v1[2] * v1[2] + v1[3] * v1[3]);
                    }
                }
                s += __shfl_xor(s, 16); s += __shfl_xor(s, 32);
                if (ok && fq == 0) SSQ2[(size_t)row * 16 + u.pn * 4 + wc] = s;
            }
    }
};

template <class Epi, class Sched, bool ALIGN_EPI = false, bool SP2 = false>
__device__ __forceinline__ void gemm_phase(PG8_LAS unsigned char* lds, const Gemm g, const Sched& S, const Epi& E) {
    const int tid = threadIdx.x, wid = __builtin_amdgcn_readfirstlane(tid >> 6), lane = tid & 63, wr = wid >> 2, wc = wid & 3, fr = lane & 15, fq = lane >> 4;
    const int K = g.K, nt = K / BK;
    unsigned voffA[2], voffB[2];
#pragma unroll
    for (int i = 0; i < 2; ++i) { int R, C; stage_rc(tid * 16 + i * 8192, R, C); const int Rb = Epi::PERM ? ((R & ~31) + perm32(R & 31)) : R;
        voffA[i] = (unsigned)(R * K + C) * 2u; voffB[i] = (unsigned)(Rb * K + C) * 2u; }
    const size_t kstep = (size_t)(BK * 2);
    const size_t hstep = (size_t)HALF * K * 2;
    const size_t tstep = 2 * hstep;
    const unsigned ldsw = (unsigned)wid * 1024u;
    const int aoff = lds_byte(wr * 64 + fr, fq * 8), boff = lds_byte(wc * 32 + fr, fq * 8);
#define PG8_SA(b, h) (((b) * 2 + (h)) * HTB)
#define PG8_SB(b, h) ((4 + (b) * 2 + (h)) * HTB)
#define PG8_STAGE(bufoff, gbase, voff) do { _Pragma("unroll") for (int _i = 0; _i < 2; ++_i) \
        __builtin_amdgcn_global_load_lds((const unsigned*)((const char*)(gbase) + (voff)[_i]), (PG8_LAS unsigned*)(lds + (bufoff) + ldsw + _i * 8192), 16, 0, 0); } while (0)
#define PG8_LDA(dst, b, h) do { _Pragma("unroll") for (int m = 0; m < 4; ++m) _Pragma("unroll") for (int k = 0; k < 2; ++k) dst[m][k] = *(const PG8_LAS bf16x8*)(lds + PG8_SA(b, h) + aoff + m * 2048 + k * 1024); } while (0)
#define PG8_LDB(dst, b, h) do { _Pragma("unroll") for (int n = 0; n < 2; ++n) _Pragma("unroll") for (int k = 0; k < 2; ++k) dst[n][k] = *(const PG8_LAS bf16x8*)(lds + PG8_SB(b, h) + boff + n * 2048 + k * 1024); } while (0)
#define PG8_MMA(ai, bj, At, Bt) do { __builtin_amdgcn_s_setprio(1); _Pragma("unroll") for (int m = 0; m < 4; ++m) _Pragma("unroll") for (int n = 0; n < 2; ++n) _Pragma("unroll") for (int k = 0; k < 2; ++k) \
        acc[ai][bj][m][n] = __builtin_amdgcn_mfma_f32_16x16x32_bf16(Bt[n][k], At[m][k], acc[ai][bj][m][n], 0, 0, 0); __builtin_amdgcn_s_setprio(0); } while (0)
#define PG8_WAIT_V(n) asm volatile("s_waitcnt vmcnt(" #n ")" ::: "memory")
#define PG8_WAIT_L(n) asm volatile("s_waitcnt lgkmcnt(" #n ")" ::: "memory")
#define PG8_BAR __builtin_amdgcn_s_barrier()
#define PG8_SCHED __builtin_amdgcn_sched_barrier(0)
    Unit cur, nxt; int ui = 0;
    if (!S.next(0, cur)) return;
    f32x4 acc[2][2][4][2];
#pragma unroll
    for (int a = 0; a < 2; ++a)
#pragma unroll
        for (int b = 0; b < 2; ++b)
#pragma unroll
            for (int m = 0; m < 4; ++m)
#pragma unroll
                for (int n = 0; n < 2; ++n) acc[a][b][m][n] = (f32x4){0.f, 0.f, 0.f, 0.f};
    bf16x8 At[4][2], B0[2][2], B1[2][2];
    const char* cA = (const char*)g.A + (size_t)cur.pm * tstep; const char* cB = (const char*)g.Bt + (size_t)cur.pn * tstep;
    S.a_ready(cur);
    if constexpr (SP2) {
        PG8_STAGE(PG8_SB(0, 0), cB, voffB); PG8_STAGE(PG8_SB(0, 1), cB + hstep, voffB); PG8_STAGE(PG8_SA(0, 0), cA, voffA); PG8_STAGE(PG8_SA(0, 1), cA + hstep, voffA);
        if (wr == 1) PG8_BAR;
        PG8_WAIT_V(2); PG8_BAR;
        PG8_STAGE(PG8_SB(1, 0), cB + kstep, voffB); PG8_STAGE(PG8_SA(1, 0), cA + kstep, voffA); PG8_STAGE(PG8_SB(1, 1), cB + hstep + kstep, voffB);
        PG8_WAIT_V(6); PG8_BAR;
    } else {
        PG8_STAGE(PG8_SB(0, 0), cB, voffB); PG8_STAGE(PG8_SA(0, 0), cA, voffA); PG8_STAGE(PG8_SB(0, 1), cB + hstep, voffB); PG8_STAGE(PG8_SA(0, 1), cA + hstep, voffA);
        if (wr == 1) PG8_BAR;
        PG8_WAIT_V(4); PG8_BAR;
        PG8_STAGE(PG8_SB(1, 0), cB + kstep, voffB); PG8_STAGE(PG8_SA(1, 0), cA + kstep, voffA); PG8_STAGE(PG8_SB(1, 1), cB + hstep + kstep, voffB);
        PG8_WAIT_V(6); PG8_BAR;
    }
    for (;;) {
        const bool has_next = S.next(ui + 1, nxt);
        const char* nA = has_next ? (const char*)g.A + (size_t)nxt.pm * tstep : cA; const char* nB = has_next ? (const char*)g.Bt + (size_t)nxt.pn * tstep : cB;
        for (int t = 0; t < nt; t += 2) {
            const bool last = (t == nt - 2);
            const char* a1 = cA + (size_t)(t + 1) * kstep;
            const char* a2 = last ? nA : cA + (size_t)(t + 2) * kstep; const char* b2 = last ? nB : cB + (size_t)(t + 2) * kstep;
            const char* a3 = a2 + kstep; const char* b3 = b2 + kstep;
            if (last && has_next) S.a_ready(nxt);
            if constexpr (SP2) {
            PG8_LDB(B0, 0, 0); PG8_LDB(B1, 0, 1); PG8_SCHED; PG8_LDA(At, 0, 0); PG8_STAGE(PG8_SA(1, 1), a1 + hstep, voffA);
            PG8_WAIT_V(8); PG8_WAIT_L(0); PG8_BAR; PG8_MMA(0, 0, At, B0); PG8_MMA(0, 1, At, B1); PG8_BAR; PG8_SCHED;
            PG8_LDA(At, 0, 1); PG8_STAGE(PG8_SB(0, 0), b2, voffB); PG8_STAGE(PG8_SB(0, 1), b2 + hstep, voffB); PG8_STAGE(PG8_SA(0, 0), a2, voffA);
            PG8_WAIT_V(8); PG8_WAIT_L(0); PG8_BAR; PG8_MMA(1, 0, At, B0); PG8_MMA(1, 1, At, B1); PG8_BAR; PG8_SCHED;
            PG8_LDB(B0, 1, 0); PG8_LDB(B1, 1, 1); PG8_SCHED; PG8_LDA(At, 1, 0); PG8_STAGE(PG8_SA(0, 1), a2 + hstep, voffA);
            PG8_WAIT_V(8); PG8_WAIT_L(0); PG8_BAR; PG8_MMA(0, 0, At, B0); PG8_MMA(0, 1, At, B1); PG8_BAR; PG8_SCHED;
            PG8_LDA(At, 1, 1); PG8_STAGE(PG8_SB(1, 0), b3, voffB); PG8_STAGE(PG8_SB(1, 1), b3 + hstep, voffB); PG8_STAGE(PG8_SA(1, 0), a3, voffA);
            PG8_WAIT_V(8); PG8_WAIT_L(0); PG8_BAR; PG8_MMA(1, 0, At, B0); PG8_MMA(1, 1, At, B1); PG8_BAR; PG8_SCHED;
            } else {
            PG8_LDB(B0, 0, 0); PG8_SCHED; PG8_LDA(At, 0, 0); PG8_STAGE(PG8_SA(1, 1), a1 + hstep, voffA);
            PG8_WAIT_L(8); PG8_BAR; PG8_WAIT_L(0); PG8_MMA(0, 0, At, B0); PG8_BAR; PG8_SCHED;
            PG8_LDB(B1, 0, 1); PG8_STAGE(PG8_SB(0, 0), b2, voffB);
            PG8_BAR; PG8_WAIT_L(0); PG8_MMA(0, 1, At, B1); PG8_BAR;
            PG8_LDA(At, 0, 1); PG8_STAGE(PG8_SA(0, 0), a2, voffA);
            PG8_BAR; PG8_WAIT_L(0); PG8_MMA(1, 0, At, B0); PG8_BAR; PG8_SCHED;
            PG8_STAGE(PG8_SB(0, 1), b2 + hstep, voffB);
            PG8_WAIT_V(6); PG8_BAR; PG8_MMA(1, 1, At, B1); PG8_BAR;
            PG8_LDB(B0, 1, 0); PG8_SCHED; PG8_LDA(At, 1, 0); PG8_STAGE(PG8_SA(0, 1), a2 + hstep, voffA);
            PG8_WAIT_L(8); PG8_BAR; PG8_WAIT_L(0); PG8_MMA(0, 0, At, B0); PG8_BAR; PG8_SCHED;
            PG8_LDB(B1, 1, 1); PG8_STAGE(PG8_SB(1, 0), b3, voffB);
            PG8_BAR; PG8_WAIT_L(0); PG8_MMA(0, 1, At, B1); PG8_BAR;
            PG8_LDA(At, 1, 1); PG8_STAGE(PG8_SA(1, 0), a3, voffA);
            PG8_BAR; PG8_WAIT_L(0); PG8_MMA(1, 0, At, B0); PG8_BAR; PG8_SCHED;
            PG8_STAGE(PG8_SB(1, 1), b3 + hstep, voffB);
            PG8_WAIT_V(6); PG8_BAR; PG8_MMA(1, 1, At, B1); PG8_BAR;
            }
        }
        if constexpr (ALIGN_EPI) { if (wr == 0) PG8_BAR; }
        if constexpr (!Epi::AFTER_DRAIN) { E(acc, cur, wr, wc, fr, fq); S.done(cur); }
        if (!has_next) break;
#pragma unroll
        for (int a = 0; a < 2; ++a)
#pragma unroll
            for (int b = 0; b < 2; ++b)
#pragma unroll
                for (int m = 0; m < 4; ++m)
#pragma unroll
                    for (int n = 0; n < 2; ++n) acc[a][b][m][n] = (f32x4){0.f, 0.f, 0.f, 0.f};
        cur = nxt; cA = nA; cB = nB; ++ui;
        if constexpr (ALIGN_EPI) { if (wr == 1) PG8_BAR; }
    }
    PG8_WAIT_V(0);
    if constexpr (!ALIGN_EPI) { if (wr == 0) PG8_BAR; }
    PG8_BAR;
    if constexpr (Epi::AFTER_DRAIN) { E.fused(acc, cur, wr, wc, fr, fq, lds, wid, lane); S.done(cur); }
#undef PG8_SA
#undef PG8_SB
#undef PG8_STAGE
#undef PG8_LDA
#undef PG8_LDB
#undef PG8_MMA
#undef PG8_WAIT_V
#undef PG8_WAIT_L
#undef PG8_BAR
#undef PG8_SCHED
}
}

#define GAS __attribute__((address_space(1)))
#define LAS __attribute__((address_space(3)))
typedef unsigned short bf16;
typedef unsigned v4u __attribute__((ext_vector_type(4)));
typedef unsigned v2u __attribute__((ext_vector_type(2)));
typedef float f32x4 __attribute__((ext_vector_type(4)));
typedef float f32x2 __attribute__((ext_vector_type(2)));
typedef float f32x16 __attribute__((ext_vector_type(16)));
typedef short bf16x8 __attribute__((ext_vector_type(8)));
typedef short s16x4 __attribute__((ext_vector_type(4)));
#define LDS_WAIT() asm volatile("s_waitcnt lgkmcnt(0)" ::: "memory")
#define VM_WAIT() asm volatile("s_waitcnt vmcnt(0)" ::: "memory")
constexpr int NWAVES = 8;
constexpr int LDS_BYTES = 147456;
constexpr int MISC_OFF = 131072 + 8192;

__device__ __forceinline__ unsigned f2bf(float f) { unsigned u = __builtin_bit_cast(unsigned, f); return (u + 0x7fffu + ((u >> 16) & 1u)) >> 16; }
__device__ __forceinline__ unsigned pk2(float lo, float hi) { return f2bf(lo) | (f2bf(hi) << 16); }
__device__ __forceinline__ float bf2f(unsigned short b) { return __builtin_bit_cast(float, ((unsigned)b) << 16); }
__device__ __forceinline__ float wave_sum(float v) {
#pragma unroll
    for (int o = 1; o < 64; o <<= 1) v += __shfl_xor(v, o);
    return v;
}
__device__ __forceinline__ float softplus_f(float x) { return fmaxf(x, 0.f) + log1pf(expf(-fabsf(x))); }
__device__ __forceinline__ float sigmoid_f(float x) { return 1.0f / (1.0f + expf(-x)); }
__device__ __forceinline__ float silu_f(float x) { return x / (1.0f + expf(-x)); }

struct Params {
    const float* in[20];
    float* out; unsigned char* ws;
    int ph_lo, ph_hi;
};
struct Ctx { int tid, lane, wave, vcu, G; };

#define XB_TMO      128
#define XB_XCNT(j)  (256  + 64 * (j))
#define XB_XSUB(j)  (1280 + 64 * (j))
#define XB_XGEN(j)  (2304 + 64 * (j))
#define XB_TOP      3328
#define XB_TOPGEN   3392
#define XCD_BAR_WORDS 3456
#define XB_SPIN_CAP (1u << 18)

__device__ __forceinline__ unsigned xb_ld(unsigned* p)              { return __hip_atomic_load(p, __ATOMIC_RELAXED, __HIP_MEMORY_SCOPE_AGENT); }
__device__ __forceinline__ unsigned xb_add(unsigned* p, unsigned v) { return __hip_atomic_fetch_add(p, v, __ATOMIC_RELAXED, __HIP_MEMORY_SCOPE_AGENT); }
__device__ __forceinline__ unsigned xb_xcc_id() { return (unsigned)__builtin_amdgcn_s_getreg((3 << 11) | 20) & 0xFu; }
#define XB_SPIN(cond, bar) do { unsigned _sp = 0; while (cond) { __builtin_amdgcn_s_sleep(1); \
    if ((++_sp & 255u) == 0u) { if (xb_ld(&(bar)[XB_TMO])) break; if (_sp > XB_SPIN_CAP) { atomicAdd(&(bar)[XB_TMO], 1u); break; } } } } while (0)

struct XcdBarrier {
    unsigned* bar; unsigned x;
    volatile LAS unsigned* st;
};

__device__ __forceinline__ XcdBarrier xcd_barrier_post(unsigned* bar, volatile LAS unsigned* st) {
    XcdBarrier b; b.bar = bar; b.x = xb_xcc_id(); b.st = st;
    if (threadIdx.x == 0) (void)xb_add(&bar[XB_XCNT(b.x)], 1u);
    return b;
}
__device__ __forceinline__ void xcd_barrier_complete(unsigned* bar, unsigned x, unsigned& nloc, unsigned& nx) {
    const unsigned G = gridDim.x * gridDim.y * gridDim.z;
    unsigned sum, cnt, mine, sp = 0u;
    for (;;) {
        sum = 0u; cnt = 0u; mine = 0u;
#pragma unroll
        for (unsigned j = 0; j < 16; ++j) { const unsigned c = xb_ld(&bar[XB_XCNT(j)]); sum += c; cnt += (c > 0u) ? 1u : 0u; mine = (j == x) ? c : mine; }
        if (sum == G) break;
        __builtin_amdgcn_s_sleep(1);
        if ((++sp & 255u) == 0u) { if (xb_ld(&bar[XB_TMO])) break; if (sp > XB_SPIN_CAP) { atomicAdd(&bar[XB_TMO], 1u); break; } }
    }
    nloc = mine > 0u ? mine : 1u; nx = cnt > 0u ? cnt : 1u;
}

__device__ __forceinline__ void xcd_barrier(const XcdBarrier& b) {
    asm volatile("s_waitcnt vmcnt(0)" ::: "memory");
    __syncthreads();
    if (threadIdx.x == 0) {
        unsigned* bar = b.bar;
        __builtin_amdgcn_s_waitcnt(0);
        unsigned nloc = b.st[0], nx = b.st[1];
        if (nloc == 0u) { xcd_barrier_complete(bar, b.x, nloc, nx); b.st[0] = nloc; b.st[1] = nx; }
        const unsigned old = xb_add(&bar[XB_XSUB(b.x)], 1u);
        const unsigned gen = old / nloc;
        if (old + 1u == (gen + 1u) * nloc) {
            __builtin_amdgcn_fence(__ATOMIC_RELEASE, "agent");
            asm volatile("s_waitcnt vmcnt(0)" ::: "memory");
            const unsigned og = xb_add(&bar[XB_TOP], 1u);
            const unsigned tg = og / nx;
            if (og + 1u == (tg + 1u) * nx) xb_add(&bar[XB_TOPGEN], 1u);
            else XB_SPIN(xb_ld(&bar[XB_TOPGEN]) == tg, bar);
            __builtin_amdgcn_fence(__ATOMIC_ACQUIRE, "agent");
            xb_add(&bar[XB_XGEN(b.x)], 1u);
            asm volatile("s_waitcnt vmcnt(0)" ::: "memory");
        } else {
            XB_SPIN(xb_ld(&bar[XB_XGEN(b.x)]) == gen, bar);
            __builtin_amdgcn_fence(__ATOMIC_ACQUIRE, "agent");
            asm volatile("s_waitcnt vmcnt(0)" ::: "memory");
        }
    }
    __syncthreads();
}

__device__ __forceinline__ void transpose_item(const float* W, int ldw, int c0, int K, int ncols, const float* scale, bf16* WT, int row_off, LAS float* scr, int item, int lane) {
    const int nblk = ncols / 32, kb = item / nblk, nb = item % nblk, k0 = 64 * kb, n0 = 32 * nb;
#pragma unroll 8
    for (int i = 0; i < 32; ++i) { const int kk = 2 * i + (lane >> 5); float w = W[(size_t)(k0 + kk) * ldw + c0 + n0 + (lane & 31)]; if (scale) w *= scale[k0 + kk]; scr[kk * 33 + (lane & 31)] = w; }
    LDS_WAIT(); asm volatile("" ::: "memory");
    const int c = lane & 7;
#pragma unroll
    for (int j = 0; j < 4; ++j) { const int n = (lane >> 3) + 8 * j; const LAS float* s = scr + (8 * c) * 33 + n;
        v4u o; o.x = pk2(s[0 * 33], s[1 * 33]); o.y = pk2(s[2 * 33], s[3 * 33]); o.z = pk2(s[4 * 33], s[5 * 33]); o.w = pk2(s[6 * 33], s[7 * 33]);
        *(GAS v4u*)(WT + (size_t)(row_off + n0 + n) * K + k0 + 8 * c) = o; }
    LDS_WAIT(); asm volatile("" ::: "memory");
}

__device__ __forceinline__ void phase_prep(const Params& P, const Ctx& C, LAS unsigned char* lds) {
    unsigned char* ws = P.ws;
    const float* xp = P.in[0]; const float* xs = P.in[1]; const float* ln1 = P.in[8]; const float* w_in = P.in[9]; const float* b_f = P.in[10];
    const float* a_log = P.in[12]; const float* dt_bias = P.in[13]; const float* w_o = P.in[15]; const float* ln2 = P.in[16]; const float* w_up = P.in[17]; const float* w_down = P.in[18];
    bf16* XN = (bf16*)(ws + WS_XN);
    float* LF = (float*)(ws + WS_LF); float* BETA = (float*)(ws + WS_BETA); float* Gg = (float*)(ws + WS_G);
    LAS float* WSm = (LAS float*)lds;
    LAS float* scr = (LAS float*)(lds + 49152 + C.wave * 8448);
    for (int idx = C.tid; idx < 12 * 1024; idx += NWAVES * 64) { const int k = idx / 12, c = idx % 12; const int col = c < 4 ? 1536 + c : 3588 + (c - 4); WSm[c * 1024 + k] = w_in[(size_t)k * INDIM + col]; }
    __syncthreads();
    const int gw = C.vcu * NWAVES + C.wave, NGW = C.G * NWAVES, lane = C.lane;
    f32x4 lw[4];
#pragma unroll
    for (int j = 0; j < 4; ++j) lw[j] = ((const f32x4*)ln1)[lane + 64 * j];
    for (int m = gw; m < M_TOT; m += NGW) {
        const float* xr = m < MP ? xp + (size_t)m * DM : xs + (size_t)(m - MP) * DM;
        f32x4 v[4]; float ss = 0.f;
#pragma unroll
        for (int j = 0; j < 4; ++j) { v[j] = ((const f32x4*)xr)[lane + 64 * j]; ss += (v[j][0] * v[j][0] + v[j][1] * v[j][1]) + (v[j][2] * v[j][2] + v[j][3] * v[j][3]); }
        ss = wave_sum(ss);
        const float rstd = 1.0f / sqrtf(ss * (1.0f / DM) + RMS_EPS);
#pragma unroll
        for (int j = 0; j < 4; ++j) { v[j] = v[j] * rstd * lw[j];
            v2u o; o.x = pk2(v[j][0], v[j][1]); o.y = pk2(v[j][2], v[j][3]);
            *(v2u*)(XN + (size_t)m * DM + 4 * lane + 256 * j) = o; }
        float mine = 0.f;
#pragma unroll
        for (int c = 0; c < 12; ++c) { float a = 0.f;
#pragma unroll
            for (int j = 0; j < 4; ++j) { const f32x4 w = *(const LAS f32x4*)(WSm + c * 1024 + 4 * lane + 256 * j); a += (v[j][0] * w[0] + v[j][1] * w[1]) + (v[j][2] * w[2] + v[j][3] * w[3]); }
            a = wave_sum(a); mine = (lane == c) ? a : mine; }
        const float bb = __shfl(mine, (lane + 4) & 63), aa = __shfl(mine, (lane + 8) & 63);
        if (lane < 4) {
            const float fa = mine;
            const float lf = -softplus_f(-(fa + b_f[lane]));
            const float beta = sigmoid_f(bb);
            const float g = -expf(a_log[lane]) * softplus_f(aa + dt_bias[lane]);
            LF[(size_t)m * 4 + lane] = lf; BETA[(size_t)m * 4 + lane] = beta; Gg[(size_t)m * 4 + lane] = g;
            if (m < MP) P.out[OLF_P + (size_t)m * 4 + lane] = lf; else P.out[OLF_S + (size_t)(m - MP) * 4 + lane] = lf;
        }
    }
    bf16* W1T = (bf16*)(ws + WS_W1T); bf16* WOT = (bf16*)(ws + WS_WOT); bf16* WUPT = (bf16*)(ws + WS_WUPT); bf16* WDNT = (bf16*)(ws + WS_WDNT);
    for (int it = gw; it < 16 * 48; it += NGW) transpose_item(w_in, INDIM, 0, DM, 1536, nullptr, W1T, 0, scr, it, lane);
    for (int it = gw; it < 16 * 48; it += NGW) transpose_item(w_in, INDIM, 1540, DM, 1536, nullptr, W1T, 1536, scr, it, lane);
    for (int it = gw; it < 16 * 16; it += NGW) transpose_item(w_in, INDIM, 3076, DM, 512, nullptr, W1T, 3072, scr, it, lane);
    for (int it = gw; it < 16 * 32; it += NGW) transpose_item(w_o, DM, 0, DM, DM, nullptr, WOT, 0, scr, it, lane);
    for (int it = gw; it < 16 * 128; it += NGW) transpose_item(w_up, FF, 0, DM, FF, ln2, WUPT, 0, scr, it, lane);
    for (int it = gw; it < 64 * 32; it += NGW) transpose_item(w_down, DM, 0, FF, DM, nullptr, WDNT, 0, scr, it, lane);
}

__device__ __forceinline__ void kbias_seq(const Params& P, int bh, int lane) {
    const float* LF = (const float*)(P.ws + WS_LF); float* KBIAS = (float*)(P.ws + WS_KBIAS);
    const int b = bh >> 2, h = bh & 3;
    const float* src = LF + ((size_t)b * SEQ + 32 * lane) * 4 + h;
    float s = 0.f;
    for (int i = 0; i < 32; ++i) s += src[i * 4];
    float x = s;
#pragma unroll
    for (int o = 1; o < 64; o <<= 1) { const float y = __shfl_up(x, o); if (lane >= o) x += y; }
    float run = x - s;
    float* dst = KBIAS + (size_t)bh * SEQ + 32 * lane;
    const float inv = -11.313708498984761f;
    for (int i = 0; i < 32; ++i) { run += src[i * 4]; dst[i] = run * inv; }
}


namespace fox {
constexpr int D = 128, NW = 8, QBLK = 32, KVBLK = 64, QB = NW * QBLK;
constexpr int SHM_V = KVBLK * D * 2, SHM_K = KVBLK * D * 2;
constexpr float SCALE = 0.08838834764831845f, THR = 8.f;
#define KSWZ(row, colB) ((row) * 256 + ((colB) ^ (((row) & 7) << 4)))
#define SBAR() __builtin_amdgcn_sched_barrier(0)
__device__ __forceinline__ int v_st(int k, int c) { const int kk = (k & ~0xC) | ((k & 4) << 1) | ((k & 8) >> 1); return ((kk >> 3) * 4 + (c >> 5)) * 512 + ((kk & 7) * 32 + (c & 31)) * 2; }
__device__ __forceinline__ int v_rd_base(int lane) { return ((lane & 3) << 3) | (((lane >> 2) & 3) << 6) | (((lane >> 4) & 1) << 5) | (((lane >> 5) & 1) << 8); }
constexpr int v_rd_off(int d0, int ks, int half) { return d0 * 512 + ks * 4096 + half * 2048; }
__device__ __forceinline__ int crow(int r, int hi) { return (r & 3) + 8 * (r >> 2) + 4 * hi; }
__device__ __forceinline__ unsigned cvtpk(float lo, float hi) { unsigned r; asm volatile("v_cvt_pk_bf16_f32 %0, %1, %2" : "=v"(r) : "v"(lo), "v"(hi)); return r; }
__device__ __forceinline__ void mask_tile(f32x16& p0, f32x16& p1, int dq, unsigned W) {
    const float NEG = -__builtin_inff();
#pragma unroll
    for (int r = 0; r < 16; ++r) {
        const int c = (r & 3) + 8 * (r >> 2);
        if ((unsigned)(dq - c) >= W) p0[r] = NEG;
        if ((unsigned)(dq - c - 32) >= W) p1[r] = NEG;
    }
}
__device__ __forceinline__ void partialSM(f32x16& p0, f32x16& p1, float& m_reg, float& mn, float& alpha) {
    float pmax = p0[0]; for (int r = 1; r < 16; ++r) pmax = fmaxf(pmax, p0[r]); for (int r = 0; r < 16; ++r) pmax = fmaxf(pmax, p1[r]);
    { auto rr = __builtin_amdgcn_permlane32_swap(__float_as_uint(pmax), __float_as_uint(pmax), false, false);
      pmax = fmaxf(__uint_as_float(rr[0]), __uint_as_float(rr[1])); }
    constexpr float C2 = 1.4426950408889634f * SCALE;
    if (__builtin_expect(__all((pmax - m_reg) * SCALE <= THR), 1)) { mn = m_reg; alpha = 1.f; }
    else { mn = fmaxf(m_reg, pmax); alpha = __builtin_amdgcn_exp2f((m_reg - mn) * C2); m_reg = mn; }
    const float mnL = -mn * C2;
    for (int r = 0; r < 16; ++r) p0[r] = fmaf(p0[r], C2, mnL); for (int r = 0; r < 16; ++r) p1[r] = fmaf(p1[r], C2, mnL);
    for (int r = 0; r < 16; ++r) p0[r] = __builtin_amdgcn_exp2f(p0[r]);
}
__device__ __forceinline__ void finishSM(f32x16& p0, f32x16& p1, float alpha, float& l_reg, bf16x8& pa0, bf16x8& pa1, bf16x8& pa2, bf16x8& pa3) {
    for (int r = 0; r < 16; ++r) p1[r] = __builtin_amdgcn_exp2f(p1[r]);
    float ps = 0; for (int r = 0; r < 16; ++r) ps += p0[r]; for (int r = 0; r < 16; ++r) ps += p1[r];
    { auto rr = __builtin_amdgcn_permlane32_swap(__float_as_uint(ps), __float_as_uint(ps), false, false);
      ps = __uint_as_float(rr[0]) + __uint_as_float(rr[1]); }
    l_reg = l_reg * alpha + ps;
#define PK4(P, B_, OUT) do { unsigned a0 = cvtpk(P[B_+0], P[B_+1]), a1 = cvtpk(P[B_+2], P[B_+3]);                          \
        unsigned b0 = cvtpk(P[B_+4], P[B_+5]), b1 = cvtpk(P[B_+6], P[B_+7]);                                             \
        auto r0 = __builtin_amdgcn_permlane32_swap(a0, b0, false, false); auto r1 = __builtin_amdgcn_permlane32_swap(a1, b1, false, false); \
        v4u w = {r0[0], r1[0], r0[1], r1[1]}; OUT = *reinterpret_cast<bf16x8*>(&w); } while (0)
    PK4(p0, 0, pa0); PK4(p0, 8, pa1); PK4(p1, 0, pa2); PK4(p1, 8, pa3);
#undef PK4
}
template <int KB>
__device__ __forceinline__ void qkt(f32x16& p0, f32x16& p1, const char* K_lds, const float* bias_l, int r32, int hi, const bf16x8* qr) {
#pragma unroll
    for (int g = 0; g < 4; ++g) { const f32x4 t0 = *(const f32x4*)(bias_l + 8 * g + 4 * hi), t1 = *(const f32x4*)(bias_l + 32 + 8 * g + 4 * hi);
#pragma unroll
        for (int i = 0; i < 4; ++i) { p0[4 * g + i] = t0[i]; p1[4 * g + i] = t1[i]; } }
    const char* kb[4];
#pragma unroll
    for (int dd = 0; dd < 4; ++dd) kb[dd] = K_lds + KB * SHM_K + KSWZ(r32, (dd * 16 + hi * 8) * 2);
#pragma unroll
    for (int d0 = 0; d0 < 8; ++d0) { const char* a = kb[d0 & 3] + (d0 >> 2) * 128;
        bf16x8 b0 = *reinterpret_cast<const bf16x8*>(a);
        bf16x8 b1 = *reinterpret_cast<const bf16x8*>(a + 32 * 256);
        p0 = __builtin_amdgcn_mfma_f32_32x32x16_bf16(b0, qr[d0], p0, 0, 0, 0);
        p1 = __builtin_amdgcn_mfma_f32_32x32x16_bf16(b1, qr[d0], p1, 0, 0, 0); }
}
template <int VB>
__device__ __forceinline__ void pv_tile(f32x16* o, int vb0, bf16x8 pa0, bf16x8 pa1, bf16x8 pa2, bf16x8 pa3) {
#define TRRD(dst, off) asm volatile("ds_read_b64_tr_b16 %0, %1 offset:%2" : "=&v"(dst) : "v"(vb0), "i"(off) : "memory")
#define PV_D0(d0) do { s16x4 l0, l1, l2, l3, h0, h1, h2, h3; constexpr int b_ = VB * SHM_V + v_rd_off(d0, 0, 0);   \
        TRRD(l0, b_); TRRD(h0, b_ + 2048); TRRD(l1, b_ + 4096); TRRD(h1, b_ + 6144); TRRD(l2, b_ + 8192); TRRD(h2, b_ + 10240); TRRD(l3, b_ + 12288); TRRD(h3, b_ + 14336); \
        asm volatile("s_waitcnt lgkmcnt(0)" ::: "memory"); SBAR();   \
        o[d0] = __builtin_amdgcn_mfma_f32_32x32x16_bf16(pa0, (bf16x8){l0[0], l0[1], l0[2], l0[3], h0[0], h0[1], h0[2], h0[3]}, o[d0], 0, 0, 0);   \
        o[d0] = __builtin_amdgcn_mfma_f32_32x32x16_bf16(pa1, (bf16x8){l1[0], l1[1], l1[2], l1[3], h1[0], h1[1], h1[2], h1[3]}, o[d0], 0, 0, 0);   \
        o[d0] = __builtin_amdgcn_mfma_f32_32x32x16_bf16(pa2, (bf16x8){l2[0], l2[1], l2[2], l2[3], h2[0], h2[1], h2[2], h2[3]}, o[d0], 0, 0, 0);   \
        o[d0] = __builtin_amdgcn_mfma_f32_32x32x16_bf16(pa3, (bf16x8){l3[0], l3[1], l3[2], l3[3], h3[0], h3[1], h3[2], h3[3]}, o[d0], 0, 0, 0); } while (0)
    PV_D0(0); PV_D0(1); PV_D0(2); PV_D0(3);
#undef PV_D0
#undef TRRD
}

__device__ __forceinline__ void fox_block(char* lds, const bf16* Qh, const bf16* Kh, const bf16* Vh, const float* kbias, bf16* Orow0, int qb) {
    const int tid = threadIdx.x, wid = __builtin_amdgcn_readfirstlane(tid >> 6), lane = tid & 63, r32 = lane & 31, hi = lane >> 5;
    const int P0 = qb * QB, qlo = P0 + wid * QBLK, qm = qlo + r32 - 4 * hi;
    char* V_lds = lds; char* K_lds = lds + SHM_V;
    float* bias_l = (float*)(lds + SHM_V + SHM_K);
    float* wsf = bias_l + 64 + wid * 64; float* li_l = wsf; float* al_l = wsf + 32;
    bf16x8 qr[8];
#pragma unroll
    for (int d0 = 0; d0 < 8; ++d0) qr[d0] = *reinterpret_cast<const bf16x8*>(Qh + (size_t)(qlo + r32) * D + d0 * 16 + hi * 8);
    float m_reg = -1e30f, l_reg = 0.f; f32x16 o[4] = {};
    const int sr = tid >> 4, sc = (tid & 15) * 8, vst0 = v_st(sr, sc), vst1 = v_st(32 + sr, sc), kws = KSWZ(sr, sc * 2);
    const int vb0 = (int)(uintptr_t)V_lds + v_rd_base(lane);
    const int ntiles = P0 / KVBLK + 4;
    for (int j = ntiles - 1; j >= 0; --j) {
        const int kb = j * KVBLK;
        __syncthreads();
        { const bf16x8 k0 = *reinterpret_cast<const bf16x8*>(Kh + (size_t)(kb + sr) * D + sc), k1 = *reinterpret_cast<const bf16x8*>(Kh + (size_t)(kb + 32 + sr) * D + sc);
          const bf16x8 v0 = *reinterpret_cast<const bf16x8*>(Vh + (size_t)(kb + sr) * D + sc), v1 = *reinterpret_cast<const bf16x8*>(Vh + (size_t)(kb + 32 + sr) * D + sc);
          *(bf16x8*)(K_lds + kws) = k0; *(bf16x8*)(K_lds + kws + 32 * 256) = k1; *(bf16x8*)(V_lds + vst0) = v0; *(bf16x8*)(V_lds + vst1) = v1;
          if (tid < 64) bias_l[tid] = kbias[kb + tid]; }
        __syncthreads();
        if (kb <= qlo + QBLK - 1) {
            f32x16 p0, p1; float mn, al; bf16x8 pa0, pa1, pa2, pa3;
            qkt<0>(p0, p1, K_lds, bias_l, r32, hi, qr);
            if (kb + KVBLK - 1 > qlo) mask_tile(p0, p1, qm - kb, 0x40000000u);
            partialSM(p0, p1, m_reg, mn, al);
            if (__any(al < 1.f)) { if (hi == 0) al_l[r32] = al; asm volatile("s_waitcnt lgkmcnt(0)" ::: "memory");
                for (int d_ = 0; d_ < 4; ++d_) for (int r = 0; r < 16; ++r) o[d_][r] *= al_l[crow(r, hi)]; }
            finishSM(p0, p1, al, l_reg, pa0, pa1, pa2, pa3); SBAR();
            pv_tile<0>(o, vb0, pa0, pa1, pa2, pa3);
        }
    }
    if (hi == 0) li_l[r32] = l_reg; asm volatile("s_waitcnt lgkmcnt(0)" ::: "memory");
    float rli[16];
#pragma unroll
    for (int r = 0; r < 16; ++r) rli[r] = __builtin_amdgcn_rcpf(li_l[crow(r, hi)]);
    bf16* Ow = Orow0 + (size_t)qlo * DM;
#pragma unroll
    for (int r = 0; r < 16; ++r) { const int orow = crow(r, hi);
#pragma unroll
        for (int d0 = 0; d0 < 4; ++d0) { const float v = o[d0][r] * rli[r];
            const float vn = __shfl_xor(v, 1);
            if ((r32 & 1) == 0) *(unsigned*)(Ow + (size_t)orow * DM + d0 * 32 + r32) = cvtpk(v, vn); } }
    __syncthreads();
}
}


__device__ __forceinline__ void dec_update(float& m, float& l, f32x4& acc, const float (&x)[4], const f32x4 (&v)[4], int n) {
    float mx = m;
#pragma unroll
    for (int u = 0; u < 4; ++u) if (u < n) mx = fmaxf(mx, x[u]);
    const float al = __expf(m - mx);
    float ps = 0.f; f32x4 a = acc * al;
#pragma unroll
    for (int u = 0; u < 4; ++u) if (u < n) { const float p = __expf(x[u] - mx); ps += p; a += v[u] * p; }
    l = l * al + ps; acc = a; m = mx;
}
__device__ __forceinline__ float red32(float s) {
#pragma unroll
    for (int o = 1; o < 32; o <<= 1) s += __shfl_xor(s, o);
    return s;
}
__device__ __forceinline__ void decode_unit(const Params& P, LAS unsigned char* lds, int db) {
    const int tid = threadIdx.x, wid = __builtin_amdgcn_readfirstlane(tid >> 6), lane = tid & 63, hi = lane >> 5;
    const float* cache_k = P.in[2]; const float* cache_v = P.in[3]; const float* cache_lf = P.in[4]; const int* page_table = (const int*)P.in[5];
    const float* LF = (const float*)(P.ws + WS_LF); const float* QS = (const float*)(P.ws + WS_QS);
    bf16* MIX = (bf16*)(P.ws + WS_MIX);
    LAS f32x4* lfs = (LAS f32x4*)lds;
    LAS f32x4* wt = lfs + 2048;
    LAS float* cm = (LAS float*)(wt + 8);
    LAS float* cl = cm + 32;
    LAS f32x4* cacc = (LAS f32x4*)(cl + 32);
    const int ptv = (lane < NPAGES) ? page_table[db * NPAGES + lane] : 0;
#pragma unroll
    for (int i = 0; i < 4; ++i) { const int j = tid + 512 * i; const int pg = __shfl(ptv, j >> 7);
        lfs[j] = *(const f32x4*)(cache_lf + ((size_t)pg * PAGE + (j & 127)) * 4); }
    __syncthreads();
    {
        const f32x4 a0 = lfs[4 * tid], a1 = lfs[4 * tid + 1], a2 = lfs[4 * tid + 2], a3 = lfs[4 * tid + 3];
        const f32x4 tot = (a0 + a1) + (a2 + a3);
        f32x4 x = tot;
#pragma unroll
        for (int o = 1; o < 64; o <<= 1) { f32x4 y; y[0] = __shfl_down(x[0], o); y[1] = __shfl_down(x[1], o); y[2] = __shfl_down(x[2], o); y[3] = __shfl_down(x[3], o); if (lane + o < 64) x += y; }
        if (lane == 0) wt[wid] = x;
        __syncthreads();
        f32x4 after = {0.f, 0.f, 0.f, 0.f};
        for (int w2 = wid + 1; w2 < NWAVES; ++w2) after += wt[w2];
        const f32x4 lfn = *(const f32x4*)(LF + (size_t)(MP + db) * 4);
        const f32x4 B3 = (x - tot) + after + lfn, B2 = B3 + a3, B1 = B2 + a2, B0 = B1 + a1;
        lfs[4 * tid] = B0; lfs[4 * tid + 1] = B1; lfs[4 * tid + 2] = B2; lfs[4 * tid + 3] = B3;
    }
    __syncthreads();
    const float* qs = QS + (size_t)db * 512;
    const f32x4 qa = *(const f32x4*)(qs + 4 * lane) * ATT_SCALE, qb = *(const f32x4*)(qs + 256 + 4 * lane) * ATT_SCALE;
    float m0 = -1e30f, l0 = 0.f, m1 = -1e30f, l1 = 0.f; f32x4 acc0 = {0.f, 0.f, 0.f, 0.f}, acc1 = {0.f, 0.f, 0.f, 0.f};
    for (int j0 = wid; j0 < PAST; j0 += 32) {
        f32x4 ka[4], kb[4], va[4], vb[4]; float x0[4], x1[4];
#pragma unroll
        for (int u = 0; u < 4; ++u) { const int j = j0 + 8 * u; const int pg = __builtin_amdgcn_readlane(ptv, j >> 7);
            const size_t ro = ((size_t)pg * PAGE + (j & 127)) * 512 + 4 * lane;
            ka[u] = *(const f32x4*)(cache_k + ro); kb[u] = *(const f32x4*)(cache_k + ro + 256);
            va[u] = *(const f32x4*)(cache_v + ro); vb[u] = *(const f32x4*)(cache_v + ro + 256); }
#pragma unroll
        for (int u = 0; u < 4; ++u) { const int j = j0 + 8 * u;
            float s0 = (qa[0] * ka[u][0] + qa[1] * ka[u][1]) + (qa[2] * ka[u][2] + qa[3] * ka[u][3]);
            float s1 = (qb[0] * kb[u][0] + qb[1] * kb[u][1]) + (qb[2] * kb[u][2] + qb[3] * kb[u][3]);
            s0 = red32(s0); s1 = red32(s1);
            const f32x4 bj = lfs[j];
            x0[u] = s0 + (hi ? bj[1] : bj[0]); x1[u] = s1 + (hi ? bj[3] : bj[2]); }
        dec_update(m0, l0, acc0, x0, va, 4); dec_update(m1, l1, acc1, x1, vb, 4);
    }
    if (wid == 0) {
        f32x4 va[4], vb[4]; float x0[4], x1[4];
        const float* kn = P.out + OK_S + (size_t)db * 512; const float* vn = P.out + OV_S + (size_t)db * 512;
        const f32x4 ka = *(const f32x4*)(kn + 4 * lane), kb = *(const f32x4*)(kn + 256 + 4 * lane);
        va[0] = *(const f32x4*)(vn + 4 * lane); vb[0] = *(const f32x4*)(vn + 256 + 4 * lane);
#pragma unroll
        for (int u = 1; u < 4; ++u) { va[u] = va[0]; vb[u] = vb[0]; }
        x0[0] = red32((qa[0] * ka[0] + qa[1] * ka[1]) + (qa[2] * ka[2] + qa[3] * ka[3]));
        x1[0] = red32((qb[0] * kb[0] + qb[1] * kb[1]) + (qb[2] * kb[2] + qb[3] * kb[3]));
#pragma unroll
        for (int u = 1; u < 4; ++u) { x0[u] = x0[0]; x1[u] = x1[0]; }
        dec_update(m0, l0, acc0, x0, va, 1); dec_update(m1, l1, acc1, x1, vb, 1);
    }
    if ((lane & 31) == 0) { cm[wid * 4 + hi] = m0; cm[wid * 4 + 2 + hi] = m1; cl[wid * 4 + hi] = l0; cl[wid * 4 + 2 + hi] = l1; }
    cacc[(wid * 2 + 0) * 64 + lane] = acc0; cacc[(wid * 2 + 1) * 64 + lane] = acc1;
    __syncthreads();
    if (tid < 128) {
        const int ab = tid >> 6, l = tid & 63, head = 2 * ab + (l >> 5);
        float M = -1e30f;
#pragma unroll
        for (int w = 0; w < NWAVES; ++w) M = fmaxf(M, cm[w * 4 + head]);
        float L = 0.f; f32x4 O = {0.f, 0.f, 0.f, 0.f};
#pragma unroll
        for (int w = 0; w < NWAVES; ++w) { const float e = __expf(cm[w * 4 + head] - M); L += cl[w * 4 + head] * e; O += cacc[(w * 2 + ab) * 64 + l] * e; }
        const float inv = 1.0f / L;
        v2u o; o.x = pk2(O[0] * inv, O[1] * inv); o.y = pk2(O[2] * inv, O[3] * inv);
        *(v2u*)(MIX + (size_t)(MP + db) * DM + head * 128 + 4 * (l & 31)) = o;
    }
    __syncthreads();
}

__device__ __forceinline__ void sgdn_unit(const Params& P, LAS unsigned char* lds, int db, int h) {
    const int tid = threadIdx.x, wid = __builtin_amdgcn_readfirstlane(tid >> 6), lane = tid & 63;
    const float* state_conv = P.in[6]; const float* state_ssm = P.in[7]; const float* w_conv = P.in[11]; const float* w_gnorm = P.in[14];
    const float* BETA = (const float*)(P.ws + WS_BETA); const float* Gg = (const float*)(P.ws + WS_G);
    const bf16* ZB = (const bf16*)(P.ws + WS_ZB); bf16* MIX = (bf16*)(P.ws + WS_MIX);
    LAS float* xs = (LAS float*)lds;
    LAS float* red1 = xs + 384;
    LAS float* red2 = red1 + 1024;
    LAS float* ov = red2 + 1024;
    if (tid < 384) {
        const int seg = tid >> 7, d = tid & 127, ch = seg * 512 + h * 128 + d;
        const float* sc = state_conv + (size_t)db * 3 * CONVD + ch;
        float* oc = P.out + OCONV_S + (size_t)db * 3 * CONVD + ch;
        const float c0 = sc[0], c1 = sc[CONVD], c2 = sc[2 * CONVD], c3 = oc[2 * CONVD];
        const float a = c0 * w_conv[ch] + c1 * w_conv[CONVD + ch] + c2 * w_conv[2 * CONVD + ch] + c3 * w_conv[3 * CONVD + ch];
        xs[tid] = silu_f(a);
        oc[0] = c1; oc[CONVD] = c2;
    }
    __syncthreads();
    if (wid < 2) {
        const float a = xs[wid * 128 + lane], b = xs[wid * 128 + 64 + lane];
        const float ss = wave_sum(a * a + b * b);
        const float sc = (1.0f / sqrtf(ss + L2_EPS)) * (wid == 0 ? ATT_SCALE : 1.0f);
        xs[wid * 128 + lane] = a * sc; xs[wid * 128 + 64 + lane] = b * sc;
    }
    __syncthreads();
    const float gsc = expf(Gg[(size_t)(MP + db) * 4 + h]), bt = BETA[(size_t)(MP + db) * 4 + h];
    const float* Sp = state_ssm + ((size_t)(db * 4 + h) * 128 + 16 * wid) * 128 + 2 * lane;
    f32x2 s[16]; f32x2 ks = {0.f, 0.f};
#pragma unroll
    for (int r = 0; r < 16; ++r) { s[r] = *(const f32x2*)(Sp + (size_t)r * 128) * gsc; const float kd = xs[128 + 16 * wid + r]; ks += s[r] * kd; }
    *(LAS f32x2*)(red1 + wid * 128 + 2 * lane) = ks;
    __syncthreads();
    f32x2 kS = {0.f, 0.f};
#pragma unroll
    for (int w = 0; w < NWAVES; ++w) kS += *(const LAS f32x2*)(red1 + w * 128 + 2 * lane);
    const f32x2 vv = *(const LAS f32x2*)(xs + 256 + 2 * lane);
    const f32x2 delta = (vv - kS) * bt;
    float* So = P.out + OSSM_S + ((size_t)(db * 4 + h) * 128 + 16 * wid) * 128 + 2 * lane;
    f32x2 os = {0.f, 0.f};
#pragma unroll
    for (int r = 0; r < 16; ++r) { const float kd = xs[128 + 16 * wid + r], qd = xs[16 * wid + r]; s[r] += delta * kd; *(f32x2*)(So + (size_t)r * 128) = s[r]; os += s[r] * qd; }
    *(LAS f32x2*)(red2 + wid * 128 + 2 * lane) = os;
    __syncthreads();
    if (tid < 128) { float o = 0.f;
#pragma unroll
        for (int w = 0; w < NWAVES; ++w) o += red2[w * 128 + tid];
        ov[tid] = o; }
    __syncthreads();
    if (wid == 0) {
        const float a = ov[lane], b = ov[64 + lane];
        const float ss = wave_sum(a * a + b * b);
        const float rstd = 1.0f / sqrtf(ss * (1.0f / 128.0f) + RMS_EPS);
        const bf16* zr = ZB + (size_t)(MP + db) * 512 + h * 128;
        bf16* mr = MIX + (size_t)(MP + db) * DM + 512 + h * 128;
        mr[lane] = (bf16)f2bf(a * rstd * w_gnorm[lane] * silu_f(bf2f(zr[lane])));
        mr[64 + lane] = (bf16)f2bf(b * rstd * w_gnorm[64 + lane] * silu_f(bf2f(zr[64 + lane])));
    }
    __syncthreads();
}


constexpr int XS = 132, LS = 68;
__device__ __forceinline__ void gdna_unit(const Params& P, LAS unsigned char* lds, int unit) {
    const int tid = threadIdx.x, wid = __builtin_amdgcn_readfirstlane(tid >> 6), lane = tid & 63;
    const int n = unit & 31, bh = unit >> 5, b = bh >> 2, h = bh & 3, m0 = b * SEQ + n * GCH;
    const float* w_conv = P.in[11];
    const bf16* CB = (const bf16*)(P.ws + WS_CB);
    const float* BETA = (const float*)(P.ws + WS_BETA); const float* Gg = (const float*)(P.ws + WS_G);
    float* UT = (float*)(P.ws + WS_UT) + (size_t)unit * 8192; bf16* WN = (bf16*)(P.ws + WS_WN) + (size_t)unit * 8192; bf16* QG = (bf16*)(P.ws + WS_QG) + (size_t)unit * 8192;
    bf16* KGT = (bf16*)(P.ws + WS_KGT) + (size_t)unit * 8192; bf16* QKM = (bf16*)(P.ws + WS_QKM) + (size_t)unit * 4096; float* GL = (float*)(P.ws + WS_GL);
    LAS float* XQ = (LAS float*)lds; LAS float* XK = XQ + 64 * XS; LAS float* XV = XK + 64 * XS;
    LAS float* Lm = XV + 64 * XS;
    LAS float* gcs = Lm + 64 * LS; LAS float* bts = gcs + 64; LAS float* sks = bts + 64;
    if (tid < 384) {
        const int seg = tid >> 7, d = tid & 127, ch = seg * 512 + h * 128 + d;
        const float w0 = w_conv[ch], w1 = w_conv[CONVD + ch], w2 = w_conv[2 * CONVD + ch], w3 = w_conv[3 * CONVD + ch];
        const bf16* src = CB + (size_t)m0 * CONVD + ch;
        float x0 = 0.f, x1 = 0.f, x2 = 0.f;
        if (n > 0) { x0 = bf2f(src[-3 * CONVD]); x1 = bf2f(src[-2 * CONVD]); x2 = bf2f(src[-1 * CONVD]); }
        LAS float* X = XQ + seg * 64 * XS + d;
#pragma unroll 4
        for (int i = 0; i < 64; ++i) { const float x3 = bf2f(src[(size_t)i * CONVD]); X[i * XS] = silu_f((x0 * w0 + x1 * w1) + (x2 * w2 + x3 * w3)); x0 = x1; x1 = x2; x2 = x3; }
    }
    if (wid == 7) {
        const float g = Gg[(size_t)(m0 + lane) * 4 + h]; float x = g;
#pragma unroll
        for (int o = 1; o < 64; o <<= 1) { const float y = __shfl_up(x, o); if (lane >= o) x += y; }
        { const float bt_ = BETA[(size_t)(m0 + lane) * 4 + h]; gcs[lane] = x; bts[lane] = bt_; sks[lane] = bt_ * expf(x); }
    }
    __syncthreads();
#pragma unroll
    for (int rr = 0; rr < 16; ++rr) { const int isq = rr < 8, i = 8 * wid + (rr & 7); LAS float* X = (isq ? XQ : XK) + i * XS;
        const float a = X[lane], c = X[64 + lane]; const float ss = wave_sum(a * a + c * c);
        const float sc = (1.0f / sqrtf(ss + L2_EPS)) * (isq ? ATT_SCALE : 1.0f);
        X[lane] = a * sc; X[64 + lane] = c * sc; }
    __syncthreads();
    {
        const int i = tid >> 3, tj = tid & 7;
        float akk[8], aqk[8];
#pragma unroll
        for (int jj = 0; jj < 8; ++jj) { akk[jj] = 0.f; aqk[jj] = 0.f; }
        if (tj * 8 <= i) {
            for (int d = 0; d < 128; d += 4) {
                const f32x4 ki = *(const LAS f32x4*)(XK + i * XS + d), qi = *(const LAS f32x4*)(XQ + i * XS + d);
#pragma unroll
                for (int jj = 0; jj < 8; ++jj) { const f32x4 kj = *(const LAS f32x4*)(XK + (tj * 8 + jj) * XS + d);
                    akk[jj] += (ki[0] * kj[0] + ki[1] * kj[1]) + (ki[2] * kj[2] + ki[3] * kj[3]);
                    aqk[jj] += (qi[0] * kj[0] + qi[1] * kj[1]) + (qi[2] * kj[2] + qi[3] * kj[3]); }
            }
        }
        const float gi = gcs[i], bi = bts[i];
        v4u qo; unsigned qw[4];
#pragma unroll
        for (int jj = 0; jj < 8; jj += 2) {
            float lv[2], qv[2];
#pragma unroll
            for (int e = 0; e < 2; ++e) { const int j = tj * 8 + jj + e; const float dec = (j <= i) ? expf(gi - gcs[j]) : 0.f;
                lv[e] = (j < i) ? bi * akk[jj + e] * dec : 0.f; qv[e] = (j <= i) ? aqk[jj + e] * dec : 0.f; }
            Lm[i * LS + tj * 8 + jj] = lv[0]; Lm[i * LS + tj * 8 + jj + 1] = lv[1];
            qw[jj >> 1] = pk2(qv[0], qv[1]);
        }
        qo.x = qw[0]; qo.y = qw[1]; qo.z = qw[2]; qo.w = qw[3];
        *(v4u*)(QKM + (size_t)i * 64 + tj * 8) = qo;
    }
    __syncthreads();
    if (tid < 256) {
        const int c = tid; const bool isv = c < 128; const LAS float* X = isv ? (XV + c) : (XK + (c - 128)); const LAS float* scp = isv ? bts : sks;
        int vz; asm volatile("v_mov_b32 %0, 0" : "=v"(vz));
        const LAS float* LmV = Lm + vz;
        float x0 = X[0] * scp[0];
        float rr1 = X[XS] * scp[1]; f32x4 L1_0 = *(const LAS f32x4*)(LmV + LS);
        asm volatile("" ::: "memory");
        const float rr2 = X[2 * XS] * scp[2]; const f32x4 L2_0 = *(const LAS f32x4*)(LmV + 2 * LS + 0);
        float x1; { float a0 = rr1, a1 = 0.f, a2 = 0.f, a3 = 0.f; a0 -= L1_0[0] * x0; x1 = (a0 + a1) + (a2 + a3); }
        asm volatile("" ::: "memory");
        const float rr3 = X[3 * XS] * scp[3]; const f32x4 L3_0 = *(const LAS f32x4*)(LmV + 3 * LS + 0);
        float x2; { float a0 = rr2, a1 = 0.f, a2 = 0.f, a3 = 0.f; a0 -= L2_0[0] * x0; a1 -= L2_0[1] * x1; x2 = (a0 + a1) + (a2 + a3); }
        asm volatile("" ::: "memory");
        const float rr4 = X[4 * XS] * scp[4]; const f32x4 L4_0 = *(const LAS f32x4*)(LmV + 4 * LS + 0);
        float x3; { float a0 = rr3, a1 = 0.f, a2 = 0.f, a3 = 0.f; a0 -= L3_0[0] * x0; a1 -= L3_0[1] * x1; a2 -= L3_0[2] * x2; x3 = (a0 + a1) + (a2 + a3); }
        asm volatile("" ::: "memory");
        const float rr5 = X[5 * XS] * scp[5]; const f32x4 L5_0 = *(const LAS f32x4*)(LmV + 5 * LS + 0); const f32x4 L5_1 = *(const LAS f32x4*)(LmV + 5 * LS + 4);
        float x4; { float a0 = rr4, a1 = 0.f, a2 = 0.f, a3 = 0.f; a0 -= L4_0[0] * x0; a1 -= L4_0[1] * x1; a2 -= L4_0[2] * x2; a3 -= L4_0[3] * x3; x4 = (a0 + a1) + (a2 + a3); }
        asm volatile("" ::: "memory");
        const float rr6 = X[6 * XS] * scp[6]; const f32x4 L6_0 = *(const LAS f32x4*)(LmV + 6 * LS + 0); const f32x4 L6_1 = *(const LAS f32x4*)(LmV + 6 * LS + 4);
        float x5; { float a0 = rr5, a1 = 0.f, a2 = 0.f, a3 = 0.f; a0 -= L5_0[0] * x0; a1 -= L5_0[1] * x1; a2 -= L5_0[2] * x2; a3 -= L5_0[3] * x3; a0 -= L5_1[0] * x4; x5 = (a0 + a1) + (a2 + a3); }
        asm volatile("" ::: "memory");
        const float rr7 = X[7 * XS] * scp[7]; const f32x4 L7_0 = *(const LAS f32x4*)(LmV + 7 * LS + 0); const f32x4 L7_1 = *(const LAS f32x4*)(LmV + 7 * LS + 4);
        float x6; { float a0 = rr6, a1 = 0.f, a2 = 0.f, a3 = 0.f; a0 -= L6_0[0] * x0; a1 -= L6_0[1] * x1; a2 -= L6_0[2] * x2; a3 -= L6_0[3] * x3; a0 -= L6_1[0] * x4; a1 -= L6_1[1] * x5; x6 = (a0 + a1) + (a2 + a3); }
        asm volatile("" ::: "memory");
        const float rr8 = X[8 * XS] * scp[8]; const f32x4 L8_0 = *(const LAS f32x4*)(LmV + 8 * LS + 0); const f32x4 L8_1 = *(const LAS f32x4*)(LmV + 8 * LS + 4);
        float x7; { float a0 = rr7, a1 = 0.f, a2 = 0.f, a3 = 0.f; a0 -= L7_0[0] * x0; a1 -= L7_0[1] * x1; a2 -= L7_0[2] * x2; a3 -= L7_0[3] * x3; a0 -= L7_1[0] * x4; a1 -= L7_1[1] * x5; a2 -= L7_1[2] * x6; x7 = (a0 + a1) + (a2 + a3); }
        asm volatile("" ::: "memory");
        const float rr9 = X[9 * XS] * scp[9]; const f32x4 L9_0 = *(const LAS f32x4*)(LmV + 9 * LS + 0); const f32x4 L9_1 = *(const LAS f32x4*)(LmV + 9 * LS + 4);
        float x8; { float a0 = rr8, a1 = 0.f, a2 = 0.f, a3 = 0.f; a0 -= L8_0[0] * x0; a1 -= L8_0[1] * x1; a2 -= L8_0[2] * x2; a3 -= L8_0[3] * x3; a0 -= L8_1[0] * x4; a1 -= L8_1[1] * x5; a2 -= L8_1[2] * x6; a3 -= L8_1[3] * x7; x8 = (a0 + a1) + (a2 + a3); }
        asm volatile("" ::: "memory");
        const float rr10 = X[10 * XS] * scp[10]; const f32x4 L10_0 = *(const LAS f32x4*)(LmV + 10 * LS + 0); const f32x4 L10_1 = *(const LAS f32x4*)(LmV + 10 * LS + 4); const f32x4 L9_2 = *(const LAS f32x4*)(LmV + 9 * LS + 8);
        float x9; { float a0 = rr9, a1 = 0.f, a2 = 0.f, a3 = 0.f; a0 -= L9_0[0] * x0; a1 -= L9_0[1] * x1; a2 -= L9_0[2] * x2; a3 -= L9_0[3] * x3; a0 -= L9_1[0] * x4; a1 -= L9_1[1] * x5; a2 -= L9_1[2] * x6; a3 -= L9_1[3] * x7; a0 -= L9_2[0] * x8; x9 = (a0 + a1) + (a2 + a3); }
        asm volatile("" ::: "memory");
        const float rr11 = X[11 * XS] * scp[11]; const f32x4 L11_0 = *(const LAS f32x4*)(LmV + 11 * LS + 0); const f32x4 L11_1 = *(const LAS f32x4*)(LmV + 11 * LS + 4); const f32x4 L10_2 = *(const LAS f32x4*)(LmV + 10 * LS + 8);
        float x10; { float a0 = rr10, a1 = 0.f, a2 = 0.f, a3 = 0.f; a0 -= L10_0[0] * x0; a1 -= L10_0[1] * x1; a2 -= L10_0[2] * x2; a3 -= L10_0[3] * x3; a0 -= L10_1[0] * x4; a1 -= L10_1[1] * x5; a2 -= L10_1[2] * x6; a3 -= L10_1[3] * x7; a0 -= L10_2[0] * x8; a1 -= L10_2[1] * x9; x10 = (a0 + a1) + (a2 + a3); }
        asm volatile("" ::: "memory");
        const float rr12 = X[12 * XS] * scp[12]; const f32x4 L12_0 = *(const LAS f32x4*)(LmV + 12 * LS + 0); const f32x4 L12_1 = *(const LAS f32x4*)(LmV + 12 * LS + 4); const f32x4 L11_2 = *(const LAS f32x4*)(LmV + 11 * LS + 8);
        float x11; { float a0 = rr11, a1 = 0.f, a2 = 0.f, a3 = 0.f; a0 -= L11_0[0] * x0; a1 -= L11_0[1] * x1; a2 -= L11_0[2] * x2; a3 -= L11_0[3] * x3; a0 -= L11_1[0] * x4; a1 -= L11_1[1] * x5; a2 -= L11_1[2] * x6; a3 -= L11_1[3] * x7; a0 -= L11_2[0] * x8; a1 -= L11_2[1] * x9; a2 -= L11_2[2] * x10; x11 = (a0 + a1) + (a2 + a3); }
        asm volatile("" ::: "memory");
        const float rr13 = X[13 * XS] * scp[13]; const f32x4 L13_0 = *(const LAS f32x4*)(LmV + 13 * LS + 0); const f32x4 L13_1 = *(const LAS f32x4*)(LmV + 13 * LS + 4); const f32x4 L12_2 = *(const LAS f32x4*)(LmV + 12 * LS + 8);
        float x12; { float a0 = rr12, a1 = 0.f, a2 = 0.f, a3 = 0.f; a0 -= L12_0[0] * x0; a1 -= L12_0[1] * x1; a2 -= L12_0[2] * x2; a3 -= L12_0[3] * x3; a0 -= L12_1[0] * x4; a1 -= L12_1[1] * x5; a2 -= L12_1[2] * x6; a3 -= L12_1[3] * x7; a0 -= L12_2[0] * x8; a1 -= L12_2[1] * x9; a2 -= L12_2[2] * x10; a3 -= L12_2[3] * x11; x12 = (a0 + a1) + (a2 + a3); }
        asm volatile("" ::: "memory");
        const float rr14 = X[14 * XS] * scp[14]; const f32x4 L14_0 = *(const LAS f32x4*)(LmV + 14 * LS + 0); const f32x4 L14_1 = *(const LAS f32x4*)(LmV + 14 * LS + 4); const f32x4 L13_2 = *(const LAS f32x4*)(LmV + 13 * LS + 8); const f32x4 L13_3 = *(const LAS f32x4*)(LmV + 13 * LS + 12);
        float x13; { float a0 = rr13, a1 = 0.f, a2 = 0.f, a3 = 0.f; a0 -= L13_0[0] * x0; a1 -= L13_0[1] * x1; a2 -= L13_0[2] * x2; a3 -= L13_0[3] * x3; a0 -= L13_1[0] * x4; a1 -= L13_1[1] * x5; a2 -= L13_1[2] * x6; a3 -= L13_1[3] * x7; a0 -= L13_2[0] * x8; a1 -= L13_2[1] * x9; a2 -= L13_2[2] * x10; a3 -= L13_2[3] * x11; a0 -= L13_3[0] * x12; x13 = (a0 + a1) + (a2 + a3); }
        asm volatile("" ::: "memory");
        const float rr15 = X[15 * XS] * scp[15]; const f32x4 L15_0 = *(const LAS f32x4*)(LmV + 15 * LS + 0); const f32x4 L15_1 = *(const LAS f32x4*)(LmV + 15 * LS + 4); const f32x4 L14_2 = *(const LAS f32x4*)(LmV + 14 * LS + 8); const f32x4 L14_3 = *(const LAS f32x4*)(LmV + 14 * LS + 12);
        float x14; { float a0 = rr14, a1 = 0.f, a2 = 0.f, a3 = 0.f; a0 -= L14_0[0] * x0; a1 -= L14_0[1] * x1; a2 -= L14_0[2] * x2; a3 -= L14_0[3] * x3; a0 -= L14_1[0] * x4; a1 -= L14_1[1] * x5; a2 -= L14_1[2] * x6; a3 -= L14_1[3] * x7; a0 -= L14_2[0] * x8; a1 -= L14_2[1] * x9; a2 -= L14_2[2] * x10; a3 -= L14_2[3] * x11; a0 -= L14_3[0] * x12; a1 -= L14_3[1] * x13; x14 = (a0 + a1) + (a2 + a3); }
        asm volatile("" ::: "memory");
        const float rr16 = X[16 * XS] * scp[16]; const f32x4 L16_0 = *(const LAS f32x4*)(LmV + 16 * LS + 0); const f32x4 L16_1 = *(const LAS f32x4*)(LmV + 16 * LS + 4); const f32x4 L15_2 = *(const LAS f32x4*)(LmV + 15 * LS + 8); const f32x4 L15_3 = *(const LAS f32x4*)(LmV + 15 * LS + 12);
        float x15; { float a0 = rr15, a1 = 0.f, a2 = 0.f, a3 = 0.f; a0 -= L15_0[0] * x0; a1 -= L15_0[1] * x1; a2 -= L15_0[2] * x2; a3 -= L15_0[3] * x3; a0 -= L15_1[0] * x4; a1 -= L15_1[1] * x5; a2 -= L15_1[2] * x6; a3 -= L15_1[3] * x7; a0 -= L15_2[0] * x8; a1 -= L15_2[1] * x9; a2 -= L15_2[2] * x10; a3 -= L15_2[3] * x11; a0 -= L15_3[0] * x12; a1 -= L15_3[1] * x13; a2 -= L15_3[2] * x14; x15 = (a0 + a1) + (a2 + a3); }
        asm volatile("" ::: "memory");
        const float rr17 = X[17 * XS] * scp[17]; const f32x4 L17_0 = *(const LAS f32x4*)(LmV + 17 * LS + 0); const f32x4 L17_1 = *(const LAS f32x4*)(LmV + 17 * LS + 4); const f32x4 L16_2 = *(const LAS f32x4*)(LmV + 16 * LS + 8); const f32x4 L16_3 = *(const LAS f32x4*)(LmV + 16 * LS + 12);
        float x16; { float a0 = rr16, a1 = 0.f, a2 = 0.f, a3 = 0.f; a0 -= L16_0[0] * x0; a1 -= L16_0[1] * x1; a2 -= L16_0[2] * x2; a3 -= L16_0[3] * x3; a0 -= L16_1[0] * x4; a1 -= L16_1[1] * x5; a2 -= L16_1[2] * x6; a3 -= L16_1[3] * x7; a0 -= L16_2[0] * x8; a1 -= L16_2[1] * x9; a2 -= L16_2[2] * x10; a3 -= L16_2[3] * x11; a0 -= L16_3[0] * x12; a1 -= L16_3[1] * x13; a2 -= L16_3[2] * x14; a3 -= L16_3[3] * x15; x16 = (a0 + a1) + (a2 + a3); }
        asm volatile("" ::: "memory");
        const float rr18 = X[18 * XS] * scp[18]; const f32x4 L18_0 = *(const LAS f32x4*)(LmV + 18 * LS + 0); const f32x4 L18_1 = *(const LAS f32x4*)(LmV + 18 * LS + 4); const f32x4 L17_2 = *(const LAS f32x4*)(LmV + 17 * LS + 8); const f32x4 L17_3 = *(const LAS f32x4*)(LmV + 17 * LS + 12); const f32x4 L17_4 = *(const LAS f32x4*)(LmV + 17 * LS + 16);
        float x17; { float a0 = rr17, a1 = 0.f, a2 = 0.f, a3 = 0.f; a0 -= L17_0[0] * x0; a1 -= L17_0[1] * x1; a2 -= L17_0[2] * x2; a3 -= L17_0[3] * x3; a0 -= L17_1[0] * x4; a1 -= L17_1[1] * x5; a2 -= L17_1[2] * x6; a3 -= L17_1[3] * x7; a0 -= L17_2[0] * x8; a1 -= L17_2[1] * x9; a2 -= L17_2[2] * x10; a3 -= L17_2[3] * x11; a0 -= L17_3[0] * x12; a1 -= L17_3[1] * x13; a2 -= L17_3[2] * x14; a3 -= L17_3[3] * x15; a0 -= L17_4[0] * x16; x17 = (a0 + a1) + (a2 + a3); }
        asm volatile("" ::: "memory");
        const float rr19 = X[19 * XS] * scp[19]; const f32x4 L19_0 = *(const LAS f32x4*)(LmV + 19 * LS + 0); const f32x4 L19_1 = *(const LAS f32x4*)(LmV + 19 * LS + 4); const f32x4 L18_2 = *(const LAS f32x4*)(LmV + 18 * LS + 8); const f32x4 L18_3 = *(const LAS f32x4*)(LmV + 18 * LS + 12); const f32x4 L18_4 = *(const LAS f32x4*)(LmV + 18 * LS + 16);
        float x18; { float a0 = rr18, a1 = 0.f, a2 = 0.f, a3 = 0.f; a0 -= L18_0[0] * x0; a1 -= L18_0[1] * x1; a2 -= L18_0[2] * x2; a3 -= L18_0[3] * x3; a0 -= L18_1[0] * x4; a1 -= L18_1[1] * x5; a2 -= L18_1[2] * x6; a3 -= L18_1[3] * x7; a0 -= L18_2[0] * x8; a1 -= L18_2[1] * x9; a2 -= L18_2[2] * x10; a3 -= L18_2[3] * x11; a0 -= L18_3[0] * x12; a1 -= L18_3[1] * x13; a2 -= L18_3[2] * x14; a3 -= L18_3[3] * x15; a0 -= L18_4[0] * x16; a1 -= L18_4[1] * x17; x18 = (a0 + a1) + (a2 + a3); }
        asm volatile("" ::: "memory");
        const float rr20 = X[20 * XS] * scp[20]; const f32x4 L20_0 = *(const LAS f32x4*)(LmV + 20 * LS + 0); const f32x4 L20_1 = *(const LAS f32x4*)(LmV + 20 * LS + 4); const f32x4 L19_2 = *(const LAS f32x4*)(LmV + 19 * LS + 8); const f32x4 L19_3 = *(const LAS f32x4*)(LmV + 19 * LS + 12); const f32x4 L19_4 = *(const LAS f32x4*)(LmV + 19 * LS + 16);
        float x19; { float a0 = rr19, a1 = 0.f, a2 = 0.f, a3 = 0.f; a0 -= L19_0[0] * x0; a1 -= L19_0[1] * x1; a2 -= L19_0[2] * x2; a3 -= L19_0[3] * x3; a0 -= L19_1[0] * x4; a1 -= L19_1[1] * x5; a2 -= L19_1[2] * x6; a3 -= L19_1[3] * x7; a0 -= L19_2[0] * x8; a1 -= L19_2[1] * x9; a2 -= L19_2[2] * x10; a3 -= L19_2[3] * x11; a0 -= L19_3[0] * x12; a1 -= L19_3[1] * x13; a2 -= L19_3[2] * x14; a3 -= L19_3[3] * x15; a0 -= L19_4[0] * x16; a1 -= L19_4[1] * x17; a2 -= L19_4[2] * x18; x19 = (a0 + a1) + (a2 + a3); }
        asm volatile("" ::: "memory");
        const float rr21 = X[21 * XS] * scp[21]; const f32x4 L21_0 = *(const LAS f32x4*)(LmV + 21 * LS + 0); const f32x4 L21_1 = *(const LAS f32x4*)(LmV + 21 * LS + 4); const f32x4 L20_2 = *(const LAS f32x4*)(LmV + 20 * LS + 8); const f32x4 L20_3 = *(const LAS f32x4*)(LmV + 20 * LS + 12); const f32x4 L20_4 = *(const LAS f32x4*)(LmV + 20 * LS + 16);
        float x20; { float a0 = rr20, a1 = 0.f, a2 = 0.f, a3 = 0.f; a0 -= L20_0[0] * x0; a1 -= L20_0[1] * x1; a2 -= L20_0[2] * x2; a3 -= L20_0[3] * x3; a0 -= L20_1[0] * x4; a1 -= L20_1[1] * x5; a2 -= L20_1[2] * x6; a3 -= L20_1[3] * x7; a0 -= L20_2[0] * x8; a1 -= L20_2[1] * x9; a2 -= L20_2[2] * x10; a3 -= L20_2[3] * x11; a0 -= L20_3[0] * x12; a1 -= L20_3[1] * x13; a2 -= L20_3[2] * x14; a3 -= L20_3[3] * x15; a0 -= L20_4[0] * x16; a1 -= L20_4[1] * x17; a2 -= L20_4[2] * x18; a3 -= L20_4[3] * x19; x20 = (a0 + a1) + (a2 + a3); }
        asm volatile("" ::: "memory");
        const float rr22 = X[22 * XS] * scp[22]; const f32x4 L22_0 = *(const LAS f32x4*)(LmV + 22 * LS + 0); const f32x4 L22_1 = *(const LAS f32x4*)(LmV + 22 * LS + 4); const f32x4 L21_2 = *(const LAS f32x4*)(LmV + 21 * LS + 8); const f32x4 L21_3 = *(const LAS f32x4*)(LmV + 21 * LS + 12); const f32x4 L21_4 = *(const LAS f32x4*)(LmV + 21 * LS + 16); const f32x4 L21_5 = *(const LAS f32x4*)(LmV + 21 * LS + 20);
        float x21; { float a0 = rr21, a1 = 0.f, a2 = 0.f, a3 = 0.f; a0 -= L21_0[0] * x0; a1 -= L21_0[1] * x1; a2 -= L21_0[2] * x2; a3 -= L21_0[3] * x3; a0 -= L21_1[0] * x4; a1 -= L21_1[1] * x5; a2 -= L21_1[2] * x6; a3 -= L21_1[3] * x7; a0 -= L21_2[0] * x8; a1 -= L21_2[1] * x9; a2 -= L21_2[2] * x10; a3 -= L21_2[3] * x11; a0 -= L21_3[0] * x12; a1 -= L21_3[1] * x13; a2 -= L21_3[2] * x14; a3 -= L21_3[3] * x15; a0 -= L21_4[0] * x16; a1 -= L21_4[1] * x17; a2 -= L21_4[2] * x18; a3 -= L21_4[3] * x19; a0 -= L21_5[0] * x20; x21 = (a0 + a1) + (a2 + a3); }
        asm volatile("" ::: "memory");
        const float rr23 = X[23 * XS] * scp[23]; const f32x4 L23_0 = *(const LAS f32x4*)(LmV + 23 * LS + 0); const f32x4 L23_1 = *(const LAS f32x4*)(LmV + 23 * LS + 4); const f32x4 L22_2 = *(const LAS f32x4*)(LmV + 22 * LS + 8); const f32x4 L22_3 = *(const LAS f32x4*)(LmV + 22 * LS + 12); const f32x4 L22_4 = *(const LAS f32x4*)(LmV + 22 * LS + 16); const f32x4 L22_5 = *(const LAS f32x4*)(LmV + 22 * LS + 20);
        float x22; { float a0 = rr22, a1 = 0.f, a2 = 0.f, a3 = 0.f; a0 -= L22_0[0] * x0; a1 -= L22_0[1] * x1; a2 -= L22_0[2] * x2; a3 -= L22_0[3] * x3; a0 -= L22_1[0] * x4; a1 -= L22_1[1] * x5; a2 -= L22_1[2] * x6; a3 -= L22_1[3] * x7; a0 -= L22_2[0] * x8; a1 -= L22_2[1] * x9; a2 -= L22_2[2] * x10; a3 -= L22_2[3] * x11; a0 -= L22_3[0] * x12; a1 -= L22_3[1] * x13; a2 -= L22_3[2] * x14; a3 -= L22_3[3] * x15; a0 -= L22_4[0] * x16; a1 -= L22_4[1] * x17; a2 -= L22_4[2] * x18; a3 -= L22_4[3] * x19; a0 -= L22_5[0] * x20; a1 -= L22_5[1] * x21; x22 = (a0 + a1) + (a2 + a3); }
        asm volatile("" ::: "memory");
        const float rr24 = X[24 * XS] * scp[24]; const f32x4 L24_0 = *(const LAS f32x4*)(LmV + 24 * LS + 0); const f32x4 L24_1 = *(const LAS f32x4*)(LmV + 24 * LS + 4); const f32x4 L23_2 = *(const LAS f32x4*)(LmV + 23 * LS + 8); const f32x4 L23_3 = *(const LAS f32x4*)(LmV + 23 * LS + 12); const f32x4 L23_4 = *(const LAS f32x4*)(LmV + 23 * LS + 16); const f32x4 L23_5 = *(const LAS f32x4*)(LmV + 23 * LS + 20);
        float x23; { float a0 = rr23, a1 = 0.f, a2 = 0.f, a3 = 0.f; a0 -= L23_0[0] * x0; a1 -= L23_0[1] * x1; a2 -= L23_0[2] * x2; a3 -= L23_0[3] * x3; a0 -= L23_1[0] * x4; a1 -= L23_1[1] * x5; a2 -= L23_1[2] * x6; a3 -= L23_1[3] * x7; a0 -= L23_2[0] * x8; a1 -= L23_2[1] * x9; a2 -= L23_2[2] * x10; a3 -= L23_2[3] * x11; a0 -= L23_3[0] * x12; a1 -= L23_3[1] * x13; a2 -= L23_3[2] * x14; a3 -= L23_3[3] * x15; a0 -= L23_4[0] * x16; a1 -= L23_4[1] * x17; a2 -= L23_4[2] * x18; a3 -= L23_4[3] * x19; a0 -= L23_5[0] * x20; a1 -= L23_5[1] * x21; a2 -= L23_5[2] * x22; x23 = (a0 + a1) + (a2 + a3); }
        asm volatile("" ::: "memory");
        const float rr25 = X[25 * XS] * scp[25]; const f32x4 L25_0 = *(const LAS f32x4*)(LmV + 25 * LS + 0); const f32x4 L25_1 = *(const LAS f32x4*)(LmV + 25 * LS + 4); const f32x4 L24_2 = *(const LAS f32x4*)(LmV + 24 * LS + 8); const f32x4 L24_3 = *(const LAS f32x4*)(LmV + 24 * LS + 12); const f32x4 L24_4 = *(const LAS f32x4*)(LmV + 24 * LS + 16); const f32x4 L24_5 = *(const LAS f32x4*)(LmV + 24 * LS + 20);
        float x24; { float a0 = rr24, a1 = 0.f, a2 = 0.f, a3 = 0.f; a0 -= L24_0[0] * x0; a1 -= L24_0[1] * x1; a2 -= L24_0[2] * x2; a3 -= L24_0[3] * x3; a0 -= L24_1[0] * x4; a1 -= L24_1[1] * x5; a2 -= L24_1[2] * x6; a3 -= L24_1[3] * x7; a0 -= L24_2[0] * x8; a1 -= L24_2[1] * x9; a2 -= L24_2[2] * x10; a3 -= L24_2[3] * x11; a0 -= L24_3[0] * x12; a1 -= L24_3[1] * x13; a2 -= L24_3[2] * x14; a3 -= L24_3[3] * x15; a0 -= L24_4[0] * x16; a1 -= L24_4[1] * x17; a2 -= L24_4[2] * x18; a3 -= L24_4[3] * x19; a0 -= L24_5[0] * x20; a1 -= L24_5[1] * x21; a2 -= L24_5[2] * x22; a3 -= L24_5[3] * x23; x24 = (a0 + a1) + (a2 + a3); }
        asm volatile("" ::: "memory");
        const float rr26 = X[26 * XS] * scp[26]; const f32x4 L26_0 = *(const LAS f32x4*)(LmV + 26 * LS + 0); const f32x4 L26_1 = *(const LAS f32x4*)(LmV + 26 * LS + 4); const f32x4 L25_2 = *(const LAS f32x4*)(LmV + 25 * LS + 8); const f32x4 L25_3 = *(const LAS f32x4*)(LmV + 25 * LS + 12); const f32x4 L25_4 = *(const LAS f32x4*)(LmV + 25 * LS + 16); const f32x4 L25_5 = *(const LAS f32x4*)(LmV + 25 * LS + 20); const f32x4 L25_6 = *(const LAS f32x4*)(LmV + 25 * LS + 24);
        float x25; { float a0 = rr25, a1 = 0.f, a2 = 0.f, a3 = 0.f; a0 -= L25_0[0] * x0; a1 -= L25_0[1] * x1; a2 -= L25_0[2] * x2; a3 -= L25_0[3] * x3; a0 -= L25_1[0] * x4; a1 -= L25_1[1] * x5; a2 -= L25_1[2] * x6; a3 -= L25_1[3] * x7; a0 -= L25_2[0] * x8; a1 -= L25_2[1] * x9; a2 -= L25_2[2] * x10; a3 -= L25_2[3] * x11; a0 -= L25_3[0] * x12; a1 -= L25_3[1] * x13; a2 -= L25_3[2] * x14; a3 -= L25_3[3] * x15; a0 -= L25_4[0] * x16; a1 -= L25_4[1] * x17; a2 -= L25_4[2] * x18; a3 -= L25_4[3] * x19; a0 -= L25_5[0] * x20; a1 -= L25_5[1] * x21; a2 -= L25_5[2] * x22; a3 -= L25_5[3] * x23; a0 -= L25_6[0] * x24; x25 = (a0 + a1) + (a2 + a3); }
        asm volatile("" ::: "memory");
        const float rr27 = X[27 * XS] * scp[27]; const f32x4 L27_0 = *(const LAS f32x4*)(LmV + 27 * LS + 0); const f32x4 L27_1 = *(const LAS f32x4*)(LmV + 27 * LS + 4); const f32x4 L26_2 = *(const LAS f32x4*)(LmV + 26 * LS + 8); const f32x4 L26_3 = *(const LAS f32x4*)(LmV + 26 * LS + 12); const f32x4 L26_4 = *(const LAS f32x4*)(LmV + 26 * LS + 16); const f32x4 L26_5 = *(const LAS f32x4*)(LmV + 26 * LS + 20); const f32x4 L26_6 = *(const LAS f32x4*)(LmV + 26 * LS + 24);
        float x26; { float a0 = rr26, a1 = 0.f, a2 = 0.f, a3 = 0.f; a0 -= L26_0[0] * x0; a1 -= L26_0[1] * x1; a2 -= L26_0[2] * x2; a3 -= L26_0[3] * x3; a0 -= L26_1[0] * x4; a1 -= L26_1[1] * x5; a2 -= L26_1[2] * x6; a3 -= L26_1[3] * x7; a0 -= L26_2[0] * x8; a1 -= L26_2[1] * x9; a2 -= L26_2[2] * x10; a3 -= L26_2[3] * x11; a0 -= L26_3[0] * x12; a1 -= L26_3[1] * x13; a2 -= L26_3[2] * x14; a3 -= L26_3[3] * x15; a0 -= L26_4[0] * x16; a1 -= L26_4[1] * x17; a2 -= L26_4[2] * x18; a3 -= L26_4[3] * x19; a0 -= L26_5[0] * x20; a1 -= L26_5[1] * x21; a2 -= L26_5[2] * x22; a3 -= L26_5[3] * x23; a0 -= L26_6[0] * x24; a1 -= L26_6[1] * x25; x26 = (a0 + a1) + (a2 + a3); }
        asm volatile("" ::: "memory");
        const float rr28 = X[28 * XS] * scp[28]; const f32x4 L28_0 = *(const LAS f32x4*)(LmV + 28 * LS + 0); const f32x4 L28_1 = *(const LAS f32x4*)(LmV + 28 * LS + 4); const f32x4 L27_2 = *(const LAS f32x4*)(LmV + 27 * LS + 8); const f32x4 L27_3 = *(const LAS f32x4*)(LmV + 27 * LS + 12); const f32x4 L27_4 = *(const LAS f32x4*)(LmV + 27 * LS + 16); const f32x4 L27_5 = *(const LAS f32x4*)(LmV + 27 * LS + 20); const f32x4 L27_6 = *(const LAS f32x4*)(LmV + 27 * LS + 24);
        float x27; { float a0 = rr27, a1 = 0.f, a2 = 0.f, a3 = 0.f; a0 -= L27_0[0] * x0; a1 -= L27_0[1] * x1; a2 -= L27_0[2] * x2; a3 -= L27_0[3] * x3; a0 -= L27_1[0] * x4; a1 -= L27_1[1] * x5; a2 -= L27_1[2] * x6; a3 -= L27_1[3] * x7; a0 -= L27_2[0] * x8; a1 -= L27_2[1] * x9; a2 -= L27_2[2] * x10; a3 -= L27_2[3] * x11; a0 -= L27_3[0] * x12; a1 -= L27_3[1] * x13; a2 -= L27_3[2] * x14; a3 -= L27_3[3] * x15; a0 -= L27_4[0] * x16; a1 -= L27_4[1] * x17; a2 -= L27_4[2] * x18; a3 -= L27_4[3] * x19; a0 -= L27_5[0] * x20; a1 -= L27_5[1] * x21; a2 -= L27_5[2] * x22; a3 -= L27_5[3] * x23; a0 -= L27_6[0] * x24; a1 -= L27_6[1] * x25; a2 -= L27_6[2] * x26; x27 = (a0 + a1) + (a2 + a3); }
        asm volatile("" ::: "memory");
        const float rr29 = X[29 * XS] * scp[29]; const f32x4 L29_0 = *(const LAS f32x4*)(LmV + 29 * LS + 0); const f32x4 L29_1 = *(const LAS f32x4*)(LmV + 29 * LS + 4); const f32x4 L28_2 = *(const LAS f32x4*)(LmV + 28 * LS + 8); const f32x4 L28_3 = *(const LAS f32x4*)(LmV + 28 * LS + 12); const f32x4 L28_4 = *(const LAS f32x4*)(LmV + 28 * LS + 16); const f32x4 L28_5 = *(const LAS f32x4*)(LmV + 28 * LS + 20); const f32x4 L28_6 = *(const LAS f32x4*)(LmV + 28 * LS + 24);
        float x28; { float a0 = rr28, a1 = 0.f, a2 = 0.f, a3 = 0.f; a0 -= L28_0[0] * x0; a1 -= L28_0[1] * x1; a2 -= L28_0[2] * x2; a3 -= L28_0[3] * x3; a0 -= L28_1[0] * x4; a1 -= L28_1[1] * x5; a2 -= L28_1[2] * x6; a3 -= L28_1[3] * x7; a0 -= L28_2[0] * x8; a1 -= L28_2[1] * x9; a2 -= L28_2[2] * x10; a3 -= L28_2[3] * x11; a0 -= L28_3[0] * x12; a1 -= L28_3[1] * x13; a2 -= L28_3[2] * x14; a3 -= L28_3[3] * x15; a0 -= L28_4[0] * x16; a1 -= L28_4[1] * x17; a2 -= L28_4[2] * x18; a3 -= L28_4[3] * x19; a0 -= L28_5[0] * x20; a1 -= L28_5[1] * x21; a2 -= L28_5[2] * x22; a3 -= L28_5[3] * x23; a0 -= L28_6[0] * x24; a1 -= L28_6[1] * x25; a2 -= L28_6[2] * x26; a3 -= L28_6[3] * x27; x28 = (a0 + a1) + (a2 + a3); }
        asm volatile("" ::: "memory");
        const float rr30 = X[30 * XS] * scp[30]; const f32x4 L30_0 = *(const LAS f32x4*)(LmV + 30 * LS + 0); const f32x4 L30_1 = *(const LAS f32x4*)(LmV + 30 * LS + 4); const f32x4 L29_2 = *(const LAS f32x4*)(LmV + 29 * LS + 8); const f32x4 L29_3 = *(const LAS f32x4*)(LmV + 29 * LS + 12); const f32x4 L29_4 = *(const LAS f32x4*)(LmV + 29 * LS + 16); const f32x4 L29_5 = *(const LAS f32x4*)(LmV + 29 * LS + 20); const f32x4 L29_6 = *(const LAS f32x4*)(LmV + 29 * LS + 24); const f32x4 L29_7 = *(const LAS f32x4*)(LmV + 29 * LS + 28);
        float x29; { float a0 = rr29, a1 = 0.f, a2 = 0.f, a3 = 0.f; a0 -= L29_0[0] * x0; a1 -= L29_0[1] * x1; a2 -= L29_0[2] * x2; a3 -= L29_0[3] * x3; a0 -= L29_1[0] * x4; a1 -= L29_1[1] * x5; a2 -= L29_1[2] * x6; a3 -= L29_1[3] * x7; a0 -= L29_2[0] * x8; a1 -= L29_2[1] * x9; a2 -= L29_2[2] * x10; a3 -= L29_2[3] * x11; a0 -= L29_3[0] * x12; a1 -= L29_3[1] * x13; a2 -= L29_3[2] * x14; a3 -= L29_3[3] * x15; a0 -= L29_4[0] * x16; a1 -= L29_4[1] * x17; a2 -= L29_4[2] * x18; a3 -= L29_4[3] * x19; a0 -= L29_5[0] * x20; a1 -= L29_5[1] * x21; a2 -= L29_5[2] * x22; a3 -= L29_5[3] * x23; a0 -= L29_6[0] * x24; a1 -= L29_6[1] * x25; a2 -= L29_6[2] * x26; a3 -= L29_6[3] * x27; a0 -= L29_7[0] * x28; x29 = (a0 + a1) + (a2 + a3); }
        asm volatile("" ::: "memory");
        const float rr31 = X[31 * XS] * scp[31]; const f32x4 L31_0 = *(const LAS f32x4*)(LmV + 31 * LS + 0); const f32x4 L31_1 = *(const LAS f32x4*)(LmV + 31 * LS + 4); const f32x4 L30_2 = *(const LAS f32x4*)(LmV + 30 * LS + 8); const f32x4 L30_3 = *(const LAS f32x4*)(LmV + 30 * LS + 12); const f32x4 L30_4 = *(const LAS f32x4*)(LmV + 30 * LS + 16); const f32x4 L30_5 = *(const LAS f32x4*)(LmV + 30 * LS + 20); const f32x4 L30_6 = *(const LAS f32x4*)(LmV + 30 * LS + 24); const f32x4 L30_7 = *(const LAS f32x4*)(LmV + 30 * LS + 28);
        float x30; { float a0 = rr30, a1 = 0.f, a2 = 0.f, a3 = 0.f; a0 -= L30_0[0] * x0; a1 -= L30_0[1] * x1; a2 -= L30_0[2] * x2; a3 -= L30_0[3] * x3; a0 -= L30_1[0] * x4; a1 -= L30_1[1] * x5; a2 -= L30_1[2] * x6; a3 -= L30_1[3] * x7; a0 -= L30_2[0] * x8; a1 -= L30_2[1] * x9; a2 -= L30_2[2] * x10; a3 -= L30_2[3] * x11; a0 -= L30_3[0] * x12; a1 -= L30_3[1] * x13; a2 -= L30_3[2] * x14; a3 -= L30_3[3] * x15; a0 -= L30_4[0] * x16; a1 -= L30_4[1] * x17; a2 -= L30_4[2] * x18; a3 -= L30_4[3] * x19; a0 -= L30_5[0] * x20; a1 -= L30_5[1] * x21; a2 -= L30_5[2] * x22; a3 -= L30_5[3] * x23; a0 -= L30_6[0] * x24; a1 -= L30_6[1] * x25; a2 -= L30_6[2] * x26; a3 -= L30_6[3] * x27; a0 -= L30_7[0] * x28; a1 -= L30_7[1] * x29; x30 = (a0 + a1) + (a2 + a3); }
        asm volatile("" ::: "memory");
        const float rr32 = X[32 * XS] * scp[32]; const f32x4 L32_0 = *(const LAS f32x4*)(LmV + 32 * LS + 0); const f32x4 L32_1 = *(const LAS f32x4*)(LmV + 32 * LS + 4); const f32x4 L31_2 = *(const LAS f32x4*)(LmV + 31 * LS + 8); const f32x4 L31_3 = *(const LAS f32x4*)(LmV + 31 * LS + 12); const f32x4 L31_4 = *(const LAS f32x4*)(LmV + 31 * LS + 16); const f32x4 L31_5 = *(const LAS f32x4*)(LmV + 31 * LS + 20); const f32x4 L31_6 = *(const LAS f32x4*)(LmV + 31 * LS + 24); const f32x4 L31_7 = *(const LAS f32x4*)(LmV + 31 * LS + 28);
        float x31; { float a0 = rr31, a1 = 0.f, a2 = 0.f, a3 = 0.f; a0 -= L31_0[0] * x0; a1 -= L31_0[1] * x1; a2 -= L31_0[2] * x2; a3 -= L31_0[3] * x3; a0 -= L31_1[0] * x4; a1 -= L31_1[1] * x5; a2 -= L31_1[2] * x6; a3 -= L31_1[3] * x7; a0 -= L31_2[0] * x8; a1 -= L31_2[1] * x9; a2 -= L31_2[2] * x10; a3 -= L31_2[3] * x11; a0 -= L31_3[0] * x12; a1 -= L31_3[1] * x13; a2 -= L31_3[2] * x14; a3 -= L31_3[3] * x15; a0 -= L31_4[0] * x16; a1 -= L31_4[1] * x17; a2 -= L31_4[2] * x18; a3 -= L31_4[3] * x19; a0 -= L31_5[0] * x20; a1 -= L31_5[1] * x21; a2 -= L31_5[2] * x22; a3 -= L31_5[3] * x23; a0 -= L31_6[0] * x24; a1 -= L31_6[1] * x25; a2 -= L31_6[2] * x26; a3 -= L31_6[3] * x27; a0 -= L31_7[0] * x28; a1 -= L31_7[1] * x29; a2 -= L31_7[2] * x30; x31 = (a0 + a1) + (a2 + a3); }
        asm volatile("" ::: "memory");
        const float rr33 = X[33 * XS] * scp[33]; const f32x4 L33_0 = *(const LAS f32x4*)(LmV + 33 * LS + 0); const f32x4 L33_1 = *(const LAS f32x4*)(LmV + 33 * LS + 4); const f32x4 L32_2 = *(const LAS f32x4*)(LmV + 32 * LS + 8); const f32x4 L32_3 = *(const LAS f32x4*)(LmV + 32 * LS + 12); const f32x4 L32_4 = *(const LAS f32x4*)(LmV + 32 * LS + 16); const f32x4 L32_5 = *(const LAS f32x4*)(LmV + 32 * LS + 20); const f32x4 L32_6 = *(const LAS f32x4*)(LmV + 32 * LS + 24); const f32x4 L32_7 = *(const LAS f32x4*)(LmV + 32 * LS + 28);
        float x32; { float a0 = rr32, a1 = 0.f, a2 = 0.f, a3 = 0.f; a0 -= L32_0[0] * x0; a1 -= L32_0[1] * x1; a2 -= L32_0[2] * x2; a3 -= L32_0[3] * x3; a0 -= L32_1[0] * x4; a1 -= L32_1[1] * x5; a2 -= L32_1[2] * x6; a3 -= L32_1[3] * x7; a0 -= L32_2[0] * x8; a1 -= L32_2[1] * x9; a2 -= L32_2[2] * x10; a3 -= L32_2[3] * x11; a0 -= L32_3[0] * x12; a1 -= L32_3[1] * x13; a2 -= L32_3[2] * x14; a3 -= L32_3[3] * x15; a0 -= L32_4[0] * x16; a1 -= L32_4[1] * x17; a2 -= L32_4[2] * x18; a3 -= L32_4[3] * x19; a0 -= L32_5[0] * x20; a1 -= L32_5[1] * x21; a2 -= L32_5[2] * x22; a3 -= L32_5[3] * x23; a0 -= L32_6[0] * x24; a1 -= L32_6[1] * x25; a2 -= L32_6[2] * x26; a3 -= L32_6[3] * x27; a0 -= L32_7[0] * x28; a1 -= L32_7[1] * x29; a2 -= L32_7[2] * x30; a3 -= L32_7[3] * x31; x32 = (a0 + a1) + (a2 + a3); }
        asm volatile("" ::: "memory");
        const float rr34 = X[34 * XS] * scp[34]; const f32x4 L34_0 = *(const LAS f32x4*)(LmV + 34 * LS + 0); const f32x4 L34_1 = *(const LAS f32x4*)(LmV + 34 * LS + 4); const f32x4 L33_2 = *(const LAS f32x4*)(LmV + 33 * LS + 8); const f32x4 L33_3 = *(const LAS f32x4*)(LmV + 33 * LS + 12); const f32x4 L33_4 = *(const LAS f32x4*)(LmV + 33 * LS + 16); const f32x4 L33_5 = *(const LAS f32x4*)(LmV + 33 * LS + 20); const f32x4 L33_6 = *(const LAS f32x4*)(LmV + 33 * LS + 24); const f32x4 L33_7 = *(const LAS f32x4*)(LmV + 33 * LS + 28); const f32x4 L33_8 = *(const LAS f32x4*)(LmV + 33 * LS + 32);
        float x33; { float a0 = rr33, a1 = 0.f, a2 = 0.f, a3 = 0.f; a0 -= L33_0[0] * x0; a1 -= L33_0[1] * x1; a2 -= L33_0[2] * x2; a3 -= L33_0[3] * x3; a0 -= L33_1[0] * x4; a1 -= L33_1[1] * x5; a2 -= L33_1[2] * x6; a3 -= L33_1[3] * x7; a0 -= L33_2[0] * x8; a1 -= L33_2[1] * x9; a2 -= L33_2[2] * x10; a3 -= L33_2[3] * x11; a0 -= L33_3[0] * x12; a1 -= L33_3[1] * x13; a2 -= L33_3[2] * x14; a3 -= L33_3[3] * x15; a0 -= L33_4[0] * x16; a1 -= L33_4[1] * x17; a2 -= L33_4[2] * x18; a3 -= L33_4[3] * x19; a0 -= L33_5[0] * x20; a1 -= L33_5[1] * x21; a2 -= L33_5[2] * x22; a3 -= L33_5[3] * x23; a0 -= L33_6[0] * x24; a1 -= L33_6[1] * x25; a2 -= L33_6[2] * x26; a3 -= L33_6[3] * x27; a0 -= L33_7[0] * x28; a1 -= L33_7[1] * x29; a2 -= L33_7[2] * x30; a3 -= L33_7[3] * x31; a0 -= L33_8[0] * x32; x33 = (a0 + a1) + (a2 + a3); }
        asm volatile("" ::: "memory");
        const float rr35 = X[35 * XS] * scp[35]; const f32x4 L35_0 = *(const LAS f32x4*)(LmV + 35 * LS + 0); const f32x4 L35_1 = *(const LAS f32x4*)(LmV + 35 * LS + 4); const f32x4 L34_2 = *(const LAS f32x4*)(LmV + 34 * LS + 8); const f32x4 L34_3 = *(const LAS f32x4*)(LmV + 34 * LS + 12); const f32x4 L34_4 = *(const LAS f32x4*)(LmV + 34 * LS + 16); const f32x4 L34_5 = *(const LAS f32x4*)(LmV + 34 * LS + 20); const f32x4 L34_6 = *(const LAS f32x4*)(LmV + 34 * LS + 24); const f32x4 L34_7 = *(const LAS f32x4*)(LmV + 34 * LS + 28); const f32x4 L34_8 = *(const LAS f32x4*)(LmV + 34 * LS + 32);
        float x34; { float a0 = rr34, a1 = 0.f, a2 = 0.f, a3 = 0.f; a0 -= L34_0[0] * x0; a1 -= L34_0[1] * x1; a2 -= L34_0[2] * x2; a3 -= L34_0[3] * x3; a0 -= L34_1[0] * x4; a1 -= L34_1[1] * x5; a2 -= L34_1[2] * x6; a3 -= L34_1[3] * x7; a0 -= L34_2[0] * x8; a1 -= L34_2[1] * x9; a2 -= L34_2[2] * x10; a3 -= L34_2[3] * x11; a0 -= L34_3[0] * x12; a1 -= L34_3[1] * x13; a2 -= L34_3[2] * x14; a3 -= L34_3[3] * x15; a0 -= L34_4[0] * x16; a1 -= L34_4[1] * x17; a2 -= L34_4[2] * x18; a3 -= L34_4[3] * x19; a0 -= L34_5[0] * x20; a1 -= L34_5[1] * x21; a2 -= L34_5[2] * x22; a3 -= L34_5[3] * x23; a0 -= L34_6[0] * x24; a1 -= L34_6[1] * x25; a2 -= L34_6[2] * x26; a3 -= L34_6[3] * x27; a0 -= L34_7[0] * x28; a1 -= L34_7[1] * x29; a2 -= L34_7[2] * x30; a3 -= L34_7[3] * x31; a0 -= L34_8[0] * x32; a1 -= L34_8[1] * x33; x34 = (a0 + a1) + (a2 + a3); }
        asm volatile("" ::: "memory");
        const float rr36 = X[36 * XS] * scp[36]; const f32x4 L36_0 = *(const LAS f32x4*)(LmV + 36 * LS + 0); const f32x4 L36_1 = *(const LAS f32x4*)(LmV + 36 * LS + 4); const f32x4 L35_2 = *(const LAS f32x4*)(LmV + 35 * LS + 8); const f32x4 L35_3 = *(const LAS f32x4*)(LmV + 35 * LS + 12); const f32x4 L35_4 = *(const LAS f32x4*)(LmV + 35 * LS + 16); const f32x4 L35_5 = *(const LAS f32x4*)(LmV + 35 * LS + 20); const f32x4 L35_6 = *(const LAS f32x4*)(LmV + 35 * LS + 24); const f32x4 L35_7 = *(const LAS f32x4*)(LmV + 35 * LS + 28); const f32x4 L35_8 = *(const LAS f32x4*)(LmV + 35 * LS + 32);
        float x35; { float a0 = rr35, a1 = 0.f, a2 = 0.f, a3 = 0.f; a0 -= L35_0[0] * x0; a1 -= L35_0[1] * x1; a2 -= L35_0[2] * x2; a3 -= L35_0[3] * x3; a0 -= L35_1[0] * x4; a1 -= L35_1[1] * x5; a2 -= L35_1[2] * x6; a3 -= L35_1[3] * x7; a0 -= L35_2[0] * x8; a1 -= L35_2[1] * x9; a2 -= L35_2[2] * x10; a3 -= L35_2[3] * x11; a0 -= L35_3[0] * x12; a1 -= L35_3[1] * x13; a2 -= L35_3[2] * x14; a3 -= L35_3[3] * x15; a0 -= L35_4[0] * x16; a1 -= L35_4[1] * x17; a2 -= L35_4[2] * x18; a3 -= L35_4[3] * x19; a0 -= L35_5[0] * x20; a1 -= L35_5[1] * x21; a2 -= L35_5[2] * x22; a3 -= L35_5[3] * x23; a0 -= L35_6[0] * x24; a1 -= L35_6[1] * x25; a2 -= L35_6[2] * x26; a3 -= L35_6[3] * x27; a0 -= L35_7[0] * x28; a1 -= L35_7[1] * x29; a2 -= L35_7[2] * x30; a3 -= L35_7[3] * x31; a0 -= L35_8[0] * x32; a1 -= L35_8[1] * x33; a2 -= L35_8[2] * x34; x35 = (a0 + a1) + (a2 + a3); }
        asm volatile("" ::: "memory");
        const float rr37 = X[37 * XS] * scp[37]; const f32x4 L37_0 = *(const LAS f32x4*)(LmV + 37 * LS + 0); const f32x4 L37_1 = *(const LAS f32x4*)(LmV + 37 * LS + 4); const f32x4 L36_2 = *(const LAS f32x4*)(LmV + 36 * LS + 8); const f32x4 L36_3 = *(const LAS f32x4*)(LmV + 36 * LS + 12); const f32x4 L36_4 = *(const LAS f32x4*)(LmV + 36 * LS + 16); const f32x4 L36_5 = *(const LAS f32x4*)(LmV + 36 * LS + 20); const f32x4 L36_6 = *(const LAS f32x4*)(LmV + 36 * LS + 24); const f32x4 L36_7 = *(const LAS f32x4*)(LmV + 36 * LS + 28); const f32x4 L36_8 = *(const LAS f32x4*)(LmV + 36 * LS + 32);
        float x36; { float a0 = rr36, a1 = 0.f, a2 = 0.f, a3 = 0.f; a0 -= L36_0[0] * x0; a1 -= L36_0[1] * x1; a2 -= L36_0[2] * x2; a3 -= L36_0[3] * x3; a0 -= L36_1[0] * x4; a1 -= L36_1[1] * x5; a2 -= L36_1[2] * x6; a3 -= L36_1[3] * x7; a0 -= L36_2[0] * x8; a1 -= L36_2[1] * x9; a2 -= L36_2[2] * x10; a3 -= L36_2[3] * x11; a0 -= L36_3[0] * x12; a1 -= L36_3[1] * x13; a2 -= L36_3[2] * x14; a3 -= L36_3[3] * x15; a0 -= L36_4[0] * x16; a1 -= L36_4[1] * x17; a2 -= L36_4[2] * x18; a3 -= L36_4[3] * x19; a0 -= L36_5[0] * x20; a1 -= L36_5[1] * x21; a2 -= L36_5[2] * x22; a3 -= L36_5[3] * x23; a0 -= L36_6[0] * x24; a1 -= L36_6[1] * x25; a2 -= L36_6[2] * x26; a3 -= L36_6[3] * x27; a0 -= L36_7[0] * x28; a1 -= L36_7[1] * x29; a2 -= L36_7[2] * x30; a3 -= L36_7[3] * x31; a0 -= L36_8[0] * x32; a1 -= L36_8[1] * x33; a2 -= L36_8[2] * x34; a3 -= L36_8[3] * x35; x36 = (a0 + a1) + (a2 + a3); }
        asm volatile("" ::: "memory");
        const float rr38 = X[38 * XS] * scp[38]; const f32x4 L38_0 = *(const LAS f32x4*)(LmV + 38 * LS + 0); const f32x4 L38_1 = *(const LAS f32x4*)(LmV + 38 * LS + 4); const f32x4 L37_2 = *(const LAS f32x4*)(LmV + 37 * LS + 8); const f32x4 L37_3 = *(const LAS f32x4*)(LmV + 37 * LS + 12); const f32x4 L37_4 = *(const LAS f32x4*)(LmV + 37 * LS + 16); const f32x4 L37_5 = *(const LAS f32x4*)(LmV + 37 * LS + 20); const f32x4 L37_6 = *(const LAS f32x4*)(LmV + 37 * LS + 24); const f32x4 L37_7 = *(const LAS f32x4*)(LmV + 37 * LS + 28); const f32x4 L37_8 = *(const LAS f32x4*)(LmV + 37 * LS + 32); const f32x4 L37_9 = *(const LAS f32x4*)(LmV + 37 * LS + 36);
        float x37; { float a0 = rr37, a1 = 0.f, a2 = 0.f, a3 = 0.f; a0 -= L37_0[0] * x0; a1 -= L37_0[1] * x1; a2 -= L37_0[2] * x2; a3 -= L37_0[3] * x3; a0 -= L37_1[0] * x4; a1 -= L37_1[1] * x5; a2 -= L37_1[2] * x6; a3 -= L37_1[3] * x7; a0 -= L37_2[0] * x8; a1 -= L37_2[1] * x9; a2 -= L37_2[2] * x10; a3 -= L37_2[3] * x11; a0 -= L37_3[0] * x12; a1 -= L37_3[1] * x13; a2 -= L37_3[2] * x14; a3 -= L37_3[3] * x15; a0 -= L37_4[0] * x16; a1 -= L37_4[1] * x17; a2 -= L37_4[2] * x18; a3 -= L37_4[3] * x19; a0 -= L37_5[0] * x20; a1 -= L37_5[1] * x21; a2 -= L37_5[2] * x22; a3 -= L37_5[3] * x23; a0 -= L37_6[0] * x24; a1 -= L37_6[1] * x25; a2 -= L37_6[2] * x26; a3 -= L37_6[3] * x27; a0 -= L37_7[0] * x28; a1 -= L37_7[1] * x29; a2 -= L37_7[2] * x30; a3 -= L37_7[3] * x31; a0 -= L37_8[0] * x32; a1 -= L37_8[1] * x33; a2 -= L37_8[2] * x34; a3 -= L37_8[3] * x35; a0 -= L37_9[0] * x36; x37 = (a0 + a1) + (a2 + a3); }
        asm volatile("" ::: "memory");
        const float rr39 = X[39 * XS] * scp[39]; const f32x4 L39_0 = *(const LAS f32x4*)(LmV + 39 * LS + 0); const f32x4 L39_1 = *(const LAS f32x4*)(LmV + 39 * LS + 4); const f32x4 L38_2 = *(const LAS f32x4*)(LmV + 38 * LS + 8); const f32x4 L38_3 = *(const LAS f32x4*)(LmV + 38 * LS + 12); const f32x4 L38_4 = *(const LAS f32x4*)(LmV + 38 * LS + 16); const f32x4 L38_5 = *(const LAS f32x4*)(LmV + 38 * LS + 20); const f32x4 L38_6 = *(const LAS f32x4*)(LmV + 38 * LS + 24); const f32x4 L38_7 = *(const LAS f32x4*)(LmV + 38 * LS + 28); const f32x4 L38_8 = *(const LAS f32x4*)(LmV + 38 * LS + 32); const f32x4 L38_9 = *(const LAS f32x4*)(LmV + 38 * LS + 36);
        float x38; { float a0 = rr38, a1 = 0.f, a2 = 0.f, a3 = 0.f; a0 -= L38_0[0] * x0; a1 -= L38_0[1] * x1; a2 -= L38_0[2] * x2; a3 -= L38_0[3] * x3; a0 -= L38_1[0] * x4; a1 -= L38_1[1] * x5; a2 -= L38_1[2] * x6; a3 -= L38_1[3] * x7; a0 -= L38_2[0] * x8; a1 -= L38_2[1] * x9; a2 -= L38_2[2] * x10; a3 -= L38_2[3] * x11; a0 -= L38_3[0] * x12; a1 -= L38_3[1] * x13; a2 -= L38_3[2] * x14; a3 -= L38_3[3] * x15; a0 -= L38_4[0] * x16; a1 -= L38_4[1] * x17; a2 -= L38_4[2] * x18; a3 -= L38_4[3] * x19; a0 -= L38_5[0] * x20; a1 -= L38_5[1] * x21; a2 -= L38_5[2] * x22; a3 -= L38_5[3] * x23; a0 -= L38_6[0] * x24; a1 -= L38_6[1] * x25; a2 -= L38_6[2] * x26; a3 -= L38_6[3] * x27; a0 -= L38_7[0] * x28; a1 -= L38_7[1] * x29; a2 -= L38_7[2] * x30; a3 -= L38_7[3] * x31; a0 -= L38_8[0] * x32; a1 -= L38_8[1] * x33; a2 -= L38_8[2] * x34; a3 -= L38_8[3] * x35; a0 -= L38_9[0] * x36; a1 -= L38_9[1] * x37; x38 = (a0 + a1) + (a2 + a3); }
        asm volatile("" ::: "memory");
        const float rr40 = X[40 * XS] * scp[40]; const f32x4 L40_0 = *(const LAS f32x4*)(LmV + 40 * LS + 0); const f32x4 L40_1 = *(const LAS f32x4*)(LmV + 40 * LS + 4); const f32x4 L39_2 = *(const LAS f32x4*)(LmV + 39 * LS + 8); const f32x4 L39_3 = *(const LAS f32x4*)(LmV + 39 * LS + 12); const f32x4 L39_4 = *(const LAS f32x4*)(LmV + 39 * LS + 16); const f32x4 L39_5 = *(const LAS f32x4*)(LmV + 39 * LS + 20); const f32x4 L39_6 = *(const LAS f32x4*)(LmV + 39 * LS + 24); const f32x4 L39_7 = *(const LAS f32x4*)(LmV + 39 * LS + 28); const f32x4 L39_8 = *(const LAS f32x4*)(LmV + 39 * LS + 32); const f32x4 L39_9 = *(const LAS f32x4*)(LmV + 39 * LS + 36);
        float x39; { float a0 = rr39, a1 = 0.f, a2 = 0.f, a3 = 0.f; a0 -= L39_0[0] * x0; a1 -= L39_0[1] * x1; a2 -= L39_0[2] * x2; a3 -= L39_0[3] * x3; a0 -= L39_1[0] * x4; a1 -= L39_1[1] * x5; a2 -= L39_1[2] * x6; a3 -= L39_1[3] * x7; a0 -= L39_2[0] * x8; a1 -= L39_2[1] * x9; a2 -= L39_2[2] * x10; a3 -= L39_2[3] * x11; a0 -= L39_3[0] * x12; a1 -= L39_3[1] * x13; a2 -= L39_3[2] * x14; a3 -= L39_3[3] * x15; a0 -= L39_4[0] * x16; a1 -= L39_4[1] * x17; a2 -= L39_4[2] * x18; a3 -= L39_4[3] * x19; a0 -= L39_5[0] * x20; a1 -= L39_5[1] * x21; a2 -= L39_5[2] * x22; a3 -= L39_5[3] * x23; a0 -= L39_6[0] * x24; a1 -= L39_6[1] * x25; a2 -= L39_6[2] * x26; a3 -= L39_6[3] * x27; a0 -= L39_7[0] * x28; a1 -= L39_7[1] * x29; a2 -= L39_7[2] * x30; a3 -= L39_7[3] * x31; a0 -= L39_8[0] * x32; a1 -= L39_8[1] * x33; a2 -= L39_8[2] * x34; a3 -= L39_8[3] * x35; a0 -= L39_9[0] * x36; a1 -= L39_9[1] * x37; a2 -= L39_9[2] * x38; x39 = (a0 + a1) + (a2 + a3); }
        asm volatile("" ::: "memory");
        const float rr41 = X[41 * XS] * scp[41]; const f32x4 L41_0 = *(const LAS f32x4*)(LmV + 41 * LS + 0); const f32x4 L41_1 = *(const LAS f32x4*)(LmV + 41 * LS + 4); const f32x4 L40_2 = *(const LAS f32x4*)(LmV + 40 * LS + 8); const f32x4 L40_3 = *(const LAS f32x4*)(LmV + 40 * LS + 12); const f32x4 L40_4 = *(const LAS f32x4*)(LmV + 40 * LS + 16); const f32x4 L40_5 = *(const LAS f32x4*)(LmV + 40 * LS + 20); const f32x4 L40_6 = *(const LAS f32x4*)(LmV + 40 * LS + 24); const f32x4 L40_7 = *(const LAS f32x4*)(LmV + 40 * LS + 28); const f32x4 L40_8 = *(const LAS f32x4*)(LmV + 40 * LS + 32); const f32x4 L40_9 = *(const LAS f32x4*)(LmV + 40 * LS + 36);
        float x40; { float a0 = rr40, a1 = 0.f, a2 = 0.f, a3 = 0.f; a0 -= L40_0[0] * x0; a1 -= L40_0[1] * x1; a2 -= L40_0[2] * x2; a3 -= L40_0[3] * x3; a0 -= L40_1[0] * x4; a1 -= L40_1[1] * x5; a2 -= L40_1[2] * x6; a3 -= L40_1[3] * x7; a0 -= L40_2[0] * x8; a1 -= L40_2[1] * x9; a2 -= L40_2[2] * x10; a3 -= L40_2[3] * x11; a0 -= L40_3[0] * x12; a1 -= L40_3[1] * x13; a2 -= L40_3[2] * x14; a3 -= L40_3[3] * x15; a0 -= L40_4[0] * x16; a1 -= L40_4[1] * x17; a2 -= L40_4[2] * x18; a3 -= L40_4[3] * x19; a0 -= L40_5[0] * x20; a1 -= L40_5[1] * x21; a2 -= L40_5[2] * x22; a3 -= L40_5[3] * x23; a0 -= L40_6[0] * x24; a1 -= L40_6[1] * x25; a2 -= L40_6[2] * x26; a3 -= L40_6[3] * x27; a0 -= L40_7[0] * x28; a1 -= L40_7[1] * x29; a2 -= L40_7[2] * x30; a3 -= L40_7[3] * x31; a0 -= L40_8[0] * x32; a1 -= L40_8[1] * x33; a2 -= L40_8[2] * x34; a3 -= L40_8[3] * x35; a0 -= L40_9[0] * x36; a1 -= L40_9[1] * x37; a2 -= L40_9[2] * x38; a3 -= L40_9[3] * x39; x40 = (a0 + a1) + (a2 + a3); }
        asm volatile("" ::: "memory");
        const float rr42 = X[42 * XS] * scp[42]; const f32x4 L42_0 = *(const LAS f32x4*)(LmV + 42 * LS + 0); const f32x4 L42_1 = *(const LAS f32x4*)(LmV + 42 * LS + 4); const f32x4 L41_2 = *(const LAS f32x4*)(LmV + 41 * LS + 8); const f32x4 L41_3 = *(const LAS f32x4*)(LmV + 41 * LS + 12); const f32x4 L41_4 = *(const LAS f32x4*)(LmV + 41 * LS + 16); const f32x4 L41_5 = *(const LAS f32x4*)(LmV + 41 * LS + 20); const f32x4 L41_6 = *(const LAS f32x4*)(LmV + 41 * LS + 24); const f32x4 L41_7 = *(const LAS f32x4*)(LmV + 41 * LS + 28); const f32x4 L41_8 = *(const LAS f32x4*)(LmV + 41 * LS + 32); const f32x4 L41_9 = *(const LAS f32x4*)(LmV + 41 * LS + 36); const f32x4 L41_10 = *(const LAS f32x4*)(LmV + 41 * LS + 40);
        float x41; { float a0 = rr41, a1 = 0.f, a2 = 0.f, a3 = 0.f; a0 -= L41_0[0] * x0; a1 -= L41_0[1] * x1; a2 -= L41_0[2] * x2; a3 -= L41_0[3] * x3; a0 -= L41_1[0] * x4; a1 -= L41_1[1] * x5; a2 -= L41_1[2] * x6; a3 -= L41_1[3] * x7; a0 -= L41_2[0] * x8; a1 -= L41_2[1] * x9; a2 -= L41_2[2] * x10; a3 -= L41_2[3] * x11; a0 -= L41_3[0] * x12; a1 -= L41_3[1] * x13; a2 -= L41_3[2] * x14; a3 -= L41_3[3] * x15; a0 -= L41_4[0] * x16; a1 -= L41_4[1] * x17; a2 -= L41_4[2] * x18; a3 -= L41_4[3] * x19; a0 -= L41_5[0] * x20; a1 -= L41_5[1] * x21; a2 -= L41_5[2] * x22; a3 -= L41_5[3] * x23; a0 -= L41_6[0] * x24; a1 -= L41_6[1] * x25; a2 -= L41_6[2] * x26; a3 -= L41_6[3] * x27; a0 -= L41_7[0] * x28; a1 -= L41_7[1] * x29; a2 -= L41_7[2] * x30; a3 -= L41_7[3] * x31; a0 -= L41_8[0] * x32; a1 -= L41_8[1] * x33; a2 -= L41_8[2] * x34; a3 -= L41_8[3] * x35; a0 -= L41_9[0] * x36; a1 -= L41_9[1] * x37; a2 -= L41_9[2] * x38; a3 -= L41_9[3] * x39; a0 -= L41_10[0] * x40; x41 = (a0 + a1) + (a2 + a3); }
        asm volatile("" ::: "memory");
        const float rr43 = X[43 * XS] * scp[43]; const f32x4 L43_0 = *(const LAS f32x4*)(LmV + 43 * LS + 0); const f32x4 L43_1 = *(const LAS f32x4*)(LmV + 43 * LS + 4); const f32x4 L42_2 = *(const LAS f32x4*)(LmV + 42 * LS + 8); const f32x4 L42_3 = *(const LAS f32x4*)(LmV + 42 * LS + 12); const f32x4 L42_4 = *(const LAS f32x4*)(LmV + 42 * LS + 16); const f32x4 L42_5 = *(const LAS f32x4*)(LmV + 42 * LS + 20); const f32x4 L42_6 = *(const LAS f32x4*)(LmV + 42 * LS + 24); const f32x4 L42_7 = *(const LAS f32x4*)(LmV + 42 * LS + 28); const f32x4 L42_8 = *(const LAS f32x4*)(LmV + 42 * LS + 32); const f32x4 L42_9 = *(const LAS f32x4*)(LmV + 42 * LS + 36); const f32x4 L42_10 = *(const LAS f32x4*)(LmV + 42 * LS + 40);
        float x42; { float a0 = rr42, a1 = 0.f, a2 = 0.f, a3 = 0.f; a0 -= L42_0[0] * x0; a1 -= L42_0[1] * x1; a2 -= L42_0[2] * x2; a3 -= L42_0[3] * x3; a0 -= L42_1[0] * x4; a1 -= L42_1[1] * x5; a2 -= L42_1[2] * x6; a3 -= L42_1[3] * x7; a0 -= L42_2[0] * x8; a1 -= L42_2[1] * x9; a2 -= L42_2[2] * x10; a3 -= L42_2[3] * x11; a0 -= L42_3[0] * x12; a1 -= L42_3[1] * x13; a2 -= L42_3[2] * x14; a3 -= L42_3[3] * x15; a0 -= L42_4[0] * x16; a1 -= L42_4[1] * x17; a2 -= L42_4[2] * x18; a3 -= L42_4[3] * x19; a0 -= L42_5[0] * x20; a1 -= L42_5[1] * x21; a2 -= L42_5[2] * x22; a3 -= L42_5[3] * x23; a0 -= L42_6[0] * x24; a1 -= L42_6[1] * x25; a2 -= L42_6[2] * x26; a3 -= L42_6[3] * x27; a0 -= L42_7[0] * x28; a1 -= L42_7[1] * x29; a2 -= L42_7[2] * x30; a3 -= L42_7[3] * x31; a0 -= L42_8[0] * x32; a1 -= L42_8[1] * x33; a2 -= L42_8[2] * x34; a3 -= L42_8[3] * x35; a0 -= L42_9[0] * x36; a1 -= L42_9[1] * x37; a2 -= L42_9[2] * x38; a3 -= L42_9[3] * x39; a0 -= L42_10[0] * x40; a1 -= L42_10[1] * x41; x42 = (a0 + a1) + (a2 + a3); }
        asm volatile("" ::: "memory");
        const float rr44 = X[44 * XS] * scp[44]; const f32x4 L44_0 = *(const LAS f32x4*)(LmV + 44 * LS + 0); const f32x4 L44_1 = *(const LAS f32x4*)(LmV + 44 * LS + 4); const f32x4 L43_2 = *(const LAS f32x4*)(LmV + 43 * LS + 8); const f32x4 L43_3 = *(const LAS f32x4*)(LmV + 43 * LS + 12); const f32x4 L43_4 = *(const LAS f32x4*)(LmV + 43 * LS + 16); const f32x4 L43_5 = *(const LAS f32x4*)(LmV + 43 * LS + 20); const f32x4 L43_6 = *(const LAS f32x4*)(LmV + 43 * LS + 24); const f32x4 L43_7 = *(const LAS f32x4*)(LmV + 43 * LS + 28); const f32x4 L43_8 = *(const LAS f32x4*)(LmV + 43 * LS + 32); const f32x4 L43_9 = *(const LAS f32x4*)(LmV + 43 * LS + 36); const f32x4 L43_10 = *(const LAS f32x4*)(LmV + 43 * LS + 40);
        float x43; { float a0 = rr43, a1 = 0.f, a2 = 0.f, a3 = 0.f; a0 -= L43_0[0] * x0; a1 -= L43_0[1] * x1; a2 -= L43_0[2] * x2; a3 -= L43_0[3] * x3; a0 -= L43_1[0] * x4; a1 -= L43_1[1] * x5; a2 -= L43_1[2] * x6; a3 -= L43_1[3] * x7; a0 -= L43_2[0] * x8; a1 -= L43_2[1] * x9; a2 -= L43_2[2] * x10; a3 -= L43_2[3] * x11; a0 -= L43_3[0] * x12; a1 -= L43_3[1] * x13; a2 -= L43_3[2] * x14; a3 -= L43_3[3] * x15; a0 -= L43_4[0] * x16; a1 -= L43_4[1] * x17; a2 -= L43_4[2] * x18; a3 -= L43_4[3] * x19; a0 -= L43_5[0] * x20; a1 -= L43_5[1] * x21; a2 -= L43_5[2] * x22; a3 -= L43_5[3] * x23; a0 -= L43_6[0] * x24; a1 -= L43_6[1] * x25; a2 -= L43_6[2] * x26; a3 -= L43_6[3] * x27; a0 -= L43_7[0] * x28; a1 -= L43_7[1] * x29; a2 -= L43_7[2] * x30; a3 -= L43_7[3] * x31; a0 -= L43_8[0] * x32; a1 -= L43_8[1] * x33; a2 -= L43_8[2] * x34; a3 -= L43_8[3] * x35; a0 -= L43_9[0] * x36; a1 -= L43_9[1] * x37; a2 -= L43_9[2] * x38; a3 -= L43_9[3] * x39; a0 -= L43_10[0] * x40; a1 -= L43_10[1] * x41; a2 -= L43_10[2] * x42; x43 = (a0 + a1) + (a2 + a3); }
        asm volatile("" ::: "memory");
        const float rr45 = X[45 * XS] * scp[45]; const f32x4 L45_0 = *(const LAS f32x4*)(LmV + 45 * LS + 0); const f32x4 L45_1 = *(const LAS f32x4*)(LmV + 45 * LS + 4); const f32x4 L44_2 = *(const LAS f32x4*)(LmV + 44 * LS + 8); const f32x4 L44_3 = *(const LAS f32x4*)(LmV + 44 * LS + 12); const f32x4 L44_4 = *(const LAS f32x4*)(LmV + 44 * LS + 16); const f32x4 L44_5 = *(const LAS f32x4*)(LmV + 44 * LS + 20); const f32x4 L44_6 = *(const LAS f32x4*)(LmV + 44 * LS + 24); const f32x4 L44_7 = *(const LAS f32x4*)(LmV + 44 * LS + 28); const f32x4 L44_8 = *(const LAS f32x4*)(LmV + 44 * LS + 32); const f32x4 L44_9 = *(const LAS f32x4*)(LmV + 44 * LS + 36); const f32x4 L44_10 = *(const LAS f32x4*)(LmV + 44 * LS + 40);
        float x44; { float a0 = rr44, a1 = 0.f, a2 = 0.f, a3 = 0.f; a0 -= L44_0[0] * x0; a1 -= L44_0[1] * x1; a2 -= L44_0[2] * x2; a3 -= L44_0[3] * x3; a0 -= L44_1[0] * x4; a1 -= L44_1[1] * x5; a2 -= L44_1[2] * x6; a3 -= L44_1[3] * x7; a0 -= L44_2[0] * x8; a1 -= L44_2[1] * x9; a2 -= L44_2[2] * x10; a3 -= L44_2[3] * x11; a0 -= L44_3[0] * x12; a1 -= L44_3[1] * x13; a2 -= L44_3[2] * x14; a3 -= L44_3[3] * x15; a0 -= L44_4[0] * x16; a1 -= L44_4[1] * x17; a2 -= L44_4[2] * x18; a3 -= L44_4[3] * x19; a0 -= L44_5[0] * x20; a1 -= L44_5[1] * x21; a2 -= L44_5[2] * x22; a3 -= L44_5[3] * x23; a0 -= L44_6[0] * x24; a1 -= L44_6[1] * x25; a2 -= L44_6[2] * x26; a3 -= L44_6[3] * x27; a0 -= L44_7[0] * x28; a1 -= L44_7[1] * x29; a2 -= L44_7[2] * x30; a3 -= L44_7[3] * x31; a0 -= L44_8[0] * x32; a1 -= L44_8[1] * x33; a2 -= L44_8[2] * x34; a3 -= L44_8[3] * x35; a0 -= L44_9[0] * x36; a1 -= L44_9[1] * x37; a2 -= L44_9[2] * x38; a3 -= L44_9[3] * x39; a0 -= L44_10[0] * x40; a1 -= L44_10[1] * x41; a2 -= L44_10[2] * x42; a3 -= L44_10[3] * x43; x44 = (a0 + a1) + (a2 + a3); }
        asm volatile("" ::: "memory");
        const float rr46 = X[46 * XS] * scp[46]; const f32x4 L46_0 = *(const LAS f32x4*)(LmV + 46 * LS + 0); const f32x4 L46_1 = *(const LAS f32x4*)(LmV + 46 * LS + 4); const f32x4 L45_2 = *(const LAS f32x4*)(LmV + 45 * LS + 8); const f32x4 L45_3 = *(const LAS f32x4*)(LmV + 45 * LS + 12); const f32x4 L45_4 = *(const LAS f32x4*)(LmV + 45 * LS + 16); const f32x4 L45_5 = *(const LAS f32x4*)(LmV + 45 * LS + 20); const f32x4 L45_6 = *(const LAS f32x4*)(LmV + 45 * LS + 24); const f32x4 L45_7 = *(const LAS f32x4*)(LmV + 45 * LS + 28); const f32x4 L45_8 = *(const LAS f32x4*)(LmV + 45 * LS + 32); const f32x4 L45_9 = *(const LAS f32x4*)(LmV + 45 * LS + 36); const f32x4 L45_10 = *(const LAS f32x4*)(LmV + 45 * LS + 40); const f32x4 L45_11 = *(const LAS f32x4*)(LmV + 45 * LS + 44);
        float x45; { float a0 = rr45, a1 = 0.f, a2 = 0.f, a3 = 0.f; a0 -= L45_0[0] * x0; a1 -= L45_0[1] * x1; a2 -= L45_0[2] * x2; a3 -= L45_0[3] * x3; a0 -= L45_1[0] * x4; a1 -= L45_1[1] * x5; a2 -= L45_1[2] * x6; a3 -= L45_1[3] * x7; a0 -= L45_2[0] * x8; a1 -= L45_2[1] * x9; a2 -= L45_2[2] * x10; a3 -= L45_2[3] * x11; a0 -= L45_3[0] * x12; a1 -= L45_3[1] * x13; a2 -= L45_3[2] * x14; a3 -= L45_3[3] * x15; a0 -= L45_4[0] * x16; a1 -= L45_4[1] * x17; a2 -= L45_4[2] * x18; a3 -= L45_4[3] * x19; a0 -= L45_5[0] * x20; a1 -= L45_5[1] * x21; a2 -= L45_5[2] * x22; a3 -= L45_5[3] * x23; a0 -= L45_6[0] * x24; a1 -= L45_6[1] * x25; a2 -= L45_6[2] * x26; a3 -= L45_6[3] * x27; a0 -= L45_7[0] * x28; a1 -= L45_7[1] * x29; a2 -= L45_7[2] * x30; a3 -= L45_7[3] * x31; a0 -= L45_8[0] * x32; a1 -= L45_8[1] * x33; a2 -= L45_8[2] * x34; a3 -= L45_8[3] * x35; a0 -= L45_9[0] * x36; a1 -= L45_9[1] * x37; a2 -= L45_9[2] * x38; a3 -= L45_9[3] * x39; a0 -= L45_10[0] * x40; a1 -= L45_10[1] * x41; a2 -= L45_10[2] * x42; a3 -= L45_10[3] * x43; a0 -= L45_11[0] * x44; x45 = (a0 + a1) + (a2 + a3); }
        asm volatile("" ::: "memory");
        const float rr47 = X[47 * XS] * scp[47]; const f32x4 L47_0 = *(const LAS f32x4*)(LmV + 47 * LS + 0); const f32x4 L47_1 = *(const LAS f32x4*)(LmV + 47 * LS + 4); const f32x4 L46_2 = *(const LAS f32x4*)(LmV + 46 * LS + 8); const f32x4 L46_3 = *(const LAS f32x4*)(LmV + 46 * LS + 12); const f32x4 L46_4 = *(const LAS f32x4*)(LmV + 46 * LS + 16); const f32x4 L46_5 = *(const LAS f32x4*)(LmV + 46 * LS + 20); const f32x4 L46_6 = *(const LAS f32x4*)(LmV + 46 * LS + 24); const f32x4 L46_7 = *(const LAS f32x4*)(LmV + 46 * LS + 28); const f32x4 L46_8 = *(const LAS f32x4*)(LmV + 46 * LS + 32); const f32x4 L46_9 = *(const LAS f32x4*)(LmV + 46 * LS + 36); const f32x4 L46_10 = *(const LAS f32x4*)(LmV + 46 * LS + 40); const f32x4 L46_11 = *(const LAS f32x4*)(LmV + 46 * LS + 44);
        float x46; { float a0 = rr46, a1 = 0.f, a2 = 0.f, a3 = 0.f; a0 -= L46_0[0] * x0; a1 -= L46_0[1] * x1; a2 -= L46_0[2] * x2; a3 -= L46_0[3] * x3; a0 -= L46_1[0] * x4; a1 -= L46_1[1] * x5; a2 -= L46_1[2] * x6; a3 -= L46_1[3] * x7; a0 -= L46_2[0] * x8; a1 -= L46_2[1] * x9; a2 -= L46_2[2] * x10; a3 -= L46_2[3] * x11; a0 -= L46_3[0] * x12; a1 -= L46_3[1] * x13; a2 -= L46_3[2] * x14; a3 -= L46_3[3] * x15; a0 -= L46_4[0] * x16; a1 -= L46_4[1] * x17; a2 -= L46_4[2] * x18; a3 -= L46_4[3] * x19; a0 -= L46_5[0] * x20; a1 -= L46_5[1] * x21; a2 -= L46_5[2] * x22; a3 -= L46_5[3] * x23; a0 -= L46_6[0] * x24; a1 -= L46_6[1] * x25; a2 -= L46_6[2] * x26; a3 -= L46_6[3] * x27; a0 -= L46_7[0] * x28; a1 -= L46_7[1] * x29; a2 -= L46_7[2] * x30; a3 -= L46_7[3] * x31; a0 -= L46_8[0] * x32; a1 -= L46_8[1] * x33; a2 -= L46_8[2] * x34; a3 -= L46_8[3] * x35; a0 -= L46_9[0] * x36; a1 -= L46_9[1] * x37; a2 -= L46_9[2] * x38; a3 -= L46_9[3] * x39; a0 -= L46_10[0] * x40; a1 -= L46_10[1] * x41; a2 -= L46_10[2] * x42; a3 -= L46_10[3] * x43; a0 -= L46_11[0] * x44; a1 -= L46_11[1] * x45; x46 = (a0 + a1) + (a2 + a3); }
        asm volatile("" ::: "memory");
        const float rr48 = X[48 * XS] * scp[48]; const f32x4 L48_0 = *(const LAS f32x4*)(LmV + 48 * LS + 0); const f32x4 L48_1 = *(const LAS f32x4*)(LmV + 48 * LS + 4); const f32x4 L47_2 = *(const LAS f32x4*)(LmV + 47 * LS + 8); const f32x4 L47_3 = *(const LAS f32x4*)(LmV + 47 * LS + 12); const f32x4 L47_4 = *(const LAS f32x4*)(LmV + 47 * LS + 16); const f32x4 L47_5 = *(const LAS f32x4*)(LmV + 47 * LS + 20); const f32x4 L47_6 = *(const LAS f32x4*)(LmV + 47 * LS + 24); const f32x4 L47_7 = *(const LAS f32x4*)(LmV + 47 * LS + 28); const f32x4 L47_8 = *(const LAS f32x4*)(LmV + 47 * LS + 32); const f32x4 L47_9 = *(const LAS f32x4*)(LmV + 47 * LS + 36); const f32x4 L47_10 = *(const LAS f32x4*)(LmV + 47 * LS + 40); const f32x4 L47_11 = *(const LAS f32x4*)(LmV + 47 * LS + 44);
        float x47; { float a0 = rr47, a1 = 0.f, a2 = 0.f, a3 = 0.f; a0 -= L47_0[0] * x0; a1 -= L47_0[1] * x1; a2 -= L47_0[2] * x2; a3 -= L47_0[3] * x3; a0 -= L47_1[0] * x4; a1 -= L47_1[1] * x5; a2 -= L47_1[2] * x6; a3 -= L47_1[3] * x7; a0 -= L47_2[0] * x8; a1 -= L47_2[1] * x9; a2 -= L47_2[2] * x10; a3 -= L47_2[3] * x11; a0 -= L47_3[0] * x12; a1 -= L47_3[1] * x13; a2 -= L47_3[2] * x14; a3 -= L47_3[3] * x15; a0 -= L47_4[0] * x16; a1 -= L47_4[1] * x17; a2 -= L47_4[2] * x18; a3 -= L47_4[3] * x19; a0 -= L47_5[0] * x20; a1 -= L47_5[1] * x21; a2 -= L47_5[2] * x22; a3 -= L47_5[3] * x23; a0 -= L47_6[0] * x24; a1 -= L47_6[1] * x25; a2 -= L47_6[2] * x26; a3 -= L47_6[3] * x27; a0 -= L47_7[0] * x28; a1 -= L47_7[1] * x29; a2 -= L47_7[2] * x30; a3 -= L47_7[3] * x31; a0 -= L47_8[0] * x32; a1 -= L47_8[1] * x33; a2 -= L47_8[2] * x34; a3 -= L47_8[3] * x35; a0 -= L47_9[0] * x36; a1 -= L47_9[1] * x37; a2 -= L47_9[2] * x38; a3 -= L47_9[3] * x39; a0 -= L47_10[0] * x40; a1 -= L47_10[1] * x41; a2 -= L47_10[2] * x42; a3 -= L47_10[3] * x43; a0 -= L47_11[0] * x44; a1 -= L47_11[1] * x45; a2 -= L47_11[2] * x46; x47 = (a0 + a1) + (a2 + a3); }
        asm volatile("" ::: "memory");
        const float rr49 = X[49 * XS] * scp[49]; const f32x4 L49_0 = *(const LAS f32x4*)(LmV + 49 * LS + 0); const f32x4 L49_1 = *(const LAS f32x4*)(LmV + 49 * LS + 4); const f32x4 L48_2 = *(const LAS f32x4*)(LmV + 48 * LS + 8); const f32x4 L48_3 = *(const LAS f32x4*)(LmV + 48 * LS + 12); const f32x4 L48_4 = *(const LAS f32x4*)(LmV + 48 * LS + 16); const f32x4 L48_5 = *(const LAS f32x4*)(LmV + 48 * LS + 20); const f32x4 L48_6 = *(const LAS f32x4*)(LmV + 48 * LS + 24); const f32x4 L48_7 = *(const LAS f32x4*)(LmV + 48 * LS + 28); const f32x4 L48_8 = *(const LAS f32x4*)(LmV + 48 * LS + 32); const f32x4 L48_9 = *(const LAS f32x4*)(LmV + 48 * LS + 36); const f32x4 L48_10 = *(const LAS f32x4*)(LmV + 48 * LS + 40); const f32x4 L48_11 = *(const LAS f32x4*)(LmV + 48 * LS + 44);
        float x48; { float a0 = rr48, a1 = 0.f, a2 = 0.f, a3 = 0.f; a0 -= L48_0[0] * x0; a1 -= L48_0[1] * x1; a2 -= L48_0[2] * x2; a3 -= L48_0[3] * x3; a0 -= L48_1[0] * x4; a1 -= L48_1[1] * x5; a2 -= L48_1[2] * x6; a3 -= L48_1[3] * x7; a0 -= L48_2[0] * x8; a1 -= L48_2[1] * x9; a2 -= L48_2[2] * x10; a3 -= L48_2[3] * x11; a0 -= L48_3[0] * x12; a1 -= L48_3[1] * x13; a2 -= L48_3[2] * x14; a3 -= L48_3[3] * x15; a0 -= L48_4[0] * x16; a1 -= L48_4[1] * x17; a2 -= L48_4[2] * x18; a3 -= L48_4[3] * x19; a0 -= L48_5[0] * x20; a1 -= L48_5[1] * x21; a2 -= L48_5[2] * x22; a3 -= L48_5[3] * x23; a0 -= L48_6[0] * x24; a1 -= L48_6[1] * x25; a2 -= L48_6[2] * x26; a3 -= L48_6[3] * x27; a0 -= L48_7[0] * x28; a1 -= L48_7[1] * x29; a2 -= L48_7[2] * x30; a3 -= L48_7[3] * x31; a0 -= L48_8[0] * x32; a1 -= L48_8[1] * x33; a2 -= L48_8[2] * x34; a3 -= L48_8[3] * x35; a0 -= L48_9[0] * x36; a1 -= L48_9[1] * x37; a2 -= L48_9[2] * x38; a3 -= L48_9[3] * x39; a0 -= L48_10[0] * x40; a1 -= L48_10[1] * x41; a2 -= L48_10[2] * x42; a3 -= L48_10[3] * x43; a0 -= L48_11[0] * x44; a1 -= L48_11[1] * x45; a2 -= L48_11[2] * x46; a3 -= L48_11[3] * x47; x48 = (a0 + a1) + (a2 + a3); }
        asm volatile("" ::: "memory");
        const float rr50 = X[50 * XS] * scp[50]; const f32x4 L50_0 = *(const LAS f32x4*)(LmV + 50 * LS + 0); const f32x4 L50_1 = *(const LAS f32x4*)(LmV + 50 * LS + 4); const f32x4 L49_2 = *(const LAS f32x4*)(LmV + 49 * LS + 8); const f32x4 L49_3 = *(const LAS f32x4*)(LmV + 49 * LS + 12); const f32x4 L49_4 = *(const LAS f32x4*)(LmV + 49 * LS + 16); const f32x4 L49_5 = *(const LAS f32x4*)(LmV + 49 * LS + 20); const f32x4 L49_6 = *(const LAS f32x4*)(LmV + 49 * LS + 24); const f32x4 L49_7 = *(const LAS f32x4*)(LmV + 49 * LS + 28); const f32x4 L49_8 = *(const LAS f32x4*)(LmV + 49 * LS + 32); const f32x4 L49_9 = *(const LAS f32x4*)(LmV + 49 * LS + 36); const f32x4 L49_10 = *(const LAS f32x4*)(LmV + 49 * LS + 40); const f32x4 L49_11 = *(const LAS f32x4*)(LmV + 49 * LS + 44); const f32x4 L49_12 = *(const LAS f32x4*)(LmV + 49 * LS + 48);
        float x49; { float a0 = rr49, a1 = 0.f, a2 = 0.f, a3 = 0.f; a0 -= L49_0[0] * x0; a1 -= L49_0[1] * x1; a2 -= L49_0[2] * x2; a3 -= L49_0[3] * x3; a0 -= L49_1[0] * x4; a1 -= L49_1[1] * x5; a2 -= L49_1[2] * x6; a3 -= L49_1[3] * x7; a0 -= L49_2[0] * x8; a1 -= L49_2[1] * x9; a2 -= L49_2[2] * x10; a3 -= L49_2[3] * x11; a0 -= L49_3[0] * x12; a1 -= L49_3[1] * x13; a2 -= L49_3[2] * x14; a3 -= L49_3[3] * x15; a0 -= L49_4[0] * x16; a1 -= L49_4[1] * x17; a2 -= L49_4[2] * x18; a3 -= L49_4[3] * x19; a0 -= L49_5[0] * x20; a1 -= L49_5[1] * x21; a2 -= L49_5[2] * x22; a3 -= L49_5[3] * x23; a0 -= L49_6[0] * x24; a1 -= L49_6[1] * x25; a2 -= L49_6[2] * x26; a3 -= L49_6[3] * x27; a0 -= L49_7[0] * x28; a1 -= L49_7[1] * x29; a2 -= L49_7[2] * x30; a3 -= L49_7[3] * x31; a0 -= L49_8[0] * x32; a1 -= L49_8[1] * x33; a2 -= L49_8[2] * x34; a3 -= L49_8[3] * x35; a0 -= L49_9[0] * x36; a1 -= L49_9[1] * x37; a2 -= L49_9[2] * x38; a3 -= L49_9[3] * x39; a0 -= L49_10[0] * x40; a1 -= L49_10[1] * x41; a2 -= L49_10[2] * x42; a3 -= L49_10[3] * x43; a0 -= L49_11[0] * x44; a1 -= L49_11[1] * x45; a2 -= L49_11[2] * x46; a3 -= L49_11[3] * x47; a0 -= L49_12[0] * x48; x49 = (a0 + a1) + (a2 + a3); }
        asm volatile("" ::: "memory");
        const float rr51 = X[51 * XS] * scp[51]; const f32x4 L51_0 = *(const LAS f32x4*)(LmV + 51 * LS + 0); const f32x4 L51_1 = *(const LAS f32x4*)(LmV + 51 * LS + 4); const f32x4 L50_2 = *(const LAS f32x4*)(LmV + 50 * LS + 8); const f32x4 L50_3 = *(const LAS f32x4*)(LmV + 50 * LS + 12); const f32x4 L50_4 = *(const LAS f32x4*)(LmV + 50 * LS + 16); const f32x4 L50_5 = *(const LAS f32x4*)(LmV + 50 * LS + 20); const f32x4 L50_6 = *(const LAS f32x4*)(LmV + 50 * LS + 24); const f32x4 L50_7 = *(const LAS f32x4*)(LmV + 50 * LS + 28); const f32x4 L50_8 = *(const LAS f32x4*)(LmV + 50 * LS + 32); const f32x4 L50_9 = *(const LAS f32x4*)(LmV + 50 * LS + 36); const f32x4 L50_10 = *(const LAS f32x4*)(LmV + 50 * LS + 40); const f32x4 L50_11 = *(const LAS f32x4*)(LmV + 50 * LS + 44); const f32x4 L50_12 = *(const LAS f32x4*)(LmV + 50 * LS + 48);
        float x50; { float a0 = rr50, a1 = 0.f, a2 = 0.f, a3 = 0.f; a0 -= L50_0[0] * x0; a1 -= L50_0[1] * x1; a2 -= L50_0[2] * x2; a3 -= L50_0[3] * x3; a0 -= L50_1[0] * x4; a1 -= L50_1[1] * x5; a2 -= L50_1[2] * x6; a3 -= L50_1[3] * x7; a0 -= L50_2[0] * x8; a1 -= L50_2[1] * x9; a2 -= L50_2[2] * x10; a3 -= L50_2[3] * x11; a0 -= L50_3[0] * x12; a1 -= L50_3[1] * x13; a2 -= L50_3[2] * x14; a3 -= L50_3[3] * x15; a0 -= L50_4[0] * x16; a1 -= L50_4[1] * x17; a2 -= L50_4[2] * x18; a3 -= L50_4[3] * x19; a0 -= L50_5[0] * x20; a1 -= L50_5[1] * x21; a2 -= L50_5[2] * x22; a3 -= L50_5[3] * x23; a0 -= L50_6[0] * x24; a1 -= L50_6[1] * x25; a2 -= L50_6[2] * x26; a3 -= L50_6[3] * x27; a0 -= L50_7[0] * x28; a1 -= L50_7[1] * x29; a2 -= L50_7[2] * x30; a3 -= L50_7[3] * x31; a0 -= L50_8[0] * x32; a1 -= L50_8[1] * x33; a2 -= L50_8[2] * x34; a3 -= L50_8[3] * x35; a0 -= L50_9[0] * x36; a1 -= L50_9[1] * x37; a2 -= L50_9[2] * x38; a3 -= L50_9[3] * x39; a0 -= L50_10[0] * x40; a1 -= L50_10[1] * x41; a2 -= L50_10[2] * x42; a3 -= L50_10[3] * x43; a0 -= L50_11[0] * x44; a1 -= L50_11[1] * x45; a2 -= L50_11[2] * x46; a3 -= L50_11[3] * x47; a0 -= L50_12[0] * x48; a1 -= L50_12[1] * x49; x50 = (a0 + a1) + (a2 + a3); }
        asm volatile("" ::: "memory");
        const float rr52 = X[52 * XS] * scp[52]; const f32x4 L52_0 = *(const LAS f32x4*)(LmV + 52 * LS + 0); const f32x4 L52_1 = *(const LAS f32x4*)(LmV + 52 * LS + 4); const f32x4 L51_2 = *(const LAS f32x4*)(LmV + 51 * LS + 8); const f32x4 L51_3 = *(const LAS f32x4*)(LmV + 51 * LS + 12); const f32x4 L51_4 = *(const LAS f32x4*)(LmV + 51 * LS + 16); const f32x4 L51_5 = *(const LAS f32x4*)(LmV + 51 * LS + 20); const f32x4 L51_6 = *(const LAS f32x4*)(LmV + 51 * LS + 24); const f32x4 L51_7 = *(const LAS f32x4*)(LmV + 51 * LS + 28); const f32x4 L51_8 = *(const LAS f32x4*)(LmV + 51 * LS + 32); const f32x4 L51_9 = *(const LAS f32x4*)(LmV + 51 * LS + 36); const f32x4 L51_10 = *(const LAS f32x4*)(LmV + 51 * LS + 40); const f32x4 L51_11 = *(const LAS f32x4*)(LmV + 51 * LS + 44); const f32x4 L51_12 = *(const LAS f32x4*)(LmV + 51 * LS + 48);
        float x51; { float a0 = rr51, a1 = 0.f, a2 = 0.f, a3 = 0.f; a0 -= L51_0[0] * x0; a1 -= L51_0[1] * x1; a2 -= L51_0[2] * x2; a3 -= L51_0[3] * x3; a0 -= L51_1[0] * x4; a1 -= L51_1[1] * x5; a2 -= L51_1[2] * x6; a3 -= L51_1[3] * x7; a0 -= L51_2[0] * x8; a1 -= L51_2[1] * x9; a2 -= L51_2[2] * x10; a3 -= L51_2[3] * x11; a0 -= L51_3[0] * x12; a1 -= L51_3[1] * x13; a2 -= L51_3[2] * x14; a3 -= L51_3[3] * x15; a0 -= L51_4[0] * x16; a1 -= L51_4[1] * x17; a2 -= L51_4[2] * x18; a3 -= L51_4[3] * x19; a0 -= L51_5[0] * x20; a1 -= L51_5[1] * x21; a2 -= L51_5[2] * x22; a3 -= L51_5[3] * x23; a0 -= L51_6[0] * x24; a1 -= L51_6[1] * x25; a2 -= L51_6[2] * x26; a3 -= L51_6[3] * x27; a0 -= L51_7[0] * x28; a1 -= L51_7[1] * x29; a2 -= L51_7[2] * x30; a3 -= L51_7[3] * x31; a0 -= L51_8[0] * x32; a1 -= L51_8[1] * x33; a2 -= L51_8[2] * x34; a3 -= L51_8[3] * x35; a0 -= L51_9[0] * x36; a1 -= L51_9[1] * x37; a2 -= L51_9[2] * x38; a3 -= L51_9[3] * x39; a0 -= L51_10[0] * x40; a1 -= L51_10[1] * x41; a2 -= L51_10[2] * x42; a3 -= L51_10[3] * x43; a0 -= L51_11[0] * x44; a1 -= L51_11[1] * x45; a2 -= L51_11[2] * x46; a3 -= L51_11[3] * x47; a0 -= L51_12[0] * x48; a1 -= L51_12[1] * x49; a2 -= L51_12[2] * x50; x51 = (a0 + a1) + (a2 + a3); }
        asm volatile("" ::: "memory");
        const float rr53 = X[53 * XS] * scp[53]; const f32x4 L53_0 = *(const LAS f32x4*)(LmV + 53 * LS + 0); const f32x4 L53_1 = *(const LAS f32x4*)(LmV + 53 * LS + 4); const f32x4 L52_2 = *(const LAS f32x4*)(LmV + 52 * LS + 8); const f32x4 L52_3 = *(const LAS f32x4*)(LmV + 52 * LS + 12); const f32x4 L52_4 = *(const LAS f32x4*)(LmV + 52 * LS + 16); const f32x4 L52_5 = *(const LAS f32x4*)(LmV + 52 * LS + 20); const f32x4 L52_6 = *(const LAS f32x4*)(LmV + 52 * LS + 24); const f32x4 L52_7 = *(const LAS f32x4*)(LmV + 52 * LS + 28); const f32x4 L52_8 = *(const LAS f32x4*)(LmV + 52 * LS + 32); const f32x4 L52_9 = *(const LAS f32x4*)(LmV + 52 * LS + 36); const f32x4 L52_10 = *(const LAS f32x4*)(LmV + 52 * LS + 40); const f32x4 L52_11 = *(const LAS f32x4*)(LmV + 52 * LS + 44); const f32x4 L52_12 = *(const LAS f32x4*)(LmV + 52 * LS + 48);
        float x52; { float a0 = rr52, a1 = 0.f, a2 = 0.f, a3 = 0.f; a0 -= L52_0[0] * x0; a1 -= L52_0[1] * x1; a2 -= L52_0[2] * x2; a3 -= L52_0[3] * x3; a0 -= L52_1[0] * x4; a1 -= L52_1[1] * x5; a2 -= L52_1[2] * x6; a3 -= L52_1[3] * x7; a0 -= L52_2[0] * x8; a1 -= L52_2[1] * x9; a2 -= L52_2[2] * x10; a3 -= L52_2[3] * x11; a0 -= L52_3[0] * x12; a1 -= L52_3[1] * x13; a2 -= L52_3[2] * x14; a3 -= L52_3[3] * x15; a0 -= L52_4[0] * x16; a1 -= L52_4[1] * x17; a2 -= L52_4[2] * x18; a3 -= L52_4[3] * x19; a0 -= L52_5[0] * x20; a1 -= L52_5[1] * x21; a2 -= L52_5[2] * x22; a3 -= L52_5[3] * x23; a0 -= L52_6[0] * x24; a1 -= L52_6[1] * x25; a2 -= L52_6[2] * x26; a3 -= L52_6[3] * x27; a0 -= L52_7[0] * x28; a1 -= L52_7[1] * x29; a2 -= L52_7[2] * x30; a3 -= L52_7[3] * x31; a0 -= L52_8[0] * x32; a1 -= L52_8[1] * x33; a2 -= L52_8[2] * x34; a3 -= L52_8[3] * x35; a0 -= L52_9[0] * x36; a1 -= L52_9[1] * x37; a2 -= L52_9[2] * x38; a3 -= L52_9[3] * x39; a0 -= L52_10[0] * x40; a1 -= L52_10[1] * x41; a2 -= L52_10[2] * x42; a3 -= L52_10[3] * x43; a0 -= L52_11[0] * x44; a1 -= L52_11[1] * x45; a2 -= L52_11[2] * x46; a3 -= L52_11[3] * x47; a0 -= L52_12[0] * x48; a1 -= L52_12[1] * x49; a2 -= L52_12[2] * x50; a3 -= L52_12[3] * x51; x52 = (a0 + a1) + (a2 + a3); }
        asm volatile("" ::: "memory");
        const float rr54 = X[54 * XS] * scp[54]; const f32x4 L54_0 = *(const LAS f32x4*)(LmV + 54 * LS + 0); const f32x4 L54_1 = *(const LAS f32x4*)(LmV + 54 * LS + 4); const f32x4 L53_2 = *(const LAS f32x4*)(LmV + 53 * LS + 8); const f32x4 L53_3 = *(const LAS f32x4*)(LmV + 53 * LS + 12); const f32x4 L53_4 = *(const LAS f32x4*)(LmV + 53 * LS + 16); const f32x4 L53_5 = *(const LAS f32x4*)(LmV + 53 * LS + 20); const f32x4 L53_6 = *(const LAS f32x4*)(LmV + 53 * LS + 24); const f32x4 L53_7 = *(const LAS f32x4*)(LmV + 53 * LS + 28); const f32x4 L53_8 = *(const LAS f32x4*)(LmV + 53 * LS + 32); const f32x4 L53_9 = *(const LAS f32x4*)(LmV + 53 * LS + 36); const f32x4 L53_10 = *(const LAS f32x4*)(LmV + 53 * LS + 40); const f32x4 L53_11 = *(const LAS f32x4*)(LmV + 53 * LS + 44); const f32x4 L53_12 = *(const LAS f32x4*)(LmV + 53 * LS + 48); const f32x4 L53_13 = *(const LAS f32x4*)(LmV + 53 * LS + 52);
        float x53; { float a0 = rr53, a1 = 0.f, a2 = 0.f, a3 = 0.f; a0 -= L53_0[0] * x0; a1 -= L53_0[1] * x1; a2 -= L53_0[2] * x2; a3 -= L53_0[3] * x3; a0 -= L53_1[0] * x4; a1 -= L53_1[1] * x5; a2 -= L53_1[2] * x6; a3 -= L53_1[3] * x7; a0 -= L53_2[0] * x8; a1 -= L53_2[1] * x9; a2 -= L53_2[2] * x10; a3 -= L53_2[3] * x11; a0 -= L53_3[0] * x12; a1 -= L53_3[1] * x13; a2 -= L53_3[2] * x14; a3 -= L53_3[3] * x15; a0 -= L53_4[0] * x16; a1 -= L53_4[1] * x17; a2 -= L53_4[2] * x18; a3 -= L53_4[3] * x19; a0 -= L53_5[0] * x20; a1 -= L53_5[1] * x21; a2 -= L53_5[2] * x22; a3 -= L53_5[3] * x23; a0 -= L53_6[0] * x24; a1 -= L53_6[1] * x25; a2 -= L53_6[2] * x26; a3 -= L53_6[3] * x27; a0 -= L53_7[0] * x28; a1 -= L53_7[1] * x29; a2 -= L53_7[2] * x30; a3 -= L53_7[3] * x31; a0 -= L53_8[0] * x32; a1 -= L53_8[1] * x33; a2 -= L53_8[2] * x34; a3 -= L53_8[3] * x35; a0 -= L53_9[0] * x36; a1 -= L53_9[1] * x37; a2 -= L53_9[2] * x38; a3 -= L53_9[3] * x39; a0 -= L53_10[0] * x40; a1 -= L53_10[1] * x41; a2 -= L53_10[2] * x42; a3 -= L53_10[3] * x43; a0 -= L53_11[0] * x44; a1 -= L53_11[1] * x45; a2 -= L53_11[2] * x46; a3 -= L53_11[3] * x47; a0 -= L53_12[0] * x48; a1 -= L53_12[1] * x49; a2 -= L53_12[2] * x50; a3 -= L53_12[3] * x51; a0 -= L53_13[0] * x52; x53 = (a0 + a1) + (a2 + a3); }
        asm volatile("" ::: "memory");
        const float rr55 = X[55 * XS] * scp[55]; const f32x4 L55_0 = *(const LAS f32x4*)(LmV + 55 * LS + 0); const f32x4 L55_1 = *(const LAS f32x4*)(LmV + 55 * LS + 4); const f32x4 L54_2 = *(const LAS f32x4*)(LmV + 54 * LS + 8); const f32x4 L54_3 = *(const LAS f32x4*)(LmV + 54 * LS + 12); const f32x4 L54_4 = *(const LAS f32x4*)(LmV + 54 * LS + 16); const f32x4 L54_5 = *(const LAS f32x4*)(LmV + 54 * LS + 20); const f32x4 L54_6 = *(const LAS f32x4*)(LmV + 54 * LS + 24); const f32x4 L54_7 = *(const LAS f32x4*)(LmV + 54 * LS + 28); const f32x4 L54_8 = *(const LAS f32x4*)(LmV + 54 * LS + 32); const f32x4 L54_9 = *(const LAS f32x4*)(LmV + 54 * LS + 36); const f32x4 L54_10 = *(const LAS f32x4*)(LmV + 54 * LS + 40); const f32x4 L54_11 = *(const LAS f32x4*)(LmV + 54 * LS + 44); const f32x4 L54_12 = *(const LAS f32x4*)(LmV + 54 * LS + 48); const f32x4 L54_13 = *(const LAS f32x4*)(LmV + 54 * LS + 52);
        float x54; { float a0 = rr54, a1 = 0.f, a2 = 0.f, a3 = 0.f; a0 -= L54_0[0] * x0; a1 -= L54_0[1] * x1; a2 -= L54_0[2] * x2; a3 -= L54_0[3] * x3; a0 -= L54_1[0] * x4; a1 -= L54_1[1] * x5; a2 -= L54_1[2] * x6; a3 -= L54_1[3] * x7; a0 -= L54_2[0] * x8; a1 -= L54_2[1] * x9; a2 -= L54_2[2] * x10; a3 -= L54_2[3] * x11; a0 -= L54_3[0] * x12; a1 -= L54_3[1] * x13; a2 -= L54_3[2] * x14; a3 -= L54_3[3] * x15; a0 -= L54_4[0] * x16; a1 -= L54_4[1] * x17; a2 -= L54_4[2] * x18; a3 -= L54_4[3] * x19; a0 -= L54_5[0] * x20; a1 -= L54_5[1] * x21; a2 -= L54_5[2] * x22; a3 -= L54_5[3] * x23; a0 -= L54_6[0] * x24; a1 -= L54_6[1] * x25; a2 -= L54_6[2] * x26; a3 -= L54_6[3] * x27; a0 -= L54_7[0] * x28; a1 -= L54_7[1] * x29; a2 -= L54_7[2] * x30; a3 -= L54_7[3] * x31; a0 -= L54_8[0] * x32; a1 -= L54_8[1] * x33; a2 -= L54_8[2] * x34; a3 -= L54_8[3] * x35; a0 -= L54_9[0] * x36; a1 -= L54_9[1] * x37; a2 -= L54_9[2] * x38; a3 -= L54_9[3] * x39; a0 -= L54_10[0] * x40; a1 -= L54_10[1] * x41; a2 -= L54_10[2] * x42; a3 -= L54_10[3] * x43; a0 -= L54_11[0] * x44; a1 -= L54_11[1] * x45; a2 -= L54_11[2] * x46; a3 -= L54_11[3] * x47; a0 -= L54_12[0] * x48; a1 -= L54_12[1] * x49; a2 -= L54_12[2] * x50; a3 -= L54_12[3] * x51; a0 -= L54_13[0] * x52; a1 -= L54_13[1] * x53; x54 = (a0 + a1) + (a2 + a3); }
        asm volatile("" ::: "memory");
        const float rr56 = X[56 * XS] * scp[56]; const f32x4 L56_0 = *(const LAS f32x4*)(LmV + 56 * LS + 0); const f32x4 L56_1 = *(const LAS f32x4*)(LmV + 56 * LS + 4); const f32x4 L55_2 = *(const LAS f32x4*)(LmV + 55 * LS + 8); const f32x4 L55_3 = *(const LAS f32x4*)(LmV + 55 * LS + 12); const f32x4 L55_4 = *(const LAS f32x4*)(LmV + 55 * LS + 16); const f32x4 L55_5 = *(const LAS f32x4*)(LmV + 55 * LS + 20); const f32x4 L55_6 = *(const LAS f32x4*)(LmV + 55 * LS + 24); const f32x4 L55_7 = *(const LAS f32x4*)(LmV + 55 * LS + 28); const f32x4 L55_8 = *(const LAS f32x4*)(LmV + 55 * LS + 32); const f32x4 L55_9 = *(const LAS f32x4*)(LmV + 55 * LS + 36); const f32x4 L55_10 = *(const LAS f32x4*)(LmV + 55 * LS + 40); const f32x4 L55_11 = *(const LAS f32x4*)(LmV + 55 * LS + 44); const f32x4 L55_12 = *(const LAS f32x4*)(LmV + 55 * LS + 48); const f32x4 L55_13 = *(const LAS f32x4*)(LmV + 55 * LS + 52);
        float x55; { float a0 = rr55, a1 = 0.f, a2 = 0.f, a3 = 0.f; a0 -= L55_0[0] * x0; a1 -= L55_0[1] * x1; a2 -= L55_0[2] * x2; a3 -= L55_0[3] * x3; a0 -= L55_1[0] * x4; a1 -= L55_1[1] * x5; a2 -= L55_1[2] * x6; a3 -= L55_1[3] * x7; a0 -= L55_2[0] * x8; a1 -= L55_2[1] * x9; a2 -= L55_2[2] * x10; a3 -= L55_2[3] * x11; a0 -= L55_3[0] * x12; a1 -= L55_3[1] * x13; a2 -= L55_3[2] * x14; a3 -= L55_3[3] * x15; a0 -= L55_4[0] * x16; a1 -= L55_4[1] * x17; a2 -= L55_4[2] * x18; a3 -= L55_4[3] * x19; a0 -= L55_5[0] * x20; a1 -= L55_5[1] * x21; a2 -= L55_5[2] * x22; a3 -= L55_5[3] * x23; a0 -= L55_6[0] * x24; a1 -= L55_6[1] * x25; a2 -= L55_6[2] * x26; a3 -= L55_6[3] * x27; a0 -= L55_7[0] * x28; a1 -= L55_7[1] * x29; a2 -= L55_7[2] * x30; a3 -= L55_7[3] * x31; a0 -= L55_8[0] * x32; a1 -= L55_8[1] * x33; a2 -= L55_8[2] * x34; a3 -= L55_8[3] * x35; a0 -= L55_9[0] * x36; a1 -= L55_9[1] * x37; a2 -= L55_9[2] * x38; a3 -= L55_9[3] * x39; a0 -= L55_10[0] * x40; a1 -= L55_10[1] * x41; a2 -= L55_10[2] * x42; a3 -= L55_10[3] * x43; a0 -= L55_11[0] * x44; a1 -= L55_11[1] * x45; a2 -= L55_11[2] * x46; a3 -= L55_11[3] * x47; a0 -= L55_12[0] * x48; a1 -= L55_12[1] * x49; a2 -= L55_12[2] * x50; a3 -= L55_12[3] * x51; a0 -= L55_13[0] * x52; a1 -= L55_13[1] * x53; a2 -= L55_13[2] * x54; x55 = (a0 + a1) + (a2 + a3); }
        asm volatile("" ::: "memory");
        const float rr57 = X[57 * XS] * scp[57]; const f32x4 L57_0 = *(const LAS f32x4*)(LmV + 57 * LS + 0); const f32x4 L57_1 = *(const LAS f32x4*)(LmV + 57 * LS + 4); const f32x4 L56_2 = *(const LAS f32x4*)(LmV + 56 * LS + 8); const f32x4 L56_3 = *(const LAS f32x4*)(LmV + 56 * LS + 12); const f32x4 L56_4 = *(const LAS f32x4*)(LmV + 56 * LS + 16); const f32x4 L56_5 = *(const LAS f32x4*)(LmV + 56 * LS + 20); const f32x4 L56_6 = *(const LAS f32x4*)(LmV + 56 * LS + 24); const f32x4 L56_7 = *(const LAS f32x4*)(LmV + 56 * LS + 28); const f32x4 L56_8 = *(const LAS f32x4*)(LmV + 56 * LS + 32); const f32x4 L56_9 = *(const LAS f32x4*)(LmV + 56 * LS + 36); const f32x4 L56_10 = *(const LAS f32x4*)(LmV + 56 * LS + 40); const f32x4 L56_11 = *(const LAS f32x4*)(LmV + 56 * LS + 44); const f32x4 L56_12 = *(const LAS f32x4*)(LmV + 56 * LS + 48); const f32x4 L56_13 = *(const LAS f32x4*)(LmV + 56 * LS + 52);
        float x56; { float a0 = rr56, a1 = 0.f, a2 = 0.f, a3 = 0.f; a0 -= L56_0[0] * x0; a1 -= L56_0[1] * x1; a2 -= L56_0[2] * x2; a3 -= L56_0[3] * x3; a0 -= L56_1[0] * x4; a1 -= L56_1[1] * x5; a2 -= L56_1[2] * x6; a3 -= L56_1[3] * x7; a0 -= L56_2[0] * x8; a1 -= L56_2[1] * x9; a2 -= L56_2[2] * x10; a3 -= L56_2[3] * x11; a0 -= L56_3[0] * x12; a1 -= L56_3[1] * x13; a2 -= L56_3[2] * x14; a3 -= L56_3[3] * x15; a0 -= L56_4[0] * x16; a1 -= L56_4[1] * x17; a2 -= L56_4[2] * x18; a3 -= L56_4[3] * x19; a0 -= L56_5[0] * x20; a1 -= L56_5[1] * x21; a2 -= L56_5[2] * x22; a3 -= L56_5[3] * x23; a0 -= L56_6[0] * x24; a1 -= L56_6[1] * x25; a2 -= L56_6[2] * x26; a3 -= L56_6[3] * x27; a0 -= L56_7[0] * x28; a1 -= L56_7[1] * x29; a2 -= L56_7[2] * x30; a3 -= L56_7[3] * x31; a0 -= L56_8[0] * x32; a1 -= L56_8[1] * x33; a2 -= L56_8[2] * x34; a3 -= L56_8[3] * x35; a0 -= L56_9[0] * x36; a1 -= L56_9[1] * x37; a2 -= L56_9[2] * x38; a3 -= L56_9[3] * x39; a0 -= L56_10[0] * x40; a1 -= L56_10[1] * x41; a2 -= L56_10[2] * x42; a3 -= L56_10[3] * x43; a0 -= L56_11[0] * x44; a1 -= L56_11[1] * x45; a2 -= L56_11[2] * x46; a3 -= L56_11[3] * x47; a0 -= L56_12[0] * x48; a1 -= L56_12[1] * x49; a2 -= L56_12[2] * x50; a3 -= L56_12[3] * x51; a0 -= L56_13[0] * x52; a1 -= L56_13[1] * x53; a2 -= L56_13[2] * x54; a3 -= L56_13[3] * x55; x56 = (a0 + a1) + (a2 + a3); }
        asm volatile("" ::: "memory");
        const float rr58 = X[58 * XS] * scp[58]; const f32x4 L58_0 = *(const LAS f32x4*)(LmV + 58 * LS + 0); const f32x4 L58_1 = *(const LAS f32x4*)(LmV + 58 * LS + 4); const f32x4 L57_2 = *(const LAS f32x4*)(LmV + 57 * LS + 8); const f32x4 L57_3 = *(const LAS f32x4*)(LmV + 57 * LS + 12); const f32x4 L57_4 = *(const LAS f32x4*)(LmV + 57 * LS + 16); const f32x4 L57_5 = *(const LAS f32x4*)(LmV + 57 * LS + 20); const f32x4 L57_6 = *(const LAS f32x4*)(LmV + 57 * LS + 24); const f32x4 L57_7 = *(const LAS f32x4*)(LmV + 57 * LS + 28); const f32x4 L57_8 = *(const LAS f32x4*)(LmV + 57 * LS + 32); const f32x4 L57_9 = *(const LAS f32x4*)(LmV + 57 * LS + 36); const f32x4 L57_10 = *(const LAS f32x4*)(LmV + 57 * LS + 40); const f32x4 L57_11 = *(const LAS f32x4*)(LmV + 57 * LS + 44); const f32x4 L57_12 = *(const LAS f32x4*)(LmV + 57 * LS + 48); const f32x4 L57_13 = *(const LAS f32x4*)(LmV + 57 * LS + 52); const f32x4 L57_14 = *(const LAS f32x4*)(LmV + 57 * LS + 56);
        float x57; { float a0 = rr57, a1 = 0.f, a2 = 0.f, a3 = 0.f; a0 -= L57_0[0] * x0; a1 -= L57_0[1] * x1; a2 -= L57_0[2] * x2; a3 -= L57_0[3] * x3; a0 -= L57_1[0] * x4; a1 -= L57_1[1] * x5; a2 -= L57_1[2] * x6; a3 -= L57_1[3] * x7; a0 -= L57_2[0] * x8; a1 -= L57_2[1] * x9; a2 -= L57_2[2] * x10; a3 -= L57_2[3] * x11; a0 -= L57_3[0] * x12; a1 -= L57_3[1] * x13; a2 -= L57_3[2] * x14; a3 -= L57_3[3] * x15; a0 -= L57_4[0] * x16; a1 -= L57_4[1] * x17; a2 -= L57_4[2] * x18; a3 -= L57_4[3] * x19; a0 -= L57_5[0] * x20; a1 -= L57_5[1] * x21; a2 -= L57_5[2] * x22; a3 -= L57_5[3] * x23; a0 -= L57_6[0] * x24; a1 -= L57_6[1] * x25; a2 -= L57_6[2] * x26; a3 -= L57_6[3] * x27; a0 -= L57_7[0] * x28; a1 -= L57_7[1] * x29; a2 -= L57_7[2] * x30; a3 -= L57_7[3] * x31; a0 -= L57_8[0] * x32; a1 -= L57_8[1] * x33; a2 -= L57_8[2] * x34; a3 -= L57_8[3] * x35; a0 -= L57_9[0] * x36; a1 -= L57_9[1] * x37; a2 -= L57_9[2] * x38; a3 -= L57_9[3] * x39; a0 -= L57_10[0] * x40; a1 -= L57_10[1] * x41; a2 -= L57_10[2] * x42; a3 -= L57_10[3] * x43; a0 -= L57_11[0] * x44; a1 -= L57_11[1] * x45; a2 -= L57_11[2] * x46; a3 -= L57_11[3] * x47; a0 -= L57_12[0] * x48; a1 -= L57_12[1] * x49; a2 -= L57_12[2] * x50; a3 -= L57_12[3] * x51; a0 -= L57_13[0] * x52; a1 -= L57_13[1] * x53; a2 -= L57_13[2] * x54; a3 -= L57_13[3] * x55; a0 -= L57_14[0] * x56; x57 = (a0 + a1) + (a2 + a3); }
        asm volatile("" ::: "memory");
        const float rr59 = X[59 * XS] * scp[59]; const f32x4 L59_0 = *(const LAS f32x4*)(LmV + 59 * LS + 0); const f32x4 L59_1 = *(const LAS f32x4*)(LmV + 59 * LS + 4); const f32x4 L58_2 = *(const LAS f32x4*)(LmV + 58 * LS + 8); const f32x4 L58_3 = *(const LAS f32x4*)(LmV + 58 * LS + 12); const f32x4 L58_4 = *(const LAS f32x4*)(LmV + 58 * LS + 16); const f32x4 L58_5 = *(const LAS f32x4*)(LmV + 58 * LS + 20); const f32x4 L58_6 = *(const LAS f32x4*)(LmV + 58 * LS + 24); const f32x4 L58_7 = *(const LAS f32x4*)(LmV + 58 * LS + 28); const f32x4 L58_8 = *(const LAS f32x4*)(LmV + 58 * LS + 32); const f32x4 L58_9 = *(const LAS f32x4*)(LmV + 58 * LS + 36); const f32x4 L58_10 = *(const LAS f32x4*)(LmV + 58 * LS + 40); const f32x4 L58_11 = *(const LAS f32x4*)(LmV + 58 * LS + 44); const f32x4 L58_12 = *(const LAS f32x4*)(LmV + 58 * LS + 48); const f32x4 L58_13 = *(const LAS f32x4*)(LmV + 58 * LS + 52); const f32x4 L58_14 = *(const LAS f32x4*)(LmV + 58 * LS + 56);
        float x58; { float a0 = rr58, a1 = 0.f, a2 = 0.f, a3 = 0.f; a0 -= L58_0[0] * x0; a1 -= L58_0[1] * x1; a2 -= L58_0[2] * x2; a3 -= L58_0[3] * x3; a0 -= L58_1[0] * x4; a1 -= L58_1[1] * x5; a2 -= L58_1[2] * x6; a3 -= L58_1[3] * x7; a0 -= L58_2[0] * x8; a1 -= L58_2[1] * x9; a2 -= L58_2[2] * x10; a3 -= L58_2[3] * x11; a0 -= L58_3[0] * x12; a1 -= L58_3[1] * x13; a2 -= L58_3[2] * x14; a3 -= L58_3[3] * x15; a0 -= L58_4[0] * x16; a1 -= L58_4[1] * x17; a2 -= L58_4[2] * x18; a3 -= L58_4[3] * x19; a0 -= L58_5[0] * x20; a1 -= L58_5[1] * x21; a2 -= L58_5[2] * x22; a3 -= L58_5[3] * x23; a0 -= L58_6[0] * x24; a1 -= L58_6[1] * x25; a2 -= L58_6[2] * x26; a3 -= L58_6[3] * x27; a0 -= L58_7[0] * x28; a1 -= L58_7[1] * x29; a2 -= L58_7[2] * x30; a3 -= L58_7[3] * x31; a0 -= L58_8[0] * x32; a1 -= L58_8[1] * x33; a2 -= L58_8[2] * x34; a3 -= L58_8[3] * x35; a0 -= L58_9[0] * x36; a1 -= L58_9[1] * x37; a2 -= L58_9[2] * x38; a3 -= L58_9[3] * x39; a0 -= L58_10[0] * x40; a1 -= L58_10[1] * x41; a2 -= L58_10[2] * x42; a3 -= L58_10[3] * x43; a0 -= L58_11[0] * x44; a1 -= L58_11[1] * x45; a2 -= L58_11[2] * x46; a3 -= L58_11[3] * x47; a0 -= L58_12[0] * x48; a1 -= L58_12[1] * x49; a2 -= L58_12[2] * x50; a3 -= L58_12[3] * x51; a0 -= L58_13[0] * x52; a1 -= L58_13[1] * x53; a2 -= L58_13[2] * x54; a3 -= L58_13[3] * x55; a0 -= L58_14[0] * x56; a1 -= L58_14[1] * x57; x58 = (a0 + a1) + (a2 + a3); }
        asm volatile("" ::: "memory");
        const float rr60 = X[60 * XS] * scp[60]; const f32x4 L60_0 = *(const LAS f32x4*)(LmV + 60 * LS + 0); const f32x4 L60_1 = *(const LAS f32x4*)(LmV + 60 * LS + 4); const f32x4 L59_2 = *(const LAS f32x4*)(LmV + 59 * LS + 8); const f32x4 L59_3 = *(const LAS f32x4*)(LmV + 59 * LS + 12); const f32x4 L59_4 = *(const LAS f32x4*)(LmV + 59 * LS + 16); const f32x4 L59_5 = *(const LAS f32x4*)(LmV + 59 * LS + 20); const f32x4 L59_6 = *(const LAS f32x4*)(LmV + 59 * LS + 24); const f32x4 L59_7 = *(const LAS f32x4*)(LmV + 59 * LS + 28); const f32x4 L59_8 = *(const LAS f32x4*)(LmV + 59 * LS + 32); const f32x4 L59_9 = *(const LAS f32x4*)(LmV + 59 * LS + 36); const f32x4 L59_10 = *(const LAS f32x4*)(LmV + 59 * LS + 40); const f32x4 L59_11 = *(const LAS f32x4*)(LmV + 59 * LS + 44); const f32x4 L59_12 = *(const LAS f32x4*)(LmV + 59 * LS + 48); const f32x4 L59_13 = *(const LAS f32x4*)(LmV + 59 * LS + 52); const f32x4 L59_14 = *(const LAS f32x4*)(LmV + 59 * LS + 56);
        float x59; { float a0 = rr59, a1 = 0.f, a2 = 0.f, a3 = 0.f; a0 -= L59_0[0] * x0; a1 -= L59_0[1] * x1; a2 -= L59_0[2] * x2; a3 -= L59_0[3] * x3; a0 -= L59_1[0] * x4; a1 -= L59_1[1] * x5; a2 -= L59_1[2] * x6; a3 -= L59_1[3] * x7; a0 -= L59_2[0] * x8; a1 -= L59_2[1] * x9; a2 -= L59_2[2] * x10; a3 -= L59_2[3] * x11; a0 -= L59_3[0] * x12; a1 -= L59_3[1] * x13; a2 -= L59_3[2] * x14; a3 -= L59_3[3] * x15; a0 -= L59_4[0] * x16; a1 -= L59_4[1] * x17; a2 -= L59_4[2] * x18; a3 -= L59_4[3] * x19; a0 -= L59_5[0] * x20; a1 -= L59_5[1] * x21; a2 -= L59_5[2] * x22; a3 -= L59_5[3] * x23; a0 -= L59_6[0] * x24; a1 -= L59_6[1] * x25; a2 -= L59_6[2] * x26; a3 -= L59_6[3] * x27; a0 -= L59_7[0] * x28; a1 -= L59_7[1] * x29; a2 -= L59_7[2] * x30; a3 -= L59_7[3] * x31; a0 -= L59_8[0] * x32; a1 -= L59_8[1] * x33; a2 -= L59_8[2] * x34; a3 -= L59_8[3] * x35; a0 -= L59_9[0] * x36; a1 -= L59_9[1] * x37; a2 -= L59_9[2] * x38; a3 -= L59_9[3] * x39; a0 -= L59_10[0] * x40; a1 -= L59_10[1] * x41; a2 -= L59_10[2] * x42; a3 -= L59_10[3] * x43; a0 -= L59_11[0] * x44; a1 -= L59_11[1] * x45; a2 -= L59_11[2] * x46; a3 -= L59_11[3] * x47; a0 -= L59_12[0] * x48; a1 -= L59_12[1] * x49; a2 -= L59_12[2] * x50; a3 -= L59_12[3] * x51; a0 -= L59_13[0] * x52; a1 -= L59_13[1] * x53; a2 -= L59_13[2] * x54; a3 -= L59_13[3] * x55; a0 -= L59_14[0] * x56; a1 -= L59_14[1] * x57; a2 -= L59_14[2] * x58; x59 = (a0 + a1) + (a2 + a3); }
        asm volatile("" ::: "memory");
        const float rr61 = X[61 * XS] * scp[61]; const f32x4 L61_0 = *(const LAS f32x4*)(LmV + 61 * LS + 0); const f32x4 L61_1 = *(const LAS f32x4*)(LmV + 61 * LS + 4); const f32x4 L60_2 = *(const LAS f32x4*)(LmV + 60 * LS + 8); const f32x4 L60_3 = *(const LAS f32x4*)(LmV + 60 * LS + 12); const f32x4 L60_4 = *(const LAS f32x4*)(LmV + 60 * LS + 16); const f32x4 L60_5 = *(const LAS f32x4*)(LmV + 60 * LS + 20); const f32x4 L60_6 = *(const LAS f32x4*)(LmV + 60 * LS + 24); const f32x4 L60_7 = *(const LAS f32x4*)(LmV + 60 * LS + 28); const f32x4 L60_8 = *(const LAS f32x4*)(LmV + 60 * LS + 32); const f32x4 L60_9 = *(const LAS f32x4*)(LmV + 60 * LS + 36); const f32x4 L60_10 = *(const LAS f32x4*)(LmV + 60 * LS + 40); const f32x4 L60_11 = *(const LAS f32x4*)(LmV + 60 * LS + 44); const f32x4 L60_12 = *(const LAS f32x4*)(LmV + 60 * LS + 48); const f32x4 L60_13 = *(const LAS f32x4*)(LmV + 60 * LS + 52); const f32x4 L60_14 = *(const LAS f32x4*)(LmV + 60 * LS + 56);
        float x60; { float a0 = rr60, a1 = 0.f, a2 = 0.f, a3 = 0.f; a0 -= L60_0[0] * x0; a1 -= L60_0[1] * x1; a2 -= L60_0[2] * x2; a3 -= L60_0[3] * x3; a0 -= L60_1[0] * x4; a1 -= L60_1[1] * x5; a2 -= L60_1[2] * x6; a3 -= L60_1[3] * x7; a0 -= L60_2[0] * x8; a1 -= L60_2[1] * x9; a2 -= L60_2[2] * x10; a3 -= L60_2[3] * x11; a0 -= L60_3[0] * x12; a1 -= L60_3[1] * x13; a2 -= L60_3[2] * x14; a3 -= L60_3[3] * x15; a0 -= L60_4[0] * x16; a1 -= L60_4[1] * x17; a2 -= L60_4[2] * x18; a3 -= L60_4[3] * x19; a0 -= L60_5[0] * x20; a1 -= L60_5[1] * x21; a2 -= L60_5[2] * x22; a3 -= L60_5[3] * x23; a0 -= L60_6[0] * x24; a1 -= L60_6[1] * x25; a2 -= L60_6[2] * x26; a3 -= L60_6[3] * x27; a0 -= L60_7[0] * x28; a1 -= L60_7[1] * x29; a2 -= L60_7[2] * x30; a3 -= L60_7[3] * x31; a0 -= L60_8[0] * x32; a1 -= L60_8[1] * x33; a2 -= L60_8[2] * x34; a3 -= L60_8[3] * x35; a0 -= L60_9[0] * x36; a1 -= L60_9[1] * x37; a2 -= L60_9[2] * x38; a3 -= L60_9[3] * x39; a0 -= L60_10[0] * x40; a1 -= L60_10[1] * x41; a2 -= L60_10[2] * x42; a3 -= L60_10[3] * x43; a0 -= L60_11[0] * x44; a1 -= L60_11[1] * x45; a2 -= L60_11[2] * x46; a3 -= L60_11[3] * x47; a0 -= L60_12[0] * x48; a1 -= L60_12[1] * x49; a2 -= L60_12[2] * x50; a3 -= L60_12[3] * x51; a0 -= L60_13[0] * x52; a1 -= L60_13[1] * x53; a2 -= L60_13[2] * x54; a3 -= L60_13[3] * x55; a0 -= L60_14[0] * x56; a1 -= L60_14[1] * x57; a2 -= L60_14[2] * x58; a3 -= L60_14[3] * x59; x60 = (a0 + a1) + (a2 + a3); }
        asm volatile("" ::: "memory");
        const float rr62 = X[62 * XS] * scp[62]; const f32x4 L62_0 = *(const LAS f32x4*)(LmV + 62 * LS + 0); const f32x4 L62_1 = *(const LAS f32x4*)(LmV + 62 * LS + 4); const f32x4 L61_2 = *(const LAS f32x4*)(LmV + 61 * LS + 8); const f32x4 L61_3 = *(const LAS f32x4*)(LmV + 61 * LS + 12); const f32x4 L61_4 = *(const LAS f32x4*)(LmV + 61 * LS + 16); const f32x4 L61_5 = *(const LAS f32x4*)(LmV + 61 * LS + 20); const f32x4 L61_6 = *(const LAS f32x4*)(LmV + 61 * LS + 24); const f32x4 L61_7 = *(const LAS f32x4*)(LmV + 61 * LS + 28); const f32x4 L61_8 = *(const LAS f32x4*)(LmV + 61 * LS + 32); const f32x4 L61_9 = *(const LAS f32x4*)(LmV + 61 * LS + 36); const f32x4 L61_10 = *(const LAS f32x4*)(LmV + 61 * LS + 40); const f32x4 L61_11 = *(const LAS f32x4*)(LmV + 61 * LS + 44); const f32x4 L61_12 = *(const LAS f32x4*)(LmV + 61 * LS + 48); const f32x4 L61_13 = *(const LAS f32x4*)(LmV + 61 * LS + 52); const f32x4 L61_14 = *(const LAS f32x4*)(LmV + 61 * LS + 56); const f32x4 L61_15 = *(const LAS f32x4*)(LmV + 61 * LS + 60);
        float x61; { float a0 = rr61, a1 = 0.f, a2 = 0.f, a3 = 0.f; a0 -= L61_0[0] * x0; a1 -= L61_0[1] * x1; a2 -= L61_0[2] * x2; a3 -= L61_0[3] * x3; a0 -= L61_1[0] * x4; a1 -= L61_1[1] * x5; a2 -= L61_1[2] * x6; a3 -= L61_1[3] * x7; a0 -= L61_2[0] * x8; a1 -= L61_2[1] * x9; a2 -= L61_2[2] * x10; a3 -= L61_2[3] * x11; a0 -= L61_3[0] * x12; a1 -= L61_3[1] * x13; a2 -= L61_3[2] * x14; a3 -= L61_3[3] * x15; a0 -= L61_4[0] * x16; a1 -= L61_4[1] * x17; a2 -= L61_4[2] * x18; a3 -= L61_4[3] * x19; a0 -= L61_5[0] * x20; a1 -= L61_5[1] * x21; a2 -= L61_5[2] * x22; a3 -= L61_5[3] * x23; a0 -= L61_6[0] * x24; a1 -= L61_6[1] * x25; a2 -= L61_6[2] * x26; a3 -= L61_6[3] * x27; a0 -= L61_7[0] * x28; a1 -= L61_7[1] * x29; a2 -= L61_7[2] * x30; a3 -= L61_7[3] * x31; a0 -= L61_8[0] * x32; a1 -= L61_8[1] * x33; a2 -= L61_8[2] * x34; a3 -= L61_8[3] * x35; a0 -= L61_9[0] * x36; a1 -= L61_9[1] * x37; a2 -= L61_9[2] * x38; a3 -= L61_9[3] * x39; a0 -= L61_10[0] * x40; a1 -= L61_10[1] * x41; a2 -= L61_10[2] * x42; a3 -= L61_10[3] * x43; a0 -= L61_11[0] * x44; a1 -= L61_11[1] * x45; a2 -= L61_11[2] * x46; a3 -= L61_11[3] * x47; a0 -= L61_12[0] * x48; a1 -= L61_12[1] * x49; a2 -= L61_12[2] * x50; a3 -= L61_12[3] * x51; a0 -= L61_13[0] * x52; a1 -= L61_13[1] * x53; a2 -= L61_13[2] * x54; a3 -= L61_13[3] * x55; a0 -= L61_14[0] * x56; a1 -= L61_14[1] * x57; a2 -= L61_14[2] * x58; a3 -= L61_14[3] * x59; a0 -= L61_15[0] * x60; x61 = (a0 + a1) + (a2 + a3); }
        asm volatile("" ::: "memory");
        const float rr63 = X[63 * XS] * scp[63]; const f32x4 L63_0 = *(const LAS f32x4*)(LmV + 63 * LS + 0); const f32x4 L63_1 = *(const LAS f32x4*)(LmV + 63 * LS + 4); const f32x4 L62_2 = *(const LAS f32x4*)(LmV + 62 * LS + 8); const f32x4 L62_3 = *(const LAS f32x4*)(LmV + 62 * LS + 12); const f32x4 L62_4 = *(const LAS f32x4*)(LmV + 62 * LS + 16); const f32x4 L62_5 = *(const LAS f32x4*)(LmV + 62 * LS + 20); const f32x4 L62_6 = *(const LAS f32x4*)(LmV + 62 * LS + 24); const f32x4 L62_7 = *(const LAS f32x4*)(LmV + 62 * LS + 28); const f32x4 L62_8 = *(const LAS f32x4*)(LmV + 62 * LS + 32); const f32x4 L62_9 = *(const LAS f32x4*)(LmV + 62 * LS + 36); const f32x4 L62_10 = *(const LAS f32x4*)(LmV + 62 * LS + 40); const f32x4 L62_11 = *(const LAS f32x4*)(LmV + 62 * LS + 44); const f32x4 L62_12 = *(const LAS f32x4*)(LmV + 62 * LS + 48); const f32x4 L62_13 = *(const LAS f32x4*)(LmV + 62 * LS + 52); const f32x4 L62_14 = *(const LAS f32x4*)(LmV + 62 * LS + 56); const f32x4 L62_15 = *(const LAS f32x4*)(LmV + 62 * LS + 60);
        float x62; { float a0 = rr62, a1 = 0.f, a2 = 0.f, a3 = 0.f; a0 -= L62_0[0] * x0; a1 -= L62_0[1] * x1; a2 -= L62_0[2] * x2; a3 -= L62_0[3] * x3; a0 -= L62_1[0] * x4; a1 -= L62_1[1] * x5; a2 -= L62_1[2] * x6; a3 -= L62_1[3] * x7; a0 -= L62_2[0] * x8; a1 -= L62_2[1] * x9; a2 -= L62_2[2] * x10; a3 -= L62_2[3] * x11; a0 -= L62_3[0] * x12; a1 -= L62_3[1] * x13; a2 -= L62_3[2] * x14; a3 -= L62_3[3] * x15; a0 -= L62_4[0] * x16; a1 -= L62_4[1] * x17; a2 -= L62_4[2] * x18; a3 -= L62_4[3] * x19; a0 -= L62_5[0] * x20; a1 -= L62_5[1] * x21; a2 -= L62_5[2] * x22; a3 -= L62_5[3] * x23; a0 -= L62_6[0] * x24; a1 -= L62_6[1] * x25; a2 -= L62_6[2] * x26; a3 -= L62_6[3] * x27; a0 -= L62_7[0] * x28; a1 -= L62_7[1] * x29; a2 -= L62_7[2] * x30; a3 -= L62_7[3] * x31; a0 -= L62_8[0] * x32; a1 -= L62_8[1] * x33; a2 -= L62_8[2] * x34; a3 -= L62_8[3] * x35; a0 -= L62_9[0] * x36; a1 -= L62_9[1] * x37; a2 -= L62_9[2] * x38; a3 -= L62_9[3] * x39; a0 -= L62_10[0] * x40; a1 -= L62_10[1] * x41; a2 -= L62_10[2] * x42; a3 -= L62_10[3] * x43; a0 -= L62_11[0] * x44; a1 -= L62_11[1] * x45; a2 -= L62_11[2] * x46; a3 -= L62_11[3] * x47; a0 -= L62_12[0] * x48; a1 -= L62_12[1] * x49; a2 -= L62_12[2] * x50; a3 -= L62_12[3] * x51; a0 -= L62_13[0] * x52; a1 -= L62_13[1] * x53; a2 -= L62_13[2] * x54; a3 -= L62_13[3] * x55; a0 -= L62_14[0] * x56; a1 -= L62_14[1] * x57; a2 -= L62_14[2] * x58; a3 -= L62_14[3] * x59; a0 -= L62_15[0] * x60; a1 -= L62_15[1] * x61; x62 = (a0 + a1) + (a2 + a3); }
        asm volatile("" ::: "memory");
 const f32x4 L63_2 = *(const LAS f32x4*)(LmV + 63 * LS + 8); const f32x4 L63_3 = *(const LAS f32x4*)(LmV + 63 * LS + 12); const f32x4 L63_4 = *(const LAS f32x4*)(LmV + 63 * LS + 16); const f32x4 L63_5 = *(const LAS f32x4*)(LmV + 63 * LS + 20); const f32x4 L63_6 = *(const LAS f32x4*)(LmV + 63 * LS + 24); const f32x4 L63_7 = *(const LAS f32x4*)(LmV + 63 * LS + 28); const f32x4 L63_8 = *(const LAS f32x4*)(LmV + 63 * LS + 32); const f32x4 L63_9 = *(const LAS f32x4*)(LmV + 63 * LS + 36); const f32x4 L63_10 = *(const LAS f32x4*)(LmV + 63 * LS + 40); const f32x4 L63_11 = *(const LAS f32x4*)(LmV + 63 * LS + 44); const f32x4 L63_12 = *(const LAS f32x4*)(LmV + 63 * LS + 48); const f32x4 L63_13 = *(const LAS f32x4*)(LmV + 63 * LS + 52); const f32x4 L63_14 = *(const LAS f32x4*)(LmV + 63 * LS + 56); const f32x4 L63_15 = *(const LAS f32x4*)(LmV + 63 * LS + 60);
        float x63; { float a0 = rr63, a1 = 0.f, a2 = 0.f, a3 = 0.f; a0 -= L63_0[0] * x0; a1 -= L63_0[1] * x1; a2 -= L63_0[2] * x2; a3 -= L63_0[3] * x3; a0 -= L63_1[0] * x4; a1 -= L63_1[1] * x5; a2 -= L63_1[2] * x6; a3 -= L63_1[3] * x7; a0 -= L63_2[0] * x8; a1 -= L63_2[1] * x9; a2 -= L63_2[2] * x10; a3 -= L63_2[3] * x11; a0 -= L63_3[0] * x12; a1 -= L63_3[1] * x13; a2 -= L63_3[2] * x14; a3 -= L63_3[3] * x15; a0 -= L63_4[0] * x16; a1 -= L63_4[1] * x17; a2 -= L63_4[2] * x18; a3 -= L63_4[3] * x19; a0 -= L63_5[0] * x20; a1 -= L63_5[1] * x21; a2 -= L63_5[2] * x22; a3 -= L63_5[3] * x23; a0 -= L63_6[0] * x24; a1 -= L63_6[1] * x25; a2 -= L63_6[2] * x26; a3 -= L63_6[3] * x27; a0 -= L63_7[0] * x28; a1 -= L63_7[1] * x29; a2 -= L63_7[2] * x30; a3 -= L63_7[3] * x31; a0 -= L63_8[0] * x32; a1 -= L63_8[1] * x33; a2 -= L63_8[2] * x34; a3 -= L63_8[3] * x35; a0 -= L63_9[0] * x36; a1 -= L63_9[1] * x37; a2 -= L63_9[2] * x38; a3 -= L63_9[3] * x39; a0 -= L63_10[0] * x40; a1 -= L63_10[1] * x41; a2 -= L63_10[2] * x42; a3 -= L63_10[3] * x43; a0 -= L63_11[0] * x44; a1 -= L63_11[1] * x45; a2 -= L63_11[2] * x46; a3 -= L63_11[3] * x47; a0 -= L63_12[0] * x48; a1 -= L63_12[1] * x49; a2 -= L63_12[2] * x50; a3 -= L63_12[3] * x51; a0 -= L63_13[0] * x52; a1 -= L63_13[1] * x53; a2 -= L63_13[2] * x54; a3 -= L63_13[3] * x55; a0 -= L63_14[0] * x56; a1 -= L63_14[1] * x57; a2 -= L63_14[2] * x58; a3 -= L63_14[3] * x59; a0 -= L63_15[0] * x60; a1 -= L63_15[1] * x61; a2 -= L63_15[2] * x62; x63 = (a0 + a1) + (a2 + a3); }
        if (isv) {
            *(f32x4*)(UT + (size_t)c * 64 + 0) = (f32x4){x0, x1, x2, x3};
            *(f32x4*)(UT + (size_t)c * 64 + 4) = (f32x4){x4, x5, x6, x7};
            *(f32x4*)(UT + (size_t)c * 64 + 8) = (f32x4){x8, x9, x10, x11};
            *(f32x4*)(UT + (size_t)c * 64 + 12) = (f32x4){x12, x13, x14, x15};
            *(f32x4*)(UT + (size_t)c * 64 + 16) = (f32x4){x16, x17, x18, x19};
            *(f32x4*)(UT + (size_t)c * 64 + 20) = (f32x4){x20, x21, x22, x23};
            *(f32x4*)(UT + (size_t)c * 64 + 24) = (f32x4){x24, x25, x26, x27};
            *(f32x4*)(UT + (size_t)c * 64 + 28) = (f32x4){x28, x29, x30, x31};
            *(f32x4*)(UT + (size_t)c * 64 + 32) = (f32x4){x32, x33, x34, x35};
            *(f32x4*)(UT + (size_t)c * 64 + 36) = (f32x4){x36, x37, x38, x39};
            *(f32x4*)(UT + (size_t)c * 64 + 40) = (f32x4){x40, x41, x42, x43};
            *(f32x4*)(UT + (size_t)c * 64 + 44) = (f32x4){x44, x45, x46, x47};
            *(f32x4*)(UT + (size_t)c * 64 + 48) = (f32x4){x48, x49, x50, x51};
            *(f32x4*)(UT + (size_t)c * 64 + 52) = (f32x4){x52, x53, x54, x55};
            *(f32x4*)(UT + (size_t)c * 64 + 56) = (f32x4){x56, x57, x58, x59};
            *(f32x4*)(UT + (size_t)c * 64 + 60) = (f32x4){x60, x61, x62, x63};
        } else {
            WN[0 * 128 + (c - 128)] = (bf16)f2bf(-x0);
            WN[1 * 128 + (c - 128)] = (bf16)f2bf(-x1);
            WN[2 * 128 + (c - 128)] = (bf16)f2bf(-x2);
            WN[3 * 128 + (c - 128)] = (bf16)f2bf(-x3);
            WN[4 * 128 + (c - 128)] = (bf16)f2bf(-x4);
            WN[5 * 128 + (c - 128)] = (bf16)f2bf(-x5);
            WN[6 * 128 + (c - 128)] = (bf16)f2bf(-x6);
            WN[7 * 128 + (c - 128)] = (bf16)f2bf(-x7);
            WN[8 * 128 + (c - 128)] = (bf16)f2bf(-x8);
            WN[9 * 128 + (c - 128)] = (bf16)f2bf(-x9);
            WN[10 * 128 + (c - 128)] = (bf16)f2bf(-x10);
            WN[11 * 128 + (c - 128)] = (bf16)f2bf(-x11);
            WN[12 * 128 + (c - 128)] = (bf16)f2bf(-x12);
            WN[13 * 128 + (c - 128)] = (bf16)f2bf(-x13);
            WN[14 * 128 + (c - 128)] = (bf16)f2bf(-x14);
            WN[15 * 128 + (c - 128)] = (bf16)f2bf(-x15);
            WN[16 * 128 + (c - 128)] = (bf16)f2bf(-x16);
            WN[17 * 128 + (c - 128)] = (bf16)f2bf(-x17);
            WN[18 * 128 + (c - 128)] = (bf16)f2bf(-x18);
            WN[19 * 128 + (c - 128)] = (bf16)f2bf(-x19);
            WN[20 * 128 + (c - 128)] = (bf16)f2bf(-x20);
            WN[21 * 128 + (c - 128)] = (bf16)f2bf(-x21);
            WN[22 * 128 + (c - 128)] = (bf16)f2bf(-x22);
            WN[23 * 128 + (c - 128)] = (bf16)f2bf(-x23);
            WN[24 * 128 + (c - 128)] = (bf16)f2bf(-x24);
            WN[25 * 128 + (c - 128)] = (bf16)f2bf(-x25);
            WN[26 * 128 + (c - 128)] = (bf16)f2bf(-x26);
            WN[27 * 128 + (c - 128)] = (bf16)f2bf(-x27);
            WN[28 * 128 + (c - 128)] = (bf16)f2bf(-x28);
            WN[29 * 128 + (c - 128)] = (bf16)f2bf(-x29);
            WN[30 * 128 + (c - 128)] = (bf16)f2bf(-x30);
            WN[31 * 128 + (c - 128)] = (bf16)f2bf(-x31);
            WN[32 * 128 + (c - 128)] = (bf16)f2bf(-x32);
            WN[33 * 128 + (c - 128)] = (bf16)f2bf(-x33);
            WN[34 * 128 + (c - 128)] = (bf16)f2bf(-x34);
            WN[35 * 128 + (c - 128)] = (bf16)f2bf(-x35);
            WN[36 * 128 + (c - 128)] = (bf16)f2bf(-x36);
            WN[37 * 128 + (c - 128)] = (bf16)f2bf(-x37);
            WN[38 * 128 + (c - 128)] = (bf16)f2bf(-x38);
            WN[39 * 128 + (c - 128)] = (bf16)f2bf(-x39);
            WN[40 * 128 + (c - 128)] = (bf16)f2bf(-x40);
            WN[41 * 128 + (c - 128)] = (bf16)f2bf(-x41);
            WN[42 * 128 + (c - 128)] = (bf16)f2bf(-x42);
            WN[43 * 128 + (c - 128)] = (bf16)f2bf(-x43);
            WN[44 * 128 + (c - 128)] = (bf16)f2bf(-x44);
            WN[45 * 128 + (c - 128)] = (bf16)f2bf(-x45);
            WN[46 * 128 + (c - 128)] = (bf16)f2bf(-x46);
            WN[47 * 128 + (c - 128)] = (bf16)f2bf(-x47);
            WN[48 * 128 + (c - 128)] = (bf16)f2bf(-x48);
            WN[49 * 128 + (c - 128)] = (bf16)f2bf(-x49);
            WN[50 * 128 + (c - 128)] = (bf16)f2bf(-x50);
            WN[51 * 128 + (c - 128)] = (bf16)f2bf(-x51);
            WN[52 * 128 + (c - 128)] = (bf16)f2bf(-x52);
            WN[53 * 128 + (c - 128)] = (bf16)f2bf(-x53);
            WN[54 * 128 + (c - 128)] = (bf16)f2bf(-x54);
            WN[55 * 128 + (c - 128)] = (bf16)f2bf(-x55);
            WN[56 * 128 + (c - 128)] = (bf16)f2bf(-x56);
            WN[57 * 128 + (c - 128)] = (bf16)f2bf(-x57);
            WN[58 * 128 + (c - 128)] = (bf16)f2bf(-x58);
            WN[59 * 128 + (c - 128)] = (bf16)f2bf(-x59);
            WN[60 * 128 + (c - 128)] = (bf16)f2bf(-x60);
            WN[61 * 128 + (c - 128)] = (bf16)f2bf(-x61);
            WN[62 * 128 + (c - 128)] = (bf16)f2bf(-x62);
            WN[63 * 128 + (c - 128)] = (bf16)f2bf(-x63);
        }
    } else {
        const int t2 = tid - 256;
        { const int i = t2 >> 2, d0 = (t2 & 3) * 32; const float e = expf(gcs[i]);
#pragma unroll
          for (int q8 = 0; q8 < 4; ++q8) { const f32x4 a = *(const LAS f32x4*)(XQ + i * XS + d0 + 8 * q8), c = *(const LAS f32x4*)(XQ + i * XS + d0 + 8 * q8 + 4);
              v4u o; o.x = pk2(a[0] * e, a[1] * e); o.y = pk2(a[2] * e, a[3] * e); o.z = pk2(c[0] * e, c[1] * e); o.w = pk2(c[2] * e, c[3] * e);
              *(v4u*)(QG + (size_t)i * 128 + d0 + 8 * q8) = o; } }
        { const int d = t2 >> 1, i0 = (t2 & 1) * 32; const float gl = gcs[63];
#pragma unroll
          for (int q8 = 0; q8 < 4; ++q8) { float v[8];
#pragma unroll
              for (int e = 0; e < 8; ++e) { const int i = i0 + 8 * q8 + e; v[e] = XK[i * XS + d] * expf(gl - gcs[i]); }
              v4u o; o.x = pk2(v[0], v[1]); o.y = pk2(v[2], v[3]); o.z = pk2(v[4], v[5]); o.w = pk2(v[6], v[7]);
              *(v4u*)(KGT + (size_t)d * 64 + i0 + 8 * q8) = o; } }
        if (t2 == 0) GL[unit] = expf(gcs[63]);
    }
    __syncthreads();
}

__device__ __forceinline__ int sw256(int row, int ch) { return row * 256 + ((ch ^ (row & 15)) << 4); }
__device__ __forceinline__ int sw128(int row, int ch) { return row * 128 + ((ch ^ ((row >> 1) & 7)) << 4); }
__device__ __forceinline__ void gdnb_unit(const Params& P, LAS unsigned char* lds, int bh) {
    typedef float f32x4_ __attribute__((ext_vector_type(4)));
    const int tid = threadIdx.x, wid = __builtin_amdgcn_readfirstlane(tid >> 6), lane = tid & 63, fr = lane & 15, fq = lane >> 4;
    const int b = bh >> 2, h = bh & 3;
    const float* w_gnorm = P.in[14];
    const bf16* ZB = (const bf16*)(P.ws + WS_ZB); bf16* MIX = (bf16*)(P.ws + WS_MIX);
    LAS unsigned char* Wl = lds;
    LAS unsigned char* Ql = lds + 16384;
    LAS unsigned char* Kl = lds + 32768;
    LAS unsigned char* Ml = lds + 49152;
    LAS unsigned char* STl = lds + 57344;
    LAS unsigned char* VTl = lds + 90112;
    LAS float* red = (LAS float*)(lds + 106496);
    f32x4_ S[8];
#pragma unroll
    for (int i = 0; i < 8; ++i) S[i] = (f32x4_){0.f, 0.f, 0.f, 0.f};
    const int e = 16 * wid + fr;
    {
#pragma unroll
        for (int db = 0; db < 8; ++db) *(LAS v2u*)(STl + sw256(e, (16 * db + 4 * fq) >> 3) + ((4 * fq) & 7) * 2) = (v2u){0u, 0u};
    }
    const float gn = w_gnorm[e];
    for (int n = 0; n < NCHUNK; ++n) {
        const int unit = bh * 32 + n;
        const bf16* WN = (const bf16*)(P.ws + WS_WN) + (size_t)unit * 8192; const bf16* QG = (const bf16*)(P.ws + WS_QG) + (size_t)unit * 8192;
        const bf16* KGT = (const bf16*)(P.ws + WS_KGT) + (size_t)unit * 8192; const bf16* QKM = (const bf16*)(P.ws + WS_QKM) + (size_t)unit * 4096;
        const float* UT = (const float*)(P.ws + WS_UT) + (size_t)unit * 8192;
        const float gl = ((const float*)(P.ws + WS_GL))[unit];
#pragma unroll
        for (int i = 0; i < 2; ++i) { const int idx = tid + 512 * i; const int r = idx >> 4, ch = idx & 15;
            *(LAS v4u*)(Wl + sw256(r, ch)) = *(const v4u*)(WN + (size_t)idx * 8); *(LAS v4u*)(Ql + sw256(r, ch)) = *(const v4u*)(QG + (size_t)idx * 8); }
#pragma unroll
        for (int i = 0; i < 2; ++i) { const int idx = tid + 512 * i; const int r = idx >> 3, ch = idx & 7; *(LAS v4u*)(Kl + sw128(r, ch)) = *(const v4u*)(KGT + (size_t)idx * 8); }
        { const int idx = tid; const int r = idx >> 3, ch = idx & 7; *(LAS v4u*)(Ml + sw128(r, ch)) = *(const v4u*)(QKM + (size_t)idx * 8); }
        __syncthreads();
        bf16x8 sb[4];
#pragma unroll
        for (int ks = 0; ks < 4; ++ks) sb[ks] = *(const LAS bf16x8*)(STl + sw256(e, 4 * ks + fq));
        f32x4_ vn[4];
#pragma unroll
        for (int rb = 0; rb < 4; ++rb) {
            vn[rb] = *(const f32x4_*)(UT + (size_t)e * 64 + 16 * rb + 4 * fq);
#pragma unroll
            for (int ks = 0; ks < 4; ++ks) { const bf16x8 a = *(const LAS bf16x8*)(Wl + sw256(16 * rb + fr, 4 * ks + fq)); vn[rb] = __builtin_amdgcn_mfma_f32_16x16x32_bf16(a, sb[ks], vn[rb], 0, 0, 0); }
            v2u o; o.x = pk2(vn[rb][0], vn[rb][1]); o.y = pk2(vn[rb][2], vn[rb][3]);
            *(LAS v2u*)(VTl + sw128(e, (16 * rb + 4 * fq) >> 3) + ((4 * fq) & 7) * 2) = o;
        }
        bf16x8 vb[2];
#pragma unroll
        for (int ks = 0; ks < 2; ++ks) vb[ks] = *(const LAS bf16x8*)(VTl + sw128(e, 4 * ks + fq));
        f32x4_ oo[4];
#pragma unroll
        for (int rb = 0; rb < 4; ++rb) {
            oo[rb] = (f32x4_){0.f, 0.f, 0.f, 0.f};
#pragma unroll
            for (int ks = 0; ks < 4; ++ks) { const bf16x8 a = *(const LAS bf16x8*)(Ql + sw256(16 * rb + fr, 4 * ks + fq)); oo[rb] = __builtin_amdgcn_mfma_f32_16x16x32_bf16(a, sb[ks], oo[rb], 0, 0, 0); }
#pragma unroll
            for (int ks = 0; ks < 2; ++ks) { const bf16x8 a = *(const LAS bf16x8*)(Ml + sw128(16 * rb + fr, 4 * ks + fq)); oo[rb] = __builtin_amdgcn_mfma_f32_16x16x32_bf16(a, vb[ks], oo[rb], 0, 0, 0); }
        }
#pragma unroll
        for (int db = 0; db < 8; ++db) {
            S[db] = S[db] * gl;
#pragma unroll
            for (int ks = 0; ks < 2; ++ks) { const bf16x8 a = *(const LAS bf16x8*)(Kl + sw128(16 * db + fr, 4 * ks + fq)); S[db] = __builtin_amdgcn_mfma_f32_16x16x32_bf16(a, vb[ks], S[db], 0, 0, 0); }
            v2u o; o.x = pk2(S[db][0], S[db][1]); o.y = pk2(S[db][2], S[db][3]);
            *(LAS v2u*)(STl + sw256(e, (16 * db + 4 * fq) >> 3) + ((4 * fq) & 7) * 2) = o;
        }
#pragma unroll
        for (int rb = 0; rb < 4; ++rb)
#pragma unroll
            for (int j = 0; j < 4; ++j) { float s = oo[rb][j] * oo[rb][j];
                s += __shfl_xor(s, 1); s += __shfl_xor(s, 2); s += __shfl_xor(s, 4); s += __shfl_xor(s, 8);
                if (fr == 0) red[(16 * rb + 4 * fq + j) * 8 + wid] = s; }
        __syncthreads();
#pragma unroll
        for (int rb = 0; rb < 4; ++rb)
#pragma unroll
            for (int j = 0; j < 4; ++j) { const int c = 16 * rb + 4 * fq + j;
                const f32x4_ r0 = *(const LAS f32x4_*)(red + c * 8), r1 = *(const LAS f32x4_*)(red + c * 8 + 4);
                const float ss = ((r0[0] + r0[1]) + (r0[2] + r0[3])) + ((r1[0] + r1[1]) + (r1[2] + r1[3]));
                const float rstd = 1.0f / sqrtf(ss * (1.0f / 128.0f) + RMS_EPS);
                const size_t m = (size_t)b * SEQ + n * GCH + c;
                const float z = bf2f(ZB[m * 512 + h * 128 + e]);
                MIX[m * DM + 512 + h * 128 + e] = (bf16)f2bf(oo[rb][j] * rstd * gn * silu_f(z)); }
        __syncthreads();
    }
    float* So = P.out + OSSM_P + (size_t)bh * 16384;
#pragma unroll
    for (int db = 0; db < 8; ++db)
#pragma unroll
        for (int j = 0; j < 4; ++j) So[(size_t)(16 * db + 4 * fq + j) * 128 + e] = S[db][j];
}


__device__ __forceinline__ void phase_final(const Params& P, const Ctx& C) {
    const float* ln_f = P.in[19]; const float* SSQ2 = (const float*)(P.ws + WS_SSQ2);
    const int gw = C.vcu * NWAVES + C.wave, NGW = C.G * NWAVES, lane = C.lane;
    f32x4 lw[4];
#pragma unroll
    for (int j = 0; j < 4; ++j) lw[j] = ((const f32x4*)ln_f)[lane + 64 * j];
    for (int m = gw; m < M_TOT; m += NGW) {
        const f32x4* sp = (const f32x4*)(SSQ2 + (size_t)m * 16);
        const f32x4 a = sp[0], b = sp[1], c = sp[2], d = sp[3];
        const float ss = ((a[0] + a[1]) + (a[2] + a[3])) + ((b[0] + b[1]) + (b[2] + b[3])) + ((c[0] + c[1]) + (c[2] + c[3])) + ((d[0] + d[1]) + (d[2] + d[3]));
        const float rstd = 1.0f / sqrtf(ss * (1.0f / DM) + RMS_EPS);
        float* yr = m < MP ? P.out + OY_P + (size_t)m * DM : P.out + OY_S + (size_t)(m - MP) * DM;
#pragma unroll
        for (int j = 0; j < 4; ++j) { f32x4 v = ((const f32x4*)yr)[lane + 64 * j]; v = v * rstd * lw[j]; ((f32x4*)yr)[lane + 64 * j] = v; }
    }
}

constexpr int NPHASES = 8;
__global__ void __launch_bounds__(NWAVES * 64, 2) fwd_kernel(Params P) {
    extern __shared__ __attribute__((aligned(16))) unsigned char shm[];
    LAS unsigned char* lds = (LAS unsigned char*)shm;
    Ctx C; C.tid = threadIdx.x; C.lane = C.tid & 63; C.wave = __builtin_amdgcn_readfirstlane(C.tid >> 6);
    C.G = gridDim.x; { const int bx = blockIdx.x; C.vcu = (C.G % 8 == 0) ? (bx % 8) * (C.G / 8) + bx / 8 : bx; }
    volatile LAS unsigned* MISC = (volatile LAS unsigned*)(lds + MISC_OFF);
    if (C.tid < 64) MISC[C.tid] = 0u;
    __syncthreads();
    unsigned* ctl = (unsigned*)(P.ws + WS_CTL);
    const int lo = P.ph_lo, hi = P.ph_hi;
    XcdBarrier bar; bar.bar = ctl + CW_BAR; bar.x = 0; bar.st = nullptr;
    if (hi - lo > 1) bar = xcd_barrier_post(ctl + CW_BAR, MISC + 8);
#ifndef SUBMASK
#define SUBMASK 15
#endif
#ifndef PHASE_MASK
#define PHASE_MASK 0xff
#endif
#define IN(k) (((PHASE_MASK >> (k)) & 1) && lo <= (k) && (k) < hi)
#define SEAM(k) do { if (IN(k) && IN((k) + 1)) xcd_barrier(bar); } while (0)
    unsigned char* ws = P.ws;

    if (IN(0)) { phase_prep(P, C, lds); SEAM(0); }

    if (IN(1)) {
        if (C.wave == 0) for (int bh = C.vcu; bh < NB * NH; bh += C.G) kbias_seq(P, bh, C.lane);
        pg8::Gemm g{(const pg8::bf16_t*)(ws + WS_XN), (const pg8::bf16_t*)(ws + WS_W1T), M_PAD, N1, DM};
        pg8::StaticOrder S; S.init(M_PAD, N1, C.G, (int)blockIdx.x);
        pg8::EpiIn E{(pg8::bf16_t*)(ws + WS_QB), (float*)(ws + WS_QS), (pg8::bf16_t*)(ws + WS_CB), (pg8::bf16_t*)(ws + WS_ZB), P.out};
        pg8::gemm_phase<pg8::EpiIn, pg8::StaticOrder, true, true>(lds, g, S, E);
        SEAM(1);
    }

    if (IN(2)) {
        for (int it = C.vcu; it < 256; it += C.G) {
            const int xg = it >> 5, slot = it & 31, idx = slot >> 1;
            if ((slot & 1) == 0) {
                const int bh = xg * 4 + (idx >> 2), x = idx & 3, b = bh >> 2, h = bh & 3;
                const bf16* Qh = (const bf16*)(ws + WS_QB) + (size_t)bh * SEQ * HD; const bf16* Kh = (const bf16*)(ws + WS_KB) + (size_t)bh * SEQ * HD; const bf16* Vh = (const bf16*)(ws + WS_VB) + (size_t)bh * SEQ * HD;
                const float* kbias = (const float*)(ws + WS_KBIAS) + (size_t)bh * SEQ;
                bf16* Orow0 = (bf16*)(ws + WS_MIX) + (size_t)b * SEQ * DM + h * HD;
#if SUBMASK & 1
                fox::fox_block((char*)shm, Qh, Kh, Vh, kbias, Orow0, 7 - x);
                fox::fox_block((char*)shm, Qh, Kh, Vh, kbias, Orow0, x);
#endif
            } else {
                const int db = xg * 16 + idx;
#if SUBMASK & 2
                decode_unit(P, lds, db);
#endif
#if SUBMASK & 4
                for (int h = 0; h < NH; ++h) sgdn_unit(P, lds, db, h);
#endif
            }
        }
#if SUBMASK & 8
        for (int u = C.vcu; u < NB * NH * NCHUNK; u += C.G) gdna_unit(P, lds, u);
#endif
        SEAM(2);
    }

    if (IN(3)) {
        for (int bh = blockIdx.x; bh < NB * NH; bh += C.G) gdnb_unit(P, lds, bh);
        SEAM(3);
    }

    if (IN(4)) {
        pg8::Gemm g{(const pg8::bf16_t*)(ws + WS_MIX), (const pg8::bf16_t*)(ws + WS_WOT), M_PAD, DM, DM};
        pg8::StaticOrder S; S.init(M_PAD, DM, C.G, (int)blockIdx.x);
        pg8::EpiRes E{P.in[0], P.in[1], P.out, (pg8::bf16_t*)(ws + WS_HB), (float*)(ws + WS_SSQ)};
        pg8::gemm_phase<pg8::EpiRes, pg8::StaticOrder, true, true>(lds, g, S, E);
        SEAM(4);
    }

    if (IN(5)) {
        pg8::Gemm g{(const pg8::bf16_t*)(ws + WS_HB), (const pg8::bf16_t*)(ws + WS_WUPT), M_PAD, FF, DM};
        pg8::StaticOrder S; S.init(M_PAD, FF, C.G, (int)blockIdx.x);
        pg8::EpiUp E{(pg8::bf16_t*)(ws + WS_UB), (const float*)(ws + WS_SSQ)};
        pg8::gemm_phase<pg8::EpiUp, pg8::StaticOrder, true, true>(lds, g, S, E);
        SEAM(5);
    }

    if (IN(6)) {
        pg8::Gemm g{(const pg8::bf16_t*)(ws + WS_UB), (const pg8::bf16_t*)(ws + WS_WDNT), M_PAD, DM, FF};
        pg8::StaticOrder S; S.init(M_PAD, DM, C.G, (int)blockIdx.x);
        pg8::EpiDown E{P.out, (float*)(ws + WS_SSQ2)};
        pg8::gemm_phase<pg8::EpiDown, pg8::StaticOrder, true, true>(lds, g, S, E);
        SEAM(6);
    }

    if (IN(7)) phase_final(P, C);
#undef IN
#undef SEAM
}

#ifndef N_LAUNCH_MODE
#define N_LAUNCH_MODE 8
#endif
extern "C" void kernel_launch(void* const* d_in, const int* in_sizes, int n_in, void* d_out, int out_size, void* d_ws, size_t ws_size, hipStream_t stream) {
    static int grid = 0;
    if (grid == 0) {
        if (n_in != 20 || out_size != (int)OUT_TOTAL || ws_size < WS_END) { fprintf(stderr, "kernel_launch: unexpected shapes (n_in %d, out %d, ws %zu); nothing launched\n", n_in, out_size, ws_size); grid = -1; return; }
        int dev = 0, cus = 0, per_cu = 0;
        if (hipGetDevice(&dev) != hipSuccess || hipDeviceGetAttribute(&cus, hipDeviceAttributeMultiprocessorCount, dev) != hipSuccess) { grid = -1; return; }
        if (hipFuncSetAttribute((const void*)fwd_kernel, hipFuncAttributeMaxDynamicSharedMemorySize, LDS_BYTES) != hipSuccess) { fprintf(stderr, "kernel_launch: hipFuncSetAttribute failed\n"); grid = -1; return; }
        if (hipOccupancyMaxActiveBlocksPerMultiprocessor(&per_cu, (const void*)fwd_kernel, NWAVES * 64, LDS_BYTES) != hipSuccess || per_cu < 1)
            fprintf(stderr, "kernel_launch: note: occupancy query reports %d workgroups per CU\n", per_cu);
        (void)hipGetLastError();
        grid = cus;
    }
    if (grid < 0) return;
    if (hipMemsetAsync((char*)d_ws + WS_CTL, 0, CTL_ZERO_BYTES, stream) != hipSuccess) return;
    Params p{};
    for (int i = 0; i < 20; ++i) p.in[i] = (const float*)d_in[i];
    p.out = (float*)d_out; p.ws = (unsigned char*)d_ws;
    if (N_LAUNCH_MODE == 1) {
        p.ph_lo = 0; p.ph_hi = NPHASES;
        hipLaunchKernelGGL(fwd_kernel, dim3(grid), dim3(NWAVES * 64), LDS_BYTES, stream, p);
    } else {
        for (int k = 0; k < NPHASES; ++k) { p.ph_lo = k; p.ph_hi = k + 1; hipLaunchKernelGGL(fwd_kernel, dim3(grid), dim3(NWAVES * 64), LDS_BYTES, stream, p); }
    }
}
```

```cpp
#include <hip/hip_runtime.h>
#include <hip/hip_bf16.h>
#include <cstdio>
#include <cstdint>

constexpr int DM = 1024, NB = 8, SEQ = 2048, DECB = 128, PAST = 2048, PAGE = 128, NPAGES = 16;
constexpr int NH = 4, HD = 128, CONVD = 1536, FF = 4096, INDIM = 3596, GCH = 64, NCHUNK = SEQ / GCH;
constexpr int MP = NB * SEQ;
constexpr int M_TOT = MP + DECB;
constexpr int M_PAD = 16640;
constexpr int N1 = 3584;
constexpr float RMS_EPS = 1e-6f, L2_EPS = 1e-6f;
constexpr float ATT_SCALE = 0.08838834764831845f;
constexpr size_t OY_P = 0, OY_S = 16777216, OK_P = 16908288, OV_P = 25296896, OLF_P = 33685504, OCONV_P = 33751040, OSSM_P = 33787904,
                 OK_S = 34312192, OV_S = 34377728, OLF_S = 34443264, OCONV_S = 34443776, OSSM_S = 35033600, OUT_TOTAL = 43422208;
constexpr size_t MiB = 1u << 20;
constexpr size_t WS_CTL = 0, CTL_ZERO_BYTES = 1 * MiB;
constexpr size_t WS_W1T = 2 * MiB, WS_WOT = 10 * MiB, WS_WUPT = 12 * MiB, WS_WDNT = 21 * MiB;
constexpr size_t WS_XN = 32 * MiB, WS_QB = 68 * MiB, WS_KB = 84 * MiB, WS_VB = 100 * MiB, WS_CB = 116 * MiB, WS_ZB = 166 * MiB;
constexpr size_t WS_MIX = 184 * MiB, WS_HB = 218 * MiB, WS_UB = 252 * MiB;
constexpr size_t WS_UT = 384 * MiB, WS_WN = 416 * MiB, WS_QG = 432 * MiB, WS_KGT = 448 * MiB, WS_QKM = 464 * MiB;
constexpr size_t WS_LF = 472 * MiB, WS_BETA = 473 * MiB, WS_G = 474 * MiB, WS_KBIAS = 475 * MiB, WS_QS = 476 * MiB, WS_SSQ = 477 * MiB, WS_SSQ2 = 479 * MiB, WS_GL = 481 * MiB;
constexpr size_t WS_END = 482 * MiB;
constexpr int CW_TMO = 0, CW_BAR = 4096;
constexpr size_t QKV_STRIDE = (WS_KB - WS_QB) / 2;
static_assert(WS_VB - WS_KB == WS_KB - WS_QB, "q/k/v copies equally spaced");

namespace pg8 {
#define PG8_LAS __attribute__((address_space(3)))
typedef unsigned short bf16_t;
typedef short bf16x8 __attribute__((ext_vector_type(8)));
typedef float f32x4 __attribute__((ext_vector_type(4)));
typedef unsigned u32x4 __attribute__((ext_vector_type(4)));
constexpr int BM = 256, BK = 64, HALF = 128, HTB = HALF * BK * 2  , STAGE_BYTES = 8 * HTB, NXCD = 8, WGM = 8;

__host__ __device__ __forceinline__ int lds_byte(int r, int c) { const int st = (r >> 4) * 2 + (c >> 5), rr = r & 15, cc = c & 31, ob = rr * 64 + cc * 2; return st * 1024 + (ob ^ (((ob >> 9) & 1) << 5)); }
__host__ __device__ __forceinline__ void stage_rc(int b, int& R, int& C) { const int st = b / 1024, sb = b % 1024, swz = sb ^ (((sb >> 9) & 1) << 5); R = (st >> 1) * 16 + swz / 64; C = (st & 1) * 32 + (swz % 64) / 2; }
__host__ __device__ __forceinline__ int perm32(int rho) { const int n = rho >> 4, i = rho & 15; return 8 * (i >> 2) + 4 * n + (i & 3); }

struct Unit { int pm, pn; };
struct Gemm { const bf16_t* A; const bf16_t* Bt; int M, N, K; };

struct StaticOrder {
    int nM, nN, nwg, G, c;
    __host__ __device__ void init(int M, int N, int G_, int c_) { nM = M / BM; nN = N / BM; nwg = nM * nN; G = G_; c = c_; }
    __host__ __device__ bool next(int i, Unit& u) const {
        const long L = (long)i * G + c; if (L >= nwg) return false;
        int wgid = (int)L; { const int q = nwg / NXCD, r = nwg % NXCD, xcd = wgid % NXCD, off = wgid / NXCD; wgid = (xcd < r ? xcd * (q + 1) : r * (q + 1) + (xcd - r) * q) + off; }
        const int nig = WGM * nN, gid = wgid / nig, fm = gid * WGM, gsz = (nM - fm) < WGM ? (nM - fm) : WGM;
        u.pm = fm + ((wgid % nig) % gsz); u.pn = (wgid % nig) / gsz; return true;
    }
    __device__ __forceinline__ void a_ready(const Unit&) const {}
    __device__ __forceinline__ void done(const Unit&) const {}
};
__device__ __forceinline__ unsigned cvt_pk_bf16(float lo, float hi) { unsigned r; asm volatile("v_cvt_pk_bf16_f32 %0, %1, %2" : "=v"(r) : "v"(lo), "v"(hi)); return r; }
typedef float f32x2 __attribute__((ext_vector_type(2)));
__device__ __forceinline__ u32x4 pack8_bf16(f32x4 v0, f32x4 v1) { u32x4 w; w.x = cvt_pk_bf16(v0[0], v0[1]); w.y = cvt_pk_bf16(v0[2], v0[3]); w.z = cvt_pk_bf16(v1[0], v1[1]); w.w = cvt_pk_bf16(v1[2], v1[3]); return w; }

struct EpiIn {
    static constexpr bool PERM = true, AFTER_DRAIN = false;
    bf16_t* QB;
    float* QS;
    bf16_t* CB;
    bf16_t* ZB;
    float* out;
    __device__ __forceinline__ void operator()(const f32x4 (&acc)[2][2][4][2], const Unit& u, int wr, int wc, int fr, int fq) const {
        const int pn = u.pn;
#pragma unroll
        for (int ai = 0; ai < 2; ++ai)
#pragma unroll
            for (int m = 0; m < 4; ++m) {
                const int row = u.pm * BM + ai * HALF + wr * 64 + m * 16 + fr;
                if (row >= M_TOT) continue;
#pragma unroll
                for (int bj = 0; bj < 2; ++bj) {
                    const int col = pn * BM + bj * HALF + wc * 32 + 8 * fq;
                    const f32x4 v0 = acc[ai][bj][m][0], v1 = acc[ai][bj][m][1];
                    if (pn < 6) {
                        const int seg = pn >> 1, c = col - seg * 512, h = c >> 7, d = c & 127;
                        if (row < MP) {
                            const int b = row >> 11, t = row & 2047;
                            const size_t idx = ((size_t)((b * NH + h) * SEQ + t)) * HD + d;
                            *(u32x4*)(QB + (size_t)seg * QKV_STRIDE + idx) = pack8_bf16(v0, v1);
                            if (seg != 0) { float* o = out + OK_P + (size_t)(seg - 1) * (OV_P - OK_P) + (size_t)row * 512 + c; *(f32x4*)o = v0; *(f32x4*)(o + 4) = v1; }
                        } else {
                            const int db = row - MP;
                            if (seg == 0) { float* o = QS + (size_t)db * 512 + c; *(f32x4*)o = v0; *(f32x4*)(o + 4) = v1; }
                            else { float* o = out + OK_S + (size_t)(seg - 1) * (OV_S - OK_S) + (size_t)db * 512 + c; *(f32x4*)o = v0; *(f32x4*)(o + 4) = v1; }
                        }
                    } else if (pn < 12) {
                        const int c = col - 1536;
                        *(u32x4*)(CB + (size_t)row * CONVD + c) = pack8_bf16(v0, v1);
                        if (row < MP) {
                            const int t = row & 2047;
                            if (t >= SEQ - 3) { float* o = out + OCONV_P + ((size_t)(row >> 11) * 3 + (t - (SEQ - 3))) * CONVD + c; *(f32x4*)o = v0; *(f32x4*)(o + 4) = v1; }
                        } else {
                            float* o = out + OCONV_S + ((size_t)(row - MP) * 3 + 2) * CONVD + c; *(f32x4*)o = v0; *(f32x4*)(o + 4) = v1;
                        }
                    } else {
                        const int c = col - 3072;
                        *(u32x4*)(ZB + (size_t)row * 512 + c) = pack8_bf16(v0, v1);
                    }
                }
            }
    }
};

struct EpiRes {
    static constexpr bool PERM = true, AFTER_DRAIN = false;
    const float *xp, *xs; float* out; bf16_t* HB; float* SSQ;
    __device__ __forceinline__ void operator()(const f32x4 (&acc)[2][2][4][2], const Unit& u, int wr, int wc, int fr, int fq) const {
#pragma unroll
        for (int ai = 0; ai < 2; ++ai)
#pragma unroll
            for (int m = 0; m < 4; ++m) {
                const int row = u.pm * BM + ai * HALF + wr * 64 + m * 16 + fr;
                const bool ok = row < M_TOT;
                const float* xr = row < MP ? xp + (size_t)row * DM : xs + (size_t)(ok ? row - MP : 0) * DM;
                float* hr = row < MP ? out + OY_P + (size_t)row * DM : out + OY_S + (size_t)(ok ? row - MP : 0) * DM;
                float s = 0.f;
#pragma unroll
                for (int bj = 0; bj < 2; ++bj) {
                    const int col = u.pn * BM + bj * HALF + wc * 32 + 8 * fq;
                    if (ok) {
                        const f32x4 v0 = acc[ai][bj][m][0] + *(const f32x4*)(xr + col), v1 = acc[ai][bj][m][1] + *(const f32x4*)(xr + col + 4);
                        *(f32x4*)(hr + col) = v0; *(f32x4*)(hr + col + 4) = v1;
                        *(u32x4*)(HB + (size_t)row * DM + col) = pack8_bf16(v0, v1);
                        s += (v0[0] * v0[0] + v0[1] * v0[1]) + (v0[2] * v0[2] + v0[3] * v0[3]) + (v1[0] * v1[0] + v1[1] * v1[1]) + (v1[2] * v1[2] + v1[3] * v1[3]);
                    }
                }
                s += __shfl_xor(s, 16); s += __shfl_xor(s, 32);
                if (ok && fq == 0) SSQ[(size_t)row * 16 + u.pn * 4 + wc] = s;
            }
    }
};

struct EpiUp {
    static constexpr bool PERM = true, AFTER_DRAIN = false;
    bf16_t* UB; const float* SSQ;
    __device__ __forceinline__ void operator()(const f32x4 (&acc)[2][2][4][2], const Unit& u, int wr, int wc, int fr, int fq) const {
#pragma unroll
        for (int ai = 0; ai < 2; ++ai)
#pragma unroll
            for (int m = 0; m < 4; ++m) {
                const int row = u.pm * BM + ai * HALF + wr * 64 + m * 16 + fr;
                if (row >= M_TOT) continue;
                const f32x4* sp = (const f32x4*)(SSQ + (size_t)row * 16);
                const f32x4 a = sp[0], b = sp[1], c = sp[2], d = sp[3];
                const float ss = ((a[0] + a[1]) + (a[2] + a[3])) + ((b[0] + b[1]) + (b[2] + b[3])) + ((c[0] + c[1]) + (c[2] + c[3])) + ((d[0] + d[1]) + (d[2] + d[3]));
                const float rstd = 1.0f / sqrtf(ss * (1.0f / DM) + RMS_EPS);
#pragma unroll
                for (int bj = 0; bj < 2; ++bj) {
                    const int col = u.pn * BM + bj * HALF + wc * 32 + 8 * fq;
                    f32x4 v0 = acc[ai][bj][m][0] * rstd, v1 = acc[ai][bj][m][1] * rstd;
#pragma unroll
                    for (int j = 0; j < 4; ++j) { const float p = fmaxf(v0[j], 0.f), q = fmaxf(v1[j], 0.f); v0[j] = p * p; v1[j] = q * q; }
                    *(u32x4*)(UB + (size_t)row * FF + col) = pack8_bf16(v0, v1);
                }
            }
    }
};

struct EpiDown {
    static constexpr bool PERM = true, AFTER_DRAIN = false;
    float* out; float* SSQ2;
    __device__ __forceinline__ void operator()(const f32x4 (&acc)[2][2][4][2], const Unit& u, int wr, int wc, int fr, int fq) const {
#pragma unroll
        for (int ai = 0; ai < 2; ++ai)
#pragma unroll
            for (int m = 0; m < 4; ++m) {
                const int row = u.pm * BM + ai * HALF + wr * 64 + m * 16 + fr;
                const bool ok = row < M_TOT;
                float* hr = row < MP ? out + OY_P + (size_t)row * DM : out + OY_S + (size_t)(ok ? row - MP : 0) * DM;
                float s = 0.f;
#pragma unroll
                for (int bj = 0; bj < 2; ++bj) {
                    const int col = u.pn * BM + bj * HALF + wc * 32 + 8 * fq;
                    if (ok) {
                        const f32x4 v0 = acc[ai][bj][m][0] + *(const f32x4*)(hr + col), v1 = acc[ai][bj][m][1] + *(const f32x4*)(hr + col + 4);
                        *(f32x4*)(hr + col) = v0; *(f32x4*)(hr + col + 4) = v1;
                        s += (v0[0] * v0[0] + v0[1] * v0[1]) + (v0[2] * v0[2] + v0[3] * v0[3]) + (v1[0] * v1[0] + v1[1] * v1[1]) + (v1[2] * v1[2] + v1[3] * v1[3]);
                    }
                }
                s += __shfl_xor(s, 16); s += __shfl_xor(s, 32);
                if (ok && fq == 0) SSQ2[(size_t)row * 16 + u.pn * 4 + wc] = s;
            }
    }
};

template <class Epi, class Sched, bool ALIGN_EPI = false, bool SP2 = false>
__device__ __forceinline__ void gemm_phase(PG8_LAS unsigned char* lds, const Gemm g, const Sched& S, const Epi& E) {
    const int tid = threadIdx.x, wid = __builtin_amdgcn_readfirstlane(tid >> 6), lane = tid & 63, wr = wid >> 2, wc = wid & 3, fr = lane & 15, fq = lane >> 4;
    const int K = g.K, nt = K / BK;
    unsigned voffA[2], voffB[2];
#pragma unroll
    for (int i = 0; i < 2; ++i) { int R, C; stage_rc(tid * 16 + i * 8192, R, C); const int Rb = Epi::PERM ? ((R & ~31) + perm32(R & 31)) : R;
        voffA[i] = (unsigned)(R * K + C) * 2u; voffB[i] = (unsigned)(Rb * K + C) * 2u; }
    const size_t kstep = (size_t)(BK * 2);
    const size_t hstep = (size_t)HALF * K * 2;
    const size_t tstep = 2 * hstep;
    const unsigned ldsw = (unsigned)wid * 1024u;
    const int aoff = lds_byte(wr * 64 + fr, fq * 8), boff = lds_byte(wc * 32 + fr, fq * 8);
#define PG8_SA(b, h) (((b) * 2 + (h)) * HTB)
#define PG8_SB(b, h) ((4 + (b) * 2 + (h)) * HTB)
#define PG8_STAGE(bufoff, gbase, voff) do { _Pragma("unroll") for (int _i = 0; _i < 2; ++_i) \
        __builtin_amdgcn_global_load_lds((const unsigned*)((const char*)(gbase) + (voff)[_i]), (PG8_LAS unsigned*)(lds + (bufoff) + ldsw + _i * 8192), 16, 0, 0); } while (0)
#define PG8_LDA(dst, b, h) do { _Pragma("unroll") for (int m = 0; m < 4; ++m) _Pragma("unroll") for (int k = 0; k < 2; ++k) dst[m][k] = *(const PG8_LAS bf16x8*)(lds + PG8_SA(b, h) + aoff + m * 2048 + k * 1024); } while (0)
#define PG8_LDB(dst, b, h) do { _Pragma("unroll") for (int n = 0; n < 2; ++n) _Pragma("unroll") for (int k = 0; k < 2; ++k) dst[n][k] = *(const PG8_LAS bf16x8*)(lds + PG8_SB(b, h) + boff + n * 2048 + k * 1024); } while (0)
#define PG8_MMA(ai, bj, At, Bt) do { __builtin_amdgcn_s_setprio(1); _Pragma("unroll") for (int m = 0; m < 4; ++m) _Pragma("unroll") for (int n = 0; n < 2; ++n) _Pragma("unroll") for (int k = 0; k < 2; ++k) \
        acc[ai][bj][m][n] = __builtin_amdgcn_mfma_f32_16x16x32_bf16(Bt[n][k], At[m][k], acc[ai][bj][m][n], 0, 0, 0); __builtin_amdgcn_s_setprio(0); } while (0)
#define PG8_WAIT_V(n) asm volatile("s_waitcnt vmcnt(" #n ")" ::: "memory")
#define PG8_WAIT_L(n) asm volatile("s_waitcnt lgkmcnt(" #n ")" ::: "memory")
#define PG8_BAR __builtin_amdgcn_s_barrier()
#define PG8_SCHED __builtin_amdgcn_sched_barrier(0)
    Unit cur, nxt; int ui = 0;
    if (!S.next(0, cur)) return;
    f32x4 acc[2][2][4][2];
#pragma unroll
    for (int a = 0; a < 2; ++a)
#pragma unroll
        for (int b = 0; b < 2; ++b)
#pragma unroll
            for (int m = 0; m < 4; ++m)
#pragma unroll
                for (int n = 0; n < 2; ++n) acc[a][b][m][n] = (f32x4){0.f, 0.f, 0.f, 0.f};
    bf16x8 At[4][2], B0[2][2], B1[2][2];
    const char* cA = (const char*)g.A + (size_t)cur.pm * tstep; const char* cB = (const char*)g.Bt + (size_t)cur.pn * tstep;
    S.a_ready(cur);
    if constexpr (SP2) {
        PG8_STAGE(PG8_SB(0, 0), cB, voffB); PG8_STAGE(PG8_SB(0, 1), cB + hstep, voffB); PG8_STAGE(PG8_SA(0, 0), cA, voffA); PG8_STAGE(PG8_SA(0, 1), cA + hstep, voffA);
        if (wr == 1) PG8_BAR;
        PG8_WAIT_V(2); PG8_BAR;
        PG8_STAGE(PG8_SB(1, 0), cB + kstep, voffB); PG8_STAGE(PG8_SA(1, 0), cA + kstep, voffA); PG8_STAGE(PG8_SB(1, 1), cB + hstep + kstep, voffB);
        PG8_WAIT_V(6); PG8_BAR;
    } else {
        PG8_STAGE(PG8_SB(0, 0), cB, voffB); PG8_STAGE(PG8_SA(0, 0), cA, voffA); PG8_STAGE(PG8_SB(0, 1), cB + hstep, voffB); PG8_STAGE(PG8_SA(0, 1), cA + hstep, voffA);
        if (wr == 1) PG8_BAR;
        PG8_WAIT_V(4); PG8_BAR;
        PG8_STAGE(PG8_SB(1, 0), cB + kstep, voffB); PG8_STAGE(PG8_SA(1, 0), cA + kstep, voffA); PG8_STAGE(PG8_SB(1, 1), cB + hstep + kstep, voffB);
        PG8_WAIT_V(6); PG8_BAR;
    }
    for (;;) {
        const bool has_next = S.next(ui + 1, nxt);
        const char* nA = has_next ? (const char*)g.A + (size_t)nxt.pm * tstep : cA; const char* nB = has_next ? (const char*)g.Bt + (size_t)nxt.pn * tstep : cB;
        for (int t = 0; t < nt; t += 2) {
            const bool last = (t == nt - 2);
            const char* a1 = cA + (size_t)(t + 1) * kstep;
            const char* a2 = last ? nA : cA + (size_t)(t + 2) * kstep; const char* b2 = last ? nB : cB + (size_t)(t + 2) * kstep;
            const char* a3 = a2 + kstep; const char* b3 = b2 + kstep;
            if (last && has_next) S.a_ready(nxt);
            if constexpr (SP2) {
            PG8_LDB(B0, 0, 0); PG8_LDB(B1, 0, 1); PG8_SCHED; PG8_LDA(At, 0, 0); PG8_STAGE(PG8_SA(1, 1), a1 + hstep, voffA);
            PG8_WAIT_V(8); PG8_WAIT_L(0); PG8_BAR; PG8_MMA(0, 0, At, B0); PG8_MMA(0, 1, At, B1); PG8_BAR; PG8_SCHED;
            PG8_LDA(At, 0, 1); PG8_STAGE(PG8_SB(0, 0), b2, voffB); PG8_STAGE(PG8_SB(0, 1), b2 + hstep, voffB); PG8_STAGE(PG8_SA(0, 0), a2, voffA);
            PG8_WAIT_V(8); PG8_WAIT_L(0); PG8_BAR; PG8_MMA(1, 0, At, B0); PG8_MMA(1, 1, At, B1); PG8_BAR; PG8_SCHED;
            PG8_LDB(B0, 1, 0); PG8_LDB(B1, 1, 1); PG8_SCHED; PG8_LDA(At, 1, 0); PG8_STAGE(PG8_SA(0, 1), a2 + hstep, voffA);
            PG8_WAIT_V(8); PG8_WAIT_L(0); PG8_BAR; PG8_MMA(0, 0, At, B0); PG8_MMA(0, 1, At, B1); PG8_BAR; PG8_SCHED;
            PG8_LDA(At, 1, 1); PG8_STAGE(PG8_SB(1, 0), b3, voffB); PG8_STAGE(PG8_SB(1, 1), b3 + hstep, voffB); PG8_STAGE(PG8_SA(1, 0), a3, voffA);
            PG8_WAIT_V(8); PG8_WAIT_L(0); PG8_BAR; PG8_MMA(1, 0, At, B0); PG8_MMA(1, 1, At, B1); PG8_BAR; PG8_SCHED;
            } else {
            PG8_LDB(B0, 0, 0); PG8_SCHED; PG8_LDA(At, 0, 0); PG8_STAGE(PG8_SA(1, 1), a1 + hstep, voffA);
            PG8_WAIT_L(8); PG8_BAR; PG8_WAIT_L(0); PG8_MMA(0, 0, At, B0); PG8_BAR; PG8_SCHED;
            PG8_LDB(B1, 0, 1); PG8_STAGE(PG8_SB(0, 0), b2, voffB);
            PG8_BAR; PG8_WAIT_L(0); PG8_MMA(0, 1, At, B1); PG8_BAR;
            PG8_LDA(At, 0, 1); PG8_STAGE(PG8_SA(0, 0), a2, voffA);
            PG8_BAR; PG8_WAIT_L(0); PG8_MMA(1, 0, At, B0); PG8_BAR; PG8_SCHED;
            PG8_STAGE(PG8_SB(0, 1), b2 + hstep, voffB);
            PG8_WAIT_V(6); PG8_BAR; PG8_MMA(1, 1, At, B1); PG8_BAR;
            PG8_LDB(B0, 1, 0); PG8_SCHED; PG8_LDA(At, 1, 0); PG8_STAGE(PG8_SA(0, 1), a2 + hstep, voffA);
            PG8_WAIT_L(8); PG8_BAR; PG8_WAIT_L(0); PG8_MMA(0, 0, At, B0); PG8_BAR; PG8_SCHED;
            PG8_LDB(B1, 1, 1); PG8_STAGE(PG8_SB(1, 0), b3, voffB);
            PG8_BAR; PG8_WAIT_L(0); PG8_MMA(0, 1, At, B1); PG8_BAR;
            PG8_LDA(At, 1, 1); PG8_STAGE(PG8_SA(1, 0), a3, voffA);
            PG8_BAR; PG8_WAIT_L(0); PG8_MMA(1, 0, At, B0); PG8_BAR; PG8_SCHED;
            PG8_STAGE(PG8_SB(1, 1), b3 + hstep, voffB);
            PG8_WAIT_V(6); PG8_BAR; PG8_MMA(1, 1, At, B1); PG8_BAR;
            }
        }
        if constexpr (ALIGN_EPI) { if (wr == 0) PG8_BAR; }
        if constexpr (!Epi::AFTER_DRAIN) { E(acc, cur, wr, wc, fr, fq); S.done(cur); }
        if (!has_next) break;
#pragma unroll
        for (int a = 0; a < 2; ++a)
#pragma unroll
            for (int b = 0; b < 2; ++b)
#pragma unroll
                for (int m = 0; m < 4; ++m)
#pragma unroll
                    for (int n = 0; n < 2; ++n) acc[a][b][m][n] = (f32x4){0.f, 0.f, 0.f, 0.f};
        cur = nxt; cA = nA; cB = nB; ++ui;
        if constexpr (ALIGN_EPI) { if (wr == 1) PG8_BAR; }
    }
    PG8_WAIT_V(0);
    if constexpr (!ALIGN_EPI) { if (wr == 0) PG8_BAR; }
    PG8_BAR;
    if constexpr (Epi::AFTER_DRAIN) { E.fused(acc, cur, wr, wc, fr, fq, lds, wid, lane); S.done(cur); }
#undef PG8_SA
#undef PG8_SB
#undef PG8_STAGE
#undef PG8_LDA
#undef PG8_LDB
#undef PG8_MMA
#undef PG8_WAIT_V
#undef PG8_WAIT_L
#undef PG8_BAR
#undef PG8_SCHED
}
}

#define GAS __attribute__((address_space(1)))
#define LAS __attribute__((address_space(3)))
typedef unsigned short bf16;
typedef unsigned v4u __attribute__((ext_vector_type(4)));
typedef unsigned v2u __attribute__((ext_vector_type(2)));
typedef float f32x4 __attribute__((ext_vector_type(4)));
typedef float f32x2 __attribute__((ext_vector_type(2)));
typedef float f32x16 __attribute__((ext_vector_type(16)));
typedef short bf16x8 __attribute__((ext_vector_type(8)));
typedef short s16x4 __attribute__((ext_vector_type(4)));
#define LDS_WAIT() asm volatile("s_waitcnt lgkmcnt(0)" ::: "memory")
#define VM_WAIT() asm volatile("s_waitcnt vmcnt(0)" ::: "memory")
constexpr int NWAVES = 8;
constexpr int LDS_BYTES = 147456;
constexpr int MISC_OFF = 131072 + 8192;

__device__ __forceinline__ unsigned f2bf(float f) { unsigned u = __builtin_bit_cast(unsigned, f); return (u + 0x7fffu + ((u >> 16) & 1u)) >> 16; }
__device__ __forceinline__ unsigned pk2(float lo, float hi) { return f2bf(lo) | (f2bf(hi) << 16); }
__device__ __forceinline__ float bf2f(unsigned short b) { return __builtin_bit_cast(float, ((unsigned)b) << 16); }
__device__ __forceinline__ float wave_sum(float v) {
#pragma unroll
    for (int o = 1; o < 64; o <<= 1) v += __shfl_xor(v, o);
    return v;
}
__device__ __forceinline__ float softplus_f(float x) { return fmaxf(x, 0.f) + log1pf(expf(-fabsf(x))); }
__device__ __forceinline__ float sigmoid_f(float x) { return 1.0f / (1.0f + expf(-x)); }
__device__ __forceinline__ float silu_f(float x) { return x / (1.0f + expf(-x)); }

struct Params {
    const float* in[20];
    float* out; unsigned char* ws;
    int ph_lo, ph_hi;
};
struct Ctx { int tid, lane, wave, vcu, G; };

#define XB_TMO      128
#define XB_XCNT(j)  (256  + 64 * (j))
#define XB_XSUB(j)  (1280 + 64 * (j))
#define XB_XGEN(j)  (2304 + 64 * (j))
#define XB_TOP      3328
#define XB_TOPGEN   3392
#define XCD_BAR_WORDS 3456
#define XB_SPIN_CAP (1u << 18)

__device__ __forceinline__ unsigned xb_ld(unsigned* p)              { return __hip_atomic_load(p, __ATOMIC_RELAXED, __HIP_MEMORY_SCOPE_AGENT); }
__device__ __forceinline__ unsigned xb_add(unsigned* p, unsigned v) { return __hip_atomic_fetch_add(p, v, __ATOMIC_RELAXED, __HIP_MEMORY_SCOPE_AGENT); }
__device__ __forceinline__ unsigned xb_xcc_id() { return (unsigned)__builtin_amdgcn_s_getreg((3 << 11) | 20) & 0xFu; }
#define XB_SPIN(cond, bar) do { unsigned _sp = 0; while (cond) { __builtin_amdgcn_s_sleep(1); \
    if ((++_sp & 255u) == 0u) { if (xb_ld(&(bar)[XB_TMO])) break; if (_sp > XB_SPIN_CAP) { atomicAdd(&(bar)[XB_TMO], 1u); break; } } } } while (0)

struct XcdBarrier {
    unsigned* bar; unsigned x;
    volatile LAS unsigned* st;
};

__device__ __forceinline__ XcdBarrier xcd_barrier_post(unsigned* bar, volatile LAS unsigned* st) {
    XcdBarrier b; b.bar = bar; b.x = xb_xcc_id(); b.st = st;
    if (threadIdx.x == 0) (void)xb_add(&bar[XB_XCNT(b.x)], 1u);
    return b;
}
__device__ __forceinline__ void xcd_barrier_complete(unsigned* bar, unsigned x, unsigned& nloc, unsigned& nx) {
    const unsigned G = gridDim.x * gridDim.y * gridDim.z;
    unsigned sum, cnt, mine, sp = 0u;
    for (;;) {
        sum = 0u; cnt = 0u; mine = 0u;
#pragma unroll
        for (unsigned j = 0; j < 16; ++j) { const unsigned c = xb_ld(&bar[XB_XCNT(j)]); sum += c; cnt += (c > 0u) ? 1u : 0u; mine = (j == x) ? c : mine; }
        if (sum == G) break;
        __builtin_amdgcn_s_sleep(1);
        if ((++sp & 255u) == 0u) { if (xb_ld(&bar[XB_TMO])) break; if (sp > XB_SPIN_CAP) { atomicAdd(&bar[XB_TMO], 1u); break; } }
    }
    nloc = mine > 0u ? mine : 1u; nx = cnt > 0u ? cnt : 1u;
}

__device__ __forceinline__ void xcd_barrier(const XcdBarrier& b) {
    asm volatile("s_waitcnt vmcnt(0)" ::: "memory");
    __syncthreads();
    if (threadIdx.x == 0) {
        unsigned* bar = b.bar;
        __builtin_amdgcn_s_waitcnt(0);
        unsigned nloc = b.st[0], nx = b.st[1];
        if (nloc == 0u) { xcd_barrier_complete(bar, b.x, nloc, nx); b.st[0] = nloc; b.st[1] = nx; }
        const unsigned old = xb_add(&bar[XB_XSUB(b.x)], 1u);
        const unsigned gen = old / nloc;
        if (old + 1u == (gen + 1u) * nloc) {
            __builtin_amdgcn_fence(__ATOMIC_RELEASE, "agent");
            asm volatile("s_waitcnt vmcnt(0)" ::: "memory");
            const unsigned og = xb_add(&bar[XB_TOP], 1u);
            const unsigned tg = og / nx;
            if (og + 1u == (tg + 1u) * nx) xb_add(&bar[XB_TOPGEN], 1u);
            else XB_SPIN(xb_ld(&bar[XB_TOPGEN]) == tg, bar);
            __builtin_amdgcn_fence(__ATOMIC_ACQUIRE, "agent");
            xb_add(&bar[XB_XGEN(b.x)], 1u);
            asm volatile("s_waitcnt vmcnt(0)" ::: "memory");
        } else {
            XB_SPIN(xb_ld(&bar[XB_XGEN(b.x)]) == gen, bar);
            __builtin_amdgcn_fence(__ATOMIC_ACQUIRE, "agent");
            asm volatile("s_waitcnt vmcnt(0)" ::: "memory");
        }
    }
    __syncthreads();
}

__device__ __forceinline__ void transpose_item(const float* W, int ldw, int c0, int K, int ncols, const float* scale, bf16* WT, int row_off, LAS float* scr, int item, int lane) {
    const int nblk = ncols / 32, kb = item / nblk, nb = item % nblk, k0 = 64 * kb, n0 = 32 * nb;
#pragma unroll 8
    for (int i = 0; i < 32; ++i) { const int kk = 2 * i + (lane >> 5); float w = W[(size_t)(k0 + kk) * ldw + c0 + n0 + (lane & 31)]; if (scale) w *= scale[k0 + kk]; scr[kk * 33 + (lane & 31)] = w; }
    LDS_WAIT(); asm volatile("" ::: "memory");
    const int c = lane & 7;
#pragma unroll
    for (int j = 0; j < 4; ++j) { const int n = (lane >> 3) + 8 * j; const LAS float* s = scr + (8 * c) * 33 + n;
        v4u o; o.x = pk2(s[0 * 33], s[1 * 33]); o.y = pk2(s[2 * 33], s[3 * 33]); o.z = pk2(s[4 * 33], s[5 * 33]); o.w = pk2(s[6 * 33], s[7 * 33]);
        *(GAS v4u*)(WT + (size_t)(row_off + n0 + n) * K + k0 + 8 * c) = o; }
    LDS_WAIT(); asm volatile("" ::: "memory");
}

__device__ __forceinline__ void phase_prep(const Params& P, const Ctx& C, LAS unsigned char* lds) {
    unsigned char* ws = P.ws;
    const float* xp = P.in[0]; const float* xs = P.in[1]; const float* ln1 = P.in[8]; const float* w_in = P.in[9]; const float* b_f = P.in[10];
    const float* a_log = P.in[12]; const float* dt_bias = P.in[13]; const float* w_o = P.in[15]; const float* ln2 = P.in[16]; const float* w_up = P.in[17]; const float* w_down = P.in[18];
    bf16* XN = (bf16*)(ws + WS_XN);
    float* LF = (float*)(ws + WS_LF); float* BETA = (float*)(ws + WS_BETA); float* Gg = (float*)(ws + WS_G);
    LAS float* WSm = (LAS float*)lds;
    LAS float* scr = (LAS float*)(lds + 49152 + C.wave * 8448);
    for (int idx = C.tid; idx < 12 * 1024; idx += NWAVES * 64) { const int k = idx / 12, c = idx % 12; const int col = c < 4 ? 1536 + c : 3588 + (c - 4); WSm[c * 1024 + k] = w_in[(size_t)k * INDIM + col]; }
    __syncthreads();
    const int gw = C.vcu * NWAVES + C.wave, NGW = C.G * NWAVES, lane = C.lane;
    f32x4 lw[4];
#pragma unroll
    for (int j = 0; j < 4; ++j) lw[j] = ((const f32x4*)ln1)[lane + 64 * j];
    for (int m = gw; m < M_TOT; m += NGW) {
        const float* xr = m < MP ? xp + (size_t)m * DM : xs + (size_t)(m - MP) * DM;
        f32x4 v[4]; float ss = 0.f;
#pragma unroll
        for (int j = 0; j < 4; ++j) { v[j] = ((const f32x4*)xr)[lane + 64 * j]; ss += (v[j][0] * v[j][0] + v[j][1] * v[j][1]) + (v[j][2] * v[j][2] + v[j][3] * v[j][3]); }
        ss = wave_sum(ss);
        const float rstd = 1.0f / sqrtf(ss * (1.0f / DM) + RMS_EPS);
#pragma unroll
        for (int j = 0; j < 4; ++j) { v[j] = v[j] * rstd * lw[j];
            v2u o; o.x = pk2(v[j][0], v[j][1]); o.y = pk2(v[j][2], v[j][3]);
            *(v2u*)(XN + (size_t)m * DM + 4 * lane + 256 * j) = o; }
        float mine = 0.f;
#pragma unroll
        for (int c = 0; c < 12; ++c) { float a = 0.f;
#pragma unroll
            for (int j = 0; j < 4; ++j) { const f32x4 w = *(const LAS f32x4*)(WSm + c * 1024 + 4 * lane + 256 * j); a += (v[j][0] * w[0] + v[j][1] * w[1]) + (v[j][2] * w[2] + v[j][3] * w[3]); }
            a = wave_sum(a); mine = (lane == c) ? a : mine; }
        const float bb = __shfl(mine, (lane + 4) & 63), aa = __shfl(mine, (lane + 8) & 63);
        if (lane < 4) {
            const float fa = mine;
            const float lf = -softplus_f(-(fa + b_f[lane]));
            const float beta = sigmoid_f(bb);
            const float g = -expf(a_log[lane]) * softplus_f(aa + dt_bias[lane]);
            LF[(size_t)m * 4 + lane] = lf; BETA[(size_t)m * 4 + lane] = beta; Gg[(size_t)m * 4 + lane] = g;
            if (m < MP) P.out[OLF_P + (size_t)m * 4 + lane] = lf; else P.out[OLF_S + (size_t)(m - MP) * 4 + lane] = lf;
        }
    }
    bf16* W1T = (bf16*)(ws + WS_W1T); bf16* WOT = (bf16*)(ws + WS_WOT); bf16* WUPT = (bf16*)(ws + WS_WUPT); bf16* WDNT = (bf16*)(ws + WS_WDNT);
    for (int it = gw; it < 16 * 48; it += NGW) transpose_item(w_in, INDIM, 0, DM, 1536, nullptr, W1T, 0, scr, it, lane);
    for (int it = gw; it < 16 * 48; it += NGW) transpose_item(w_in, INDIM, 1540, DM, 1536, nullptr, W1T, 1536, scr, it, lane);
    for (int it = gw; it < 16 * 16; it += NGW) transpose_item(w_in, INDIM, 3076, DM, 512, nullptr, W1T, 3072, scr, it, lane);
    for (int it = gw; it < 16 * 32; it += NGW) transpose_item(w_o, DM, 0, DM, DM, nullptr, WOT, 0, scr, it, lane);
    for (int it = gw; it < 16 * 128; it += NGW) transpose_item(w_up, FF, 0, DM, FF, ln2, WUPT, 0, scr, it, lane);
    for (int it = gw; it < 64 * 32; it += NGW) transpose_item(w_down, DM, 0, FF, DM, nullptr, WDNT, 0, scr, it, lane);
}

__device__ __forceinline__ void kbias_seq(const Params& P, int bh, int lane) {
    const float* LF = (const float*)(P.ws + WS_LF); float* KBIAS = (float*)(P.ws + WS_KBIAS);
    const int b = bh >> 2, h = bh & 3;
    const float* src = LF + ((size_t)b * SEQ + 32 * lane) * 4 + h;
    float s = 0.f;
    for (int i = 0; i < 32; ++i) s += src[i * 4];
    float x = s;
#pragma unroll
    for (int o = 1; o < 64; o <<= 1) { const float y = __shfl_up(x, o); if (lane >= o) x += y; }
    float run = x - s;
    float* dst = KBIAS + (size_t)bh * SEQ + 32 * lane;
    const float inv = -11.313708498984761f;
    for (int i = 0; i < 32; ++i) { run += src[i * 4]; dst[i] = run * inv; }
}


namespace fox {
constexpr int D = 128, NW = 8, QBLK = 32, KVBLK = 64, QB = NW * QBLK;
constexpr int SHM_V = KVBLK * D * 2, SHM_K = KVBLK * D * 2;
constexpr float SCALE = 0.08838834764831845f, THR = 8.f;
#define KSWZ(row, colB) ((row) * 256 + ((colB) ^ (((row) & 7) << 4)))
#define SBAR() __builtin_amdgcn_sched_barrier(0)
__device__ __forceinline__ int v_st(int k, int c) { const int kk = (k & ~0xC) | ((k & 4) << 1) | ((k & 8) >> 1); return ((kk >> 3) * 4 + (c >> 5)) * 512 + ((kk & 7) * 32 + (c & 31)) * 2; }
__device__ __forceinline__ int v_rd_base(int lane) { return ((lane & 3) << 3) | (((lane >> 2) & 3) << 6) | (((lane >> 4) & 1) << 5) | (((lane >> 5) & 1) << 8); }
constexpr int v_rd_off(int d0, int ks, int half) { return d0 * 512 + ks * 4096 + half * 2048; }
__device__ __forceinline__ int crow(int r, int hi) { return (r & 3) + 8 * (r >> 2) + 4 * hi; }
__device__ __forceinline__ unsigned cvtpk(float lo, float hi) { unsigned r; asm volatile("v_cvt_pk_bf16_f32 %0, %1, %2" : "=v"(r) : "v"(lo), "v"(hi)); return r; }
__device__ __forceinline__ void mask_tile(f32x16& p0, f32x16& p1, int dq, unsigned W) {
    const float NEG = -__builtin_inff();
#pragma unroll
    for (int r = 0; r < 16; ++r) {
        const int c = (r & 3) + 8 * (r >> 2);
        if ((unsigned)(dq - c) >= W) p0[r] = NEG;
        if ((unsigned)(dq - c - 32) >= W) p1[r] = NEG;
    }
}
__device__ __forceinline__ void partialSM(f32x16& p0, f32x16& p1, float& m_reg, float& mn, float& alpha) {
    float pmax = p0[0]; for (int r = 1; r < 16; ++r) pmax = fmaxf(pmax, p0[r]); for (int r = 0; r < 16; ++r) pmax = fmaxf(pmax, p1[r]);
    { auto rr = __builtin_amdgcn_permlane32_swap(__float_as_uint(pmax), __float_as_uint(pmax), false, false);
      pmax = fmaxf(__uint_as_float(rr[0]), __uint_as_float(rr[1])); }
    constexpr float C2 = 1.4426950408889634f * SCALE;
    if (__builtin_expect(__all((pmax - m_reg) * SCALE <= THR), 1)) { mn = m_reg; alpha = 1.f; }
    else { mn = fmaxf(m_reg, pmax); alpha = __builtin_amdgcn_exp2f((m_reg - mn) * C2); m_reg = mn; }
    const float mnL = -mn * C2;
    for (int r = 0; r < 16; ++r) p0[r] = fmaf(p0[r], C2, mnL); for (int r = 0; r < 16; ++r) p1[r] = fmaf(p1[r], C2, mnL);
    for (int r = 0; r < 16; ++r) p0[r] = __builtin_amdgcn_exp2f(p0[r]);
}
__device__ __forceinline__ void finishSM(f32x16& p0, f32x16& p1, float alpha, float& l_reg, bf16x8& pa0, bf16x8& pa1, bf16x8& pa2, bf16x8& pa3) {
    for (int r = 0; r < 16; ++r) p1[r] = __builtin_amdgcn_exp2f(p1[r]);
    float ps = 0; for (int r = 0; r < 16; ++r) ps += p0[r]; for (int r = 0; r < 16; ++r) ps += p1[r];
    { auto rr = __builtin_amdgcn_permlane32_swap(__float_as_uint(ps), __float_as_uint(ps), false, false);
      ps = __uint_as_float(rr[0]) + __uint_as_float(rr[1]); }
    l_reg = l_reg * alpha + ps;
#define PK4(P, B_, OUT) do { unsigned a0 = cvtpk(P[B_+0], P[B_+1]), a1 = cvtpk(P[B_+2], P[B_+3]);                          \
        unsigned b0 = cvtpk(P[B_+4], P[B_+5]), b1 = cvtpk(P[B_+6], P[B_+7]);                                             \
        auto r0 = __builtin_amdgcn_permlane32_swap(a0, b0, false, false); auto r1 = __builtin_amdgcn_permlane32_swap(a1, b1, false, false); \
        v4u w = {r0[0], r1[0], r0[1], r1[1]}; OUT = *reinterpret_cast<bf16x8*>(&w); } while (0)
    PK4(p0, 0, pa0); PK4(p0, 8, pa1); PK4(p1, 0, pa2); PK4(p1, 8, pa3);
#undef PK4
}
template <int KB>
__device__ __forceinline__ void qkt(f32x16& p0, f32x16& p1, const char* K_lds, const float* bias_l, int r32, int hi, const bf16x8* qr) {
#pragma unroll
    for (int g = 0; g < 4; ++g) { const f32x4 t0 = *(const f32x4*)(bias_l + 8 * g + 4 * hi), t1 = *(const f32x4*)(bias_l + 32 + 8 * g + 4 * hi);
#pragma unroll
        for (int i = 0; i < 4; ++i) { p0[4 * g + i] = t0[i]; p1[4 * g + i] = t1[i]; } }
    const char* kb[4];
#pragma unroll
    for (int dd = 0; dd < 4; ++dd) kb[dd] = K_lds + KB * SHM_K + KSWZ(r32, (dd * 16 + hi * 8) * 2);
#pragma unroll
    for (int d0 = 0; d0 < 8; ++d0) { const char* a = kb[d0 & 3] + (d0 >> 2) * 128;
        bf16x8 b0 = *reinterpret_cast<const bf16x8*>(a);
        bf16x8 b1 = *reinterpret_cast<const bf16x8*>(a + 32 * 256);
        p0 = __builtin_amdgcn_mfma_f32_32x32x16_bf16(b0, qr[d0], p0, 0, 0, 0);
        p1 = __builtin_amdgcn_mfma_f32_32x32x16_bf16(b1, qr[d0], p1, 0, 0, 0); }
}
template <int VB>
__device__ __forceinline__ void pv_tile(f32x16* o, int vb0, bf16x8 pa0, bf16x8 pa1, bf16x8 pa2, bf16x8 pa3) {
#define TRRD(dst, off) asm volatile("ds_read_b64_tr_b16 %0, %1 offset:%2" : "=&v"(dst) : "v"(vb0), "i"(off) : "memory")
#define PV_D0(d0) do { s16x4 l0, l1, l2, l3, h0, h1, h2, h3; constexpr int b_ = VB * SHM_V + v_rd_off(d0, 0, 0);   \
        TRRD(l0, b_); TRRD(h0, b_ + 2048); TRRD(l1, b_ + 4096); TRRD(h1, b_ + 6144); TRRD(l2, b_ + 8192); TRRD(h2, b_ + 10240); TRRD(l3, b_ + 12288); TRRD(h3, b_ + 14336); \
        asm volatile("s_waitcnt lgkmcnt(0)" ::: "memory"); SBAR();   \
        o[d0] = __builtin_amdgcn_mfma_f32_32x32x16_bf16(pa0, (bf16x8){l0[0], l0[1], l0[2], l0[3], h0[0], h0[1], h0[2], h0[3]}, o[d0], 0, 0, 0);   \
        o[d0] = __builtin_amdgcn_mfma_f32_32x32x16_bf16(pa1, (bf16x8){l1[0], l1[1], l1[2], l1[3], h1[0], h1[1], h1[2], h1[3]}, o[d0], 0, 0, 0);   \
        o[d0] = __builtin_amdgcn_mfma_f32_32x32x16_bf16(pa2, (bf16x8){l2[0], l2[1], l2[2], l2[3], h2[0], h2[1], h2[2], h2[3]}, o[d0], 0, 0, 0);   \
        o[d0] = __builtin_amdgcn_mfma_f32_32x32x16_bf16(pa3, (bf16x8){l3[0], l3[1], l3[2], l3[3], h3[0], h3[1], h3[2], h3[3]}, o[d0], 0, 0, 0); } while (0)
    PV_D0(0); PV_D0(1); PV_D0(2); PV_D0(3);
#undef PV_D0
#undef TRRD
}

__device__ __forceinline__ void fox_block(char* lds, const bf16* Qh, const bf16* Kh, const bf16* Vh, const float* kbias, bf16* Orow0, int qb) {
    const int tid = threadIdx.x, wid = __builtin_amdgcn_readfirstlane(tid >> 6), lane = tid & 63, r32 = lane & 31, hi = lane >> 5;
    const int P0 = qb * QB, qlo = P0 + wid * QBLK, qm = qlo + r32 - 4 * hi;
    char* V_lds = lds; char* K_lds = lds + SHM_V;
    float* bias_l = (float*)(lds + SHM_V + SHM_K);
    float* wsf = bias_l + 64 + wid * 64; float* li_l = wsf; float* al_l = wsf + 32;
    bf16x8 qr[8];
#pragma unroll
    for (int d0 = 0; d0 < 8; ++d0) qr[d0] = *reinterpret_cast<const bf16x8*>(Qh + (size_t)(qlo + r32) * D + d0 * 16 + hi * 8);
    float m_reg = -1e30f, l_reg = 0.f; f32x16 o[4] = {};
    const int sr = tid >> 4, sc = (tid & 15) * 8, vst0 = v_st(sr, sc), vst1 = v_st(32 + sr, sc), kws = KSWZ(sr, sc * 2);
    const int vb0 = (int)(uintptr_t)V_lds + v_rd_base(lane);
    const int ntiles = P0 / KVBLK + 4;
    for (int j = ntiles - 1; j >= 0; --j) {
        const int kb = j * KVBLK;
        __syncthreads();
        { const bf16x8 k0 = *reinterpret_cast<const bf16x8*>(Kh + (size_t)(kb + sr) * D + sc), k1 = *reinterpret_cast<const bf16x8*>(Kh + (size_t)(kb + 32 + sr) * D + sc);
          const bf16x8 v0 = *reinterpret_cast<const bf16x8*>(Vh + (size_t)(kb + sr) * D + sc), v1 = *reinterpret_cast<const bf16x8*>(Vh + (size_t)(kb + 32 + sr) * D + sc);
          *(bf16x8*)(K_lds + kws) = k0; *(bf16x8*)(K_lds + kws + 32 * 256) = k1; *(bf16x8*)(V_lds + vst0) = v0; *(bf16x8*)(V_lds + vst1) = v1;
          if (tid < 64) bias_l[tid] = kbias[kb + tid]; }
        __syncthreads();
        if (kb <= qlo + QBLK - 1) {
            f32x16 p0, p1; float mn, al; bf16x8 pa0, pa1, pa2, pa3;
            qkt<0>(p0, p1, K_lds, bias_l, r32, hi, qr);
            if (kb + KVBLK - 1 > qlo) mask_tile(p0, p1, qm - kb, 0x40000000u);
            partialSM(p0, p1, m_reg, mn, al);
            if (__any(al < 1.f)) { if (hi == 0) al_l[r32] = al; asm volatile("s_waitcnt lgkmcnt(0)" ::: "memory");
                for (int d_ = 0; d_ < 4; ++d_) for (int r = 0; r < 16; ++r) o[d_][r] *= al_l[crow(r, hi)]; }
            finishSM(p0, p1, al, l_reg, pa0, pa1, pa2, pa3); SBAR();
            pv_tile<0>(o, vb0, pa0, pa1, pa2, pa3);
        }
    }
    if (hi == 0) li_l[r32] = l_reg; asm volatile("s_waitcnt lgkmcnt(0)" ::: "memory");
    float rli[16];
#pragma unroll
    for (int r = 0; r < 16; ++r) rli[r] = __builtin_amdgcn_rcpf(li_l[crow(r, hi)]);
    bf16* Ow = Orow0 + (size_t)qlo * DM;
#pragma unroll
    for (int r = 0; r < 16; ++r) { const int orow = crow(r, hi);
#pragma unroll
        for (int d0 = 0; d0 < 4; ++d0) { const float v = o[d0][r] * rli[r];
            const float vn = __shfl_xor(v, 1);
            if ((r32 & 1) == 0) *(unsigned*)(Ow + (size_t)orow * DM + d0 * 32 + r32) = cvtpk(v, vn); } }
    __syncthreads();
}
}


__device__ __forceinline__ void dec_update(float& m, float& l, f32x4& acc, const float (&x)[4], const f32x4 (&v)[4], int n) {
    float mx = m;
#pragma unroll
    for (int u = 0; u < 4; ++u) if (u < n) mx = fmaxf(mx, x[u]);
    const float al = __expf(m - mx);
    float ps = 0.f; f32x4 a = acc * al;
#pragma unroll
    for (int u = 0; u < 4; ++u) if (u < n) { const float p = __expf(x[u] - mx); ps += p; a += v[u] * p; }
    l = l * al + ps; acc = a; m = mx;
}
__device__ __forceinline__ float red32(float s) {
#pragma unroll
    for (int o = 1; o < 32; o <<= 1) s += __shfl_xor(s, o);
    return s;
}
__device__ __forceinline__ void decode_unit(const Params& P, LAS unsigned char* lds, int db) {
    const int tid = threadIdx.x, wid = __builtin_amdgcn_readfirstlane(tid >> 6), lane = tid & 63, hi = lane >> 5;
    const float* cache_k = P.in[2]; const float* cache_v = P.in[3]; const float* cache_lf = P.in[4]; const int* page_table = (const int*)P.in[5];
    const float* LF = (const float*)(P.ws + WS_LF); const float* QS = (const float*)(P.ws + WS_QS);
    bf16* MIX = (bf16*)(P.ws + WS_MIX);
    LAS f32x4* lfs = (LAS f32x4*)lds;
    LAS f32x4* wt = lfs + 2048;
    LAS float* cm = (LAS float*)(wt + 8);
    LAS float* cl = cm + 32;
    LAS f32x4* cacc = (LAS f32x4*)(cl + 32);
    const int ptv = (lane < NPAGES) ? page_table[db * NPAGES + lane] : 0;
#pragma unroll
    for (int i = 0; i < 4; ++i) { const int j = tid + 512 * i; const int pg = __shfl(ptv, j >> 7);
        lfs[j] = *(const f32x4*)(cache_lf + ((size_t)pg * PAGE + (j & 127)) * 4); }
    __syncthreads();
    {
        const f32x4 a0 = lfs[4 * tid], a1 = lfs[4 * tid + 1], a2 = lfs[4 * tid + 2], a3 = lfs[4 * tid + 3];
        const f32x4 tot = (a0 + a1) + (a2 + a3);
        f32x4 x = tot;
#pragma unroll
        for (int o = 1; o < 64; o <<= 1) { f32x4 y; y[0] = __shfl_down(x[0], o); y[1] = __shfl_down(x[1], o); y[2] = __shfl_down(x[2], o); y[3] = __shfl_down(x[3], o); if (lane + o < 64) x += y; }
        if (lane == 0) wt[wid] = x;
        __syncthreads();
        f32x4 after = {0.f, 0.f, 0.f, 0.f};
        for (int w2 = wid + 1; w2 < NWAVES; ++w2) after += wt[w2];
        const f32x4 lfn = *(const f32x4*)(LF + (size_t)(MP + db) * 4);
        const f32x4 B3 = (x - tot) + after + lfn, B2 = B3 + a3, B1 = B2 + a2, B0 = B1 + a1;
        lfs[4 * tid] = B0; lfs[4 * tid + 1] = B1; lfs[4 * tid + 2] = B2; lfs[4 * tid + 3] = B3;
    }
    __syncthreads();
    const float* qs = QS + (size_t)db * 512;
    const f32x4 qa = *(const f32x4*)(qs + 4 * lane) * ATT_SCALE, qb = *(const f32x4*)(qs + 256 + 4 * lane) * ATT_SCALE;
    float m0 = -1e30f, l0 = 0.f, m1 = -1e30f, l1 = 0.f; f32x4 acc0 = {0.f, 0.f, 0.f, 0.f}, acc1 = {0.f, 0.f, 0.f, 0.f};
    for (int j0 = wid; j0 < PAST; j0 += 32) {
        f32x4 ka[4], kb[4], va[4], vb[4]; float x0[4], x1[4];
#pragma unroll
        for (int u = 0; u < 4; ++u) { const int j = j0 + 8 * u; const int pg = __builtin_amdgcn_readlane(ptv, j >> 7);
            const size_t ro = ((size_t)pg * PAGE + (j & 127)) * 512 + 4 * lane;
            ka[u] = *(const f32x4*)(cache_k + ro); kb[u] = *(const f32x4*)(cache_k + ro + 256);
            va[u] = *(const f32x4*)(cache_v + ro); vb[u] = *(const f32x4*)(cache_v + ro + 256); }
#pragma unroll
        for (int u = 0; u < 4; ++u) { const int j = j0 + 8 * u;
            float s0 = (qa[0] * ka[u][0] + qa[1] * ka[u][1]) + (qa[2] * ka[u][2] + qa[3] * ka[u][3]);
            float s1 = (qb[0] * kb[u][0] + qb[1] * kb[u][1]) + (qb[2] * kb[u][2] + qb[3] * kb[u][3]);
            s0 = red32(s0); s1 = red32(s1);
            const f32x4 bj = lfs[j];
            x0[u] = s0 + (hi ? bj[1] : bj[0]); x1[u] = s1 + (hi ? bj[3] : bj[2]); }
        dec_update(m0, l0, acc0, x0, va, 4); dec_update(m1, l1, acc1, x1, vb, 4);
    }
    if (wid == 0) {
        f32x4 va[4], vb[4]; float x0[4], x1[4];
        const float* kn = P.out + OK_S + (size_t)db * 512; const float* vn = P.out + OV_S + (size_t)db * 512;
        const f32x4 ka = *(const f32x4*)(kn + 4 * lane), kb = *(const f32x4*)(kn + 256 + 4 * lane);
        va[0] = *(const f32x4*)(vn + 4 * lane); vb[0] = *(const f32x4*)(vn + 256 + 4 * lane);
#pragma unroll
        for (int u = 1; u < 4; ++u) { va[u] = va[0]; vb[u] = vb[0]; }
        x0[0] = red32((qa[0] * ka[0] + qa[1] * ka[1]) + (qa[2] * ka[2] + qa[3] * ka[3]));
        x1[0] = red32((qb[0] * kb[0] + qb[1] * kb[1]) + (qb[2] * kb[2] + qb[3] * kb[3]));
#pragma unroll
        for (int u = 1; u < 4; ++u) { x0[u] = x0[0]; x1[u] = x1[0]; }
        dec_update(m0, l0, acc0, x0, va, 1); dec_update(m1, l1, acc1, x1, vb, 1);
    }
    if ((lane & 31) == 0) { cm[wid * 4 + hi] = m0; cm[wid * 4 + 2 + hi] = m1; cl[wid * 4 + hi] = l0; cl[wid * 4 + 2 + hi] = l1; }
    cacc[(wid * 2 + 0) * 64 + lane] = acc0; cacc[(wid * 2 + 1) * 64 + lane] = acc1;
    __syncthreads();
    if (tid < 128) {
        const int ab = tid >> 6, l = tid & 63, head = 2 * ab + (l >> 5);
        float M = -1e30f;
#pragma unroll
        for (int w = 0; w < NWAVES; ++w) M = fmaxf(M, cm[w * 4 + head]);
        float L = 0.f; f32x4 O = {0.f, 0.f, 0.f, 0.f};
#pragma unroll
        for (int w = 0; w < NWAVES; ++w) { const float e = __expf(cm[w * 4 + head] - M); L += cl[w * 4 + head] * e; O += cacc[(w * 2 + ab) * 64 + l] * e; }
        const float inv = 1.0f / L;
        v2u o; o.x = pk2(O[0] * inv, O[1] * inv); o.y = pk2(O[2] * inv, O[3] * inv);
        *(v2u*)(MIX + (size_t)(MP + db) * DM + head * 128 + 4 * (l & 31)) = o;
    }
    __syncthreads();
}

__device__ __forceinline__ void sgdn_unit(const Params& P, LAS unsigned char* lds, int db, int h) {
    const int tid = threadIdx.x, wid = __builtin_amdgcn_readfirstlane(tid >> 6), lane = tid & 63;
    const float* state_conv = P.in[6]; const float* state_ssm = P.in[7]; const float* w_conv = P.in[11]; const float* w_gnorm = P.in[14];
    const float* BETA = (const float*)(P.ws + WS_BETA); const float* Gg = (const float*)(P.ws + WS_G);
    const bf16* ZB = (const bf16*)(P.ws + WS_ZB); bf16* MIX = (bf16*)(P.ws + WS_MIX);
    LAS float* xs = (LAS float*)lds;
    LAS float* red1 = xs + 384;
    LAS float* red2 = red1 + 1024;
    LAS float* ov = red2 + 1024;
    if (tid < 384) {
        const int seg = tid >> 7, d = tid & 127, ch = seg * 512 + h * 128 + d;
        const float* sc = state_conv + (size_t)db * 3 * CONVD + ch;
        float* oc = P.out + OCONV_S + (size_t)db * 3 * CONVD + ch;
        const float c0 = sc[0], c1 = sc[CONVD], c2 = sc[2 * CONVD], c3 = oc[2 * CONVD];
        const float a = c0 * w_conv[ch] + c1 * w_conv[CONVD + ch] + c2 * w_conv[2 * CONVD + ch] + c3 * w_conv[3 * CONVD + ch];
        xs[tid] = silu_f(a);
        oc[0] = c1; oc[CONVD] = c2;
    }
    __syncthreads();
    if (wid < 2) {
        const float a = xs[wid * 128 + lane], b = xs[wid * 128 + 64 + lane];
        const float ss = wave_sum(a * a + b * b);
        const float sc = (1.0f / sqrtf(ss + L2_EPS)) * (wid == 0 ? ATT_SCALE : 1.0f);
        xs[wid * 128 + lane] = a * sc; xs[wid * 128 + 64 + lane] = b * sc;
    }
    __syncthreads();
    const float gsc = expf(Gg[(size_t)(MP + db) * 4 + h]), bt = BETA[(size_t)(MP + db) * 4 + h];
    const float* Sp = state_ssm + ((size_t)(db * 4 + h) * 128 + 16 * wid) * 128 + 2 * lane;
    f32x2 s[16]; f32x2 ks = {0.f, 0.f};
#pragma unroll
    for (int r = 0; r < 16; ++r) { s[r] = *(const f32x2*)(Sp + (size_t)r * 128) * gsc; const float kd = xs[128 + 16 * wid + r]; ks += s[r] * kd; }
    *(LAS f32x2*)(red1 + wid * 128 + 2 * lane) = ks;
    __syncthreads();
    f32x2 kS = {0.f, 0.f};
#pragma unroll
    for (int w = 0; w < NWAVES; ++w) kS += *(const LAS f32x2*)(red1 + w * 128 + 2 * lane);
    const f32x2 vv = *(const LAS f32x2*)(xs + 256 + 2 * lane);
    const f32x2 delta = (vv - kS) * bt;
    float* So = P.out + OSSM_S + ((size_t)(db * 4 + h) * 128 + 16 * wid) * 128 + 2 * lane;
    f32x2 os = {0.f, 0.f};
#pragma unroll
    for (int r = 0; r < 16; ++r) { const float kd = xs[128 + 16 * wid + r], qd = xs[16 * wid + r]; s[r] += delta * kd; *(f32x2*)(So + (size_t)r * 128) = s[r]; os += s[r] * qd; }
    *(LAS f32x2*)(red2 + wid * 128 + 2 * lane) = os;
    __syncthreads();
    if (tid < 128) { float o = 0.f;
#pragma unroll
        for (int w = 0; w < NWAVES; ++w) o += red2[w * 128 + tid];
        ov[tid] = o; }
    __syncthreads();
    if (wid == 0) {
        const float a = ov[lane], b = ov[64 + lane];
        const float ss = wave_sum(a * a + b * b);
        const float rstd = 1.0f / sqrtf(ss * (1.0f / 128.0f) + RMS_EPS);
        const bf16* zr = ZB + (size_t)(MP + db) * 512 + h * 128;
        bf16* mr = MIX + (size_t)(MP + db) * DM + 512 + h * 128;
        mr[lane] = (bf16)f2bf(a * rstd * w_gnorm[lane] * silu_f(bf2f(zr[lane])));
        mr[64 + lane] = (bf16)f2bf(b * rstd * w_gnorm[64 + lane] * silu_f(bf2f(zr[64 + lane])));
    }
    __syncthreads();
}


constexpr int XS = 132, LS = 68;
__device__ __forceinline__ void gdna_unit(const Params& P, LAS unsigned char* lds, int unit) {
    const int tid = threadIdx.x, wid = __builtin_amdgcn_readfirstlane(tid >> 6), lane = tid & 63;
    const int n = unit & 31, bh = unit >> 5, b = bh >> 2, h = bh & 3, m0 = b * SEQ + n * GCH;
    const float* w_conv = P.in[11];
    const bf16* CB = (const bf16*)(P.ws + WS_CB);
    const float* BETA = (const float*)(P.ws + WS_BETA); const float* Gg = (const float*)(P.ws + WS_G);
    float* UT = (float*)(P.ws + WS_UT) + (size_t)unit * 8192; bf16* WN = (bf16*)(P.ws + WS_WN) + (size_t)unit * 8192; bf16* QG = (bf16*)(P.ws + WS_QG) + (size_t)unit * 8192;
    bf16* KGT = (bf16*)(P.ws + WS_KGT) + (size_t)unit * 8192; bf16* QKM = (bf16*)(P.ws + WS_QKM) + (size_t)unit * 4096; float* GL = (float*)(P.ws + WS_GL);
    LAS float* XQ = (LAS float*)lds; LAS float* XK = XQ + 64 * XS; LAS float* XV = XK + 64 * XS;
    LAS float* Lm = XV + 64 * XS;
    LAS float* gcs = Lm + 64 * LS; LAS float* bts = gcs + 64; LAS float* sks = bts + 64;
    if (tid < 384) {
        const int seg = tid >> 7, d = tid & 127, ch = seg * 512 + h * 128 + d;
        const float w0 = w_conv[ch], w1 = w_conv[CONVD + ch], w2 = w_conv[2 * CONVD + ch], w3 = w_conv[3 * CONVD + ch];
        const bf16* src = CB + (size_t)m0 * CONVD + ch;
        float x0 = 0.f, x1 = 0.f, x2 = 0.f;
        if (n > 0) { x0 = bf2f(src[-3 * CONVD]); x1 = bf2f(src[-2 * CONVD]); x2 = bf2f(src[-1 * CONVD]); }
        LAS float* X = XQ + seg * 64 * XS + d;
#pragma unroll 4
        for (int i = 0; i < 64; ++i) { const float x3 = bf2f(src[(size_t)i * CONVD]); X[i * XS] = silu_f((x0 * w0 + x1 * w1) + (x2 * w2 + x3 * w3)); x0 = x1; x1 = x2; x2 = x3; }
    }
    if (wid == 7) {
        const float g = Gg[(size_t)(m0 + lane) * 4 + h]; float x = g;
#pragma unroll
        for (int o = 1; o < 64; o <<= 1) { const float y = __shfl_up(x, o); if (lane >= o) x += y; }
        { const float bt_ = BETA[(size_t)(m0 + lane) * 4 + h]; gcs[lane] = x; bts[lane] = bt_; sks[lane] = bt_ * expf(x); }
    }
    __syncthreads();
#pragma unroll
    for (int rr = 0; rr < 16; ++rr) { const int isq = rr < 8, i = 8 * wid + (rr & 7); LAS float* X = (isq ? XQ : XK) + i * XS;
        const float a = X[lane], c = X[64 + lane]; const float ss = wave_sum(a * a + c * c);
        const float sc = (1.0f / sqrtf(ss + L2_EPS)) * (isq ? ATT_SCALE : 1.0f);
        X[lane] = a * sc; X[64 + lane] = c * sc; }
    __syncthreads();
    {
        const int i = tid >> 3, tj = tid & 7;
        float akk[8], aqk[8];
#pragma unroll
        for (int jj = 0; jj < 8; ++jj) { akk[jj] = 0.f; aqk[jj] = 0.f; }
        if (tj * 8 <= i) {
            for (int d = 0; d < 128; d += 4) {
                const f32x4 ki = *(const LAS f32x4*)(XK + i * XS + d), qi = *(const LAS f32x4*)(XQ + i * XS + d);
#pragma unroll
                for (int jj = 0; jj < 8; ++jj) { const f32x4 kj = *(const LAS f32x4*)(XK + (tj * 8 + jj) * XS + d);
                    akk[jj] += (ki[0] * kj[0] + ki[1] * kj[1]) + (ki[2] * kj[2] + ki[3] * kj[3]);
                    aqk[jj] += (qi[0] * kj[0] + qi[1] * kj[1]) + (qi[2] * kj[2] + qi[3] * kj[3]); }
            }
        }
        const float gi = gcs[i], bi = bts[i];
        v4u qo; unsigned qw[4];
#pragma unroll
        for (int jj = 0; jj < 8; jj += 2) {
            float lv[2], qv[2];
#pragma unroll
            for (int e = 0; e < 2; ++e) { const int j = tj * 8 + jj + e; const float dec = (j <= i) ? expf(gi - gcs[j]) : 0.f;
                lv[e] = (j < i) ? bi * akk[jj + e] * dec : 0.f; qv[e] = (j <= i) ? aqk[jj + e] * dec : 0.f; }
            Lm[i * LS + tj * 8 + jj] = lv[0]; Lm[i * LS + tj * 8 + jj + 1] = lv[1];
            qw[jj >> 1] = pk2(qv[0], qv[1]);
        }
        qo.x = qw[0]; qo.y = qw[1]; qo.z = qw[2]; qo.w = qw[3];
        *(v4u*)(QKM + (size_t)i * 64 + tj * 8) = qo;
    }
    __syncthreads();
    if (tid < 256) {
        const int c = tid; const bool isv = c < 128; const LAS float* X = isv ? (XV + c) : (XK + (c - 128)); const LAS float* scp = isv ? bts : sks;
        int vz; asm volatile("v_mov_b32 %0, 0" : "=v"(vz));
        const LAS float* LmV = Lm + vz;
        float x0 = X[0] * scp[0];
        float rr1 = X[XS] * scp[1]; f32x4 L1_0 = *(const LAS f32x4*)(LmV + LS);
        asm volatile("" ::: "memory");
        const float rr2 = X[2 * XS] * scp[2]; const f32x4 L2_0 = *(const LAS f32x4*)(LmV + 2 * LS + 0);
        float x1; { float a0 = rr1, a1 = 0.f, a2 = 0.f, a3 = 0.f; a0 -= L1_0[0] * x0; x1 = (a0 + a1) + (a2 + a3); }
        asm volatile("" ::: "memory");
        const float rr3 = X[3 * XS] * scp[3]; const f32x4 L3_0 = *(const LAS f32x4*)(LmV + 3 * LS + 0);
        float x2; { float a0 = rr2, a1 = 0.f, a2 = 0.f, a3 = 0.f; a0 -= L2_0[0] * x0; a1 -= L2_0[1] * x1; x2 = (a0 + a1) + (a2 + a3); }
        asm volatile("" ::: "memory");
        const float rr4 = X[4 * XS] * scp[4]; const f32x4 L4_0 = *(const LAS f32x4*)(LmV + 4 * LS + 0);
        float x3; { float a0 = rr3, a1 = 0.f, a2 = 0.f, a3 = 0.f; a0 -= L3_0[0] * x0; a1 -= L3_0[1] * x1; a2 -= L3_0[2] * x2; x3 = (a0 + a1) + (a2 + a3); }
        asm volatile("" ::: "memory");
        const float rr5 = X[5 * XS] * scp[5]; const f32x4 L5_0 = *(const LAS f32x4*)(LmV + 5 * LS + 0); const f32x4 L5_1 = *(const LAS f32x4*)(LmV + 5 * LS + 4);
        float x4; { float a0 = rr4, a1 = 0.f, a2 = 0.f, a3 = 0.f; a0 -= L4_0[0] * x0; a1 -= L4_0[1] * x1; a2 -= L4_0[2] * x2; a3 -= L4_0[3] * x3; x4 = (a0 + a1) + (a2 + a3); }
        asm volatile("" ::: "memory");
        const float rr6 = X[6 * XS] * scp[6]; const f32x4 L6_0 = *(const LAS f32x4*)(LmV + 6 * LS + 0); const f32x4 L6_1 = *(const LAS f32x4*)(LmV + 6 * LS + 4);
        float x5; { float a0 = rr5, a1 = 0.f, a2 = 0.f, a3 = 0.f; a0 -= L5_0[0] * x0; a1 -= L5_0[1] * x1; a2 -= L5_0[2] * x2; a3 -= L5_0[3] * x3; a0 -= L5_1[0] * x4; x5 = (a0 + a1) + (a2 + a3); }
        asm volatile("" ::: "memory");
        const float rr7 = X[7 * XS] * scp[7]; const f32x4 L7_0 = *(const LAS f32x4*)(LmV + 7 * LS + 0); const f32x4 L7_1 = *(const LAS f32x4*)(LmV + 7 * LS + 4);
        float x6; { float a0 = rr6, a1 = 0.f, a2 = 0.f, a3 = 0.f; a0 -= L6_0[0] * x0; a1 -= L6_0[1] * x1; a2 -= L6_0[2] * x2; a3 -= L6_0[3] * x3; a0 -= L6_1[0] * x4; a1 -= L6_1[1] * x5; x6 = (a0 + a1) + (a2 + a3); }
        asm volatile("" ::: "memory");
        const float rr8 = X[8 * XS] * scp[8]; const f32x4 L8_0 = *(const LAS f32x4*)(LmV + 8 * LS + 0); const f32x4 L8_1 = *(const LAS f32x4*)(LmV + 8 * LS + 4);
        float x7; { float a0 = rr7, a1 = 0.f, a2 = 0.f, a3 = 0.f; a0 -= L7_0[0] * x0; a1 -= L7_0[1] * x1; a2 -= L7_0[2] * x2; a3 -= L7_0[3] * x3; a0 -= L7_1[0] * x4; a1 -= L7_1[1] * x5; a2 -= L7_1[2] * x6; x7 = (a0 + a1) + (a2 + a3); }
        asm volatile("" ::: "memory");
        const float rr9 = X[9 * XS] * scp[9]; const f32x4 L9_0 = *(const LAS f32x4*)(LmV + 9 * LS + 0); const f32x4 L9_1 = *(const LAS f32x4*)(LmV + 9 * LS + 4);
        float x8; { float a0 = rr8, a1 = 0.f, a2 = 0.f, a3 = 0.f; a0 -= L8_0[0] * x0; a1 -= L8_0[1] * x1; a2 -= L8_0[2] * x2; a3 -= L8_0[3] * x3; a0 -= L8_1[0] * x4; a1 -= L8_1[1] * x5; a2 -= L8_1[2] * x6; a3 -= L8_1[3] * x7; x8 = (a0 + a1) + (a2 + a3); }
        asm volatile("" ::: "memory");
        const float rr10 = X[10 * XS] * scp[10]; const f32x4 L10_0 = *(const LAS f32x4*)(LmV + 10 * LS + 0); const f32x4 L10_1 = *(const LAS f32x4*)(LmV + 10 * LS + 4); const f32x4 L9_2 = *(const LAS f32x4*)(LmV + 9 * LS + 8);
        float x9; { float a0 = rr9, a1 = 0.f, a2 = 0.f, a3 = 0.f; a0 -= L9_0[0] * x0; a1 -= L9_0[1] * x1; a2 -= L9_0[2] * x2; a3 -= L9_0[3] * x3; a0 -= L9_1[0] * x4; a1 -= L9_1[1] * x5; a2 -= L9_1[2] * x6; a3 -= L9_1[3] * x7; a0 -= L9_2[0] * x8; x9 = (a0 + a1) + (a2 + a3); }
        asm volatile("" ::: "memory");
        const float rr11 = X[11 * XS] * scp[11]; const f32x4 L11_0 = *(const LAS f32x4*)(LmV + 11 * LS + 0); const f32x4 L11_1 = *(const LAS f32x4*)(LmV + 11 * LS + 4); const f32x4 L10_2 = *(const LAS f32x4*)(LmV + 10 * LS + 8);
        float x10; { float a0 = rr10, a1 = 0.f, a2 = 0.f, a3 = 0.f; a0 -= L10_0[0] * x0; a1 -= L10_0[1] * x1; a2 -= L10_0[2] * x2; a3 -= L10_0[3] * x3; a0 -= L10_1[0] * x4; a1 -= L10_1[1] * x5; a2 -= L10_1[2] * x6; a3 -= L10_1[3] * x7; a0 -= L10_2[0] * x8; a1 -= L10_2[1] * x9; x10 = (a0 + a1) + (a2 + a3); }
        asm volatile("" ::: "memory");
        const float rr12 = X[12 * XS] * scp[12]; const f32x4 L12_0 = *(const LAS f32x4*)(LmV + 12 * LS + 0); const f32x4 L12_1 = *(const LAS f32x4*)(LmV + 12 * LS + 4); const f32x4 L11_2 = *(const LAS f32x4*)(LmV + 11 * LS + 8);
        float x11; { float a0 = rr11, a1 = 0.f, a2 = 0.f, a3 = 0.f; a0 -= L11_0[0] * x0; a1 -= L11_0[1] * x1; a2 -= L11_0[2] * x2; a3 -= L11_0[3] * x3; a0 -= L11_1[0] * x4; a1 -= L11_1[1] * x5; a2 -= L11_1[2] * x6; a3 -= L11_1[3] * x7; a0 -= L11_2[0] * x8; a1 -= L11_2[1] * x9; a2 -= L11_2[2] * x10; x11 = (a0 + a1) + (a2 + a3); }
        asm volatile("" ::: "memory");
        const float rr13 = X[13 * XS] * scp[13]; const f32x4 L13_0 = *(const LAS f32x4*)(LmV + 13 * LS + 0); const f32x4 L13_1 = *(const LAS f32x4*)(LmV + 13 * LS + 4); const f32x4 L12_2 = *(const LAS f32x4*)(LmV + 12 * LS + 8);
        float x12; { float a0 = rr12, a1 = 0.f, a2 = 0.f, a3 = 0.f; a0 -= L12_0[0] * x0; a1 -= L12_0[1] * x1; a2 -= L12_0[2] * x2; a3 -= L12_0[3] * x3; a0 -= L12_1[0] * x4; a1 -= L12_1[1] * x5; a2 -= L12_1[2] * x6; a3 -= L12_1[3] * x7; a0 -= L12_2[0] * x8; a1 -= L12_2[1] * x9; a2 -= L12_2[2] * x10; a3 -= L12_2[3] * x11; x12 = (a0 + a1) + (a2 + a3); }
        asm volatile("" ::: "memory");
        const float rr14 = X[14 * XS] * scp[14]; const f32x4 L14_0 = *(const LAS f32x4*)(LmV + 14 * LS + 0); const f32x4 L14_1 = *(const LAS f32x4*)(LmV + 14 * LS + 4); const f32x4 L13_2 = *(const LAS f32x4*)(LmV + 13 * LS + 8); const f32x4 L13_3 = *(const LAS f32x4*)(LmV + 13 * LS + 12);
        float x13; { float a0 = rr13, a1 = 0.f, a2 = 0.f, a3 = 0.f; a0 -= L13_0[0] * x0; a1 -= L13_0[1] * x1; a2 -= L13_0[2] * x2; a3 -= L13_0[3] * x3; a0 -= L13_1[0] * x4; a1 -= L13_1[1] * x5; a2 -= L13_1[2] * x6; a3 -= L13_1[3] * x7; a0 -= L13_2[0] * x8; a1 -= L13_2[1] * x9; a2 -= L13_2[2] * x10; a3 -= L13_2[3] * x11; a0 -= L13_3[0] * x12; x13 = (a0 + a1) + (a2 + a3); }
        asm volatile("" ::: "memory");
        const float rr15 = X[15 * XS] * scp[15]; const f32x4 L15_0 = *(const LAS f32x4*)(LmV + 15 * LS + 0); const f32x4 L15_1 = *(const LAS f32x4*)(LmV + 15 * LS + 4); const f32x4 L14_2 = *(const LAS f32x4*)(LmV + 14 * LS + 8); const f32x4 L14_3 = *(const LAS f32x4*)(LmV + 14 * LS + 12);
        float x14; { float a0 = rr14, a1 = 0.f, a2 = 0.f, a3 = 0.f; a0 -= L14_0[0] * x0; a1 -= L14_0[1] * x1; a2 -= L14_0[2] * x2; a3 -= L14_0[3] * x3; a0 -= L14_1[0] * x4; a1 -= L14_1[1] * x5; a2 -= L14_1[2] * x6; a3 -= L14_1[3] * x7; a0 -= L14_2[0] * x8; a1 -= L14_2[1] * x9; a2 -= L14_2[2] * x10; a3 -= L14_2[3] * x11; a0 -= L14_3[0] * x12; a1 -= L14_3[1] * x13; x14 = (a0 + a1) + (a2 + a3); }
        asm volatile("" ::: "memory");
        const float rr16 = X[16 * XS] * scp[16]; const f32x4 L16_0 = *(const LAS f32x4*)(LmV + 16 * LS + 0); const f32x4 L16_1 = *(const LAS f32x4*)(LmV + 16 * LS + 4); const f32x4 L15_2 = *(const LAS f32x4*)(LmV + 15 * LS + 8); const f32x4 L15_3 = *(const LAS f32x4*)(LmV + 15 * LS + 12);
        float x15; { float a0 = rr15, a1 = 0.f, a2 = 0.f, a3 = 0.f; a0 -= L15_0[0] * x0; a1 -= L15_0[1] * x1; a2 -= L15_0[2] * x2; a3 -= L15_0[3] * x3; a0 -= L15_1[0] * x4; a1 -= L15_1[1] * x5; a2 -= L15_1[2] * x6; a3 -= L15_1[3] * x7; a0 -= L15_2[0] * x8; a1 -= L15_2[1] * x9; a2 -= L15_2[2] * x10; a3 -= L15_2[3] * x11; a0 -= L15_3[0] * x12; a1 -= L15_3[1] * x13; a2 -= L15_3[2] * x14; x15 = (a0 + a1) + (a2 + a3); }
        asm volatile("" ::: "memory");
        const float rr17 = X[17 * XS] * scp[17]; const f32x4 L17_0 = *(const LAS f32x4*)(LmV + 17 * LS + 0); const f32x4 L17_1 = *(const LAS f32x4*)(LmV + 17 * LS + 4); const f32x4 L16_2 = *(const LAS f32x4*)(LmV + 16 * LS + 8); const f32x4 L16_3 = *(const LAS f32x4*)(LmV + 16 * LS + 12);
        float x16; { float a0 = rr16, a1 = 0.f, a2 = 0.f, a3 = 0.f; a0 -= L16_0[0] * x0; a1 -= L16_0[1] * x1; a2 -= L16_0[2] * x2; a3 -= L16_0[3] * x3; a0 -= L16_1[0] * x4; a1 -= L16_1[1] * x5; a2 -= L16_1[2] * x6; a3 -= L16_1[3] * x7; a0 -= L16_2[0] * x8; a1 -= L16_2[1] * x9; a2 -= L16_2[2] * x10; a3 -= L16_2[3] * x11; a0 -= L16_3[0] * x12; a1 -= L16_3[1] * x13; a2 -= L16_3[2] * x14; a3 -= L16_3[3] * x15; x16 = (a0 + a1) + (a2 + a3); }
        asm volatile("" ::: "memory");
        const float rr18 = X[18 * XS] * scp[18]; const f32x4 L18_0 = *(const LAS f32x4*)(LmV + 18 * LS + 0); const f32x4 L18_1 = *(const LAS f32x4*)(LmV + 18 * LS + 4); const f32x4 L17_2 = *(const LAS f32x4*)(LmV + 17 * LS + 8); const f32x4 L17_3 = *(const LAS f32x4*)(LmV + 17 * LS + 12); const f32x4 L17_4 = *(const LAS f32x4*)(LmV + 17 * LS + 16);
        float x17; { float a0 = rr17, a1 = 0.f, a2 = 0.f, a3 = 0.f; a0 -= L17_0[0] * x0; a1 -= L17_0[1] * x1; a2 -= L17_0[2] * x2; a3 -= L17_0[3] * x3; a0 -= L17_1[0] * x4; a1 -= L17_1[1] * x5; a2 -= L17_1[2] * x6; a3 -= L17_1[3] * x7; a0 -= L17_2[0] * x8; a1 -= L17_2[1] * x9; a2 -= L17_2[2] * x10; a3 -= L17_2[3] * x11; a0 -= L17_3[0] * x12; a1 -= L17_3[1] * x13; a2 -= L17_3[2] * x14; a3 -= L17_3[3] * x15; a0 -= L17_4[0] * x16; x17 = (a0 + a1) + (a2 + a3); }
        asm volatile("" ::: "memory");
        const float rr19 = X[19 * XS] * scp[19]; const f32x4 L19_0 = *(const LAS f32x4*)(LmV + 19 * LS + 0); const f32x4 L19_1 = *(const LAS f32x4*)(LmV + 19 * LS + 4); const f32x4 L18_2 = *(const LAS f32x4*)(LmV + 18 * LS + 8); const f32x4 L18_3 = *(const LAS f32x4*)(LmV + 18 * LS + 12); const f32x4 L18_4 = *(const LAS f32x4*)(LmV + 18 * LS + 16);
        float x18; { float a0 = rr18, a1 = 0.f, a2 = 0.f, a3 = 0.f; a0 -= L18_0[0] * x0; a1 -= L18_0[1] * x1; a2 -= L18_0[2] * x2; a3 -= L18_0[3] * x3; a0 -= L18_1[0] * x4; a1 -= L18_1[1] * x5; a2 -= L18_1[2] * x6; a3 -= L18_1[3] * x7; a0 -= L18_2[0] * x8; a1 -= L18_2[1] * x9; a2 -= L18_2[2] * x10; a3 -= L18_2[3] * x11; a0 -= L18_3[0] * x12; a1 -= L18_3[1] * x13; a2 -= L18_3[2] * x14; a3 -= L18_3[3] * x15; a0 -= L18_4[0] * x16; a1 -= L18_4[1] * x17; x18 = (a0 + a1) + (a2 + a3); }
        asm volatile("" ::: "memory");
        const float rr20 = X[20 * XS] * scp[20]; const f32x4 L20_0 = *(const LAS f32x4*)(LmV + 20 * LS + 0); const f32x4 L20_1 = *(const LAS f32x4*)(LmV + 20 * LS + 4); const f32x4 L19_2 = *(const LAS f32x4*)(LmV + 19 * LS + 8); const f32x4 L19_3 = *(const LAS f32x4*)(LmV + 19 * LS + 12); const f32x4 L19_4 = *(const LAS f32x4*)(LmV + 19 * LS + 16);
        float x19; { float a0 = rr19, a1 = 0.f, a2 = 0.f, a3 = 0.f; a0 -= L19_0[0] * x0; a1 -= L19_0[1] * x1; a2 -= L19_0[2] * x2; a3 -= L19_0[3] * x3; a0 -= L19_1[0] * x4; a1 -= L19_1[1] * x5; a2 -= L19_1[2] * x6; a3 -= L19_1[3] * x7; a0 -= L19_2[0] * x8; a1 -= L19_2[1] * x9; a2 -= L19_2[2] * x10; a3 -= L19_2[3] * x11; a0 -= L19_3[0] * x12; a1 -= L19_3[1] * x13; a2 -= L19_3[2] * x14; a3 -= L19_3[3] * x15; a0 -= L19_4[0] * x16; a1 -= L19_4[1] * x17; a2 -= L19_4[2] * x18; x19 = (a0 + a1) + (a2 + a3); }
        asm volatile("" ::: "memory");
        const float rr21 = X[21 * XS] * scp[21]; const f32x4 L21_0 = *(const LAS f32x4*)(LmV + 21 * LS + 0); const f32x4 L21_1 = *(const LAS f32x4*)(LmV + 21 * LS + 4); const f32x4 L20_2 = *(const LAS f32x4*)(LmV + 20 * LS + 8); const f32x4 L20_3 = *(const LAS f32x4*)(LmV + 20 * LS + 12); const f32x4 L20_4 = *(const LAS f32x4*)(LmV + 20 * LS + 16);
        float x20; { float a0 = rr20, a1 = 0.f, a2 = 0.f, a3 = 0.f; a0 -= L20_0[0] * x0; a1 -= L20_0[1] * x1; a2 -= L20_0[2] * x2; a3 -= L20_0[3] * x3; a0 -= L20_1[0] * x4; a1 -= L20_1[1] * x5; a2 -= L20_1[2] * x6; a3 -= L20_1[3] * x7; a0 -= L20_2[0] * x8; a1 -= L20_2[1] * x9; a2 -= L20_2[2] * x10; a3 -= L20_2[3] * x11; a0 -= L20_3[0] * x12; a1 -= L20_3[1] * x13; a2 -= L20_3[2] * x14; a3 -= L20_3[3] * x15; a0 -= L20_4[0] * x16; a1 -= L20_4[1] * x17; a2 -= L20_4[2] * x18; a3 -= L20_4[3] * x19; x20 = (a0 + a1) + (a2 + a3); }
        asm volatile("" ::: "memory");
        const float rr22 = X[22 * XS] * scp[22]; const f32x4 L22_0 = *(const LAS f32x4*)(LmV + 22 * LS + 0); const f32x4 L22_1 = *(const LAS f32x4*)(LmV + 22 * LS + 4); const f32x4 L21_2 = *(const LAS f32x4*)(LmV + 21 * LS + 8); const f32x4 L21_3 = *(const LAS f32x4*)(LmV + 21 * LS + 12); const f32x4 L21_4 = *(const LAS f32x4*)(LmV + 21 * LS + 16); const f32x4 L21_5 = *(const LAS f32x4*)(LmV + 21 * LS + 20);
        float x21; { float a0 = rr21, a1 = 0.f, a2 = 0.f, a3 = 0.f; a0 -= L21_0[0] * x0; a1 -= L21_0[1] * x1; a2 -= L21_0[2] * x2; a3 -= L21_0[3] * x3; a0 -= L21_1[0] * x4; a1 -= L21_1[1] * x5; a2 -= L21_1[2] * x6; a3 -= L21_1[3] * x7; a0 -= L21_2[0] * x8; a1 -= L21_2[1] * x9; a2 -= L21_2[2] * x10; a3 -= L21_2[3] * x11; a0 -= L21_3[0] * x12; a1 -= L21_3[1] * x13; a2 -= L21_3[2] * x14; a3 -= L21_3[3] * x15; a0 -= L21_4[0] * x16; a1 -= L21_4[1] * x17; a2 -= L21_4[2] * x18; a3 -= L21_4[3] * x19; a0 -= L21_5[0] * x20; x21 = (a0 + a1) + (a2 + a3); }
        asm volatile("" ::: "memory");
        const float rr23 = X[23 * XS] * scp[23]; const f32x4 L23_0 = *(const LAS f32x4*)(LmV + 23 * LS + 0); const f32x4 L23_1 = *(const LAS f32x4*)(LmV + 23 * LS + 4); const f32x4 L22_2 = *(const LAS f32x4*)(LmV + 22 * LS + 8); const f32x4 L22_3 = *(const LAS f32x4*)(LmV + 22 * LS + 12); const f32x4 L22_4 = *(const LAS f32x4*)(LmV + 22 * LS + 16); const f32x4 L22_5 = *(const LAS f32x4*)(LmV + 22 * LS + 20);
        float x22; { float a0 = rr22, a1 = 0.f, a2 = 0.f, a3 = 0.f; a0 -= L22_0[0] * x0; a1 -= L22_0[1] * x1; a2 -= L22_0[2] * x2; a3 -= L22_0[3] * x3; a0 -= L22_1[0] * x4; a1 -= L22_1[1] * x5; a2 -= L22_1[2] * x6; a3 -= L22_1[3] * x7; a0 -= L22_2[0] * x8; a1 -= L22_2[1] * x9; a2 -= L22_2[2] * x10; a3 -= L22_2[3] * x11; a0 -= L22_3[0] * x12; a1 -= L22_3[1] * x13; a2 -= L22_3[2] * x14; a3 -= L22_3[3] * x15; a0 -= L22_4[0] * x16; a1 -= L22_4[1] * x17; a2 -= L22_4[2] * x18; a3 -= L22_4[3] * x19; a0 -= L22_5[0] * x20; a1 -= L22_5[1] * x21; x22 = (a0 + a1) + (a2 + a3); }
        asm volatile("" ::: "memory");
        const float rr24 = X[24 * XS] * scp[24]; const f32x4 L24_0 = *(const LAS f32x4*)(LmV + 24 * LS + 0); const f32x4 L24_1 = *(const LAS f32x4*)(LmV + 24 * LS + 4); const f32x4 L23_2 = *(const LAS f32x4*)(LmV + 23 * LS + 8); const f32x4 L23_3 = *(const LAS f32x4*)(LmV + 23 * LS + 12); const f32x4 L23_4 = *(const LAS f32x4*)(LmV + 23 * LS + 16); const f32x4 L23_5 = *(const LAS f32x4*)(LmV + 23 * LS + 20);
        float x23; { float a0 = rr23, a1 = 0.f, a2 = 0.f, a3 = 0.f; a0 -= L23_0[0] * x0; a1 -= L23_0[1] * x1; a2 -= L23_0[2] * x2; a3 -= L23_0[3] * x3; a0 -= L23_1[0] * x4; a1 -= L23_1[1] * x5; a2 -= L23_1[2] * x6; a3 -= L23_1[3] * x7; a0 -= L23_2[0] * x8; a1 -= L23_2[1] * x9; a2 -= L23_2[2] * x10; a3 -= L23_2[3] * x11; a0 -= L23_3[0] * x12; a1 -= L23_3[1] * x13; a2 -= L23_3[2] * x14; a3 -= L23_3[3] * x15; a0 -= L23_4[0] * x16; a1 -= L23_4[1] * x17; a2 -= L23_4[2] * x18; a3 -= L23_4[3] * x19; a0 -= L23_5[0] * x20; a1 -= L23_5[1] * x21; a2 -= L23_5[2] * x22; x23 = (a0 + a1) + (a2 + a3); }
        asm volatile("" ::: "memory");
        const float rr25 = X[25 * XS] * scp[25]; const f32x4 L25_0 = *(const LAS f32x4*)(LmV + 25 * LS + 0); const f32x4 L25_1 = *(const LAS f32x4*)(LmV + 25 * LS + 4); const f32x4 L24_2 = *(const LAS f32x4*)(LmV + 24 * LS + 8); const f32x4 L24_3 = *(const LAS f32x4*)(LmV + 24 * LS + 12); const f32x4 L24_4 = *(const LAS f32x4*)(LmV + 24 * LS + 16); const f32x4 L24_5 = *(const LAS f32x4*)(LmV + 24 * LS + 20);
        float x24; { float a0 = rr24, a1 = 0.f, a2 = 0.f, a3 = 0.f; a0 -= L24_0[0] * x0; a1 -= L24_0[1] * x1; a2 -= L24_0[2] * x2; a3 -= L24_0[3] * x3; a0 -= L24_1[0] * x4; a1 -= L24_1[1] * x5; a2 -= L24_1[2] * x6; a3 -= L24_1[3] * x7; a0 -= L24_2[0] * x8; a1 -= L24_2[1] * x9; a2 -= L24_2[2] * x10; a3 -= L24_2[3] * x11; a0 -= L24_3[0] * x12; a1 -= L24_3[1] * x13; a2 -= L24_3[2] * x14; a3 -= L24_3[3] * x15; a0 -= L24_4[0] * x16; a1 -= L24_4[1] * x17; a2 -= L24_4[2] * x18; a3 -= L24_4[3] * x19; a0 -= L24_5[0] * x20; a1 -= L24_5[1] * x21; a2 -= L24_5[2] * x22; a3 -= L24_5[3] * x23; x24 = (a0 + a1) + (a2 + a3); }
        asm volatile("" ::: "memory");
        const float rr26 = X[26 * XS] * scp[26]; const f32x4 L26_0 = *(const LAS f32x4*)(LmV + 26 * LS + 0); const f32x4 L26_1 = *(const LAS f32x4*)(LmV + 26 * LS + 4); const f32x4 L25_2 = *(const LAS f32x4*)(LmV + 25 * LS + 8); const f32x4 L25_3 = *(const LAS f32x4*)(LmV + 25 * LS + 12); const f32x4 L25_4 = *(const LAS f32x4*)(LmV + 25 * LS + 16); const f32x4 L25_5 = *(const LAS f32x4*)(LmV + 25 * LS + 20); const f32x4 L25_6 = *(const LAS f32x4*)(LmV + 25 * LS + 24);
        float x25; { float a0 = rr25, a1 = 0.f, a2 = 0.f, a3 = 0.f; a0 -= L25_0[0] * x0; a1 -= L25_0[1] * x1; a2 -= L25_0[2] * x2; a3 -= L25_0[3] * x3; a0 -= L25_1[0] * x4; a1 -= L25_1[1] * x5; a2 -= L25_1[2] * x6; a3 -= L25_1[3] * x7; a0 -= L25_2[0] * x8; a1 -= L25_2[1] * x9; a2 -= L25_2[2] * x10; a3 -= L25_2[3] * x11; a0 -= L25_3[0] * x12; a1 -= L25_3[1] * x13; a2 -= L25_3[2] * x14; a3 -= L25_3[3] * x15; a0 -= L25_4[0] * x16; a1 -= L25_4[1] * x17; a2 -= L25_4[2] * x18; a3 -= L25_4[3] * x19; a0 -= L25_5[0] * x20; a1 -= L25_5[1] * x21; a2 -= L25_5[2] * x22; a3 -= L25_5[3] * x23; a0 -= L25_6[0] * x24; x25 = (a0 + a1) + (a2 + a3); }
        asm volatile("" ::: "memory");
        const float rr27 = X[27 * XS] * scp[27]; const f32x4 L27_0 = *(const LAS f32x4*)(LmV + 27 * LS + 0); const f32x4 L27_1 = *(const LAS f32x4*)(LmV + 27 * LS + 4); const f32x4 L26_2 = *(const LAS f32x4*)(LmV + 26 * LS + 8); const f32x4 L26_3 = *(const LAS f32x4*)(LmV + 26 * LS + 12); const f32x4 L26_4 = *(const LAS f32x4*)(LmV + 26 * LS + 16); const f32x4 L26_5 = *(const LAS f32x4*)(LmV + 26 * LS + 20); const f32x4 L26_6 = *(const LAS f32x4*)(LmV + 26 * LS + 24);
        float x26; { float a0 = rr26, a1 = 0.f, a2 = 0.f, a3 = 0.f; a0 -= L26_0[0] * x0; a1 -= L26_0[1] * x1; a2 -= L26_0[2] * x2; a3 -= L26_0[3] * x3; a0 -= L26_1[0] * x4; a1 -= L26_1[1] * x5; a2 -= L26_1[2] * x6; a3 -= L26_1[3] * x7; a0 -= L26_2[0] * x8; a1 -= L26_2[1] * x9; a2 -= L26_2[2] * x10; a3 -= L26_2[3] * x11; a0 -= L26_3[0] * x12; a1 -= L26_3[1] * x13; a2 -= L26_3[2] * x14; a3 -= L26_3[3] * x15; a0 -= L26_4[0] * x16; a1 -= L26_4[1] * x17; a2 -= L26_4[2] * x18; a3 -= L26_4[3] * x19; a0 -= L26_5[0] * x20; a1 -= L26_5[1] * x21; a2 -= L26_5[2] * x22; a3 -= L26_5[3] * x23; a0 -= L26_6[0] * x24; a1 -= L26_6[1] * x25; x26 = (a0 + a1) + (a2 + a3); }
        asm volatile("" ::: "memory");
        const float rr28 = X[28 * XS] * scp[28]; const f32x4 L28_0 = *(const LAS f32x4*)(LmV + 28 * LS + 0); const f32x4 L28_1 = *(const LAS f32x4*)(LmV + 28 * LS + 4); const f32x4 L27_2 = *(const LAS f32x4*)(LmV + 27 * LS + 8); const f32x4 L27_3 = *(const LAS f32x4*)(LmV + 27 * LS + 12); const f32x4 L27_4 = *(const LAS f32x4*)(LmV + 27 * LS + 16); const f32x4 L27_5 = *(const LAS f32x4*)(LmV + 27 * LS + 20); const f32x4 L27_6 = *(const LAS f32x4*)(LmV + 27 * LS + 24);
        float x27; { float a0 = rr27, a1 = 0.f, a2 = 0.f, a3 = 0.f; a0 -= L27_0[0] * x0; a1 -= L27_0[1] * x1; a2 -= L27_0[2] * x2; a3 -= L27_0[3] * x3; a0 -= L27_1[0] * x4; a1 -= L27_1[1] * x5; a2 -= L27_1[2] * x6; a3 -= L27_1[3] * x7; a0 -= L27_2[0] * x8; a1 -= L27_2[1] * x9; a2 -= L27_2[2] * x10; a3 -= L27_2[3] * x11; a0 -= L27_3[0] * x12; a1 -= L27_3[1] * x13; a2 -= L27_3[2] * x14; a3 -= L27_3[3] * x15; a0 -= L27_4[0] * x16; a1 -= L27_4[1] * x17; a2 -= L27_4[2] * x18; a3 -= L27_4[3] * x19; a0 -= L27_5[0] * x20; a1 -= L27_5[1] * x21; a2 -= L27_5[2] * x22; a3 -= L27_5[3] * x23; a0 -= L27_6[0] * x24; a1 -= L27_6[1] * x25; a2 -= L27_6[2] * x26; x27 = (a0 + a1) + (a2 + a3); }
        asm volatile("" ::: "memory");
        const float rr29 = X[29 * XS] * scp[29]; const f32x4 L29_0 = *(const LAS f32x4*)(LmV + 29 * LS + 0); const f32x4 L29_1 = *(const LAS f32x4*)(LmV + 29 * LS + 4); const f32x4 L28_2 = *(const LAS f32x4*)(LmV + 28 * LS + 8); const f32x4 L28_3 = *(const LAS f32x4*)(LmV + 28 * LS + 12); const f32x4 L28_4 = *(const LAS f32x4*)(LmV + 28 * LS + 16); const f32x4 L28_5 = *(const LAS f32x4*)(LmV + 28 * LS + 20); const f32x4 L28_6 = *(const LAS f32x4*)(LmV + 28 * LS + 24);
        float x28; { float a0 = rr28, a1 = 0.f, a2 = 0.f, a3 = 0.f; a0 -= L28_0[0] * x0; a1 -= L28_0[1] * x1; a2 -= L28_0[2] * x2; a3 -= L28_0[3] * x3; a0 -= L28_1[0] * x4; a1 -= L28_1[1] * x5; a2 -= L28_1[2] * x6; a3 -= L28_1[3] * x7; a0 -= L28_2[0] * x8; a1 -= L28_2[1] * x9; a2 -= L28_2[2] * x10; a3 -= L28_2[3] * x11; a0 -= L28_3[0] * x12; a1 -= L28_3[1] * x13; a2 -= L28_3[2] * x14; a3 -= L28_3[3] * x15; a0 -= L28_4[0] * x16; a1 -= L28_4[1] * x17; a2 -= L28_4[2] * x18; a3 -= L28_4[3] * x19; a0 -= L28_5[0] * x20; a1 -= L28_5[1] * x21; a2 -= L28_5[2] * x22; a3 -= L28_5[3] * x23; a0 -= L28_6[0] * x24; a1 -= L28_6[1] * x25; a2 -= L28_6[2] * x26; a3 -= L28_6[3] * x27; x28 = (a0 + a1) + (a2 + a3); }
        asm volatile("" ::: "memory");
        const float rr30 = X[30 * XS] * scp[30]; const f32x4 L30_0 = *(const LAS f32x4*)(LmV + 30 * LS + 0); const f32x4 L30_1 = *(const LAS f32x4*)(LmV + 30 * LS + 4); const f32x4 L29_2 = *(const LAS f32x4*)(LmV + 29 * LS + 8); const f32x4 L29_3 = *(const LAS f32x4*)(LmV + 29 * LS + 12); const f32x4 L29_4 = *(const LAS f32x4*)(LmV + 29 * LS + 16); const f32x4 L29_5 = *(const LAS f32x4*)(LmV + 29 * LS + 20); const f32x4 L29_6 = *(const LAS f32x4*)(LmV + 29 * LS + 24); const f32x4 L29_7 = *(const LAS f32x4*)(LmV + 29 * LS + 28);
        float x29; { float a0 = rr29, a1 = 0.f, a2 = 0.f, a3 = 0.f; a0 -= L29_0[0] * x0; a1 -= L29_0[1] * x1; a2 -= L29_0[2] * x2; a3 -= L29_0[3] * x3; a0 -= L29_1[0] * x4; a1 -= L29_1[1] * x5; a2 -= L29_1[2] * x6; a3 -= L29_1[3] * x7; a0 -= L29_2[0] * x8; a1 -= L29_2[1] * x9; a2 -= L29_2[2] * x10; a3 -= L29_2[3] * x11; a0 -= L29_3[0] * x12; a1 -= L29_3[1] * x13; a2 -= L29_3[2] * x14; a3 -= L29_3[3] * x15; a0 -= L29_4[0] * x16; a1 -= L29_4[1] * x17; a2 -= L29_4[2] * x18; a3 -= L29_4[3] * x19; a0 -= L29_5[0] * x20; a1 -= L29_5[1] * x21; a2 -= L29_5[2] * x22; a3 -= L29_5[3] * x23; a0 -= L29_6[0] * x24; a1 -= L29_6[1] * x25; a2 -= L29_6[2] * x26; a3 -= L29_6[3] * x27; a0 -= L29_7[0] * x28; x29 = (a0 + a1) + (a2 + a3); }
        asm volatile("" ::: "memory");
        const float rr31 = X[31 * XS] * scp[31]; const f32x4 L31_0 = *(const LAS f32x4*)(LmV + 31 * LS + 0); const f32x4 L31_1 = *(const LAS f32x4*)(LmV + 31 * LS + 4); const f32x4 L30_2 = *(const LAS f32x4*)(LmV + 30 * LS + 8); const f32x4 L30_3 = *(const LAS f32x4*)(LmV + 30 * LS + 12); const f32x4 L30_4 = *(const LAS f32x4*)(LmV + 30 * LS + 16); const f32x4 L30_5 = *(const LAS f32x4*)(LmV + 30 * LS + 20); const f32x4 L30_6 = *(const LAS f32x4*)(LmV + 30 * LS + 24); const f32x4 L30_7 = *(const LAS f32x4*)(LmV + 30 * LS + 28);
        float x30; { float a0 = rr30, a1 = 0.f, a2 = 0.f, a3 = 0.f; a0 -= L30_0[0] * x0; a1 -= L30_0[1] * x1; a2 -= L30_0[2] * x2; a3 -= L30_0[3] * x3; a0 -= L30_1[0] * x4; a1 -= L30_1[1] * x5; a2 -= L30_1[2] * x6; a3 -= L30_1[3] * x7; a0 -= L30_2[0] * x8; a1 -= L30_2[1] * x9; a2 -= L30_2[2] * x10; a3 -= L30_2[3] * x11; a0 -= L30_3[0] * x12; a1 -= L30_3[1] * x13; a2 -= L30_3[2] * x14; a3 -= L30_3[3] * x15; a0 -= L30_4[0] * x16; a1 -= L30_4[1] * x17; a2 -= L30_4[2] * x18; a3 -= L30_4[3] * x19; a0 -= L30_5[0] * x20; a1 -= L30_5[1] * x21; a2 -= L30_5[2] * x22; a3 -= L30_5[3] * x23; a0 -= L30_6[0] * x24; a1 -= L30_6[1] * x25; a2 -= L30_6[2] * x26; a3 -= L30_6[3] * x27; a0 -= L30_7[0] * x28; a1 -= L30_7[1] * x29; x30 = (a0 + a1) + (a2 + a3); }
        asm volatile("" ::: "memory");
        const float rr32 = X[32 * XS] * scp[32]; const f32x4 L32_0 = *(const LAS f32x4*)(LmV + 32 * LS + 0); const f32x4 L32_1 = *(const LAS f32x4*)(LmV + 32 * LS + 4); const f32x4 L31_2 = *(const LAS f32x4*)(LmV + 31 * LS + 8); const f32x4 L31_3 = *(const LAS f32x4*)(LmV + 31 * LS + 12); const f32x4 L31_4 = *(const LAS f32x4*)(LmV + 31 * LS + 16); const f32x4 L31_5 = *(const LAS f32x4*)(LmV + 31 * LS + 20); const f32x4 L31_6 = *(const LAS f32x4*)(LmV + 31 * LS + 24); const f32x4 L31_7 = *(const LAS f32x4*)(LmV + 31 * LS + 28);
        float x31; { float a0 = rr31, a1 = 0.f, a2 = 0.f, a3 = 0.f; a0 -= L31_0[0] * x0; a1 -= L31_0[1] * x1; a2 -= L31_0[2] * x2; a3 -= L31_0[3] * x3; a0 -= L31_1[0] * x4; a1 -= L31_1[1] * x5; a2 -= L31_1[2] * x6; a3 -= L31_1[3] * x7; a0 -= L31_2[0] * x8; a1 -= L31_2[1] * x9; a2 -= L31_2[2] * x10; a3 -= L31_2[3] * x11; a0 -= L31_3[0] * x12; a1 -= L31_3[1] * x13; a2 -= L31_3[2] * x14; a3 -= L31_3[3] * x15; a0 -= L31_4[0] * x16; a1 -= L31_4[1] * x17; a2 -= L31_4[2] * x18; a3 -= L31_4[3] * x19; a0 -= L31_5[0] * x20; a1 -= L31_5[1] * x21; a2 -= L31_5[2] * x22; a3 -= L31_5[3] * x23; a0 -= L31_6[0] * x24; a1 -= L31_6[1] * x25; a2 -= L31_6[2] * x26; a3 -= L31_6[3] * x27; a0 -= L31_7[0] * x28; a1 -= L31_7[1] * x29; a2 -= L31_7[2] * x30; x31 = (a0 + a1) + (a2 + a3); }
        asm volatile("" ::: "memory");
        const float rr33 = X[33 * XS] * scp[33]; const f32x4 L33_0 = *(const LAS f32x4*)(LmV + 33 * LS + 0); const f32x4 L33_1 = *(const LAS f32x4*)(LmV + 33 * LS + 4); const f32x4 L32_2 = *(const LAS f32x4*)(LmV + 32 * LS + 8); const f32x4 L32_3 = *(const LAS f32x4*)(LmV + 32 * LS + 12); const f32x4 L32_4 = *(const LAS f32x4*)(LmV + 32 * LS + 16); const f32x4 L32_5 = *(const LAS f32x4*)(LmV + 32 * LS + 20); const f32x4 L32_6 = *(const LAS f32x4*)(LmV + 32 * LS + 24); const f32x4 L32_7 = *(const LAS f32x4*)(LmV + 32 * LS + 28);
        float x32; { float a0 = rr32, a1 = 0.f, a2 = 0.f, a3 = 0.f; a0 -= L32_0[0] * x0; a1 -= L32_0[1] * x1; a2 -= L32_0[2] * x2; a3 -= L32_0[3] * x3; a0 -= L32_1[0] * x4; a1 -= L32_1[1] * x5; a2 -= L32_1[2] * x6; a3 -= L32_1[3] * x7; a0 -= L32_2[0] * x8; a1 -= L32_2[1] * x9; a2 -= L32_2[2] * x10; a3 -= L32_2[3] * x11; a0 -= L32_3[0] * x12; a1 -= L32_3[1] * x13; a2 -= L32_3[2] * x14; a3 -= L32_3[3] * x15; a0 -= L32_4[0] * x16; a1 -= L32_4[1] * x17; a2 -= L32_4[2] * x18; a3 -= L32_4[3] * x19; a0 -= L32_5[0] * x20; a1 -= L32_5[1] * x21; a2 -= L32_5[2] * x22; a3 -= L32_5[3] * x23; a0 -= L32_6[0] * x24; a1 -= L32_6[1] * x25; a2 -= L32_6[2] * x26; a3 -= L32_6[3] * x27; a0 -= L32_7[0] * x28; a1 -= L32_7[1] * x29; a2 -= L32_7[2] * x30; a3 -= L32_7[3] * x31; x32 = (a0 + a1) + (a2 + a3); }
        asm volatile("" ::: "memory");
        const float rr34 = X[34 * XS] * scp[34]; const f32x4 L34_0 = *(const LAS f32x4*)(LmV + 34 * LS + 0); const f32x4 L34_1 = *(const LAS f32x4*)(LmV + 34 * LS + 4); const f32x4 L33_2 = *(const LAS f32x4*)(LmV + 33 * LS + 8); const f32x4 L33_3 = *(const LAS f32x4*)(LmV + 33 * LS + 12); const f32x4 L33_4 = *(const LAS f32x4*)(LmV + 33 * LS + 16); const f32x4 L33_5 = *(const LAS f32x4*)(LmV + 33 * LS + 20); const f32x4 L33_6 = *(const LAS f32x4*)(LmV + 33 * LS + 24); const f32x4 L33_7 = *(const LAS f32x4*)(LmV + 33 * LS + 28); const f32x4 L33_8 = *(const LAS f32x4*)(LmV + 33 * LS + 32);
        float x33; { float a0 = rr33, a1 = 0.f, a2 = 0.f, a3 = 0.f; a0 -= L33_0[0] * x0; a1 -= L33_0[1] * x1; a2 -= L33_0[2] * x2; a3 -= L33_0[3] * x3; a0 -= L33_1[0] * x4; a1 -= L33_1[1] * x5; a2 -= L33_1[2] * x6; a3 -= L33_1[3] * x7; a0 -= L33_2[0] * x8; a1 -= L33_2[1] * x9; a2 -= L33_2[2] * x10; a3 -= L33_2[3] * x11; a0 -= L33_3[0] * x12; a1 -= L33_3[1] * x13; a2 -= L33_3[2] * x14; a3 -= L33_3[3] * x15; a0 -= L33_4[0] * x16; a1 -= L33_4[1] * x17; a2 -= L33_4[2] * x18; a3 -= L33_4[3] * x19; a0 -= L33_5[0] * x20; a1 -= L33_5[1] * x21; a2 -= L33_5[2] * x22; a3 -= L33_5[3] * x23; a0 -= L33_6[0] * x24; a1 -= L33_6[1] * x25; a2 -= L33_6[2] * x26; a3 -= L33_6[3] * x27; a0 -= L33_7[0] * x28; a1 -= L33_7[1] * x29; a2 -= L33_7[2] * x30; a3 -= L33_7[3] * x31; a0 -= L33_8[0] * x32; x33 = (a0 + a1) + (a2 + a3); }
        asm volatile("" ::: "memory");
        const float rr35 = X[35 * XS] * scp[35]; const f32x4 L35_0 = *(const LAS f32x4*)(LmV + 35 * LS + 0); const f32x4 L35_1 = *(const LAS f32x4*)(LmV + 35 * LS + 4); const f32x4 L34_2 = *(const LAS f32x4*)(LmV + 34 * LS + 8); const f32x4 L34_3 = *(const LAS f32x4*)(LmV + 34 * LS + 12); const f32x4 L34_4 = *(const LAS f32x4*)(LmV + 34 * LS + 16); const f32x4 L34_5 = *(const LAS f32x4*)(LmV + 34 * LS + 20); const f32x4 L34_6 = *(const LAS f32x4*)(LmV + 34 * LS + 24); const f32x4 L34_7 = *(const LAS f32x4*)(LmV + 34 * LS + 28); const f32x4 L34_8 = *(const LAS f32x4*)(LmV + 34 * LS + 32);
        float x34; { float a0 = rr34, a1 = 0.f, a2 = 0.f, a3 = 0.f; a0 -= L34_0[0] * x0; a1 -= L34_0[1] * x1; a2 -= L34_0[2] * x2; a3 -= L34_0[3] * x3; a0 -= L34_1[0] * x4; a1 -= L34_1[1] * x5; a2 -= L34_1[2] * x6; a3 -= L34_1[3] * x7; a0 -= L34_2[0] * x8; a1 -= L34_2[1] * x9; a2 -= L34_2[2] * x10; a3 -= L34_2[3] * x11; a0 -= L34_3[0] * x12; a1 -= L34_3[1] * x13; a2 -= L34_3[2] * x14; a3 -= L34_3[3] * x15; a0 -= L34_4[0] * x16; a1 -= L34_4[1] * x17; a2 -= L34_4[2] * x18; a3 -= L34_4[3] * x19; a0 -= L34_5[0] * x20; a1 -= L34_5[1] * x21; a2 -= L34_5[2] * x22; a3 -= L34_5[3] * x23; a0 -= L34_6[0] * x24; a1 -= L34_6[1] * x25; a2 -= L34_6[2] * x26; a3 -= L34_6[3] * x27; a0 -= L34_7[0] * x28; a1 -= L34_7[1] * x29; a2 -= L34_7[2] * x30; a3 -= L34_7[3] * x31; a0 -= L34_8[0] * x32; a1 -= L34_8[1] * x33; x34 = (a0 + a1) + (a2 + a3); }
        asm volatile("" ::: "memory");
        const float rr36 = X[36 * XS] * scp[36]; const f32x4 L36_0 = *(const LAS f32x4*)(LmV + 36 * LS + 0); const f32x4 L36_1 = *(const LAS f32x4*)(LmV + 36 * LS + 4); const f32x4 L35_2 = *(const LAS f32x4*)(LmV + 35 * LS + 8); const f32x4 L35_3 = *(const LAS f32x4*)(LmV + 35 * LS + 12); const f32x4 L35_4 = *(const LAS f32x4*)(LmV + 35 * LS + 16); const f32x4 L35_5 = *(const LAS f32x4*)(LmV + 35 * LS + 20); const f32x4 L35_6 = *(const LAS f32x4*)(LmV + 35 * LS + 24); const f32x4 L35_7 = *(const LAS f32x4*)(LmV + 35 * LS + 28); const f32x4 L35_8 = *(const LAS f32x4*)(LmV + 35 * LS + 32);
        float x35; { float a0 = rr35, a1 = 0.f, a2 = 0.f, a3 = 0.f; a0 -= L35_0[0] * x0; a1 -= L35_0[1] * x1; a2 -= L35_0[2] * x2; a3 -= L35_0[3] * x3; a0 -= L35_1[0] * x4; a1 -= L35_1[1] * x5; a2 -= L35_1[2] * x6; a3 -= L35_1[3] * x7; a0 -= L35_2[0] * x8; a1 -= L35_2[1] * x9; a2 -= L35_2[2] * x10; a3 -= L35_2[3] * x11; a0 -= L35_3[0] * x12; a1 -= L35_3[1] * x13; a2 -= L35_3[2] * x14; a3 -= L35_3[3] * x15; a0 -= L35_4[0] * x16; a1 -= L35_4[1] * x17; a2 -= L35_4[2] * x18; a3 -= L35_4[3] * x19; a0 -= L35_5[0] * x20; a1 -= L35_5[1] * x21; a2 -= L35_5[2] * x22; a3 -= L35_5[3] * x23; a0 -= L35_6[0] * x24; a1 -= L35_6[1] * x25; a2 -= L35_6[2] * x26; a3 -= L35_6[3] * x27; a0 -= L35_7[0] * x28; a1 -= L35_7[1] * x29; a2 -= L35_7[2] * x30; a3 -= L35_7[3] * x31; a0 -= L35_8[0] * x32; a1 -= L35_8[1] * x33; a2 -= L35_8[2] * x34; x35 = (a0 + a1) + (a2 + a3); }
        asm volatile("" ::: "memory");
        const float rr37 = X[37 * XS] * scp[37]; const f32x4 L37_0 = *(const LAS f32x4*)(LmV + 37 * LS + 0); const f32x4 L37_1 = *(const LAS f32x4*)(LmV + 37 * LS + 4); const f32x4 L36_2 = *(const LAS f32x4*)(LmV + 36 * LS + 8); const f32x4 L36_3 = *(const LAS f32x4*)(LmV + 36 * LS + 12); const f32x4 L36_4 = *(const LAS f32x4*)(LmV + 36 * LS + 16); const f32x4 L36_5 = *(const LAS f32x4*)(LmV + 36 * LS + 20); const f32x4 L36_6 = *(const LAS f32x4*)(LmV + 36 * LS + 24); const f32x4 L36_7 = *(const LAS f32x4*)(LmV + 36 * LS + 28); const f32x4 L36_8 = *(const LAS f32x4*)(LmV + 36 * LS + 32);
        float x36; { float a0 = rr36, a1 = 0.f, a2 = 0.f, a3 = 0.f; a0 -= L36_0[0] * x0; a1 -= L36_0[1] * x1; a2 -= L36_0[2] * x2; a3 -= L36_0[3] * x3; a0 -= L36_1[0] * x4; a1 -= L36_1[1] * x5; a2 -= L36_1[2] * x6; a3 -= L36_1[3] * x7; a0 -= L36_2[0] * x8; a1 -= L36_2[1] * x9; a2 -= L36_2[2] * x10; a3 -= L36_2[3] * x11; a0 -= L36_3[0] * x12; a1 -= L36_3[1] * x13; a2 -= L36_3[2] * x14; a3 -= L36_3[3] * x15; a0 -= L36_4[0] * x16; a1 -= L36_4[1] * x17; a2 -= L36_4[2] * x18; a3 -= L36_4[3] * x19; a0 -= L36_5[0] * x20; a1 -= L36_5[1] * x21; a2 -= L36_5[2] * x22; a3 -= L36_5[3] * x23; a0 -= L36_6[0] * x24; a1 -= L36_6[1] * x25; a2 -= L36_6[2] * x26; a3 -= L36_6[3] * x27; a0 -= L36_7[0] * x28; a1 -= L36_7[1] * x29; a2 -= L36_7[2] * x30; a3 -= L36_7[3] * x31; a0 -= L36_8[0] * x32; a1 -= L36_8[1] * x33; a2 -= L36_8[2] * x34; a3 -= L36_8[3] * x35; x36 = (a0 + a1) + (a2 + a3); }
        asm volatile("" ::: "memory");
        const float rr38 = X[38 * XS] * scp[38]; const f32x4 L38_0 = *(const LAS f32x4*)(LmV + 38 * LS + 0); const f32x4 L38_1 = *(const LAS f32x4*)(LmV + 38 * LS + 4); const f32x4 L37_2 = *(const LAS f32x4*)(LmV + 37 * LS + 8); const f32x4 L37_3 = *(const LAS f32x4*)(LmV + 37 * LS + 12); const f32x4 L37_4 = *(const LAS f32x4*)(LmV + 37 * LS + 16); const f32x4 L37_5 = *(const LAS f32x4*)(LmV + 37 * LS + 20); const f32x4 L37_6 = *(const LAS f32x4*)(LmV + 37 * LS + 24); const f32x4 L37_7 = *(const LAS f32x4*)(LmV + 37 * LS + 28); const f32x4 L37_8 = *(const LAS f32x4*)(LmV + 37 * LS + 32); const f32x4 L37_9 = *(const LAS f32x4*)(LmV + 37 * LS + 36);
        float x37; { float a0 = rr37, a1 = 0.f, a2 = 0.f, a3 = 0.f; a0 -= L37_0[0] * x0; a1 -= L37_0[1] * x1; a2 -= L37_0[2] * x2; a3 -= L37_0[3] * x3; a0 -= L37_1[0] * x4; a1 -= L37_1[1] * x5; a2 -= L37_1[2] * x6; a3 -= L37_1[3] * x7; a0 -= L37_2[0] * x8; a1 -= L37_2[1] * x9; a2 -= L37_2[2] * x10; a3 -= L37_2[3] * x11; a0 -= L37_3[0] * x12; a1 -= L37_3[1] * x13; a2 -= L37_3[2] * x14; a3 -= L37_3[3] * x15; a0 -= L37_4[0] * x16; a1 -= L37_4[1] * x17; a2 -= L37_4[2] * x18; a3 -= L37_4[3] * x19; a0 -= L37_5[0] * x20; a1 -= L37_5[1] * x21; a2 -= L37_5[2] * x22; a3 -= L37_5[3] * x23; a0 -= L37_6[0] * x24; a1 -= L37_6[1] * x25; a2 -= L37_6[2] * x26; a3 -= L37_6[3] * x27; a0 -= L37_7[0] * x28; a1 -= L37_7[1] * x29; a2 -= L37_7[2] * x30; a3 -= L37_7[3] * x31; a0 -= L37_8[0] * x32; a1 -= L37_8[1] * x33; a2 -= L37_8[2] * x34; a3 -= L37_8[3] * x35; a0 -= L37_9[0] * x36; x37 = (a0 + a1) + (a2 + a3); }
        asm volatile("" ::: "memory");
        const float rr39 = X[39 * XS] * scp[39]; const f32x4 L39_0 = *(const LAS f32x4*)(LmV + 39 * LS + 0); const f32x4 L39_1 = *(const LAS f32x4*)(LmV + 39 * LS + 4); const f32x4 L38_2 = *(const LAS f32x4*)(LmV + 38 * LS + 8); const f32x4 L38_3 = *(const LAS f32x4*)(LmV + 38 * LS + 12); const f32x4 L38_4 = *(const LAS f32x4*)(LmV + 38 * LS + 16); const f32x4 L38_5 = *(const LAS f32x4*)(LmV + 38 * LS + 20); const f32x4 L38_6 = *(const LAS f32x4*)(LmV + 38 * LS + 24); const f32x4 L38_7 = *(const LAS f32x4*)(LmV + 38 * LS + 28); const f32x4 L38_8 = *(const LAS f32x4*)(LmV + 38 * LS + 32); const f32x4 L38_9 = *(const LAS f32x4*)(LmV + 38 * LS + 36);
        float x38; { float a0 = rr38, a1 = 0.f, a2 = 0.f, a3 = 0.f; a0 -= L38_0[0] * x0; a1 -= L38_0[1] * x1; a2 -= L38_0[2] * x2; a3 -= L38_0[3] * x3; a0 -= L38_1[0] * x4; a1 -= L38_1[1] * x5; a2 -= L38_1[2] * x6; a3 -= L38_1[3] * x7; a0 -= L38_2[0] * x8; a1 -= L38_2[1] * x9; a2 -= L38_2[2] * x10; a3 -= L38_2[3] * x11; a0 -= L38_3[0] * x12; a1 -= L38_3[1] * x13; a2 -= L38_3[2] * x14; a3 -= L38_3[3] * x15; a0 -= L38_4[0] * x16; a1 -= L38_4[1] * x17; a2 -= L38_4[2] * x18; a3 -= L38_4[3] * x19; a0 -= L38_5[0] * x20; a1 -= L38_5[1] * x21; a2 -= L38_5[2] * x22; a3 -= L38_5[3] * x23; a0 -= L38_6[0] * x24; a1 -= L38_6[1] * x25; a2 -= L38_6[2] * x26; a3 -= L38_6[3] * x27; a0 -= L38_7[0] * x28; a1 -= L38_7[1] * x29; a2 -= L38_7[2] * x30; a3 -= L38_7[3] * x31; a0 -= L38_8[0] * x32; a1 -= L38_8[1] * x33; a2 -= L38_8[2] * x34; a3 -= L38_8[3] * x35; a0 -= L38_9[0] * x36; a1 -= L38_9[1] * x37; x38 = (a0 + a1) + (a2 + a3); }
        asm volatile("" ::: "memory");
        const float rr40 = X[40 * XS] * scp[40]; const f32x4 L40_0 = *(const LAS f32x4*)(LmV + 40 * LS + 0); const f32x4 L40_1 = *(const LAS f32x4*)(LmV + 40 * LS + 4); const f32x4 L39_2 = *(const LAS f32x4*)(LmV + 39 * LS + 8); const f32x4 L39_3 = *(const LAS f32x4*)(LmV + 39 * LS + 12); const f32x4 L39_4 = *(const LAS f32x4*)(LmV + 39 * LS + 16); const f32x4 L39_5 = *(const LAS f32x4*)(LmV + 39 * LS + 20); const f32x4 L39_6 = *(const LAS f32x4*)(LmV + 39 * LS + 24); const f32x4 L39_7 = *(const LAS f32x4*)(LmV + 39 * LS + 28); const f32x4 L39_8 = *(const LAS f32x4*)(LmV + 39 * LS + 32); const f32x4 L39_9 = *(const LAS f32x4*)(LmV + 39 * LS + 36);
        float x39; { float a0 = rr39, a1 = 0.f, a2 = 0.f, a3 = 0.f; a0 -= L39_0[0] * x0; a1 -= L39_0[1] * x1; a2 -= L39_0[2] * x2; a3 -= L39_0[3] * x3; a0 -= L39_1[0] * x4; a1 -= L39_1[1] * x5; a2 -= L39_1[2] * x6; a3 -= L39_1[3] * x7; a0 -= L39_2[0] * x8; a1 -= L39_2[1] * x9; a2 -= L39_2[2] * x10; a3 -= L39_2[3] * x11; a0 -= L39_3[0] * x12; a1 -= L39_3[1] * x13; a2 -= L39_3[2] * x14; a3 -= L39_3[3] * x15; a0 -= L39_4[0] * x16; a1 -= L39_4[1] * x17; a2 -= L39_4[2] * x18; a3 -= L39_4[3] * x19; a0 -= L39_5[0] * x20; a1 -= L39_5[1] * x21; a2 -= L39_5[2] * x22; a3 -= L39_5[3] * x23; a0 -= L39_6[0] * x24; a1 -= L39_6[1] * x25; a2 -= L39_6[2] * x26; a3 -= L39_6[3] * x27; a0 -= L39_7[0] * x28; a1 -= L39_7[1] * x29; a2 -= L39_7[2] * x30; a3 -= L39_7[3] * x31; a0 -= L39_8[0] * x32; a1 -= L39_8[1] * x33; a2 -= L39_8[2] * x34; a3 -= L39_8[3] * x35; a0 -= L39_9[0] * x36; a1 -= L39_9[1] * x37; a2 -= L39_9[2] * x38; x39 = (a0 + a1) + (a2 + a3); }
        asm volatile("" ::: "memory");
        const float rr41 = X[41 * XS] * scp[41]; const f32x4 L41_0 = *(const LAS f32x4*)(LmV + 41 * LS + 0); const f32x4 L41_1 = *(const LAS f32x4*)(LmV + 41 * LS + 4); const f32x4 L40_2 = *(const LAS f32x4*)(LmV + 40 * LS + 8); const f32x4 L40_3 = *(const LAS f32x4*)(LmV + 40 * LS + 12); const f32x4 L40_4 = *(const LAS f32x4*)(LmV + 40 * LS + 16); const f32x4 L40_5 = *(const LAS f32x4*)(LmV + 40 * LS + 20); const f32x4 L40_6 = *(const LAS f32x4*)(LmV + 40 * LS + 24); const f32x4 L40_7 = *(const LAS f32x4*)(LmV + 40 * LS + 28); const f32x4 L40_8 = *(const LAS f32x4*)(LmV + 40 * LS + 32); const f32x4 L40_9 = *(const LAS f32x4*)(LmV + 40 * LS + 36);
        float x40; { float a0 = rr40, a1 = 0.f, a2 = 0.f, a3 = 0.f; a0 -= L40_0[0] * x0; a1 -= L40_0[1] * x1; a2 -= L40_0[2] * x2; a3 -= L40_0[3] * x3; a0 -= L40_1[0] * x4; a1 -= L40_1[1] * x5; a2 -= L40_1[2] * x6; a3 -= L40_1[3] * x7; a0 -= L40_2[0] * x8; a1 -= L40_2[1] * x9; a2 -= L40_2[2] * x10; a3 -= L40_2[3] * x11; a0 -= L40_3[0] * x12; a1 -= L40_3[1] * x13; a2 -= L40_3[2] * x14; a3 -= L40_3[3] * x15; a0 -= L40_4[0] * x16; a1 -= L40_4[1] * x17; a2 -= L40_4[2] * x18; a3 -= L40_4[3] * x19; a0 -= L40_5[0] * x20; a1 -= L40_5[1] * x21; a2 -= L40_5[2] * x22; a3 -= L40_5[3] * x23; a0 -= L40_6[0] * x24; a1 -= L40_6[1] * x25; a2 -= L40_6[2] * x26; a3 -= L40_6[3] * x27; a0 -= L40_7[0] * x28; a1 -= L40_7[1] * x29; a2 -= L40_7[2] * x30; a3 -= L40_7[3] * x31; a0 -= L40_8[0] * x32; a1 -= L40_8[1] * x33; a2 -= L40_8[2] * x34; a3 -= L40_8[3] * x35; a0 -= L40_9[0] * x36; a1 -= L40_9[1] * x37; a2 -= L40_9[2] * x38; a3 -= L40_9[3] * x39; x40 = (a0 + a1) + (a2 + a3); }
        asm volatile("" ::: "memory");
        const float rr42 = X[42 * XS] * scp[42]; const f32x4 L42_0 = *(const LAS f32x4*)(LmV + 42 * LS + 0); const f32x4 L42_1 = *(const LAS f32x4*)(LmV + 42 * LS + 4); const f32x4 L41_2 = *(const LAS f32x4*)(LmV + 41 * LS + 8); const f32x4 L41_3 = *(const LAS f32x4*)(LmV + 41 * LS + 12); const f32x4 L41_4 = *(const LAS f32x4*)(LmV + 41 * LS + 16); const f32x4 L41_5 = *(const LAS f32x4*)(LmV + 41 * LS + 20); const f32x4 L41_6 = *(const LAS f32x4*)(LmV + 41 * LS + 24); const f32x4 L41_7 = *(const LAS f32x4*)(LmV + 41 * LS + 28); const f32x4 L41_8 = *(const LAS f32x4*)(LmV + 41 * LS + 32); const f32x4 L41_9 = *(const LAS f32x4*)(LmV + 41 * LS + 36); const f32x4 L41_10 = *(const LAS f32x4*)(LmV + 41 * LS + 40);
        float x41; { float a0 = rr41, a1 = 0.f, a2 = 0.f, a3 = 0.f; a0 -= L41_0[0] * x0; a1 -= L41_0[1] * x1; a2 -= L41_0[2] * x2; a3 -= L41_0[3] * x3; a0 -= L41_1[0] * x4; a1 -= L41_1[1] * x5; a2 -= L41_1[2] * x6; a3 -= L41_1[3] * x7; a0 -= L41_2[0] * x8; a1 -= L41_2[1] * x9; a2 -= L41_2[2] * x10; a3 -= L41_2[3] * x11; a0 -= L41_3[0] * x12; a1 -= L41_3[1] * x13; a2 -= L41_3[2] * x14; a3 -= L41_3[3] * x15; a0 -= L41_4[0] * x16; a1 -= L41_4[1] * x17; a2 -= L41_4[2] * x18; a3 -= L41_4[3] * x19; a0 -= L41_5[0] * x20; a1 -= L41_5[1] * x21; a2 -= L41_5[2] * x22; a3 -= L41_5[3] * x23; a0 -= L41_6[0] * x24; a1 -= L41_6[1] * x25; a2 -= L41_6[2] * x26; a3 -= L41_6[3] * x27; a0 -= L41_7[0] * x28; a1 -= L41_7[1] * x29; a2 -= L41_7[2] * x30; a3 -= L41_7[3] * x31; a0 -= L41_8[0] * x32; a1 -= L41_8[1] * x33; a2 -= L41_8[2] * x34; a3 -= L41_8[3] * x35; a0 -= L41_9[0] * x36; a1 -= L41_9[1] * x37; a2 -= L41_9[2] * x38; a3 -= L41_9[3] * x39; a0 -= L41_10[0] * x40; x41 = (a0 + a1) + (a2 + a3); }
        asm volatile("" ::: "memory");
        const float rr43 = X[43 * XS] * scp[43]; const f32x4 L43_0 = *(const LAS f32x4*)(LmV + 43 * LS + 0); const f32x4 L43_1 = *(const LAS f32x4*)(LmV + 43 * LS + 4); const f32x4 L42_2 = *(const LAS f32x4*)(LmV + 42 * LS + 8); const f32x4 L42_3 = *(const LAS f32x4*)(LmV + 42 * LS + 12); const f32x4 L42_4 = *(const LAS f32x4*)(LmV + 42 * LS + 16); const f32x4 L42_5 = *(const LAS f32x4*)(LmV + 42 * LS + 20); const f32x4 L42_6 = *(const LAS f32x4*)(LmV + 42 * LS + 24); const f32x4 L42_7 = *(const LAS f32x4*)(LmV + 42 * LS + 28); const f32x4 L42_8 = *(const LAS f32x4*)(LmV + 42 * LS + 32); const f32x4 L42_9 = *(const LAS f32x4*)(LmV + 42 * LS + 36); const f32x4 L42_10 = *(const LAS f32x4*)(LmV + 42 * LS + 40);
        float x42; { float a0 = rr42, a1 = 0.f, a2 = 0.f, a3 = 0.f; a0 -= L42_0[0] * x0; a1 -= L42_0[1] * x1; a2 -= L42_0[2] * x2; a3 -= L42_0[3] * x3; a0 -= L42_1[0] * x4; a1 -= L42_1[1] * x5; a2 -= L42_1[2] * x6; a3 -= L42_1[3] * x7; a0 -= L42_2[0] * x8; a1 -= L42_2[1] * x9; a2 -= L42_2[2] * x10; a3 -= L42_2[3] * x11; a0 -= L42_3[0] * x12; a1 -= L42_3[1] * x13; a2 -= L42_3[2] * x14; a3 -= L42_3[3] * x15; a0 -= L42_4[0] * x16; a1 -= L42_4[1] * x17; a2 -= L42_4[2] * x18; a3 -= L42_4[3] * x19; a0 -= L42_5[0] * x20; a1 -= L42_5[1] * x21; a2 -= L42_5[2] * x22; a3 -= L42_5[3] * x23; a0 -= L42_6[0] * x24; a1 -= L42_6[1] * x25; a2 -= L42_6[2] * x26; a3 -= L42_6[3] * x27; a0 -= L42_7[0] * x28; a1 -= L42_7[1] * x29; a2 -= L42_7[2] * x30; a3 -= L42_7[3] * x31; a0 -= L42_8[0] * x32; a1 -= L42_8[1] * x33; a2 -= L42_8[2] * x34; a3 -= L42_8[3] * x35; a0 -= L42_9[0] * x36; a1 -= L42_9[1] * x37; a2 -= L42_9[2] * x38; a3 -= L42_9[3] * x39; a0 -= L42_10[0] * x40; a1 -= L42_10[1] * x41; x42 = (a0 + a1) + (a2 + a3); }
        asm volatile("" ::: "memory");
        const float rr44 = X[44 * XS] * scp[44]; const f32x4 L44_0 = *(const LAS f32x4*)(LmV + 44 * LS + 0); const f32x4 L44_1 = *(const LAS f32x4*)(LmV + 44 * LS + 4); const f32x4 L43_2 = *(const LAS f32x4*)(LmV + 43 * LS + 8); const f32x4 L43_3 = *(const LAS f32x4*)(LmV + 43 * LS + 12); const f32x4 L43_4 = *(const LAS f32x4*)(LmV + 43 * LS + 16); const f32x4 L43_5 = *(const LAS f32x4*)(LmV + 43 * LS + 20); const f32x4 L43_6 = *(const LAS f32x4*)(LmV + 43 * LS + 24); const f32x4 L43_7 = *(const LAS f32x4*)(LmV + 43 * LS + 28); const f32x4 L43_8 = *(const LAS f32x4*)(LmV + 43 * LS + 32); const f32x4 L43_9 = *(const LAS f32x4*)(LmV + 43 * LS + 36); const f32x4 L43_10 = *(const LAS f32x4*)(LmV + 43 * LS + 40);
        float x43; { float a0 = rr43, a1 = 0.f, a2 = 0.f, a3 = 0.f; a0 -= L43_0[0] * x0; a1 -= L43_0[1] * x1; a2 -= L43_0[2] * x2; a3 -= L43_0[3] * x3; a0 -= L43_1[0] * x4; a1 -= L43_1[1] * x5; a2 -= L43_1[2] * x6; a3 -= L43_1[3] * x7; a0 -= L43_2[0] * x8; a1 -= L43_2[1] * x9; a2 -= L43_2[2] * x10; a3 -= L43_2[3] * x11; a0 -= L43_3[0] * x12; a1 -= L43_3[1] * x13; a2 -= L43_3[2] * x14; a3 -= L43_3[3] * x15; a0 -= L43_4[0] * x16; a1 -= L43_4[1] * x17; a2 -= L43_4[2] * x18; a3 -= L43_4[3] * x19; a0 -= L43_5[0] * x20; a1 -= L43_5[1] * x21; a2 -= L43_5[2] * x22; a3 -= L43_5[3] * x23; a0 -= L43_6[0] * x24; a1 -= L43_6[1] * x25; a2 -= L43_6[2] * x26; a3 -= L43_6[3] * x27; a0 -= L43_7[0] * x28; a1 -= L43_7[1] * x29; a2 -= L43_7[2] * x30; a3 -= L43_7[3] * x31; a0 -= L43_8[0] * x32; a1 -= L43_8[1] * x33; a2 -= L43_8[2] * x34; a3 -= L43_8[3] * x35; a0 -= L43_9[0] * x36; a1 -= L43_9[1] * x37; a2 -= L43_9[2] * x38; a3 -= L43_9[3] * x39; a0 -= L43_10[0] * x40; a1 -= L43_10[1] * x41; a2 -= L43_10[2] * x42; x43 = (a0 + a1) + (a2 + a3); }
        asm volatile("" ::: "memory");
        const float rr45 = X[45 * XS] * scp[45]; const f32x4 L45_0 = *(const LAS f32x4*)(LmV + 45 * LS + 0); const f32x4 L45_1 = *(const LAS f32x4*)(LmV + 45 * LS + 4); const f32x4 L44_2 = *(const LAS f32x4*)(LmV + 44 * LS + 8); const f32x4 L44_3 = *(const LAS f32x4*)(LmV + 44 * LS + 12); const f32x4 L44_4 = *(const LAS f32x4*)(LmV + 44 * LS + 16); const f32x4 L44_5 = *(const LAS f32x4*)(LmV + 44 * LS + 20); const f32x4 L44_6 = *(const LAS f32x4*)(LmV + 44 * LS + 24); const f32x4 L44_7 = *(const LAS f32x4*)(LmV + 44 * LS + 28); const f32x4 L44_8 = *(const LAS f32x4*)(LmV + 44 * LS + 32); const f32x4 L44_9 = *(const LAS f32x4*)(LmV + 44 * LS + 36); const f32x4 L44_10 = *(const LAS f32x4*)(LmV + 44 * LS + 40);
        float x44; { float a0 = rr44, a1 = 0.f, a2 = 0.f, a3 = 0.f; a0 -= L44_0[0] * x0; a1 -= L44_0[1] * x1; a2 -= L44_0[2] * x2; a3 -= L44_0[3] * x3; a0 -= L44_1[0] * x4; a1 -= L44_1[1] * x5; a2 -= L44_1[2] * x6; a3 -= L44_1[3] * x7; a0 -= L44_2[0] * x8; a1 -= L44_2[1] * x9; a2 -= L44_2[2] * x10; a3 -= L44_2[3] * x11; a0 -= L44_3[0] * x12; a1 -= L44_3[1] * x13; a2 -= L44_3[2] * x14; a3 -= L44_3[3] * x15; a0 -= L44_4[0] * x16; a1 -= L44_4[1] * x17; a2 -= L44_4[2] * x18; a3 -= L44_4[3] * x19; a0 -= L44_5[0] * x20; a1 -= L44_5[1] * x21; a2 -= L44_5[2] * x22; a3 -= L44_5[3] * x23; a0 -= L44_6[0] * x24; a1 -= L44_6[1] * x25; a2 -= L44_6[2] * x26; a3 -= L44_6[3] * x27; a0 -= L44_7[0] * x28; a1 -= L44_7[1] * x29; a2 -= L44_7[2] * x30; a3 -= L44_7[3] * x31; a0 -= L44_8[0] * x32; a1 -= L44_8[1] * x33; a2 -= L44_8[2] * x34; a3 -= L44_8[3] * x35; a0 -= L44_9[0] * x36; a1 -= L44_9[1] * x37; a2 -= L44_9[2] * x38; a3 -= L44_9[3] * x39; a0 -= L44_10[0] * x40; a1 -= L44_10[1] * x41; a2 -= L44_10[2] * x42; a3 -= L44_10[3] * x43; x44 = (a0 + a1) + (a2 + a3); }
        asm volatile("" ::: "memory");
        const float rr46 = X[46 * XS] * scp[46]; const f32x4 L46_0 = *(const LAS f32x4*)(LmV + 46 * LS + 0); const f32x4 L46_1 = *(const LAS f32x4*)(LmV + 46 * LS + 4); const f32x4 L45_2 = *(const LAS f32x4*)(LmV + 45 * LS + 8); const f32x4 L45_3 = *(const LAS f32x4*)(LmV + 45 * LS + 12); const f32x4 L45_4 = *(const LAS f32x4*)(LmV + 45 * LS + 16); const f32x4 L45_5 = *(const LAS f32x4*)(LmV + 45 * LS + 20); const f32x4 L45_6 = *(const LAS f32x4*)(LmV + 45 * LS + 24); const f32x4 L45_7 = *(const LAS f32x4*)(LmV + 45 * LS + 28); const f32x4 L45_8 = *(const LAS f32x4*)(LmV + 45 * LS + 32); const f32x4 L45_9 = *(const LAS f32x4*)(LmV + 45 * LS + 36); const f32x4 L45_10 = *(const LAS f32x4*)(LmV + 45 * LS + 40); const f32x4 L45_11 = *(const LAS f32x4*)(LmV + 45 * LS + 44);
        float x45; { float a0 = rr45, a1 = 0.f, a2 = 0.f, a3 = 0.f; a0 -= L45_0[0] * x0; a1 -= L45_0[1] * x1; a2 -= L45_0[2] * x2; a3 -= L45_0[3] * x3; a0 -= L45_1[0] * x4; a1 -= L45_1[1] * x5; a2 -= L45_1[2] * x6; a3 -= L45_1[3] * x7; a0 -= L45_2[0] * x8; a1 -= L45_2[1] * x9; a2 -= L45_2[2] * x10; a3 -= L45_2[3] * x11; a0 -= L45_3[0] * x12; a1 -= L45_3[1] * x13; a2 -= L45_3[2] * x14; a3 -= L45_3[3] * x15; a0 -= L45_4[0] * x16; a1 -= L45_4[1] * x17; a2 -= L45_4[2] * x18; a3 -= L45_4[3] * x19; a0 -= L45_5[0] * x20; a1 -= L45_5[1] * x21; a2 -= L45_5[2] * x22; a3 -= L45_5[3] * x23; a0 -= L45_6[0] * x24; a1 -= L45_6[1] * x25; a2 -= L45_6[2] * x26; a3 -= L45_6[3] * x27; a0 -= L45_7[0] * x28; a1 -= L45_7[1] * x29; a2 -= L45_7[2] * x30; a3 -= L45_7[3] * x31; a0 -= L45_8[0] * x32; a1 -= L45_8[1] * x33; a2 -= L45_8[2] * x34; a3 -= L45_8[3] * x35; a0 -= L45_9[0] * x36; a1 -= L45_9[1] * x37; a2 -= L45_9[2] * x38; a3 -= L45_9[3] * x39; a0 -= L45_10[0] * x40; a1 -= L45_10[1] * x41; a2 -= L45_10[2] * x42; a3 -= L45_10[3] * x43; a0 -= L45_11[0] * x44; x45 = (a0 + a1) + (a2 + a3); }
        asm volatile("" ::: "memory");
        const float rr47 = X[47 * XS] * scp[47]; const f32x4 L47_0 = *(const LAS f32x4*)(LmV + 47 * LS + 0); const f32x4 L47_1 = *(const LAS f32x4*)(LmV + 47 * LS + 4); const f32x4 L46_2 = *(const LAS f32x4*)(LmV + 46 * LS + 8); const f32x4 L46_3 = *(const LAS f32x4*)(LmV + 46 * LS + 12); const f32x4 L46_4 = *(const LAS f32x4*)(LmV + 46 * LS + 16); const f32x4 L46_5 = *(const LAS f32x4*)(LmV + 46 * LS + 20); const f32x4 L46_6 = *(const LAS f32x4*)(LmV + 46 * LS + 24); const f32x4 L46_7 = *(const LAS f32x4*)(LmV + 46 * LS + 28); const f32x4 L46_8 = *(const LAS f32x4*)(LmV + 46 * LS + 32); const f32x4 L46_9 = *(const LAS f32x4*)(LmV + 46 * LS + 36); const f32x4 L46_10 = *(const LAS f32x4*)(LmV + 46 * LS + 40); const f32x4 L46_11 = *(const LAS f32x4*)(LmV + 46 * LS + 44);
        float x46; { float a0 = rr46, a1 = 0.f, a2 = 0.f, a3 = 0.f; a0 -= L46_0[0] * x0; a1 -= L46_0[1] * x1; a2 -= L46_0[2] * x2; a3 -= L46_0[3] * x3; a0 -= L46_1[0] * x4; a1 -= L46_1[1] * x5; a2 -= L46_1[2] * x6; a3 -= L46_1[3] * x7; a0 -= L46_2[0] * x8; a1 -= L46_2[1] * x9; a2 -= L46_2[2] * x10; a3 -= L46_2[3] * x11; a0 -= L46_3[0] * x12; a1 -= L46_3[1] * x13; a2 -= L46_3[2] * x14; a3 -= L46_3[3] * x15; a0 -= L46_4[0] * x16; a1 -= L46_4[1] * x17; a2 -= L46_4[2] * x18; a3 -= L46_4[3] * x19; a0 -= L46_5[0] * x20; a1 -= L46_5[1] * x21; a2 -= L46_5[2] * x22; a3 -= L46_5[3] * x23; a0 -= L46_6[0] * x24; a1 -= L46_6[1] * x25; a2 -= L46_6[2] * x26; a3 -= L46_6[3] * x27; a0 -= L46_7[0] * x28; a1 -= L46_7[1] * x29; a2 -= L46_7[2] * x30; a3 -= L46_7[3] * x31; a0 -= L46_8[0] * x32; a1 -= L46_8[1] * x33; a2 -= L46_8[2] * x34; a3 -= L46_8[3] * x35; a0 -= L46_9[0] * x36; a1 -= L46_9[1] * x37; a2 -= L46_9[2] * x38; a3 -= L46_9[3] * x39; a0 -= L46_10[0] * x40; a1 -= L46_10[1] * x41; a2 -= L46_10[2] * x42; a3 -= L46_10[3] * x43; a0 -= L46_11[0] * x44; a1 -= L46_11[1] * x45; x46 = (a0 + a1) + (a2 + a3); }
        asm volatile("" ::: "memory");
        const float rr48 = X[48 * XS] * scp[48]; const f32x4 L48_0 = *(const LAS f32x4*)(LmV + 48 * LS + 0); const f32x4 L48_1 = *(const LAS f32x4*)(LmV + 48 * LS + 4); const f32x4 L47_2 = *(const LAS f32x4*)(LmV + 47 * LS + 8); const f32x4 L47_3 = *(const LAS f32x4*)(LmV + 47 * LS + 12); const f32x4 L47_4 = *(const LAS f32x4*)(LmV + 47 * LS + 16); const f32x4 L47_5 = *(const LAS f32x4*)(LmV + 47 * LS + 20); const f32x4 L47_6 = *(const LAS f32x4*)(LmV + 47 * LS + 24); const f32x4 L47_7 = *(const LAS f32x4*)(LmV + 47 * LS + 28); const f32x4 L47_8 = *(const LAS f32x4*)(LmV + 47 * LS + 32); const f32x4 L47_9 = *(const LAS f32x4*)(LmV + 47 * LS + 36); const f32x4 L47_10 = *(const LAS f32x4*)(LmV + 47 * LS + 40); const f32x4 L47_11 = *(const LAS f32x4*)(LmV + 47 * LS + 44);
        float x47; { float a0 = rr47, a1 = 0.f, a2 = 0.f, a3 = 0.f; a0 -= L47_0[0] * x0; a1 -= L47_0[1] * x1; a2 -= L47_0[2] * x2; a3 -= L47_0[3] * x3; a0 -= L47_1[0] * x4; a1 -= L47_1[1] * x5; a2 -= L47_1[2] * x6; a3 -= L47_1[3] * x7; a0 -= L47_2[0] * x8; a1 -= L47_2[1] * x9; a2 -= L47_2[2] * x10; a3 -= L47_2[3] * x11; a0 -= L47_3[0] * x12; a1 -= L47_3[1] * x13; a2 -= L47_3[2] * x14; a3 -= L47_3[3] * x15; a0 -= L47_4[0] * x16; a1 -= L47_4[1] * x17; a2 -= L47_4[2] * x18; a3 -= L47_4[3] * x19; a0 -= L47_5[0] * x20; a1 -= L47_5[1] * x21; a2 -= L47_5[2] * x22; a3 -= L47_5[3] * x23; a0 -= L47_6[0] * x24; a1 -= L47_6[1] * x25; a2 -= L47_6[2] * x26; a3 -= L47_6[3] * x27; a0 -= L47_7[0] * x28; a1 -= L47_7[1] * x29; a2 -= L47_7[2] * x30; a3 -= L47_7[3] * x31; a0 -= L47_8[0] * x32; a1 -= L47_8[1] * x33; a2 -= L47_8[2] * x34; a3 -= L47_8[3] * x35; a0 -= L47_9[0] * x36; a1 -= L47_9[1] * x37; a2 -= L47_9[2] * x38; a3 -= L47_9[3] * x39; a0 -= L47_10[0] * x40; a1 -= L47_10[1] * x41; a2 -= L47_10[2] * x42; a3 -= L47_10[3] * x43; a0 -= L47_11[0] * x44; a1 -= L47_11[1] * x45; a2 -= L47_11[2] * x46; x47 = (a0 + a1) + (a2 + a3); }
        asm volatile("" ::: "memory");
        const float rr49 = X[49 * XS] * scp[49]; const f32x4 L49_0 = *(const LAS f32x4*)(LmV + 49 * LS + 0); const f32x4 L49_1 = *(const LAS f32x4*)(LmV + 49 * LS + 4); const f32x4 L48_2 = *(const LAS f32x4*)(LmV + 48 * LS + 8); const f32x4 L48_3 = *(const LAS f32x4*)(LmV + 48 * LS + 12); const f32x4 L48_4 = *(const LAS f32x4*)(LmV + 48 * LS + 16); const f32x4 L48_5 = *(const LAS f32x4*)(LmV + 48 * LS + 20); const f32x4 L48_6 = *(const LAS f32x4*)(LmV + 48 * LS + 24); const f32x4 L48_7 = *(const LAS f32x4*)(LmV + 48 * LS + 28); const f32x4 L48_8 = *(const LAS f32x4*)(LmV + 48 * LS + 32); const f32x4 L48_9 = *(const LAS f32x4*)(LmV + 48 * LS + 36); const f32x4 L48_10 = *(const LAS f32x4*)(LmV + 48 * LS + 40); const f32x4 L48_11 = *(const LAS f32x4*)(LmV + 48 * LS + 44);
        float x48; { float a0 = rr48, a1 = 0.f, a2 = 0.f, a3 = 0.f; a0 -= L48_0[0] * x0; a1 -= L48_0[1] * x1; a2 -= L48_0[2] * x2; a3 -= L48_0[3] * x3; a0 -= L48_1[0] * x4; a1 -= L48_1[1] * x5; a2 -= L48_1[2] * x6; a3 -= L48_1[3] * x7; a0 -= L48_2[0] * x8; a1 -= L48_2[1] * x9; a2 -= L48_2[2] * x10; a3 -= L48_2[3] * x11; a0 -= L48_3[0] * x12; a1 -= L48_3[1] * x13; a2 -= L48_3[2] * x14; a3 -= L48_3[3] * x15; a0 -= L48_4[0] * x16; a1 -= L48_4[1] * x17; a2 -= L48_4[2] * x18; a3 -= L48_4[3] * x19; a0 -= L48_5[0] * x20; a1 -= L48_5[1] * x21; a2 -= L48_5[2] * x22; a3 -= L48_5[3] * x23; a0 -= L48_6[0] * x24; a1 -= L48_6[1] * x25; a2 -= L48_6[2] * x26; a3 -= L48_6[3] * x27; a0 -= L48_7[0] * x28; a1 -= L48_7[1] * x29; a2 -= L48_7[2] * x30; a3 -= L48_7[3] * x31; a0 -= L48_8[0] * x32; a1 -= L48_8[1] * x33; a2 -= L48_8[2] * x34; a3 -= L48_8[3] * x35; a0 -= L48_9[0] * x36; a1 -= L48_9[1] * x37; a2 -= L48_9[2] * x38; a3 -= L48_9[3] * x39; a0 -= L48_10[0] * x40; a1 -= L48_10[1] * x41; a2 -= L48_10[2] * x42; a3 -= L48_10[3] * x43; a0 -= L48_11[0] * x44; a1 -= L48_11[1] * x45; a2 -= L48_11[2] * x46; a3 -= L48_11[3] * x47; x48 = (a0 + a1) + (a2 + a3); }
        asm volatile("" ::: "memory");
        const float rr50 = X[50 * XS] * scp[50]; const f32x4 L50_0 = *(const LAS f32x4*)(LmV + 50 * LS + 0); const f32x4 L50_1 = *(const LAS f32x4*)(LmV + 50 * LS + 4); const f32x4 L49_2 = *(const LAS f32x4*)(LmV + 49 * LS + 8); const f32x4 L49_3 = *(const LAS f32x4*)(LmV + 49 * LS + 12); const f32x4 L49_4 = *(const LAS f32x4*)(LmV + 49 * LS + 16); const f32x4 L49_5 = *(const LAS f32x4*)(LmV + 49 * LS + 20); const f32x4 L49_6 = *(const LAS f32x4*)(LmV + 49 * LS + 24); const f32x4 L49_7 = *(const LAS f32x4*)(LmV + 49 * LS + 28); const f32x4 L49_8 = *(const LAS f32x4*)(LmV + 49 * LS + 32); const f32x4 L49_9 = *(const LAS f32x4*)(LmV + 49 * LS + 36); const f32x4 L49_10 = *(const LAS f32x4*)(LmV + 49 * LS + 40); const f32x4 L49_11 = *(const LAS f32x4*)(LmV + 49 * LS + 44); const f32x4 L49_12 = *(const LAS f32x4*)(LmV + 49 * LS + 48);
        float x49; { float a0 = rr49, a1 = 0.f, a2 = 0.f, a3 = 0.f; a0 -= L49_0[0] * x0; a1 -= L49_0[1] * x1; a2 -= L49_0[2] * x2; a3 -= L49_0[3] * x3; a0 -= L49_1[0] * x4; a1 -= L49_1[1] * x5; a2 -= L49_1[2] * x6; a3 -= L49_1[3] * x7; a0 -= L49_2[0] * x8; a1 -= L49_2[1] * x9; a2 -= L49_2[2] * x10; a3 -= L49_2[3] * x11; a0 -= L49_3[0] * x12; a1 -= L49_3[1] * x13; a2 -= L49_3[2] * x14; a3 -= L49_3[3] * x15; a0 -= L49_4[0] * x16; a1 -= L49_4[1] * x17; a2 -= L49_4[2] * x18; a3 -= L49_4[3] * x19; a0 -= L49_5[0] * x20; a1 -= L49_5[1] * x21; a2 -= L49_5[2] * x22; a3 -= L49_5[3] * x23; a0 -= L49_6[0] * x24; a1 -= L49_6[1] * x25; a2 -= L49_6[2] * x26; a3 -= L49_6[3] * x27; a0 -= L49_7[0] * x28; a1 -= L49_7[1] * x29; a2 -= L49_7[2] * x30; a3 -= L49_7[3] * x31; a0 -= L49_8[0] * x32; a1 -= L49_8[1] * x33; a2 -= L49_8[2] * x34; a3 -= L49_8[3] * x35; a0 -= L49_9[0] * x36; a1 -= L49_9[1] * x37; a2 -= L49_9[2] * x38; a3 -= L49_9[3] * x39; a0 -= L49_10[0] * x40; a1 -= L49_10[1] * x41; a2 -= L49_10[2] * x42; a3 -= L49_10[3] * x43; a0 -= L49_11[0] * x44; a1 -= L49_11[1] * x45; a2 -= L49_11[2] * x46; a3 -= L49_11[3] * x47; a0 -= L49_12[0] * x48; x49 = (a0 + a1) + (a2 + a3); }
        asm volatile("" ::: "memory");
        const float rr51 = X[51 * XS] * scp[51]; const f32x4 L51_0 = *(const LAS f32x4*)(LmV + 51 * LS + 0); const f32x4 L51_1 = *(const LAS f32x4*)(LmV + 51 * LS + 4); const f32x4 L50_2 = *(const LAS f32x4*)(LmV + 50 * LS + 8); const f32x4 L50_3 = *(const LAS f32x4*)(LmV + 50 * LS + 12); const f32x4 L50_4 = *(const LAS f32x4*)(LmV + 50 * LS + 16); const f32x4 L50_5 = *(const LAS f32x4*)(LmV + 50 * LS + 20); const f32x4 L50_6 = *(const LAS f32x4*)(LmV + 50 * LS + 24); const f32x4 L50_7 = *(const LAS f32x4*)(LmV + 50 * LS + 28); const f32x4 L50_8 = *(const LAS f32x4*)(LmV + 50 * LS + 32); const f32x4 L50_9 = *(const LAS f32x4*)(LmV + 50 * LS + 36); const f32x4 L50_10 = *(const LAS f32x4*)(LmV + 50 * LS + 40); const f32x4 L50_11 = *(const LAS f32x4*)(LmV + 50 * LS + 44); const f32x4 L50_12 = *(const LAS f32x4*)(LmV + 50 * LS + 48);
        float x50; { float a0 = rr50, a1 = 0.f, a2 = 0.f, a3 = 0.f; a0 -= L50_0[0] * x0; a1 -= L50_0[1] * x1; a2 -= L50_0[2] * x2; a3 -= L50_0[3] * x3; a0 -= L50_1[0] * x4; a1 -= L50_1[1] * x5; a2 -= L50_1[2] * x6; a3 -= L50_1[3] * x7; a0 -= L50_2[0] * x8; a1 -= L50_2[1] * x9; a2 -= L50_2[2] * x10; a3 -= L50_2[3] * x11; a0 -= L50_3[0] * x12; a1 -= L50_3[1] * x13; a2 -= L50_3[2] * x14; a3 -= L50_3[3] * x15; a0 -= L50_4[0] * x16; a1 -= L50_4[1] * x17; a2 -= L50_4[2] * x18; a3 -= L50_4[3] * x19; a0 -= L50_5[0] * x20; a1 -= L50_5[1] * x21; a2 -= L50_5[2] * x22; a3 -= L50_5[3] * x23; a0 -= L50_6[0] * x24; a1 -= L50_6[1] * x25; a2 -= L50_6[2] * x26; a3 -= L50_6[3] * x27; a0 -= L50_7[0] * x28; a1 -= L50_7[1] * x29; a2 -= L50_7[2] * x30; a3 -= L50_7[3] * x31; a0 -= L50_8[0] * x32; a1 -= L50_8[1] * x33; a2 -= L50_8[2] * x34; a3 -= L50_8[3] * x35; a0 -= L50_9[0] * x36; a1 -= L50_9[1] * x37; a2 -= L50_9[2] * x38; a3 -= L50_9[3] * x39; a0 -= L50_10[0] * x40; a1 -= L50_10[1] * x41; a2 -= L50_10[2] * x42; a3 -= L50_10[3] * x43; a0 -= L50_11[0] * x44; a1 -= L50_11[1] * x45; a2 -= L50_11[2] * x46; a3 -= L50_11[3] * x47; a0 -= L50_12[0] * x48; a1 -= L50_12[1] * x49; x50 = (a0 + a1) + (a2 + a3); }
        asm volatile("" ::: "memory");
        const float rr52 = X[52 * XS] * scp[52]; const f32x4 L52_0 = *(const LAS f32x4*)(LmV + 52 * LS + 0); const f32x4 L52_1 = *(const LAS f32x4*)(LmV + 52 * LS + 4); const f32x4 L51_2 = *(const LAS f32x4*)(LmV + 51 * LS + 8); const f32x4 L51_3 = *(const LAS f32x4*)(LmV + 51 * LS + 12); const f32x4 L51_4 = *(const LAS f32x4*)(LmV + 51 * LS + 16); const f32x4 L51_5 = *(const LAS f32x4*)(LmV + 51 * LS + 20); const f32x4 L51_6 = *(const LAS f32x4*)(LmV + 51 * LS + 24); const f32x4 L51_7 = *(const LAS f32x4*)(LmV + 51 * LS + 28); const f32x4 L51_8 = *(const LAS f32x4*)(LmV + 51 * LS + 32); const f32x4 L51_9 = *(const LAS f32x4*)(LmV + 51 * LS + 36); const f32x4 L51_10 = *(const LAS f32x4*)(LmV + 51 * LS + 40); const f32x4 L51_11 = *(const LAS f32x4*)(LmV + 51 * LS + 44); const f32x4 L51_12 = *(const LAS f32x4*)(LmV + 51 * LS + 48);
        float x51; { float a0 = rr51, a1 = 0.f, a2 = 0.f, a3 = 0.f; a0 -= L51_0[0] * x0; a1 -= L51_0[1] * x1; a2 -= L51_0[2] * x2; a3 -= L51_0[3] * x3; a0 -= L51_1[0] * x4; a1 -= L51_1[1] * x5; a2 -= L51_1[2] * x6; a3 -= L51_1[3] * x7; a0 -= L51_2[0] * x8; a1 -= L51_2[1] * x9; a2 -= L51_2[2] * x10; a3 -= L51_2[3] * x11; a0 -= L51_3[0] * x12; a1 -= L51_3[1] * x13; a2 -= L51_3[2] * x14; a3 -= L51_3[3] * x15; a0 -= L51_4[0] * x16; a1 -= L51_4[1] * x17; a2 -= L51_4[2] * x18; a3 -= L51_4[3] * x19; a0 -= L51_5[0] * x20; a1 -= L51_5[1] * x21; a2 -= L51_5[2] * x22; a3 -= L51_5[3] * x23; a0 -= L51_6[0] * x24; a1 -= L51_6[1] * x25; a2 -= L51_6[2] * x26; a3 -= L51_6[3] * x27; a0 -= L51_7[0] * x28; a1 -= L51_7[1] * x29; a2 -= L51_7[2] * x30; a3 -= L51_7[3] * x31; a0 -= L51_8[0] * x32; a1 -= L51_8[1] * x33; a2 -= L51_8[2] * x34; a3 -= L51_8[3] * x35; a0 -= L51_9[0] * x36; a1 -= L51_9[1] * x37; a2 -= L51_9[2] * x38; a3 -= L51_9[3] * x39; a0 -= L51_10[0] * x40; a1 -= L51_10[1] * x41; a2 -= L51_10[2] * x42; a3 -= L51_10[3] * x43; a0 -= L51_11[0] * x44; a1 -= L51_11[1] * x45; a2 -= L51_11[2] * x46; a3 -= L51_11[3] * x47; a0 -= L51_12[0] * x48; a1 -= L51_12[1] * x49; a2 -= L51_12[2] * x50; x51 = (a0 + a1) + (a2 + a3); }
        asm volatile("" ::: "memory");
        const float rr53 = X[53 * XS] * scp[53]; const f32x4 L53_0 = *(const LAS f32x4*)(LmV + 53 * LS + 0); const f32x4 L53_1 = *(const LAS f32x4*)(LmV + 53 * LS + 4); const f32x4 L52_2 = *(const LAS f32x4*)(LmV + 52 * LS + 8); const f32x4 L52_3 = *(const LAS f32x4*)(LmV + 52 * LS + 12); const f32x4 L52_4 = *(const LAS f32x4*)(LmV + 52 * LS + 16); const f32x4 L52_5 = *(const LAS f32x4*)(LmV + 52 * LS + 20); const f32x4 L52_6 = *(const LAS f32x4*)(LmV + 52 * LS + 24); const f32x4 L52_7 = *(const LAS f32x4*)(LmV + 52 * LS + 28); const f32x4 L52_8 = *(const LAS f32x4*)(LmV + 52 * LS + 32); const f32x4 L52_9 = *(const LAS f32x4*)(LmV + 52 * LS + 36); const f32x4 L52_10 = *(const LAS f32x4*)(LmV + 52 * LS + 40); const f32x4 L52_11 = *(const LAS f32x4*)(LmV + 52 * LS + 44); const f32x4 L52_12 = *(const LAS f32x4*)(LmV + 52 * LS + 48);
        float x52; { float a0 = rr52, a1 = 0.f, a2 = 0.f, a3 = 0.f; a0 -= L52_0[0] * x0; a1 -= L52_0[1] * x1; a2 -= L52_0[2] * x2; a3 -= L52_0[3] * x3; a0 -= L52_1[0] * x4; a1 -= L52_1[1] * x5; a2 -= L52_1[2] * x6; a3 -= L52_1[3] * x7; a0 -= L52_2[0] * x8; a1 -= L52_2[1] * x9; a2 -= L52_2[2] * x10; a3 -= L52_2[3] * x11; a0 -= L52_3[0] * x12; a1 -= L52_3[1] * x13; a2 -= L52_3[2] * x14; a3 -= L52_3[3] * x15; a0 -= L52_4[0] * x16; a1 -= L52_4[1] * x17; a2 -= L52_4[2] * x18; a3 -= L52_4[3] * x19; a0 -= L52_5[0] * x20; a1 -= L52_5[1] * x21; a2 -= L52_5[2] * x22; a3 -= L52_5[3] * x23; a0 -= L52_6[0] * x24; a1 -= L52_6[1] * x25; a2 -= L52_6[2] * x26; a3 -= L52_6[3] * x27; a0 -= L52_7[0] * x28; a1 -= L52_7[1] * x29; a2 -= L52_7[2] * x30; a3 -= L52_7[3] * x31; a0 -= L52_8[0] * x32; a1 -= L52_8[1] * x33; a2 -= L52_8[2] * x34; a3 -= L52_8[3] * x35; a0 -= L52_9[0] * x36; a1 -= L52_9[1] * x37; a2 -= L52_9[2] * x38; a3 -= L52_9[3] * x39; a0 -= L52_10[0] * x40; a1 -= L52_10[1] * x41; a2 -= L52_10[2] * x42; a3 -= L52_10[3] * x43; a0 -= L52_11[0] * x44; a1 -= L52_11[1] * x45; a2 -= L52_11[2] * x46; a3 -= L52_11[3] * x47; a0 -= L52_12[0] * x48; a1 -= L52_12[1] * x49; a2 -= L52_12[2] * x50; a3 -= L52_12[3] * x51; x52 = (a0 + a1) + (a2 + a3); }
        asm volatile("" ::: "memory");
        const float rr54 = X[54 * XS] * scp[54]; const f32x4 L54_0 = *(const LAS f32x4*)(LmV + 54 * LS + 0); const f32x4 L54_1 = *(const LAS f32x4*)(LmV + 54 * LS + 4); const f32x4 L53_2 = *(const LAS f32x4*)(LmV + 53 * LS + 8); const f32x4 L53_3 = *(const LAS f32x4*)(LmV + 53 * LS + 12); const f32x4 L53_4 = *(const LAS f32x4*)(LmV + 53 * LS + 16); const f32x4 L53_5 = *(const LAS f32x4*)(LmV + 53 * LS + 20); const f32x4 L53_6 = *(const LAS f32x4*)(LmV + 53 * LS + 24); const f32x4 L53_7 = *(const LAS f32x4*)(LmV + 53 * LS + 28); const f32x4 L53_8 = *(const LAS f32x4*)(LmV + 53 * LS + 32); const f32x4 L53_9 = *(const LAS f32x4*)(LmV + 53 * LS + 36); const f32x4 L53_10 = *(const LAS f32x4*)(LmV + 53 * LS + 40); const f32x4 L53_11 = *(const LAS f32x4*)(LmV + 53 * LS + 44); const f32x4 L53_12 = *(const LAS f32x4*)(LmV + 53 * LS + 48); const f32x4 L53_13 = *(const LAS f32x4*)(LmV + 53 * LS + 52);
        float x53; { float a0 = rr53, a1 = 0.f, a2 = 0.f, a3 = 0.f; a0 -= L53_0[0] * x0; a1 -= L53_0[1] * x1; a2 -= L53_0[2] * x2; a3 -= L53_0[3] * x3; a0 -= L53_1[0] * x4; a1 -= L53_1[1] * x5; a2 -= L53_1[2] * x6; a3 -= L53_1[3] * x7; a0 -= L53_2[0] * x8; a1 -= L53_2[1] * x9; a2 -= L53_2[2] * x10; a3 -= L53_2[3] * x11; a0 -= L53_3[0] * x12; a1 -= L53_3[1] * x13; a2 -= L53_3[2] * x14; a3 -= L53_3[3] * x15; a0 -= L53_4[0] * x16; a1 -= L53_4[1] * x17; a2 -= L53_4[2] * x18; a3 -= L53_4[3] * x19; a0 -= L53_5[0] * x20; a1 -= L53_5[1] * x21; a2 -= L53_5[2] * x22; a3 -= L53_5[3] * x23; a0 -= L53_6[0] * x24; a1 -= L53_6[1] * x25; a2 -= L53_6[2] * x26; a3 -= L53_6[3] * x27; a0 -= L53_7[0] * x28; a1 -= L53_7[1] * x29; a2 -= L53_7[2] * x30; a3 -= L53_7[3] * x31; a0 -= L53_8[0] * x32; a1 -= L53_8[1] * x33; a2 -= L53_8[2] * x34; a3 -= L53_8[3] * x35; a0 -= L53_9[0] * x36; a1 -= L53_9[1] * x37; a2 -= L53_9[2] * x38; a3 -= L53_9[3] * x39; a0 -= L53_10[0] * x40; a1 -= L53_10[1] * x41; a2 -= L53_10[2] * x42; a3 -= L53_10[3] * x43; a0 -= L53_11[0] * x44; a1 -= L53_11[1] * x45; a2 -= L53_11[2] * x46; a3 -= L53_11[3] * x47; a0 -= L53_12[0] * x48; a1 -= L53_12[1] * x49; a2 -= L53_12[2] * x50; a3 -= L53_12[3] * x51; a0 -= L53_13[0] * x52; x53 = (a0 + a1) + (a2 + a3); }
        asm volatile("" ::: "memory");
        const float rr55 = X[55 * XS] * scp[55]; const f32x4 L55_0 = *(const LAS f32x4*)(LmV + 55 * LS + 0); const f32x4 L55_1 = *(const LAS f32x4*)(LmV + 55 * LS + 4); const f32x4 L54_2 = *(const LAS f32x4*)(LmV + 54 * LS + 8); const f32x4 L54_3 = *(const LAS f32x4*)(LmV + 54 * LS + 12); const f32x4 L54_4 = *(const LAS f32x4*)(LmV + 54 * LS + 16); const f32x4 L54_5 = *(const LAS f32x4*)(LmV + 54 * LS + 20); const f32x4 L54_6 = *(const LAS f32x4*)(LmV + 54 * LS + 24); const f32x4 L54_7 = *(const LAS f32x4*)(LmV + 54 * LS + 28); const f32x4 L54_8 = *(const LAS f32x4*)(LmV + 54 * LS + 32); const f32x4 L54_9 = *(const LAS f32x4*)(LmV + 54 * LS + 36); const f32x4 L54_10 = *(const LAS f32x4*)(LmV + 54 * LS + 40); const f32x4 L54_11 = *(const LAS f32x4*)(LmV + 54 * LS + 44); const f32x4 L54_12 = *(const LAS f32x4*)(LmV + 54 * LS + 48); const f32x4 L54_13 = *(const LAS f32x4*)(LmV + 54 * LS + 52);
        float x54; { float a0 = rr54, a1 = 0.f, a2 = 0.f, a3 = 0.f; a0 -= L54_0[0] * x0; a1 -= L54_0[1] * x1; a2 -= L54_0[2] * x2; a3 -= L54_0[3] * x3; a0 -= L54_1[0] * x4; a1 -= L54_1[1] * x5; a2 -= L54_1[2] * x6; a3 -= L54_1[3] * x7; a0 -= L54_2[0] * x8; a1 -= L54_2[1] * x9; a2 -= L54_2[2] * x10; a3 -= L54_2[3] * x11; a0 -= L54_3[0] * x12; a1 -= L54_3[1] * x13; a2 -= L54_3[2] * x14; a3 -= L54_3[3] * x15; a0 -= L54_4[0] * x16; a1 -= L54_4[1] * x17; a2 -= L54_4[2] * x18; a3 -= L54_4[3] * x19; a0 -= L54_5[0] * x20; a1 -= L54_5[1] * x21; a2 -= L54_5[2] * x22; a3 -= L54_5[3] * x23; a0 -= L54_6[0] * x24; a1 -= L54_6[1] * x25; a2 -= L54_6[2] * x26; a3 -= L54_6[3] * x27; a0 -= L54_7[0] * x28; a1 -= L54_7[1] * x29; a2 -= L54_7[2] * x30; a3 -= L54_7[3] * x31; a0 -= L54_8[0] * x32; a1 -= L54_8[1] * x33; a2 -= L54_8[2] * x34; a3 -= L54_8[3] * x35; a0 -= L54_9[0] * x36; a1 -= L54_9[1] * x37; a2 -= L54_9[2] * x38; a3 -= L54_9[3] * x39; a0 -= L54_10[0] * x40; a1 -= L54_10[1] * x41; a2 -= L54_10[2] * x42; a3 -= L54_10[3] * x43; a0 -= L54_11[0] * x44; a1 -= L54_11[1] * x45; a2 -= L54_11[2] * x46; a3 -= L54_11[3] * x47; a0 -= L54_12[0] * x48; a1 -= L54_12[1] * x49; a2 -= L54_12[2] * x50; a3 -= L54_12[3] * x51; a0 -= L54_13[0] * x52; a1 -= L54_13[1] * x53; x54 = (a0 + a1) + (a2 + a3); }
        asm volatile("" ::: "memory");
        const float rr56 = X[56 * XS] * scp[56]; const f32x4 L56_0 = *(const LAS f32x4*)(LmV + 56 * LS + 0); const f32x4 L56_1 = *(const LAS f32x4*)(LmV + 56 * LS + 4); const f32x4 L55_2 = *(const LAS f32x4*)(LmV + 55 * LS + 8); const f32x4 L55_3 = *(const LAS f32x4*)(LmV + 55 * LS + 12); const f32x4 L55_4 = *(const LAS f32x4*)(LmV + 55 * LS + 16); const f32x4 L55_5 = *(const LAS f32x4*)(LmV + 55 * LS + 20); const f32x4 L55_6 = *(const LAS f32x4*)(LmV + 55 * LS + 24); const f32x4 L55_7 = *(const LAS f32x4*)(LmV + 55 * LS + 28); const f32x4 L55_8 = *(const LAS f32x4*)(LmV + 55 * LS + 32); const f32x4 L55_9 = *(const LAS f32x4*)(LmV + 55 * LS + 36); const f32x4 L55_10 = *(const LAS f32x4*)(LmV + 55 * LS + 40); const f32x4 L55_11 = *(const LAS f32x4*)(LmV + 55 * LS + 44); const f32x4 L55_12 = *(const LAS f32x4*)(LmV + 55 * LS + 48); const f32x4 L55_13 = *(const LAS f32x4*)(LmV + 55 * LS + 52);
        float x55; { float a0 = rr55, a1 = 0.f, a2 = 0.f, a3 = 0.f; a0 -= L55_0[0] * x0; a1 -= L55_0[1] * x1; a2 -= L55_0[2] * x2; a3 -= L55_0[3] * x3; a0 -= L55_1[0] * x4; a1 -= L55_1[1] * x5; a2 -= L55_1[2] * x6; a3 -= L55_1[3] * x7; a0 -= L55_2[0] * x8; a1 -= L55_2[1] * x9; a2 -= L55_2[2] * x10; a3 -= L55_2[3] * x11; a0 -= L55_3[0] * x12; a1 -= L55_3[1] * x13; a2 -= L55_3[2] * x14; a3 -= L55_3[3] * x15; a0 -= L55_4[0] * x16; a1 -= L55_4[1] * x17; a2 -= L55_4[2] * x18; a3 -= L55_4[3] * x19; a0 -= L55_5[0] * x20; a1 -= L55_5[1] * x21; a2 -= L55_5[2] * x22; a3 -= L55_5[3] * x23; a0 -= L55_6[0] * x24; a1 -= L55_6[1] * x25; a2 -= L55_6[2] * x26; a3 -= L55_6[3] * x27; a0 -= L55_7[0] * x28; a1 -= L55_7[1] * x29; a2 -= L55_7[2] * x30; a3 -= L55_7[3] * x31; a0 -= L55_8[0] * x32; a1 -= L55_8[1] * x33; a2 -= L55_8[2] * x34; a3 -= L55_8[3] * x35; a0 -= L55_9[0] * x36; a1 -= L55_9[1] * x37; a2 -= L55_9[2] * x38; a3 -= L55_9[3] * x39; a0 -= L55_10[0] * x40; a1 -= L55_10[1] * x41; a2 -= L55_10[2] * x42; a3 -= L55_10[3] * x43; a0 -= L55_11[0] * x44; a1 -= L55_11[1] * x45; a2 -= L55_11[2] * x46; a3 -= L55_11[3] * x47; a0 -= L55_12[0] * x48; a1 -= L55_12[1] * x49; a2 -= L55_12[2] * x50; a3 -= L55_12[3] * x51; a0 -= L55_13[0] * x52; a1 -= L55_13[1] * x53; a2 -= L55_13[2] * x54; x55 = (a0 + a1) + (a2 + a3); }
        asm volatile("" ::: "memory");
        const float rr57 = X[57 * XS] * scp[57]; const f32x4 L57_0 = *(const LAS f32x4*)(LmV + 57 * LS + 0); const f32x4 L57_1 = *(const LAS f32x4*)(LmV + 57 * LS + 4); const f32x4 L56_2 = *(const LAS f32x4*)(LmV + 56 * LS + 8); const f32x4 L56_3 = *(const LAS f32x4*)(LmV + 56 * LS + 12); const f32x4 L56_4 = *(const LAS f32x4*)(LmV + 56 * LS + 16); const f32x4 L56_5 = *(const LAS f32x4*)(LmV + 56 * LS + 20); const f32x4 L56_6 = *(const LAS f32x4*)(LmV + 56 * LS + 24); const f32x4 L56_7 = *(const LAS f32x4*)(LmV + 56 * LS + 28); const f32x4 L56_8 = *(const LAS f32x4*)(LmV + 56 * LS + 32); const f32x4 L56_9 = *(const LAS f32x4*)(LmV + 56 * LS + 36); const f32x4 L56_10 = *(const LAS f32x4*)(LmV + 56 * LS + 40); const f32x4 L56_11 = *(const LAS f32x4*)(LmV + 56 * LS + 44); const f32x4 L56_12 = *(const LAS f32x4*)(LmV + 56 * LS + 48); const f32x4 L56_13 = *(const LAS f32x4*)(LmV + 56 * LS + 52);
        float x56; { float a0 = rr56, a1 = 0.f, a2 = 0.f, a3 = 0.f; a0 -= L56_0[0] * x0; a1 -= L56_0[1] * x1; a2 -= L56_0[2] * x2; a3 -= L56_0[3] * x3; a0 -= L56_1[0] * x4; a1 -= L56_1[1] * x5; a2 -= L56_1[2] * x6; a3 -= L56_1[3] * x7; a0 -= L56_2[0] * x8; a1 -= L56_2[1] * x9; a2 -= L56_2[2] * x10; a3 -= L56_2[3] * x11; a0 -= L56_3[0] * x12; a1 -= L56_3[1] * x13; a2 -= L56_3[2] * x14; a3 -= L56_3[3] * x15; a0 -= L56_4[0] * x16; a1 -= L56_4[1] * x17; a2 -= L56_4[2] * x18; a3 -= L56_4[3] * x19; a0 -= L56_5[0] * x20; a1 -= L56_5[1] * x21; a2 -= L56_5[2] * x22; a3 -= L56_5[3] * x23; a0 -= L56_6[0] * x24; a1 -= L56_6[1] * x25; a2 -= L56_6[2] * x26; a3 -= L56_6[3] * x27; a0 -= L56_7[0] * x28; a1 -= L56_7[1] * x29; a2 -= L56_7[2] * x30; a3 -= L56_7[3] * x31; a0 -= L56_8[0] * x32; a1 -= L56_8[1] * x33; a2 -= L56_8[2] * x34; a3 -= L56_8[3] * x35; a0 -= L56_9[0] * x36; a1 -= L56_9[1] * x37; a2 -= L56_9[2] * x38; a3 -= L56_9[3] * x39; a0 -= L56_10[0] * x40; a1 -= L56_10[1] * x41; a2 -= L56_10[2] * x42; a3 -= L56_10[3] * x43; a0 -= L56_11[0] * x44; a1 -= L56_11[1] * x45; a2 -= L56_11[2] * x46; a3 -= L56_11[3] * x47; a0 -= L56_12[0] * x48; a1 -= L56_12[1] * x49; a2 -= L56_12[2] * x50; a3 -= L56_12[3] * x51; a0 -= L56_13[0] * x52; a1 -= L56_13[1] * x53; a2 -= L56_13[2] * x54; a3 -= L56_13[3] * x55; x56 = (a0 + a1) + (a2 + a3); }
        asm volatile("" ::: "memory");
        const float rr58 = X[58 * XS] * scp[58]; const f32x4 L58_0 = *(const LAS f32x4*)(LmV + 58 * LS + 0); const f32x4 L58_1 = *(const LAS f32x4*)(LmV + 58 * LS + 4); const f32x4 L57_2 = *(const LAS f32x4*)(LmV + 57 * LS + 8); const f32x4 L57_3 = *(const LAS f32x4*)(LmV + 57 * LS + 12); const f32x4 L57_4 = *(const LAS f32x4*)(LmV + 57 * LS + 16); const f32x4 L57_5 = *(const LAS f32x4*)(LmV + 57 * LS + 20); const f32x4 L57_6 = *(const LAS f32x4*)(LmV + 57 * LS + 24); const f32x4 L57_7 = *(const LAS f32x4*)(LmV + 57 * LS + 28); const f32x4 L57_8 = *(const LAS f32x4*)(LmV + 57 * LS + 32); const f32x4 L57_9 = *(const LAS f32x4*)(LmV + 57 * LS + 36); const f32x4 L57_10 = *(const LAS f32x4*)(LmV + 57 * LS + 40); const f32x4 L57_11 = *(const LAS f32x4*)(LmV + 57 * LS + 44); const f32x4 L57_12 = *(const LAS f32x4*)(LmV + 57 * LS + 48); const f32x4 L57_13 = *(const LAS f32x4*)(LmV + 57 * LS + 52); const f32x4 L57_14 = *(const LAS f32x4*)(LmV + 57 * LS + 56);
        float x57; { float a0 = rr57, a1 = 0.f, a2 = 0.f, a3 = 0.f; a0 -= L57_0[0] * x0; a1 -= L57_0[1] * x1; a2 -= L57_0[2] * x2; a3 -= L57_0[3] * x3; a0 -= L57_1[0] * x4; a1 -= L57_1[1] * x5; a2 -= L57_1[2] * x6; a3 -= L57_1[3] * x7; a0 -= L57_2[0] * x8; a1 -= L57_2[1] * x9; a2 -= L57_2[2] * x10; a3 -= L57_2[3] * x11; a0 -= L57_3[0] * x12; a1 -= L57_3[1] * x13; a2 -= L57_3[2] * x14; a3 -= L57_3[3] * x15; a0 -= L57_4[0] * x16; a1 -= L57_4[1] * x17; a2 -= L57_4[2] * x18; a3 -= L57_4[3] * x19; a0 -= L57_5[0] * x20; a1 -= L57_5[1] * x21; a2 -= L57_5[2] * x22; a3 -= L57_5[3] * x23; a0 -= L57_6[0] * x24; a1 -= L57_6[1] * x25; a2 -= L57_6[2] * x26; a3 -= L57_6[3] * x27; a0 -= L57_7[0] * x28; a1 -= L57_7[1] * x29; a2 -= L57_7[2] * x30; a3 -= L57_7[3] * x31; a0 -= L57_8[0] * x32; a1 -= L57_8[1] * x33; a2 -= L57_8[2] * x34; a3 -= L57_8[3] * x35; a0 -= L57_9[0] * x36; a1 -= L57_9[1] * x37; a2 -= L57_9[2] * x38; a3 -= L57_9[3] * x39; a0 -= L57_10[0] * x40; a1 -= L57_10[1] * x41; a2 -= L57_10[2] * x42; a3 -= L57_10[3] * x43; a0 -= L57_11[0] * x44; a1 -= L57_11[1] * x45; a2 -= L57_11[2] * x46; a3 -= L57_11[3] * x47; a0 -= L57_12[0] * x48; a1 -= L57_12[1] * x49; a2 -= L57_12[2] * x50; a3 -= L57_12[3] * x51; a0 -= L57_13[0] * x52; a1 -= L57_13[1] * x53; a2 -= L57_13[2] * x54; a3 -= L57_13[3] * x55; a0 -= L57_14[0] * x56; x57 = (a0 + a1) + (a2 + a3); }
        asm volatile("" ::: "memory");
        const float rr59 = X[59 * XS] * scp[59]; const f32x4 L59_0 = *(const LAS f32x4*)(LmV + 59 * LS + 0); const f32x4 L59_1 = *(const LAS f32x4*)(LmV + 59 * LS + 4); const f32x4 L58_2 = *(const LAS f32x4*)(LmV + 58 * LS + 8); const f32x4 L58_3 = *(const LAS f32x4*)(LmV + 58 * LS + 12); const f32x4 L58_4 = *(const LAS f32x4*)(LmV + 58 * LS + 16); const f32x4 L58_5 = *(const LAS f32x4*)(LmV + 58 * LS + 20); const f32x4 L58_6 = *(const LAS f32x4*)(LmV + 58 * LS + 24); const f32x4 L58_7 = *(const LAS f32x4*)(LmV + 58 * LS + 28); const f32x4 L58_8 = *(const LAS f32x4*)(LmV + 58 * LS + 32); const f32x4 L58_9 = *(const LAS f32x4*)(LmV + 58 * LS + 36); const f32x4 L58_10 = *(const LAS f32x4*)(LmV + 58 * LS + 40); const f32x4 L58_11 = *(const LAS f32x4*)(LmV + 58 * LS + 44); const f32x4 L58_12 = *(const LAS f32x4*)(LmV + 58 * LS + 48); const f32x4 L58_13 = *(const LAS f32x4*)(LmV + 58 * LS + 52); const f32x4 L58_14 = *(const LAS f32x4*)(LmV + 58 * LS + 56);
        float x58; { float a0 = rr58, a1 = 0.f, a2 = 0.f, a3 = 0.f; a0 -= L58_0[0] * x0; a1 -= L58_0[1] * x1; a2 -= L58_0[2] * x2; a3 -= L58_0[3] * x3; a0 -= L58_1[0] * x4; a1 -= L58_1[1] * x5; a2 -= L58_1[2] * x6; a3 -= L58_1[3] * x7; a0 -= L58_2[0] * x8; a1 -= L58_2[1] * x9; a2 -= L58_2[2] * x10; a3 -= L58_2[3] * x11; a0 -= L58_3[0] * x12; a1 -= L58_3[1] * x13; a2 -= L58_3[2] * x14; a3 -= L58_3[3] * x15; a0 -= L58_4[0] * x16; a1 -= L58_4[1] * x17; a2 -= L58_4[2] * x18; a3 -= L58_4[3] * x19; a0 -= L58_5[0] * x20; a1 -= L58_5[1] * x21; a2 -= L58_5[2] * x22; a3 -= L58_5[3] * x23; a0 -= L58_6[0] * x24; a1 -= L58_6[1] * x25; a2 -= L58_6[2] * x26; a3 -= L58_6[3] * x27; a0 -= L58_7[0] * x28; a1 -= L58_7[1] * x29; a2 -= L58_7[2] * x30; a3 -= L58_7[3] * x31; a0 -= L58_8[0] * x32; a1 -= L58_8[1] * x33; a2 -= L58_8[2] * x34; a3 -= L58_8[3] * x35; a0 -= L58_9[0] * x36; a1 -= L58_9[1] * x37; a2 -= L58_9[2] * x38; a3 -= L58_9[3] * x39; a0 -= L58_10[0] * x40; a1 -= L58_10[1] * x41; a2 -= L58_10[2] * x42; a3 -= L58_10[3] * x43; a0 -= L58_11[0] * x44; a1 -= L58_11[1] * x45; a2 -= L58_11[2] * x46; a3 -= L58_11[3] * x47; a0 -= L58_12[0] * x48; a1 -= L58_12[1] * x49; a2 -= L58_12[2] * x50; a3 -= L58_12[3] * x51; a0 -= L58_13[0] * x52; a1 -= L58_13[1] * x53; a2 -= L58_13[2] * x54; a3 -= L58_13[3] * x55; a0 -= L58_14[0] * x56; a1 -= L58_14[1] * x57; x58 = (a0 + a1) + (a2 + a3); }
        asm volatile("" ::: "memory");
        const float rr60 = X[60 * XS] * scp[60]; const f32x4 L60_0 = *(const LAS f32x4*)(LmV + 60 * LS + 0); const f32x4 L60_1 = *(const LAS f32x4*)(LmV + 60 * LS + 4); const f32x4 L59_2 = *(const LAS f32x4*)(LmV + 59 * LS + 8); const f32x4 L59_3 = *(const LAS f32x4*)(LmV + 59 * LS + 12); const f32x4 L59_4 = *(const LAS f32x4*)(LmV + 59 * LS + 16); const f32x4 L59_5 = *(const LAS f32x4*)(LmV + 59 * LS + 20); const f32x4 L59_6 = *(const LAS f32x4*)(LmV + 59 * LS + 24); const f32x4 L59_7 = *(const LAS f32x4*)(LmV + 59 * LS + 28); const f32x4 L59_8 = *(const LAS f32x4*)(LmV + 59 * LS + 32); const f32x4 L59_9 = *(const LAS f32x4*)(LmV + 59 * LS + 36); const f32x4 L59_10 = *(const LAS f32x4*)(LmV + 59 * LS + 40); const f32x4 L59_11 = *(const LAS f32x4*)(LmV + 59 * LS + 44); const f32x4 L59_12 = *(const LAS f32x4*)(LmV + 59 * LS + 48); const f32x4 L59_13 = *(const LAS f32x4*)(LmV + 59 * LS + 52); const f32x4 L59_14 = *(const LAS f32x4*)(LmV + 59 * LS + 56);
        float x59; { float a0 = rr59, a1 = 0.f, a2 = 0.f, a3 = 0.f; a0 -= L59_0[0] * x0; a1 -= L59_0[1] * x1; a2 -= L59_0[2] * x2; a3 -= L59_0[3] * x3; a0 -= L59_1[0] * x4; a1 -= L59_1[1] * x5; a2 -= L59_1[2] * x6; a3 -= L59_1[3] * x7; a0 -= L59_2[0] * x8; a1 -= L59_2[1] * x9; a2 -= L59_2[2] * x10; a3 -= L59_2[3] * x11; a0 -= L59_3[0] * x12; a1 -= L59_3[1] * x13; a2 -= L59_3[2] * x14; a3 -= L59_3[3] * x15; a0 -= L59_4[0] * x16; a1 -= L59_4[1] * x17; a2 -= L59_4[2] * x18; a3 -= L59_4[3] * x19; a0 -= L59_5[0] * x20; a1 -= L59_5[1] * x21; a2 -= L59_5[2] * x22; a3 -= L59_5[3] * x23; a0 -= L59_6[0] * x24; a1 -= L59_6[1] * x25; a2 -= L59_6[2] * x26; a3 -= L59_6[3] * x27; a0 -= L59_7[0] * x28; a1 -= L59_7[1] * x29; a2 -= L59_7[2] * x30; a3 -= L59_7[3] * x31; a0 -= L59_8[0] * x32; a1 -= L59_8[1] * x33; a2 -= L59_8[2] * x34; a3 -= L59_8[3] * x35; a0 -= L59_9[0] * x36; a1 -= L59_9[1] * x37; a2 -= L59_9[2] * x38; a3 -= L59_9[3] * x39; a0 -= L59_10[0] * x40; a1 -= L59_10[1] * x41; a2 -= L59_10[2] * x42; a3 -= L59_10[3] * x43; a0 -= L59_11[0] * x44; a1 -= L59_11[1] * x45; a2 -= L59_11[2] * x46; a3 -= L59_11[3] * x47; a0 -= L59_12[0] * x48; a1 -= L59_12[1] * x49; a2 -= L59_12[2] * x50; a3 -= L59_12[3] * x51; a0 -= L59_13[0] * x52; a1 -= L59_13[1] * x53; a2 -= L59_13[2] * x54; a3 -= L59_13[3] * x55; a0 -= L59_14[0] * x56; a1 -= L59_14[1] * x57; a2 -= L59_14[2] * x58; x59 = (a0 + a1) + (a2 + a3); }
        asm volatile("" ::: "memory");
        const float rr61 = X[61 * XS] * scp[61]; const f32x4 L61_0 = *(const LAS f32x4*)(LmV + 61 * LS + 0); const f32x4 L61_1 = *(const LAS f32x4*)(LmV + 61 * LS + 4); const f32x4 L60_2 = *(const LAS f32x4*)(LmV + 60 * LS + 8); const f32x4 L60_3 = *(const LAS f32x4*)(LmV + 60 * LS + 12); const f32x4 L60_4 = *(const LAS f32x4*)(LmV + 60 * LS + 16); const f32x4 L60_5 = *(const LAS f32x4*)(LmV + 60 * LS + 20); const f32x4 L60_6 = *(const LAS f32x4*)(LmV + 60 * LS + 24); const f32x4 L60_7 = *(const LAS f32x4*)(LmV + 60 * LS + 28); const f32x4 L60_8 = *(const LAS f32x4*)(LmV + 60 * LS + 32); const f32x4 L60_9 = *(const LAS f32x4*)(LmV + 60 * LS + 36); const f32x4 L60_10 = *(const LAS f32x4*)(LmV + 60 * LS + 40); const f32x4 L60_11 = *(const LAS f32x4*)(LmV + 60 * LS + 44); const f32x4 L60_12 = *(const LAS f32x4*)(LmV + 60 * LS + 48); const f32x4 L60_13 = *(const LAS f32x4*)(LmV + 60 * LS + 52); const f32x4 L60_14 = *(const LAS f32x4*)(LmV + 60 * LS + 56);
        float x60; { float a0 = rr60, a1 = 0.f, a2 = 0.f, a3 = 0.f; a0 -= L60_0[0] * x0; a1 -= L60_0[1] * x1; a2 -= L60_0[2] * x2; a3 -= L60_0[3] * x3; a0 -= L60_1[0] * x4; a1 -= L60_1[1] * x5; a2 -= L60_1[2] * x6; a3 -= L60_1[3] * x7; a0 -= L60_2[0] * x8; a1 -= L60_2[1] * x9; a2 -= L60_2[2] * x10; a3 -= L60_2[3] * x11; a0 -= L60_3[0] * x12; a1 -= L60_3[1] * x13; a2 -= L60_3[2] * x14; a3 -= L60_3[3] * x15; a0 -= L60_4[0] * x16; a1 -= L60_4[1] * x17; a2 -= L60_4[2] * x18; a3 -= L60_4[3] * x19; a0 -= L60_5[0] * x20; a1 -= L60_5[1] * x21; a2 -= L60_5[2] * x22; a3 -= L60_5[3] * x23; a0 -= L60_6[0] * x24; a1 -= L60_6[1] * x25; a2 -= L60_6[2] * x26; a3 -= L60_6[3] * x27; a0 -= L60_7[0] * x28; a1 -= L60_7[1] * x29; a2 -= L60_7[2] * x30; a3 -= L60_7[3] * x31; a0 -= L60_8[0] * x32; a1 -= L60_8[1] * x33; a2 -= L60_8[2] * x34; a3 -= L60_8[3] * x35; a0 -= L60_9[0] * x36; a1 -= L60_9[1] * x37; a2 -= L60_9[2] * x38; a3 -= L60_9[3] * x39; a0 -= L60_10[0] * x40; a1 -= L60_10[1] * x41; a2 -= L60_10[2] * x42; a3 -= L60_10[3] * x43; a0 -= L60_11[0] * x44; a1 -= L60_11[1] * x45; a2 -= L60_11[2] * x46; a3 -= L60_11[3] * x47; a0 -= L60_12[0] * x48; a1 -= L60_12[1] * x49; a2 -= L60_12[2] * x50; a3 -= L60_12[3] * x51; a0 -= L60_13[0] * x52; a1 -= L60_13[1] * x53; a2 -= L60_13[2] * x54; a3 -= L60_13[3] * x55; a0 -= L60_14[0] * x56; a1 -= L60_14[1] * x57; a2 -= L60_14[2] * x58; a3 -= L60_14[3] * x59; x60 = (a0 + a1) + (a2 + a3); }
        asm volatile("" ::: "memory");
        const float rr62 = X[62 * XS] * scp[62]; const f32x4 L62_0 = *(const LAS f32x4*)(LmV + 62 * LS + 0); const f32x4 L62_1 = *(const LAS f32x4*)(LmV + 62 * LS + 4); const f32x4 L61_2 = *(const LAS f32x4*)(LmV + 61 * LS + 8); const f32x4 L61_3 = *(const LAS f32x4*)(LmV + 61 * LS + 12); const f32x4 L61_4 = *(const LAS f32x4*)(LmV + 61 * LS + 16); const f32x4 L61_5 = *(const LAS f32x4*)(LmV + 61 * LS + 20); const f32x4 L61_6 = *(const LAS f32x4*)(LmV + 61 * LS + 24); const f32x4 L61_7 = *(const LAS f32x4*)(LmV + 61 * LS + 28); const f32x4 L61_8 = *(const LAS f32x4*)(LmV + 61 * LS + 32); const f32x4 L61_9 = *(const LAS f32x4*)(LmV + 61 * LS + 36); const f32x4 L61_10 = *(const LAS f32x4*)(LmV + 61 * LS + 40); const f32x4 L61_11 = *(const LAS f32x4*)(LmV + 61 * LS + 44); const f32x4 L61_12 = *(const LAS f32x4*)(LmV + 61 * LS + 48); const f32x4 L61_13 = *(const LAS f32x4*)(LmV + 61 * LS + 52); const f32x4 L61_14 = *(const LAS f32x4*)(LmV + 61 * LS + 56); const f32x4 L61_15 = *(const LAS f32x4*)(LmV + 61 * LS + 60);
        float x61; { float a0 = rr61, a1 = 0.f, a2 = 0.f, a3 = 0.f; a0 -= L61_0[0] * x0; a1 -= L61_0[1] * x1; a2 -= L61_0[2] * x2; a3 -= L61_0[3] * x3; a0 -= L61_1[0] * x4; a1 -= L61_1[1] * x5; a2 -= L61_1[2] * x6; a3 -= L61_1[3] * x7; a0 -= L61_2[0] * x8; a1 -= L61_2[1] * x9; a2 -= L61_2[2] * x10; a3 -= L61_2[3] * x11; a0 -= L61_3[0] * x12; a1 -= L61_3[1] * x13; a2 -= L61_3[2] * x14; a3 -= L61_3[3] * x15; a0 -= L61_4[0] * x16; a1 -= L61_4[1] * x17; a2 -= L61_4[2] * x18; a3 -= L61_4[3] * x19; a0 -= L61_5[0] * x20; a1 -= L61_5[1] * x21; a2 -= L61_5[2] * x22; a3 -= L61_5[3] * x23; a0 -= L61_6[0] * x24; a1 -= L61_6[1] * x25; a2 -= L61_6[2] * x26; a3 -= L61_6[3] * x27; a0 -= L61_7[0] * x28; a1 -= L61_7[1] * x29; a2 -= L61_7[2] * x30; a3 -= L61_7[3] * x31; a0 -= L61_8[0] * x32; a1 -= L61_8[1] * x33; a2 -= L61_8[2] * x34; a3 -= L61_8[3] * x35; a0 -= L61_9[0] * x36; a1 -= L61_9[1] * x37; a2 -= L61_9[2] * x38; a3 -= L61_9[3] * x39; a0 -= L61_10[0] * x40; a1 -= L61_10[1] * x41; a2 -= L61_10[2] * x42; a3 -= L61_10[3] * x43; a0 -= L61_11[0] * x44; a1 -= L61_11[1] * x45; a2 -= L61_11[2] * x46; a3 -= L61_11[3] * x47; a0 -= L61_12[0] * x48; a1 -= L61_12[1] * x49; a2 -= L61_12[2] * x50; a3 -= L61_12[3] * x51; a0 -= L61_13[0] * x52; a1 -= L61_13[1] * x53; a2 -= L61_13[2] * x54; a3 -= L61_13[3] * x55; a0 -= L61_14[0] * x56; a1 -= L61_14[1] * x57; a2 -= L61_14[2] * x58; a3 -= L61_14[3] * x59; a0 -= L61_15[0] * x60; x61 = (a0 + a1) + (a2 + a3); }
        asm volatile("" ::: "memory");
        const float rr63 = X[63 * XS] * scp[63]; const f32x4 L63_0 = *(const LAS f32x4*)(LmV + 63 * LS + 0); const f32x4 L63_1 = *(const LAS f32x4*)(LmV + 63 * LS + 4); const f32x4 L62_2 = *(const LAS f32x4*)(LmV + 62 * LS + 8); const f32x4 L62_3 = *(const LAS f32x4*)(LmV + 62 * LS + 12); const f32x4 L62_4 = *(const LAS f32x4*)(LmV + 62 * LS + 16); const f32x4 L62_5 = *(const LAS f32x4*)(LmV + 62 * LS + 20); const f32x4 L62_6 = *(const LAS f32x4*)(LmV + 62 * LS + 24); const f32x4 L62_7 = *(const LAS f32x4*)(LmV + 62 * LS + 28); const f32x4 L62_8 = *(const LAS f32x4*)(LmV + 62 * LS + 32); const f32x4 L62_9 = *(const LAS f32x4*)(LmV + 62 * LS + 36); const f32x4 L62_10 = *(const LAS f32x4*)(LmV + 62 * LS + 40); const f32x4 L62_11 = *(const LAS f32x4*)(LmV + 62 * LS + 44); const f32x4 L62_12 = *(const LAS f32x4*)(LmV + 62 * LS + 48); const f32x4 L62_13 = *(const LAS f32x4*)(LmV + 62 * LS + 52); const f32x4 L62_14 = *(const LAS f32x4*)(LmV + 62 * LS + 56); const f32x4 L62_15 = *(const LAS f32x4*)(LmV + 62 * LS + 60);
        float x62; { float a0 = rr62, a1 = 0.f, a2 = 0.f, a3 = 0.f; a0 -= L62_0[0] * x0; a1 -= L62_0[1] * x1; a2 -= L62_0[2] * x2; a3 -= L62_0[3] * x3; a0 -= L62_1[0] * x4; a1 -= L62_1[1] * x5; a2 -= L62_1[2] * x6; a3 -= L62_1[3] * x7; a0 -= L62_2[0] * x8; a1 -= L62_2[1] * x9; a2 -= L62_2[2] * x10; a3 -= L62_2[3] * x11; a0 -= L62_3[0] * x12; a1 -= L62_3[1] * x13; a2 -= L62_3[2] * x14; a3 -= L62_3[3] * x15; a0 -= L62_4[0] * x16; a1 -= L62_4[1] * x17; a2 -= L62_4[2] * x18; a3 -= L62_4[3] * x19; a0 -= L62_5[0] * x20; a1 -= L62_5[1] * x21; a2 -= L62_5[2] * x22; a3 -= L62_5[3] * x23; a0 -= L62_6[0] * x24; a1 -= L62_6[1] * x25; a2 -= L62_6[2] * x26; a3 -= L62_6[3] * x27; a0 -= L62_7[0] * x28; a1 -= L62_7[1] * x29; a2 -= L62_7[2] * x30; a3 -= L62_7[3] * x31; a0 -= L62_8[0] * x32; a1 -= L62_8[1] * x33; a2 -= L62_8[2] * x34; a3 -= L62_8[3] * x35; a0 -= L62_9[0] * x36; a1 -= L62_9[1] * x37; a2 -= L62_9[2] * x38; a3 -= L62_9[3] * x39; a0 -= L62_10[0] * x40; a1 -= L62_10[1] * x41; a2 -= L62_10[2] * x42; a3 -= L62_10[3] * x43; a0 -= L62_11[0] * x44; a1 -= L62_11[1] * x45; a2 -= L62_11[2] * x46; a3 -= L62_11[3] * x47; a0 -= L62_12[0] * x48; a1 -= L62_12[1] * x49; a2 -= L62_12[2] * x50; a3 -= L62_12[3] * x51; a0 -= L62_13[0] * x52; a1 -= L62_13[1] * x53; a2 -= L62_13[2] * x54; a3 -= L62_13[3] * x55; a0 -= L62_14[0] * x56; a1 -= L62_14[1] * x57; a2 -= L62_14[2] * x58; a3 -= L62_14[3] * x59; a0 -= L62_15[0] * x60; a1 -= L62_15[1] * x61; x62 = (a0 + a1) + (a2 + a3); }
        asm volatile("" ::: "memory");
 const f32x4 L63_2 = *(const LAS f32x4*)(LmV + 63 * LS + 8); const f32x4 L63_3 = *(const LAS f32x4*)(LmV + 63 * LS + 12); const f32x4 L63_4 = *(const LAS f32x4*)(LmV + 63 * LS + 16); const f32x4 L63_5 = *(const LAS f32x4*)(LmV + 63 * LS + 20); const f32x4 L63_6 = *(const LAS f32x4*)(LmV + 63 * LS + 24); const f32x4 L63_7 = *(const LAS f32x4*)(LmV + 63 * LS + 28); const f32x4 L63_8 = *(const LAS f32x4*)(LmV + 63 * LS + 32); const f32x4 L63_9 = *(const LAS f32x4*)(LmV + 63 * LS + 36); const f32x4 L63_10 = *(const LAS f32x4*)(LmV + 63 * LS + 40); const f32x4 L63_11 = *(const LAS f32x4*)(LmV + 63 * LS + 44); const f32x4 L63_12 = *(const LAS f32x4*)(LmV + 63 * LS + 48); const f32x4 L63_13 = *(const LAS f32x4*)(LmV + 63 * LS + 52); const f32x4 L63_14 = *(const LAS f32x4*)(LmV + 63 * LS + 56); const f32x4 L63_15 = *(const LAS f32x4*)(LmV + 63 * LS + 60);
        float x63; { float a0 = rr63, a1 = 0.f, a2 = 0.f, a3 = 0.f; a0 -= L63_0[0] * x0; a1 -= L63_0[1] * x1; a2 -= L63_0[2] * x2; a3 -= L63_0[3] * x3; a0 -= L63_1[0] * x4; a1 -= L63_1[1] * x5; a2 -= L63_1[2] * x6; a3 -= L63_1[3] * x7; a0 -= L63_2[0] * x8; a1 -= L63_2[1] * x9; a2 -= L63_2[2] * x10; a3 -= L63_2[3] * x11; a0 -= L63_3[0] * x12; a1 -= L63_3[1] * x13; a2 -= L63_3[2] * x14; a3 -= L63_3[3] * x15; a0 -= L63_4[0] * x16; a1 -= L63_4[1] * x17; a2 -= L63_4[2] * x18; a3 -= L63_4[3] * x19; a0 -= L63_5[0] * x20; a1 -= L63_5[1] * x21; a2 -= L63_5[2] * x22; a3 -= L63_5[3] * x23; a0 -= L63_6[0] * x24; a1 -= L63_6[1] * x25; a2 -= L63_6[2] * x26; a3 -= L63_6[3] * x27; a0 -= L63_7[0] * x28; a1 -= L63_7[1] * x29; a2 -= L63_7[2] * x30; a3 -= L63_7[3] * x31; a0 -= L63_8[0] * x32; a1 -= L63_8[1] * x33; a2 -= L63_8[2] * x34; a3 -= L63_8[3] * x35; a0 -= L63_9[0] * x36; a1 -= L63_9[1] * x37; a2 -= L63_9[2] * x38; a3 -= L63_9[3] * x39; a0 -= L63_10[0] * x40; a1 -= L63_10[1] * x41; a2 -= L63_10[2] * x42; a3 -= L63_10[3] * x43; a0 -= L63_11[0] * x44; a1 -= L63_11[1] * x45; a2 -= L63_11[2] * x46; a3 -= L63_11[3] * x47; a0 -= L63_12[0] * x48; a1 -= L63_12[1] * x49; a2 -= L63_12[2] * x50; a3 -= L63_12[3] * x51; a0 -= L63_13[0] * x52; a1 -= L63_13[1] * x53; a2 -= L63_13[2] * x54; a3 -= L63_13[3] * x55; a0 -= L63_14[0] * x56; a1 -= L63_14[1] * x57; a2 -= L63_14[2] * x58; a3 -= L63_14[3] * x59; a0 -= L63_15[0] * x60; a1 -= L63_15[1] * x61; a2 -= L63_15[2] * x62; x63 = (a0 + a1) + (a2 + a3); }
        if (isv) {
            *(f32x4*)(UT + (size_t)c * 64 + 0) = (f32x4){x0, x1, x2, x3};
            *(f32x4*)(UT + (size_t)c * 64 + 4) = (f32x4){x4, x5, x6, x7};
            *(f32x4*)(UT + (size_t)c * 64 + 8) = (f32x4){x8, x9, x10, x11};
            *(f32x4*)(UT + (size_t)c * 64 + 12) = (f32x4){x12, x13, x14, x15};
            *(f32x4*)(UT + (size_t)c * 64 + 16) = (f32x4){x16, x17, x18, x19};
            *(f32x4*)(UT + (size_t)c * 64 + 20) = (f32x4){x20, x21, x22, x23};
            *(f32x4*)(UT + (size_t)c * 64 + 24) = (f32x4){x24, x25, x26, x27};
            *(f32x4*)(UT + (size_t)c * 64 + 28) = (f32x4){x28, x29, x30, x31};
            *(f32x4*)(UT + (size_t)c * 64 + 32) = (f32x4){x32, x33, x34, x35};
            *(f32x4*)(UT + (size_t)c * 64 + 36) = (f32x4){x36, x37, x38, x39};
            *(f32x4*)(UT + (size_t)c * 64 + 40) = (f32x4){x40, x41, x42, x43};
            *(f32x4*)(UT + (size_t)c * 64 + 44) = (f32x4){x44, x45, x46, x47};
            *(f32x4*)(UT + (size_t)c * 64 + 48) = (f32x4){x48, x49, x50, x51};
            *(f32x4*)(UT + (size_t)c * 64 + 52) = (f32x4){x52, x53, x54, x55};
            *(f32x4*)(UT + (size_t)c * 64 + 56) = (f32x4){x56, x57, x58, x59};
            *(f32x4*)(UT + (size_t)c * 64 + 60) = (f32x4){x60, x61, x62, x63};
        } else {
            WN[0 * 128 + (c - 128)] = (bf16)f2bf(-x0);
            WN[1 * 128 + (c - 128)] = (bf16)f2bf(-x1);
            WN[2 * 128 + (c - 128)] = (bf16)f2bf(-x2);
            WN[3 * 128 + (c - 128)] = (bf16)f2bf(-x3);
            WN[4 * 128 + (c - 128)] = (bf16)f2bf(-x4);
            WN[5 * 128 + (c - 128)] = (bf16)f2bf(-x5);
            WN[6 * 128 + (c - 128)] = (bf16)f2bf(-x6);
            WN[7 * 128 + (c - 128)] = (bf16)f2bf(-x7);
            WN[8 * 128 + (c - 128)] = (bf16)f2bf(-x8);
            WN[9 * 128 + (c - 128)] = (bf16)f2bf(-x9);
            WN[10 * 128 + (c - 128)] = (bf16)f2bf(-x10);
            WN[11 * 128 + (c - 128)] = (bf16)f2bf(-x11);
            WN[12 * 128 + (c - 128)] = (bf16)f2bf(-x12);
            WN[13 * 128 + (c - 128)] = (bf16)f2bf(-x13);
            WN[14 * 128 + (c - 128)] = (bf16)f2bf(-x14);
            WN[15 * 128 + (c - 128)] = (bf16)f2bf(-x15);
            WN[16 * 128 + (c - 128)] = (bf16)f2bf(-x16);
            WN[17 * 128 + (c - 128)] = (bf16)f2bf(-x17);
            WN[18 * 128 + (c - 128)] = (bf16)f2bf(-x18);
            WN[19 * 128 + (c - 128)] = (bf16)f2bf(-x19);
            WN[20 * 128 + (c - 128)] = (bf16)f2bf(-x20);
            WN[21 * 128 + (c - 128)] = (bf16)f2bf(-x21);
            WN[22 * 128 + (c - 128)] = (bf16)f2bf(-x22);
            WN[23 * 128 + (c - 128)] = (bf16)f2bf(-x23);
            WN[24 * 128 + (c - 128)] = (bf16)f2bf(-x24);
            WN[25 * 128 + (c - 128)] = (bf16)f2bf(-x25);
            WN[26 * 128 + (c - 128)] = (bf16)f2bf(-x26);
            WN[27 * 128 + (c - 128)] = (bf16)f2bf(-x27);
            WN[28 * 128 + (c - 128)] = (bf16)f2bf(-x28);
            WN[29 * 128 + (c - 128)] = (bf16)f2bf(-x29);
            WN[30 * 128 + (c - 128)] = (bf16)f2bf(-x30);
            WN[31 * 128 + (c - 128)] = (bf16)f2bf(-x31);
            WN[32 * 128 + (c - 128)] = (bf16)f2bf(-x32);
            WN[33 * 128 + (c - 128)] = (bf16)f2bf(-x33);
            WN[34 * 128 + (c - 128)] = (bf16)f2bf(-x34);
            WN[35 * 128 + (c - 128)] = (bf16)f2bf(-x35);
            WN[36 * 128 + (c - 128)] = (bf16)f2bf(-x36);
            WN[37 * 128 + (c - 128)] = (bf16)f2bf(-x37);
            WN[38 * 128 + (c - 128)] = (bf16)f2bf(-x38);
            WN[39 * 128 + (c - 128)] = (bf16)f2bf(-x39);
            WN[40 * 128 + (c - 128)] = (bf16)f2bf(-x40);
            WN[41 * 128 + (c - 128)] = (bf16)f2bf(-x41);
            WN[42 * 128 + (c - 128)] = (bf16)f2bf(-x42);
            WN[43 * 128 + (c - 128)] = (bf16)f2bf(-x43);
            WN[44 * 128 + (c - 128)] = (bf16)f2bf(-x44);
            WN[45 * 128 + (c - 128)] = (bf16)f2bf(-x45);
            WN[46 * 128 + (c - 128)] = (bf16)f2bf(-x46);
            WN[47 * 128 + (c - 128)] = (bf16)f2bf(-x47);
            WN[48 * 128 + (c - 128)] = (bf16)f2bf(-x48);
            WN[49 * 128 + (c - 128)] = (bf16)f2bf(-x49);
            WN[50 * 128 + (c - 128)] = (bf16)f2bf(-x50);
            WN[51 * 128 + (c - 128)] = (bf16)f2bf(-x51);
            WN[52 * 128 + (c - 128)] = (bf16)f2bf(-x52);
            WN[53 * 128 + (c - 128)] = (bf16)f2bf(-x53);
            WN[54 * 128 + (c - 128)] = (bf16)f2bf(-x54);
            WN[55 * 128 + (c - 128)] = (bf16)f2bf(-x55);
            WN[56 * 128 + (c - 128)] = (bf16)f2bf(-x56);
            WN[57 * 128 + (c - 128)] = (bf16)f2bf(-x57);
            WN[58 * 128 + (c - 128)] = (bf16)f2bf(-x58);
            WN[59 * 128 + (c - 128)] = (bf16)f2bf(-x59);
            WN[60 * 128 + (c - 128)] = (bf16)f2bf(-x60);
            WN[61 * 128 + (c - 128)] = (bf16)f2bf(-x61);
            WN[62 * 128 + (c - 128)] = (bf16)f2bf(-x62);
            WN[63 * 128 + (c - 128)] = (bf16)f2bf(-x63);
        }
    } else {
        const int t2 = tid - 256;
        { const int i = t2 >> 2, d0 = (t2 & 3) * 32; const float e = expf(gcs[i]);
#pragma unroll
          for (int q8 = 0; q8 < 4; ++q8) { const f32x4 a = *(const LAS f32x4*)(XQ + i * XS + d0 + 8 * q8), c = *(const LAS f32x4*)(XQ + i * XS + d0 + 8 * q8 + 4);
              v4u o; o.x = pk2(a[0] * e, a[1] * e); o.y = pk2(a[2] * e, a[3] * e); o.z = pk2(c[0] * e, c[1] * e); o.w = pk2(c[2] * e, c[3] * e);
              *(v4u*)(QG + (size_t)i * 128 + d0 + 8 * q8) = o; } }
        { const int d = t2 >> 1, i0 = (t2 & 1) * 32; const float gl = gcs[63];
#pragma unroll
          for (int q8 = 0; q8 < 4; ++q8) { float v[8];
#pragma unroll
              for (int e = 0; e < 8; ++e) { const int i = i0 + 8 * q8 + e; v[e] = XK[i * XS + d] * expf(gl - gcs[i]); }
              v4u o; o.x = pk2(v[0], v[1]); o.y = pk2(v[2], v[3]); o.z = pk2(v[4], v[5]); o.w = pk2(v[6], v[7]);
              *(v4u*)(KGT + (size_t)d * 64 + i0 + 8 * q8) = o; } }
        if (t2 == 0) GL[unit] = expf(gcs[63]);
    }
    __syncthreads();
}

__device__ __forceinline__ int sw256(int row, int ch) { return row * 256 + ((ch ^ (row & 15)) << 4); }
__device__ __forceinline__ int sw128(int row, int ch) { return row * 128 + ((ch ^ ((row >> 1) & 7)) << 4); }
__device__ __forceinline__ void gdnb_unit(const Params& P, LAS unsigned char* lds, int bh) {
    typedef float f32x4_ __attribute__((ext_vector_type(4)));
    const int tid = threadIdx.x, wid = __builtin_amdgcn_readfirstlane(tid >> 6), lane = tid & 63, fr = lane & 15, fq = lane >> 4;
    const int b = bh >> 2, h = bh & 3;
    const float* w_gnorm = P.in[14];
    const bf16* ZB = (const bf16*)(P.ws + WS_ZB); bf16* MIX = (bf16*)(P.ws + WS_MIX);
    LAS unsigned char* Wl = lds;
    LAS unsigned char* Ql = lds + 16384;
    LAS unsigned char* Kl = lds + 32768;
    LAS unsigned char* Ml = lds + 49152;
    LAS unsigned char* STl = lds + 57344;
    LAS unsigned char* VTl = lds + 90112;
    LAS float* red = (LAS float*)(lds + 106496);
    f32x4_ S[8];
#pragma unroll
    for (int i = 0; i < 8; ++i) S[i] = (f32x4_){0.f, 0.f, 0.f, 0.f};
    const int e = 16 * wid + fr;
    {
#pragma unroll
        for (int db = 0; db < 8; ++db) *(LAS v2u*)(STl + sw256(e, (16 * db + 4 * fq) >> 3) + ((4 * fq) & 7) * 2) = (v2u){0u, 0u};
    }
    const float gn = w_gnorm[e];
    for (int n = 0; n < NCHUNK; ++n) {
        const int unit = bh * 32 + n;
        const bf16* WN = (const bf16*)(P.ws + WS_WN) + (size_t)unit * 8192; const bf16* QG = (const bf16*)(P.ws + WS_QG) + (size_t)unit * 8192;
        const bf16* KGT = (const bf16*)(P.ws + WS_KGT) + (size_t)unit * 8192; const bf16* QKM = (const bf16*)(P.ws + WS_QKM) + (size_t)unit * 4096;
        const float* UT = (const float*)(P.ws + WS_UT) + (size_t)unit * 8192;
        const float gl = ((const float*)(P.ws + WS_GL))[unit];
#pragma unroll
        for (int i = 0; i < 2; ++i) { const int idx = tid + 512 * i; const int r = idx >> 4, ch = idx & 15;
            *(LAS v4u*)(Wl + sw256(r, ch)) = *(const v4u*)(WN + (size_t)idx * 8); *(LAS v4u*)(Ql + sw256(r, ch)) = *(const v4u*)(QG + (size_t)idx * 8); }
#pragma unroll
        for (int i = 0; i < 2; ++i) { const int idx = tid + 512 * i; const int r = idx >> 3, ch = idx & 7; *(LAS v4u*)(Kl + sw128(r, ch)) = *(const v4u*)(KGT + (size_t)idx * 8); }
        { const int idx = tid; const int r = idx >> 3, ch = idx & 7; *(LAS v4u*)(Ml + sw128(r, ch)) = *(const v4u*)(QKM + (size_t)idx * 8); }
        __syncthreads();
        bf16x8 sb[4];
#pragma unroll
        for (int ks = 0; ks < 4; ++ks) sb[ks] = *(const LAS bf16x8*)(STl + sw256(e, 4 * ks + fq));
        f32x4_ vn[4];
#pragma unroll
        for (int rb = 0; rb < 4; ++rb) {
            vn[rb] = *(const f32x4_*)(UT + (size_t)e * 64 + 16 * rb + 4 * fq);
#pragma unroll
            for (int ks = 0; ks < 4; ++ks) { const bf16x8 a = *(const LAS bf16x8*)(Wl + sw256(16 * rb + fr, 4 * ks + fq)); vn[rb] = __builtin_amdgcn_mfma_f32_16x16x32_bf16(a, sb[ks], vn[rb], 0, 0, 0); }
            v2u o; o.x = pk2(vn[rb][0], vn[rb][1]); o.y = pk2(vn[rb][2], vn[rb][3]);
            *(LAS v2u*)(VTl + sw128(e, (16 * rb + 4 * fq) >> 3) + ((4 * fq) & 7) * 2) = o;
        }
        bf16x8 vb[2];
#pragma unroll
        for (int ks = 0; ks < 2; ++ks) vb[ks] = *(const LAS bf16x8*)(VTl + sw128(e, 4 * ks + fq));
        f32x4_ oo[4];
#pragma unroll
        for (int rb = 0; rb < 4; ++rb) {
            oo[rb] = (f32x4_){0.f, 0.f, 0.f, 0.f};
#pragma unroll
            for (int ks = 0; ks < 4; ++ks) { const bf16x8 a = *(const LAS bf16x8*)(Ql + sw256(16 * rb + fr, 4 * ks + fq)); oo[rb] = __builtin_amdgcn_mfma_f32_16x16x32_bf16(a, sb[ks], oo[rb], 0, 0, 0); }
#pragma unroll
            for (int ks = 0; ks < 2; ++ks) { const bf16x8 a = *(const LAS bf16x8*)(Ml + sw128(16 * rb + fr, 4 * ks + fq)); oo[rb] = __builtin_amdgcn_mfma_f32_16x16x32_bf16(a, vb[ks], oo[rb], 0, 0, 0); }
        }
#pragma unroll
        for (int db = 0; db < 8; ++db) {
            S[db] = S[db] * gl;
#pragma unroll
            for (int ks = 0; ks < 2; ++ks) { const bf16x8 a = *(const LAS bf16x8*)(Kl + sw128(16 * db + fr, 4 * ks + fq)); S[db] = __builtin_amdgcn_mfma_f32_16x16x32_bf16(a, vb[ks], S[db], 0, 0, 0); }
            v2u o; o.x = pk2(S[db][0], S[db][1]); o.y = pk2(S[db][2], S[db][3]);
            *(LAS v2u*)(STl + sw256(e, (16 * db + 4 * fq) >> 3) + ((4 * fq) & 7) * 2) = o;
        }
#pragma unroll
        for (int rb = 0; rb < 4; ++rb)
#pragma unroll
            for (int j = 0; j < 4; ++j) { float s = oo[rb][j] * oo[rb][j];
                s += __shfl_xor(s, 1); s += __shfl_xor(s, 2); s += __shfl_xor(s, 4); s += __shfl_xor(s, 8);
                if (fr == 0) red[(16 * rb + 4 * fq + j) * 8 + wid] = s; }
        __syncthreads();
#pragma unroll
        for (int rb = 0; rb < 4; ++rb)
#pragma unroll
            for (int j = 0; j < 4; ++j) { const int c = 16 * rb + 4 * fq + j;
                const f32x4_ r0 = *(const LAS f32x4_*)(red + c * 8), r1 = *(const LAS f32x4_*)(red + c * 8 + 4);
                const float ss = ((r0[0] + r0[1]) + (r0[2] + r0[3])) + ((r1[0] + r1[1]) + (r1[2] + r1[3]));
                const float rstd = 1.0f / sqrtf(ss * (1.0f / 128.0f) + RMS_EPS);
                const size_t m = (size_t)b * SEQ + n * GCH + c;
                const float z = bf2f(ZB[m * 512 + h * 128 + e]);
                MIX[m * DM + 512 + h * 128 + e] = (bf16)f2bf(oo[rb][j] * rstd * gn * silu_f(z)); }
        __syncthreads();
    }
    float* So = P.out + OSSM_P + (size_t)bh * 16384;
#pragma unroll
    for (int db = 0; db < 8; ++db)
#pragma unroll
        for (int j = 0; j < 4; ++j) So[(size_t)(16 * db + 4 * fq + j) * 128 + e] = S[db][j];
}


__device__ __forceinline__ void phase_final(const Params& P, const Ctx& C) {
    const float* ln_f = P.in[19]; const float* SSQ2 = (const float*)(P.ws + WS_SSQ2);
    const int gw = C.vcu * NWAVES + C.wave, NGW = C.G * NWAVES, lane = C.lane;
    f32x4 lw[4];
#pragma unroll
    for (int j = 0; j < 4; ++j) lw[j] = ((const f32x4*)ln_f)[lane + 64 * j];
    for (int m = gw; m < M_TOT; m += NGW) {
        const f32x4* sp = (const f32x4*)(SSQ2 + (size_t)m * 16);
        const f32x4 a = sp[0], b = sp[1], c = sp[2], d = sp[3];
        const float ss = ((a[0] + a[1]) + (a[2] + a[3])) + ((b[0] + b[1]) + (b[2] + b[3])) + ((c[0] + c[1]) + (c[2] + c[3])) + ((d[0] + d[1]) + (d[2] + d[3]));
        const float rstd = 1.0f / sqrtf(ss * (1.0f / DM) + RMS_EPS);
        float* yr = m < MP ? P.out + OY_P + (size_t)m * DM : P.out + OY_S + (size_t)(m - MP) * DM;
#pragma unroll
        for (int j = 0; j < 4; ++j) { f32x4 v = ((const f32x4*)yr)[lane + 64 * j]; v = v * rstd * lw[j]; ((f32x4*)yr)[lane + 64 * j] = v; }
    }
}

constexpr int NPHASES = 8;
__global__ void __launch_bounds__(NWAVES * 64, 2) fwd_kernel(Params P) {
    extern __shared__ __attribute__((aligned(16))) unsigned char shm[];
    LAS unsigned char* lds = (LAS unsigned char*)shm;
    Ctx C; C.tid = threadIdx.x; C.lane = C.tid & 63; C.wave = __builtin_amdgcn_readfirstlane(C.tid >> 6);
    C.G = gridDim.x; { const int bx = blockIdx.x; C.vcu = (C.G % 8 == 0) ? (bx % 8) * (C.G / 8) + bx / 8 : bx; }
    volatile LAS unsigned* MISC = (volatile LAS unsigned*)(lds + MISC_OFF);
    if (C.tid < 64) MISC[C.tid] = 0u;
    __syncthreads();
    unsigned* ctl = (unsigned*)(P.ws + WS_CTL);
    const int lo = P.ph_lo, hi = P.ph_hi;
    XcdBarrier bar; bar.bar = ctl + CW_BAR; bar.x = 0; bar.st = nullptr;
    if (hi - lo > 1) bar = xcd_barrier_post(ctl + CW_BAR, MISC + 8);
#ifndef SUBMASK
#define SUBMASK 15
#endif
#ifndef PHASE_MASK
#define PHASE_MASK 0xff
#endif
#define IN(k) (((PHASE_MASK >> (k)) & 1) && lo <= (k) && (k) < hi)
#define SEAM(k) do { if (IN(k) && IN((k) + 1)) xcd_barrier(bar); } while (0)
    unsigned char* ws = P.ws;

    if (IN(0)) { phase_prep(P, C, lds); SEAM(0); }

    if (IN(1)) {
        if (C.wave == 0) for (int bh = C.vcu; bh < NB * NH; bh += C.G) kbias_seq(P, bh, C.lane);
        pg8::Gemm g{(const pg8::bf16_t*)(ws + WS_XN), (const pg8::bf16_t*)(ws + WS_W1T), M_PAD, N1, DM};
        pg8::StaticOrder S; S.init(M_PAD, N1, C.G, (int)blockIdx.x);
        pg8::EpiIn E{(pg8::bf16_t*)(ws + WS_QB), (float*)(ws + WS_QS), (pg8::bf16_t*)(ws + WS_CB), (pg8::bf16_t*)(ws + WS_ZB), P.out};
        pg8::gemm_phase<pg8::EpiIn, pg8::StaticOrder, true, true>(lds, g, S, E);
        SEAM(1);
    }

    if (IN(2)) {
        for (int it = C.vcu; it < 256; it += C.G) {
            const int xg = it >> 5, slot = it & 31, idx = slot >> 1;
            if ((slot & 1) == 0) {
                const int bh = xg * 4 + (idx >> 2), x = idx & 3, b = bh >> 2, h = bh & 3;
                const bf16* Qh = (const bf16*)(ws + WS_QB) + (size_t)bh * SEQ * HD; const bf16* Kh = (const bf16*)(ws + WS_KB) + (size_t)bh * SEQ * HD; const bf16* Vh = (const bf16*)(ws + WS_VB) + (size_t)bh * SEQ * HD;
                const float* kbias = (const float*)(ws + WS_KBIAS) + (size_t)bh * SEQ;
                bf16* Orow0 = (bf16*)(ws + WS_MIX) + (size_t)b * SEQ * DM + h * HD;
#if SUBMASK & 1
                fox::fox_block((char*)shm, Qh, Kh, Vh, kbias, Orow0, 7 - x);
                fox::fox_block((char*)shm, Qh, Kh, Vh, kbias, Orow0, x);
#endif
            } else {
                const int db = xg * 16 + idx;
#if SUBMASK & 2
                decode_unit(P, lds, db);
#endif
#if SUBMASK & 4
                for (int h = 0; h < NH; ++h) sgdn_unit(P, lds, db, h);
#endif
            }
        }
#if SUBMASK & 8
        for (int u = C.vcu; u < NB * NH * NCHUNK; u += C.G) gdna_unit(P, lds, u);
#endif
        SEAM(2);
    }

    if (IN(3)) {
        for (int bh = blockIdx.x; bh < NB * NH; bh += C.G) gdnb_unit(P, lds, bh);
        SEAM(3);
    }

    if (IN(4)) {
        pg8::Gemm g{(const pg8::bf16_t*)(ws + WS_MIX), (const pg8::bf16_t*)(ws + WS_WOT), M_PAD, DM, DM};
        pg8::StaticOrder S; S.init(M_PAD, DM, C.G, (int)blockIdx.x);
        pg8::EpiRes E{P.in[0], P.in[1], P.out, (pg8::bf16_t*)(ws + WS_HB), (float*)(ws + WS_SSQ)};
        pg8::gemm_phase<pg8::EpiRes, pg8::StaticOrder, true, true>(lds, g, S, E);
        SEAM(4);
    }

    if (IN(5)) {
        pg8::Gemm g{(const pg8::bf16_t*)(ws + WS_HB), (const pg8::bf16_t*)(ws + WS_WUPT), M_PAD, FF, DM};
        pg8::StaticOrder S; S.init(M_PAD, FF, C.G, (int)blockIdx.x);
        pg8::EpiUp E{(pg8::bf16_t*)(ws + WS_UB), (const float*)(ws + WS_SSQ)};
        pg8::gemm_phase<pg8::EpiUp, pg8::StaticOrder, true, true>(lds, g, S, E);
        SEAM(5);
    }

    if (IN(6)) {
        pg8::Gemm g{(const pg8::bf16_t*)(ws + WS_UB), (const pg8::bf16_t*)(ws + WS_WDNT), M_PAD, DM, FF};
        pg8::StaticOrder S; S.init(M_PAD, DM, C.G, (int)blockIdx.x);
        pg8::EpiDown E{P.out, (float*)(ws + WS_SSQ2)};
        pg8::gemm_phase<pg8::EpiDown, pg8::StaticOrder, true, true>(lds, g, S, E);
        SEAM(6);
    }

    if (IN(7)) phase_final(P, C);
#undef IN
#undef SEAM
}

#ifndef N_LAUNCH_MODE
#define N_LAUNCH_MODE 1
#endif
extern "C" void kernel_launch(void* const* d_in, const int* in_sizes, int n_in, void* d_out, int out_size, void* d_ws, size_t ws_size, hipStream_t stream) {
    static int grid = 0;
    if (grid == 0) {
        if (n_in != 20 || out_size != (int)OUT_TOTAL || ws_size < WS_END) { fprintf(stderr, "kernel_launch: unexpected shapes (n_in %d, out %d, ws %zu); nothing launched\n", n_in, out_size, ws_size); grid = -1; return; }
        int dev = 0, cus = 0, per_cu = 0;
        if (hipGetDevice(&dev) != hipSuccess || hipDeviceGetAttribute(&cus, hipDeviceAttributeMultiprocessorCount, dev) != hipSuccess) { grid = -1; return; }
        if (hipFuncSetAttribute((const void*)fwd_kernel, hipFuncAttributeMaxDynamicSharedMemorySize, LDS_BYTES) != hipSuccess) { fprintf(stderr, "kernel_launch: hipFuncSetAttribute failed\n"); grid = -1; return; }
        if (hipOccupancyMaxActiveBlocksPerMultiprocessor(&per_cu, (const void*)fwd_kernel, NWAVES * 64, LDS_BYTES) != hipSuccess || per_cu < 1)
            fprintf(stderr, "kernel_launch: note: occupancy query reports %d workgroups per CU\n", per_cu);
        (void)hipGetLastError();
        grid = cus;
    }
    if (grid < 0) return;
    if (hipMemsetAsync((char*)d_ws + WS_CTL, 0, CTL_ZERO_BYTES, stream) != hipSuccess) return;
    Params p{};
    for (int i = 0; i < 20; ++i) p.in[i] = (const float*)d_in[i];
    p.out = (float*)d_out; p.ws = (unsigned char*)d_ws;
    if (N_LAUNCH_MODE == 1) {
        p.ph_lo = 0; p.ph_hi = NPHASES;
        hipLaunchKernelGGL(fwd_kernel, dim3(grid), dim3(NWAVES * 64), LDS_BYTES, stream, p);
    } else {
        for (int k = 0; k < NPHASES; ++k) { p.ph_lo = k; p.ph_hi = k + 1; hipLaunchKernelGGL(fwd_kernel, dim3(grid), dim3(NWAVES * 64), LDS_BYTES, stream, p); }
    }
}
```

```cpp
#include <hip/hip_runtime.h>
#include <hip/hip_bf16.h>
#include <cstdio>
#include <cstdint>

constexpr int DM = 1024, NB = 8, SEQ = 2048, DECB = 128, PAST = 2048, PAGE = 128, NPAGES = 16;
constexpr int NH = 4, HD = 128, CONVD = 1536, FF = 4096, INDIM = 3596, GCH = 64, NCHUNK = SEQ / GCH;
constexpr int MP = NB * SEQ;
constexpr int M_TOT = MP + DECB;
constexpr int M_PAD = 16640;
constexpr int N1 = 3584;
constexpr float RMS_EPS = 1e-6f, L2_EPS = 1e-6f;
constexpr float ATT_SCALE = 0.08838834764831845f;
constexpr size_t OY_P = 0, OY_S = 16777216, OK_P = 16908288, OV_P = 25296896, OLF_P = 33685504, OCONV_P = 33751040, OSSM_P = 33787904,
                 OK_S = 34312192, OV_S = 34377728, OLF_S = 34443264, OCONV_S = 34443776, OSSM_S = 35033600, OUT_TOTAL = 43422208;
constexpr size_t MiB = 1u << 20;
constexpr size_t WS_CTL = 0, CTL_ZERO_BYTES = 1 * MiB;
constexpr size_t WS_W1T = 2 * MiB, WS_WOT = 10 * MiB, WS_WUPT = 12 * MiB, WS_WDNT = 21 * MiB;
constexpr size_t WS_XN = 32 * MiB, WS_QB = 68 * MiB, WS_KB = 84 * MiB, WS_VB = 100 * MiB, WS_CB = 116 * MiB, WS_ZB = 166 * MiB;
constexpr size_t WS_MIX = 184 * MiB, WS_HB = 218 * MiB, WS_UB = 252 * MiB;
constexpr size_t WS_UT = 384 * MiB, WS_WN = 416 * MiB, WS_QG = 432 * MiB, WS_KGT = 448 * MiB, WS_QKM = 464 * MiB;
constexpr size_t WS_LF = 472 * MiB, WS_BETA = 473 * MiB, WS_G = 474 * MiB, WS_KBIAS = 475 * MiB, WS_QS = 476 * MiB, WS_SSQ = 477 * MiB, WS_SSQ2 = 479 * MiB, WS_GL = 481 * MiB, WS_SSQS = 482 * MiB, WS_PART = 483 * MiB;
constexpr size_t WS_END = 486 * MiB;
constexpr int CW_TMO = 0, CW_BAR = 4096;
constexpr size_t QKV_STRIDE = (WS_KB - WS_QB) / 2;
static_assert(WS_VB - WS_KB == WS_KB - WS_QB, "q/k/v copies equally spaced");

namespace pg8 {
#define PG8_LAS __attribute__((address_space(3)))
typedef unsigned short bf16_t;
typedef short bf16x8 __attribute__((ext_vector_type(8)));
typedef float f32x4 __attribute__((ext_vector_type(4)));
typedef unsigned u32x4 __attribute__((ext_vector_type(4)));
constexpr int BM = 256, BK = 64, HALF = 128, HTB = HALF * BK * 2  , STAGE_BYTES = 8 * HTB, NXCD = 8, WGM = 8;

__host__ __device__ __forceinline__ int lds_byte(int r, int c) { const int st = (r >> 4) * 2 + (c >> 5), rr = r & 15, cc = c & 31, ob = rr * 64 + cc * 2; return st * 1024 + (ob ^ (((ob >> 9) & 1) << 5)); }
__host__ __device__ __forceinline__ void stage_rc(int b, int& R, int& C) { const int st = b / 1024, sb = b % 1024, swz = sb ^ (((sb >> 9) & 1) << 5); R = (st >> 1) * 16 + swz / 64; C = (st & 1) * 32 + (swz % 64) / 2; }
__host__ __device__ __forceinline__ int perm32(int rho) { const int n = rho >> 4, i = rho & 15; return 8 * (i >> 2) + 4 * n + (i & 3); }

struct Unit { int pm, pn; };
struct Gemm { const bf16_t* A; const bf16_t* Bt; int M, N, K; };

struct StaticOrder {
    int nM, nN, nwg, G, c;
    __host__ __device__ void init(int M, int N, int G_, int c_) { nM = M / BM; nN = N / BM; nwg = nM * nN; G = G_; c = c_; }
    __host__ __device__ bool next(int i, Unit& u) const {
        const long L = (long)i * G + c; if (L >= nwg) return false;
        int wgid = (int)L; { const int q = nwg / NXCD, r = nwg % NXCD, xcd = wgid % NXCD, off = wgid / NXCD; wgid = (xcd < r ? xcd * (q + 1) : r * (q + 1) + (xcd - r) * q) + off; }
        const int nig = WGM * nN, gid = wgid / nig, fm = gid * WGM, gsz = (nM - fm) < WGM ? (nM - fm) : WGM;
        u.pm = fm + ((wgid % nig) % gsz); u.pn = (wgid % nig) / gsz; return true;
    }
    __device__ __forceinline__ void a_ready(const Unit&) const {}
    __device__ __forceinline__ void done(const Unit&) const {}
};
__device__ __forceinline__ unsigned cvt_pk_bf16(float lo, float hi) { unsigned r; asm volatile("v_cvt_pk_bf16_f32 %0, %1, %2" : "=v"(r) : "v"(lo), "v"(hi)); return r; }
typedef float f32x2 __attribute__((ext_vector_type(2)));
__device__ __forceinline__ u32x4 pack8_bf16(f32x4 v0, f32x4 v1) { u32x4 w; w.x = cvt_pk_bf16(v0[0], v0[1]); w.y = cvt_pk_bf16(v0[2], v0[3]); w.z = cvt_pk_bf16(v1[0], v1[1]); w.w = cvt_pk_bf16(v1[2], v1[3]); return w; }

struct EpiIn {
    static constexpr bool PERM = true, AFTER_DRAIN = false;
    bf16_t* QB;
    float* QS;
    bf16_t* CB;
    bf16_t* ZB;
    float* out;
    __device__ __forceinline__ void operator()(const f32x4 (&acc)[2][2][4][2], const Unit& u, int wr, int wc, int fr, int fq) const {
        const int pn = u.pn;
#pragma unroll
        for (int ai = 0; ai < 2; ++ai)
#pragma unroll
            for (int m = 0; m < 4; ++m) {
                const int row = u.pm * BM + ai * HALF + wr * 64 + m * 16 + fr;
                if (row >= M_TOT) continue;
#pragma unroll
                for (int bj = 0; bj < 2; ++bj) {
                    const int col = pn * BM + bj * HALF + wc * 32 + 8 * fq;
                    const f32x4 v0 = acc[ai][bj][m][0], v1 = acc[ai][bj][m][1];
                    if (pn < 6) {
                        const int seg = pn >> 1, c = col - seg * 512, h = c >> 7, d = c & 127;
                        if (row < MP) {
                            const int b = row >> 11, t = row & 2047;
                            const size_t idx = ((size_t)((b * NH + h) * SEQ + t)) * HD + d;
                            *(u32x4*)(QB + (size_t)seg * QKV_STRIDE + idx) = pack8_bf16(v0, v1);
                            if (seg != 0) { float* o = out + OK_P + (size_t)(seg - 1) * (OV_P - OK_P) + (size_t)row * 512 + c; *(f32x4*)o = v0; *(f32x4*)(o + 4) = v1; }
                        } else {
                            const int db = row - MP;
                            if (seg == 0) { float* o = QS + (size_t)db * 512 + c; *(f32x4*)o = v0; *(f32x4*)(o + 4) = v1; }
                            else { float* o = out + OK_S + (size_t)(seg - 1) * (OV_S - OK_S) + (size_t)db * 512 + c; *(f32x4*)o = v0; *(f32x4*)(o + 4) = v1; }
                        }
                    } else if (pn < 12) {
                        const int c = col - 1536;
                        *(u32x4*)(CB + (size_t)row * CONVD + c) = pack8_bf16(v0, v1);
                        if (row < MP) {
                            const int t = row & 2047;
                            if (t >= SEQ - 3) { float* o = out + OCONV_P + ((size_t)(row >> 11) * 3 + (t - (SEQ - 3))) * CONVD + c; *(f32x4*)o = v0; *(f32x4*)(o + 4) = v1; }
                        } else {
                            float* o = out + OCONV_S + ((size_t)(row - MP) * 3 + 2) * CONVD + c; *(f32x4*)o = v0; *(f32x4*)(o + 4) = v1;
                        }
                    } else {
                        const int c = col - 3072;
                        *(u32x4*)(ZB + (size_t)row * 512 + c) = pack8_bf16(v0, v1);
                    }
                }
            }
    }
};

struct EpiRes {
    static constexpr bool PERM = true, AFTER_DRAIN = false;
    const float *xp, *xs; float* out; bf16_t* HB; float* SSQ;
    __device__ __forceinline__ void operator()(const f32x4 (&acc)[2][2][4][2], const Unit& u, int wr, int wc, int fr, int fq) const {
#pragma unroll
        for (int ai = 0; ai < 2; ++ai)
#pragma unroll
            for (int m = 0; m < 4; ++m) {
                const int row = u.pm * BM + ai * HALF + wr * 64 + m * 16 + fr;
                const bool ok = row < M_TOT;
                const float* xr = row < MP ? xp + (size_t)row * DM : xs + (size_t)(ok ? row - MP : 0) * DM;
                float* hr = row < MP ? out + OY_P + (size_t)row * DM : out + OY_S + (size_t)(ok ? row - MP : 0) * DM;
                float s = 0.f;
#pragma unroll
                for (int bj = 0; bj < 2; ++bj) {
                    const int col = u.pn * BM + bj * HALF + wc * 32 + 8 * fq;
                    if (ok) {
                        const f32x4 v0 = acc[ai][bj][m][0] + *(const f32x4*)(xr + col), v1 = acc[ai][bj][m][1] + *(const f32x4*)(xr + col + 4);
                        *(f32x4*)(hr + col) = v0; *(f32x4*)(hr + col + 4) = v1;
                        *(u32x4*)(HB + (size_t)row * DM + col) = pack8_bf16(v0, v1);
                        s += (v0[0] * v0[0] + v0[1] * v0[1]) + (v0[2] * v0[2] + v0[3] * v0[3]) + (v1[0] * v1[0] + v1[1] * v1[1]) + (v1[2] * v1[2] + v1[3] * v1[3]);
                    }
                }
                s += __shfl_xor(s, 16); s += __shfl_xor(s, 32);
                if (ok && fq == 0) SSQ[(size_t)row * 16 + u.pn * 4 + wc] = s;
            }
    }
};

struct EpiUp {
    static constexpr bool PERM = true, AFTER_DRAIN = false;
    bf16_t* UB; const float* SSQ;
    __device__ __forceinline__ void operator()(const f32x4 (&acc)[2][2][4][2], const Unit& u, int wr, int wc, int fr, int fq) const {
#pragma unroll
        for (int ai = 0; ai < 2; ++ai)
#pragma unroll
            for (int m = 0; m < 4; ++m) {
                const int row = u.pm * BM + ai * HALF + wr * 64 + m * 16 + fr;
                if (row >= M_TOT) continue;
                const f32x4* sp = (const f32x4*)(SSQ + (size_t)row * 16);
                const f32x4 a = sp[0], b = sp[1], c = sp[2], d = sp[3];
                const float ss = ((a[0] + a[1]) + (a[2] + a[3])) + ((b[0] + b[1]) + (b[2] + b[3])) + ((c[0] + c[1]) + (c[2] + c[3])) + ((d[0] + d[1]) + (d[2] + d[3]));
                const float rstd = 1.0f / sqrtf(ss * (1.0f / DM) + RMS_EPS);
#pragma unroll
                for (int bj = 0; bj < 2; ++bj) {
                    const int col = u.pn * BM + bj * HALF + wc * 32 + 8 * fq;
                    f32x4 v0 = acc[ai][bj][m][0] * rstd, v1 = acc[ai][bj][m][1] * rstd;
#pragma unroll
                    for (int j = 0; j < 4; ++j) { const float p = fmaxf(v0[j], 0.f), q = fmaxf(v1[j], 0.f); v0[j] = p * p; v1[j] = q * q; }
                    *(u32x4*)(UB + (size_t)row * FF + col) = pack8_bf16(v0, v1);
                }
            }
    }
};

struct EpiDown {
    static constexpr bool PERM = true, AFTER_DRAIN = false;
    float* out; float* SSQ2;
    __device__ __forceinline__ void operator()(const f32x4 (&acc)[2][2][4][2], const Unit& u, int wr, int wc, int fr, int fq) const {
#pragma unroll
        for (int ai = 0; ai < 2; ++ai)
#pragma unroll
            for (int m = 0; m < 4; ++m) {
                const int row = u.pm * BM + ai * HALF + wr * 64 + m * 16 + fr;
                const bool ok = row < M_TOT;
                float* hr = row < MP ? out + OY_P + (size_t)row * DM : out + OY_S + (size_t)(ok ? row - MP : 0) * DM;
                float s = 0.f;
#pragma unroll
                for (int bj = 0; bj < 2; ++bj) {
                    const int col = u.pn * BM + bj * HALF + wc * 32 + 8 * fq;
                    if (ok) {
                        const f32x4 v0 = acc[ai][bj][m][0] + *(const f32x4*)(hr + col), v1 = acc[ai][bj][m][1] + *(const f32x4*)(hr + col + 4);
                        *(f32x4*)(hr + col) = v0; *(f32x4*)(hr + col + 4) = v1;
                        s += (v0[0] * v0[0] + v0[1] * v0[1]) + (v0[2] * v0[2] + v0[3] * v0[3]) + (v1[0] * v1[0] + v1[1] * v1[1]) + (v1[2] * v1[2] + v1[3] * v1[3]);
                    }
                }
                s += __shfl_xor(s, 16); s += __shfl_xor(s, 32);
                if (ok && fq == 0) SSQ2[(size_t)row * 16 + u.pn * 4 + wc] = s;
            }
    }
};

template <class Epi, class Sched, bool ALIGN_EPI = false, bool SP2 = false>
__device__ __forceinline__ void gemm_phase(PG8_LAS unsigned char* lds, const Gemm g, const Sched& S, const Epi& E) {
    const int tid = threadIdx.x, wid = __builtin_amdgcn_readfirstlane(tid >> 6), lane = tid & 63, wr = wid >> 2, wc = wid & 3, fr = lane & 15, fq = lane >> 4;
    const int K = g.K, nt = K / BK;
    unsigned voffA[2], voffB[2];
#pragma unroll
    for (int i = 0; i < 2; ++i) { int R, C; stage_rc(tid * 16 + i * 8192, R, C); const int Rb = Epi::PERM ? ((R & ~31) + perm32(R & 31)) : R;
        voffA[i] = (unsigned)(R * K + C) * 2u; voffB[i] = (unsigned)(Rb * K + C) * 2u; }
    const size_t kstep = (size_t)(BK * 2);
    const size_t hstep = (size_t)HALF * K * 2;
    const size_t tstep = 2 * hstep;
    const unsigned ldsw = (unsigned)wid * 1024u;
    const int aoff = lds_byte(wr * 64 + fr, fq * 8), boff = lds_byte(wc * 32 + fr, fq * 8);
#define PG8_SA(b, h) (((b) * 2 + (h)) * HTB)
#define PG8_SB(b, h) ((4 + (b) * 2 + (h)) * HTB)
#define PG8_STAGE(bufoff, gbase, voff) do { _Pragma("unroll") for (int _i = 0; _i < 2; ++_i) \
        __builtin_amdgcn_global_load_lds((const unsigned*)((const char*)(gbase) + (voff)[_i]), (PG8_LAS unsigned*)(lds + (bufoff) + ldsw + _i * 8192), 16, 0, 0); } while (0)
#define PG8_LDA(dst, b, h) do { _Pragma("unroll") for (int m = 0; m < 4; ++m) _Pragma("unroll") for (int k = 0; k < 2; ++k) dst[m][k] = *(const PG8_LAS bf16x8*)(lds + PG8_SA(b, h) + aoff + m * 2048 + k * 1024); } while (0)
#define PG8_LDB(dst, b, h) do { _Pragma("unroll") for (int n = 0; n < 2; ++n) _Pragma("unroll") for (int k = 0; k < 2; ++k) dst[n][k] = *(const PG8_LAS bf16x8*)(lds + PG8_SB(b, h) + boff + n * 2048 + k * 1024); } while (0)
#define PG8_MMA(ai, bj, At, Bt) do { __builtin_amdgcn_s_setprio(1); _Pragma("unroll") for (int m = 0; m < 4; ++m) _Pragma("unroll") for (int n = 0; n < 2; ++n) _Pragma("unroll") for (int k = 0; k < 2; ++k) \
        acc[ai][bj][m][n] = __builtin_amdgcn_mfma_f32_16x16x32_bf16(Bt[n][k], At[m][k], acc[ai][bj][m][n], 0, 0, 0); __builtin_amdgcn_s_setprio(0); } while (0)
#define PG8_WAIT_V(n) asm volatile("s_waitcnt vmcnt(" #n ")" ::: "memory")
#define PG8_WAIT_L(n) asm volatile("s_waitcnt lgkmcnt(" #n ")" ::: "memory")
#define PG8_BAR __builtin_amdgcn_s_barrier()
#define PG8_SCHED __builtin_amdgcn_sched_barrier(0)
    Unit cur, nxt; int ui = 0;
    if (!S.next(0, cur)) return;
    f32x4 acc[2][2][4][2];
#pragma unroll
    for (int a = 0; a < 2; ++a)
#pragma unroll
        for (int b = 0; b < 2; ++b)
#pragma unroll
            for (int m = 0; m < 4; ++m)
#pragma unroll
                for (int n = 0; n < 2; ++n) acc[a][b][m][n] = (f32x4){0.f, 0.f, 0.f, 0.f};
    bf16x8 At[4][2], B0[2][2], B1[2][2];
    const char* cA = (const char*)g.A + (size_t)cur.pm * tstep; const char* cB = (const char*)g.Bt + (size_t)cur.pn * tstep;
    S.a_ready(cur);
    if constexpr (SP2) {
        PG8_STAGE(PG8_SB(0, 0), cB, voffB); PG8_STAGE(PG8_SB(0, 1), cB + hstep, voffB); PG8_STAGE(PG8_SA(0, 0), cA, voffA); PG8_STAGE(PG8_SA(0, 1), cA + hstep, voffA);
        if (wr == 1) PG8_BAR;
        PG8_WAIT_V(2); PG8_BAR;
        PG8_STAGE(PG8_SB(1, 0), cB + kstep, voffB); PG8_STAGE(PG8_SA(1, 0), cA + kstep, voffA); PG8_STAGE(PG8_SB(1, 1), cB + hstep + kstep, voffB);
        PG8_WAIT_V(6); PG8_BAR;
    } else {
        PG8_STAGE(PG8_SB(0, 0), cB, voffB); PG8_STAGE(PG8_SA(0, 0), cA, voffA); PG8_STAGE(PG8_SB(0, 1), cB + hstep, voffB); PG8_STAGE(PG8_SA(0, 1), cA + hstep, voffA);
        if (wr == 1) PG8_BAR;
        PG8_WAIT_V(4); PG8_BAR;
        PG8_STAGE(PG8_SB(1, 0), cB + kstep, voffB); PG8_STAGE(PG8_SA(1, 0), cA + kstep, voffA); PG8_STAGE(PG8_SB(1, 1), cB + hstep + kstep, voffB);
        PG8_WAIT_V(6); PG8_BAR;
    }
    for (;;) {
        const bool has_next = S.next(ui + 1, nxt);
        const char* nA = has_next ? (const char*)g.A + (size_t)nxt.pm * tstep : cA; const char* nB = has_next ? (const char*)g.Bt + (size_t)nxt.pn * tstep : cB;
        for (int t = 0; t < nt; t += 2) {
            const bool last = (t == nt - 2);
            const char* a1 = cA + (size_t)(t + 1) * kstep;
            const char* a2 = last ? nA : cA + (size_t)(t + 2) * kstep; const char* b2 = last ? nB : cB + (size_t)(t + 2) * kstep;
            const char* a3 = a2 + kstep; const char* b3 = b2 + kstep;
            if (last && has_next) S.a_ready(nxt);
            if constexpr (SP2) {
            PG8_LDB(B0, 0, 0); PG8_LDB(B1, 0, 1); PG8_SCHED; PG8_LDA(At, 0, 0); PG8_STAGE(PG8_SA(1, 1), a1 + hstep, voffA);
            PG8_WAIT_V(8); PG8_WAIT_L(0); PG8_BAR; PG8_MMA(0, 0, At, B0); PG8_MMA(0, 1, At, B1); PG8_BAR; PG8_SCHED;
            PG8_LDA(At, 0, 1); PG8_STAGE(PG8_SB(0, 0), b2, voffB); PG8_STAGE(PG8_SB(0, 1), b2 + hstep, voffB); PG8_STAGE(PG8_SA(0, 0), a2, voffA);
            PG8_WAIT_V(8); PG8_WAIT_L(0); PG8_BAR; PG8_MMA(1, 0, At, B0); PG8_MMA(1, 1, At, B1); PG8_BAR; PG8_SCHED;
            PG8_LDB(B0, 1, 0); PG8_LDB(B1, 1, 1); PG8_SCHED; PG8_LDA(At, 1, 0); PG8_STAGE(PG8_SA(0, 1), a2 + hstep, voffA);
            PG8_WAIT_V(8); PG8_WAIT_L(0); PG8_BAR; PG8_MMA(0, 0, At, B0); PG8_MMA(0, 1, At, B1); PG8_BAR; PG8_SCHED;
            PG8_LDA(At, 1, 1); PG8_STAGE(PG8_SB(1, 0), b3, voffB); PG8_STAGE(PG8_SB(1, 1), b3 + hstep, voffB); PG8_STAGE(PG8_SA(1, 0), a3, voffA);
            PG8_WAIT_V(8); PG8_WAIT_L(0); PG8_BAR; PG8_MMA(1, 0, At, B0); PG8_MMA(1, 1, At, B1); PG8_BAR; PG8_SCHED;
            } else {
            PG8_LDB(B0, 0, 0); PG8_SCHED; PG8_LDA(At, 0, 0); PG8_STAGE(PG8_SA(1, 1), a1 + hstep, voffA);
            PG8_WAIT_L(8); PG8_BAR; PG8_WAIT_L(0); PG8_MMA(0, 0, At, B0); PG8_BAR; PG8_SCHED;
            PG8_LDB(B1, 0, 1); PG8_STAGE(PG8_SB(0, 0), b2, voffB);
            PG8_BAR; PG8_WAIT_L(0); PG8_MMA(0, 1, At, B1); PG8_BAR;
            PG8_LDA(At, 0, 1); PG8_STAGE(PG8_SA(0, 0), a2, voffA);
            PG8_BAR; PG8_WAIT_L(0); PG8_MMA(1, 0, At, B0); PG8_BAR; PG8_SCHED;
            PG8_STAGE(PG8_SB(0, 1), b2 + hstep, voffB);
            PG8_WAIT_V(6); PG8_BAR; PG8_MMA(1, 1, At, B1); PG8_BAR;
            PG8_LDB(B0, 1, 0); PG8_SCHED; PG8_LDA(At, 1, 0); PG8_STAGE(PG8_SA(0, 1), a2 + hstep, voffA);
            PG8_WAIT_L(8); PG8_BAR; PG8_WAIT_L(0); PG8_MMA(0, 0, At, B0); PG8_BAR; PG8_SCHED;
            PG8_LDB(B1, 1, 1); PG8_STAGE(PG8_SB(1, 0), b3, voffB);
            PG8_BAR; PG8_WAIT_L(0); PG8_MMA(0, 1, At, B1); PG8_BAR;
            PG8_LDA(At, 1, 1); PG8_STAGE(PG8_SA(1, 0), a3, voffA);
            PG8_BAR; PG8_WAIT_L(0); PG8_MMA(1, 0, At, B0); PG8_BAR; PG8_SCHED;
            PG8_STAGE(PG8_SB(1, 1), b3 + hstep, voffB);
            PG8_WAIT_V(6); PG8_BAR; PG8_MMA(1, 1, At, B1); PG8_BAR;
            }
        }
        if constexpr (ALIGN_EPI) { if (wr == 0) PG8_BAR; }
        if constexpr (!Epi::AFTER_DRAIN) { E(acc, cur, wr, wc, fr, fq); S.done(cur); }
        if (!has_next) break;
#pragma unroll
        for (int a = 0; a < 2; ++a)
#pragma unroll
            for (int b = 0; b < 2; ++b)
#pragma unroll
                for (int m = 0; m < 4; ++m)
#pragma unroll
                    for (int n = 0; n < 2; ++n) acc[a][b][m][n] = (f32x4){0.f, 0.f, 0.f, 0.f};
        cur = nxt; cA = nA; cB = nB; ++ui;
        if constexpr (ALIGN_EPI) { if (wr == 1) PG8_BAR; }
    }
    PG8_WAIT_V(0);
    if constexpr (!ALIGN_EPI) { if (wr == 0) PG8_BAR; }
    PG8_BAR;
    if constexpr (Epi::AFTER_DRAIN) { E.fused(acc, cur, wr, wc, fr, fq, lds, wid, lane); S.done(cur); }
#undef PG8_SA
#undef PG8_SB
#undef PG8_STAGE
#undef PG8_LDA
#undef PG8_LDB
#undef PG8_MMA
#undef PG8_WAIT_V
#undef PG8_WAIT_L
#undef PG8_BAR
#undef PG8_SCHED
}
}

#define GAS __attribute__((address_space(1)))
#define LAS __attribute__((address_space(3)))
typedef unsigned short bf16;
typedef unsigned v4u __attribute__((ext_vector_type(4)));
typedef unsigned v2u __attribute__((ext_vector_type(2)));
typedef float f32x4 __attribute__((ext_vector_type(4)));
typedef float f32x2 __attribute__((ext_vector_type(2)));
typedef float f32x16 __attribute__((ext_vector_type(16)));
typedef short bf16x8 __attribute__((ext_vector_type(8)));
typedef short s16x4 __attribute__((ext_vector_type(4)));
#define LDS_WAIT() asm volatile("s_waitcnt lgkmcnt(0)" ::: "memory")
#define VM_WAIT() asm volatile("s_waitcnt vmcnt(0)" ::: "memory")
constexpr int NWAVES = 8;
constexpr int LDS_BYTES = 147456;
constexpr int MISC_OFF = 131072 + 8192;

__device__ __forceinline__ unsigned f2bf(float f) { unsigned u = __builtin_bit_cast(unsigned, f); return (u + 0x7fffu + ((u >> 16) & 1u)) >> 16; }
__device__ __forceinline__ unsigned pk2(float lo, float hi) { return f2bf(lo) | (f2bf(hi) << 16); }
__device__ __forceinline__ float bf2f(unsigned short b) { return __builtin_bit_cast(float, ((unsigned)b) << 16); }
__device__ __forceinline__ float wave_sum(float v) {
#pragma unroll
    for (int o = 1; o < 64; o <<= 1) v += __shfl_xor(v, o);
    return v;
}
__device__ __forceinline__ float softplus_f(float x) { return fmaxf(x, 0.f) + log1pf(expf(-fabsf(x))); }
__device__ __forceinline__ float sigmoid_f(float x) { return 1.0f / (1.0f + expf(-x)); }
__device__ __forceinline__ float silu_f(float x) { return x / (1.0f + expf(-x)); }

struct Params {
    const float* in[20];
    float* out; unsigned char* ws;
    int ph_lo, ph_hi;
};
struct Ctx { int tid, lane, wave, vcu, G; };

#define XB_TMO      128
#define XB_XCNT(j)  (256  + 64 * (j))
#define XB_XSUB(j)  (1280 + 64 * (j))
#define XB_XGEN(j)  (2304 + 64 * (j))
#define XB_TOP      3328
#define XB_TOPGEN   3392
#define XCD_BAR_WORDS 3456
#define XB_SPIN_CAP (1u << 18)

__device__ __forceinline__ unsigned xb_ld(unsigned* p)              { return __hip_atomic_load(p, __ATOMIC_RELAXED, __HIP_MEMORY_SCOPE_AGENT); }
__device__ __forceinline__ unsigned xb_add(unsigned* p, unsigned v) { return __hip_atomic_fetch_add(p, v, __ATOMIC_RELAXED, __HIP_MEMORY_SCOPE_AGENT); }
__device__ __forceinline__ unsigned xb_xcc_id() { return (unsigned)__builtin_amdgcn_s_getreg((3 << 11) | 20) & 0xFu; }
#define XB_SPIN(cond, bar) do { unsigned _sp = 0; while (cond) { __builtin_amdgcn_s_sleep(1); \
    if ((++_sp & 255u) == 0u) { if (xb_ld(&(bar)[XB_TMO])) break; if (_sp > XB_SPIN_CAP) { atomicAdd(&(bar)[XB_TMO], 1u); break; } } } } while (0)

struct XcdBarrier {
    unsigned* bar; unsigned x;
    volatile LAS unsigned* st;
};

__device__ __forceinline__ XcdBarrier xcd_barrier_post(unsigned* bar, volatile LAS unsigned* st) {
    XcdBarrier b; b.bar = bar; b.x = xb_xcc_id(); b.st = st;
    if (threadIdx.x == 0) (void)xb_add(&bar[XB_XCNT(b.x)], 1u);
    return b;
}
__device__ __forceinline__ void xcd_barrier_complete(unsigned* bar, unsigned x, unsigned& nloc, unsigned& nx) {
    const unsigned G = gridDim.x * gridDim.y * gridDim.z;
    unsigned sum, cnt, mine, sp = 0u;
    for (;;) {
        sum = 0u; cnt = 0u; mine = 0u;
#pragma unroll
        for (unsigned j = 0; j < 16; ++j) { const unsigned c = xb_ld(&bar[XB_XCNT(j)]); sum += c; cnt += (c > 0u) ? 1u : 0u; mine = (j == x) ? c : mine; }
        if (sum == G) break;
        __builtin_amdgcn_s_sleep(1);
        if ((++sp & 255u) == 0u) { if (xb_ld(&bar[XB_TMO])) break; if (sp > XB_SPIN_CAP) { atomicAdd(&bar[XB_TMO], 1u); break; } }
    }
    nloc = mine > 0u ? mine : 1u; nx = cnt > 0u ? cnt : 1u;
}

__device__ __forceinline__ void xcd_barrier(const XcdBarrier& b) {
    asm volatile("s_waitcnt vmcnt(0)" ::: "memory");
    __syncthreads();
    if (threadIdx.x == 0) {
        unsigned* bar = b.bar;
        __builtin_amdgcn_s_waitcnt(0);
        unsigned nloc = b.st[0], nx = b.st[1];
        if (nloc == 0u) { xcd_barrier_complete(bar, b.x, nloc, nx); b.st[0] = nloc; b.st[1] = nx; }
        const unsigned old = xb_add(&bar[XB_XSUB(b.x)], 1u);
        const unsigned gen = old / nloc;
        if (old + 1u == (gen + 1u) * nloc) {
            __builtin_amdgcn_fence(__ATOMIC_RELEASE, "agent");
            asm volatile("s_waitcnt vmcnt(0)" ::: "memory");
            const unsigned og = xb_add(&bar[XB_TOP], 1u);
            const unsigned tg = og / nx;
            if (og + 1u == (tg + 1u) * nx) xb_add(&bar[XB_TOPGEN], 1u);
            else XB_SPIN(xb_ld(&bar[XB_TOPGEN]) == tg, bar);
            __builtin_amdgcn_fence(__ATOMIC_ACQUIRE, "agent");
            xb_add(&bar[XB_XGEN(b.x)], 1u);
            asm volatile("s_waitcnt vmcnt(0)" ::: "memory");
        } else {
            XB_SPIN(xb_ld(&bar[XB_XGEN(b.x)]) == gen, bar);
            __builtin_amdgcn_fence(__ATOMIC_ACQUIRE, "agent");
            asm volatile("s_waitcnt vmcnt(0)" ::: "memory");
        }
    }
    __syncthreads();
}

__device__ __forceinline__ void transpose_item(const float* W, int ldw, int c0, int K, int ncols, const float* scale, bf16* WT, int row_off, LAS float* scr, int item, int lane) {
    const int nblk = ncols / 32, kb = item / nblk, nb = item % nblk, k0 = 64 * kb, n0 = 32 * nb;
#pragma unroll 8
    for (int i = 0; i < 32; ++i) { const int kk = 2 * i + (lane >> 5); float w = W[(size_t)(k0 + kk) * ldw + c0 + n0 + (lane & 31)]; if (scale) w *= scale[k0 + kk]; scr[kk * 33 + (lane & 31)] = w; }
    LDS_WAIT(); asm volatile("" ::: "memory");
    const int c = lane & 7;
#pragma unroll
    for (int j = 0; j < 4; ++j) { const int n = (lane >> 3) + 8 * j; const LAS float* s = scr + (8 * c) * 33 + n;
        v4u o; o.x = pk2(s[0 * 33], s[1 * 33]); o.y = pk2(s[2 * 33], s[3 * 33]); o.z = pk2(s[4 * 33], s[5 * 33]); o.w = pk2(s[6 * 33], s[7 * 33]);
        *(GAS v4u*)(WT + (size_t)(row_off + n0 + n) * K + k0 + 8 * c) = o; }
    LDS_WAIT(); asm volatile("" ::: "memory");
}

__device__ __forceinline__ void phase_prep(const Params& P, const Ctx& C, LAS unsigned char* lds) {
    unsigned char* ws = P.ws;
    const float* xp = P.in[0]; const float* xs = P.in[1]; const float* ln1 = P.in[8]; const float* w_in = P.in[9]; const float* b_f = P.in[10];
    const float* a_log = P.in[12]; const float* dt_bias = P.in[13]; const float* w_o = P.in[15]; const float* ln2 = P.in[16]; const float* w_up = P.in[17]; const float* w_down = P.in[18];
    bf16* XN = (bf16*)(ws + WS_XN);
    float* LF = (float*)(ws + WS_LF); float* BETA = (float*)(ws + WS_BETA); float* Gg = (float*)(ws + WS_G);
    LAS float* WSm = (LAS float*)lds;
    LAS float* scr = (LAS float*)(lds + 49152 + C.wave * 8448);
    for (int idx = C.tid; idx < 12 * 1024; idx += NWAVES * 64) { const int k = idx / 12, c = idx % 12; const int col = c < 4 ? 1536 + c : 3588 + (c - 4); WSm[c * 1024 + k] = w_in[(size_t)k * INDIM + col]; }
    __syncthreads();
    const int gw = C.vcu * NWAVES + C.wave, NGW = C.G * NWAVES, lane = C.lane;
    f32x4 lw[4];
#pragma unroll
    for (int j = 0; j < 4; ++j) lw[j] = ((const f32x4*)ln1)[lane + 64 * j];
    for (int m = gw; m < M_TOT; m += NGW) {
        const float* xr = m < MP ? xp + (size_t)m * DM : xs + (size_t)(m - MP) * DM;
        f32x4 v[4]; float ss = 0.f;
#pragma unroll
        for (int j = 0; j < 4; ++j) { v[j] = ((const f32x4*)xr)[lane + 64 * j]; ss += (v[j][0] * v[j][0] + v[j][1] * v[j][1]) + (v[j][2] * v[j][2] + v[j][3] * v[j][3]); }
        ss = wave_sum(ss);
        const float rstd = 1.0f / sqrtf(ss * (1.0f / DM) + RMS_EPS);
#pragma unroll
        for (int j = 0; j < 4; ++j) { v[j] = v[j] * rstd * lw[j];
            v2u o; o.x = pk2(v[j][0], v[j][1]); o.y = pk2(v[j][2], v[j][3]);
            *(v2u*)(XN + (size_t)m * DM + 4 * lane + 256 * j) = o; }
        float mine = 0.f;
#pragma unroll
        for (int c = 0; c < 12; ++c) { float a = 0.f;
#pragma unroll
            for (int j = 0; j < 4; ++j) { const f32x4 w = *(const LAS f32x4*)(WSm + c * 1024 + 4 * lane + 256 * j); a += (v[j][0] * w[0] + v[j][1] * w[1]) + (v[j][2] * w[2] + v[j][3] * w[3]); }
            a = wave_sum(a); mine = (lane == c) ? a : mine; }
        const float bb = __shfl(mine, (lane + 4) & 63), aa = __shfl(mine, (lane + 8) & 63);
        if (lane < 4) {
            const float fa = mine;
            const float lf = -softplus_f(-(fa + b_f[lane]));
            const float beta = sigmoid_f(bb);
            const float g = -expf(a_log[lane]) * softplus_f(aa + dt_bias[lane]);
            LF[(size_t)m * 4 + lane] = lf; BETA[(size_t)m * 4 + lane] = beta; Gg[(size_t)m * 4 + lane] = g;
            if (m < MP) P.out[OLF_P + (size_t)m * 4 + lane] = lf; else P.out[OLF_S + (size_t)(m - MP) * 4 + lane] = lf;
        }
    }
    bf16* W1T = (bf16*)(ws + WS_W1T); bf16* WOT = (bf16*)(ws + WS_WOT); bf16* WUPT = (bf16*)(ws + WS_WUPT); bf16* WDNT = (bf16*)(ws + WS_WDNT);
    for (int it = gw; it < 16 * 48; it += NGW) transpose_item(w_in, INDIM, 0, DM, 1536, nullptr, W1T, 0, scr, it, lane);
    for (int it = gw; it < 16 * 48; it += NGW) transpose_item(w_in, INDIM, 1540, DM, 1536, nullptr, W1T, 1536, scr, it, lane);
    for (int it = gw; it < 16 * 16; it += NGW) transpose_item(w_in, INDIM, 3076, DM, 512, nullptr, W1T, 3072, scr, it, lane);
    for (int it = gw; it < 16 * 32; it += NGW) transpose_item(w_o, DM, 0, DM, DM, nullptr, WOT, 0, scr, it, lane);
    for (int it = gw; it < 16 * 128; it += NGW) transpose_item(w_up, FF, 0, DM, FF, ln2, WUPT, 0, scr, it, lane);
    for (int it = gw; it < 64 * 32; it += NGW) transpose_item(w_down, DM, 0, FF, DM, nullptr, WDNT, 0, scr, it, lane);
}

__device__ __forceinline__ void kbias_seq(const Params& P, int bh, int lane) {
    const float* LF = (const float*)(P.ws + WS_LF); float* KBIAS = (float*)(P.ws + WS_KBIAS);
    const int b = bh >> 2, h = bh & 3;
    const float* src = LF + ((size_t)b * SEQ + 32 * lane) * 4 + h;
    float s = 0.f;
    for (int i = 0; i < 32; ++i) s += src[i * 4];
    float x = s;
#pragma unroll
    for (int o = 1; o < 64; o <<= 1) { const float y = __shfl_up(x, o); if (lane >= o) x += y; }
    float run = x - s;
    float* dst = KBIAS + (size_t)bh * SEQ + 32 * lane;
    const float inv = -11.313708498984761f;
    for (int i = 0; i < 32; ++i) { run += src[i * 4]; dst[i] = run * inv; }
}


namespace fox {
constexpr int D = 128, NW = 8, QBLK = 32, KVBLK = 64, QB = NW * QBLK;
constexpr int SHM_V = KVBLK * D * 2, SHM_K = KVBLK * D * 2;
constexpr float SCALE = 0.08838834764831845f, THR = 8.f;
#define KSWZ(row, colB) ((row) * 256 + ((colB) ^ (((row) & 7) << 4)))
#define SBAR() __builtin_amdgcn_sched_barrier(0)
__device__ __forceinline__ int v_st(int k, int c) { const int kk = (k & ~0xC) | ((k & 4) << 1) | ((k & 8) >> 1); return ((kk >> 3) * 4 + (c >> 5)) * 512 + ((kk & 7) * 32 + (c & 31)) * 2; }
__device__ __forceinline__ int v_rd_base(int lane) { return ((lane & 3) << 3) | (((lane >> 2) & 3) << 6) | (((lane >> 4) & 1) << 5) | (((lane >> 5) & 1) << 8); }
constexpr int v_rd_off(int d0, int ks, int half) { return d0 * 512 + ks * 4096 + half * 2048; }
__device__ __forceinline__ int crow(int r, int hi) { return (r & 3) + 8 * (r >> 2) + 4 * hi; }
__device__ __forceinline__ unsigned cvtpk(float lo, float hi) { unsigned r; asm volatile("v_cvt_pk_bf16_f32 %0, %1, %2" : "=v"(r) : "v"(lo), "v"(hi)); return r; }
__device__ __forceinline__ void mask_tile(f32x16& p0, f32x16& p1, int dq, unsigned W) {
    const float NEG = -__builtin_inff();
#pragma unroll
    for (int r = 0; r < 16; ++r) {
        const int c = (r & 3) + 8 * (r >> 2);
        if ((unsigned)(dq - c) >= W) p0[r] = NEG;
        if ((unsigned)(dq - c - 32) >= W) p1[r] = NEG;
    }
}
__device__ __forceinline__ void partialSM(f32x16& p0, f32x16& p1, float& m_reg, float& mn, float& alpha) {
    float pmax = p0[0]; for (int r = 1; r < 16; ++r) pmax = fmaxf(pmax, p0[r]); for (int r = 0; r < 16; ++r) pmax = fmaxf(pmax, p1[r]);
    { auto rr = __builtin_amdgcn_permlane32_swap(__float_as_uint(pmax), __float_as_uint(pmax), false, false);
      pmax = fmaxf(__uint_as_float(rr[0]), __uint_as_float(rr[1])); }
    constexpr float C2 = 1.4426950408889634f * SCALE;
    if (__builtin_expect(__all((pmax - m_reg) * SCALE <= THR), 1)) { mn = m_reg; alpha = 1.f; }
    else { mn = fmaxf(m_reg, pmax); alpha = __builtin_amdgcn_exp2f((m_reg - mn) * C2); m_reg = mn; }
    const float mnL = -mn * C2;
    for (int r = 0; r < 16; ++r) p0[r] = fmaf(p0[r], C2, mnL); for (int r = 0; r < 16; ++r) p1[r] = fmaf(p1[r], C2, mnL);
    for (int r = 0; r < 16; ++r) p0[r] = __builtin_amdgcn_exp2f(p0[r]);
}
__device__ __forceinline__ void finishSM(f32x16& p0, f32x16& p1, float alpha, float& l_reg, bf16x8& pa0, bf16x8& pa1, bf16x8& pa2, bf16x8& pa3) {
    for (int r = 0; r < 16; ++r) p1[r] = __builtin_amdgcn_exp2f(p1[r]);
    float ps = 0; for (int r = 0; r < 16; ++r) ps += p0[r]; for (int r = 0; r < 16; ++r) ps += p1[r];
    { auto rr = __builtin_amdgcn_permlane32_swap(__float_as_uint(ps), __float_as_uint(ps), false, false);
      ps = __uint_as_float(rr[0]) + __uint_as_float(rr[1]); }
    l_reg = l_reg * alpha + ps;
#define PK4(P, B_, OUT) do { unsigned a0 = cvtpk(P[B_+0], P[B_+1]), a1 = cvtpk(P[B_+2], P[B_+3]);                          \
        unsigned b0 = cvtpk(P[B_+4], P[B_+5]), b1 = cvtpk(P[B_+6], P[B_+7]);                                             \
        auto r0 = __builtin_amdgcn_permlane32_swap(a0, b0, false, false); auto r1 = __builtin_amdgcn_permlane32_swap(a1, b1, false, false); \
        v4u w = {r0[0], r1[0], r0[1], r1[1]}; OUT = *reinterpret_cast<bf16x8*>(&w); } while (0)
    PK4(p0, 0, pa0); PK4(p0, 8, pa1); PK4(p1, 0, pa2); PK4(p1, 8, pa3);
#undef PK4
}
template <int KB>
__device__ __forceinline__ void qkt(f32x16& p0, f32x16& p1, const char* K_lds, const float* bias_l, int r32, int hi, const bf16x8* qr) {
#pragma unroll
    for (int g = 0; g < 4; ++g) { const f32x4 t0 = *(const f32x4*)(bias_l + 8 * g + 4 * hi), t1 = *(const f32x4*)(bias_l + 32 + 8 * g + 4 * hi);
#pragma unroll
        for (int i = 0; i < 4; ++i) { p0[4 * g + i] = t0[i]; p1[4 * g + i] = t1[i]; } }
    const char* kb[4];
#pragma unroll
    for (int dd = 0; dd < 4; ++dd) kb[dd] = K_lds + KB * SHM_K + KSWZ(r32, (dd * 16 + hi * 8) * 2);
#pragma unroll
    for (int d0 = 0; d0 < 8; ++d0) { const char* a = kb[d0 & 3] + (d0 >> 2) * 128;
        bf16x8 b0 = *reinterpret_cast<const bf16x8*>(a);
        bf16x8 b1 = *reinterpret_cast<const bf16x8*>(a + 32 * 256);
        p0 = __builtin_amdgcn_mfma_f32_32x32x16_bf16(b0, qr[d0], p0, 0, 0, 0);
        p1 = __builtin_amdgcn_mfma_f32_32x32x16_bf16(b1, qr[d0], p1, 0, 0, 0); }
}
template <int VB>
__device__ __forceinline__ void pv_tile(f32x16* o, int vb0, bf16x8 pa0, bf16x8 pa1, bf16x8 pa2, bf16x8 pa3) {
#define TRRD(dst, off) asm volatile("ds_read_b64_tr_b16 %0, %1 offset:%2" : "=&v"(dst) : "v"(vb0), "i"(off) : "memory")
#define PV_D0(d0) do { s16x4 l0, l1, l2, l3, h0, h1, h2, h3; constexpr int b_ = VB * SHM_V + v_rd_off(d0, 0, 0);   \
        TRRD(l0, b_); TRRD(h0, b_ + 2048); TRRD(l1, b_ + 4096); TRRD(h1, b_ + 6144); TRRD(l2, b_ + 8192); TRRD(h2, b_ + 10240); TRRD(l3, b_ + 12288); TRRD(h3, b_ + 14336); \
        asm volatile("s_waitcnt lgkmcnt(0)" ::: "memory"); SBAR();   \
        o[d0] = __builtin_amdgcn_mfma_f32_32x32x16_bf16(pa0, (bf16x8){l0[0], l0[1], l0[2], l0[3], h0[0], h0[1], h0[2], h0[3]}, o[d0], 0, 0, 0);   \
        o[d0] = __builtin_amdgcn_mfma_f32_32x32x16_bf16(pa1, (bf16x8){l1[0], l1[1], l1[2], l1[3], h1[0], h1[1], h1[2], h1[3]}, o[d0], 0, 0, 0);   \
        o[d0] = __builtin_amdgcn_mfma_f32_32x32x16_bf16(pa2, (bf16x8){l2[0], l2[1], l2[2], l2[3], h2[0], h2[1], h2[2], h2[3]}, o[d0], 0, 0, 0);   \
        o[d0] = __builtin_amdgcn_mfma_f32_32x32x16_bf16(pa3, (bf16x8){l3[0], l3[1], l3[2], l3[3], h3[0], h3[1], h3[2], h3[3]}, o[d0], 0, 0, 0); } while (0)
    PV_D0(0); PV_D0(1); PV_D0(2); PV_D0(3);
#undef PV_D0
#undef TRRD
}

__device__ __forceinline__ void fox_block(char* lds, const bf16* Qh, const bf16* Kh, const bf16* Vh, const float* kbias, bf16* Orow0, int qb) {
    const int tid = threadIdx.x, wid = __builtin_amdgcn_readfirstlane(tid >> 6), lane = tid & 63, r32 = lane & 31, hi = lane >> 5;
    const int P0 = qb * QB, qlo = P0 + wid * QBLK, qm = qlo + r32 - 4 * hi;
    char* V_lds = lds; char* K_lds = lds + SHM_V;
    float* bias_l = (float*)(lds + SHM_V + SHM_K);
    float* wsf = bias_l + 64 + wid * 64; float* li_l = wsf; float* al_l = wsf + 32;
    bf16x8 qr[8];
#pragma unroll
    for (int d0 = 0; d0 < 8; ++d0) qr[d0] = *reinterpret_cast<const bf16x8*>(Qh + (size_t)(qlo + r32) * D + d0 * 16 + hi * 8);
    float m_reg = -1e30f, l_reg = 0.f; f32x16 o[4] = {};
    const int sr = tid >> 4, sc = (tid & 15) * 8, vst0 = v_st(sr, sc), vst1 = v_st(32 + sr, sc), kws = KSWZ(sr, sc * 2);
    const int vb0 = (int)(uintptr_t)V_lds + v_rd_base(lane);
    const int ntiles = P0 / KVBLK + 4;
    for (int j = ntiles - 1; j >= 0; --j) {
        const int kb = j * KVBLK;
        __syncthreads();
        { const bf16x8 k0 = *reinterpret_cast<const bf16x8*>(Kh + (size_t)(kb + sr) * D + sc), k1 = *reinterpret_cast<const bf16x8*>(Kh + (size_t)(kb + 32 + sr) * D + sc);
          const bf16x8 v0 = *reinterpret_cast<const bf16x8*>(Vh + (size_t)(kb + sr) * D + sc), v1 = *reinterpret_cast<const bf16x8*>(Vh + (size_t)(kb + 32 + sr) * D + sc);
          *(bf16x8*)(K_lds + kws) = k0; *(bf16x8*)(K_lds + kws + 32 * 256) = k1; *(bf16x8*)(V_lds + vst0) = v0; *(bf16x8*)(V_lds + vst1) = v1;
          if (tid < 64) bias_l[tid] = kbias[kb + tid]; }
        __syncthreads();
        if (kb <= qlo + QBLK - 1) {
            f32x16 p0, p1; float mn, al; bf16x8 pa0, pa1, pa2, pa3;
            qkt<0>(p0, p1, K_lds, bias_l, r32, hi, qr);
            if (kb + KVBLK - 1 > qlo) mask_tile(p0, p1, qm - kb, 0x40000000u);
            partialSM(p0, p1, m_reg, mn, al);
            if (__any(al < 1.f)) { if (hi == 0) al_l[r32] = al; asm volatile("s_waitcnt lgkmcnt(0)" ::: "memory");
                for (int d_ = 0; d_ < 4; ++d_) for (int r = 0; r < 16; ++r) o[d_][r] *= al_l[crow(r, hi)]; }
            finishSM(p0, p1, al, l_reg, pa0, pa1, pa2, pa3); SBAR();
            pv_tile<0>(o, vb0, pa0, pa1, pa2, pa3);
        }
    }
    if (hi == 0) li_l[r32] = l_reg; asm volatile("s_waitcnt lgkmcnt(0)" ::: "memory");
    float rli[16];
#pragma unroll
    for (int r = 0; r < 16; ++r) rli[r] = __builtin_amdgcn_rcpf(li_l[crow(r, hi)]);
    bf16* Ow = Orow0 + (size_t)qlo * DM;
#pragma unroll
    for (int r = 0; r < 16; ++r) { const int orow = crow(r, hi);
#pragma unroll
        for (int d0 = 0; d0 < 4; ++d0) { const float v = o[d0][r] * rli[r];
            const float vn = __shfl_xor(v, 1);
            if ((r32 & 1) == 0) *(unsigned*)(Ow + (size_t)orow * DM + d0 * 32 + r32) = cvtpk(v, vn); } }
    __syncthreads();
}
}


__device__ __forceinline__ void dec_update(float& m, float& l, f32x4& acc, const float (&x)[4], const f32x4 (&v)[4], int n) {
    float mx = m;
#pragma unroll
    for (int u = 0; u < 4; ++u) if (u < n) mx = fmaxf(mx, x[u]);
    const float al = __expf(m - mx);
    float ps = 0.f; f32x4 a = acc * al;
#pragma unroll
    for (int u = 0; u < 4; ++u) if (u < n) { const float p = __expf(x[u] - mx); ps += p; a += v[u] * p; }
    l = l * al + ps; acc = a; m = mx;
}
__device__ __forceinline__ float red32(float s) {
#pragma unroll
    for (int o = 1; o < 32; o <<= 1) s += __shfl_xor(s, o);
    return s;
}
__device__ __forceinline__ void decode_unit(const Params& P, LAS unsigned char* lds, int db) {
    const int tid = threadIdx.x, wid = __builtin_amdgcn_readfirstlane(tid >> 6), lane = tid & 63, hi = lane >> 5;
    const float* cache_k = P.in[2]; const float* cache_v = P.in[3]; const float* cache_lf = P.in[4]; const int* page_table = (const int*)P.in[5];
    const float* LF = (const float*)(P.ws + WS_LF); const float* QS = (const float*)(P.ws + WS_QS);
    bf16* MIX = (bf16*)(P.ws + WS_MIX);
    LAS f32x4* lfs = (LAS f32x4*)lds;
    LAS f32x4* wt = lfs + 2048;
    LAS float* cm = (LAS float*)(wt + 8);
    LAS float* cl = cm + 32;
    LAS f32x4* cacc = (LAS f32x4*)(cl + 32);
    const int ptv = (lane < NPAGES) ? page_table[db * NPAGES + lane] : 0;
#pragma unroll
    for (int i = 0; i < 4; ++i) { const int j = tid + 512 * i; const int pg = __shfl(ptv, j >> 7);
        lfs[j] = *(const f32x4*)(cache_lf + ((size_t)pg * PAGE + (j & 127)) * 4); }
    __syncthreads();
    {
        const f32x4 a0 = lfs[4 * tid], a1 = lfs[4 * tid + 1], a2 = lfs[4 * tid + 2], a3 = lfs[4 * tid + 3];
        const f32x4 tot = (a0 + a1) + (a2 + a3);
        f32x4 x = tot;
#pragma unroll
        for (int o = 1; o < 64; o <<= 1) { f32x4 y; y[0] = __shfl_down(x[0], o); y[1] = __shfl_down(x[1], o); y[2] = __shfl_down(x[2], o); y[3] = __shfl_down(x[3], o); if (lane + o < 64) x += y; }
        if (lane == 0) wt[wid] = x;
        __syncthreads();
        f32x4 after = {0.f, 0.f, 0.f, 0.f};
        for (int w2 = wid + 1; w2 < NWAVES; ++w2) after += wt[w2];
        const f32x4 lfn = *(const f32x4*)(LF + (size_t)(MP + db) * 4);
        const f32x4 B3 = (x - tot) + after + lfn, B2 = B3 + a3, B1 = B2 + a2, B0 = B1 + a1;
        lfs[4 * tid] = B0; lfs[4 * tid + 1] = B1; lfs[4 * tid + 2] = B2; lfs[4 * tid + 3] = B3;
    }
    __syncthreads();
    const float* qs = QS + (size_t)db * 512;
    const f32x4 qa = *(const f32x4*)(qs + 4 * lane) * ATT_SCALE, qb = *(const f32x4*)(qs + 256 + 4 * lane) * ATT_SCALE;
    float m0 = -1e30f, l0 = 0.f, m1 = -1e30f, l1 = 0.f; f32x4 acc0 = {0.f, 0.f, 0.f, 0.f}, acc1 = {0.f, 0.f, 0.f, 0.f};
    for (int j0 = wid; j0 < PAST; j0 += 32) {
        f32x4 ka[4], kb[4], va[4], vb[4]; float x0[4], x1[4];
#pragma unroll
        for (int u = 0; u < 4; ++u) { const int j = j0 + 8 * u; const int pg = __builtin_amdgcn_readlane(ptv, j >> 7);
            const size_t ro = ((size_t)pg * PAGE + (j & 127)) * 512 + 4 * lane;
            ka[u] = *(const f32x4*)(cache_k + ro); kb[u] = *(const f32x4*)(cache_k + ro + 256);
            va[u] = *(const f32x4*)(cache_v + ro); vb[u] = *(const f32x4*)(cache_v + ro + 256); }
#pragma unroll
        for (int u = 0; u < 4; ++u) { const int j = j0 + 8 * u;
            float s0 = (qa[0] * ka[u][0] + qa[1] * ka[u][1]) + (qa[2] * ka[u][2] + qa[3] * ka[u][3]);
            float s1 = (qb[0] * kb[u][0] + qb[1] * kb[u][1]) + (qb[2] * kb[u][2] + qb[3] * kb[u][3]);
            s0 = red32(s0); s1 = red32(s1);
            const f32x4 bj = lfs[j];
            x0[u] = s0 + (hi ? bj[1] : bj[0]); x1[u] = s1 + (hi ? bj[3] : bj[2]); }
        dec_update(m0, l0, acc0, x0, va, 4); dec_update(m1, l1, acc1, x1, vb, 4);
    }
    if (wid == 0) {
        f32x4 va[4], vb[4]; float x0[4], x1[4];
        const float* kn = P.out + OK_S + (size_t)db * 512; const float* vn = P.out + OV_S + (size_t)db * 512;
        const f32x4 ka = *(const f32x4*)(kn + 4 * lane), kb = *(const f32x4*)(kn + 256 + 4 * lane);
        va[0] = *(const f32x4*)(vn + 4 * lane); vb[0] = *(const f32x4*)(vn + 256 + 4 * lane);
#pragma unroll
        for (int u = 1; u < 4; ++u) { va[u] = va[0]; vb[u] = vb[0]; }
        x0[0] = red32((qa[0] * ka[0] + qa[1] * ka[1]) + (qa[2] * ka[2] + qa[3] * ka[3]));
        x1[0] = red32((qb[0] * kb[0] + qb[1] * kb[1]) + (qb[2] * kb[2] + qb[3] * kb[3]));
#pragma unroll
        for (int u = 1; u < 4; ++u) { x0[u] = x0[0]; x1[u] = x1[0]; }
        dec_update(m0, l0, acc0, x0, va, 1); dec_update(m1, l1, acc1, x1, vb, 1);
    }
    if ((lane & 31) == 0) { cm[wid * 4 + hi] = m0; cm[wid * 4 + 2 + hi] = m1; cl[wid * 4 + hi] = l0; cl[wid * 4 + 2 + hi] = l1; }
    cacc[(wid * 2 + 0) * 64 + lane] = acc0; cacc[(wid * 2 + 1) * 64 + lane] = acc1;
    __syncthreads();
    if (tid < 128) {
        const int ab = tid >> 6, l = tid & 63, head = 2 * ab + (l >> 5);
        float M = -1e30f;
#pragma unroll
        for (int w = 0; w < NWAVES; ++w) M = fmaxf(M, cm[w * 4 + head]);
        float L = 0.f; f32x4 O = {0.f, 0.f, 0.f, 0.f};
#pragma unroll
        for (int w = 0; w < NWAVES; ++w) { const float e = __expf(cm[w * 4 + head] - M); L += cl[w * 4 + head] * e; O += cacc[(w * 2 + ab) * 64 + l] * e; }
        const float inv = 1.0f / L;
        v2u o; o.x = pk2(O[0] * inv, O[1] * inv); o.y = pk2(O[2] * inv, O[3] * inv);
        *(v2u*)(MIX + (size_t)(MP + db) * DM + head * 128 + 4 * (l & 31)) = o;
    }
    __syncthreads();
}

__device__ __forceinline__ void sgdn_unit(const Params& P, LAS unsigned char* lds, int db, int h) {
    const int tid = threadIdx.x, wid = __builtin_amdgcn_readfirstlane(tid >> 6), lane = tid & 63;
    const float* state_conv = P.in[6]; const float* state_ssm = P.in[7]; const float* w_conv = P.in[11]; const float* w_gnorm = P.in[14];
    const float* BETA = (const float*)(P.ws + WS_BETA); const float* Gg = (const float*)(P.ws + WS_G);
    const bf16* ZB = (const bf16*)(P.ws + WS_ZB); bf16* MIX = (bf16*)(P.ws + WS_MIX);
    LAS float* xs = (LAS float*)lds;
    LAS float* red1 = xs + 384;
    LAS float* red2 = red1 + 1024;
    LAS float* ov = red2 + 1024;
    if (tid < 384) {
        const int seg = tid >> 7, d = tid & 127, ch = seg * 512 + h * 128 + d;
        const float* sc = state_conv + (size_t)db * 3 * CONVD + ch;
        float* oc = P.out + OCONV_S + (size_t)db * 3 * CONVD + ch;
        const float c0 = sc[0], c1 = sc[CONVD], c2 = sc[2 * CONVD], c3 = oc[2 * CONVD];
        const float a = c0 * w_conv[ch] + c1 * w_conv[CONVD + ch] + c2 * w_conv[2 * CONVD + ch] + c3 * w_conv[3 * CONVD + ch];
        xs[tid] = silu_f(a);
        oc[0] = c1; oc[CONVD] = c2;
    }
    __syncthreads();
    if (wid < 2) {
        const float a = xs[wid * 128 + lane], b = xs[wid * 128 + 64 + lane];
        const float ss = wave_sum(a * a + b * b);
        const float sc = (1.0f / sqrtf(ss + L2_EPS)) * (wid == 0 ? ATT_SCALE : 1.0f);
        xs[wid * 128 + lane] = a * sc; xs[wid * 128 + 64 + lane] = b * sc;
    }
    __syncthreads();
    const float gsc = expf(Gg[(size_t)(MP + db) * 4 + h]), bt = BETA[(size_t)(MP + db) * 4 + h];
    const float* Sp = state_ssm + ((size_t)(db * 4 + h) * 128 + 16 * wid) * 128 + 2 * lane;
    f32x2 s[16]; f32x2 ks = {0.f, 0.f};
#pragma unroll
    for (int r = 0; r < 16; ++r) { s[r] = *(const f32x2*)(Sp + (size_t)r * 128) * gsc; const float kd = xs[128 + 16 * wid + r]; ks += s[r] * kd; }
    *(LAS f32x2*)(red1 + wid * 128 + 2 * lane) = ks;
    __syncthreads();
    f32x2 kS = {0.f, 0.f};
#pragma unroll
    for (int w = 0; w < NWAVES; ++w) kS += *(const LAS f32x2*)(red1 + w * 128 + 2 * lane);
    const f32x2 vv = *(const LAS f32x2*)(xs + 256 + 2 * lane);
    const f32x2 delta = (vv - kS) * bt;
    float* So = P.out + OSSM_S + ((size_t)(db * 4 + h) * 128 + 16 * wid) * 128 + 2 * lane;
    f32x2 os = {0.f, 0.f};
#pragma unroll
    for (int r = 0; r < 16; ++r) { const float kd = xs[128 + 16 * wid + r], qd = xs[16 * wid + r]; s[r] += delta * kd; *(f32x2*)(So + (size_t)r * 128) = s[r]; os += s[r] * qd; }
    *(LAS f32x2*)(red2 + wid * 128 + 2 * lane) = os;
    __syncthreads();
    if (tid < 128) { float o = 0.f;
#pragma unroll
        for (int w = 0; w < NWAVES; ++w) o += red2[w * 128 + tid];
        ov[tid] = o; }
    __syncthreads();
    if (wid == 0) {
        const float a = ov[lane], b = ov[64 + lane];
        const float ss = wave_sum(a * a + b * b);
        const float rstd = 1.0f / sqrtf(ss * (1.0f / 128.0f) + RMS_EPS);
        const bf16* zr = ZB + (size_t)(MP + db) * 512 + h * 128;
        bf16* mr = MIX + (size_t)(MP + db) * DM + 512 + h * 128;
        mr[lane] = (bf16)f2bf(a * rstd * w_gnorm[lane] * silu_f(bf2f(zr[lane])));
        mr[64 + lane] = (bf16)f2bf(b * rstd * w_gnorm[64 + lane] * silu_f(bf2f(zr[64 + lane])));
    }
    __syncthreads();
}


constexpr int XS = 132, LS = 68;
__device__ __forceinline__ void gdna_unit(const Params& P, LAS unsigned char* lds, int unit) {
    const int tid = threadIdx.x, wid = __builtin_amdgcn_readfirstlane(tid >> 6), lane = tid & 63;
    const int n = unit & 31, bh = unit >> 5, b = bh >> 2, h = bh & 3, m0 = b * SEQ + n * GCH;
    const float* w_conv = P.in[11];
    const bf16* CB = (const bf16*)(P.ws + WS_CB);
    const float* BETA = (const float*)(P.ws + WS_BETA); const float* Gg = (const float*)(P.ws + WS_G);
    float* UT = (float*)(P.ws + WS_UT) + (size_t)unit * 8192; bf16* WN = (bf16*)(P.ws + WS_WN) + (size_t)unit * 8192; bf16* QG = (bf16*)(P.ws + WS_QG) + (size_t)unit * 8192;
    bf16* KGT = (bf16*)(P.ws + WS_KGT) + (size_t)unit * 8192; bf16* QKM = (bf16*)(P.ws + WS_QKM) + (size_t)unit * 4096; float* GL = (float*)(P.ws + WS_GL);
    LAS float* XQ = (LAS float*)lds; LAS float* XK = XQ + 64 * XS; LAS float* XV = XK + 64 * XS;
    LAS float* Lm = XV + 64 * XS;
    LAS float* gcs = Lm + 64 * LS; LAS float* bts = gcs + 64; LAS float* sks = bts + 64;
    if (tid < 384) {
        const int seg = tid >> 7, d = tid & 127, ch = seg * 512 + h * 128 + d;
        const float w0 = w_conv[ch], w1 = w_conv[CONVD + ch], w2 = w_conv[2 * CONVD + ch], w3 = w_conv[3 * CONVD + ch];
        const bf16* src = CB + (size_t)m0 * CONVD + ch;
        float x0 = 0.f, x1 = 0.f, x2 = 0.f;
        if (n > 0) { x0 = bf2f(src[-3 * CONVD]); x1 = bf2f(src[-2 * CONVD]); x2 = bf2f(src[-1 * CONVD]); }
        LAS float* X = XQ + seg * 64 * XS + d;
#pragma unroll 4
        for (int i = 0; i < 64; ++i) { const float x3 = bf2f(src[(size_t)i * CONVD]); X[i * XS] = silu_f((x0 * w0 + x1 * w1) + (x2 * w2 + x3 * w3)); x0 = x1; x1 = x2; x2 = x3; }
    }
    if (wid == 7) {
        const float g = Gg[(size_t)(m0 + lane) * 4 + h]; float x = g;
#pragma unroll
        for (int o = 1; o < 64; o <<= 1) { const float y = __shfl_up(x, o); if (lane >= o) x += y; }
        { const float bt_ = BETA[(size_t)(m0 + lane) * 4 + h]; gcs[lane] = x; bts[lane] = bt_; sks[lane] = bt_ * expf(x); }
    }
    __syncthreads();
#pragma unroll
    for (int rr = 0; rr < 16; ++rr) { const int isq = rr < 8, i = 8 * wid + (rr & 7); LAS float* X = (isq ? XQ : XK) + i * XS;
        const float a = X[lane], c = X[64 + lane]; const float ss = wave_sum(a * a + c * c);
        const float sc = (1.0f / sqrtf(ss + L2_EPS)) * (isq ? ATT_SCALE : 1.0f);
        X[lane] = a * sc; X[64 + lane] = c * sc; }
    __syncthreads();
    {
        const int i = tid >> 3, tj = tid & 7;
        float akk[8], aqk[8];
#pragma unroll
        for (int jj = 0; jj < 8; ++jj) { akk[jj] = 0.f; aqk[jj] = 0.f; }
        if (tj * 8 <= i) {
            for (int d = 0; d < 128; d += 4) {
                const f32x4 ki = *(const LAS f32x4*)(XK + i * XS + d), qi = *(const LAS f32x4*)(XQ + i * XS + d);
#pragma unroll
                for (int jj = 0; jj < 8; ++jj) { const f32x4 kj = *(const LAS f32x4*)(XK + (tj * 8 + jj) * XS + d);
                    akk[jj] += (ki[0] * kj[0] + ki[1] * kj[1]) + (ki[2] * kj[2] + ki[3] * kj[3]);
                    aqk[jj] += (qi[0] * kj[0] + qi[1] * kj[1]) + (qi[2] * kj[2] + qi[3] * kj[3]); }
            }
        }
        const float gi = gcs[i], bi = bts[i];
        v4u qo; unsigned qw[4];
#pragma unroll
        for (int jj = 0; jj < 8; jj += 2) {
            float lv[2], qv[2];
#pragma unroll
            for (int e = 0; e < 2; ++e) { const int j = tj * 8 + jj + e; const float dec = (j <= i) ? expf(gi - gcs[j]) : 0.f;
                lv[e] = (j < i) ? bi * akk[jj + e] * dec : 0.f; qv[e] = (j <= i) ? aqk[jj + e] * dec : 0.f; }
            Lm[i * LS + tj * 8 + jj] = lv[0]; Lm[i * LS + tj * 8 + jj + 1] = lv[1];
            qw[jj >> 1] = pk2(qv[0], qv[1]);
        }
        qo.x = qw[0]; qo.y = qw[1]; qo.z = qw[2]; qo.w = qw[3];
        *(v4u*)(QKM + (size_t)i * 64 + tj * 8) = qo;
    }
    __syncthreads();
    if (tid < 256) {
        const int c = tid; const bool isv = c < 128; const LAS float* X = isv ? (XV + c) : (XK + (c - 128)); const LAS float* scp = isv ? bts : sks;
        int vz; asm volatile("v_mov_b32 %0, 0" : "=v"(vz));
        const LAS float* LmV = Lm + vz;
        float x0 = X[0] * scp[0];
        float rr1 = X[XS] * scp[1]; f32x4 L1_0 = *(const LAS f32x4*)(LmV + LS);
        asm volatile("" ::: "memory");
        const float rr2 = X[2 * XS] * scp[2]; const f32x4 L2_0 = *(const LAS f32x4*)(LmV + 2 * LS + 0);
        float x1; { float a0 = rr1, a1 = 0.f, a2 = 0.f, a3 = 0.f; a0 -= L1_0[0] * x0; x1 = (a0 + a1) + (a2 + a3); }
        asm volatile("" ::: "memory");
        const float rr3 = X[3 * XS] * scp[3]; const f32x4 L3_0 = *(const LAS f32x4*)(LmV + 3 * LS + 0);
        float x2; { float a0 = rr2, a1 = 0.f, a2 = 0.f, a3 = 0.f; a0 -= L2_0[0] * x0; a1 -= L2_0[1] * x1; x2 = (a0 + a1) + (a2 + a3); }
        asm volatile("" ::: "memory");
        const float rr4 = X[4 * XS] * scp[4]; const f32x4 L4_0 = *(const LAS f32x4*)(LmV + 4 * LS + 0);
        float x3; { float a0 = rr3, a1 = 0.f, a2 = 0.f, a3 = 0.f; a0 -= L3_0[0] * x0; a1 -= L3_0[1] * x1; a2 -= L3_0[2] * x2; x3 = (a0 + a1) + (a2 + a3); }
        asm volatile("" ::: "memory");
        const float rr5 = X[5 * XS] * scp[5]; const f32x4 L5_0 = *(const LAS f32x4*)(LmV + 5 * LS + 0); const f32x4 L5_1 = *(const LAS f32x4*)(LmV + 5 * LS + 4);
        float x4; { float a0 = rr4, a1 = 0.f, a2 = 0.f, a3 = 0.f; a0 -= L4_0[0] * x0; a1 -= L4_0[1] * x1; a2 -= L4_0[2] * x2; a3 -= L4_0[3] * x3; x4 = (a0 + a1) + (a2 + a3); }
        asm volatile("" ::: "memory");
        const float rr6 = X[6 * XS] * scp[6]; const f32x4 L6_0 = *(const LAS f32x4*)(LmV + 6 * LS + 0); const f32x4 L6_1 = *(const LAS f32x4*)(LmV + 6 * LS + 4);
        float x5; { float a0 = rr5, a1 = 0.f, a2 = 0.f, a3 = 0.f; a0 -= L5_0[0] * x0; a1 -= L5_0[1] * x1; a2 -= L5_0[2] * x2; a3 -= L5_0[3] * x3; a0 -= L5_1[0] * x4; x5 = (a0 + a1) + (a2 + a3); }
        asm volatile("" ::: "memory");
        const float rr7 = X[7 * XS] * scp[7]; const f32x4 L7_0 = *(const LAS f32x4*)(LmV + 7 * LS + 0); const f32x4 L7_1 = *(const LAS f32x4*)(LmV + 7 * LS + 4);
        float x6; { float a0 = rr6, a1 = 0.f, a2 = 0.f, a3 = 0.f; a0 -= L6_0[0] * x0; a1 -= L6_0[1] * x1; a2 -= L6_0[2] * x2; a3 -= L6_0[3] * x3; a0 -= L6_1[0] * x4; a1 -= L6_1[1] * x5; x6 = (a0 + a1) + (a2 + a3); }
        asm volatile("" ::: "memory");
        const float rr8 = X[8 * XS] * scp[8]; const f32x4 L8_0 = *(const LAS f32x4*)(LmV + 8 * LS + 0); const f32x4 L8_1 = *(const LAS f32x4*)(LmV + 8 * LS + 4);
        float x7; { float a0 = rr7, a1 = 0.f, a2 = 0.f, a3 = 0.f; a0 -= L7_0[0] * x0; a1 -= L7_0[1] * x1; a2 -= L7_0[2] * x2; a3 -= L7_0[3] * x3; a0 -= L7_1[0] * x4; a1 -= L7_1[1] * x5; a2 -= L7_1[2] * x6; x7 = (a0 + a1) + (a2 + a3); }
        asm volatile("" ::: "memory");
        const float rr9 = X[9 * XS] * scp[9]; const f32x4 L9_0 = *(const LAS f32x4*)(LmV + 9 * LS + 0); const f32x4 L9_1 = *(const LAS f32x4*)(LmV + 9 * LS + 4);
        float x8; { float a0 = rr8, a1 = 0.f, a2 = 0.f, a3 = 0.f; a0 -= L8_0[0] * x0; a1 -= L8_0[1] * x1; a2 -= L8_0[2] * x2; a3 -= L8_0[3] * x3; a0 -= L8_1[0] * x4; a1 -= L8_1[1] * x5; a2 -= L8_1[2] * x6; a3 -= L8_1[3] * x7; x8 = (a0 + a1) + (a2 + a3); }
        asm volatile("" ::: "memory");
        const float rr10 = X[10 * XS] * scp[10]; const f32x4 L10_0 = *(const LAS f32x4*)(LmV + 10 * LS + 0); const f32x4 L10_1 = *(const LAS f32x4*)(LmV + 10 * LS + 4); const f32x4 L9_2 = *(const LAS f32x4*)(LmV + 9 * LS + 8);
        float x9; { float a0 = rr9, a1 = 0.f, a2 = 0.f, a3 = 0.f; a0 -= L9_0[0] * x0; a1 -= L9_0[1] * x1; a2 -= L9_0[2] * x2; a3 -= L9_0[3] * x3; a0 -= L9_1[0] * x4; a1 -= L9_1[1] * x5; a2 -= L9_1[2] * x6; a3 -= L9_1[3] * x7; a0 -= L9_2[0] * x8; x9 = (a0 + a1) + (a2 + a3); }
        asm volatile("" ::: "memory");
        const float rr11 = X[11 * XS] * scp[11]; const f32x4 L11_0 = *(const LAS f32x4*)(LmV + 11 * LS + 0); const f32x4 L11_1 = *(const LAS f32x4*)(LmV + 11 * LS + 4); const f32x4 L10_2 = *(const LAS f32x4*)(LmV + 10 * LS + 8);
        float x10; { float a0 = rr10, a1 = 0.f, a2 = 0.f, a3 = 0.f; a0 -= L10_0[0] * x0; a1 -= L10_0[1] * x1; a2 -= L10_0[2] * x2; a3 -= L10_0[3] * x3; a0 -= L10_1[0] * x4; a1 -= L10_1[1] * x5; a2 -= L10_1[2] * x6; a3 -= L10_1[3] * x7; a0 -= L10_2[0] * x8; a1 -= L10_2[1] * x9; x10 = (a0 + a1) + (a2 + a3); }
        asm volatile("" ::: "memory");
        const float rr12 = X[12 * XS] * scp[12]; const f32x4 L12_0 = *(const LAS f32x4*)(LmV + 12 * LS + 0); const f32x4 L12_1 = *(const LAS f32x4*)(LmV + 12 * LS + 4); const f32x4 L11_2 = *(const LAS f32x4*)(LmV + 11 * LS + 8);
        float x11; { float a0 = rr11, a1 = 0.f, a2 = 0.f, a3 = 0.f; a0 -= L11_0[0] * x0; a1 -= L11_0[1] * x1; a2 -= L11_0[2] * x2; a3 -= L11_0[3] * x3; a0 -= L11_1[0] * x4; a1 -= L11_1[1] * x5; a2 -= L11_1[2] * x6; a3 -= L11_1[3] * x7; a0 -= L11_2[0] * x8; a1 -= L11_2[1] * x9; a2 -= L11_2[2] * x10; x11 = (a0 + a1) + (a2 + a3); }
        asm volatile("" ::: "memory");
        const float rr13 = X[13 * XS] * scp[13]; const f32x4 L13_0 = *(const LAS f32x4*)(LmV + 13 * LS + 0); const f32x4 L13_1 = *(const LAS f32x4*)(LmV + 13 * LS + 4); const f32x4 L12_2 = *(const LAS f32x4*)(LmV + 12 * LS + 8);
        float x12; { float a0 = rr12, a1 = 0.f, a2 = 0.f, a3 = 0.f; a0 -= L12_0[0] * x0; a1 -= L12_0[1] * x1; a2 -= L12_0[2] * x2; a3 -= L12_0[3] * x3; a0 -= L12_1[0] * x4; a1 -= L12_1[1] * x5; a2 -= L12_1[2] * x6; a3 -= L12_1[3] * x7; a0 -= L12_2[0] * x8; a1 -= L12_2[1] * x9; a2 -= L12_2[2] * x10; a3 -= L12_2[3] * x11; x12 = (a0 + a1) + (a2 + a3); }
        asm volatile("" ::: "memory");
        const float rr14 = X[14 * XS] * scp[14]; const f32x4 L14_0 = *(const LAS f32x4*)(LmV + 14 * LS + 0); const f32x4 L14_1 = *(const LAS f32x4*)(LmV + 14 * LS + 4); const f32x4 L13_2 = *(const LAS f32x4*)(LmV + 13 * LS + 8); const f32x4 L13_3 = *(const LAS f32x4*)(LmV + 13 * LS + 12);
        float x13; { float a0 = rr13, a1 = 0.f, a2 = 0.f, a3 = 0.f; a0 -= L13_0[0] * x0; a1 -= L13_0[1] * x1; a2 -= L13_0[2] * x2; a3 -= L13_0[3] * x3; a0 -= L13_1[0] * x4; a1 -= L13_1[1] * x5; a2 -= L13_1[2] * x6; a3 -= L13_1[3] * x7; a0 -= L13_2[0] * x8; a1 -= L13_2[1] * x9; a2 -= L13_2[2] * x10; a3 -= L13_2[3] * x11; a0 -= L13_3[0] * x12; x13 = (a0 + a1) + (a2 + a3); }
        asm volatile("" ::: "memory");
        const float rr15 = X[15 * XS] * scp[15]; const f32x4 L15_0 = *(const LAS f32x4*)(LmV + 15 * LS + 0); const f32x4 L15_1 = *(const LAS f32x4*)(LmV + 15 * LS + 4); const f32x4 L14_2 = *(const LAS f32x4*)(LmV + 14 * LS + 8); const f32x4 L14_3 = *(const LAS f32x4*)(LmV + 14 * LS + 12);
        float x14; { float a0 = rr14, a1 = 0.f, a2 = 0.f, a3 = 0.f; a0 -= L14_0[0] * x0; a1 -= L14_0[1] * x1; a2 -= L14_0[2] * x2; a3 -= L14_0[3] * x3; a0 -= L14_1[0] * x4; a1 -= L14_1[1] * x5; a2 -= L14_1[2] * x6; a3 -= L14_1[3] * x7; a0 -= L14_2[0] * x8; a1 -= L14_2[1] * x9; a2 -= L14_2[2] * x10; a3 -= L14_2[3] * x11; a0 -= L14_3[0] * x12; a1 -= L14_3[1] * x13; x14 = (a0 + a1) + (a2 + a3); }
        asm volatile("" ::: "memory");
        const float rr16 = X[16 * XS] * scp[16]; const f32x4 L16_0 = *(const LAS f32x4*)(LmV + 16 * LS + 0); const f32x4 L16_1 = *(const LAS f32x4*)(LmV + 16 * LS + 4); const f32x4 L15_2 = *(const LAS f32x4*)(LmV + 15 * LS + 8); const f32x4 L15_3 = *(const LAS f32x4*)(LmV + 15 * LS + 12);
        float x15; { float a0 = rr15, a1 = 0.f, a2 = 0.f, a3 = 0.f; a0 -= L15_0[0] * x0; a1 -= L15_0[1] * x1; a2 -= L15_0[2] * x2; a3 -= L15_0[3] * x3; a0 -= L15_1[0] * x4; a1 -= L15_1[1] * x5; a2 -= L15_1[2] * x6; a3 -= L15_1[3] * x7; a0 -= L15_2[0] * x8; a1 -= L15_2[1] * x9; a2 -= L15_2[2] * x10; a3 -= L15_2[3] * x11; a0 -= L15_3[0] * x12; a1 -= L15_3[1] * x13; a2 -= L15_3[2] * x14; x15 = (a0 + a1) + (a2 + a3); }
        asm volatile("" ::: "memory");
        const float rr17 = X[17 * XS] * scp[17]; const f32x4 L17_0 = *(const LAS f32x4*)(LmV + 17 * LS + 0); const f32x4 L17_1 = *(const LAS f32x4*)(LmV + 17 * LS + 4); const f32x4 L16_2 = *(const LAS f32x4*)(LmV + 16 * LS + 8); const f32x4 L16_3 = *(const LAS f32x4*)(LmV + 16 * LS + 12);
        float x16; { float a0 = rr16, a1 = 0.f, a2 = 0.f, a3 = 0.f; a0 -= L16_0[0] * x0; a1 -= L16_0[1] * x1; a2 -= L16_0[2] * x2; a3 -= L16_0[3] * x3; a0 -= L16_1[0] * x4; a1 -= L16_1[1] * x5; a2 -= L16_1[2] * x6; a3 -= L16_1[3] * x7; a0 -= L16_2[0] * x8; a1 -= L16_2[1] * x9; a2 -= L16_2[2] * x10; a3 -= L16_2[3] * x11; a0 -= L16_3[0] * x12; a1 -= L16_3[1] * x13; a2 -= L16_3[2] * x14; a3 -= L16_3[3] * x15; x16 = (a0 + a1) + (a2 + a3); }
        asm volatile("" ::: "memory");
        const float rr18 = X[18 * XS] * scp[18]; const f32x4 L18_0 = *(const LAS f32x4*)(LmV + 18 * LS + 0); const f32x4 L18_1 = *(const LAS f32x4*)(LmV + 18 * LS + 4); const f32x4 L17_2 = *(const LAS f32x4*)(LmV + 17 * LS + 8); const f32x4 L17_3 = *(const LAS f32x4*)(LmV + 17 * LS + 12); const f32x4 L17_4 = *(const LAS f32x4*)(LmV + 17 * LS + 16);
        float x17; { float a0 = rr17, a1 = 0.f, a2 = 0.f, a3 = 0.f; a0 -= L17_0[0] * x0; a1 -= L17_0[1] * x1; a2 -= L17_0[2] * x2; a3 -= L17_0[3] * x3; a0 -= L17_1[0] * x4; a1 -= L17_1[1] * x5; a2 -= L17_1[2] * x6; a3 -= L17_1[3] * x7; a0 -= L17_2[0] * x8; a1 -= L17_2[1] * x9; a2 -= L17_2[2] * x10; a3 -= L17_2[3] * x11; a0 -= L17_3[0] * x12; a1 -= L17_3[1] * x13; a2 -= L17_3[2] * x14; a3 -= L17_3[3] * x15; a0 -= L17_4[0] * x16; x17 = (a0 + a1) + (a2 + a3); }
        asm volatile("" ::: "memory");
        const float rr19 = X[19 * XS] * scp[19]; const f32x4 L19_0 = *(const LAS f32x4*)(LmV + 19 * LS + 0); const f32x4 L19_1 = *(const LAS f32x4*)(LmV + 19 * LS + 4); const f32x4 L18_2 = *(const LAS f32x4*)(LmV + 18 * LS + 8); const f32x4 L18_3 = *(const LAS f32x4*)(LmV + 18 * LS + 12); const f32x4 L18_4 = *(const LAS f32x4*)(LmV + 18 * LS + 16);
        float x18; { float a0 = rr18, a1 = 0.f, a2 = 0.f, a3 = 0.f; a0 -= L18_0[0] * x0; a1 -= L18_0[1] * x1; a2 -= L18_0[2] * x2; a3 -= L18_0[3] * x3; a0 -= L18_1[0] * x4; a1 -= L18_1[1] * x5; a2 -= L18_1[2] * x6; a3 -= L18_1[3] * x7; a0 -= L18_2[0] * x8; a1 -= L18_2[1] * x9; a2 -= L18_2[2] * x10; a3 -= L18_2[3] * x11; a0 -= L18_3[0] * x12; a1 -= L18_3[1] * x13; a2 -= L18_3[2] * x14; a3 -= L18_3[3] * x15; a0 -= L18_4[0] * x16; a1 -= L18_4[1] * x17; x18 = (a0 + a1) + (a2 + a3); }
        asm volatile("" ::: "memory");
        const float rr20 = X[20 * XS] * scp[20]; const f32x4 L20_0 = *(const LAS f32x4*)(LmV + 20 * LS + 0); const f32x4 L20_1 = *(const LAS f32x4*)(LmV + 20 * LS + 4); const f32x4 L19_2 = *(const LAS f32x4*)(LmV + 19 * LS + 8); const f32x4 L19_3 = *(const LAS f32x4*)(LmV + 19 * LS + 12); const f32x4 L19_4 = *(const LAS f32x4*)(LmV + 19 * LS + 16);
        float x19; { float a0 = rr19, a1 = 0.f, a2 = 0.f, a3 = 0.f; a0 -= L19_0[0] * x0; a1 -= L19_0[1] * x1; a2 -= L19_0[2] * x2; a3 -= L19_0[3] * x3; a0 -= L19_1[0] * x4; a1 -= L19_1[1] * x5; a2 -= L19_1[2] * x6; a3 -= L19_1[3] * x7; a0 -= L19_2[0] * x8; a1 -= L19_2[1] * x9; a2 -= L19_2[2] * x10; a3 -= L19_2[3] * x11; a0 -= L19_3[0] * x12; a1 -= L19_3[1] * x13; a2 -= L19_3[2] * x14; a3 -= L19_3[3] * x15; a0 -= L19_4[0] * x16; a1 -= L19_4[1] * x17; a2 -= L19_4[2] * x18; x19 = (a0 + a1) + (a2 + a3); }
        asm volatile("" ::: "memory");
        const float rr21 = X[21 * XS] * scp[21]; const f32x4 L21_0 = *(const LAS f32x4*)(LmV + 21 * LS + 0); const f32x4 L21_1 = *(const LAS f32x4*)(LmV + 21 * LS + 4); const f32x4 L20_2 = *(const LAS f32x4*)(LmV + 20 * LS + 8); const f32x4 L20_3 = *(const LAS f32x4*)(LmV + 20 * LS + 12); const f32x4 L20_4 = *(const LAS f32x4*)(LmV + 20 * LS + 16);
        float x20; { float a0 = rr20, a1 = 0.f, a2 = 0.f, a3 = 0.f; a0 -= L20_0[0] * x0; a1 -= L20_0[1] * x1; a2 -= L20_0[2] * x2; a3 -= L20_0[3] * x3; a0 -= L20_1[0] * x4; a1 -= L20_1[1] * x5; a2 -= L20_1[2] * x6; a3 -= L20_1[3] * x7; a0 -= L20_2[0] * x8; a1 -= L20_2[1] * x9; a2 -= L20_2[2] * x10; a3 -= L20_2[3] * x11; a0 -= L20_3[0] * x12; a1 -= L20_3[1] * x13; a2 -= L20_3[2] * x14; a3 -= L20_3[3] * x15; a0 -= L20_4[0] * x16; a1 -= L20_4[1] * x17; a2 -= L20_4[2] * x18; a3 -= L20_4[3] * x19; x20 = (a0 + a1) + (a2 + a3); }
        asm volatile("" ::: "memory");
        const float rr22 = X[22 * XS] * scp[22]; const f32x4 L22_0 = *(const LAS f32x4*)(LmV + 22 * LS + 0); const f32x4 L22_1 = *(const LAS f32x4*)(LmV + 22 * LS + 4); const f32x4 L21_2 = *(const LAS f32x4*)(LmV + 21 * LS + 8); const f32x4 L21_3 = *(const LAS f32x4*)(LmV + 21 * LS + 12); const f32x4 L21_4 = *(const LAS f32x4*)(LmV + 21 * LS + 16); const f32x4 L21_5 = *(const LAS f32x4*)(LmV + 21 * LS + 20);
        float x21; { float a0 = rr21, a1 = 0.f, a2 = 0.f, a3 = 0.f; a0 -= L21_0[0] * x0; a1 -= L21_0[1] * x1; a2 -= L21_0[2] * x2; a3 -= L21_0[3] * x3; a0 -= L21_1[0] * x4; a1 -= L21_1[1] * x5; a2 -= L21_1[2] * x6; a3 -= L21_1[3] * x7; a0 -= L21_2[0] * x8; a1 -= L21_2[1] * x9; a2 -= L21_2[2] * x10; a3 -= L21_2[3] * x11; a0 -= L21_3[0] * x12; a1 -= L21_3[1] * x13; a2 -= L21_3[2] * x14; a3 -= L21_3[3] * x15; a0 -= L21_4[0] * x16; a1 -= L21_4[1] * x17; a2 -= L21_4[2] * x18; a3 -= L21_4[3] * x19; a0 -= L21_5[0] * x20; x21 = (a0 + a1) + (a2 + a3); }
        asm volatile("" ::: "memory");
        const float rr23 = X[23 * XS] * scp[23]; const f32x4 L23_0 = *(const LAS f32x4*)(LmV + 23 * LS + 0); const f32x4 L23_1 = *(const LAS f32x4*)(LmV + 23 * LS + 4); const f32x4 L22_2 = *(const LAS f32x4*)(LmV + 22 * LS + 8); const f32x4 L22_3 = *(const LAS f32x4*)(LmV + 22 * LS + 12); const f32x4 L22_4 = *(const LAS f32x4*)(LmV + 22 * LS + 16); const f32x4 L22_5 = *(const LAS f32x4*)(LmV + 22 * LS + 20);
        float x22; { float a0 = rr22, a1 = 0.f, a2 = 0.f, a3 = 0.f; a0 -= L22_0[0] * x0; a1 -= L22_0[1] * x1; a2 -= L22_0[2] * x2; a3 -= L22_0[3] * x3; a0 -= L22_1[0] * x4; a1 -= L22_1[1] * x5; a2 -= L22_1[2] * x6; a3 -= L22_1[3] * x7; a0 -= L22_2[0] * x8; a1 -= L22_2[1] * x9; a2 -= L22_2[2] * x10; a3 -= L22_2[3] * x11; a0 -= L22_3[0] * x12; a1 -= L22_3[1] * x13; a2 -= L22_3[2] * x14; a3 -= L22_3[3] * x15; a0 -= L22_4[0] * x16; a1 -= L22_4[1] * x17; a2 -= L22_4[2] * x18; a3 -= L22_4[3] * x19; a0 -= L22_5[0] * x20; a1 -= L22_5[1] * x21; x22 = (a0 + a1) + (a2 + a3); }
        asm volatile("" ::: "memory");
        const float rr24 = X[24 * XS] * scp[24]; const f32x4 L24_0 = *(const LAS f32x4*)(LmV + 24 * LS + 0); const f32x4 L24_1 = *(const LAS f32x4*)(LmV + 24 * LS + 4); const f32x4 L23_2 = *(const LAS f32x4*)(LmV + 23 * LS + 8); const f32x4 L23_3 = *(const LAS f32x4*)(LmV + 23 * LS + 12); const f32x4 L23_4 = *(const LAS f32x4*)(LmV + 23 * LS + 16); const f32x4 L23_5 = *(const LAS f32x4*)(LmV + 23 * LS + 20);
        float x23; { float a0 = rr23, a1 = 0.f, a2 = 0.f, a3 = 0.f; a0 -= L23_0[0] * x0; a1 -= L23_0[1] * x1; a2 -= L23_0[2] * x2; a3 -= L23_0[3] * x3; a0 -= L23_1[0] * x4; a1 -= L23_1[1] * x5; a2 -= L23_1[2] * x6; a3 -= L23_1[3] * x7; a0 -= L23_2[0] * x8; a1 -= L23_2[1] * x9; a2 -= L23_2[2] * x10; a3 -= L23_2[3] * x11; a0 -= L23_3[0] * x12; a1 -= L23_3[1] * x13; a2 -= L23_3[2] * x14; a3 -= L23_3[3] * x15; a0 -= L23_4[0] * x16; a1 -= L23_4[1] * x17; a2 -= L23_4[2] * x18; a3 -= L23_4[3] * x19; a0 -= L23_5[0] * x20; a1 -= L23_5[1] * x21; a2 -= L23_5[2] * x22; x23 = (a0 + a1) + (a2 + a3); }
        asm volatile("" ::: "memory");
        const float rr25 = X[25 * XS] * scp[25]; const f32x4 L25_0 = *(const LAS f32x4*)(LmV + 25 * LS + 0); const f32x4 L25_1 = *(const LAS f32x4*)(LmV + 25 * LS + 4); const f32x4 L24_2 = *(const LAS f32x4*)(LmV + 24 * LS + 8); const f32x4 L24_3 = *(const LAS f32x4*)(LmV + 24 * LS + 12); const f32x4 L24_4 = *(const LAS f32x4*)(LmV + 24 * LS + 16); const f32x4 L24_5 = *(const LAS f32x4*)(LmV + 24 * LS + 20);
        float x24; { float a0 = rr24, a1 = 0.f, a2 = 0.f, a3 = 0.f; a0 -= L24_0[0] * x0; a1 -= L24_0[1] * x1; a2 -= L24_0[2] * x2; a3 -= L24_0[3] * x3; a0 -= L24_1[0] * x4; a1 -= L24_1[1] * x5; a2 -= L24_1[2] * x6; a3 -= L24_1[3] * x7; a0 -= L24_2[0] * x8; a1 -= L24_2[1] * x9; a2 -= L24_2[2] * x10; a3 -= L24_2[3] * x11; a0 -= L24_3[0] * x12; a1 -= L24_3[1] * x13; a2 -= L24_3[2] * x14; a3 -= L24_3[3] * x15; a0 -= L24_4[0] * x16; a1 -= L24_4[1] * x17; a2 -= L24_4[2] * x18; a3 -= L24_4[3] * x19; a0 -= L24_5[0] * x20; a1 -= L24_5[1] * x21; a2 -= L24_5[2] * x22; a3 -= L24_5[3] * x23; x24 = (a0 + a1) + (a2 + a3); }
        asm volatile("" ::: "memory");
        const float rr26 = X[26 * XS] * scp[26]; const f32x4 L26_0 = *(const LAS f32x4*)(LmV + 26 * LS + 0); const f32x4 L26_1 = *(const LAS f32x4*)(LmV + 26 * LS + 4); const f32x4 L25_2 = *(const LAS f32x4*)(LmV + 25 * LS + 8); const f32x4 L25_3 = *(const LAS f32x4*)(LmV + 25 * LS + 12); const f32x4 L25_4 = *(const LAS f32x4*)(LmV + 25 * LS + 16); const f32x4 L25_5 = *(const LAS f32x4*)(LmV + 25 * LS + 20); const f32x4 L25_6 = *(const LAS f32x4*)(LmV + 25 * LS + 24);
        float x25; { float a0 = rr25, a1 = 0.f, a2 = 0.f, a3 = 0.f; a0 -= L25_0[0] * x0; a1 -= L25_0[1] * x1; a2 -= L25_0[2] * x2; a3 -= L25_0[3] * x3; a0 -= L25_1[0] * x4; a1 -= L25_1[1] * x5; a2 -= L25_1[2] * x6; a3 -= L25_1[3] * x7; a0 -= L25_2[0] * x8; a1 -= L25_2[1] * x9; a2 -= L25_2[2] * x10; a3 -= L25_2[3] * x11; a0 -= L25_3[0] * x12; a1 -= L25_3[1] * x13; a2 -= L25_3[2] * x14; a3 -= L25_3[3] * x15; a0 -= L25_4[0] * x16; a1 -= L25_4[1] * x17; a2 -= L25_4[2] * x18; a3 -= L25_4[3] * x19; a0 -= L25_5[0] * x20; a1 -= L25_5[1] * x21; a2 -= L25_5[2] * x22; a3 -= L25_5[3] * x23; a0 -= L25_6[0] * x24; x25 = (a0 + a1) + (a2 + a3); }
        asm volatile("" ::: "memory");
        const float rr27 = X[27 * XS] * scp[27]; const f32x4 L27_0 = *(const LAS f32x4*)(LmV + 27 * LS + 0); const f32x4 L27_1 = *(const LAS f32x4*)(LmV + 27 * LS + 4); const f32x4 L26_2 = *(const LAS f32x4*)(LmV + 26 * LS + 8); const f32x4 L26_3 = *(const LAS f32x4*)(LmV + 26 * LS + 12); const f32x4 L26_4 = *(const LAS f32x4*)(LmV + 26 * LS + 16); const f32x4 L26_5 = *(const LAS f32x4*)(LmV + 26 * LS + 20); const f32x4 L26_6 = *(const LAS f32x4*)(LmV + 26 * LS + 24);
        float x26; { float a0 = rr26, a1 = 0.f, a2 = 0.f, a3 = 0.f; a0 -= L26_0[0] * x0; a1 -= L26_0[1] * x1; a2 -= L26_0[2] * x2; a3 -= L26_0[3] * x3; a0 -= L26_1[0] * x4; a1 -= L26_1[1] * x5; a2 -= L26_1[2] * x6; a3 -= L26_1[3] * x7; a0 -= L26_2[0] * x8; a1 -= L26_2[1] * x9; a2 -= L26_2[2] * x10; a3 -= L26_2[3] * x11; a0 -= L26_3[0] * x12; a1 -= L26_3[1] * x13; a2 -= L26_3[2] * x14; a3 -= L26_3[3] * x15; a0 -= L26_4[0] * x16; a1 -= L26_4[1] * x17; a2 -= L26_4[2] * x18; a3 -= L26_4[3] * x19; a0 -= L26_5[0] * x20; a1 -= L26_5[1] * x21; a2 -= L26_5[2] * x22; a3 -= L26_5[3] * x23; a0 -= L26_6[0] * x24; a1 -= L26_6[1] * x25; x26 = (a0 + a1) + (a2 + a3); }
        asm volatile("" ::: "memory");
        const float rr28 = X[28 * XS] * scp[28]; const f32x4 L28_0 = *(const LAS f32x4*)(LmV + 28 * LS + 0); const f32x4 L28_1 = *(const LAS f32x4*)(LmV + 28 * LS + 4); const f32x4 L27_2 = *(const LAS f32x4*)(LmV + 27 * LS + 8); const f32x4 L27_3 = *(const LAS f32x4*)(LmV + 27 * LS + 12); const f32x4 L27_4 = *(const LAS f32x4*)(LmV + 27 * LS + 16); const f32x4 L27_5 = *(const LAS f32x4*)(LmV + 27 * LS + 20); const f32x4 L27_6 = *(const LAS f32x4*)(LmV + 27 * LS + 24);
        float x27; { float a0 = rr27, a1 = 0.f, a2 = 0.f, a3 = 0.f; a0 -= L27_0[0] * x0; a1 -= L27_0[1] * x1; a2 -= L27_0[2] * x2; a3 -= L27_0[3] * x3; a0 -= L27_1[0] * x4; a1 -= L27_1[1] * x5; a2 -= L27_1[2] * x6; a3 -= L27_1[3] * x7; a0 -= L27_2[0] * x8; a1 -= L27_2[1] * x9; a2 -= L27_2[2] * x10; a3 -= L27_2[3] * x11; a0 -= L27_3[0] * x12; a1 -= L27_3[1] * x13; a2 -= L27_3[2] * x14; a3 -= L27_3[3] * x15; a0 -= L27_4[0] * x16; a1 -= L27_4[1] * x17; a2 -= L27_4[2] * x18; a3 -= L27_4[3] * x19; a0 -= L27_5[0] * x20; a1 -= L27_5[1] * x21; a2 -= L27_5[2] * x22; a3 -= L27_5[3] * x23; a0 -= L27_6[0] * x24; a1 -= L27_6[1] * x25; a2 -= L27_6[2] * x26; x27 = (a0 + a1) + (a2 + a3); }
        asm volatile("" ::: "memory");
        const float rr29 = X[29 * XS] * scp[29]; const f32x4 L29_0 = *(const LAS f32x4*)(LmV + 29 * LS + 0); const f32x4 L29_1 = *(const LAS f32x4*)(LmV + 29 * LS + 4); const f32x4 L28_2 = *(const LAS f32x4*)(LmV + 28 * LS + 8); const f32x4 L28_3 = *(const LAS f32x4*)(LmV + 28 * LS + 12); const f32x4 L28_4 = *(const LAS f32x4*)(LmV + 28 * LS + 16); const f32x4 L28_5 = *(const LAS f32x4*)(LmV + 28 * LS + 20); const f32x4 L28_6 = *(const LAS f32x4*)(LmV + 28 * LS + 24);
        float x28; { float a0 = rr28, a1 = 0.f, a2 = 0.f, a3 = 0.f; a0 -= L28_0[0] * x0; a1 -= L28_0[1] * x1; a2 -= L28_0[2] * x2; a3 -= L28_0[3] * x3; a0 -= L28_1[0] * x4; a1 -= L28_1[1] * x5; a2 -= L28_1[2] * x6; a3 -= L28_1[3] * x7; a0 -= L28_2[0] * x8; a1 -= L28_2[1] * x9; a2 -= L28_2[2] * x10; a3 -= L28_2[3] * x11; a0 -= L28_3[0] * x12; a1 -= L28_3[1] * x13; a2 -= L28_3[2] * x14; a3 -= L28_3[3] * x15; a0 -= L28_4[0] * x16; a1 -= L28_4[1] * x17; a2 -= L28_4[2] * x18; a3 -= L28_4[3] * x19; a0 -= L28_5[0] * x20; a1 -= L28_5[1] * x21; a2 -= L28_5[2] * x22; a3 -= L28_5[3] * x23; a0 -= L28_6[0] * x24; a1 -= L28_6[1] * x25; a2 -= L28_6[2] * x26; a3 -= L28_6[3] * x27; x28 = (a0 + a1) + (a2 + a3); }
        asm volatile("" ::: "memory");
        const float rr30 = X[30 * XS] * scp[30]; const f32x4 L30_0 = *(const LAS f32x4*)(LmV + 30 * LS + 0); const f32x4 L30_1 = *(const LAS f32x4*)(LmV + 30 * LS + 4); const f32x4 L29_2 = *(const LAS f32x4*)(LmV + 29 * LS + 8); const f32x4 L29_3 = *(const LAS f32x4*)(LmV + 29 * LS + 12); const f32x4 L29_4 = *(const LAS f32x4*)(LmV + 29 * LS + 16); const f32x4 L29_5 = *(const LAS f32x4*)(LmV + 29 * LS + 20); const f32x4 L29_6 = *(const LAS f32x4*)(LmV + 29 * LS + 24); const f32x4 L29_7 = *(const LAS f32x4*)(LmV + 29 * LS + 28);
        float x29; { float a0 = rr29, a1 = 0.f, a2 = 0.f, a3 = 0.f; a0 -= L29_0[0] * x0; a1 -= L29_0[1] * x1; a2 -= L29_0[2] * x2; a3 -= L29_0[3] * x3; a0 -= L29_1[0] * x4; a1 -= L29_1[1] * x5; a2 -= L29_1[2] * x6; a3 -= L29_1[3] * x7; a0 -= L29_2[0] * x8; a1 -= L29_2[1] * x9; a2 -= L29_2[2] * x10; a3 -= L29_2[3] * x11; a0 -= L29_3[0] * x12; a1 -= L29_3[1] * x13; a2 -= L29_3[2] * x14; a3 -= L29_3[3] * x15; a0 -= L29_4[0] * x16; a1 -= L29_4[1] * x17; a2 -= L29_4[2] * x18; a3 -= L29_4[3] * x19; a0 -= L29_5[0] * x20; a1 -= L29_5[1] * x21; a2 -= L29_5[2] * x22; a3 -= L29_5[3] * x23; a0 -= L29_6[0] * x24; a1 -= L29_6[1] * x25; a2 -= L29_6[2] * x26; a3 -= L29_6[3] * x27; a0 -= L29_7[0] * x28; x29 = (a0 + a1) + (a2 + a3); }
        asm volatile("" ::: "memory");
        const float rr31 = X[31 * XS] * scp[31]; const f32x4 L31_0 = *(const LAS f32x4*)(LmV + 31 * LS + 0); const f32x4 L31_1 = *(const LAS f32x4*)(LmV + 31 * LS + 4); const f32x4 L30_2 = *(const LAS f32x4*)(LmV + 30 * LS + 8); const f32x4 L30_3 = *(const LAS f32x4*)(LmV + 30 * LS + 12); const f32x4 L30_4 = *(const LAS f32x4*)(LmV + 30 * LS + 16); const f32x4 L30_5 = *(const LAS f32x4*)(LmV + 30 * LS + 20); const f32x4 L30_6 = *(const LAS f32x4*)(LmV + 30 * LS + 24); const f32x4 L30_7 = *(const LAS f32x4*)(LmV + 30 * LS + 28);
        float x30; { float a0 = rr30, a1 = 0.f, a2 = 0.f, a3 = 0.f; a0 -= L30_0[0] * x0; a1 -= L30_0[1] * x1; a2 -= L30_0[2] * x2; a3 -= L30_0[3] * x3; a0 -= L30_1[0] * x4; a1 -= L30_1[1] * x5; a2 -= L30_1[2] * x6; a3 -= L30_1[3] * x7; a0 -= L30_2[0] * x8; a1 -= L30_2[1] * x9; a2 -= L30_2[2] * x10; a3 -= L30_2[3] * x11; a0 -= L30_3[0] * x12; a1 -= L30_3[1] * x13; a2 -= L30_3[2] * x14; a3 -= L30_3[3] * x15; a0 -= L30_4[0] * x16; a1 -= L30_4[1] * x17; a2 -= L30_4[2] * x18; a3 -= L30_4[3] * x19; a0 -= L30_5[0] * x20; a1 -= L30_5[1] * x21; a2 -= L30_5[2] * x22; a3 -= L30_5[3] * x23; a0 -= L30_6[0] * x24; a1 -= L30_6[1] * x25; a2 -= L30_6[2] * x26; a3 -= L30_6[3] * x27; a0 -= L30_7[0] * x28; a1 -= L30_7[1] * x29; x30 = (a0 + a1) + (a2 + a3); }
        asm volatile("" ::: "memory");
        const float rr32 = X[32 * XS] * scp[32]; const f32x4 L32_0 = *(const LAS f32x4*)(LmV + 32 * LS + 0); const f32x4 L32_1 = *(const LAS f32x4*)(LmV + 32 * LS + 4); const f32x4 L31_2 = *(const LAS f32x4*)(LmV + 31 * LS + 8); const f32x4 L31_3 = *(const LAS f32x4*)(LmV + 31 * LS + 12); const f32x4 L31_4 = *(const LAS f32x4*)(LmV + 31 * LS + 16); const f32x4 L31_5 = *(const LAS f32x4*)(LmV + 31 * LS + 20); const f32x4 L31_6 = *(const LAS f32x4*)(LmV + 31 * LS + 24); const f32x4 L31_7 = *(const LAS f32x4*)(LmV + 31 * LS + 28);
        float x31; { float a0 = rr31, a1 = 0.f, a2 = 0.f, a3 = 0.f; a0 -= L31_0[0] * x0; a1 -= L31_0[1] * x1; a2 -= L31_0[2] * x2; a3 -= L31_0[3] * x3; a0 -= L31_1[0] * x4; a1 -= L31_1[1] * x5; a2 -= L31_1[2] * x6; a3 -= L31_1[3] * x7; a0 -= L31_2[0] * x8; a1 -= L31_2[1] * x9; a2 -= L31_2[2] * x10; a3 -= L31_2[3] * x11; a0 -= L31_3[0] * x12; a1 -= L31_3[1] * x13; a2 -= L31_3[2] * x14; a3 -= L31_3[3] * x15; a0 -= L31_4[0] * x16; a1 -= L31_4[1] * x17; a2 -= L31_4[2] * x18; a3 -= L31_4[3] * x19; a0 -= L31_5[0] * x20; a1 -= L31_5[1] * x21; a2 -= L31_5[2] * x22; a3 -= L31_5[3] * x23; a0 -= L31_6[0] * x24; a1 -= L31_6[1] * x25; a2 -= L31_6[2] * x26; a3 -= L31_6[3] * x27; a0 -= L31_7[0] * x28; a1 -= L31_7[1] * x29; a2 -= L31_7[2] * x30; x31 = (a0 + a1) + (a2 + a3); }
        asm volatile("" ::: "memory");
        const float rr33 = X[33 * XS] * scp[33]; const f32x4 L33_0 = *(const LAS f32x4*)(LmV + 33 * LS + 0); const f32x4 L33_1 = *(const LAS f32x4*)(LmV + 33 * LS + 4); const f32x4 L32_2 = *(const LAS f32x4*)(LmV + 32 * LS + 8); const f32x4 L32_3 = *(const LAS f32x4*)(LmV + 32 * LS + 12); const f32x4 L32_4 = *(const LAS f32x4*)(LmV + 32 * LS + 16); const f32x4 L32_5 = *(const LAS f32x4*)(LmV + 32 * LS + 20); const f32x4 L32_6 = *(const LAS f32x4*)(LmV + 32 * LS + 24); const f32x4 L32_7 = *(const LAS f32x4*)(LmV + 32 * LS + 28);
        float x32; { float a0 = rr32, a1 = 0.f, a2 = 0.f, a3 = 0.f; a0 -= L32_0[0] * x0; a1 -= L32_0[1] * x1; a2 -= L32_0[2] * x2; a3 -= L32_0[3] * x3; a0 -= L32_1[0] * x4; a1 -= L32_1[1] * x5; a2 -= L32_1[2] * x6; a3 -= L32_1[3] * x7; a0 -= L32_2[0] * x8; a1 -= L32_2[1] * x9; a2 -= L32_2[2] * x10; a3 -= L32_2[3] * x11; a0 -= L32_3[0] * x12; a1 -= L32_3[1] * x13; a2 -= L32_3[2] * x14; a3 -= L32_3[3] * x15; a0 -= L32_4[0] * x16; a1 -= L32_4[1] * x17; a2 -= L32_4[2] * x18; a3 -= L32_4[3] * x19; a0 -= L32_5[0] * x20; a1 -= L32_5[1] * x21; a2 -= L32_5[2] * x22; a3 -= L32_5[3] * x23; a0 -= L32_6[0] * x24; a1 -= L32_6[1] * x25; a2 -= L32_6[2] * x26; a3 -= L32_6[3] * x27; a0 -= L32_7[0] * x28; a1 -= L32_7[1] * x29; a2 -= L32_7[2] * x30; a3 -= L32_7[3] * x31; x32 = (a0 + a1) + (a2 + a3); }
        asm volatile("" ::: "memory");
        const float rr34 = X[34 * XS] * scp[34]; const f32x4 L34_0 = *(const LAS f32x4*)(LmV + 34 * LS + 0); const f32x4 L34_1 = *(const LAS f32x4*)(LmV + 34 * LS + 4); const f32x4 L33_2 = *(const LAS f32x4*)(LmV + 33 * LS + 8); const f32x4 L33_3 = *(const LAS f32x4*)(LmV + 33 * LS + 12); const f32x4 L33_4 = *(const LAS f32x4*)(LmV + 33 * LS + 16); const f32x4 L33_5 = *(const LAS f32x4*)(LmV + 33 * LS + 20); const f32x4 L33_6 = *(const LAS f32x4*)(LmV + 33 * LS + 24); const f32x4 L33_7 = *(const LAS f32x4*)(LmV + 33 * LS + 28); const f32x4 L33_8 = *(const LAS f32x4*)(LmV + 33 * LS + 32);
        float x33; { float a0 = rr33, a1 = 0.f, a2 = 0.f, a3 = 0.f; a0 -= L33_0[0] * x0; a1 -= L33_0[1] * x1; a2 -= L33_0[2] * x2; a3 -= L33_0[3] * x3; a0 -= L33_1[0] * x4; a1 -= L33_1[1] * x5; a2 -= L33_1[2] * x6; a3 -= L33_1[3] * x7; a0 -= L33_2[0] * x8; a1 -= L33_2[1] * x9; a2 -= L33_2[2] * x10; a3 -= L33_2[3] * x11; a0 -= L33_3[0] * x12; a1 -= L33_3[1] * x13; a2 -= L33_3[2] * x14; a3 -= L33_3[3] * x15; a0 -= L33_4[0] * x16; a1 -= L33_4[1] * x17; a2 -= L33_4[2] * x18; a3 -= L33_4[3] * x19; a0 -= L33_5[0] * x20; a1 -= L33_5[1] * x21; a2 -= L33_5[2] * x22; a3 -= L33_5[3] * x23; a0 -= L33_6[0] * x24; a1 -= L33_6[1] * x25; a2 -= L33_6[2] * x26; a3 -= L33_6[3] * x27; a0 -= L33_7[0] * x28; a1 -= L33_7[1] * x29; a2 -= L33_7[2] * x30; a3 -= L33_7[3] * x31; a0 -= L33_8[0] * x32; x33 = (a0 + a1) + (a2 + a3); }
        asm volatile("" ::: "memory");
        const float rr35 = X[35 * XS] * scp[35]; const f32x4 L35_0 = *(const LAS f32x4*)(LmV + 35 * LS + 0); const f32x4 L35_1 = *(const LAS f32x4*)(LmV + 35 * LS + 4); const f32x4 L34_2 = *(const LAS f32x4*)(LmV + 34 * LS + 8); const f32x4 L34_3 = *(const LAS f32x4*)(LmV + 34 * LS + 12); const f32x4 L34_4 = *(const LAS f32x4*)(LmV + 34 * LS + 16); const f32x4 L34_5 = *(const LAS f32x4*)(LmV + 34 * LS + 20); const f32x4 L34_6 = *(const LAS f32x4*)(LmV + 34 * LS + 24); const f32x4 L34_7 = *(const LAS f32x4*)(LmV + 34 * LS + 28); const f32x4 L34_8 = *(const LAS f32x4*)(LmV + 34 * LS + 32);
        float x34; { float a0 = rr34, a1 = 0.f, a2 = 0.f, a3 = 0.f; a0 -= L34_0[0] * x0; a1 -= L34_0[1] * x1; a2 -= L34_0[2] * x2; a3 -= L34_0[3] * x3; a0 -= L34_1[0] * x4; a1 -= L34_1[1] * x5; a2 -= L34_1[2] * x6; a3 -= L34_1[3] * x7; a0 -= L34_2[0] * x8; a1 -= L34_2[1] * x9; a2 -= L34_2[2] * x10; a3 -= L34_2[3] * x11; a0 -= L34_3[0] * x12; a1 -= L34_3[1] * x13; a2 -= L34_3[2] * x14; a3 -= L34_3[3] * x15; a0 -= L34_4[0] * x16; a1 -= L34_4[1] * x17; a2 -= L34_4[2] * x18; a3 -= L34_4[3] * x19; a0 -= L34_5[0] * x20; a1 -= L34_5[1] * x21; a2 -= L34_5[2] * x22; a3 -= L34_5[3] * x23; a0 -= L34_6[0] * x24; a1 -= L34_6[1] * x25; a2 -= L34_6[2] * x26; a3 -= L34_6[3] * x27; a0 -= L34_7[0] * x28; a1 -= L34_7[1] * x29; a2 -= L34_7[2] * x30; a3 -= L34_7[3] * x31; a0 -= L34_8[0] * x32; a1 -= L34_8[1] * x33; x34 = (a0 + a1) + (a2 + a3); }
        asm volatile("" ::: "memory");
        const float rr36 = X[36 * XS] * scp[36]; const f32x4 L36_0 = *(const LAS f32x4*)(LmV + 36 * LS + 0); const f32x4 L36_1 = *(const LAS f32x4*)(LmV + 36 * LS + 4); const f32x4 L35_2 = *(const LAS f32x4*)(LmV + 35 * LS + 8); const f32x4 L35_3 = *(const LAS f32x4*)(LmV + 35 * LS + 12); const f32x4 L35_4 = *(const LAS f32x4*)(LmV + 35 * LS + 16); const f32x4 L35_5 = *(const LAS f32x4*)(LmV + 35 * LS + 20); const f32x4 L35_6 = *(const LAS f32x4*)(LmV + 35 * LS + 24); const f32x4 L35_7 = *(const LAS f32x4*)(LmV + 35 * LS + 28); const f32x4 L35_8 = *(const LAS f32x4*)(LmV + 35 * LS + 32);
        float x35; { float a0 = rr35, a1 = 0.f, a2 = 0.f, a3 = 0.f; a0 -= L35_0[0] * x0; a1 -= L35_0[1] * x1; a2 -= L35_0[2] * x2; a3 -= L35_0[3] * x3; a0 -= L35_1[0] * x4; a1 -= L35_1[1] * x5; a2 -= L35_1[2] * x6; a3 -= L35_1[3] * x7; a0 -= L35_2[0] * x8; a1 -= L35_2[1] * x9; a2 -= L35_2[2] * x10; a3 -= L35_2[3] * x11; a0 -= L35_3[0] * x12; a1 -= L35_3[1] * x13; a2 -= L35_3[2] * x14; a3 -= L35_3[3] * x15; a0 -= L35_4[0] * x16; a1 -= L35_4[1] * x17; a2 -= L35_4[2] * x18; a3 -= L35_4[3] * x19; a0 -= L35_5[0] * x20; a1 -= L35_5[1] * x21; a2 -= L35_5[2] * x22; a3 -= L35_5[3] * x23; a0 -= L35_6[0] * x24; a1 -= L35_6[1] * x25; a2 -= L35_6[2] * x26; a3 -= L35_6[3] * x27; a0 -= L35_7[0] * x28; a1 -= L35_7[1] * x29; a2 -= L35_7[2] * x30; a3 -= L35_7[3] * x31; a0 -= L35_8[0] * x32; a1 -= L35_8[1] * x33; a2 -= L35_8[2] * x34; x35 = (a0 + a1) + (a2 + a3); }
        asm volatile("" ::: "memory");
        const float rr37 = X[37 * XS] * scp[37]; const f32x4 L37_0 = *(const LAS f32x4*)(LmV + 37 * LS + 0); const f32x4 L37_1 = *(const LAS f32x4*)(LmV + 37 * LS + 4); const f32x4 L36_2 = *(const LAS f32x4*)(LmV + 36 * LS + 8); const f32x4 L36_3 = *(const LAS f32x4*)(LmV + 36 * LS + 12); const f32x4 L36_4 = *(const LAS f32x4*)(LmV + 36 * LS + 16); const f32x4 L36_5 = *(const LAS f32x4*)(LmV + 36 * LS + 20); const f32x4 L36_6 = *(const LAS f32x4*)(LmV + 36 * LS + 24); const f32x4 L36_7 = *(const LAS f32x4*)(LmV + 36 * LS + 28); const f32x4 L36_8 = *(const LAS f32x4*)(LmV + 36 * LS + 32);
        float x36; { float a0 = rr36, a1 = 0.f, a2 = 0.f, a3 = 0.f; a0 -= L36_0[0] * x0; a1 -= L36_0[1] * x1; a2 -= L36_0[2] * x2; a3 -= L36_0[3] * x3; a0 -= L36_1[0] * x4; a1 -= L36_1[1] * x5; a2 -= L36_1[2] * x6; a3 -= L36_1[3] * x7; a0 -= L36_2[0] * x8; a1 -= L36_2[1] * x9; a2 -= L36_2[2] * x10; a3 -= L36_2[3] * x11; a0 -= L36_3[0] * x12; a1 -= L36_3[1] * x13; a2 -= L36_3[2] * x14; a3 -= L36_3[3] * x15; a0 -= L36_4[0] * x16; a1 -= L36_4[1] * x17; a2 -= L36_4[2] * x18; a3 -= L36_4[3] * x19; a0 -= L36_5[0] * x20; a1 -= L36_5[1] * x21; a2 -= L36_5[2] * x22; a3 -= L36_5[3] * x23; a0 -= L36_6[0] * x24; a1 -= L36_6[1] * x25; a2 -= L36_6[2] * x26; a3 -= L36_6[3] * x27; a0 -= L36_7[0] * x28; a1 -= L36_7[1] * x29; a2 -= L36_7[2] * x30; a3 -= L36_7[3] * x31; a0 -= L36_8[0] * x32; a1 -= L36_8[1] * x33; a2 -= L36_8[2] * x34; a3 -= L36_8[3] * x35; x36 = (a0 + a1) + (a2 + a3); }
        asm volatile("" ::: "memory");
        const float rr38 = X[38 * XS] * scp[38]; const f32x4 L38_0 = *(const LAS f32x4*)(LmV + 38 * LS + 0); const f32x4 L38_1 = *(const LAS f32x4*)(LmV + 38 * LS + 4); const f32x4 L37_2 = *(const LAS f32x4*)(LmV + 37 * LS + 8); const f32x4 L37_3 = *(const LAS f32x4*)(LmV + 37 * LS + 12); const f32x4 L37_4 = *(const LAS f32x4*)(LmV + 37 * LS + 16); const f32x4 L37_5 = *(const LAS f32x4*)(LmV + 37 * LS + 20); const f32x4 L37_6 = *(const LAS f32x4*)(LmV + 37 * LS + 24); const f32x4 L37_7 = *(const LAS f32x4*)(LmV + 37 * LS + 28); const f32x4 L37_8 = *(const LAS f32x4*)(LmV + 37 * LS + 32); const f32x4 L37_9 = *(const LAS f32x4*)(LmV + 37 * LS + 36);
        float x37; { float a0 = rr37, a1 = 0.f, a2 = 0.f, a3 = 0.f; a0 -= L37_0[0] * x0; a1 -= L37_0[1] * x1; a2 -= L37_0[2] * x2; a3 -= L37_0[3] * x3; a0 -= L37_1[0] * x4; a1 -= L37_1[1] * x5; a2 -= L37_1[2] * x6; a3 -= L37_1[3] * x7; a0 -= L37_2[0] * x8; a1 -= L37_2[1] * x9; a2 -= L37_2[2] * x10; a3 -= L37_2[3] * x11; a0 -= L37_3[0] * x12; a1 -= L37_3[1] * x13; a2 -= L37_3[2] * x14; a3 -= L37_3[3] * x15; a0 -= L37_4[0] * x16; a1 -= L37_4[1] * x17; a2 -= L37_4[2] * x18; a3 -= L37_4[3] * x19; a0 -= L37_5[0] * x20; a1 -= L37_5[1] * x21; a2 -= L37_5[2] * x22; a3 -= L37_5[3] * x23; a0 -= L37_6[0] * x24; a1 -= L37_6[1] * x25; a2 -= L37_6[2] * x26; a3 -= L37_6[3] * x27; a0 -= L37_7[0] * x28; a1 -= L37_7[1] * x29; a2 -= L37_7[2] * x30; a3 -= L37_7[3] * x31; a0 -= L37_8[0] * x32; a1 -= L37_8[1] * x33; a2 -= L37_8[2] * x34; a3 -= L37_8[3] * x35; a0 -= L37_9[0] * x36; x37 = (a0 + a1) + (a2 + a3); }
        asm volatile("" ::: "memory");
        const float rr39 = X[39 * XS] * scp[39]; const f32x4 L39_0 = *(const LAS f32x4*)(LmV + 39 * LS + 0); const f32x4 L39_1 = *(const LAS f32x4*)(LmV + 39 * LS + 4); const f32x4 L38_2 = *(const LAS f32x4*)(LmV + 38 * LS + 8); const f32x4 L38_3 = *(const LAS f32x4*)(LmV + 38 * LS + 12); const f32x4 L38_4 = *(const LAS f32x4*)(LmV + 38 * LS + 16); const f32x4 L38_5 = *(const LAS f32x4*)(LmV + 38 * LS + 20); const f32x4 L38_6 = *(const LAS f32x4*)(LmV + 38 * LS + 24); const f32x4 L38_7 = *(const LAS f32x4*)(LmV + 38 * LS + 28); const f32x4 L38_8 = *(const LAS f32x4*)(LmV + 38 * LS + 32); const f32x4 L38_9 = *(const LAS f32x4*)(LmV + 38 * LS + 36);
        float x38; { float a0 = rr38, a1 = 0.f, a2 = 0.f, a3 = 0.f; a0 -= L38_0[0] * x0; a1 -= L38_0[1] * x1; a2 -= L38_0[2] * x2; a3 -= L38_0[3] * x3; a0 -= L38_1[0] * x4; a1 -= L38_1[1] * x5; a2 -= L38_1[2] * x6; a3 -= L38_1[3] * x7; a0 -= L38_2[0] * x8; a1 -= L38_2[1] * x9; a2 -= L38_2[2] * x10; a3 -= L38_2[3] * x11; a0 -= L38_3[0] * x12; a1 -= L38_3[1] * x13; a2 -= L38_3[2] * x14; a3 -= L38_3[3] * x15; a0 -= L38_4[0] * x16; a1 -= L38_4[1] * x17; a2 -= L38_4[2] * x18; a3 -= L38_4[3] * x19; a0 -= L38_5[0] * x20; a1 -= L38_5[1] * x21; a2 -= L38_5[2] * x22; a3 -= L38_5[3] * x23; a0 -= L38_6[0] * x24; a1 -= L38_6[1] * x25; a2 -= L38_6[2] * x26; a3 -= L38_6[3] * x27; a0 -= L38_7[0] * x28; a1 -= L38_7[1] * x29; a2 -= L38_7[2] * x30; a3 -= L38_7[3] * x31; a0 -= L38_8[0] * x32; a1 -= L38_8[1] * x33; a2 -= L38_8[2] * x34; a3 -= L38_8[3] * x35; a0 -= L38_9[0] * x36; a1 -= L38_9[1] * x37; x38 = (a0 + a1) + (a2 + a3); }
        asm volatile("" ::: "memory");
        const float rr40 = X[40 * XS] * scp[40]; const f32x4 L40_0 = *(const LAS f32x4*)(LmV + 40 * LS + 0); const f32x4 L40_1 = *(const LAS f32x4*)(LmV + 40 * LS + 4); const f32x4 L39_2 = *(const LAS f32x4*)(LmV + 39 * LS + 8); const f32x4 L39_3 = *(const LAS f32x4*)(LmV + 39 * LS + 12); const f32x4 L39_4 = *(const LAS f32x4*)(LmV + 39 * LS + 16); const f32x4 L39_5 = *(const LAS f32x4*)(LmV + 39 * LS + 20); const f32x4 L39_6 = *(const LAS f32x4*)(LmV + 39 * LS + 24); const f32x4 L39_7 = *(const LAS f32x4*)(LmV + 39 * LS + 28); const f32x4 L39_8 = *(const LAS f32x4*)(LmV + 39 * LS + 32); const f32x4 L39_9 = *(const LAS f32x4*)(LmV + 39 * LS + 36);
        float x39; { float a0 = rr39, a1 = 0.f, a2 = 0.f, a3 = 0.f; a0 -= L39_0[0] * x0; a1 -= L39_0[1] * x1; a2 -= L39_0[2] * x2; a3 -= L39_0[3] * x3; a0 -= L39_1[0] * x4; a1 -= L39_1[1] * x5; a2 -= L39_1[2] * x6; a3 -= L39_1[3] * x7; a0 -= L39_2[0] * x8; a1 -= L39_2[1] * x9; a2 -= L39_2[2] * x10; a3 -= L39_2[3] * x11; a0 -= L39_3[0] * x12; a1 -= L39_3[1] * x13; a2 -= L39_3[2] * x14; a3 -= L39_3[3] * x15; a0 -= L39_4[0] * x16; a1 -= L39_4[1] * x17; a2 -= L39_4[2] * x18; a3 -= L39_4[3] * x19; a0 -= L39_5[0] * x20; a1 -= L39_5[1] * x21; a2 -= L39_5[2] * x22; a3 -= L39_5[3] * x23; a0 -= L39_6[0] * x24; a1 -= L39_6[1] * x25; a2 -= L39_6[2] * x26; a3 -= L39_6[3] * x27; a0 -= L39_7[0] * x28; a1 -= L39_7[1] * x29; a2 -= L39_7[2] * x30; a3 -= L39_7[3] * x31; a0 -= L39_8[0] * x32; a1 -= L39_8[1] * x33; a2 -= L39_8[2] * x34; a3 -= L39_8[3] * x35; a0 -= L39_9[0] * x36; a1 -= L39_9[1] * x37; a2 -= L39_9[2] * x38; x39 = (a0 + a1) + (a2 + a3); }
        asm volatile("" ::: "memory");
        const float rr41 = X[41 * XS] * scp[41]; const f32x4 L41_0 = *(const LAS f32x4*)(LmV + 41 * LS + 0); const f32x4 L41_1 = *(const LAS f32x4*)(LmV + 41 * LS + 4); const f32x4 L40_2 = *(const LAS f32x4*)(LmV + 40 * LS + 8); const f32x4 L40_3 = *(const LAS f32x4*)(LmV + 40 * LS + 12); const f32x4 L40_4 = *(const LAS f32x4*)(LmV + 40 * LS + 16); const f32x4 L40_5 = *(const LAS f32x4*)(LmV + 40 * LS + 20); const f32x4 L40_6 = *(const LAS f32x4*)(LmV + 40 * LS + 24); const f32x4 L40_7 = *(const LAS f32x4*)(LmV + 40 * LS + 28); const f32x4 L40_8 = *(const LAS f32x4*)(LmV + 40 * LS + 32); const f32x4 L40_9 = *(const LAS f32x4*)(LmV + 40 * LS + 36);
        float x40; { float a0 = rr40, a1 = 0.f, a2 = 0.f, a3 = 0.f; a0 -= L40_0[0] * x0; a1 -= L40_0[1] * x1; a2 -= L40_0[2] * x2; a3 -= L40_0[3] * x3; a0 -= L40_1[0] * x4; a1 -= L40_1[1] * x5; a2 -= L40_1[2] * x6; a3 -= L40_1[3] * x7; a0 -= L40_2[0] * x8; a1 -= L40_2[1] * x9; a2 -= L40_2[2] * x10; a3 -= L40_2[3] * x11; a0 -= L40_3[0] * x12; a1 -= L40_3[1] * x13; a2 -= L40_3[2] * x14; a3 -= L40_3[3] * x15; a0 -= L40_4[0] * x16; a1 -= L40_4[1] * x17; a2 -= L40_4[2] * x18; a3 -= L40_4[3] * x19; a0 -= L40_5[0] * x20; a1 -= L40_5[1] * x21; a2 -= L40_5[2] * x22; a3 -= L40_5[3] * x23; a0 -= L40_6[0] * x24; a1 -= L40_6[1] * x25; a2 -= L40_6[2] * x26; a3 -= L40_6[3] * x27; a0 -= L40_7[0] * x28; a1 -= L40_7[1] * x29; a2 -= L40_7[2] * x30; a3 -= L40_7[3] * x31; a0 -= L40_8[0] * x32; a1 -= L40_8[1] * x33; a2 -= L40_8[2] * x34; a3 -= L40_8[3] * x35; a0 -= L40_9[0] * x36; a1 -= L40_9[1] * x37; a2 -= L40_9[2] * x38; a3 -= L40_9[3] * x39; x40 = (a0 + a1) + (a2 + a3); }
        asm volatile("" ::: "memory");
        const float rr42 = X[42 * XS] * scp[42]; const f32x4 L42_0 = *(const LAS f32x4*)(LmV + 42 * LS + 0); const f32x4 L42_1 = *(const LAS f32x4*)(LmV + 42 * LS + 4); const f32x4 L41_2 = *(const LAS f32x4*)(LmV + 41 * LS + 8); const f32x4 L41_3 = *(const LAS f32x4*)(LmV + 41 * LS + 12); const f32x4 L41_4 = *(const LAS f32x4*)(LmV + 41 * LS + 16); const f32x4 L41_5 = *(const LAS f32x4*)(LmV + 41 * LS + 20); const f32x4 L41_6 = *(const LAS f32x4*)(LmV + 41 * LS + 24); const f32x4 L41_7 = *(const LAS f32x4*)(LmV + 41 * LS + 28); const f32x4 L41_8 = *(const LAS f32x4*)(LmV + 41 * LS + 32); const f32x4 L41_9 = *(const LAS f32x4*)(LmV + 41 * LS + 36); const f32x4 L41_10 = *(const LAS f32x4*)(LmV + 41 * LS + 40);
        float x41; { float a0 = rr41, a1 = 0.f, a2 = 0.f, a3 = 0.f; a0 -= L41_0[0] * x0; a1 -= L41_0[1] * x1; a2 -= L41_0[2] * x2; a3 -= L41_0[3] * x3; a0 -= L41_1[0] * x4; a1 -= L41_1[1] * x5; a2 -= L41_1[2] * x6; a3 -= L41_1[3] * x7; a0 -= L41_2[0] * x8; a1 -= L41_2[1] * x9; a2 -= L41_2[2] * x10; a3 -= L41_2[3] * x11; a0 -= L41_3[0] * x12; a1 -= L41_3[1] * x13; a2 -= L41_3[2] * x14; a3 -= L41_3[3] * x15; a0 -= L41_4[0] * x16; a1 -= L41_4[1] * x17; a2 -= L41_4[2] * x18; a3 -= L41_4[3] * x19; a0 -= L41_5[0] * x20; a1 -= L41_5[1] * x21; a2 -= L41_5[2] * x22; a3 -= L41_5[3] * x23; a0 -= L41_6[0] * x24; a1 -= L41_6[1] * x25; a2 -= L41_6[2] * x26; a3 -= L41_6[3] * x27; a0 -= L41_7[0] * x28; a1 -= L41_7[1] * x29; a2 -= L41_7[2] * x30; a3 -= L41_7[3] * x31; a0 -= L41_8[0] * x32; a1 -= L41_8[1] * x33; a2 -= L41_8[2] * x34; a3 -= L41_8[3] * x35; a0 -= L41_9[0] * x36; a1 -= L41_9[1] * x37; a2 -= L41_9[2] * x38; a3 -= L41_9[3] * x39; a0 -= L41_10[0] * x40; x41 = (a0 + a1) + (a2 + a3); }
        asm volatile("" ::: "memory");
        const float rr43 = X[43 * XS] * scp[43]; const f32x4 L43_0 = *(const LAS f32x4*)(LmV + 43 * LS + 0); const f32x4 L43_1 = *(const LAS f32x4*)(LmV + 43 * LS + 4); const f32x4 L42_2 = *(const LAS f32x4*)(LmV + 42 * LS + 8); const f32x4 L42_3 = *(const LAS f32x4*)(LmV + 42 * LS + 12); const f32x4 L42_4 = *(const LAS f32x4*)(LmV + 42 * LS + 16); const f32x4 L42_5 = *(const LAS f32x4*)(LmV + 42 * LS + 20); const f32x4 L42_6 = *(const LAS f32x4*)(LmV + 42 * LS + 24); const f32x4 L42_7 = *(const LAS f32x4*)(LmV + 42 * LS + 28); const f32x4 L42_8 = *(const LAS f32x4*)(LmV + 42 * LS + 32); const f32x4 L42_9 = *(const LAS f32x4*)(LmV + 42 * LS + 36); const f32x4 L42_10 = *(const LAS f32x4*)(LmV + 42 * LS + 40);
        float x42; { float a0 = rr42, a1 = 0.f, a2 = 0.f, a3 = 0.f; a0 -= L42_0[0] * x0; a1 -= L42_0[1] * x1; a2 -= L42_0[2] * x2; a3 -= L42_0[3] * x3; a0 -= L42_1[0] * x4; a1 -= L42_1[1] * x5; a2 -= L42_1[2] * x6; a3 -= L42_1[3] * x7; a0 -= L42_2[0] * x8; a1 -= L42_2[1] * x9; a2 -= L42_2[2] * x10; a3 -= L42_2[3] * x11; a0 -= L42_3[0] * x12; a1 -= L42_3[1] * x13; a2 -= L42_3[2] * x14; a3 -= L42_3[3] * x15; a0 -= L42_4[0] * x16; a1 -= L42_4[1] * x17; a2 -= L42_4[2] * x18; a3 -= L42_4[3] * x19; a0 -= L42_5[0] * x20; a1 -= L42_5[1] * x21; a2 -= L42_5[2] * x22; a3 -= L42_5[3] * x23; a0 -= L42_6[0] * x24; a1 -= L42_6[1] * x25; a2 -= L42_6[2] * x26; a3 -= L42_6[3] * x27; a0 -= L42_7[0] * x28; a1 -= L42_7[1] * x29; a2 -= L42_7[2] * x30; a3 -= L42_7[3] * x31; a0 -= L42_8[0] * x32; a1 -= L42_8[1] * x33; a2 -= L42_8[2] * x34; a3 -= L42_8[3] * x35; a0 -= L42_9[0] * x36; a1 -= L42_9[1] * x37; a2 -= L42_9[2] * x38; a3 -= L42_9[3] * x39; a0 -= L42_10[0] * x40; a1 -= L42_10[1] * x41; x42 = (a0 + a1) + (a2 + a3); }
        asm volatile("" ::: "memory");
        const float rr44 = X[44 * XS] * scp[44]; const f32x4 L44_0 = *(const LAS f32x4*)(LmV + 44 * LS + 0); const f32x4 L44_1 = *(const LAS f32x4*)(LmV + 44 * LS + 4); const f32x4 L43_2 = *(const LAS f32x4*)(LmV + 43 * LS + 8); const f32x4 L43_3 = *(const LAS f32x4*)(LmV + 43 * LS + 12); const f32x4 L43_4 = *(const LAS f32x4*)(LmV + 43 * LS + 16); const f32x4 L43_5 = *(const LAS f32x4*)(LmV + 43 * LS + 20); const f32x4 L43_6 = *(const LAS f32x4*)(LmV + 43 * LS + 24); const f32x4 L43_7 = *(const LAS f32x4*)(LmV + 43 * LS + 28); const f32x4 L43_8 = *(const LAS f32x4*)(LmV + 43 * LS + 32); const f32x4 L43_9 = *(const LAS f32x4*)(LmV + 43 * LS + 36); const f32x4 L43_10 = *(const LAS f32x4*)(LmV + 43 * LS + 40);
        float x43; { float a0 = rr43, a1 = 0.f, a2 = 0.f, a3 = 0.f; a0 -= L43_0[0] * x0; a1 -= L43_0[1] * x1; a2 -= L43_0[2] * x2; a3 -= L43_0[3] * x3; a0 -= L43_1[0] * x4; a1 -= L43_1[1] * x5; a2 -= L43_1[2] * x6; a3 -= L43_1[3] * x7; a0 -= L43_2[0] * x8; a1 -= L43_2[1] * x9; a2 -= L43_2[2] * x10; a3 -= L43_2[3] * x11; a0 -= L43_3[0] * x12; a1 -= L43_3[1] * x13; a2 -= L43_3[2] * x14; a3 -= L43_3[3] * x15; a0 -= L43_4[0] * x16; a1 -= L43_4[1] * x17; a2 -= L43_4[2] * x18; a3 -= L43_4[3] * x19; a0 -= L43_5[0] * x20; a1 -= L43_5[1] * x21; a2 -= L43_5[2] * x22; a3 -= L43_5[3] * x23; a0 -= L43_6[0] * x24; a1 -= L43_6[1] * x25; a2 -= L43_6[2] * x26; a3 -= L43_6[3] * x27; a0 -= L43_7[0] * x28; a1 -= L43_7[1] * x29; a2 -= L43_7[2] * x30; a3 -= L43_7[3] * x31; a0 -= L43_8[0] * x32; a1 -= L43_8[1] * x33; a2 -= L43_8[2] * x34; a3 -= L43_8[3] * x35; a0 -= L43_9[0] * x36; a1 -= L43_9[1] * x37; a2 -= L43_9[2] * x38; a3 -= L43_9[3] * x39; a0 -= L43_10[0] * x40; a1 -= L43_10[1] * x41; a2 -= L43_10[2] * x42; x43 = (a0 + a1) + (a2 + a3); }
        asm volatile("" ::: "memory");
        const float rr45 = X[45 * XS] * scp[45]; const f32x4 L45_0 = *(const LAS f32x4*)(LmV + 45 * LS + 0); const f32x4 L45_1 = *(const LAS f32x4*)(LmV + 45 * LS + 4); const f32x4 L44_2 = *(const LAS f32x4*)(LmV + 44 * LS + 8); const f32x4 L44_3 = *(const LAS f32x4*)(LmV + 44 * LS + 12); const f32x4 L44_4 = *(const LAS f32x4*)(LmV + 44 * LS + 16); const f32x4 L44_5 = *(const LAS f32x4*)(LmV + 44 * LS + 20); const f32x4 L44_6 = *(const LAS f32x4*)(LmV + 44 * LS + 24); const f32x4 L44_7 = *(const LAS f32x4*)(LmV + 44 * LS + 28); const f32x4 L44_8 = *(const LAS f32x4*)(LmV + 44 * LS + 32); const f32x4 L44_9 = *(const LAS f32x4*)(LmV + 44 * LS + 36); const f32x4 L44_10 = *(const LAS f32x4*)(LmV + 44 * LS + 40);
        float x44; { float a0 = rr44, a1 = 0.f, a2 = 0.f, a3 = 0.f; a0 -= L44_0[0] * x0; a1 -= L44_0[1] * x1; a2 -= L44_0[2] * x2; a3 -= L44_0[3] * x3; a0 -= L44_1[0] * x4; a1 -= L44_1[1] * x5; a2 -= L44_1[2] * x6; a3 -= L44_1[3] * x7; a0 -= L44_2[0] * x8; a1 -= L44_2[1] * x9; a2 -= L44_2[2] * x10; a3 -= L44_2[3] * x11; a0 -= L44_3[0] * x12; a1 -= L44_3[1] * x13; a2 -= L44_3[2] * x14; a3 -= L44_3[3] * x15; a0 -= L44_4[0] * x16; a1 -= L44_4[1] * x17; a2 -= L44_4[2] * x18; a3 -= L44_4[3] * x19; a0 -= L44_5[0] * x20; a1 -= L44_5[1] * x21; a2 -= L44_5[2] * x22; a3 -= L44_5[3] * x23; a0 -= L44_6[0] * x24; a1 -= L44_6[1] * x25; a2 -= L44_6[2] * x26; a3 -= L44_6[3] * x27; a0 -= L44_7[0] * x28; a1 -= L44_7[1] * x29; a2 -= L44_7[2] * x30; a3 -= L44_7[3] * x31; a0 -= L44_8[0] * x32; a1 -= L44_8[1] * x33; a2 -= L44_8[2] * x34; a3 -= L44_8[3] * x35; a0 -= L44_9[0] * x36; a1 -= L44_9[1] * x37; a2 -= L44_9[2] * x38; a3 -= L44_9[3] * x39; a0 -= L44_10[0] * x40; a1 -= L44_10[1] * x41; a2 -= L44_10[2] * x42; a3 -= L44_10[3] * x43; x44 = (a0 + a1) + (a2 + a3); }
        asm volatile("" ::: "memory");
        const float rr46 = X[46 * XS] * scp[46]; const f32x4 L46_0 = *(const LAS f32x4*)(LmV + 46 * LS + 0); const f32x4 L46_1 = *(const LAS f32x4*)(LmV + 46 * LS + 4); const f32x4 L45_2 = *(const LAS f32x4*)(LmV + 45 * LS + 8); const f32x4 L45_3 = *(const LAS f32x4*)(LmV + 45 * LS + 12); const f32x4 L45_4 = *(const LAS f32x4*)(LmV + 45 * LS + 16); const f32x4 L45_5 = *(const LAS f32x4*)(LmV + 45 * LS + 20); const f32x4 L45_6 = *(const LAS f32x4*)(LmV + 45 * LS + 24); const f32x4 L45_7 = *(const LAS f32x4*)(LmV + 45 * LS + 28); const f32x4 L45_8 = *(const LAS f32x4*)(LmV + 45 * LS + 32); const f32x4 L45_9 = *(const LAS f32x4*)(LmV + 45 * LS + 36); const f32x4 L45_10 = *(const LAS f32x4*)(LmV + 45 * LS + 40); const f32x4 L45_11 = *(const LAS f32x4*)(LmV + 45 * LS + 44);
        float x45; { float a0 = rr45, a1 = 0.f, a2 = 0.f, a3 = 0.f; a0 -= L45_0[0] * x0; a1 -= L45_0[1] * x1; a2 -= L45_0[2] * x2; a3 -= L45_0[3] * x3; a0 -= L45_1[0] * x4; a1 -= L45_1[1] * x5; a2 -= L45_1[2] * x6; a3 -= L45_1[3] * x7; a0 -= L45_2[0] * x8; a1 -= L45_2[1] * x9; a2 -= L45_2[2] * x10; a3 -= L45_2[3] * x11; a0 -= L45_3[0] * x12; a1 -= L45_3[1] * x13; a2 -= L45_3[2] * x14; a3 -= L45_3[3] * x15; a0 -= L45_4[0] * x16; a1 -= L45_4[1] * x17; a2 -= L45_4[2] * x18; a3 -= L45_4[3] * x19; a0 -= L45_5[0] * x20; a1 -= L45_5[1] * x21; a2 -= L45_5[2] * x22; a3 -= L45_5[3] * x23; a0 -= L45_6[0] * x24; a1 -= L45_6[1] * x25; a2 -= L45_6[2] * x26; a3 -= L45_6[3] * x27; a0 -= L45_7[0] * x28; a1 -= L45_7[1] * x29; a2 -= L45_7[2] * x30; a3 -= L45_7[3] * x31; a0 -= L45_8[0] * x32; a1 -= L45_8[1] * x33; a2 -= L45_8[2] * x34; a3 -= L45_8[3] * x35; a0 -= L45_9[0] * x36; a1 -= L45_9[1] * x37; a2 -= L45_9[2] * x38; a3 -= L45_9[3] * x39; a0 -= L45_10[0] * x40; a1 -= L45_10[1] * x41; a2 -= L45_10[2] * x42; a3 -= L45_10[3] * x43; a0 -= L45_11[0] * x44; x45 = (a0 + a1) + (a2 + a3); }
        asm volatile("" ::: "memory");
        const float rr47 = X[47 * XS] * scp[47]; const f32x4 L47_0 = *(const LAS f32x4*)(LmV + 47 * LS + 0); const f32x4 L47_1 = *(const LAS f32x4*)(LmV + 47 * LS + 4); const f32x4 L46_2 = *(const LAS f32x4*)(LmV + 46 * LS + 8); const f32x4 L46_3 = *(const LAS f32x4*)(LmV + 46 * LS + 12); const f32x4 L46_4 = *(const LAS f32x4*)(LmV + 46 * LS + 16); const f32x4 L46_5 = *(const LAS f32x4*)(LmV + 46 * LS + 20); const f32x4 L46_6 = *(const LAS f32x4*)(LmV + 46 * LS + 24); const f32x4 L46_7 = *(const LAS f32x4*)(LmV + 46 * LS + 28); const f32x4 L46_8 = *(const LAS f32x4*)(LmV + 46 * LS + 32); const f32x4 L46_9 = *(const LAS f32x4*)(LmV + 46 * LS + 36); const f32x4 L46_10 = *(const LAS f32x4*)(LmV + 46 * LS + 40); const f32x4 L46_11 = *(const LAS f32x4*)(LmV + 46 * LS + 44);
        float x46; { float a0 = rr46, a1 = 0.f, a2 = 0.f, a3 = 0.f; a0 -= L46_0[0] * x0; a1 -= L46_0[1] * x1; a2 -= L46_0[2] * x2; a3 -= L46_0[3] * x3; a0 -= L46_1[0] * x4; a1 -= L46_1[1] * x5; a2 -= L46_1[2] * x6; a3 -= L46_1[3] * x7; a0 -= L46_2[0] * x8; a1 -= L46_2[1] * x9; a2 -= L46_2[2] * x10; a3 -= L46_2[3] * x11; a0 -= L46_3[0] * x12; a1 -= L46_3[1] * x13; a2 -= L46_3[2] * x14; a3 -= L46_3[3] * x15; a0 -= L46_4[0] * x16; a1 -= L46_4[1] * x17; a2 -= L46_4[2] * x18; a3 -= L46_4[3] * x19; a0 -= L46_5[0] * x20; a1 -= L46_5[1] * x21; a2 -= L46_5[2] * x22; a3 -= L46_5[3] * x23; a0 -= L46_6[0] * x24; a1 -= L46_6[1] * x25; a2 -= L46_6[2] * x26; a3 -= L46_6[3] * x27; a0 -= L46_7[0] * x28; a1 -= L46_7[1] * x29; a2 -= L46_7[2] * x30; a3 -= L46_7[3] * x31; a0 -= L46_8[0] * x32; a1 -= L46_8[1] * x33; a2 -= L46_8[2] * x34; a3 -= L46_8[3] * x35; a0 -= L46_9[0] * x36; a1 -= L46_9[1] * x37; a2 -= L46_9[2] * x38; a3 -= L46_9[3] * x39; a0 -= L46_10[0] * x40; a1 -= L46_10[1] * x41; a2 -= L46_10[2] * x42; a3 -= L46_10[3] * x43; a0 -= L46_11[0] * x44; a1 -= L46_11[1] * x45; x46 = (a0 + a1) + (a2 + a3); }
        asm volatile("" ::: "memory");
        const float rr48 = X[48 * XS] * scp[48]; const f32x4 L48_0 = *(const LAS f32x4*)(LmV + 48 * LS + 0); const f32x4 L48_1 = *(const LAS f32x4*)(LmV + 48 * LS + 4); const f32x4 L47_2 = *(const LAS f32x4*)(LmV + 47 * LS + 8); const f32x4 L47_3 = *(const LAS f32x4*)(LmV + 47 * LS + 12); const f32x4 L47_4 = *(const LAS f32x4*)(LmV + 47 * LS + 16); const f32x4 L47_5 = *(const LAS f32x4*)(LmV + 47 * LS + 20); const f32x4 L47_6 = *(const LAS f32x4*)(LmV + 47 * LS + 24); const f32x4 L47_7 = *(const LAS f32x4*)(LmV + 47 * LS + 28); const f32x4 L47_8 = *(const LAS f32x4*)(LmV + 47 * LS + 32); const f32x4 L47_9 = *(const LAS f32x4*)(LmV + 47 * LS + 36); const f32x4 L47_10 = *(const LAS f32x4*)(LmV + 47 * LS + 40); const f32x4 L47_11 = *(const LAS f32x4*)(LmV + 47 * LS + 44);
        float x47; { float a0 = rr47, a1 = 0.f, a2 = 0.f, a3 = 0.f; a0 -= L47_0[0] * x0; a1 -= L47_0[1] * x1; a2 -= L47_0[2] * x2; a3 -= L47_0[3] * x3; a0 -= L47_1[0] * x4; a1 -= L47_1[1] * x5; a2 -= L47_1[2] * x6; a3 -= L47_1[3] * x7; a0 -= L47_2[0] * x8; a1 -= L47_2[1] * x9; a2 -= L47_2[2] * x10; a3 -= L47_2[3] * x11; a0 -= L47_3[0] * x12; a1 -= L47_3[1] * x13; a2 -= L47_3[2] * x14; a3 -= L47_3[3] * x15; a0 -= L47_4[0] * x16; a1 -= L47_4[1] * x17; a2 -= L47_4[2] * x18; a3 -= L47_4[3] * x19; a0 -= L47_5[0] * x20; a1 -= L47_5[1] * x21; a2 -= L47_5[2] * x22; a3 -= L47_5[3] * x23; a0 -= L47_6[0] * x24; a1 -= L47_6[1] * x25; a2 -= L47_6[2] * x26; a3 -= L47_6[3] * x27; a0 -= L47_7[0] * x28; a1 -= L47_7[1] * x29; a2 -= L47_7[2] * x30; a3 -= L47_7[3] * x31; a0 -= L47_8[0] * x32; a1 -= L47_8[1] * x33; a2 -= L47_8[2] * x34; a3 -= L47_8[3] * x35; a0 -= L47_9[0] * x36; a1 -= L47_9[1] * x37; a2 -= L47_9[2] * x38; a3 -= L47_9[3] * x39; a0 -= L47_10[0] * x40; a1 -= L47_10[1] * x41; a2 -= L47_10[2] * x42; a3 -= L47_10[3] * x43; a0 -= L47_11[0] * x44; a1 -= L47_11[1] * x45; a2 -= L47_11[2] * x46; x47 = (a0 + a1) + (a2 + a3); }
        asm volatile("" ::: "memory");
        const float rr49 = X[49 * XS] * scp[49]; const f32x4 L49_0 = *(const LAS f32x4*)(LmV + 49 * LS + 0); const f32x4 L49_1 = *(const LAS f32x4*)(LmV + 49 * LS + 4); const f32x4 L48_2 = *(const LAS f32x4*)(LmV + 48 * LS + 8); const f32x4 L48_3 = *(const LAS f32x4*)(LmV + 48 * LS + 12); const f32x4 L48_4 = *(const LAS f32x4*)(LmV + 48 * LS + 16); const f32x4 L48_5 = *(const LAS f32x4*)(LmV + 48 * LS + 20); const f32x4 L48_6 = *(const LAS f32x4*)(LmV + 48 * LS + 24); const f32x4 L48_7 = *(const LAS f32x4*)(LmV + 48 * LS + 28); const f32x4 L48_8 = *(const LAS f32x4*)(LmV + 48 * LS + 32); const f32x4 L48_9 = *(const LAS f32x4*)(LmV + 48 * LS + 36); const f32x4 L48_10 = *(const LAS f32x4*)(LmV + 48 * LS + 40); const f32x4 L48_11 = *(const LAS f32x4*)(LmV + 48 * LS + 44);
        float x48; { float a0 = rr48, a1 = 0.f, a2 = 0.f, a3 = 0.f; a0 -= L48_0[0] * x0; a1 -= L48_0[1] * x1; a2 -= L48_0[2] * x2; a3 -= L48_0[3] * x3; a0 -= L48_1[0] * x4; a1 -= L48_1[1] * x5; a2 -= L48_1[2] * x6; a3 -= L48_1[3] * x7; a0 -= L48_2[0] * x8; a1 -= L48_2[1] * x9; a2 -= L48_2[2] * x10; a3 -= L48_2[3] * x11; a0 -= L48_3[0] * x12; a1 -= L48_3[1] * x13; a2 -= L48_3[2] * x14; a3 -= L48_3[3] * x15; a0 -= L48_4[0] * x16; a1 -= L48_4[1] * x17; a2 -= L48_4[2] * x18; a3 -= L48_4[3] * x19; a0 -= L48_5[0] * x20; a1 -= L48_5[1] * x21; a2 -= L48_5[2] * x22; a3 -= L48_5[3] * x23; a0 -= L48_6[0] * x24; a1 -= L48_6[1] * x25; a2 -= L48_6[2] * x26; a3 -= L48_6[3] * x27; a0 -= L48_7[0] * x28; a1 -= L48_7[1] * x29; a2 -= L48_7[2] * x30; a3 -= L48_7[3] * x31; a0 -= L48_8[0] * x32; a1 -= L48_8[1] * x33; a2 -= L48_8[2] * x34; a3 -= L48_8[3] * x35; a0 -= L48_9[0] * x36; a1 -= L48_9[1] * x37; a2 -= L48_9[2] * x38; a3 -= L48_9[3] * x39; a0 -= L48_10[0] * x40; a1 -= L48_10[1] * x41; a2 -= L48_10[2] * x42; a3 -= L48_10[3] * x43; a0 -= L48_11[0] * x44; a1 -= L48_11[1] * x45; a2 -= L48_11[2] * x46; a3 -= L48_11[3] * x47; x48 = (a0 + a1) + (a2 + a3); }
        asm volatile("" ::: "memory");
        const float rr50 = X[50 * XS] * scp[50]; const f32x4 L50_0 = *(const LAS f32x4*)(LmV + 50 * LS + 0); const f32x4 L50_1 = *(const LAS f32x4*)(LmV + 50 * LS + 4); const f32x4 L49_2 = *(const LAS f32x4*)(LmV + 49 * LS + 8); const f32x4 L49_3 = *(const LAS f32x4*)(LmV + 49 * LS + 12); const f32x4 L49_4 = *(const LAS f32x4*)(LmV + 49 * LS + 16); const f32x4 L49_5 = *(const LAS f32x4*)(LmV + 49 * LS + 20); const f32x4 L49_6 = *(const LAS f32x4*)(LmV + 49 * LS + 24); const f32x4 L49_7 = *(const LAS f32x4*)(LmV + 49 * LS + 28); const f32x4 L49_8 = *(const LAS f32x4*)(LmV + 49 * LS + 32); const f32x4 L49_9 = *(const LAS f32x4*)(LmV + 49 * LS + 36); const f32x4 L49_10 = *(const LAS f32x4*)(LmV + 49 * LS + 40); const f32x4 L49_11 = *(const LAS f32x4*)(LmV + 49 * LS + 44); const f32x4 L49_12 = *(const LAS f32x4*)(LmV + 49 * LS + 48);
        float x49; { float a0 = rr49, a1 = 0.f, a2 = 0.f, a3 = 0.f; a0 -= L49_0[0] * x0; a1 -= L49_0[1] * x1; a2 -= L49_0[2] * x2; a3 -= L49_0[3] * x3; a0 -= L49_1[0] * x4; a1 -= L49_1[1] * x5; a2 -= L49_1[2] * x6; a3 -= L49_1[3] * x7; a0 -= L49_2[0] * x8; a1 -= L49_2[1] * x9; a2 -= L49_2[2] * x10; a3 -= L49_2[3] * x11; a0 -= L49_3[0] * x12; a1 -= L49_3[1] * x13; a2 -= L49_3[2] * x14; a3 -= L49_3[3] * x15; a0 -= L49_4[0] * x16; a1 -= L49_4[1] * x17; a2 -= L49_4[2] * x18; a3 -= L49_4[3] * x19; a0 -= L49_5[0] * x20; a1 -= L49_5[1] * x21; a2 -= L49_5[2] * x22; a3 -= L49_5[3] * x23; a0 -= L49_6[0] * x24; a1 -= L49_6[1] * x25; a2 -= L49_6[2] * x26; a3 -= L49_6[3] * x27; a0 -= L49_7[0] * x28; a1 -= L49_7[1] * x29; a2 -= L49_7[2] * x30; a3 -= L49_7[3] * x31; a0 -= L49_8[0] * x32; a1 -= L49_8[1] * x33; a2 -= L49_8[2] * x34; a3 -= L49_8[3] * x35; a0 -= L49_9[0] * x36; a1 -= L49_9[1] * x37; a2 -= L49_9[2] * x38; a3 -= L49_9[3] * x39; a0 -= L49_10[0] * x40; a1 -= L49_10[1] * x41; a2 -= L49_10[2] * x42; a3 -= L49_10[3] * x43; a0 -= L49_11[0] * x44; a1 -= L49_11[1] * x45; a2 -= L49_11[2] * x46; a3 -= L49_11[3] * x47; a0 -= L49_12[0] * x48; x49 = (a0 + a1) + (a2 + a3); }
        asm volatile("" ::: "memory");
        const float rr51 = X[51 * XS] * scp[51]; const f32x4 L51_0 = *(const LAS f32x4*)(LmV + 51 * LS + 0); const f32x4 L51_1 = *(const LAS f32x4*)(LmV + 51 * LS + 4); const f32x4 L50_2 = *(const LAS f32x4*)(LmV + 50 * LS + 8); const f32x4 L50_3 = *(const LAS f32x4*)(LmV + 50 * LS + 12); const f32x4 L50_4 = *(const LAS f32x4*)(LmV + 50 * LS + 16); const f32x4 L50_5 = *(const LAS f32x4*)(LmV + 50 * LS + 20); const f32x4 L50_6 = *(const LAS f32x4*)(LmV + 50 * LS + 24); const f32x4 L50_7 = *(const LAS f32x4*)(LmV + 50 * LS + 28); const f32x4 L50_8 = *(const LAS f32x4*)(LmV + 50 * LS + 32); const f32x4 L50_9 = *(const LAS f32x4*)(LmV + 50 * LS + 36); const f32x4 L50_10 = *(const LAS f32x4*)(LmV + 50 * LS + 40); const f32x4 L50_11 = *(const LAS f32x4*)(LmV + 50 * LS + 44); const f32x4 L50_12 = *(const LAS f32x4*)(LmV + 50 * LS + 48);
        float x50; { float a0 = rr50, a1 = 0.f, a2 = 0.f, a3 = 0.f; a0 -= L50_0[0] * x0; a1 -= L50_0[1] * x1; a2 -= L50_0[2] * x2; a3 -= L50_0[3] * x3; a0 -= L50_1[0] * x4; a1 -= L50_1[1] * x5; a2 -= L50_1[2] * x6; a3 -= L50_1[3] * x7; a0 -= L50_2[0] * x8; a1 -= L50_2[1] * x9; a2 -= L50_2[2] * x10; a3 -= L50_2[3] * x11; a0 -= L50_3[0] * x12; a1 -= L50_3[1] * x13; a2 -= L50_3[2] * x14; a3 -= L50_3[3] * x15; a0 -= L50_4[0] * x16; a1 -= L50_4[1] * x17; a2 -= L50_4[2] * x18; a3 -= L50_4[3] * x19; a0 -= L50_5[0] * x20; a1 -= L50_5[1] * x21; a2 -= L50_5[2] * x22; a3 -= L50_5[3] * x23; a0 -= L50_6[0] * x24; a1 -= L50_6[1] * x25; a2 -= L50_6[2] * x26; a3 -= L50_6[3] * x27; a0 -= L50_7[0] * x28; a1 -= L50_7[1] * x29; a2 -= L50_7[2] * x30; a3 -= L50_7[3] * x31; a0 -= L50_8[0] * x32; a1 -= L50_8[1] * x33; a2 -= L50_8[2] * x34; a3 -= L50_8[3] * x35; a0 -= L50_9[0] * x36; a1 -= L50_9[1] * x37; a2 -= L50_9[2] * x38; a3 -= L50_9[3] * x39; a0 -= L50_10[0] * x40; a1 -= L50_10[1] * x41; a2 -= L50_10[2] * x42; a3 -= L50_10[3] * x43; a0 -= L50_11[0] * x44; a1 -= L50_11[1] * x45; a2 -= L50_11[2] * x46; a3 -= L50_11[3] * x47; a0 -= L50_12[0] * x48; a1 -= L50_12[1] * x49; x50 = (a0 + a1) + (a2 + a3); }
        asm volatile("" ::: "memory");
        const float rr52 = X[52 * XS] * scp[52]; const f32x4 L52_0 = *(const LAS f32x4*)(LmV + 52 * LS + 0); const f32x4 L52_1 = *(const LAS f32x4*)(LmV + 52 * LS + 4); const f32x4 L51_2 = *(const LAS f32x4*)(LmV + 51 * LS + 8); const f32x4 L51_3 = *(const LAS f32x4*)(LmV + 51 * LS + 12); const f32x4 L51_4 = *(const LAS f32x4*)(LmV + 51 * LS + 16); const f32x4 L51_5 = *(const LAS f32x4*)(LmV + 51 * LS + 20); const f32x4 L51_6 = *(const LAS f32x4*)(LmV + 51 * LS + 24); const f32x4 L51_7 = *(const LAS f32x4*)(LmV + 51 * LS + 28); const f32x4 L51_8 = *(const LAS f32x4*)(LmV + 51 * LS + 32); const f32x4 L51_9 = *(const LAS f32x4*)(LmV + 51 * LS + 36); const f32x4 L51_10 = *(const LAS f32x4*)(LmV + 51 * LS + 40); const f32x4 L51_11 = *(const LAS f32x4*)(LmV + 51 * LS + 44); const f32x4 L51_12 = *(const LAS f32x4*)(LmV + 51 * LS + 48);
        float x51; { float a0 = rr51, a1 = 0.f, a2 = 0.f, a3 = 0.f; a0 -= L51_0[0] * x0; a1 -= L51_0[1] * x1; a2 -= L51_0[2] * x2; a3 -= L51_0[3] * x3; a0 -= L51_1[0] * x4; a1 -= L51_1[1] * x5; a2 -= L51_1[2] * x6; a3 -= L51_1[3] * x7; a0 -= L51_2[0] * x8; a1 -= L51_2[1] * x9; a2 -= L51_2[2] * x10; a3 -= L51_2[3] * x11; a0 -= L51_3[0] * x12; a1 -= L51_3[1] * x13; a2 -= L51_3[2] * x14; a3 -= L51_3[3] * x15; a0 -= L51_4[0] * x16; a1 -= L51_4[1] * x17; a2 -= L51_4[2] * x18; a3 -= L51_4[3] * x19; a0 -= L51_5[0] * x20; a1 -= L51_5[1] * x21; a2 -= L51_5[2] * x22; a3 -= L51_5[3] * x23; a0 -= L51_6[0] * x24; a1 -= L51_6[1] * x25; a2 -= L51_6[2] * x26; a3 -= L51_6[3] * x27; a0 -= L51_7[0] * x28; a1 -= L51_7[1] * x29; a2 -= L51_7[2] * x30; a3 -= L51_7[3] * x31; a0 -= L51_8[0] * x32; a1 -= L51_8[1] * x33; a2 -= L51_8[2] * x34; a3 -= L51_8[3] * x35; a0 -= L51_9[0] * x36; a1 -= L51_9[1] * x37; a2 -= L51_9[2] * x38; a3 -= L51_9[3] * x39; a0 -= L51_10[0] * x40; a1 -= L51_10[1] * x41; a2 -= L51_10[2] * x42; a3 -= L51_10[3] * x43; a0 -= L51_11[0] * x44; a1 -= L51_11[1] * x45; a2 -= L51_11[2] * x46; a3 -= L51_11[3] * x47; a0 -= L51_12[0] * x48; a1 -= L51_12[1] * x49; a2 -= L51_12[2] * x50; x51 = (a0 + a1) + (a2 + a3); }
        asm volatile("" ::: "memory");
        const float rr53 = X[53 * XS] * scp[53]; const f32x4 L53_0 = *(const LAS f32x4*)(LmV + 53 * LS + 0); const f32x4 L53_1 = *(const LAS f32x4*)(LmV + 53 * LS + 4); const f32x4 L52_2 = *(const LAS f32x4*)(LmV + 52 * LS + 8); const f32x4 L52_3 = *(const LAS f32x4*)(LmV + 52 * LS + 12); const f32x4 L52_4 = *(const LAS f32x4*)(LmV + 52 * LS + 16); const f32x4 L52_5 = *(const LAS f32x4*)(LmV + 52 * LS + 20); const f32x4 L52_6 = *(const LAS f32x4*)(LmV + 52 * LS + 24); const f32x4 L52_7 = *(const LAS f32x4*)(LmV + 52 * LS + 28); const f32x4 L52_8 = *(const LAS f32x4*)(LmV + 52 * LS + 32); const f32x4 L52_9 = *(const LAS f32x4*)(LmV + 52 * LS + 36); const f32x4 L52_10 = *(const LAS f32x4*)(LmV + 52 * LS + 40); const f32x4 L52_11 = *(const LAS f32x4*)(LmV + 52 * LS + 44); const f32x4 L52_12 = *(const LAS f32x4*)(LmV + 52 * LS + 48);
        float x52; { float a0 = rr52, a1 = 0.f, a2 = 0.f, a3 = 0.f; a0 -= L52_0[0] * x0; a1 -= L52_0[1] * x1; a2 -= L52_0[2] * x2; a3 -= L52_0[3] * x3; a0 -= L52_1[0] * x4; a1 -= L52_1[1] * x5; a2 -= L52_1[2] * x6; a3 -= L52_1[3] * x7; a0 -= L52_2[0] * x8; a1 -= L52_2[1] * x9; a2 -= L52_2[2] * x10; a3 -= L52_2[3] * x11; a0 -= L52_3[0] * x12; a1 -= L52_3[1] * x13; a2 -= L52_3[2] * x14; a3 -= L52_3[3] * x15; a0 -= L52_4[0] * x16; a1 -= L52_4[1] * x17; a2 -= L52_4[2] * x18; a3 -= L52_4[3] * x19; a0 -= L52_5[0] * x20; a1 -= L52_5[1] * x21; a2 -= L52_5[2] * x22; a3 -= L52_5[3] * x23; a0 -= L52_6[0] * x24; a1 -= L52_6[1] * x25; a2 -= L52_6[2] * x26; a3 -= L52_6[3] * x27; a0 -= L52_7[0] * x28; a1 -= L52_7[1] * x29; a2 -= L52_7[2] * x30; a3 -= L52_7[3] * x31; a0 -= L52_8[0] * x32; a1 -= L52_8[1] * x33; a2 -= L52_8[2] * x34; a3 -= L52_8[3] * x35; a0 -= L52_9[0] * x36; a1 -= L52_9[1] * x37; a2 -= L52_9[2] * x38; a3 -= L52_9[3] * x39; a0 -= L52_10[0] * x40; a1 -= L52_10[1] * x41; a2 -= L52_10[2] * x42; a3 -= L52_10[3] * x43; a0 -= L52_11[0] * x44; a1 -= L52_11[1] * x45; a2 -= L52_11[2] * x46; a3 -= L52_11[3] * x47; a0 -= L52_12[0] * x48; a1 -= L52_12[1] * x49; a2 -= L52_12[2] * x50; a3 -= L52_12[3] * x51; x52 = (a0 + a1) + (a2 + a3); }
        asm volatile("" ::: "memory");
        const float rr54 = X[54 * XS] * scp[54]; const f32x4 L54_0 = *(const LAS f32x4*)(LmV + 54 * LS + 0); const f32x4 L54_1 = *(const LAS f32x4*)(LmV + 54 * LS + 4); const f32x4 L53_2 = *(const LAS f32x4*)(LmV + 53 * LS + 8); const f32x4 L53_3 = *(const LAS f32x4*)(LmV + 53 * LS + 12); const f32x4 L53_4 = *(const LAS f32x4*)(LmV + 53 * LS + 16); const f32x4 L53_5 = *(const LAS f32x4*)(LmV + 53 * LS + 20); const f32x4 L53_6 = *(const LAS f32x4*)(LmV + 53 * LS + 24); const f32x4 L53_7 = *(const LAS f32x4*)(LmV + 53 * LS + 28); const f32x4 L53_8 = *(const LAS f32x4*)(LmV + 53 * LS + 32); const f32x4 L53_9 = *(const LAS f32x4*)(LmV + 53 * LS + 36); const f32x4 L53_10 = *(const LAS f32x4*)(LmV + 53 * LS + 40); const f32x4 L53_11 = *(const LAS f32x4*)(LmV + 53 * LS + 44); const f32x4 L53_12 = *(const LAS f32x4*)(LmV + 53 * LS + 48); const f32x4 L53_13 = *(const LAS f32x4*)(LmV + 53 * LS + 52);
        float x53; { float a0 = rr53, a1 = 0.f, a2 = 0.f, a3 = 0.f; a0 -= L53_0[0] * x0; a1 -= L53_0[1] * x1; a2 -= L53_0[2] * x2; a3 -= L53_0[3] * x3; a0 -= L53_1[0] * x4; a1 -= L53_1[1] * x5; a2 -= L53_1[2] * x6; a3 -= L53_1[3] * x7; a0 -= L53_2[0] * x8; a1 -= L53_2[1] * x9; a2 -= L53_2[2] * x10; a3 -= L53_2[3] * x11; a0 -= L53_3[0] * x12; a1 -= L53_3[1] * x13; a2 -= L53_3[2] * x14; a3 -= L53_3[3] * x15; a0 -= L53_4[0] * x16; a1 -= L53_4[1] * x17; a2 -= L53_4[2] * x18; a3 -= L53_4[3] * x19; a0 -= L53_5[0] * x20; a1 -= L53_5[1] * x21; a2 -= L53_5[2] * x22; a3 -= L53_5[3] * x23; a0 -= L53_6[0] * x24; a1 -= L53_6[1] * x25; a2 -= L53_6[2] * x26; a3 -= L53_6[3] * x27; a0 -= L53_7[0] * x28; a1 -= L53_7[1] * x29; a2 -= L53_7[2] * x30; a3 -= L53_7[3] * x31; a0 -= L53_8[0] * x32; a1 -= L53_8[1] * x33; a2 -= L53_8[2] * x34; a3 -= L53_8[3] * x35; a0 -= L53_9[0] * x36; a1 -= L53_9[1] * x37; a2 -= L53_9[2] * x38; a3 -= L53_9[3] * x39; a0 -= L53_10[0] * x40; a1 -= L53_10[1] * x41; a2 -= L53_10[2] * x42; a3 -= L53_10[3] * x43; a0 -= L53_11[0] * x44; a1 -= L53_11[1] * x45; a2 -= L53_11[2] * x46; a3 -= L53_11[3] * x47; a0 -= L53_12[0] * x48; a1 -= L53_12[1] * x49; a2 -= L53_12[2] * x50; a3 -= L53_12[3] * x51; a0 -= L53_13[0] * x52; x53 = (a0 + a1) + (a2 + a3); }
        asm volatile("" ::: "memory");
        const float rr55 = X[55 * XS] * scp[55]; const f32x4 L55_0 = *(const LAS f32x4*)(LmV + 55 * LS + 0); const f32x4 L55_1 = *(const LAS f32x4*)(LmV + 55 * LS + 4); const f32x4 L54_2 = *(const LAS f32x4*)(LmV + 54 * LS + 8); const f32x4 L54_3 = *(const LAS f32x4*)(LmV + 54 * LS + 12); const f32x4 L54_4 = *(const LAS f32x4*)(LmV + 54 * LS + 16); const f32x4 L54_5 = *(const LAS f32x4*)(LmV + 54 * LS + 20); const f32x4 L54_6 = *(const LAS f32x4*)(LmV + 54 * LS + 24); const f32x4 L54_7 = *(const LAS f32x4*)(LmV + 54 * LS + 28); const f32x4 L54_8 = *(const LAS f32x4*)(LmV + 54 * LS + 32); const f32x4 L54_9 = *(const LAS f32x4*)(LmV + 54 * LS + 36); const f32x4 L54_10 = *(const LAS f32x4*)(LmV + 54 * LS + 40); const f32x4 L54_11 = *(const LAS f32x4*)(LmV + 54 * LS + 44); const f32x4 L54_12 = *(const LAS f32x4*)(LmV + 54 * LS + 48); const f32x4 L54_13 = *(const LAS f32x4*)(LmV + 54 * LS + 52);
        float x54; { float a0 = rr54, a1 = 0.f, a2 = 0.f, a3 = 0.f; a0 -= L54_0[0] * x0; a1 -= L54_0[1] * x1; a2 -= L54_0[2] * x2; a3 -= L54_0[3] * x3; a0 -= L54_1[0] * x4; a1 -= L54_1[1] * x5; a2 -= L54_1[2] * x6; a3 -= L54_1[3] * x7; a0 -= L54_2[0] * x8; a1 -= L54_2[1] * x9; a2 -= L54_2[2] * x10; a3 -= L54_2[3] * x11; a0 -= L54_3[0] * x12; a1 -= L54_3[1] * x13; a2 -= L54_3[2] * x14; a3 -= L54_3[3] * x15; a0 -= L54_4[0] * x16; a1 -= L54_4[1] * x17; a2 -= L54_4[2] * x18; a3 -= L54_4[3] * x19; a0 -= L54_5[0] * x20; a1 -= L54_5[1] * x21; a2 -= L54_5[2] * x22; a3 -= L54_5[3] * x23; a0 -= L54_6[0] * x24; a1 -= L54_6[1] * x25; a2 -= L54_6[2] * x26; a3 -= L54_6[3] * x27; a0 -= L54_7[0] * x28; a1 -= L54_7[1] * x29; a2 -= L54_7[2] * x30; a3 -= L54_7[3] * x31; a0 -= L54_8[0] * x32; a1 -= L54_8[1] * x33; a2 -= L54_8[2] * x34; a3 -= L54_8[3] * x35; a0 -= L54_9[0] * x36; a1 -= L54_9[1] * x37; a2 -= L54_9[2] * x38; a3 -= L54_9[3] * x39; a0 -= L54_10[0] * x40; a1 -= L54_10[1] * x41; a2 -= L54_10[2] * x42; a3 -= L54_10[3] * x43; a0 -= L54_11[0] * x44; a1 -= L54_11[1] * x45; a2 -= L54_11[2] * x46; a3 -= L54_11[3] * x47; a0 -= L54_12[0] * x48; a1 -= L54_12[1] * x49; a2 -= L54_12[2] * x50; a3 -= L54_12[3] * x51; a0 -= L54_13[0] * x52; a1 -= L54_13[1] * x53; x54 = (a0 + a1) + (a2 + a3); }
        asm volatile("" ::: "memory");
        const float rr56 = X[56 * XS] * scp[56]; const f32x4 L56_0 = *(const LAS f32x4*)(LmV + 56 * LS + 0); const f32x4 L56_1 = *(const LAS f32x4*)(LmV + 56 * LS + 4); const f32x4 L55_2 = *(const LAS f32x4*)(LmV + 55 * LS + 8); const f32x4 L55_3 = *(const LAS f32x4*)(LmV + 55 * LS + 12); const f32x4 L55_4 = *(const LAS f32x4*)(LmV + 55 * LS + 16); const f32x4 L55_5 = *(const LAS f32x4*)(LmV + 55 * LS + 20); const f32x4 L55_6 = *(const LAS f32x4*)(LmV + 55 * LS + 24); const f32x4 L55_7 = *(const LAS f32x4*)(LmV + 55 * LS + 28); const f32x4 L55_8 = *(const LAS f32x4*)(LmV + 55 * LS + 32); const f32x4 L55_9 = *(const LAS f32x4*)(LmV + 55 * LS + 36); const f32x4 L55_10 = *(const LAS f32x4*)(LmV + 55 * LS + 40); const f32x4 L55_11 = *(const LAS f32x4*)(LmV + 55 * LS + 44); const f32x4 L55_12 = *(const LAS f32x4*)(LmV + 55 * LS + 48); const f32x4 L55_13 = *(const LAS f32x4*)(LmV + 55 * LS + 52);
        float x55; { float a0 = rr55, a1 = 0.f, a2 = 0.f, a3 = 0.f; a0 -= L55_0[0] * x0; a1 -= L55_0[1] * x1; a2 -= L55_0[2] * x2; a3 -= L55_0[3] * x3; a0 -= L55_1[0] * x4; a1 -= L55_1[1] * x5; a2 -= L55_1[2] * x6; a3 -= L55_1[3] * x7; a0 -= L55_2[0] * x8; a1 -= L55_2[1] * x9; a2 -= L55_2[2] * x10; a3 -= L55_2[3] * x11; a0 -= L55_3[0] * x12; a1 -= L55_3[1] * x13; a2 -= L55_3[2] * x14; a3 -= L55_3[3] * x15; a0 -= L55_4[0] * x16; a1 -= L55_4[1] * x17; a2 -= L55_4[2] * x18; a3 -= L55_4[3] * x19; a0 -= L55_5[0] * x20; a1 -= L55_5[1] * x21; a2 -= L55_5[2] * x22; a3 -= L55_5[3] * x23; a0 -= L55_6[0] * x24; a1 -= L55_6[1] * x25; a2 -= L55_6[2] * x26; a3 -= L55_6[3] * x27; a0 -= L55_7[0] * x28; a1 -= L55_7[1] * x29; a2 -= L55_7[2] * x30; a3 -= L55_7[3] * x31; a0 -= L55_8[0] * x32; a1 -= L55_8[1] * x33; a2 -= L55_8[2] * x34; a3 -= L55_8[3] * x35; a0 -= L55_9[0] * x36; a1 -= L55_9[1] * x37; a2 -= L55_9[2] * x38; a3 -= L55_9[3] * x39; a0 -= L55_10[0] * x40; a1 -= L55_10[1] * x41; a2 -= L55_10[2] * x42; a3 -= L55_10[3] * x43; a0 -= L55_11[0] * x44; a1 -= L55_11[1] * x45; a2 -= L55_11[2] * x46; a3 -= L55_11[3] * x47; a0 -= L55_12[0] * x48; a1 -= L55_12[1] * x49; a2 -= L55_12[2] * x50; a3 -= L55_12[3] * x51; a0 -= L55_13[0] * x52; a1 -= L55_13[1] * x53; a2 -= L55_13[2] * x54; x55 = (a0 + a1) + (a2 + a3); }
        asm volatile("" ::: "memory");
        const float rr57 = X[57 * XS] * scp[57]; const f32x4 L57_0 = *(const LAS f32x4*)(LmV + 57 * LS + 0); const f32x4 L57_1 = *(const LAS f32x4*)(LmV + 57 * LS + 4); const f32x4 L56_2 = *(const LAS f32x4*)(LmV + 56 * LS + 8); const f32x4 L56_3 = *(const LAS f32x4*)(LmV + 56 * LS + 12); const f32x4 L56_4 = *(const LAS f32x4*)(LmV + 56 * LS + 16); const f32x4 L56_5 = *(const LAS f32x4*)(LmV + 56 * LS + 20); const f32x4 L56_6 = *(const LAS f32x4*)(LmV + 56 * LS + 24); const f32x4 L56_7 = *(const LAS f32x4*)(LmV + 56 * LS + 28); const f32x4 L56_8 = *(const LAS f32x4*)(LmV + 56 * LS + 32); const f32x4 L56_9 = *(const LAS f32x4*)(LmV + 56 * LS + 36); const f32x4 L56_10 = *(const LAS f32x4*)(LmV + 56 * LS + 40); const f32x4 L56_11 = *(const LAS f32x4*)(LmV + 56 * LS + 44); const f32x4 L56_12 = *(const LAS f32x4*)(LmV + 56 * LS + 48); const f32x4 L56_13 = *(const LAS f32x4*)(LmV + 56 * LS + 52);
        float x56; { float a0 = rr56, a1 = 0.f, a2 = 0.f, a3 = 0.f; a0 -= L56_0[0] * x0; a1 -= L56_0[1] * x1; a2 -= L56_0[2] * x2; a3 -= L56_0[3] * x3; a0 -= L56_1[0] * x4; a1 -= L56_1[1] * x5; a2 -= L56_1[2] * x6; a3 -= L56_1[3] * x7; a0 -= L56_2[0] * x8; a1 -= L56_2[1] * x9; a2 -= L56_2[2] * x10; a3 -= L56_2[3] * x11; a0 -= L56_3[0] * x12; a1 -= L56_3[1] * x13; a2 -= L56_3[2] * x14; a3 -= L56_3[3] * x15; a0 -= L56_4[0] * x16; a1 -= L56_4[1] * x17; a2 -= L56_4[2] * x18; a3 -= L56_4[3] * x19; a0 -= L56_5[0] * x20; a1 -= L56_5[1] * x21; a2 -= L56_5[2] * x22; a3 -= L56_5[3] * x23; a0 -= L56_6[0] * x24; a1 -= L56_6[1] * x25; a2 -= L56_6[2] * x26; a3 -= L56_6[3] * x27; a0 -= L56_7[0] * x28; a1 -= L56_7[1] * x29; a2 -= L56_7[2] * x30; a3 -= L56_7[3] * x31; a0 -= L56_8[0] * x32; a1 -= L56_8[1] * x33; a2 -= L56_8[2] * x34; a3 -= L56_8[3] * x35; a0 -= L56_9[0] * x36; a1 -= L56_9[1] * x37; a2 -= L56_9[2] * x38; a3 -= L56_9[3] * x39; a0 -= L56_10[0] * x40; a1 -= L56_10[1] * x41; a2 -= L56_10[2] * x42; a3 -= L56_10[3] * x43; a0 -= L56_11[0] * x44; a1 -= L56_11[1] * x45; a2 -= L56_11[2] * x46; a3 -= L56_11[3] * x47; a0 -= L56_12[0] * x48; a1 -= L56_12[1] * x49; a2 -= L56_12[2] * x50; a3 -= L56_12[3] * x51; a0 -= L56_13[0] * x52; a1 -= L56_13[1] * x53; a2 -= L56_13[2] * x54; a3 -= L56_13[3] * x55; x56 = (a0 + a1) + (a2 + a3); }
        asm volatile("" ::: "memory");
        const float rr58 = X[58 * XS] * scp[58]; const f32x4 L58_0 = *(const LAS f32x4*)(LmV + 58 * LS + 0); const f32x4 L58_1 = *(const LAS f32x4*)(LmV + 58 * LS + 4); const f32x4 L57_2 = *(const LAS f32x4*)(LmV + 57 * LS + 8); const f32x4 L57_3 = *(const LAS f32x4*)(LmV + 57 * LS + 12); const f32x4 L57_4 = *(const LAS f32x4*)(LmV + 57 * LS + 16); const f32x4 L57_5 = *(const LAS f32x4*)(LmV + 57 * LS + 20); const f32x4 L57_6 = *(const LAS f32x4*)(LmV + 57 * LS + 24); const f32x4 L57_7 = *(const LAS f32x4*)(LmV + 57 * LS + 28); const f32x4 L57_8 = *(const LAS f32x4*)(LmV + 57 * LS + 32); const f32x4 L57_9 = *(const LAS f32x4*)(LmV + 57 * LS + 36); const f32x4 L57_10 = *(const LAS f32x4*)(LmV + 57 * LS + 40); const f32x4 L57_11 = *(const LAS f32x4*)(LmV + 57 * LS + 44); const f32x4 L57_12 = *(const LAS f32x4*)(LmV + 57 * LS + 48); const f32x4 L57_13 = *(const LAS f32x4*)(LmV + 57 * LS + 52); const f32x4 L57_14 = *(const LAS f32x4*)(LmV + 57 * LS + 56);
        float x57; { float a0 = rr57, a1 = 0.f, a2 = 0.f, a3 = 0.f; a0 -= L57_0[0] * x0; a1 -= L57_0[1] * x1; a2 -= L57_0[2] * x2; a3 -= L57_0[3] * x3; a0 -= L57_1[0] * x4; a1 -= L57_1[1] * x5; a2 -= L57_1[2] * x6; a3 -= L57_1[3] * x7; a0 -= L57_2[0] * x8; a1 -= L57_2[1] * x9; a2 -= L57_2[2] * x10; a3 -= L57_2[3] * x11; a0 -= L57_3[0] * x12; a1 -= L57_3[1] * x13; a2 -= L57_3[2] * x14; a3 -= L57_3[3] * x15; a0 -= L57_4[0] * x16; a1 -= L57_4[1] * x17; a2 -= L57_4[2] * x18; a3 -= L57_4[3] * x19; a0 -= L57_5[0] * x20; a1 -= L57_5[1] * x21; a2 -= L57_5[2] * x22; a3 -= L57_5[3] * x23; a0 -= L57_6[0] * x24; a1 -= L57_6[1] * x25; a2 -= L57_6[2] * x26; a3 -= L57_6[3] * x27; a0 -= L57_7[0] * x28; a1 -= L57_7[1] * x29; a2 -= L57_7[2] * x30; a3 -= L57_7[3] * x31; a0 -= L57_8[0] * x32; a1 -= L57_8[1] * x33; a2 -= L57_8[2] * x34; a3 -= L57_8[3] * x35; a0 -= L57_9[0] * x36; a1 -= L57_9[1] * x37; a2 -= L57_9[2] * x38; a3 -= L57_9[3] * x39; a0 -= L57_10[0] * x40; a1 -= L57_10[1] * x41; a2 -= L57_10[2] * x42; a3 -= L57_10[3] * x43; a0 -= L57_11[0] * x44; a1 -= L57_11[1] * x45; a2 -= L57_11[2] * x46; a3 -= L57_11[3] * x47; a0 -= L57_12[0] * x48; a1 -= L57_12[1] * x49; a2 -= L57_12[2] * x50; a3 -= L57_12[3] * x51; a0 -= L57_13[0] * x52; a1 -= L57_13[1] * x53; a2 -= L57_13[2] * x54; a3 -= L57_13[3] * x55; a0 -= L57_14[0] * x56; x57 = (a0 + a1) + (a2 + a3); }
        asm volatile("" ::: "memory");
        const float rr59 = X[59 * XS] * scp[59]; const f32x4 L59_0 = *(const LAS f32x4*)(LmV + 59 * LS + 0); const f32x4 L59_1 = *(const LAS f32x4*)(LmV + 59 * LS + 4); const f32x4 L58_2 = *(const LAS f32x4*)(LmV + 58 * LS + 8); const f32x4 L58_3 = *(const LAS f32x4*)(LmV + 58 * LS + 12); const f32x4 L58_4 = *(const LAS f32x4*)(LmV + 58 * LS + 16); const f32x4 L58_5 = *(const LAS f32x4*)(LmV + 58 * LS + 20); const f32x4 L58_6 = *(const LAS f32x4*)(LmV + 58 * LS + 24); const f32x4 L58_7 = *(const LAS f32x4*)(LmV + 58 * LS + 28); const f32x4 L58_8 = *(const LAS f32x4*)(LmV + 58 * LS + 32); const f32x4 L58_9 = *(const LAS f32x4*)(LmV + 58 * LS + 36); const f32x4 L58_10 = *(const LAS f32x4*)(LmV + 58 * LS + 40); const f32x4 L58_11 = *(const LAS f32x4*)(LmV + 58 * LS + 44); const f32x4 L58_12 = *(const LAS f32x4*)(LmV + 58 * LS + 48); const f32x4 L58_13 = *(const LAS f32x4*)(LmV + 58 * LS + 52); const f32x4 L58_14 = *(const LAS f32x4*)(LmV + 58 * LS + 56);
        float x58; { float a0 = rr58, a1 = 0.f, a2 = 0.f, a3 = 0.f; a0 -= L58_0[0] * x0; a1 -= L58_0[1] * x1; a2 -= L58_0[2] * x2; a3 -= L58_0[3] * x3; a0 -= L58_1[0] * x4; a1 -= L58_1[1] * x5; a2 -= L58_1[2] * x6; a3 -= L58_1[3] * x7; a0 -= L58_2[0] * x8; a1 -= L58_2[1] * x9; a2 -= L58_2[2] * x10; a3 -= L58_2[3] * x11; a0 -= L58_3[0] * x12; a1 -= L58_3[1] * x13; a2 -= L58_3[2] * x14; a3 -= L58_3[3] * x15; a0 -= L58_4[0] * x16; a1 -= L58_4[1] * x17; a2 -= L58_4[2] * x18; a3 -= L58_4[3] * x19; a0 -= L58_5[0] * x20; a1 -= L58_5[1] * x21; a2 -= L58_5[2] * x22; a3 -= L58_5[3] * x23; a0 -= L58_6[0] * x24; a1 -= L58_6[1] * x25; a2 -= L58_6[2] * x26; a3 -= L58_6[3] * x27; a0 -= L58_7[0] * x28; a1 -= L58_7[1] * x29; a2 -= L58_7[2] * x30; a3 -= L58_7[3] * x31; a0 -= L58_8[0] * x32; a1 -= L58_8[1] * x33; a2 -= L58_8[2] * x34; a3 -= L58_8[3] * x35; a0 -= L58_9[0] * x36; a1 -= L58_9[1] * x37; a2 -= L58_9[2] * x38; a3 -= L58_9[3] * x39; a0 -= L58_10[0] * x40; a1 -= L58_10[1] * x41; a2 -= L58_10[2] * x42; a3 -= L58_10[3] * x43; a0 -= L58_11[0] * x44; a1 -= L58_11[1] * x45; a2 -= L58_11[2] * x46; a3 -= L58_11[3] * x47; a0 -= L58_12[0] * x48; a1 -= L58_12[1] * x49; a2 -= L58_12[2] * x50; a3 -= L58_12[3] * x51; a0 -= L58_13[0] * x52; a1 -= L58_13[1] * x53; a2 -= L58_13[2] * x54; a3 -= L58_13[3] * x55; a0 -= L58_14[0] * x56; a1 -= L58_14[1] * x57; x58 = (a0 + a1) + (a2 + a3); }
        asm volatile("" ::: "memory");
        const float rr60 = X[60 * XS] * scp[60]; const f32x4 L60_0 = *(const LAS f32x4*)(LmV + 60 * LS + 0); const f32x4 L60_1 = *(const LAS f32x4*)(LmV + 60 * LS + 4); const f32x4 L59_2 = *(const LAS f32x4*)(LmV + 59 * LS + 8); const f32x4 L59_3 = *(const LAS f32x4*)(LmV + 59 * LS + 12); const f32x4 L59_4 = *(const LAS f32x4*)(LmV + 59 * LS + 16); const f32x4 L59_5 = *(const LAS f32x4*)(LmV + 59 * LS + 20); const f32x4 L59_6 = *(const LAS f32x4*)(LmV + 59 * LS + 24); const f32x4 L59_7 = *(const LAS f32x4*)(LmV + 59 * LS + 28); const f32x4 L59_8 = *(const LAS f32x4*)(LmV + 59 * LS + 32); const f32x4 L59_9 = *(const LAS f32x4*)(LmV + 59 * LS + 36); const f32x4 L59_10 = *(const LAS f32x4*)(LmV + 59 * LS + 40); const f32x4 L59_11 = *(const LAS f32x4*)(LmV + 59 * LS + 44); const f32x4 L59_12 = *(const LAS f32x4*)(LmV + 59 * LS + 48); const f32x4 L59_13 = *(const LAS f32x4*)(LmV + 59 * LS + 52); const f32x4 L59_14 = *(const LAS f32x4*)(LmV + 59 * LS + 56);
        float x59; { float a0 = rr59, a1 = 0.f, a2 = 0.f, a3 = 0.f; a0 -= L59_0[0] * x0; a1 -= L59_0[1] * x1; a2 -= L59_0[2] * x2; a3 -= L59_0[3] * x3; a0 -= L59_1[0] * x4; a1 -= L59_1[1] * x5; a2 -= L59_1[2] * x6; a3 -= L59_1[3] * x7; a0 -= L59_2[0] * x8; a1 -= L59_2[1] * x9; a2 -= L59_2[2] * x10; a3 -= L59_2[3] * x11; a0 -= L59_3[0] * x12; a1 -= L59_3[1] * x13; a2 -= L59_3[2] * x14; a3 -= L59_3[3] * x15; a0 -= L59_4[0] * x16; a1 -= L59_4[1] * x17; a2 -= L59_4[2] * x18; a3 -= L59_4[3] * x19; a0 -= L59_5[0] * x20; a1 -= L59_5[1] * x21; a2 -= L59_5[2] * x22; a3 -= L59_5[3] * x23; a0 -= L59_6[0] * x24; a1 -= L59_6[1] * x25; a2 -= L59_6[2] * x26; a3 -= L59_6[3] * x27; a0 -= L59_7[0] * x28; a1 -= L59_7[1] * x29; a2 -= L59_7[2] * x30; a3 -= L59_7[3] * x31; a0 -= L59_8[0] * x32; a1 -= L59_8[1] * x33; a2 -= L59_8[2] * x34; a3 -= L59_8[3] * x35; a0 -= L59_9[0] * x36; a1 -= L59_9[1] * x37; a2 -= L59_9[2] * x38; a3 -= L59_9[3] * x39; a0 -= L59_10[0] * x40; a1 -= L59_10[1] * x41; a2 -= L59_10[2] * x42; a3 -= L59_10[3] * x43; a0 -= L59_11[0] * x44; a1 -= L59_11[1] * x45; a2 -= L59_11[2] * x46; a3 -= L59_11[3] * x47; a0 -= L59_12[0] * x48; a1 -= L59_12[1] * x49; a2 -= L59_12[2] * x50; a3 -= L59_12[3] * x51; a0 -= L59_13[0] * x52; a1 -= L59_13[1] * x53; a2 -= L59_13[2] * x54; a3 -= L59_13[3] * x55; a0 -= L59_14[0] * x56; a1 -= L59_14[1] * x57; a2 -= L59_14[2] * x58; x59 = (a0 + a1) + (a2 + a3); }
        asm volatile("" ::: "memory");
        const float rr61 = X[61 * XS] * scp[61]; const f32x4 L61_0 = *(const LAS f32x4*)(LmV + 61 * LS + 0); const f32x4 L61_1 = *(const LAS f32x4*)(LmV + 61 * LS + 4); const f32x4 L60_2 = *(const LAS f32x4*)(LmV + 60 * LS + 8); const f32x4 L60_3 = *(const LAS f32x4*)(LmV + 60 * LS + 12); const f32x4 L60_4 = *(const LAS f32x4*)(LmV + 60 * LS + 16); const f32x4 L60_5 = *(const LAS f32x4*)(LmV + 60 * LS + 20); const f32x4 L60_6 = *(const LAS f32x4*)(LmV + 60 * LS + 24); const f32x4 L60_7 = *(const LAS f32x4*)(LmV + 60 * LS + 28); const f32x4 L60_8 = *(const LAS f32x4*)(LmV + 60 * LS + 32); const f32x4 L60_9 = *(const LAS f32x4*)(LmV + 60 * LS + 36); const f32x4 L60_10 = *(const LAS f32x4*)(LmV + 60 * LS + 40); const f32x4 L60_11 = *(const LAS f32x4*)(LmV + 60 * LS + 44); const f32x4 L60_12 = *(const LAS f32x4*)(LmV + 60 * LS + 48); const f32x4 L60_13 = *(const LAS f32x4*)(LmV + 60 * LS + 52); const f32x4 L60_14 = *(const LAS f32x4*)(LmV + 60 * LS + 56);
        float x60; { float a0 = rr60, a1 = 0.f, a2 = 0.f, a3 = 0.f; a0 -= L60_0[0] * x0; a1 -= L60_0[1] * x1; a2 -= L60_0[2] * x2; a3 -= L60_0[3] * x3; a0 -= L60_1[0] * x4; a1 -= L60_1[1] * x5; a2 -= L60_1[2] * x6; a3 -= L60_1[3] * x7; a0 -= L60_2[0] * x8; a1 -= L60_2[1] * x9; a2 -= L60_2[2] * x10; a3 -= L60_2[3] * x11; a0 -= L60_3[0] * x12; a1 -= L60_3[1] * x13; a2 -= L60_3[2] * x14; a3 -= L60_3[3] * x15; a0 -= L60_4[0] * x16; a1 -= L60_4[1] * x17; a2 -= L60_4[2] * x18; a3 -= L60_4[3] * x19; a0 -= L60_5[0] * x20; a1 -= L60_5[1] * x21; a2 -= L60_5[2] * x22; a3 -= L60_5[3] * x23; a0 -= L60_6[0] * x24; a1 -= L60_6[1] * x25; a2 -= L60_6[2] * x26; a3 -= L60_6[3] * x27; a0 -= L60_7[0] * x28; a1 -= L60_7[1] * x29; a2 -= L60_7[2] * x30; a3 -= L60_7[3] * x31; a0 -= L60_8[0] * x32; a1 -= L60_8[1] * x33; a2 -= L60_8[2] * x34; a3 -= L60_8[3] * x35; a0 -= L60_9[0] * x36; a1 -= L60_9[1] * x37; a2 -= L60_9[2] * x38; a3 -= L60_9[3] * x39; a0 -= L60_10[0] * x40; a1 -= L60_10[1] * x41; a2 -= L60_10[2] * x42; a3 -= L60_10[3] * x43; a0 -= L60_11[0] * x44; a1 -= L60_11[1] * x45; a2 -= L60_11[2] * x46; a3 -= L60_11[3] * x47; a0 -= L60_12[0] * x48; a1 -= L60_12[1] * x49; a2 -= L60_12[2] * x50; a3 -= L60_12[3] * x51; a0 -= L60_13[0] * x52; a1 -= L60_13[1] * x53; a2 -= L60_13[2] * x54; a3 -= L60_13[3] * x55; a0 -= L60_14[0] * x56; a1 -= L60_14[1] * x57; a2 -= L60_14[2] * x58; a3 -= L60_14[3] * x59; x60 = (a0 + a1) + (a2 + a3); }
        asm volatile("" ::: "memory");
        const float rr62 = X[62 * XS] * scp[62]; const f32x4 L62_0 = *(const LAS f32x4*)(LmV + 62 * LS + 0); const f32x4 L62_1 = *(const LAS f32x4*)(LmV + 62 * LS + 4); const f32x4 L61_2 = *(const LAS f32x4*)(LmV + 61 * LS + 8); const f32x4 L61_3 = *(const LAS f32x4*)(LmV + 61 * LS + 12); const f32x4 L61_4 = *(const LAS f32x4*)(LmV + 61 * LS + 16); const f32x4 L61_5 = *(const LAS f32x4*)(LmV + 61 * LS + 20); const f32x4 L61_6 = *(const LAS f32x4*)(LmV + 61 * LS + 24); const f32x4 L61_7 = *(const LAS f32x4*)(LmV + 61 * LS + 28); const f32x4 L61_8 = *(const LAS f32x4*)(LmV + 61 * LS + 32); const f32x4 L61_9 = *(const LAS f32x4*)(LmV + 61 * LS + 36); const f32x4 L61_10 = *(const LAS f32x4*)(LmV + 61 * LS + 40); const f32x4 L61_11 = *(const LAS f32x4*)(LmV + 61 * LS + 44); const f32x4 L61_12 = *(const LAS f32x4*)(LmV + 61 * LS + 48); const f32x4 L61_13 = *(const LAS f32x4*)(LmV + 61 * LS + 52); const f32x4 L61_14 = *(const LAS f32x4*)(LmV + 61 * LS + 56); const f32x4 L61_15 = *(const LAS f32x4*)(LmV + 61 * LS + 60);
        float x61; { float a0 = rr61, a1 = 0.f, a2 = 0.f, a3 = 0.f; a0 -= L61_0[0] * x0; a1 -= L61_0[1] * x1; a2 -= L61_0[2] * x2; a3 -= L61_0[3] * x3; a0 -= L61_1[0] * x4; a1 -= L61_1[1] * x5; a2 -= L61_1[2] * x6; a3 -= L61_1[3] * x7; a0 -= L61_2[0] * x8; a1 -= L61_2[1] * x9; a2 -= L61_2[2] * x10; a3 -= L61_2[3] * x11; a0 -= L61_3[0] * x12; a1 -= L61_3[1] * x13; a2 -= L61_3[2] * x14; a3 -= L61_3[3] * x15; a0 -= L61_4[0] * x16; a1 -= L61_4[1] * x17; a2 -= L61_4[2] * x18; a3 -= L61_4[3] * x19; a0 -= L61_5[0] * x20; a1 -= L61_5[1] * x21; a2 -= L61_5[2] * x22; a3 -= L61_5[3] * x23; a0 -= L61_6[0] * x24; a1 -= L61_6[1] * x25; a2 -= L61_6[2] * x26; a3 -= L61_6[3] * x27; a0 -= L61_7[0] * x28; a1 -= L61_7[1] * x29; a2 -= L61_7[2] * x30; a3 -= L61_7[3] * x31; a0 -= L61_8[0] * x32; a1 -= L61_8[1] * x33; a2 -= L61_8[2] * x34; a3 -= L61_8[3] * x35; a0 -= L61_9[0] * x36; a1 -= L61_9[1] * x37; a2 -= L61_9[2] * x38; a3 -= L61_9[3] * x39; a0 -= L61_10[0] * x40; a1 -= L61_10[1] * x41; a2 -= L61_10[2] * x42; a3 -= L61_10[3] * x43; a0 -= L61_11[0] * x44; a1 -= L61_11[1] * x45; a2 -= L61_11[2] * x46; a3 -= L61_11[3] * x47; a0 -= L61_12[0] * x48; a1 -= L61_12[1] * x49; a2 -= L61_12[2] * x50; a3 -= L61_12[3] * x51; a0 -= L61_13[0] * x52; a1 -= L61_13[1] * x53; a2 -= L61_13[2] * x54; a3 -= L61_13[3] * x55; a0 -= L61_14[0] * x56; a1 -= L61_14[1] * x57; a2 -= L61_14[2] * x58; a3 -= L61_14[3] * x59; a0 -= L61_15[0] * x60; x61 = (a0 + a1) + (a2 + a3); }
        asm volatile("" ::: "memory");
        const float rr63 = X[63 * XS] * scp[63]; const f32x4 L63_0 = *(const LAS f32x4*)(LmV + 63 * LS + 0); const f32x4 L63_1 = *(const LAS f32x4*)(LmV + 63 * LS + 4); const f32x4 L62_2 = *(const LAS f32x4*)(LmV + 62 * LS + 8); const f32x4 L62_3 = *(const LAS f32x4*)(LmV + 62 * LS + 12); const f32x4 L62_4 = *(const LAS f32x4*)(LmV + 62 * LS + 16); const f32x4 L62_5 = *(const LAS f32x4*)(LmV + 62 * LS + 20); const f32x4 L62_6 = *(const LAS f32x4*)(LmV + 62 * LS + 24); const f32x4 L62_7 = *(const LAS f32x4*)(LmV + 62 * LS + 28); const f32x4 L62_8 = *(const LAS f32x4*)(LmV + 62 * LS + 32); const f32x4 L62_9 = *(const LAS f32x4*)(LmV + 62 * LS + 36); const f32x4 L62_10 = *(const LAS f32x4*)(LmV + 62 * LS + 40); const f32x4 L62_11 = *(const LAS f32x4*)(LmV + 62 * LS + 44); const f32x4 L62_12 = *(const LAS f32x4*)(LmV + 62 * LS + 48); const f32x4 L62_13 = *(const LAS f32x4*)(LmV + 62 * LS + 52); const f32x4 L62_14 = *(const LAS f32x4*)(LmV + 62 * LS + 56); const f32x4 L62_15 = *(const LAS f32x4*)(LmV + 62 * LS + 60);
        float x62; { float a0 = rr62, a1 = 0.f, a2 = 0.f, a3 = 0.f; a0 -= L62_0[0] * x0; a1 -= L62_0[1] * x1; a2 -= L62_0[2] * x2; a3 -= L62_0[3] * x3; a0 -= L62_1[0] * x4; a1 -= L62_1[1] * x5; a2 -= L62_1[2] * x6; a3 -= L62_1[3] * x7; a0 -= L62_2[0] * x8; a1 -= L62_2[1] * x9; a2 -= L62_2[2] * x10; a3 -= L62_2[3] * x11; a0 -= L62_3[0] * x12; a1 -= L62_3[1] * x13; a2 -= L62_3[2] * x14; a3 -= L62_3[3] * x15; a0 -= L62_4[0] * x16; a1 -= L62_4[1] * x17; a2 -= L62_4[2] * x18; a3 -= L62_4[3] * x19; a0 -= L62_5[0] * x20; a1 -= L62_5[1] * x21; a2 -= L62_5[2] * x22; a3 -= L62_5[3] * x23; a0 -= L62_6[0] * x24; a1 -= L62_6[1] * x25; a2 -= L62_6[2] * x26; a3 -= L62_6[3] * x27; a0 -= L62_7[0] * x28; a1 -= L62_7[1] * x29; a2 -= L62_7[2] * x30; a3 -= L62_7[3] * x31; a0 -= L62_8[0] * x32; a1 -= L62_8[1] * x33; a2 -= L62_8[2] * x34; a3 -= L62_8[3] * x35; a0 -= L62_9[0] * x36; a1 -= L62_9[1] * x37; a2 -= L62_9[2] * x38; a3 -= L62_9[3] * x39; a0 -= L62_10[0] * x40; a1 -= L62_10[1] * x41; a2 -= L62_10[2] * x42; a3 -= L62_10[3] * x43; a0 -= L62_11[0] * x44; a1 -= L62_11[1] * x45; a2 -= L62_11[2] * x46; a3 -= L62_11[3] * x47; a0 -= L62_12[0] * x48; a1 -= L62_12[1] * x49; a2 -= L62_12[2] * x50; a3 -= L62_12[3] * x51; a0 -= L62_13[0] * x52; a1 -= L62_13[1] * x53; a2 -= L62_13[2] * x54; a3 -= L62_13[3] * x55; a0 -= L62_14[0] * x56; a1 -= L62_14[1] * x57; a2 -= L62_14[2] * x58; a3 -= L62_14[3] * x59; a0 -= L62_15[0] * x60; a1 -= L62_15[1] * x61; x62 = (a0 + a1) + (a2 + a3); }
        asm volatile("" ::: "memory");
 const f32x4 L63_2 = *(const LAS f32x4*)(LmV + 63 * LS + 8); const f32x4 L63_3 = *(const LAS f32x4*)(LmV + 63 * LS + 12); const f32x4 L63_4 = *(const LAS f32x4*)(LmV + 63 * LS + 16); const f32x4 L63_5 = *(const LAS f32x4*)(LmV + 63 * LS + 20); const f32x4 L63_6 = *(const LAS f32x4*)(LmV + 63 * LS + 24); const f32x4 L63_7 = *(const LAS f32x4*)(LmV + 63 * LS + 28); const f32x4 L63_8 = *(const LAS f32x4*)(LmV + 63 * LS + 32); const f32x4 L63_9 = *(const LAS f32x4*)(LmV + 63 * LS + 36); const f32x4 L63_10 = *(const LAS f32x4*)(LmV + 63 * LS + 40); const f32x4 L63_11 = *(const LAS f32x4*)(LmV + 63 * LS + 44); const f32x4 L63_12 = *(const LAS f32x4*)(LmV + 63 * LS + 48); const f32x4 L63_13 = *(const LAS f32x4*)(LmV + 63 * LS + 52); const f32x4 L63_14 = *(const LAS f32x4*)(LmV + 63 * LS + 56); const f32x4 L63_15 = *(const LAS f32x4*)(LmV + 63 * LS + 60);
        float x63; { float a0 = rr63, a1 = 0.f, a2 = 0.f, a3 = 0.f; a0 -= L63_0[0] * x0; a1 -= L63_0[1] * x1; a2 -= L63_0[2] * x2; a3 -= L63_0[3] * x3; a0 -= L63_1[0] * x4; a1 -= L63_1[1] * x5; a2 -= L63_1[2] * x6; a3 -= L63_1[3] * x7; a0 -= L63_2[0] * x8; a1 -= L63_2[1] * x9; a2 -= L63_2[2] * x10; a3 -= L63_2[3] * x11; a0 -= L63_3[0] * x12; a1 -= L63_3[1] * x13; a2 -= L63_3[2] * x14; a3 -= L63_3[3] * x15; a0 -= L63_4[0] * x16; a1 -= L63_4[1] * x17; a2 -= L63_4[2] * x18; a3 -= L63_4[3] * x19; a0 -= L63_5[0] * x20; a1 -= L63_5[1] * x21; a2 -= L63_5[2] * x22; a3 -= L63_5[3] * x23; a0 -= L63_6[0] * x24; a1 -= L63_6[1] * x25; a2 -= L63_6[2] * x26; a3 -= L63_6[3] * x27; a0 -= L63_7[0] * x28; a1 -= L63_7[1] * x29; a2 -= L63_7[2] * x30; a3 -= L63_7[3] * x31; a0 -= L63_8[0] * x32; a1 -= L63_8[1] * x33; a2 -= L63_8[2] * x34; a3 -= L63_8[3] * x35; a0 -= L63_9[0] * x36; a1 -= L63_9[1] * x37; a2 -= L63_9[2] * x38; a3 -= L63_9[3] * x39; a0 -= L63_10[0] * x40; a1 -= L63_10[1] * x41; a2 -= L63_10[2] * x42; a3 -= L63_10[3] * x43; a0 -= L63_11[0] * x44; a1 -= L63_11[1] * x45; a2 -= L63_11[2] * x46; a3 -= L63_11[3] * x47; a0 -= L63_12[0] * x48; a1 -= L63_12[1] * x49; a2 -= L63_12[2] * x50; a3 -= L63_12[3] * x51; a0 -= L63_13[0] * x52; a1 -= L63_13[1] * x53; a2 -= L63_13[2] * x54; a3 -= L63_13[3] * x55; a0 -= L63_14[0] * x56; a1 -= L63_14[1] * x57; a2 -= L63_14[2] * x58; a3 -= L63_14[3] * x59; a0 -= L63_15[0] * x60; a1 -= L63_15[1] * x61; a2 -= L63_15[2] * x62; x63 = (a0 + a1) + (a2 + a3); }
        if (isv) {
            *(f32x4*)(UT + (size_t)c * 64 + 0) = (f32x4){x0, x1, x2, x3};
            *(f32x4*)(UT + (size_t)c * 64 + 4) = (f32x4){x4, x5, x6, x7};
            *(f32x4*)(UT + (size_t)c * 64 + 8) = (f32x4){x8, x9, x10, x11};
            *(f32x4*)(UT + (size_t)c * 64 + 12) = (f32x4){x12, x13, x14, x15};
            *(f32x4*)(UT + (size_t)c * 64 + 16) = (f32x4){x16, x17, x18, x19};
            *(f32x4*)(UT + (size_t)c * 64 + 20) = (f32x4){x20, x21, x22, x23};
            *(f32x4*)(UT + (size_t)c * 64 + 24) = (f32x4){x24, x25, x26, x27};
            *(f32x4*)(UT + (size_t)c * 64 + 28) = (f32x4){x28, x29, x30, x31};
            *(f32x4*)(UT + (size_t)c * 64 + 32) = (f32x4){x32, x33, x34, x35};
            *(f32x4*)(UT + (size_t)c * 64 + 36) = (f32x4){x36, x37, x38, x39};
            *(f32x4*)(UT + (size_t)c * 64 + 40) = (f32x4){x40, x41, x42, x43};
            *(f32x4*)(UT + (size_t)c * 64 + 44) = (f32x4){x44, x45, x46, x47};
            *(f32x4*)(UT + (size_t)c * 64 + 48) = (f32x4){x48, x49, x50, x51};
            *(f32x4*)(UT + (size_t)c * 64 + 52) = (f32x4){x52, x53, x54, x55};
            *(f32x4*)(UT + (size_t)c * 64 + 56) = (f32x4){x56, x57, x58, x59};
            *(f32x4*)(UT + (size_t)c * 64 + 60) = (f32x4){x60, x61, x62, x63};
        } else {
            WN[0 * 128 + (c - 128)] = (bf16)f2bf(-x0);
            WN[1 * 128 + (c - 128)] = (bf16)f2bf(-x1);
            WN[2 * 128 + (c - 128)] = (bf16)f2bf(-x2);
            WN[3 * 128 + (c - 128)] = (bf16)f2bf(-x3);
            WN[4 * 128 + (c - 128)] = (bf16)f2bf(-x4);
            WN[5 * 128 + (c - 128)] = (bf16)f2bf(-x5);
            WN[6 * 128 + (c - 128)] = (bf16)f2bf(-x6);
            WN[7 * 128 + (c - 128)] = (bf16)f2bf(-x7);
            WN[8 * 128 + (c - 128)] = (bf16)f2bf(-x8);
            WN[9 * 128 + (c - 128)] = (bf16)f2bf(-x9);
            WN[10 * 128 + (c - 128)] = (bf16)f2bf(-x10);
            WN[11 * 128 + (c - 128)] = (bf16)f2bf(-x11);
            WN[12 * 128 + (c - 128)] = (bf16)f2bf(-x12);
            WN[13 * 128 + (c - 128)] = (bf16)f2bf(-x13);
            WN[14 * 128 + (c - 128)] = (bf16)f2bf(-x14);
            WN[15 * 128 + (c - 128)] = (bf16)f2bf(-x15);
            WN[16 * 128 + (c - 128)] = (bf16)f2bf(-x16);
            WN[17 * 128 + (c - 128)] = (bf16)f2bf(-x17);
            WN[18 * 128 + (c - 128)] = (bf16)f2bf(-x18);
            WN[19 * 128 + (c - 128)] = (bf16)f2bf(-x19);
            WN[20 * 128 + (c - 128)] = (bf16)f2bf(-x20);
            WN[21 * 128 + (c - 128)] = (bf16)f2bf(-x21);
            WN[22 * 128 + (c - 128)] = (bf16)f2bf(-x22);
            WN[23 * 128 + (c - 128)] = (bf16)f2bf(-x23);
            WN[24 * 128 + (c - 128)] = (bf16)f2bf(-x24);
            WN[25 * 128 + (c - 128)] = (bf16)f2bf(-x25);
            WN[26 * 128 + (c - 128)] = (bf16)f2bf(-x26);
            WN[27 * 128 + (c - 128)] = (bf16)f2bf(-x27);
            WN[28 * 128 + (c - 128)] = (bf16)f2bf(-x28);
            WN[29 * 128 + (c - 128)] = (bf16)f2bf(-x29);
            WN[30 * 128 + (c - 128)] = (bf16)f2bf(-x30);
            WN[31 * 128 + (c - 128)] = (bf16)f2bf(-x31);
            WN[32 * 128 + (c - 128)] = (bf16)f2bf(-x32);
            WN[33 * 128 + (c - 128)] = (bf16)f2bf(-x33);
            WN[34 * 128 + (c - 128)] = (bf16)f2bf(-x34);
            WN[35 * 128 + (c - 128)] = (bf16)f2bf(-x35);
            WN[36 * 128 + (c - 128)] = (bf16)f2bf(-x36);
            WN[37 * 128 + (c - 128)] = (bf16)f2bf(-x37);
            WN[38 * 128 + (c - 128)] = (bf16)f2bf(-x38);
            WN[39 * 128 + (c - 128)] = (bf16)f2bf(-x39);
            WN[40 * 128 + (c - 128)] = (bf16)f2bf(-x40);
            WN[41 * 128 + (c - 128)] = (bf16)f2bf(-x41);
            WN[42 * 128 + (c - 128)] = (bf16)f2bf(-x42);
            WN[43 * 128 + (c - 128)] = (bf16)f2bf(-x43);
            WN[44 * 128 + (c - 128)] = (bf16)f2bf(-x44);
            WN[45 * 128 + (c - 128)] = (bf16)f2bf(-x45);
            WN[46 * 128 + (c - 128)] = (bf16)f2bf(-x46);
            WN[47 * 128 + (c - 128)] = (bf16)f2bf(-x47);
            WN[48 * 128 + (c - 128)] = (bf16)f2bf(-x48);
            WN[49 * 128 + (c - 128)] = (bf16)f2bf(-x49);
            WN[50 * 128 + (c - 128)] = (bf16)f2bf(-x50);
            WN[51 * 128 + (c - 128)] = (bf16)f2bf(-x51);
            WN[52 * 128 + (c - 128)] = (bf16)f2bf(-x52);
            WN[53 * 128 + (c - 128)] = (bf16)f2bf(-x53);
            WN[54 * 128 + (c - 128)] = (bf16)f2bf(-x54);
            WN[55 * 128 + (c - 128)] = (bf16)f2bf(-x55);
            WN[56 * 128 + (c - 128)] = (bf16)f2bf(-x56);
            WN[57 * 128 + (c - 128)] = (bf16)f2bf(-x57);
            WN[58 * 128 + (c - 128)] = (bf16)f2bf(-x58);
            WN[59 * 128 + (c - 128)] = (bf16)f2bf(-x59);
            WN[60 * 128 + (c - 128)] = (bf16)f2bf(-x60);
            WN[61 * 128 + (c - 128)] = (bf16)f2bf(-x61);
            WN[62 * 128 + (c - 128)] = (bf16)f2bf(-x62);
            WN[63 * 128 + (c - 128)] = (bf16)f2bf(-x63);
        }
    } else {
        const int t2 = tid - 256;
        { const int i = t2 >> 2, d0 = (t2 & 3) * 32; const float e = expf(gcs[i]);
#pragma unroll
          for (int q8 = 0; q8 < 4; ++q8) { const f32x4 a = *(const LAS f32x4*)(XQ + i * XS + d0 + 8 * q8), c = *(const LAS f32x4*)(XQ + i * XS + d0 + 8 * q8 + 4);
              v4u o; o.x = pk2(a[0] * e, a[1] * e); o.y = pk2(a[2] * e, a[3] * e); o.z = pk2(c[0] * e, c[1] * e); o.w = pk2(c[2] * e, c[3] * e);
              *(v4u*)(QG + (size_t)i * 128 + d0 + 8 * q8) = o; } }
        { const int d = t2 >> 1, i0 = (t2 & 1) * 32; const float gl = gcs[63];
#pragma unroll
          for (int q8 = 0; q8 < 4; ++q8) { float v[8];
#pragma unroll
              for (int e = 0; e < 8; ++e) { const int i = i0 + 8 * q8 + e; v[e] = XK[i * XS + d] * expf(gl - gcs[i]); }
              v4u o; o.x = pk2(v[0], v[1]); o.y = pk2(v[2], v[3]); o.z = pk2(v[4], v[5]); o.w = pk2(v[6], v[7]);
              *(v4u*)(KGT + (size_t)d * 64 + i0 + 8 * q8) = o; } }
        if (t2 == 0) GL[unit] = expf(gcs[63]);
    }
    __syncthreads();
}

__device__ __forceinline__ int sw256(int row, int ch) { return row * 256 + ((ch ^ (row & 15)) << 4); }
__device__ __forceinline__ int sw128(int row, int ch) { return row * 128 + ((ch ^ ((row >> 1) & 7)) << 4); }
__device__ __forceinline__ void gdnb_unit(const Params& P, LAS unsigned char* lds, int bh) {
    typedef float f32x4_ __attribute__((ext_vector_type(4)));
    const int tid = threadIdx.x, wid = __builtin_amdgcn_readfirstlane(tid >> 6), lane = tid & 63, fr = lane & 15, fq = lane >> 4;
    const int b = bh >> 2, h = bh & 3;
    const float* w_gnorm = P.in[14];
    const bf16* ZB = (const bf16*)(P.ws + WS_ZB); bf16* MIX = (bf16*)(P.ws + WS_MIX);
    LAS unsigned char* Wl = lds;
    LAS unsigned char* Ql = lds + 16384;
    LAS unsigned char* Kl = lds + 32768;
    LAS unsigned char* Ml = lds + 49152;
    LAS unsigned char* STl = lds + 57344;
    LAS unsigned char* VTl = lds + 90112;
    LAS float* red = (LAS float*)(lds + 106496);
    f32x4_ S[8];
#pragma unroll
    for (int i = 0; i < 8; ++i) S[i] = (f32x4_){0.f, 0.f, 0.f, 0.f};
    const int e = 16 * wid + fr;
    {
#pragma unroll
        for (int db = 0; db < 8; ++db) *(LAS v2u*)(STl + sw256(e, (16 * db + 4 * fq) >> 3) + ((4 * fq) & 7) * 2) = (v2u){0u, 0u};
    }
    const float gn = w_gnorm[e];
    for (int n = 0; n < NCHUNK; ++n) {
        const int unit = bh * 32 + n;
        const bf16* WN = (const bf16*)(P.ws + WS_WN) + (size_t)unit * 8192; const bf16* QG = (const bf16*)(P.ws + WS_QG) + (size_t)unit * 8192;
        const bf16* KGT = (const bf16*)(P.ws + WS_KGT) + (size_t)unit * 8192; const bf16* QKM = (const bf16*)(P.ws + WS_QKM) + (size_t)unit * 4096;
        const float* UT = (const float*)(P.ws + WS_UT) + (size_t)unit * 8192;
        const float gl = ((const float*)(P.ws + WS_GL))[unit];
#pragma unroll
        for (int i = 0; i < 2; ++i) { const int idx = tid + 512 * i; const int r = idx >> 4, ch = idx & 15;
            *(LAS v4u*)(Wl + sw256(r, ch)) = *(const v4u*)(WN + (size_t)idx * 8); *(LAS v4u*)(Ql + sw256(r, ch)) = *(const v4u*)(QG + (size_t)idx * 8); }
#pragma unroll
        for (int i = 0; i < 2; ++i) { const int idx = tid + 512 * i; const int r = idx >> 3, ch = idx & 7; *(LAS v4u*)(Kl + sw128(r, ch)) = *(const v4u*)(KGT + (size_t)idx * 8); }
        { const int idx = tid; const int r = idx >> 3, ch = idx & 7; *(LAS v4u*)(Ml + sw128(r, ch)) = *(const v4u*)(QKM + (size_t)idx * 8); }
        __syncthreads();
        bf16x8 sb[4];
#pragma unroll
        for (int ks = 0; ks < 4; ++ks) sb[ks] = *(const LAS bf16x8*)(STl + sw256(e, 4 * ks + fq));
        f32x4_ vn[4];
#pragma unroll
        for (int rb = 0; rb < 4; ++rb) {
            vn[rb] = *(const f32x4_*)(UT + (size_t)e * 64 + 16 * rb + 4 * fq);
#pragma unroll
            for (int ks = 0; ks < 4; ++ks) { const bf16x8 a = *(const LAS bf16x8*)(Wl + sw256(16 * rb + fr, 4 * ks + fq)); vn[rb] = __builtin_amdgcn_mfma_f32_16x16x32_bf16(a, sb[ks], vn[rb], 0, 0, 0); }
            v2u o; o.x = pk2(vn[rb][0], vn[rb][1]); o.y = pk2(vn[rb][2], vn[rb][3]);
            *(LAS v2u*)(VTl + sw128(e, (16 * rb + 4 * fq) >> 3) + ((4 * fq) & 7) * 2) = o;
        }
        bf16x8 vb[2];
#pragma unroll
        for (int ks = 0; ks < 2; ++ks) vb[ks] = *(const LAS bf16x8*)(VTl + sw128(e, 4 * ks + fq));
        f32x4_ oo[4];
#pragma unroll
        for (int rb = 0; rb < 4; ++rb) {
            oo[rb] = (f32x4_){0.f, 0.f, 0.f, 0.f};
#pragma unroll
            for (int ks = 0; ks < 4; ++ks) { const bf16x8 a = *(const LAS bf16x8*)(Ql + sw256(16 * rb + fr, 4 * ks + fq)); oo[rb] = __builtin_amdgcn_mfma_f32_16x16x32_bf16(a, sb[ks], oo[rb], 0, 0, 0); }
#pragma unroll
            for (int ks = 0; ks < 2; ++ks) { const bf16x8 a = *(const LAS bf16x8*)(Ml + sw128(16 * rb + fr, 4 * ks + fq)); oo[rb] = __builtin_amdgcn_mfma_f32_16x16x32_bf16(a, vb[ks], oo[rb], 0, 0, 0); }
        }
#pragma unroll
        for (int db = 0; db < 8; ++db) {
            S[db] = S[db] * gl;
#pragma unroll
            for (int ks = 0; ks < 2; ++ks) { const bf16x8 a = *(const LAS bf16x8*)(Kl + sw128(16 * db + fr, 4 * ks + fq)); S[db] = __builtin_amdgcn_mfma_f32_16x16x32_bf16(a, vb[ks], S[db], 0, 0, 0); }
            v2u o; o.x = pk2(S[db][0], S[db][1]); o.y = pk2(S[db][2], S[db][3]);
            *(LAS v2u*)(STl + sw256(e, (16 * db + 4 * fq) >> 3) + ((4 * fq) & 7) * 2) = o;
        }
#pragma unroll
        for (int rb = 0; rb < 4; ++rb)
#pragma unroll
            for (int j = 0; j < 4; ++j) { float s = oo[rb][j] * oo[rb][j];
                s += __shfl_xor(s, 1); s += __shfl_xor(s, 2); s += __shfl_xor(s, 4); s += __shfl_xor(s, 8);
                if (fr == 0) red[(16 * rb + 4 * fq + j) * 8 + wid] = s; }
        __syncthreads();
#pragma unroll
        for (int rb = 0; rb < 4; ++rb)
#pragma unroll
            for (int j = 0; j < 4; ++j) { const int c = 16 * rb + 4 * fq + j;
                const f32x4_ r0 = *(const LAS f32x4_*)(red + c * 8), r1 = *(const LAS f32x4_*)(red + c * 8 + 4);
                const float ss = ((r0[0] + r0[1]) + (r0[2] + r0[3])) + ((r1[0] + r1[1]) + (r1[2] + r1[3]));
                const float rstd = 1.0f / sqrtf(ss * (1.0f / 128.0f) + RMS_EPS);
                const size_t m = (size_t)b * SEQ + n * GCH + c;
                const float z = bf2f(ZB[m * 512 + h * 128 + e]);
                MIX[m * DM + 512 + h * 128 + e] = (bf16)f2bf(oo[rb][j] * rstd * gn * silu_f(z)); }
        __syncthreads();
    }
    float* So = P.out + OSSM_P + (size_t)bh * 16384;
#pragma unroll
    for (int db = 0; db < 8; ++db)
#pragma unroll
        for (int j = 0; j < 4; ++j) So[(size_t)(16 * db + 4 * fq + j) * 128 + e] = S[db][j];
}


__device__ __forceinline__ f32x4 sgemm_slice16(const bf16* A, int lda, const bf16* Bt, int ldb, int n0, int k0, int k1, int wid, int fr, int fq) {
    f32x4 acc = {0.f, 0.f, 0.f, 0.f};
    const bf16* ap = A + (size_t)(16 * wid + fr) * lda + 8 * fq;
    const bf16* bp = Bt + (size_t)(n0 + fr) * ldb + 8 * fq;
#pragma unroll 8
    for (int ks = k0; ks < k1; ks += 32) {
        const bf16x8 a = *(const bf16x8*)(ap + ks), b = *(const bf16x8*)(bp + ks);
        acc = __builtin_amdgcn_mfma_f32_16x16x32_bf16(b, a, acc, 0, 0, 0);
    }
    return acc;
}
__device__ __forceinline__ void sample_wo_slice(const Params& P, int slice) {
    const int tid = threadIdx.x, wid = __builtin_amdgcn_readfirstlane(tid >> 6), lane = tid & 63, fr = lane & 15, fq = lane >> 4;
    const bf16* MIX = (const bf16*)(P.ws + WS_MIX) + (size_t)MP * DM; const bf16* WOT = (const bf16*)(P.ws + WS_WOT);
    bf16* HB = (bf16*)(P.ws + WS_HB) + (size_t)MP * DM; float* SSQS = (float*)(P.ws + WS_SSQS);
    const f32x4 acc = sgemm_slice16(MIX, DM, WOT, DM, 16 * slice, 0, DM, wid, fr, fq);
    const int m = 16 * wid + fr, n = 16 * slice + 4 * fq;
    const f32x4 h = acc + *(const f32x4*)(P.in[1] + (size_t)m * DM + n);
    *(f32x4*)(P.out + OY_S + (size_t)m * DM + n) = h;
    v2u o; o.x = pk2(h[0], h[1]); o.y = pk2(h[2], h[3]); *(v2u*)(HB + (size_t)m * DM + n) = o;
    float s = (h[0] * h[0] + h[1] * h[1]) + (h[2] * h[2] + h[3] * h[3]);
    s += __shfl_xor(s, 16); s += __shfl_xor(s, 32);
    if (fq == 0) SSQS[m * 64 + slice] = s;
}
__device__ __forceinline__ void sample_up_slice(const Params& P, int slice) {
    const int tid = threadIdx.x, wid = __builtin_amdgcn_readfirstlane(tid >> 6), lane = tid & 63, fr = lane & 15, fq = lane >> 4;
    const bf16* HB = (const bf16*)(P.ws + WS_HB) + (size_t)MP * DM; const bf16* WUPT = (const bf16*)(P.ws + WS_WUPT);
    bf16* UB = (bf16*)(P.ws + WS_UB) + (size_t)MP * FF; const float* SSQS = (const float*)(P.ws + WS_SSQS);
    const int m = 16 * wid + fr, n = 16 * slice + 4 * fq;
    float ss = 0.f;
#pragma unroll
    for (int i = 0; i < 4; ++i) { const f32x4 t = *(const f32x4*)(SSQS + m * 64 + 16 * fq + 4 * i); ss += (t[0] + t[1]) + (t[2] + t[3]); }
    ss += __shfl_xor(ss, 16); ss += __shfl_xor(ss, 32);
    const float rstd = 1.0f / sqrtf(ss * (1.0f / DM) + RMS_EPS);
    const f32x4 acc = sgemm_slice16(HB, DM, WUPT, DM, 16 * slice, 0, DM, wid, fr, fq);
    float u[4];
#pragma unroll
    for (int j = 0; j < 4; ++j) { const float p = fmaxf(acc[j] * rstd, 0.f); u[j] = p * p; }
    v2u o; o.x = pk2(u[0], u[1]); o.y = pk2(u[2], u[3]); *(v2u*)(UB + (size_t)m * FF + n) = o;
}
__device__ __forceinline__ void sample_down_slice(const Params& P, int item) {
    const int tid = threadIdx.x, wid = __builtin_amdgcn_readfirstlane(tid >> 6), lane = tid & 63, fr = lane & 15, fq = lane >> 4;
    const bf16* UB = (const bf16*)(P.ws + WS_UB) + (size_t)MP * FF; const bf16* WDNT = (const bf16*)(P.ws + WS_WDNT);
    float* PART = (float*)(P.ws + WS_PART);
    const int slice = item & 63, q = item >> 6;
    const f32x4 acc = sgemm_slice16(UB, FF, WDNT, FF, 16 * slice, 1024 * q, 1024 * q + 1024, wid, fr, fq);
    const int m = 16 * wid + fr, n = 16 * slice + 4 * fq;
    *(f32x4*)(PART + ((size_t)q * DECB + m) * DM + n) = acc;
}

__device__ __forceinline__ void phase_final(const Params& P, const Ctx& C) {
    const float* ln_f = P.in[19]; const float* SSQ2 = (const float*)(P.ws + WS_SSQ2);
    const int gw = C.vcu * NWAVES + C.wave, NGW = C.G * NWAVES, lane = C.lane;
    f32x4 lw[4];
#pragma unroll
    for (int j = 0; j < 4; ++j) lw[j] = ((const f32x4*)ln_f)[lane + 64 * j];
    for (int m = gw; m < M_TOT; m += NGW) {
        if (m < MP) {
            const f32x4* sp = (const f32x4*)(SSQ2 + (size_t)m * 16);
            const f32x4 a = sp[0], b = sp[1], c = sp[2], d = sp[3];
            const float ss = ((a[0] + a[1]) + (a[2] + a[3])) + ((b[0] + b[1]) + (b[2] + b[3])) + ((c[0] + c[1]) + (c[2] + c[3])) + ((d[0] + d[1]) + (d[2] + d[3]));
            const float rstd = 1.0f / sqrtf(ss * (1.0f / DM) + RMS_EPS);
            float* yr = P.out + OY_P + (size_t)m * DM;
#pragma unroll
            for (int j = 0; j < 4; ++j) { f32x4 v = ((const f32x4*)yr)[lane + 64 * j]; v = v * rstd * lw[j]; ((f32x4*)yr)[lane + 64 * j] = v; }
        } else {
            const int r = m - MP; float* yr = P.out + OY_S + (size_t)r * DM; const float* PART = (const float*)(P.ws + WS_PART);
            f32x4 v[4]; float ss = 0.f;
#pragma unroll
            for (int j = 0; j < 4; ++j) { v[j] = ((const f32x4*)yr)[lane + 64 * j];
#pragma unroll
                for (int q = 0; q < 4; ++q) v[j] += ((const f32x4*)(PART + ((size_t)q * DECB + r) * DM))[lane + 64 * j];
                ss += (v[j][0] * v[j][0] + v[j][1] * v[j][1]) + (v[j][2] * v[j][2] + v[j][3] * v[j][3]); }
            ss = wave_sum(ss);
            const float rstd = 1.0f / sqrtf(ss * (1.0f / DM) + RMS_EPS);
#pragma unroll
            for (int j = 0; j < 4; ++j) ((f32x4*)yr)[lane + 64 * j] = v[j] * rstd * lw[j];
        }
    }
}

constexpr int NPHASES = 8;
__global__ void __launch_bounds__(NWAVES * 64, 2) fwd_kernel(Params P) {
    extern __shared__ __attribute__((aligned(16))) unsigned char shm[];
    LAS unsigned char* lds = (LAS unsigned char*)shm;
    Ctx C; C.tid = threadIdx.x; C.lane = C.tid & 63; C.wave = __builtin_amdgcn_readfirstlane(C.tid >> 6);
    C.G = gridDim.x; { const int bx = blockIdx.x; C.vcu = (C.G % 8 == 0) ? (bx % 8) * (C.G / 8) + bx / 8 : bx; }
    volatile LAS unsigned* MISC = (volatile LAS unsigned*)(lds + MISC_OFF);
    if (C.tid < 64) MISC[C.tid] = 0u;
    __syncthreads();
    unsigned* ctl = (unsigned*)(P.ws + WS_CTL);
    const int lo = P.ph_lo, hi = P.ph_hi;
    XcdBarrier bar; bar.bar = ctl + CW_BAR; bar.x = 0; bar.st = nullptr;
    if (hi - lo > 1) bar = xcd_barrier_post(ctl + CW_BAR, MISC + 8);
#ifndef REPEAT_MASK
#define REPEAT_MASK 0
#endif
#define NREP(k) (((REPEAT_MASK >> (k)) & 1) ? 2 : 1)
#ifndef SUBMASK
#define SUBMASK 15
#endif
#ifndef PHASE_MASK
#define PHASE_MASK 0xff
#endif
#define IN(k) (((PHASE_MASK >> (k)) & 1) && lo <= (k) && (k) < hi)
#define SEAM(k) do { if (IN(k) && IN((k) + 1)) xcd_barrier(bar); } while (0)
    unsigned char* ws = P.ws;

    if (IN(0)) { for (int rep = 0; rep < NREP(0); ++rep) phase_prep(P, C, lds); SEAM(0); }

    if (IN(1)) {
        if (C.wave == 0) for (int bh = C.vcu; bh < NB * NH; bh += C.G) kbias_seq(P, bh, C.lane);
        for (int rep = 0; rep < NREP(1); ++rep) {
        pg8::Gemm g{(const pg8::bf16_t*)(ws + WS_XN), (const pg8::bf16_t*)(ws + WS_W1T), M_PAD, N1, DM};
        pg8::StaticOrder S; S.init(M_PAD, N1, C.G, (int)blockIdx.x);
        pg8::EpiIn E{(pg8::bf16_t*)(ws + WS_QB), (float*)(ws + WS_QS), (pg8::bf16_t*)(ws + WS_CB), (pg8::bf16_t*)(ws + WS_ZB), P.out};
        pg8::gemm_phase<pg8::EpiIn, pg8::StaticOrder, true, true>(lds, g, S, E);
        }
        SEAM(1);
    }

    if (IN(2)) {
        for (int it = C.vcu; it < 256; it += C.G) {
            const int xg = it >> 5, slot = it & 31, idx = slot >> 1;
            if ((slot & 1) == 0) {
                const int bh = xg * 4 + (idx >> 2), x = idx & 3, b = bh >> 2, h = bh & 3;
                const bf16* Qh = (const bf16*)(ws + WS_QB) + (size_t)bh * SEQ * HD; const bf16* Kh = (const bf16*)(ws + WS_KB) + (size_t)bh * SEQ * HD; const bf16* Vh = (const bf16*)(ws + WS_VB) + (size_t)bh * SEQ * HD;
                const float* kbias = (const float*)(ws + WS_KBIAS) + (size_t)bh * SEQ;
                bf16* Orow0 = (bf16*)(ws + WS_MIX) + (size_t)b * SEQ * DM + h * HD;
#if SUBMASK & 1
                for (int rep = 0; rep < NREP(2); ++rep) {
                fox::fox_block((char*)shm, Qh, Kh, Vh, kbias, Orow0, 7 - x);
                fox::fox_block((char*)shm, Qh, Kh, Vh, kbias, Orow0, x); }
#endif
            } else {
                const int db = xg * 16 + idx;
#if SUBMASK & 2
                for (int rep = 0; rep < NREP(3); ++rep) decode_unit(P, lds, db);
#endif
#if SUBMASK & 4
                for (int rep = 0; rep < NREP(4); ++rep) for (int h = 0; h < NH; ++h) sgdn_unit(P, lds, db, h);
#endif
            }
        }
#if SUBMASK & 8
        for (int rep = 0; rep < NREP(5); ++rep) for (int u = C.vcu; u < NB * NH * NCHUNK; u += C.G) gdna_unit(P, lds, u);
#endif
        SEAM(2);
    }

    if (IN(3)) {
        for (int rep = 0; rep < NREP(6); ++rep) for (int bh = blockIdx.x; bh < NB * NH; bh += C.G) gdnb_unit(P, lds, bh);
        SEAM(3);
    }

    if (IN(4)) {
        for (int it = blockIdx.x; it < 64; it += C.G) sample_wo_slice(P, it);
        pg8::Gemm g{(const pg8::bf16_t*)(ws + WS_MIX), (const pg8::bf16_t*)(ws + WS_WOT), MP, DM, DM};
        pg8::StaticOrder S; S.init(MP, DM, C.G, (int)blockIdx.x);
        pg8::EpiRes E{P.in[0], P.in[1], P.out, (pg8::bf16_t*)(ws + WS_HB), (float*)(ws + WS_SSQ)};
        for (int rep = 0; rep < NREP(7); ++rep) pg8::gemm_phase<pg8::EpiRes, pg8::StaticOrder, true, true>(lds, g, S, E);
        SEAM(4);
    }

    if (IN(5)) {
        for (int it = blockIdx.x; it < 256; it += C.G) sample_up_slice(P, it);
        pg8::Gemm g{(const pg8::bf16_t*)(ws + WS_HB), (const pg8::bf16_t*)(ws + WS_WUPT), MP, FF, DM};
        pg8::StaticOrder S; S.init(MP, FF, C.G, (int)blockIdx.x);
        pg8::EpiUp E{(pg8::bf16_t*)(ws + WS_UB), (const float*)(ws + WS_SSQ)};
        for (int rep = 0; rep < NREP(8); ++rep) pg8::gemm_phase<pg8::EpiUp, pg8::StaticOrder, true, true>(lds, g, S, E);
        SEAM(5);
    }

    if (IN(6)) {
        for (int it = blockIdx.x; it < 256; it += C.G) sample_down_slice(P, it);
        pg8::Gemm g{(const pg8::bf16_t*)(ws + WS_UB), (const pg8::bf16_t*)(ws + WS_WDNT), MP, DM, FF};
        pg8::StaticOrder S; S.init(MP, DM, C.G, (int)blockIdx.x);
        pg8::EpiDown E{P.out, (float*)(ws + WS_SSQ2)};
        pg8::gemm_phase<pg8::EpiDown, pg8::StaticOrder, true, true>(lds, g, S, E);
        SEAM(6);
    }

    if (IN(7)) phase_final(P, C);
#undef IN
#undef SEAM
}

#ifndef N_LAUNCH_MODE
#define N_LAUNCH_MODE 1
#endif
extern "C" void kernel_launch(void* const* d_in, const int* in_sizes, int n_in, void* d_out, int out_size, void* d_ws, size_t ws_size, hipStream_t stream) {
    static int grid = 0;
    if (grid == 0) {
        if (n_in != 20 || out_size != (int)OUT_TOTAL || ws_size < WS_END) { fprintf(stderr, "kernel_launch: unexpected shapes (n_in %d, out %d, ws %zu); nothing launched\n", n_in, out_size, ws_size); grid = -1; return; }
        int dev = 0, cus = 0, per_cu = 0;
        if (hipGetDevice(&dev) != hipSuccess || hipDeviceGetAttribute(&cus, hipDeviceAttributeMultiprocessorCount, dev) != hipSuccess) { grid = -1; return; }
        if (hipFuncSetAttribute((const void*)fwd_kernel, hipFuncAttributeMaxDynamicSharedMemorySize, LDS_BYTES) != hipSuccess) { fprintf(stderr, "kernel_launch: hipFuncSetAttribute failed\n"); grid = -1; return; }
        if (hipOccupancyMaxActiveBlocksPerMultiprocessor(&per_cu, (const void*)fwd_kernel, NWAVES * 64, LDS_BYTES) != hipSuccess || per_cu < 1)
            fprintf(stderr, "kernel_launch: note: occupancy query reports %d workgroups per CU\n", per_cu);
        (void)hipGetLastError();
        grid = cus;
    }
    if (grid < 0) return;
    if (hipMemsetAsync((char*)d_ws + WS_CTL, 0, CTL_ZERO_BYTES, stream) != hipSuccess) return;
    Params p{};
    for (int i = 0; i < 20; ++i) p.in[i] = (const float*)d_in[i];
    p.out = (float*)d_out; p.ws = (unsigned char*)d_ws;
    if (N_LAUNCH_MODE == 1) {
        p.ph_lo = 0; p.ph_hi = NPHASES;
        hipLaunchKernelGGL(fwd_kernel, dim3(grid), dim3(NWAVES * 64), LDS_BYTES, stream, p);
    } else {
        for (int k = 0; k < NPHASES; ++k) { p.ph_lo = k; p.ph_hi = k + 1; hipLaunchKernelGGL(fwd_kernel, dim3(grid), dim3(NWAVES * 64), LDS_BYTES, stream, p); }
    }
}
```

```cpp
#include <hip/hip_runtime.h>
#include <hip/hip_bf16.h>
#include <cstdio>
#include <cstdint>

constexpr int DM = 1024, NB = 8, SEQ = 2048, DECB = 128, PAST = 2048, PAGE = 128, NPAGES = 16;
constexpr int NH = 4, HD = 128, CONVD = 1536, FF = 4096, INDIM = 3596, GCH = 64, NCHUNK = SEQ / GCH;
constexpr int MP = NB * SEQ;
constexpr int M_TOT = MP + DECB;
constexpr int M_PAD = 16640;
constexpr int N1 = 3584;
constexpr float RMS_EPS = 1e-6f, L2_EPS = 1e-6f;
constexpr float ATT_SCALE = 0.08838834764831845f;
constexpr size_t OY_P = 0, OY_S = 16777216, OK_P = 16908288, OV_P = 25296896, OLF_P = 33685504, OCONV_P = 33751040, OSSM_P = 33787904,
                 OK_S = 34312192, OV_S = 34377728, OLF_S = 34443264, OCONV_S = 34443776, OSSM_S = 35033600, OUT_TOTAL = 43422208;
constexpr size_t MiB = 1u << 20;
constexpr size_t WS_CTL = 0, CTL_ZERO_BYTES = 1 * MiB;
constexpr size_t WS_W1T = 2 * MiB, WS_WOT = 10 * MiB, WS_WUPT = 12 * MiB, WS_WDNT = 21 * MiB;
constexpr size_t WS_XN = 32 * MiB, WS_QB = 68 * MiB, WS_KB = 84 * MiB, WS_VB = 100 * MiB, WS_CB = 116 * MiB, WS_ZB = 166 * MiB;
constexpr size_t WS_MIX = 184 * MiB, WS_HB = 218 * MiB, WS_UB = 252 * MiB;
constexpr size_t WS_UT = 384 * MiB, WS_WN = 416 * MiB, WS_QG = 432 * MiB, WS_KGT = 448 * MiB, WS_QKM = 464 * MiB;
constexpr size_t WS_LF = 472 * MiB, WS_BETA = 473 * MiB, WS_G = 474 * MiB, WS_KBIAS = 475 * MiB, WS_QS = 476 * MiB, WS_SSQ = 477 * MiB, WS_SSQ2 = 479 * MiB, WS_GL = 481 * MiB, WS_SSQS = 482 * MiB, WS_PART = 483 * MiB;
constexpr size_t WS_END = 486 * MiB;
constexpr int CW_TMO = 0, CW_BAR = 4096;
constexpr size_t QKV_STRIDE = (WS_KB - WS_QB) / 2;
static_assert(WS_VB - WS_KB == WS_KB - WS_QB, "q/k/v copies equally spaced");

namespace pg8 {
#define PG8_LAS __attribute__((address_space(3)))
typedef unsigned short bf16_t;
typedef short bf16x8 __attribute__((ext_vector_type(8)));
typedef float f32x4 __attribute__((ext_vector_type(4)));
typedef unsigned u32x4 __attribute__((ext_vector_type(4)));
constexpr int BM = 256, BK = 64, HALF = 128, HTB = HALF * BK * 2  , STAGE_BYTES = 8 * HTB, NXCD = 8, WGM = 8;

__host__ __device__ __forceinline__ int lds_byte(int r, int c) { const int st = (r >> 4) * 2 + (c >> 5), rr = r & 15, cc = c & 31, ob = rr * 64 + cc * 2; return st * 1024 + (ob ^ (((ob >> 9) & 1) << 5)); }
__host__ __device__ __forceinline__ void stage_rc(int b, int& R, int& C) { const int st = b / 1024, sb = b % 1024, swz = sb ^ (((sb >> 9) & 1) << 5); R = (st >> 1) * 16 + swz / 64; C = (st & 1) * 32 + (swz % 64) / 2; }
__host__ __device__ __forceinline__ int perm32(int rho) { const int n = rho >> 4, i = rho & 15; return 8 * (i >> 2) + 4 * n + (i & 3); }

struct Unit { int pm, pn; };
struct Gemm { const bf16_t* A; const bf16_t* Bt; int M, N, K; };

struct StaticOrder {
    int nM, nN, nwg, G, c;
    __host__ __device__ void init(int M, int N, int G_, int c_) { nM = M / BM; nN = N / BM; nwg = nM * nN; G = G_; c = c_; }
    __host__ __device__ bool next(int i, Unit& u) const {
        const long L = (long)i * G + c; if (L >= nwg) return false;
        int wgid = (int)L; { const int q = nwg / NXCD, r = nwg % NXCD, xcd = wgid % NXCD, off = wgid / NXCD; wgid = (xcd < r ? xcd * (q + 1) : r * (q + 1) + (xcd - r) * q) + off; }
        const int nig = WGM * nN, gid = wgid / nig, fm = gid * WGM, gsz = (nM - fm) < WGM ? (nM - fm) : WGM;
        u.pm = fm + ((wgid % nig) % gsz); u.pn = (wgid % nig) / gsz; return true;
    }
    __device__ __forceinline__ void a_ready(const Unit&) const {}
    __device__ __forceinline__ void done(const Unit&) const {}
};
__device__ __forceinline__ unsigned cvt_pk_bf16(float lo, float hi) { unsigned r; asm volatile("v_cvt_pk_bf16_f32 %0, %1, %2" : "=v"(r) : "v"(lo), "v"(hi)); return r; }
typedef float f32x2 __attribute__((ext_vector_type(2)));
__device__ __forceinline__ u32x4 pack8_bf16(f32x4 v0, f32x4 v1) { u32x4 w; w.x = cvt_pk_bf16(v0[0], v0[1]); w.y = cvt_pk_bf16(v0[2], v0[3]); w.z = cvt_pk_bf16(v1[0], v1[1]); w.w = cvt_pk_bf16(v1[2], v1[3]); return w; }

struct EpiIn {
    static constexpr bool PERM = true, AFTER_DRAIN = false;
    bf16_t* QB;
    float* QS;
    bf16_t* CB;
    bf16_t* ZB;
    float* out;
    __device__ __forceinline__ void operator()(const f32x4 (&acc)[2][2][4][2], const Unit& u, int wr, int wc, int fr, int fq) const {
        const int pn = u.pn;
#pragma unroll
        for (int ai = 0; ai < 2; ++ai)
#pragma unroll
            for (int m = 0; m < 4; ++m) {
                const int row = u.pm * BM + ai * HALF + wr * 64 + m * 16 + fr;
                if (row >= M_TOT) continue;
#pragma unroll
                for (int bj = 0; bj < 2; ++bj) {
                    const int col = pn * BM + bj * HALF + wc * 32 + 8 * fq;
                    const f32x4 v0 = acc[ai][bj][m][0], v1 = acc[ai][bj][m][1];
                    if (pn < 6) {
                        const int seg = pn >> 1, c = col - seg * 512, h = c >> 7, d = c & 127;
                        if (row < MP) {
                            const int b = row >> 11, t = row & 2047;
                            const size_t idx = ((size_t)((b * NH + h) * SEQ + t)) * HD + d;
                            *(u32x4*)(QB + (size_t)seg * QKV_STRIDE + idx) = pack8_bf16(v0, v1);
                            if (seg != 0) { float* o = out + OK_P + (size_t)(seg - 1) * (OV_P - OK_P) + (size_t)row * 512 + c; *(f32x4*)o = v0; *(f32x4*)(o + 4) = v1; }
                        } else {
                            const int db = row - MP;
                            if (seg == 0) { float* o = QS + (size_t)db * 512 + c; *(f32x4*)o = v0; *(f32x4*)(o + 4) = v1; }
                            else { float* o = out + OK_S + (size_t)(seg - 1) * (OV_S - OK_S) + (size_t)db * 512 + c; *(f32x4*)o = v0; *(f32x4*)(o + 4) = v1; }
                        }
                    } else if (pn < 12) {
                        const int c = col - 1536;
                        *(u32x4*)(CB + (size_t)row * CONVD + c) = pack8_bf16(v0, v1);
                        if (row < MP) {
                            const int t = row & 2047;
                            if (t >= SEQ - 3) { float* o = out + OCONV_P + ((size_t)(row >> 11) * 3 + (t - (SEQ - 3))) * CONVD + c; *(f32x4*)o = v0; *(f32x4*)(o + 4) = v1; }
                        } else {
                            float* o = out + OCONV_S + ((size_t)(row - MP) * 3 + 2) * CONVD + c; *(f32x4*)o = v0; *(f32x4*)(o + 4) = v1;
                        }
                    } else {
                        const int c = col - 3072;
                        *(u32x4*)(ZB + (size_t)row * 512 + c) = pack8_bf16(v0, v1);
                    }
                }
            }
    }
};

struct EpiRes {
    static constexpr bool PERM = true, AFTER_DRAIN = false;
    const float *xp, *xs; float* out; bf16_t* HB; float* SSQ;
    __device__ __forceinline__ void operator()(const f32x4 (&acc)[2][2][4][2], const Unit& u, int wr, int wc, int fr, int fq) const {
#pragma unroll
        for (int ai = 0; ai < 2; ++ai)
#pragma unroll
            for (int m = 0; m < 4; ++m) {
                const int row = u.pm * BM + ai * HALF + wr * 64 + m * 16 + fr;
                const bool ok = row < M_TOT;
                const float* xr = row < MP ? xp + (size_t)row * DM : xs + (size_t)(ok ? row - MP : 0) * DM;
                float* hr = row < MP ? out + OY_P + (size_t)row * DM : out + OY_S + (size_t)(ok ? row - MP : 0) * DM;
                float s = 0.f;
#pragma unroll
                for (int bj = 0; bj < 2; ++bj) {
                    const int col = u.pn * BM + bj * HALF + wc * 32 + 8 * fq;
                    if (ok) {
                        const f32x4 v0 = acc[ai][bj][m][0] + *(const f32x4*)(xr + col), v1 = acc[ai][bj][m][1] + *(const f32x4*)(xr + col + 4);
                        *(f32x4*)(hr + col) = v0; *(f32x4*)(hr + col + 4) = v1;
                        *(u32x4*)(HB + (size_t)row * DM + col) = pack8_bf16(v0, v1);
                        s += (v0[0] * v0[0] + v0[1] * v0[1]) + (v0[2] * v0[2] + v0[3] * v0[3]) + (v1[0] * v1[0] + v1[1] * v1[1]) + (v1[2] * v1[2] + v1[3] * v1[3]);
                    }
                }
                s += __shfl_xor(s, 16); s += __shfl_xor(s, 32);
                if (ok && fq == 0) SSQ[(size_t)row * 16 + u.pn * 4 + wc] = s;
            }
    }
};

struct EpiUp {
    static constexpr bool PERM = true, AFTER_DRAIN = false;
    bf16_t* UB; const float* SSQ;
    __device__ __forceinline__ void operator()(const f32x4 (&acc)[2][2][4][2], const Unit& u, int wr, int wc, int fr, int fq) const {
#pragma unroll
        for (int ai = 0; ai < 2; ++ai)
#pragma unroll
            for (int m = 0; m < 4; ++m) {
                const int row = u.pm * BM + ai * HALF + wr * 64 + m * 16 + fr;
                if (row >= M_TOT) continue;
                const f32x4* sp = (const f32x4*)(SSQ + (size_t)row * 16);
                const f32x4 a = sp[0], b = sp[1], c = sp[2], d = sp[3];
                const float ss = ((a[0] + a[1]) + (a[2] + a[3])) + ((b[0] + b[1]) + (b[2] + b[3])) + ((c[0] + c[1]) + (c[2] + c[3])) + ((d[0] + d[1]) + (d[2] + d[3]));
                const float rstd = 1.0f / sqrtf(ss * (1.0f / DM) + RMS_EPS);
#pragma unroll
                for (int bj = 0; bj < 2; ++bj) {
                    const int col = u.pn * BM + bj * HALF + wc * 32 + 8 * fq;
                    f32x4 v0 = acc[ai][bj][m][0] * rstd, v1 = acc[ai][bj][m][1] * rstd;
#pragma unroll
                    for (int j = 0; j < 4; ++j) { const float p = fmaxf(v0[j], 0.f), q = fmaxf(v1[j], 0.f); v0[j] = p * p; v1[j] = q * q; }
                    *(u32x4*)(UB + (size_t)row * FF + col) = pack8_bf16(v0, v1);
                }
            }
    }
};

struct EpiDown {
    static constexpr bool PERM = true, AFTER_DRAIN = false;
    float* out; float* SSQ2;
    __device__ __forceinline__ void operator()(const f32x4 (&acc)[2][2][4][2], const Unit& u, int wr, int wc, int fr, int fq) const {
#pragma unroll
        for (int ai = 0; ai < 2; ++ai)
#pragma unroll
            for (int m = 0; m < 4; ++m) {
                const int row = u.pm * BM + ai * HALF + wr * 64 + m * 16 + fr;
                const bool ok = row < M_TOT;
                float* hr = row < MP ? out + OY_P + (size_t)row * DM : out + OY_S + (size_t)(ok ? row - MP : 0) * DM;
                float s = 0.f;
#pragma unroll
                for (int bj = 0; bj < 2; ++bj) {
                    const int col = u.pn * BM + bj * HALF + wc * 32 + 8 * fq;
                    if (ok) {
                        const f32x4 v0 = acc[ai][bj][m][0] + *(const f32x4*)(hr + col), v1 = acc[ai][bj][m][1] + *(const f32x4*)(hr + col + 4);
                        *(f32x4*)(hr + col) = v0; *(f32x4*)(hr + col + 4) = v1;
                        s += (v0[0] * v0[0] + v0[1] * v0[1]) + (v0[2] * v0[2] + v0[3] * v0[3]) + (v1[0] * v1[0] + v1[1] * v1[1]) + (v1[2] * v1[2] + v1[3] * v1[3]);
                    }
                }
                s += __shfl_xor(s, 16); s += __shfl_xor(s, 32);
                if (ok && fq == 0) SSQ2[(size_t)row * 16 + u.pn * 4 + wc] = s;
            }
    }
};

template <class Epi, class Sched, bool ALIGN_EPI = false, bool SP2 = false>
__device__ __forceinline__ void gemm_phase(PG8_LAS unsigned char* lds, const Gemm g, const Sched& S, const Epi& E) {
    const int tid = threadIdx.x, wid = __builtin_amdgcn_readfirstlane(tid >> 6), lane = tid & 63, wr = wid >> 2, wc = wid & 3, fr = lane & 15, fq = lane >> 4;
    const int K = g.K, nt = K / BK;
    unsigned voffA[2], voffB[2];
#pragma unroll
    for (int i = 0; i < 2; ++i) { int R, C; stage_rc(tid * 16 + i * 8192, R, C); const int Rb = Epi::PERM ? ((R & ~31) + perm32(R & 31)) : R;
        voffA[i] = (unsigned)(R * K + C) * 2u; voffB[i] = (unsigned)(Rb * K + C) * 2u; }
    const size_t kstep = (size_t)(BK * 2);
    const size_t hstep = (size_t)HALF * K * 2;
    const size_t tstep = 2 * hstep;
    const unsigned ldsw = (unsigned)wid * 1024u;
    const int aoff = lds_byte(wr * 64 + fr, fq * 8), boff = lds_byte(wc * 32 + fr, fq * 8);
#define PG8_SA(b, h) (((b) * 2 + (h)) * HTB)
#define PG8_SB(b, h) ((4 + (b) * 2 + (h)) * HTB)
#define PG8_STAGE(bufoff, gbase, voff) do { _Pragma("unroll") for (int _i = 0; _i < 2; ++_i) \
        __builtin_amdgcn_global_load_lds((const unsigned*)((const char*)(gbase) + (voff)[_i]), (PG8_LAS unsigned*)(lds + (bufoff) + ldsw + _i * 8192), 16, 0, 0); } while (0)
#define PG8_LDA(dst, b, h) do { _Pragma("unroll") for (int m = 0; m < 4; ++m) _Pragma("unroll") for (int k = 0; k < 2; ++k) dst[m][k] = *(const PG8_LAS bf16x8*)(lds + PG8_SA(b, h) + aoff + m * 2048 + k * 1024); } while (0)
#define PG8_LDB(dst, b, h) do { _Pragma("unroll") for (int n = 0; n < 2; ++n) _Pragma("unroll") for (int k = 0; k < 2; ++k) dst[n][k] = *(const PG8_LAS bf16x8*)(lds + PG8_SB(b, h) + boff + n * 2048 + k * 1024); } while (0)
#define PG8_MMA(ai, bj, At, Bt) do { __builtin_amdgcn_s_setprio(1); _Pragma("unroll") for (int m = 0; m < 4; ++m) _Pragma("unroll") for (int n = 0; n < 2; ++n) _Pragma("unroll") for (int k = 0; k < 2; ++k) \
        acc[ai][bj][m][n] = __builtin_amdgcn_mfma_f32_16x16x32_bf16(Bt[n][k], At[m][k], acc[ai][bj][m][n], 0, 0, 0); __builtin_amdgcn_s_setprio(0); } while (0)
#define PG8_WAIT_V(n) asm volatile("s_waitcnt vmcnt(" #n ")" ::: "memory")
#define PG8_WAIT_L(n) asm volatile("s_waitcnt lgkmcnt(" #n ")" ::: "memory")
#define PG8_BAR __builtin_amdgcn_s_barrier()
#define PG8_SCHED __builtin_amdgcn_sched_barrier(0)
    Unit cur, nxt; int ui = 0;
    if (!S.next(0, cur)) return;
    f32x4 acc[2][2][4][2];
#pragma unroll
    for (int a = 0; a < 2; ++a)
#pragma unroll
        for (int b = 0; b < 2; ++b)
#pragma unroll
            for (int m = 0; m < 4; ++m)
#pragma unroll
                for (int n = 0; n < 2; ++n) acc[a][b][m][n] = (f32x4){0.f, 0.f, 0.f, 0.f};
    bf16x8 At[4][2], B0[2][2], B1[2][2];
    const char* cA = (const char*)g.A + (size_t)cur.pm * tstep; const char* cB = (const char*)g.Bt + (size_t)cur.pn * tstep;
    S.a_ready(cur);
    if constexpr (SP2) {
        PG8_STAGE(PG8_SB(0, 0), cB, voffB); PG8_STAGE(PG8_SB(0, 1), cB + hstep, voffB); PG8_STAGE(PG8_SA(0, 0), cA, voffA); PG8_STAGE(PG8_SA(0, 1), cA + hstep, voffA);
        if (wr == 1) PG8_BAR;
        PG8_WAIT_V(2); PG8_BAR;
        PG8_STAGE(PG8_SB(1, 0), cB + kstep, voffB); PG8_STAGE(PG8_SA(1, 0), cA + kstep, voffA); PG8_STAGE(PG8_SB(1, 1), cB + hstep + kstep, voffB);
        PG8_WAIT_V(6); PG8_BAR;
    } else {
        PG8_STAGE(PG8_SB(0, 0), cB, voffB); PG8_STAGE(PG8_SA(0, 0), cA, voffA); PG8_STAGE(PG8_SB(0, 1), cB + hstep, voffB); PG8_STAGE(PG8_SA(0, 1), cA + hstep, voffA);
        if (wr == 1) PG8_BAR;
        PG8_WAIT_V(4); PG8_BAR;
        PG8_STAGE(PG8_SB(1, 0), cB + kstep, voffB); PG8_STAGE(PG8_SA(1, 0), cA + kstep, voffA); PG8_STAGE(PG8_SB(1, 1), cB + hstep + kstep, voffB);
        PG8_WAIT_V(6); PG8_BAR;
    }
    for (;;) {
        const bool has_next = S.next(ui + 1, nxt);
        const char* nA = has_next ? (const char*)g.A + (size_t)nxt.pm * tstep : cA; const char* nB = has_next ? (const char*)g.Bt + (size_t)nxt.pn * tstep : cB;
        for (int t = 0; t < nt; t += 2) {
            const bool last = (t == nt - 2);
            const char* a1 = cA + (size_t)(t + 1) * kstep;
            const char* a2 = last ? nA : cA + (size_t)(t + 2) * kstep; const char* b2 = last ? nB : cB + (size_t)(t + 2) * kstep;
            const char* a3 = a2 + kstep; const char* b3 = b2 + kstep;
            if (last && has_next) S.a_ready(nxt);
            if constexpr (SP2) {
            PG8_LDB(B0, 0, 0); PG8_LDB(B1, 0, 1); PG8_SCHED; PG8_LDA(At, 0, 0); PG8_STAGE(PG8_SA(1, 1), a1 + hstep, voffA);
            PG8_WAIT_V(8); PG8_WAIT_L(0); PG8_BAR; PG8_MMA(0, 0, At, B0); PG8_MMA(0, 1, At, B1); PG8_BAR; PG8_SCHED;
            PG8_LDA(At, 0, 1); PG8_STAGE(PG8_SB(0, 0), b2, voffB); PG8_STAGE(PG8_SB(0, 1), b2 + hstep, voffB); PG8_STAGE(PG8_SA(0, 0), a2, voffA);
            PG8_WAIT_V(8); PG8_WAIT_L(0); PG8_BAR; PG8_MMA(1, 0, At, B0); PG8_MMA(1, 1, At, B1); PG8_BAR; PG8_SCHED;
            PG8_LDB(B0, 1, 0); PG8_LDB(B1, 1, 1); PG8_SCHED; PG8_LDA(At, 1, 0); PG8_STAGE(PG8_SA(0, 1), a2 + hstep, voffA);
            PG8_WAIT_V(8); PG8_WAIT_L(0); PG8_BAR; PG8_MMA(0, 0, At, B0); PG8_MMA(0, 1, At, B1); PG8_BAR; PG8_SCHED;
            PG8_LDA(At, 1, 1); PG8_STAGE(PG8_SB(1, 0), b3, voffB); PG8_STAGE(PG8_SB(1, 1), b3 + hstep, voffB); PG8_STAGE(PG8_SA(1, 0), a3, voffA);
            PG8_WAIT_V(8); PG8_WAIT_L(0); PG8_BAR; PG8_MMA(1, 0, At, B0); PG8_MMA(1, 1, At, B1); PG8_BAR; PG8_SCHED;
            } else {
            PG8_LDB(B0, 0, 0); PG8_SCHED; PG8_LDA(At, 0, 0); PG8_STAGE(PG8_SA(1, 1), a1 + hstep, voffA);
            PG8_WAIT_L(8); PG8_BAR; PG8_WAIT_L(0); PG8_MMA(0, 0, At, B0); PG8_BAR; PG8_SCHED;
            PG8_LDB(B1, 0, 1); PG8_STAGE(PG8_SB(0, 0), b2, voffB);
            PG8_BAR; PG8_WAIT_L(0); PG8_MMA(0, 1, At, B1); PG8_BAR;
            PG8_LDA(At, 0, 1); PG8_STAGE(PG8_SA(0, 0), a2, voffA);
            PG8_BAR; PG8_WAIT_L(0); PG8_MMA(1, 0, At, B0); PG8_BAR; PG8_SCHED;
            PG8_STAGE(PG8_SB(0, 1), b2 + hstep, voffB);
            PG8_WAIT_V(6); PG8_BAR; PG8_MMA(1, 1, At, B1); PG8_BAR;
            PG8_LDB(B0, 1, 0); PG8_SCHED; PG8_LDA(At, 1, 0); PG8_STAGE(PG8_SA(0, 1), a2 + hstep, voffA);
            PG8_WAIT_L(8); PG8_BAR; PG8_WAIT_L(0); PG8_MMA(0, 0, At, B0); PG8_BAR; PG8_SCHED;
            PG8_LDB(B1, 1, 1); PG8_STAGE(PG8_SB(1, 0), b3, voffB);
            PG8_BAR; PG8_WAIT_L(0); PG8_MMA(0, 1, At, B1); PG8_BAR;
            PG8_LDA(At, 1, 1); PG8_STAGE(PG8_SA(1, 0), a3, voffA);
            PG8_BAR; PG8_WAIT_L(0); PG8_MMA(1, 0, At, B0); PG8_BAR; PG8_SCHED;
            PG8_STAGE(PG8_SB(1, 1), b3 + hstep, voffB);
            PG8_WAIT_V(6); PG8_BAR; PG8_MMA(1, 1, At, B1); PG8_BAR;
            }
        }
        if constexpr (ALIGN_EPI) { if (wr == 0) PG8_BAR; }
        if constexpr (!Epi::AFTER_DRAIN) { E(acc, cur, wr, wc, fr, fq); S.done(cur); }
        if (!has_next) break;
#pragma unroll
        for (int a = 0; a < 2; ++a)
#pragma unroll
            for (int b = 0; b < 2; ++b)
#pragma unroll
                for (int m = 0; m < 4; ++m)
#pragma unroll
                    for (int n = 0; n < 2; ++n) acc[a][b][m][n] = (f32x4){0.f, 0.f, 0.f, 0.f};
        cur = nxt; cA = nA; cB = nB; ++ui;
        if constexpr (ALIGN_EPI) { if (wr == 1) PG8_BAR; }
    }
    PG8_WAIT_V(0);
    if constexpr (!ALIGN_EPI) { if (wr == 0) PG8_BAR; }
    PG8_BAR;
    if constexpr (Epi::AFTER_DRAIN) { E.fused(acc, cur, wr, wc, fr, fq, lds, wid, lane); S.done(cur); }
#undef PG8_SA
#undef PG8_SB
#undef PG8_STAGE
#undef PG8_LDA
#undef PG8_LDB
#undef PG8_MMA
#undef PG8_WAIT_V
#undef PG8_WAIT_L
#undef PG8_BAR
#undef PG8_SCHED
}
}

#define GAS __attribute__((address_space(1)))
#define LAS __attribute__((address_space(3)))
typedef unsigned short bf16;
typedef unsigned v4u __attribute__((ext_vector_type(4)));
typedef unsigned v2u __attribute__((ext_vector_type(2)));
typedef float f32x4 __attribute__((ext_vector_type(4)));
typedef float f32x2 __attribute__((ext_vector_type(2)));
typedef float f32x16 __attribute__((ext_vector_type(16)));
typedef short bf16x8 __attribute__((ext_vector_type(8)));
typedef short s16x4 __attribute__((ext_vector_type(4)));
#define LDS_WAIT() asm volatile("s_waitcnt lgkmcnt(0)" ::: "memory")
#define VM_WAIT() asm volatile("s_waitcnt vmcnt(0)" ::: "memory")
constexpr int NWAVES = 8;
constexpr int LDS_BYTES = 163840;
constexpr int MISC_OFF = 163840 - 256;

__device__ __forceinline__ unsigned f2bf(float f) { unsigned u = __builtin_bit_cast(unsigned, f); return (u + 0x7fffu + ((u >> 16) & 1u)) >> 16; }
__device__ __forceinline__ unsigned pk2(float lo, float hi) { return f2bf(lo) | (f2bf(hi) << 16); }
__device__ __forceinline__ float bf2f(unsigned short b) { return __builtin_bit_cast(float, ((unsigned)b) << 16); }
__device__ __forceinline__ float wave_sum(float v) {
#pragma unroll
    for (int o = 1; o < 64; o <<= 1) v += __shfl_xor(v, o);
    return v;
}
__device__ __forceinline__ float softplus_f(float x) { return fmaxf(x, 0.f) + log1pf(expf(-fabsf(x))); }
__device__ __forceinline__ float sigmoid_f(float x) { return 1.0f / (1.0f + expf(-x)); }
__device__ __forceinline__ float silu_f(float x) { return x / (1.0f + expf(-x)); }

struct Params {
    const float* in[20];
    float* out; unsigned char* ws;
    int ph_lo, ph_hi;
};
struct Ctx { int tid, lane, wave, vcu, G; };

#define XB_TMO      128
#define XB_XCNT(j)  (256  + 64 * (j))
#define XB_XSUB(j)  (1280 + 64 * (j))
#define XB_XGEN(j)  (2304 + 64 * (j))
#define XB_TOP      3328
#define XB_TOPGEN   3392
#define XCD_BAR_WORDS 3456
#define XB_SPIN_CAP (1u << 18)

__device__ __forceinline__ unsigned xb_ld(unsigned* p)              { return __hip_atomic_load(p, __ATOMIC_RELAXED, __HIP_MEMORY_SCOPE_AGENT); }
__device__ __forceinline__ unsigned xb_add(unsigned* p, unsigned v) { return __hip_atomic_fetch_add(p, v, __ATOMIC_RELAXED, __HIP_MEMORY_SCOPE_AGENT); }
__device__ __forceinline__ unsigned xb_xcc_id() { return (unsigned)__builtin_amdgcn_s_getreg((3 << 11) | 20) & 0xFu; }
#define XB_SPIN(cond, bar) do { unsigned _sp = 0; while (cond) { __builtin_amdgcn_s_sleep(1); \
    if ((++_sp & 255u) == 0u) { if (xb_ld(&(bar)[XB_TMO])) break; if (_sp > XB_SPIN_CAP) { atomicAdd(&(bar)[XB_TMO], 1u); break; } } } } while (0)

struct XcdBarrier {
    unsigned* bar; unsigned x;
    volatile LAS unsigned* st;
};

__device__ __forceinline__ XcdBarrier xcd_barrier_post(unsigned* bar, volatile LAS unsigned* st) {
    XcdBarrier b; b.bar = bar; b.x = xb_xcc_id(); b.st = st;
    if (threadIdx.x == 0) (void)xb_add(&bar[XB_XCNT(b.x)], 1u);
    return b;
}
__device__ __forceinline__ void xcd_barrier_complete(unsigned* bar, unsigned x, unsigned& nloc, unsigned& nx) {
    const unsigned G = gridDim.x * gridDim.y * gridDim.z;
    unsigned sum, cnt, mine, sp = 0u;
    for (;;) {
        sum = 0u; cnt = 0u; mine = 0u;
#pragma unroll
        for (unsigned j = 0; j < 16; ++j) { const unsigned c = xb_ld(&bar[XB_XCNT(j)]); sum += c; cnt += (c > 0u) ? 1u : 0u; mine = (j == x) ? c : mine; }
        if (sum == G) break;
        __builtin_amdgcn_s_sleep(1);
        if ((++sp & 255u) == 0u) { if (xb_ld(&bar[XB_TMO])) break; if (sp > XB_SPIN_CAP) { atomicAdd(&bar[XB_TMO], 1u); break; } }
    }
    nloc = mine > 0u ? mine : 1u; nx = cnt > 0u ? cnt : 1u;
}

__device__ __forceinline__ void xcd_barrier(const XcdBarrier& b) {
    asm volatile("s_waitcnt vmcnt(0)" ::: "memory");
    __syncthreads();
    if (threadIdx.x == 0) {
        unsigned* bar = b.bar;
        __builtin_amdgcn_s_waitcnt(0);
        unsigned nloc = b.st[0], nx = b.st[1];
        if (nloc == 0u) { xcd_barrier_complete(bar, b.x, nloc, nx); b.st[0] = nloc; b.st[1] = nx; }
        const unsigned old = xb_add(&bar[XB_XSUB(b.x)], 1u);
        const unsigned gen = old / nloc;
        if (old + 1u == (gen + 1u) * nloc) {
            __builtin_amdgcn_fence(__ATOMIC_RELEASE, "agent");
            asm volatile("s_waitcnt vmcnt(0)" ::: "memory");
            const unsigned og = xb_add(&bar[XB_TOP], 1u);
            const unsigned tg = og / nx;
            if (og + 1u == (tg + 1u) * nx) xb_add(&bar[XB_TOPGEN], 1u);
            else XB_SPIN(xb_ld(&bar[XB_TOPGEN]) == tg, bar);
            __builtin_amdgcn_fence(__ATOMIC_ACQUIRE, "agent");
            xb_add(&bar[XB_XGEN(b.x)], 1u);
            asm volatile("s_waitcnt vmcnt(0)" ::: "memory");
        } else {
            XB_SPIN(xb_ld(&bar[XB_XGEN(b.x)]) == gen, bar);
            __builtin_amdgcn_fence(__ATOMIC_ACQUIRE, "agent");
            asm volatile("s_waitcnt vmcnt(0)" ::: "memory");
        }
    }
    __syncthreads();
}

__device__ __forceinline__ void transpose_item(const float* W, int ldw, int c0, int K, int ncols, const float* scale, bf16* WT, int row_off, LAS float* scr, int item, int lane) {
    const int nblk = ncols / 32, kb = item / nblk, nb = item % nblk, k0 = 64 * kb, n0 = 32 * nb;
#pragma unroll 8
    for (int i = 0; i < 32; ++i) { const int kk = 2 * i + (lane >> 5); float w = W[(size_t)(k0 + kk) * ldw + c0 + n0 + (lane & 31)]; if (scale) w *= scale[k0 + kk]; scr[kk * 33 + (lane & 31)] = w; }
    LDS_WAIT(); asm volatile("" ::: "memory");
    const int c = lane & 7;
#pragma unroll
    for (int j = 0; j < 4; ++j) { const int n = (lane >> 3) + 8 * j; const LAS float* s = scr + (8 * c) * 33 + n;
        v4u o; o.x = pk2(s[0 * 33], s[1 * 33]); o.y = pk2(s[2 * 33], s[3 * 33]); o.z = pk2(s[4 * 33], s[5 * 33]); o.w = pk2(s[6 * 33], s[7 * 33]);
        *(GAS v4u*)(WT + (size_t)(row_off + n0 + n) * K + k0 + 8 * c) = o; }
    LDS_WAIT(); asm volatile("" ::: "memory");
}

__device__ __forceinline__ void phase_prep(const Params& P, const Ctx& C, LAS unsigned char* lds) {
    unsigned char* ws = P.ws;
    const float* xp = P.in[0]; const float* xs = P.in[1]; const float* ln1 = P.in[8]; const float* w_in = P.in[9]; const float* b_f = P.in[10];
    const float* a_log = P.in[12]; const float* dt_bias = P.in[13]; const float* w_o = P.in[15]; const float* ln2 = P.in[16]; const float* w_up = P.in[17]; const float* w_down = P.in[18];
    bf16* XN = (bf16*)(ws + WS_XN);
    float* LF = (float*)(ws + WS_LF); float* BETA = (float*)(ws + WS_BETA); float* Gg = (float*)(ws + WS_G);
    LAS float* WSm = (LAS float*)lds;
    LAS float* scr = (LAS float*)(lds + 49152 + C.wave * 8448);
    for (int idx = C.tid; idx < 12 * 1024; idx += NWAVES * 64) { const int k = idx / 12, c = idx % 12; const int col = c < 4 ? 1536 + c : 3588 + (c - 4); WSm[c * 1024 + k] = w_in[(size_t)k * INDIM + col]; }
    __syncthreads();
    const int gw = C.vcu * NWAVES + C.wave, NGW = C.G * NWAVES, lane = C.lane;
    f32x4 lw[4];
#pragma unroll
    for (int j = 0; j < 4; ++j) lw[j] = ((const f32x4*)ln1)[lane + 64 * j];
    for (int m = gw; m < M_TOT; m += NGW) {
        asm volatile("" ::: "memory");
        const float* xr = m < MP ? xp + (size_t)m * DM : xs + (size_t)(m - MP) * DM;
        f32x4 v[4]; float ss = 0.f;
#pragma unroll
        for (int j = 0; j < 4; ++j) { v[j] = ((const f32x4*)xr)[lane + 64 * j]; ss += (v[j][0] * v[j][0] + v[j][1] * v[j][1]) + (v[j][2] * v[j][2] + v[j][3] * v[j][3]); }
        ss = wave_sum(ss);
        const float rstd = 1.0f / sqrtf(ss * (1.0f / DM) + RMS_EPS);
#pragma unroll
        for (int j = 0; j < 4; ++j) { v[j] = v[j] * rstd * lw[j];
            v2u o; o.x = pk2(v[j][0], v[j][1]); o.y = pk2(v[j][2], v[j][3]);
            *(v2u*)(XN + (size_t)m * DM + 4 * lane + 256 * j) = o; }
        float mine = 0.f;
#pragma unroll
        for (int c = 0; c < 12; ++c) { float a = 0.f;
#pragma unroll
            for (int j = 0; j < 4; ++j) { const f32x4 w = *(const LAS f32x4*)(WSm + c * 1024 + 4 * lane + 256 * j); a += (v[j][0] * w[0] + v[j][1] * w[1]) + (v[j][2] * w[2] + v[j][3] * w[3]); }
            a = wave_sum(a); mine = (lane == c) ? a : mine; }
        const float bb = __shfl(mine, (lane + 4) & 63), aa = __shfl(mine, (lane + 8) & 63);
        if (lane < 4) {
            const float fa = mine;
            const float lf = -softplus_f(-(fa + b_f[lane]));
            const float beta = sigmoid_f(bb);
            const float g = -expf(a_log[lane]) * softplus_f(aa + dt_bias[lane]);
            LF[(size_t)m * 4 + lane] = lf; BETA[(size_t)m * 4 + lane] = beta; Gg[(size_t)m * 4 + lane] = g;
            if (m < MP) P.out[OLF_P + (size_t)m * 4 + lane] = lf; else P.out[OLF_S + (size_t)(m - MP) * 4 + lane] = lf;
        }
    }
    bf16* W1T = (bf16*)(ws + WS_W1T); bf16* WOT = (bf16*)(ws + WS_WOT); bf16* WUPT = (bf16*)(ws + WS_WUPT); bf16* WDNT = (bf16*)(ws + WS_WDNT);
    for (int it = gw; it < 16 * 48; it += NGW) transpose_item(w_in, INDIM, 0, DM, 1536, nullptr, W1T, 0, scr, it, lane);
    for (int it = gw; it < 16 * 48; it += NGW) transpose_item(w_in, INDIM, 1540, DM, 1536, nullptr, W1T, 1536, scr, it, lane);
    for (int it = gw; it < 16 * 16; it += NGW) transpose_item(w_in, INDIM, 3076, DM, 512, nullptr, W1T, 3072, scr, it, lane);
    for (int it = gw; it < 16 * 32; it += NGW) transpose_item(w_o, DM, 0, DM, DM, nullptr, WOT, 0, scr, it, lane);
    for (int it = gw; it < 16 * 128; it += NGW) transpose_item(w_up, FF, 0, DM, FF, ln2, WUPT, 0, scr, it, lane);
    for (int it = gw; it < 64 * 32; it += NGW) transpose_item(w_down, DM, 0, FF, DM, nullptr, WDNT, 0, scr, it, lane);
}

__device__ __forceinline__ void kbias_seq(const Params& P, int bh, int lane) {
    const float* LF = (const float*)(P.ws + WS_LF); float* KBIAS = (float*)(P.ws + WS_KBIAS);
    const int b = bh >> 2, h = bh & 3;
    const float* src = LF + ((size_t)b * SEQ + 32 * lane) * 4 + h;
    float s = 0.f;
    for (int i = 0; i < 32; ++i) s += src[i * 4];
    float x = s;
#pragma unroll
    for (int o = 1; o < 64; o <<= 1) { const float y = __shfl_up(x, o); if (lane >= o) x += y; }
    float run = x - s;
    float* dst = KBIAS + (size_t)bh * SEQ + 32 * lane;
    const float inv = -11.313708498984761f;
    for (int i = 0; i < 32; ++i) { run += src[i * 4]; dst[i] = run * inv; }
}


namespace fox {
constexpr int D = 128, NW = 8, QBLK = 32, KVBLK = 64, QB = NW * QBLK;
constexpr int SHM_V = KVBLK * D * 2, SHM_K = KVBLK * D * 2;
constexpr float SCALE = 0.08838834764831845f, THR = 8.f;
#define KSWZ(row, colB) ((row) * 256 + ((colB) ^ (((row) & 7) << 4)))
#define SBAR() __builtin_amdgcn_sched_barrier(0)
__device__ __forceinline__ int v_st(int k, int c) { const int kk = (k & ~0xC) | ((k & 4) << 1) | ((k & 8) >> 1); return ((kk >> 3) * 4 + (c >> 5)) * 512 + ((kk & 7) * 32 + (c & 31)) * 2; }
__device__ __forceinline__ int v_rd_base(int lane) { return ((lane & 3) << 3) | (((lane >> 2) & 3) << 6) | (((lane >> 4) & 1) << 5) | (((lane >> 5) & 1) << 8); }
constexpr int v_rd_off(int d0, int ks, int half) { return d0 * 512 + ks * 4096 + half * 2048; }
__device__ __forceinline__ int crow(int r, int hi) { return (r & 3) + 8 * (r >> 2) + 4 * hi; }
__device__ __forceinline__ unsigned cvtpk(float lo, float hi) { unsigned r; asm volatile("v_cvt_pk_bf16_f32 %0, %1, %2" : "=v"(r) : "v"(lo), "v"(hi)); return r; }
__device__ __forceinline__ void mask_tile(f32x16& p0, f32x16& p1, int dq, unsigned W) {
    const float NEG = -__builtin_inff();
#pragma unroll
    for (int r = 0; r < 16; ++r) {
        const int c = (r & 3) + 8 * (r >> 2);
        if ((unsigned)(dq - c) >= W) p0[r] = NEG;
        if ((unsigned)(dq - c - 32) >= W) p1[r] = NEG;
    }
}
__device__ __forceinline__ void partialSM(f32x16& p0, f32x16& p1, float& m_reg, float& mn, float& alpha) {
    float pmax = p0[0]; for (int r = 1; r < 16; ++r) pmax = fmaxf(pmax, p0[r]); for (int r = 0; r < 16; ++r) pmax = fmaxf(pmax, p1[r]);
    { auto rr = __builtin_amdgcn_permlane32_swap(__float_as_uint(pmax), __float_as_uint(pmax), false, false);
      pmax = fmaxf(__uint_as_float(rr[0]), __uint_as_float(rr[1])); }
    constexpr float C2 = 1.4426950408889634f * SCALE;
    if (__builtin_expect(__all((pmax - m_reg) * SCALE <= THR), 1)) { mn = m_reg; alpha = 1.f; }
    else { mn = fmaxf(m_reg, pmax); alpha = __builtin_amdgcn_exp2f((m_reg - mn) * C2); m_reg = mn; }
    const float mnL = -mn * C2;
    for (int r = 0; r < 16; ++r) p0[r] = fmaf(p0[r], C2, mnL); for (int r = 0; r < 16; ++r) p1[r] = fmaf(p1[r], C2, mnL);
    for (int r = 0; r < 16; ++r) p0[r] = __builtin_amdgcn_exp2f(p0[r]);
}
__device__ __forceinline__ void finishSM(f32x16& p0, f32x16& p1, float alpha, float& l_reg, bf16x8& pa0, bf16x8& pa1, bf16x8& pa2, bf16x8& pa3) {
    for (int r = 0; r < 16; ++r) p1[r] = __builtin_amdgcn_exp2f(p1[r]);
    float ps = 0; for (int r = 0; r < 16; ++r) ps += p0[r]; for (int r = 0; r < 16; ++r) ps += p1[r];
    { auto rr = __builtin_amdgcn_permlane32_swap(__float_as_uint(ps), __float_as_uint(ps), false, false);
      ps = __uint_as_float(rr[0]) + __uint_as_float(rr[1]); }
    l_reg = l_reg * alpha + ps;
#define PK4(P, B_, OUT) do { unsigned a0 = cvtpk(P[B_+0], P[B_+1]), a1 = cvtpk(P[B_+2], P[B_+3]);                          \
        unsigned b0 = cvtpk(P[B_+4], P[B_+5]), b1 = cvtpk(P[B_+6], P[B_+7]);                                             \
        auto r0 = __builtin_amdgcn_permlane32_swap(a0, b0, false, false); auto r1 = __builtin_amdgcn_permlane32_swap(a1, b1, false, false); \
        v4u w = {r0[0], r1[0], r0[1], r1[1]}; OUT = *reinterpret_cast<bf16x8*>(&w); } while (0)
    PK4(p0, 0, pa0); PK4(p0, 8, pa1); PK4(p1, 0, pa2); PK4(p1, 8, pa3);
#undef PK4
}
template <int KB>
__device__ __forceinline__ void qkt(f32x16& p0, f32x16& p1, const char* K_lds, const float* bias_l, int r32, int hi, const bf16x8* qr) {
#pragma unroll
    for (int g = 0; g < 4; ++g) { const f32x4 t0 = *(const f32x4*)(bias_l + 8 * g + 4 * hi), t1 = *(const f32x4*)(bias_l + 32 + 8 * g + 4 * hi);
#pragma unroll
        for (int i = 0; i < 4; ++i) { p0[4 * g + i] = t0[i]; p1[4 * g + i] = t1[i]; } }
    const char* kb[4];
#pragma unroll
    for (int dd = 0; dd < 4; ++dd) kb[dd] = K_lds + KB * SHM_K + KSWZ(r32, (dd * 16 + hi * 8) * 2);
#pragma unroll
    for (int d0 = 0; d0 < 8; ++d0) { const char* a = kb[d0 & 3] + (d0 >> 2) * 128;
        bf16x8 b0 = *reinterpret_cast<const bf16x8*>(a);
        bf16x8 b1 = *reinterpret_cast<const bf16x8*>(a + 32 * 256);
        p0 = __builtin_amdgcn_mfma_f32_32x32x16_bf16(b0, qr[d0], p0, 0, 0, 0);
        p1 = __builtin_amdgcn_mfma_f32_32x32x16_bf16(b1, qr[d0], p1, 0, 0, 0); }
}
template <int VB>
__device__ __forceinline__ void pv_tile(f32x16* o, int vb0, bf16x8 pa0, bf16x8 pa1, bf16x8 pa2, bf16x8 pa3) {
#define TRRD(dst, off) asm volatile("ds_read_b64_tr_b16 %0, %1 offset:%2" : "=&v"(dst) : "v"(vb0), "i"(off) : "memory")
#define PV_D0(d0) do { s16x4 l0, l1, l2, l3, h0, h1, h2, h3; constexpr int b_ = VB * SHM_V + v_rd_off(d0, 0, 0);   \
        TRRD(l0, b_); TRRD(h0, b_ + 2048); TRRD(l1, b_ + 4096); TRRD(h1, b_ + 6144); TRRD(l2, b_ + 8192); TRRD(h2, b_ + 10240); TRRD(l3, b_ + 12288); TRRD(h3, b_ + 14336); \
        asm volatile("s_waitcnt lgkmcnt(0)" ::: "memory"); SBAR();   \
        o[d0] = __builtin_amdgcn_mfma_f32_32x32x16_bf16(pa0, (bf16x8){l0[0], l0[1], l0[2], l0[3], h0[0], h0[1], h0[2], h0[3]}, o[d0], 0, 0, 0);   \
        o[d0] = __builtin_amdgcn_mfma_f32_32x32x16_bf16(pa1, (bf16x8){l1[0], l1[1], l1[2], l1[3], h1[0], h1[1], h1[2], h1[3]}, o[d0], 0, 0, 0);   \
        o[d0] = __builtin_amdgcn_mfma_f32_32x32x16_bf16(pa2, (bf16x8){l2[0], l2[1], l2[2], l2[3], h2[0], h2[1], h2[2], h2[3]}, o[d0], 0, 0, 0);   \
        o[d0] = __builtin_amdgcn_mfma_f32_32x32x16_bf16(pa3, (bf16x8){l3[0], l3[1], l3[2], l3[3], h3[0], h3[1], h3[2], h3[3]}, o[d0], 0, 0, 0); } while (0)
    PV_D0(0); PV_D0(1); PV_D0(2); PV_D0(3);
#undef PV_D0
#undef TRRD
}

__device__ __forceinline__ void fox_block(char* lds, const bf16* Qh, const bf16* Kh, const bf16* Vh, const float* kbias, bf16* Orow0, int qb) {
    const int tid = threadIdx.x, wid = __builtin_amdgcn_readfirstlane(tid >> 6), lane = tid & 63, r32 = lane & 31, hi = lane >> 5;
    const int P0 = qb * QB, qlo = P0 + wid * QBLK, qm = qlo + r32 - 4 * hi;
    char* V_lds = lds; char* K_lds = lds + SHM_V;
    float* bias_l = (float*)(lds + SHM_V + SHM_K);
    float* wsf = bias_l + 64 + wid * 64; float* li_l = wsf; float* al_l = wsf + 32;
    bf16x8 qr[8];
#pragma unroll
    for (int d0 = 0; d0 < 8; ++d0) qr[d0] = *reinterpret_cast<const bf16x8*>(Qh + (size_t)(qlo + r32) * D + d0 * 16 + hi * 8);
    float m_reg = -1e30f, l_reg = 0.f; f32x16 o[4] = {};
    const int sr = tid >> 4, sc = (tid & 15) * 8, vst0 = v_st(sr, sc), vst1 = v_st(32 + sr, sc), kws = KSWZ(sr, sc * 2);
    const int vb0 = (int)(uintptr_t)V_lds + v_rd_base(lane);
    const int ntiles = P0 / KVBLK + 4;
    for (int j = ntiles - 1; j >= 0; --j) {
        const int kb = j * KVBLK;
        __syncthreads();
        { const bf16x8 k0 = *reinterpret_cast<const bf16x8*>(Kh + (size_t)(kb + sr) * D + sc), k1 = *reinterpret_cast<const bf16x8*>(Kh + (size_t)(kb + 32 + sr) * D + sc);
          const bf16x8 v0 = *reinterpret_cast<const bf16x8*>(Vh + (size_t)(kb + sr) * D + sc), v1 = *reinterpret_cast<const bf16x8*>(Vh + (size_t)(kb + 32 + sr) * D + sc);
          *(bf16x8*)(K_lds + kws) = k0; *(bf16x8*)(K_lds + kws + 32 * 256) = k1; *(bf16x8*)(V_lds + vst0) = v0; *(bf16x8*)(V_lds + vst1) = v1;
          if (tid < 64) bias_l[tid] = kbias[kb + tid]; }
        __syncthreads();
        if (kb <= qlo + QBLK - 1) {
            f32x16 p0, p1; float mn, al; bf16x8 pa0, pa1, pa2, pa3;
            qkt<0>(p0, p1, K_lds, bias_l, r32, hi, qr);
            if (kb + KVBLK - 1 > qlo) mask_tile(p0, p1, qm - kb, 0x40000000u);
            partialSM(p0, p1, m_reg, mn, al);
            if (__any(al < 1.f)) { if (hi == 0) al_l[r32] = al; asm volatile("s_waitcnt lgkmcnt(0)" ::: "memory");
                for (int d_ = 0; d_ < 4; ++d_) for (int r = 0; r < 16; ++r) o[d_][r] *= al_l[crow(r, hi)]; }
            finishSM(p0, p1, al, l_reg, pa0, pa1, pa2, pa3); SBAR();
            pv_tile<0>(o, vb0, pa0, pa1, pa2, pa3);
        }
    }
    if (hi == 0) li_l[r32] = l_reg; asm volatile("s_waitcnt lgkmcnt(0)" ::: "memory");
    float rli[16];
#pragma unroll
    for (int r = 0; r < 16; ++r) rli[r] = __builtin_amdgcn_rcpf(li_l[crow(r, hi)]);
    bf16* Ow = Orow0 + (size_t)qlo * DM;
#pragma unroll
    for (int r = 0; r < 16; ++r) { const int orow = crow(r, hi);
#pragma unroll
        for (int d0 = 0; d0 < 4; ++d0) { const float v = o[d0][r] * rli[r];
            const float vn = __shfl_xor(v, 1);
            if ((r32 & 1) == 0) *(unsigned*)(Ow + (size_t)orow * DM + d0 * 32 + r32) = cvtpk(v, vn); } }
    __syncthreads();
}
}


__device__ __forceinline__ void dec_update(float& m, float& l, f32x4& acc, const float (&x)[4], const f32x4 (&v)[4], int n) {
    float mx = m;
#pragma unroll
    for (int u = 0; u < 4; ++u) if (u < n) mx = fmaxf(mx, x[u]);
    const float al = __expf(m - mx);
    float ps = 0.f; f32x4 a = acc * al;
#pragma unroll
    for (int u = 0; u < 4; ++u) if (u < n) { const float p = __expf(x[u] - mx); ps += p; a += v[u] * p; }
    l = l * al + ps; acc = a; m = mx;
}
__device__ __forceinline__ float red32(float s) {
#pragma unroll
    for (int o = 1; o < 32; o <<= 1) s += __shfl_xor(s, o);
    return s;
}
__device__ __forceinline__ void decode_unit(const Params& P, LAS unsigned char* lds, int db) {
    const int tid = threadIdx.x, wid = __builtin_amdgcn_readfirstlane(tid >> 6), lane = tid & 63, hi = lane >> 5;
    const float* cache_k = P.in[2]; const float* cache_v = P.in[3]; const float* cache_lf = P.in[4]; const int* page_table = (const int*)P.in[5];
    const float* LF = (const float*)(P.ws + WS_LF); const float* QS = (const float*)(P.ws + WS_QS);
    bf16* MIX = (bf16*)(P.ws + WS_MIX);
    LAS f32x4* lfs = (LAS f32x4*)lds;
    LAS f32x4* wt = lfs + 2048;
    LAS float* cm = (LAS float*)(wt + 8);
    LAS float* cl = cm + 32;
    LAS f32x4* cacc = (LAS f32x4*)(cl + 32);
    const int ptv = (lane < NPAGES) ? page_table[db * NPAGES + lane] : 0;
#pragma unroll
    for (int i = 0; i < 4; ++i) { const int j = tid + 512 * i; const int pg = __shfl(ptv, j >> 7);
        lfs[j] = *(const f32x4*)(cache_lf + ((size_t)pg * PAGE + (j & 127)) * 4); }
    __syncthreads();
    {
        const f32x4 a0 = lfs[4 * tid], a1 = lfs[4 * tid + 1], a2 = lfs[4 * tid + 2], a3 = lfs[4 * tid + 3];
        const f32x4 tot = (a0 + a1) + (a2 + a3);
        f32x4 x = tot;
#pragma unroll
        for (int o = 1; o < 64; o <<= 1) { f32x4 y; y[0] = __shfl_down(x[0], o); y[1] = __shfl_down(x[1], o); y[2] = __shfl_down(x[2], o); y[3] = __shfl_down(x[3], o); if (lane + o < 64) x += y; }
        if (lane == 0) wt[wid] = x;
        __syncthreads();
        f32x4 after = {0.f, 0.f, 0.f, 0.f};
        for (int w2 = wid + 1; w2 < NWAVES; ++w2) after += wt[w2];
        const f32x4 lfn = *(const f32x4*)(LF + (size_t)(MP + db) * 4);
        const f32x4 B3 = (x - tot) + after + lfn, B2 = B3 + a3, B1 = B2 + a2, B0 = B1 + a1;
        lfs[4 * tid] = B0; lfs[4 * tid + 1] = B1; lfs[4 * tid + 2] = B2; lfs[4 * tid + 3] = B3;
    }
    __syncthreads();
    const float* qs = QS + (size_t)db * 512;
    const f32x4 qa = *(const f32x4*)(qs + 4 * lane) * ATT_SCALE, qb = *(const f32x4*)(qs + 256 + 4 * lane) * ATT_SCALE;
    float m0 = -1e30f, l0 = 0.f, m1 = -1e30f, l1 = 0.f; f32x4 acc0 = {0.f, 0.f, 0.f, 0.f}, acc1 = {0.f, 0.f, 0.f, 0.f};
    for (int j0 = wid; j0 < PAST; j0 += 32) {
        f32x4 ka[4], kb[4], va[4], vb[4]; float x0[4], x1[4];
#pragma unroll
        for (int u = 0; u < 4; ++u) { const int j = j0 + 8 * u; const int pg = __builtin_amdgcn_readlane(ptv, j >> 7);
            const size_t ro = ((size_t)pg * PAGE + (j & 127)) * 512 + 4 * lane;
            ka[u] = *(const f32x4*)(cache_k + ro); kb[u] = *(const f32x4*)(cache_k + ro + 256);
            va[u] = *(const f32x4*)(cache_v + ro); vb[u] = *(const f32x4*)(cache_v + ro + 256); }
#pragma unroll
        for (int u = 0; u < 4; ++u) { const int j = j0 + 8 * u;
            float s0 = (qa[0] * ka[u][0] + qa[1] * ka[u][1]) + (qa[2] * ka[u][2] + qa[3] * ka[u][3]);
            float s1 = (qb[0] * kb[u][0] + qb[1] * kb[u][1]) + (qb[2] * kb[u][2] + qb[3] * kb[u][3]);
            s0 = red32(s0); s1 = red32(s1);
            const f32x4 bj = lfs[j];
            x0[u] = s0 + (hi ? bj[1] : bj[0]); x1[u] = s1 + (hi ? bj[3] : bj[2]); }
        dec_update(m0, l0, acc0, x0, va, 4); dec_update(m1, l1, acc1, x1, vb, 4);
    }
    if (wid == 0) {
        f32x4 va[4], vb[4]; float x0[4], x1[4];
        const float* kn = P.out + OK_S + (size_t)db * 512; const float* vn = P.out + OV_S + (size_t)db * 512;
        const f32x4 ka = *(const f32x4*)(kn + 4 * lane), kb = *(const f32x4*)(kn + 256 + 4 * lane);
        va[0] = *(const f32x4*)(vn + 4 * lane); vb[0] = *(const f32x4*)(vn + 256 + 4 * lane);
#pragma unroll
        for (int u = 1; u < 4; ++u) { va[u] = va[0]; vb[u] = vb[0]; }
        x0[0] = red32((qa[0] * ka[0] + qa[1] * ka[1]) + (qa[2] * ka[2] + qa[3] * ka[3]));
        x1[0] = red32((qb[0] * kb[0] + qb[1] * kb[1]) + (qb[2] * kb[2] + qb[3] * kb[3]));
#pragma unroll
        for (int u = 1; u < 4; ++u) { x0[u] = x0[0]; x1[u] = x1[0]; }
        dec_update(m0, l0, acc0, x0, va, 1); dec_update(m1, l1, acc1, x1, vb, 1);
    }
    if ((lane & 31) == 0) { cm[wid * 4 + hi] = m0; cm[wid * 4 + 2 + hi] = m1; cl[wid * 4 + hi] = l0; cl[wid * 4 + 2 + hi] = l1; }
    cacc[(wid * 2 + 0) * 64 + lane] = acc0; cacc[(wid * 2 + 1) * 64 + lane] = acc1;
    __syncthreads();
    if (tid < 128) {
        const int ab = tid >> 6, l = tid & 63, head = 2 * ab + (l >> 5);
        float M = -1e30f;
#pragma unroll
        for (int w = 0; w < NWAVES; ++w) M = fmaxf(M, cm[w * 4 + head]);
        float L = 0.f; f32x4 O = {0.f, 0.f, 0.f, 0.f};
#pragma unroll
        for (int w = 0; w < NWAVES; ++w) { const float e = __expf(cm[w * 4 + head] - M); L += cl[w * 4 + head] * e; O += cacc[(w * 2 + ab) * 64 + l] * e; }
        const float inv = 1.0f / L;
        v2u o; o.x = pk2(O[0] * inv, O[1] * inv); o.y = pk2(O[2] * inv, O[3] * inv);
        *(v2u*)(MIX + (size_t)(MP + db) * DM + head * 128 + 4 * (l & 31)) = o;
    }
    __syncthreads();
}

__device__ __forceinline__ void sgdn_unit(const Params& P, LAS unsigned char* lds, int db, int h) {
    const int tid = threadIdx.x, wid = __builtin_amdgcn_readfirstlane(tid >> 6), lane = tid & 63;
    const float* state_conv = P.in[6]; const float* state_ssm = P.in[7]; const float* w_conv = P.in[11]; const float* w_gnorm = P.in[14];
    const float* BETA = (const float*)(P.ws + WS_BETA); const float* Gg = (const float*)(P.ws + WS_G);
    const bf16* ZB = (const bf16*)(P.ws + WS_ZB); bf16* MIX = (bf16*)(P.ws + WS_MIX);
    LAS float* xs = (LAS float*)lds;
    LAS float* red1 = xs + 384;
    LAS float* red2 = red1 + 1024;
    LAS float* ov = red2 + 1024;
    if (tid < 384) {
        const int seg = tid >> 7, d = tid & 127, ch = seg * 512 + h * 128 + d;
        const float* sc = state_conv + (size_t)db * 3 * CONVD + ch;
        float* oc = P.out + OCONV_S + (size_t)db * 3 * CONVD + ch;
        const float c0 = sc[0], c1 = sc[CONVD], c2 = sc[2 * CONVD], c3 = oc[2 * CONVD];
        const float a = c0 * w_conv[ch] + c1 * w_conv[CONVD + ch] + c2 * w_conv[2 * CONVD + ch] + c3 * w_conv[3 * CONVD + ch];
        xs[tid] = silu_f(a);
        oc[0] = c1; oc[CONVD] = c2;
    }
    __syncthreads();
    if (wid < 2) {
        const float a = xs[wid * 128 + lane], b = xs[wid * 128 + 64 + lane];
        const float ss = wave_sum(a * a + b * b);
        const float sc = (1.0f / sqrtf(ss + L2_EPS)) * (wid == 0 ? ATT_SCALE : 1.0f);
        xs[wid * 128 + lane] = a * sc; xs[wid * 128 + 64 + lane] = b * sc;
    }
    __syncthreads();
    const float gsc = expf(Gg[(size_t)(MP + db) * 4 + h]), bt = BETA[(size_t)(MP + db) * 4 + h];
    const float* Sp = state_ssm + ((size_t)(db * 4 + h) * 128 + 16 * wid) * 128 + 2 * lane;
    f32x2 s[16]; f32x2 ks = {0.f, 0.f};
#pragma unroll
    for (int r = 0; r < 16; ++r) { s[r] = *(const f32x2*)(Sp + (size_t)r * 128) * gsc; const float kd = xs[128 + 16 * wid + r]; ks += s[r] * kd; }
    *(LAS f32x2*)(red1 + wid * 128 + 2 * lane) = ks;
    __syncthreads();
    f32x2 kS = {0.f, 0.f};
#pragma unroll
    for (int w = 0; w < NWAVES; ++w) kS += *(const LAS f32x2*)(red1 + w * 128 + 2 * lane);
    const f32x2 vv = *(const LAS f32x2*)(xs + 256 + 2 * lane);
    const f32x2 delta = (vv - kS) * bt;
    float* So = P.out + OSSM_S + ((size_t)(db * 4 + h) * 128 + 16 * wid) * 128 + 2 * lane;
    f32x2 os = {0.f, 0.f};
#pragma unroll
    for (int r = 0; r < 16; ++r) { const float kd = xs[128 + 16 * wid + r], qd = xs[16 * wid + r]; s[r] += delta * kd; *(f32x2*)(So + (size_t)r * 128) = s[r]; os += s[r] * qd; }
    *(LAS f32x2*)(red2 + wid * 128 + 2 * lane) = os;
    __syncthreads();
    if (tid < 128) { float o = 0.f;
#pragma unroll
        for (int w = 0; w < NWAVES; ++w) o += red2[w * 128 + tid];
        ov[tid] = o; }
    __syncthreads();
    if (wid == 0) {
        const float a = ov[lane], b = ov[64 + lane];
        const float ss = wave_sum(a * a + b * b);
        const float rstd = 1.0f / sqrtf(ss * (1.0f / 128.0f) + RMS_EPS);
        const bf16* zr = ZB + (size_t)(MP + db) * 512 + h * 128;
        bf16* mr = MIX + (size_t)(MP + db) * DM + 512 + h * 128;
        mr[lane] = (bf16)f2bf(a * rstd * w_gnorm[lane] * silu_f(bf2f(zr[lane])));
        mr[64 + lane] = (bf16)f2bf(b * rstd * w_gnorm[64 + lane] * silu_f(bf2f(zr[64 + lane])));
    }
    __syncthreads();
}


constexpr int XS = 132, LS = 68;
__device__ __forceinline__ void gdna_unit(const Params& P, LAS unsigned char* lds, int unit) {
    const int tid = threadIdx.x, wid = __builtin_amdgcn_readfirstlane(tid >> 6), lane = tid & 63;
    const int n = unit & 31, bh = unit >> 5, b = bh >> 2, h = bh & 3, m0 = b * SEQ + n * GCH;
    const float* w_conv = P.in[11];
    const bf16* CB = (const bf16*)(P.ws + WS_CB);
    const float* BETA = (const float*)(P.ws + WS_BETA); const float* Gg = (const float*)(P.ws + WS_G);
    float* UT = (float*)(P.ws + WS_UT) + (size_t)unit * 8192; bf16* WN = (bf16*)(P.ws + WS_WN) + (size_t)unit * 8192; bf16* QG = (bf16*)(P.ws + WS_QG) + (size_t)unit * 8192;
    bf16* KGT = (bf16*)(P.ws + WS_KGT) + (size_t)unit * 8192; bf16* QKM = (bf16*)(P.ws + WS_QKM) + (size_t)unit * 4096; float* GL = (float*)(P.ws + WS_GL);
    LAS float* XQ = (LAS float*)lds; LAS float* XK = XQ + 64 * XS; LAS float* XV = XK + 64 * XS;
    LAS float* Lm = XV + 64 * XS;
    LAS float* gcs = Lm + 64 * LS; LAS float* bts = gcs + 64; LAS float* sks = bts + 64;
    if (tid < 384) {
        const int seg = tid >> 7, d = tid & 127, ch = seg * 512 + h * 128 + d;
        const float w0 = w_conv[ch], w1 = w_conv[CONVD + ch], w2 = w_conv[2 * CONVD + ch], w3 = w_conv[3 * CONVD + ch];
        const bf16* src = CB + (size_t)m0 * CONVD + ch;
        float x0 = 0.f, x1 = 0.f, x2 = 0.f;
        if (n > 0) { x0 = bf2f(src[-3 * CONVD]); x1 = bf2f(src[-2 * CONVD]); x2 = bf2f(src[-1 * CONVD]); }
        LAS float* X = XQ + seg * 64 * XS + d;
#pragma unroll 4
        for (int i = 0; i < 64; ++i) { const float x3 = bf2f(src[(size_t)i * CONVD]); X[i * XS] = silu_f((x0 * w0 + x1 * w1) + (x2 * w2 + x3 * w3)); x0 = x1; x1 = x2; x2 = x3; }
    }
    if (wid == 7) {
        const float g = Gg[(size_t)(m0 + lane) * 4 + h]; float x = g;
#pragma unroll
        for (int o = 1; o < 64; o <<= 1) { const float y = __shfl_up(x, o); if (lane >= o) x += y; }
        { const float bt_ = BETA[(size_t)(m0 + lane) * 4 + h]; gcs[lane] = x; bts[lane] = bt_; sks[lane] = bt_ * expf(x); }
    }
    __syncthreads();
#pragma unroll
    for (int rr = 0; rr < 16; ++rr) { const int isq = rr < 8, i = 8 * wid + (rr & 7); LAS float* X = (isq ? XQ : XK) + i * XS;
        const float a = X[lane], c = X[64 + lane]; const float ss = wave_sum(a * a + c * c);
        const float sc = (1.0f / sqrtf(ss + L2_EPS)) * (isq ? ATT_SCALE : 1.0f);
        X[lane] = a * sc; X[64 + lane] = c * sc; }
    __syncthreads();
    {
        const int i = tid >> 3, tj = tid & 7;
        float akk[8], aqk[8];
#pragma unroll
        for (int jj = 0; jj < 8; ++jj) { akk[jj] = 0.f; aqk[jj] = 0.f; }
        if (tj * 8 <= i) {
            for (int d = 0; d < 128; d += 4) {
                const f32x4 ki = *(const LAS f32x4*)(XK + i * XS + d), qi = *(const LAS f32x4*)(XQ + i * XS + d);
#pragma unroll
                for (int jj = 0; jj < 8; ++jj) { const f32x4 kj = *(const LAS f32x4*)(XK + (tj * 8 + jj) * XS + d);
                    akk[jj] += (ki[0] * kj[0] + ki[1] * kj[1]) + (ki[2] * kj[2] + ki[3] * kj[3]);
                    aqk[jj] += (qi[0] * kj[0] + qi[1] * kj[1]) + (qi[2] * kj[2] + qi[3] * kj[3]); }
            }
        }
        const float gi = gcs[i], bi = bts[i];
        v4u qo; unsigned qw[4];
#pragma unroll
        for (int jj = 0; jj < 8; jj += 2) {
            float lv[2], qv[2];
#pragma unroll
            for (int e = 0; e < 2; ++e) { const int j = tj * 8 + jj + e; const float dec = (j <= i) ? expf(gi - gcs[j]) : 0.f;
                lv[e] = (j < i) ? bi * akk[jj + e] * dec : 0.f; qv[e] = (j <= i) ? aqk[jj + e] * dec : 0.f; }
            Lm[i * LS + tj * 8 + jj] = lv[0]; Lm[i * LS + tj * 8 + jj + 1] = lv[1];
            qw[jj >> 1] = pk2(qv[0], qv[1]);
        }
        qo.x = qw[0]; qo.y = qw[1]; qo.z = qw[2]; qo.w = qw[3];
        *(v4u*)(QKM + (size_t)i * 64 + tj * 8) = qo;
    }
    __syncthreads();
    if (tid < 256) {
        const int c = tid; const bool isv = c < 128; const LAS float* X = isv ? (XV + c) : (XK + (c - 128)); const LAS float* scp = isv ? bts : sks;
        int vz; asm volatile("v_mov_b32 %0, 0" : "=v"(vz));
        const LAS float* LmV = Lm + vz;
        float x0 = X[0] * scp[0];
        float rr1 = X[XS] * scp[1]; f32x4 L1_0 = *(const LAS f32x4*)(LmV + LS);
        asm volatile("" ::: "memory");
        const float rr2 = X[2 * XS] * scp[2]; const f32x4 L2_0 = *(const LAS f32x4*)(LmV + 2 * LS + 0);
        float x1; { float a0 = rr1, a1 = 0.f, a2 = 0.f, a3 = 0.f; a0 -= L1_0[0] * x0; x1 = (a0 + a1) + (a2 + a3); }
        asm volatile("" ::: "memory");
        const float rr3 = X[3 * XS] * scp[3]; const f32x4 L3_0 = *(const LAS f32x4*)(LmV + 3 * LS + 0);
        float x2; { float a0 = rr2, a1 = 0.f, a2 = 0.f, a3 = 0.f; a0 -= L2_0[0] * x0; a1 -= L2_0[1] * x1; x2 = (a0 + a1) + (a2 + a3); }
        asm volatile("" ::: "memory");
        const float rr4 = X[4 * XS] * scp[4]; const f32x4 L4_0 = *(const LAS f32x4*)(LmV + 4 * LS + 0);
        float x3; { float a0 = rr3, a1 = 0.f, a2 = 0.f, a3 = 0.f; a0 -= L3_0[0] * x0; a1 -= L3_0[1] * x1; a2 -= L3_0[2] * x2; x3 = (a0 + a1) + (a2 + a3); }
        asm volatile("" ::: "memory");
        const float rr5 = X[5 * XS] * scp[5]; const f32x4 L5_0 = *(const LAS f32x4*)(LmV + 5 * LS + 0); const f32x4 L5_1 = *(const LAS f32x4*)(LmV + 5 * LS + 4);
        float x4; { float a0 = rr4, a1 = 0.f, a2 = 0.f, a3 = 0.f; a0 -= L4_0[0] * x0; a1 -= L4_0[1] * x1; a2 -= L4_0[2] * x2; a3 -= L4_0[3] * x3; x4 = (a0 + a1) + (a2 + a3); }
        asm volatile("" ::: "memory");
        const float rr6 = X[6 * XS] * scp[6]; const f32x4 L6_0 = *(const LAS f32x4*)(LmV + 6 * LS + 0); const f32x4 L6_1 = *(const LAS f32x4*)(LmV + 6 * LS + 4);
        float x5; { float a0 = rr5, a1 = 0.f, a2 = 0.f, a3 = 0.f; a0 -= L5_0[0] * x0; a1 -= L5_0[1] * x1; a2 -= L5_0[2] * x2; a3 -= L5_0[3] * x3; a0 -= L5_1[0] * x4; x5 = (a0 + a1) + (a2 + a3); }
        asm volatile("" ::: "memory");
        const float rr7 = X[7 * XS] * scp[7]; const f32x4 L7_0 = *(const LAS f32x4*)(LmV + 7 * LS + 0); const f32x4 L7_1 = *(const LAS f32x4*)(LmV + 7 * LS + 4);
        float x6; { float a0 = rr6, a1 = 0.f, a2 = 0.f, a3 = 0.f; a0 -= L6_0[0] * x0; a1 -= L6_0[1] * x1; a2 -= L6_0[2] * x2; a3 -= L6_0[3] * x3; a0 -= L6_1[0] * x4; a1 -= L6_1[1] * x5; x6 = (a0 + a1) + (a2 + a3); }
        asm volatile("" ::: "memory");
        const float rr8 = X[8 * XS] * scp[8]; const f32x4 L8_0 = *(const LAS f32x4*)(LmV + 8 * LS + 0); const f32x4 L8_1 = *(const LAS f32x4*)(LmV + 8 * LS + 4);
        float x7; { float a0 = rr7, a1 = 0.f, a2 = 0.f, a3 = 0.f; a0 -= L7_0[0] * x0; a1 -= L7_0[1] * x1; a2 -= L7_0[2] * x2; a3 -= L7_0[3] * x3; a0 -= L7_1[0] * x4; a1 -= L7_1[1] * x5; a2 -= L7_1[2] * x6; x7 = (a0 + a1) + (a2 + a3); }
        asm volatile("" ::: "memory");
        const float rr9 = X[9 * XS] * scp[9]; const f32x4 L9_0 = *(const LAS f32x4*)(LmV + 9 * LS + 0); const f32x4 L9_1 = *(const LAS f32x4*)(LmV + 9 * LS + 4);
        float x8; { float a0 = rr8, a1 = 0.f, a2 = 0.f, a3 = 0.f; a0 -= L8_0[0] * x0; a1 -= L8_0[1] * x1; a2 -= L8_0[2] * x2; a3 -= L8_0[3] * x3; a0 -= L8_1[0] * x4; a1 -= L8_1[1] * x5; a2 -= L8_1[2] * x6; a3 -= L8_1[3] * x7; x8 = (a0 + a1) + (a2 + a3); }
        asm volatile("" ::: "memory");
        const float rr10 = X[10 * XS] * scp[10]; const f32x4 L10_0 = *(const LAS f32x4*)(LmV + 10 * LS + 0); const f32x4 L10_1 = *(const LAS f32x4*)(LmV + 10 * LS + 4); const f32x4 L9_2 = *(const LAS f32x4*)(LmV + 9 * LS + 8);
        float x9; { float a0 = rr9, a1 = 0.f, a2 = 0.f, a3 = 0.f; a0 -= L9_0[0] * x0; a1 -= L9_0[1] * x1; a2 -= L9_0[2] * x2; a3 -= L9_0[3] * x3; a0 -= L9_1[0] * x4; a1 -= L9_1[1] * x5; a2 -= L9_1[2] * x6; a3 -= L9_1[3] * x7; a0 -= L9_2[0] * x8; x9 = (a0 + a1) + (a2 + a3); }
        asm volatile("" ::: "memory");
        const float rr11 = X[11 * XS] * scp[11]; const f32x4 L11_0 = *(const LAS f32x4*)(LmV + 11 * LS + 0); const f32x4 L11_1 = *(const LAS f32x4*)(LmV + 11 * LS + 4); const f32x4 L10_2 = *(const LAS f32x4*)(LmV + 10 * LS + 8);
        float x10; { float a0 = rr10, a1 = 0.f, a2 = 0.f, a3 = 0.f; a0 -= L10_0[0] * x0; a1 -= L10_0[1] * x1; a2 -= L10_0[2] * x2; a3 -= L10_0[3] * x3; a0 -= L10_1[0] * x4; a1 -= L10_1[1] * x5; a2 -= L10_1[2] * x6; a3 -= L10_1[3] * x7; a0 -= L10_2[0] * x8; a1 -= L10_2[1] * x9; x10 = (a0 + a1) + (a2 + a3); }
        asm volatile("" ::: "memory");
        const float rr12 = X[12 * XS] * scp[12]; const f32x4 L12_0 = *(const LAS f32x4*)(LmV + 12 * LS + 0); const f32x4 L12_1 = *(const LAS f32x4*)(LmV + 12 * LS + 4); const f32x4 L11_2 = *(const LAS f32x4*)(LmV + 11 * LS + 8);
        float x11; { float a0 = rr11, a1 = 0.f, a2 = 0.f, a3 = 0.f; a0 -= L11_0[0] * x0; a1 -= L11_0[1] * x1; a2 -= L11_0[2] * x2; a3 -= L11_0[3] * x3; a0 -= L11_1[0] * x4; a1 -= L11_1[1] * x5; a2 -= L11_1[2] * x6; a3 -= L11_1[3] * x7; a0 -= L11_2[0] * x8; a1 -= L11_2[1] * x9; a2 -= L11_2[2] * x10; x11 = (a0 + a1) + (a2 + a3); }
        asm volatile("" ::: "memory");
        const float rr13 = X[13 * XS] * scp[13]; const f32x4 L13_0 = *(const LAS f32x4*)(LmV + 13 * LS + 0); const f32x4 L13_1 = *(const LAS f32x4*)(LmV + 13 * LS + 4); const f32x4 L12_2 = *(const LAS f32x4*)(LmV + 12 * LS + 8);
        float x12; { float a0 = rr12, a1 = 0.f, a2 = 0.f, a3 = 0.f; a0 -= L12_0[0] * x0; a1 -= L12_0[1] * x1; a2 -= L12_0[2] * x2; a3 -= L12_0[3] * x3; a0 -= L12_1[0] * x4; a1 -= L12_1[1] * x5; a2 -= L12_1[2] * x6; a3 -= L12_1[3] * x7; a0 -= L12_2[0] * x8; a1 -= L12_2[1] * x9; a2 -= L12_2[2] * x10; a3 -= L12_2[3] * x11; x12 = (a0 + a1) + (a2 + a3); }
        asm volatile("" ::: "memory");
        const float rr14 = X[14 * XS] * scp[14]; const f32x4 L14_0 = *(const LAS f32x4*)(LmV + 14 * LS + 0); const f32x4 L14_1 = *(const LAS f32x4*)(LmV + 14 * LS + 4); const f32x4 L13_2 = *(const LAS f32x4*)(LmV + 13 * LS + 8); const f32x4 L13_3 = *(const LAS f32x4*)(LmV + 13 * LS + 12);
        float x13; { float a0 = rr13, a1 = 0.f, a2 = 0.f, a3 = 0.f; a0 -= L13_0[0] * x0; a1 -= L13_0[1] * x1; a2 -= L13_0[2] * x2; a3 -= L13_0[3] * x3; a0 -= L13_1[0] * x4; a1 -= L13_1[1] * x5; a2 -= L13_1[2] * x6; a3 -= L13_1[3] * x7; a0 -= L13_2[0] * x8; a1 -= L13_2[1] * x9; a2 -= L13_2[2] * x10; a3 -= L13_2[3] * x11; a0 -= L13_3[0] * x12; x13 = (a0 + a1) + (a2 + a3); }
        asm volatile("" ::: "memory");
        const float rr15 = X[15 * XS] * scp[15]; const f32x4 L15_0 = *(const LAS f32x4*)(LmV + 15 * LS + 0); const f32x4 L15_1 = *(const LAS f32x4*)(LmV + 15 * LS + 4); const f32x4 L14_2 = *(const LAS f32x4*)(LmV + 14 * LS + 8); const f32x4 L14_3 = *(const LAS f32x4*)(LmV + 14 * LS + 12);
        float x14; { float a0 = rr14, a1 = 0.f, a2 = 0.f, a3 = 0.f; a0 -= L14_0[0] * x0; a1 -= L14_0[1] * x1; a2 -= L14_0[2] * x2; a3 -= L14_0[3] * x3; a0 -= L14_1[0] * x4; a1 -= L14_1[1] * x5; a2 -= L14_1[2] * x6; a3 -= L14_1[3] * x7; a0 -= L14_2[0] * x8; a1 -= L14_2[1] * x9; a2 -= L14_2[2] * x10; a3 -= L14_2[3] * x11; a0 -= L14_3[0] * x12; a1 -= L14_3[1] * x13; x14 = (a0 + a1) + (a2 + a3); }
        asm volatile("" ::: "memory");
        const float rr16 = X[16 * XS] * scp[16]; const f32x4 L16_0 = *(const LAS f32x4*)(LmV + 16 * LS + 0); const f32x4 L16_1 = *(const LAS f32x4*)(LmV + 16 * LS + 4); const f32x4 L15_2 = *(const LAS f32x4*)(LmV + 15 * LS + 8); const f32x4 L15_3 = *(const LAS f32x4*)(LmV + 15 * LS + 12);
        float x15; { float a0 = rr15, a1 = 0.f, a2 = 0.f, a3 = 0.f; a0 -= L15_0[0] * x0; a1 -= L15_0[1] * x1; a2 -= L15_0[2] * x2; a3 -= L15_0[3] * x3; a0 -= L15_1[0] * x4; a1 -= L15_1[1] * x5; a2 -= L15_1[2] * x6; a3 -= L15_1[3] * x7; a0 -= L15_2[0] * x8; a1 -= L15_2[1] * x9; a2 -= L15_2[2] * x10; a3 -= L15_2[3] * x11; a0 -= L15_3[0] * x12; a1 -= L15_3[1] * x13; a2 -= L15_3[2] * x14; x15 = (a0 + a1) + (a2 + a3); }
        asm volatile("" ::: "memory");
        const float rr17 = X[17 * XS] * scp[17]; const f32x4 L17_0 = *(const LAS f32x4*)(LmV + 17 * LS + 0); const f32x4 L17_1 = *(const LAS f32x4*)(LmV + 17 * LS + 4); const f32x4 L16_2 = *(const LAS f32x4*)(LmV + 16 * LS + 8); const f32x4 L16_3 = *(const LAS f32x4*)(LmV + 16 * LS + 12);
        float x16; { float a0 = rr16, a1 = 0.f, a2 = 0.f, a3 = 0.f; a0 -= L16_0[0] * x0; a1 -= L16_0[1] * x1; a2 -= L16_0[2] * x2; a3 -= L16_0[3] * x3; a0 -= L16_1[0] * x4; a1 -= L16_1[1] * x5; a2 -= L16_1[2] * x6; a3 -= L16_1[3] * x7; a0 -= L16_2[0] * x8; a1 -= L16_2[1] * x9; a2 -= L16_2[2] * x10; a3 -= L16_2[3] * x11; a0 -= L16_3[0] * x12; a1 -= L16_3[1] * x13; a2 -= L16_3[2] * x14; a3 -= L16_3[3] * x15; x16 = (a0 + a1) + (a2 + a3); }
        asm volatile("" ::: "memory");
        const float rr18 = X[18 * XS] * scp[18]; const f32x4 L18_0 = *(const LAS f32x4*)(LmV + 18 * LS + 0); const f32x4 L18_1 = *(const LAS f32x4*)(LmV + 18 * LS + 4); const f32x4 L17_2 = *(const LAS f32x4*)(LmV + 17 * LS + 8); const f32x4 L17_3 = *(const LAS f32x4*)(LmV + 17 * LS + 12); const f32x4 L17_4 = *(const LAS f32x4*)(LmV + 17 * LS + 16);
        float x17; { float a0 = rr17, a1 = 0.f, a2 = 0.f, a3 = 0.f; a0 -= L17_0[0] * x0; a1 -= L17_0[1] * x1; a2 -= L17_0[2] * x2; a3 -= L17_0[3] * x3; a0 -= L17_1[0] * x4; a1 -= L17_1[1] * x5; a2 -= L17_1[2] * x6; a3 -= L17_1[3] * x7; a0 -= L17_2[0] * x8; a1 -= L17_2[1] * x9; a2 -= L17_2[2] * x10; a3 -= L17_2[3] * x11; a0 -= L17_3[0] * x12; a1 -= L17_3[1] * x13; a2 -= L17_3[2] * x14; a3 -= L17_3[3] * x15; a0 -= L17_4[0] * x16; x17 = (a0 + a1) + (a2 + a3); }
        asm volatile("" ::: "memory");
        const float rr19 = X[19 * XS] * scp[19]; const f32x4 L19_0 = *(const LAS f32x4*)(LmV + 19 * LS + 0); const f32x4 L19_1 = *(const LAS f32x4*)(LmV + 19 * LS + 4); const f32x4 L18_2 = *(const LAS f32x4*)(LmV + 18 * LS + 8); const f32x4 L18_3 = *(const LAS f32x4*)(LmV + 18 * LS + 12); const f32x4 L18_4 = *(const LAS f32x4*)(LmV + 18 * LS + 16);
        float x18; { float a0 = rr18, a1 = 0.f, a2 = 0.f, a3 = 0.f; a0 -= L18_0[0] * x0; a1 -= L18_0[1] * x1; a2 -= L18_0[2] * x2; a3 -= L18_0[3] * x3; a0 -= L18_1[0] * x4; a1 -= L18_1[1] * x5; a2 -= L18_1[2] * x6; a3 -= L18_1[3] * x7; a0 -= L18_2[0] * x8; a1 -= L18_2[1] * x9; a2 -= L18_2[2] * x10; a3 -= L18_2[3] * x11; a0 -= L18_3[0] * x12; a1 -= L18_3[1] * x13; a2 -= L18_3[2] * x14; a3 -= L18_3[3] * x15; a0 -= L18_4[0] * x16; a1 -= L18_4[1] * x17; x18 = (a0 + a1) + (a2 + a3); }
        asm volatile("" ::: "memory");
        const float rr20 = X[20 * XS] * scp[20]; const f32x4 L20_0 = *(const LAS f32x4*)(LmV + 20 * LS + 0); const f32x4 L20_1 = *(const LAS f32x4*)(LmV + 20 * LS + 4); const f32x4 L19_2 = *(const LAS f32x4*)(LmV + 19 * LS + 8); const f32x4 L19_3 = *(const LAS f32x4*)(LmV + 19 * LS + 12); const f32x4 L19_4 = *(const LAS f32x4*)(LmV + 19 * LS + 16);
        float x19; { float a0 = rr19, a1 = 0.f, a2 = 0.f, a3 = 0.f; a0 -= L19_0[0] * x0; a1 -= L19_0[1] * x1; a2 -= L19_0[2] * x2; a3 -= L19_0[3] * x3; a0 -= L19_1[0] * x4; a1 -= L19_1[1] * x5; a2 -= L19_1[2] * x6; a3 -= L19_1[3] * x7; a0 -= L19_2[0] * x8; a1 -= L19_2[1] * x9; a2 -= L19_2[2] * x10; a3 -= L19_2[3] * x11; a0 -= L19_3[0] * x12; a1 -= L19_3[1] * x13; a2 -= L19_3[2] * x14; a3 -= L19_3[3] * x15; a0 -= L19_4[0] * x16; a1 -= L19_4[1] * x17; a2 -= L19_4[2] * x18; x19 = (a0 + a1) + (a2 + a3); }
        asm volatile("" ::: "memory");
        const float rr21 = X[21 * XS] * scp[21]; const f32x4 L21_0 = *(const LAS f32x4*)(LmV + 21 * LS + 0); const f32x4 L21_1 = *(const LAS f32x4*)(LmV + 21 * LS + 4); const f32x4 L20_2 = *(const LAS f32x4*)(LmV + 20 * LS + 8); const f32x4 L20_3 = *(const LAS f32x4*)(LmV + 20 * LS + 12); const f32x4 L20_4 = *(const LAS f32x4*)(LmV + 20 * LS + 16);
        float x20; { float a0 = rr20, a1 = 0.f, a2 = 0.f, a3 = 0.f; a0 -= L20_0[0] * x0; a1 -= L20_0[1] * x1; a2 -= L20_0[2] * x2; a3 -= L20_0[3] * x3; a0 -= L20_1[0] * x4; a1 -= L20_1[1] * x5; a2 -= L20_1[2] * x6; a3 -= L20_1[3] * x7; a0 -= L20_2[0] * x8; a1 -= L20_2[1] * x9; a2 -= L20_2[2] * x10; a3 -= L20_2[3] * x11; a0 -= L20_3[0] * x12; a1 -= L20_3[1] * x13; a2 -= L20_3[2] * x14; a3 -= L20_3[3] * x15; a0 -= L20_4[0] * x16; a1 -= L20_4[1] * x17; a2 -= L20_4[2] * x18; a3 -= L20_4[3] * x19; x20 = (a0 + a1) + (a2 + a3); }
        asm volatile("" ::: "memory");
        const float rr22 = X[22 * XS] * scp[22]; const f32x4 L22_0 = *(const LAS f32x4*)(LmV + 22 * LS + 0); const f32x4 L22_1 = *(const LAS f32x4*)(LmV + 22 * LS + 4); const f32x4 L21_2 = *(const LAS f32x4*)(LmV + 21 * LS + 8); const f32x4 L21_3 = *(const LAS f32x4*)(LmV + 21 * LS + 12); const f32x4 L21_4 = *(const LAS f32x4*)(LmV + 21 * LS + 16); const f32x4 L21_5 = *(const LAS f32x4*)(LmV + 21 * LS + 20);
        float x21; { float a0 = rr21, a1 = 0.f, a2 = 0.f, a3 = 0.f; a0 -= L21_0[0] * x0; a1 -= L21_0[1] * x1; a2 -= L21_0[2] * x2; a3 -= L21_0[3] * x3; a0 -= L21_1[0] * x4; a1 -= L21_1[1] * x5; a2 -= L21_1[2] * x6; a3 -= L21_1[3] * x7; a0 -= L21_2[0] * x8; a1 -= L21_2[1] * x9; a2 -= L21_2[2] * x10; a3 -= L21_2[3] * x11; a0 -= L21_3[0] * x12; a1 -= L21_3[1] * x13; a2 -= L21_3[2] * x14; a3 -= L21_3[3] * x15; a0 -= L21_4[0] * x16; a1 -= L21_4[1] * x17; a2 -= L21_4[2] * x18; a3 -= L21_4[3] * x19; a0 -= L21_5[0] * x20; x21 = (a0 + a1) + (a2 + a3); }
        asm volatile("" ::: "memory");
        const float rr23 = X[23 * XS] * scp[23]; const f32x4 L23_0 = *(const LAS f32x4*)(LmV + 23 * LS + 0); const f32x4 L23_1 = *(const LAS f32x4*)(LmV + 23 * LS + 4); const f32x4 L22_2 = *(const LAS f32x4*)(LmV + 22 * LS + 8); const f32x4 L22_3 = *(const LAS f32x4*)(LmV + 22 * LS + 12); const f32x4 L22_4 = *(const LAS f32x4*)(LmV + 22 * LS + 16); const f32x4 L22_5 = *(const LAS f32x4*)(LmV + 22 * LS + 20);
        float x22; { float a0 = rr22, a1 = 0.f, a2 = 0.f, a3 = 0.f; a0 -= L22_0[0] * x0; a1 -= L22_0[1] * x1; a2 -= L22_0[2] * x2; a3 -= L22_0[3] * x3; a0 -= L22_1[0] * x4; a1 -= L22_1[1] * x5; a2 -= L22_1[2] * x6; a3 -= L22_1[3] * x7; a0 -= L22_2[0] * x8; a1 -= L22_2[1] * x9; a2 -= L22_2[2] * x10; a3 -= L22_2[3] * x11; a0 -= L22_3[0] * x12; a1 -= L22_3[1] * x13; a2 -= L22_3[2] * x14; a3 -= L22_3[3] * x15; a0 -= L22_4[0] * x16; a1 -= L22_4[1] * x17; a2 -= L22_4[2] * x18; a3 -= L22_4[3] * x19; a0 -= L22_5[0] * x20; a1 -= L22_5[1] * x21; x22 = (a0 + a1) + (a2 + a3); }
        asm volatile("" ::: "memory");
        const float rr24 = X[24 * XS] * scp[24]; const f32x4 L24_0 = *(const LAS f32x4*)(LmV + 24 * LS + 0); const f32x4 L24_1 = *(const LAS f32x4*)(LmV + 24 * LS + 4); const f32x4 L23_2 = *(const LAS f32x4*)(LmV + 23 * LS + 8); const f32x4 L23_3 = *(const LAS f32x4*)(LmV + 23 * LS + 12); const f32x4 L23_4 = *(const LAS f32x4*)(LmV + 23 * LS + 16); const f32x4 L23_5 = *(const LAS f32x4*)(LmV + 23 * LS + 20);
        float x23; { float a0 = rr23, a1 = 0.f, a2 = 0.f, a3 = 0.f; a0 -= L23_0[0] * x0; a1 -= L23_0[1] * x1; a2 -= L23_0[2] * x2; a3 -= L23_0[3] * x3; a0 -= L23_1[0] * x4; a1 -= L23_1[1] * x5; a2 -= L23_1[2] * x6; a3 -= L23_1[3] * x7; a0 -= L23_2[0] * x8; a1 -= L23_2[1] * x9; a2 -= L23_2[2] * x10; a3 -= L23_2[3] * x11; a0 -= L23_3[0] * x12; a1 -= L23_3[1] * x13; a2 -= L23_3[2] * x14; a3 -= L23_3[3] * x15; a0 -= L23_4[0] * x16; a1 -= L23_4[1] * x17; a2 -= L23_4[2] * x18; a3 -= L23_4[3] * x19; a0 -= L23_5[0] * x20; a1 -= L23_5[1] * x21; a2 -= L23_5[2] * x22; x23 = (a0 + a1) + (a2 + a3); }
        asm volatile("" ::: "memory");
        const float rr25 = X[25 * XS] * scp[25]; const f32x4 L25_0 = *(const LAS f32x4*)(LmV + 25 * LS + 0); const f32x4 L25_1 = *(const LAS f32x4*)(LmV + 25 * LS + 4); const f32x4 L24_2 = *(const LAS f32x4*)(LmV + 24 * LS + 8); const f32x4 L24_3 = *(const LAS f32x4*)(LmV + 24 * LS + 12); const f32x4 L24_4 = *(const LAS f32x4*)(LmV + 24 * LS + 16); const f32x4 L24_5 = *(const LAS f32x4*)(LmV + 24 * LS + 20);
        float x24; { float a0 = rr24, a1 = 0.f, a2 = 0.f, a3 = 0.f; a0 -= L24_0[0] * x0; a1 -= L24_0[1] * x1; a2 -= L24_0[2] * x2; a3 -= L24_0[3] * x3; a0 -= L24_1[0] * x4; a1 -= L24_1[1] * x5; a2 -= L24_1[2] * x6; a3 -= L24_1[3] * x7; a0 -= L24_2[0] * x8; a1 -= L24_2[1] * x9; a2 -= L24_2[2] * x10; a3 -= L24_2[3] * x11; a0 -= L24_3[0] * x12; a1 -= L24_3[1] * x13; a2 -= L24_3[2] * x14; a3 -= L24_3[3] * x15; a0 -= L24_4[0] * x16; a1 -= L24_4[1] * x17; a2 -= L24_4[2] * x18; a3 -= L24_4[3] * x19; a0 -= L24_5[0] * x20; a1 -= L24_5[1] * x21; a2 -= L24_5[2] * x22; a3 -= L24_5[3] * x23; x24 = (a0 + a1) + (a2 + a3); }
        asm volatile("" ::: "memory");
        const float rr26 = X[26 * XS] * scp[26]; const f32x4 L26_0 = *(const LAS f32x4*)(LmV + 26 * LS + 0); const f32x4 L26_1 = *(const LAS f32x4*)(LmV + 26 * LS + 4); const f32x4 L25_2 = *(const LAS f32x4*)(LmV + 25 * LS + 8); const f32x4 L25_3 = *(const LAS f32x4*)(LmV + 25 * LS + 12); const f32x4 L25_4 = *(const LAS f32x4*)(LmV + 25 * LS + 16); const f32x4 L25_5 = *(const LAS f32x4*)(LmV + 25 * LS + 20); const f32x4 L25_6 = *(const LAS f32x4*)(LmV + 25 * LS + 24);
        float x25; { float a0 = rr25, a1 = 0.f, a2 = 0.f, a3 = 0.f; a0 -= L25_0[0] * x0; a1 -= L25_0[1] * x1; a2 -= L25_0[2] * x2; a3 -= L25_0[3] * x3; a0 -= L25_1[0] * x4; a1 -= L25_1[1] * x5; a2 -= L25_1[2] * x6; a3 -= L25_1[3] * x7; a0 -= L25_2[0] * x8; a1 -= L25_2[1] * x9; a2 -= L25_2[2] * x10; a3 -= L25_2[3] * x11; a0 -= L25_3[0] * x12; a1 -= L25_3[1] * x13; a2 -= L25_3[2] * x14; a3 -= L25_3[3] * x15; a0 -= L25_4[0] * x16; a1 -= L25_4[1] * x17; a2 -= L25_4[2] * x18; a3 -= L25_4[3] * x19; a0 -= L25_5[0] * x20; a1 -= L25_5[1] * x21; a2 -= L25_5[2] * x22; a3 -= L25_5[3] * x23; a0 -= L25_6[0] * x24; x25 = (a0 + a1) + (a2 + a3); }
        asm volatile("" ::: "memory");
        const float rr27 = X[27 * XS] * scp[27]; const f32x4 L27_0 = *(const LAS f32x4*)(LmV + 27 * LS + 0); const f32x4 L27_1 = *(const LAS f32x4*)(LmV + 27 * LS + 4); const f32x4 L26_2 = *(const LAS f32x4*)(LmV + 26 * LS + 8); const f32x4 L26_3 = *(const LAS f32x4*)(LmV + 26 * LS + 12); const f32x4 L26_4 = *(const LAS f32x4*)(LmV + 26 * LS + 16); const f32x4 L26_5 = *(const LAS f32x4*)(LmV + 26 * LS + 20); const f32x4 L26_6 = *(const LAS f32x4*)(LmV + 26 * LS + 24);
        float x26; { float a0 = rr26, a1 = 0.f, a2 = 0.f, a3 = 0.f; a0 -= L26_0[0] * x0; a1 -= L26_0[1] * x1; a2 -= L26_0[2] * x2; a3 -= L26_0[3] * x3; a0 -= L26_1[0] * x4; a1 -= L26_1[1] * x5; a2 -= L26_1[2] * x6; a3 -= L26_1[3] * x7; a0 -= L26_2[0] * x8; a1 -= L26_2[1] * x9; a2 -= L26_2[2] * x10; a3 -= L26_2[3] * x11; a0 -= L26_3[0] * x12; a1 -= L26_3[1] * x13; a2 -= L26_3[2] * x14; a3 -= L26_3[3] * x15; a0 -= L26_4[0] * x16; a1 -= L26_4[1] * x17; a2 -= L26_4[2] * x18; a3 -= L26_4[3] * x19; a0 -= L26_5[0] * x20; a1 -= L26_5[1] * x21; a2 -= L26_5[2] * x22; a3 -= L26_5[3] * x23; a0 -= L26_6[0] * x24; a1 -= L26_6[1] * x25; x26 = (a0 + a1) + (a2 + a3); }
        asm volatile("" ::: "memory");
        const float rr28 = X[28 * XS] * scp[28]; const f32x4 L28_0 = *(const LAS f32x4*)(LmV + 28 * LS + 0); const f32x4 L28_1 = *(const LAS f32x4*)(LmV + 28 * LS + 4); const f32x4 L27_2 = *(const LAS f32x4*)(LmV + 27 * LS + 8); const f32x4 L27_3 = *(const LAS f32x4*)(LmV + 27 * LS + 12); const f32x4 L27_4 = *(const LAS f32x4*)(LmV + 27 * LS + 16); const f32x4 L27_5 = *(const LAS f32x4*)(LmV + 27 * LS + 20); const f32x4 L27_6 = *(const LAS f32x4*)(LmV + 27 * LS + 24);
        float x27; { float a0 = rr27, a1 = 0.f, a2 = 0.f, a3 = 0.f; a0 -= L27_0[0] * x0; a1 -= L27_0[1] * x1; a2 -= L27_0[2] * x2; a3 -= L27_0[3] * x3; a0 -= L27_1[0] * x4; a1 -= L27_1[1] * x5; a2 -= L27_1[2] * x6; a3 -= L27_1[3] * x7; a0 -= L27_2[0] * x8; a1 -= L27_2[1] * x9; a2 -= L27_2[2] * x10; a3 -= L27_2[3] * x11; a0 -= L27_3[0] * x12; a1 -= L27_3[1] * x13; a2 -= L27_3[2] * x14; a3 -= L27_3[3] * x15; a0 -= L27_4[0] * x16; a1 -= L27_4[1] * x17; a2 -= L27_4[2] * x18; a3 -= L27_4[3] * x19; a0 -= L27_5[0] * x20; a1 -= L27_5[1] * x21; a2 -= L27_5[2] * x22; a3 -= L27_5[3] * x23; a0 -= L27_6[0] * x24; a1 -= L27_6[1] * x25; a2 -= L27_6[2] * x26; x27 = (a0 + a1) + (a2 + a3); }
        asm volatile("" ::: "memory");
        const float rr29 = X[29 * XS] * scp[29]; const f32x4 L29_0 = *(const LAS f32x4*)(LmV + 29 * LS + 0); const f32x4 L29_1 = *(const LAS f32x4*)(LmV + 29 * LS + 4); const f32x4 L28_2 = *(const LAS f32x4*)(LmV + 28 * LS + 8); const f32x4 L28_3 = *(const LAS f32x4*)(LmV + 28 * LS + 12); const f32x4 L28_4 = *(const LAS f32x4*)(LmV + 28 * LS + 16); const f32x4 L28_5 = *(const LAS f32x4*)(LmV + 28 * LS + 20); const f32x4 L28_6 = *(const LAS f32x4*)(LmV + 28 * LS + 24);
        float x28; { float a0 = rr28, a1 = 0.f, a2 = 0.f, a3 = 0.f; a0 -= L28_0[0] * x0; a1 -= L28_0[1] * x1; a2 -= L28_0[2] * x2; a3 -= L28_0[3] * x3; a0 -= L28_1[0] * x4; a1 -= L28_1[1] * x5; a2 -= L28_1[2] * x6; a3 -= L28_1[3] * x7; a0 -= L28_2[0] * x8; a1 -= L28_2[1] * x9; a2 -= L28_2[2] * x10; a3 -= L28_2[3] * x11; a0 -= L28_3[0] * x12; a1 -= L28_3[1] * x13; a2 -= L28_3[2] * x14; a3 -= L28_3[3] * x15; a0 -= L28_4[0] * x16; a1 -= L28_4[1] * x17; a2 -= L28_4[2] * x18; a3 -= L28_4[3] * x19; a0 -= L28_5[0] * x20; a1 -= L28_5[1] * x21; a2 -= L28_5[2] * x22; a3 -= L28_5[3] * x23; a0 -= L28_6[0] * x24; a1 -= L28_6[1] * x25; a2 -= L28_6[2] * x26; a3 -= L28_6[3] * x27; x28 = (a0 + a1) + (a2 + a3); }
        asm volatile("" ::: "memory");
        const float rr30 = X[30 * XS] * scp[30]; const f32x4 L30_0 = *(const LAS f32x4*)(LmV + 30 * LS + 0); const f32x4 L30_1 = *(const LAS f32x4*)(LmV + 30 * LS + 4); const f32x4 L29_2 = *(const LAS f32x4*)(LmV + 29 * LS + 8); const f32x4 L29_3 = *(const LAS f32x4*)(LmV + 29 * LS + 12); const f32x4 L29_4 = *(const LAS f32x4*)(LmV + 29 * LS + 16); const f32x4 L29_5 = *(const LAS f32x4*)(LmV + 29 * LS + 20); const f32x4 L29_6 = *(const LAS f32x4*)(LmV + 29 * LS + 24); const f32x4 L29_7 = *(const LAS f32x4*)(LmV + 29 * LS + 28);
        float x29; { float a0 = rr29, a1 = 0.f, a2 = 0.f, a3 = 0.f; a0 -= L29_0[0] * x0; a1 -= L29_0[1] * x1; a2 -= L29_0[2] * x2; a3 -= L29_0[3] * x3; a0 -= L29_1[0] * x4; a1 -= L29_1[1] * x5; a2 -= L29_1[2] * x6; a3 -= L29_1[3] * x7; a0 -= L29_2[0] * x8; a1 -= L29_2[1] * x9; a2 -= L29_2[2] * x10; a3 -= L29_2[3] * x11; a0 -= L29_3[0] * x12; a1 -= L29_3[1] * x13; a2 -= L29_3[2] * x14; a3 -= L29_3[3] * x15; a0 -= L29_4[0] * x16; a1 -= L29_4[1] * x17; a2 -= L29_4[2] * x18; a3 -= L29_4[3] * x19; a0 -= L29_5[0] * x20; a1 -= L29_5[1] * x21; a2 -= L29_5[2] * x22; a3 -= L29_5[3] * x23; a0 -= L29_6[0] * x24; a1 -= L29_6[1] * x25; a2 -= L29_6[2] * x26; a3 -= L29_6[3] * x27; a0 -= L29_7[0] * x28; x29 = (a0 + a1) + (a2 + a3); }
        asm volatile("" ::: "memory");
        const float rr31 = X[31 * XS] * scp[31]; const f32x4 L31_0 = *(const LAS f32x4*)(LmV + 31 * LS + 0); const f32x4 L31_1 = *(const LAS f32x4*)(LmV + 31 * LS + 4); const f32x4 L30_2 = *(const LAS f32x4*)(LmV + 30 * LS + 8); const f32x4 L30_3 = *(const LAS f32x4*)(LmV + 30 * LS + 12); const f32x4 L30_4 = *(const LAS f32x4*)(LmV + 30 * LS + 16); const f32x4 L30_5 = *(const LAS f32x4*)(LmV + 30 * LS + 20); const f32x4 L30_6 = *(const LAS f32x4*)(LmV + 30 * LS + 24); const f32x4 L30_7 = *(const LAS f32x4*)(LmV + 30 * LS + 28);
        float x30; { float a0 = rr30, a1 = 0.f, a2 = 0.f, a3 = 0.f; a0 -= L30_0[0] * x0; a1 -= L30_0[1] * x1; a2 -= L30_0[2] * x2; a3 -= L30_0[3] * x3; a0 -= L30_1[0] * x4; a1 -= L30_1[1] * x5; a2 -= L30_1[2] * x6; a3 -= L30_1[3] * x7; a0 -= L30_2[0] * x8; a1 -= L30_2[1] * x9; a2 -= L30_2[2] * x10; a3 -= L30_2[3] * x11; a0 -= L30_3[0] * x12; a1 -= L30_3[1] * x13; a2 -= L30_3[2] * x14; a3 -= L30_3[3] * x15; a0 -= L30_4[0] * x16; a1 -= L30_4[1] * x17; a2 -= L30_4[2] * x18; a3 -= L30_4[3] * x19; a0 -= L30_5[0] * x20; a1 -= L30_5[1] * x21; a2 -= L30_5[2] * x22; a3 -= L30_5[3] * x23; a0 -= L30_6[0] * x24; a1 -= L30_6[1] * x25; a2 -= L30_6[2] * x26; a3 -= L30_6[3] * x27; a0 -= L30_7[0] * x28; a1 -= L30_7[1] * x29; x30 = (a0 + a1) + (a2 + a3); }
        asm volatile("" ::: "memory");
        const float rr32 = X[32 * XS] * scp[32]; const f32x4 L32_0 = *(const LAS f32x4*)(LmV + 32 * LS + 0); const f32x4 L32_1 = *(const LAS f32x4*)(LmV + 32 * LS + 4); const f32x4 L31_2 = *(const LAS f32x4*)(LmV + 31 * LS + 8); const f32x4 L31_3 = *(const LAS f32x4*)(LmV + 31 * LS + 12); const f32x4 L31_4 = *(const LAS f32x4*)(LmV + 31 * LS + 16); const f32x4 L31_5 = *(const LAS f32x4*)(LmV + 31 * LS + 20); const f32x4 L31_6 = *(const LAS f32x4*)(LmV + 31 * LS + 24); const f32x4 L31_7 = *(const LAS f32x4*)(LmV + 31 * LS + 28);
        float x31; { float a0 = rr31, a1 = 0.f, a2 = 0.f, a3 = 0.f; a0 -= L31_0[0] * x0; a1 -= L31_0[1] * x1; a2 -= L31_0[2] * x2; a3 -= L31_0[3] * x3; a0 -= L31_1[0] * x4; a1 -= L31_1[1] * x5; a2 -= L31_1[2] * x6; a3 -= L31_1[3] * x7; a0 -= L31_2[0] * x8; a1 -= L31_2[1] * x9; a2 -= L31_2[2] * x10; a3 -= L31_2[3] * x11; a0 -= L31_3[0] * x12; a1 -= L31_3[1] * x13; a2 -= L31_3[2] * x14; a3 -= L31_3[3] * x15; a0 -= L31_4[0] * x16; a1 -= L31_4[1] * x17; a2 -= L31_4[2] * x18; a3 -= L31_4[3] * x19; a0 -= L31_5[0] * x20; a1 -= L31_5[1] * x21; a2 -= L31_5[2] * x22; a3 -= L31_5[3] * x23; a0 -= L31_6[0] * x24; a1 -= L31_6[1] * x25; a2 -= L31_6[2] * x26; a3 -= L31_6[3] * x27; a0 -= L31_7[0] * x28; a1 -= L31_7[1] * x29; a2 -= L31_7[2] * x30; x31 = (a0 + a1) + (a2 + a3); }
        asm volatile("" ::: "memory");
        const float rr33 = X[33 * XS] * scp[33]; const f32x4 L33_0 = *(const LAS f32x4*)(LmV + 33 * LS + 0); const f32x4 L33_1 = *(const LAS f32x4*)(LmV + 33 * LS + 4); const f32x4 L32_2 = *(const LAS f32x4*)(LmV + 32 * LS + 8); const f32x4 L32_3 = *(const LAS f32x4*)(LmV + 32 * LS + 12); const f32x4 L32_4 = *(const LAS f32x4*)(LmV + 32 * LS + 16); const f32x4 L32_5 = *(const LAS f32x4*)(LmV + 32 * LS + 20); const f32x4 L32_6 = *(const LAS f32x4*)(LmV + 32 * LS + 24); const f32x4 L32_7 = *(const LAS f32x4*)(LmV + 32 * LS + 28);
        float x32; { float a0 = rr32, a1 = 0.f, a2 = 0.f, a3 = 0.f; a0 -= L32_0[0] * x0; a1 -= L32_0[1] * x1; a2 -= L32_0[2] * x2; a3 -= L32_0[3] * x3; a0 -= L32_1[0] * x4; a1 -= L32_1[1] * x5; a2 -= L32_1[2] * x6; a3 -= L32_1[3] * x7; a0 -= L32_2[0] * x8; a1 -= L32_2[1] * x9; a2 -= L32_2[2] * x10; a3 -= L32_2[3] * x11; a0 -= L32_3[0] * x12; a1 -= L32_3[1] * x13; a2 -= L32_3[2] * x14; a3 -= L32_3[3] * x15; a0 -= L32_4[0] * x16; a1 -= L32_4[1] * x17; a2 -= L32_4[2] * x18; a3 -= L32_4[3] * x19; a0 -= L32_5[0] * x20; a1 -= L32_5[1] * x21; a2 -= L32_5[2] * x22; a3 -= L32_5[3] * x23; a0 -= L32_6[0] * x24; a1 -= L32_6[1] * x25; a2 -= L32_6[2] * x26; a3 -= L32_6[3] * x27; a0 -= L32_7[0] * x28; a1 -= L32_7[1] * x29; a2 -= L32_7[2] * x30; a3 -= L32_7[3] * x31; x32 = (a0 + a1) + (a2 + a3); }
        asm volatile("" ::: "memory");
        const float rr34 = X[34 * XS] * scp[34]; const f32x4 L34_0 = *(const LAS f32x4*)(LmV + 34 * LS + 0); const f32x4 L34_1 = *(const LAS f32x4*)(LmV + 34 * LS + 4); const f32x4 L33_2 = *(const LAS f32x4*)(LmV + 33 * LS + 8); const f32x4 L33_3 = *(const LAS f32x4*)(LmV + 33 * LS + 12); const f32x4 L33_4 = *(const LAS f32x4*)(LmV + 33 * LS + 16); const f32x4 L33_5 = *(const LAS f32x4*)(LmV + 33 * LS + 20); const f32x4 L33_6 = *(const LAS f32x4*)(LmV + 33 * LS + 24); const f32x4 L33_7 = *(const LAS f32x4*)(LmV + 33 * LS + 28); const f32x4 L33_8 = *(const LAS f32x4*)(LmV + 33 * LS + 32);
        float x33; { float a0 = rr33, a1 = 0.f, a2 = 0.f, a3 = 0.f; a0 -= L33_0[0] * x0; a1 -= L33_0[1] * x1; a2 -= L33_0[2] * x2; a3 -= L33_0[3] * x3; a0 -= L33_1[0] * x4; a1 -= L33_1[1] * x5; a2 -= L33_1[2] * x6; a3 -= L33_1[3] * x7; a0 -= L33_2[0] * x8; a1 -= L33_2[1] * x9; a2 -= L33_2[2] * x10; a3 -= L33_2[3] * x11; a0 -= L33_3[0] * x12; a1 -= L33_3[1] * x13; a2 -= L33_3[2] * x14; a3 -= L33_3[3] * x15; a0 -= L33_4[0] * x16; a1 -= L33_4[1] * x17; a2 -= L33_4[2] * x18; a3 -= L33_4[3] * x19; a0 -= L33_5[0] * x20; a1 -= L33_5[1] * x21; a2 -= L33_5[2] * x22; a3 -= L33_5[3] * x23; a0 -= L33_6[0] * x24; a1 -= L33_6[1] * x25; a2 -= L33_6[2] * x26; a3 -= L33_6[3] * x27; a0 -= L33_7[0] * x28; a1 -= L33_7[1] * x29; a2 -= L33_7[2] * x30; a3 -= L33_7[3] * x31; a0 -= L33_8[0] * x32; x33 = (a0 + a1) + (a2 + a3); }
        asm volatile("" ::: "memory");
        const float rr35 = X[35 * XS] * scp[35]; const f32x4 L35_0 = *(const LAS f32x4*)(LmV + 35 * LS + 0); const f32x4 L35_1 = *(const LAS f32x4*)(LmV + 35 * LS + 4); const f32x4 L34_2 = *(const LAS f32x4*)(LmV + 34 * LS + 8); const f32x4 L34_3 = *(const LAS f32x4*)(LmV + 34 * LS + 12); const f32x4 L34_4 = *(const LAS f32x4*)(LmV + 34 * LS + 16); const f32x4 L34_5 = *(const LAS f32x4*)(LmV + 34 * LS + 20); const f32x4 L34_6 = *(const LAS f32x4*)(LmV + 34 * LS + 24); const f32x4 L34_7 = *(const LAS f32x4*)(LmV + 34 * LS + 28); const f32x4 L34_8 = *(const LAS f32x4*)(LmV + 34 * LS + 32);
        float x34; { float a0 = rr34, a1 = 0.f, a2 = 0.f, a3 = 0.f; a0 -= L34_0[0] * x0; a1 -= L34_0[1] * x1; a2 -= L34_0[2] * x2; a3 -= L34_0[3] * x3; a0 -= L34_1[0] * x4; a1 -= L34_1[1] * x5; a2 -= L34_1[2] * x6; a3 -= L34_1[3] * x7; a0 -= L34_2[0] * x8; a1 -= L34_2[1] * x9; a2 -= L34_2[2] * x10; a3 -= L34_2[3] * x11; a0 -= L34_3[0] * x12; a1 -= L34_3[1] * x13; a2 -= L34_3[2] * x14; a3 -= L34_3[3] * x15; a0 -= L34_4[0] * x16; a1 -= L34_4[1] * x17; a2 -= L34_4[2] * x18; a3 -= L34_4[3] * x19; a0 -= L34_5[0] * x20; a1 -= L34_5[1] * x21; a2 -= L34_5[2] * x22; a3 -= L34_5[3] * x23; a0 -= L34_6[0] * x24; a1 -= L34_6[1] * x25; a2 -= L34_6[2] * x26; a3 -= L34_6[3] * x27; a0 -= L34_7[0] * x28; a1 -= L34_7[1] * x29; a2 -= L34_7[2] * x30; a3 -= L34_7[3] * x31; a0 -= L34_8[0] * x32; a1 -= L34_8[1] * x33; x34 = (a0 + a1) + (a2 + a3); }
        asm volatile("" ::: "memory");
        const float rr36 = X[36 * XS] * scp[36]; const f32x4 L36_0 = *(const LAS f32x4*)(LmV + 36 * LS + 0); const f32x4 L36_1 = *(const LAS f32x4*)(LmV + 36 * LS + 4); const f32x4 L35_2 = *(const LAS f32x4*)(LmV + 35 * LS + 8); const f32x4 L35_3 = *(const LAS f32x4*)(LmV + 35 * LS + 12); const f32x4 L35_4 = *(const LAS f32x4*)(LmV + 35 * LS + 16); const f32x4 L35_5 = *(const LAS f32x4*)(LmV + 35 * LS + 20); const f32x4 L35_6 = *(const LAS f32x4*)(LmV + 35 * LS + 24); const f32x4 L35_7 = *(const LAS f32x4*)(LmV + 35 * LS + 28); const f32x4 L35_8 = *(const LAS f32x4*)(LmV + 35 * LS + 32);
        float x35; { float a0 = rr35, a1 = 0.f, a2 = 0.f, a3 = 0.f; a0 -= L35_0[0] * x0; a1 -= L35_0[1] * x1; a2 -= L35_0[2] * x2; a3 -= L35_0[3] * x3; a0 -= L35_1[0] * x4; a1 -= L35_1[1] * x5; a2 -= L35_1[2] * x6; a3 -= L35_1[3] * x7; a0 -= L35_2[0] * x8; a1 -= L35_2[1] * x9; a2 -= L35_2[2] * x10; a3 -= L35_2[3] * x11; a0 -= L35_3[0] * x12; a1 -= L35_3[1] * x13; a2 -= L35_3[2] * x14; a3 -= L35_3[3] * x15; a0 -= L35_4[0] * x16; a1 -= L35_4[1] * x17; a2 -= L35_4[2] * x18; a3 -= L35_4[3] * x19; a0 -= L35_5[0] * x20; a1 -= L35_5[1] * x21; a2 -= L35_5[2] * x22; a3 -= L35_5[3] * x23; a0 -= L35_6[0] * x24; a1 -= L35_6[1] * x25; a2 -= L35_6[2] * x26; a3 -= L35_6[3] * x27; a0 -= L35_7[0] * x28; a1 -= L35_7[1] * x29; a2 -= L35_7[2] * x30; a3 -= L35_7[3] * x31; a0 -= L35_8[0] * x32; a1 -= L35_8[1] * x33; a2 -= L35_8[2] * x34; x35 = (a0 + a1) + (a2 + a3); }
        asm volatile("" ::: "memory");
        const float rr37 = X[37 * XS] * scp[37]; const f32x4 L37_0 = *(const LAS f32x4*)(LmV + 37 * LS + 0); const f32x4 L37_1 = *(const LAS f32x4*)(LmV + 37 * LS + 4); const f32x4 L36_2 = *(const LAS f32x4*)(LmV + 36 * LS + 8); const f32x4 L36_3 = *(const LAS f32x4*)(LmV + 36 * LS + 12); const f32x4 L36_4 = *(const LAS f32x4*)(LmV + 36 * LS + 16); const f32x4 L36_5 = *(const LAS f32x4*)(LmV + 36 * LS + 20); const f32x4 L36_6 = *(const LAS f32x4*)(LmV + 36 * LS + 24); const f32x4 L36_7 = *(const LAS f32x4*)(LmV + 36 * LS + 28); const f32x4 L36_8 = *(const LAS f32x4*)(LmV + 36 * LS + 32);
        float x36; { float a0 = rr36, a1 = 0.f, a2 = 0.f, a3 = 0.f; a0 -= L36_0[0] * x0; a1 -= L36_0[1] * x1; a2 -= L36_0[2] * x2; a3 -= L36_0[3] * x3; a0 -= L36_1[0] * x4; a1 -= L36_1[1] * x5; a2 -= L36_1[2] * x6; a3 -= L36_1[3] * x7; a0 -= L36_2[0] * x8; a1 -= L36_2[1] * x9; a2 -= L36_2[2] * x10; a3 -= L36_2[3] * x11; a0 -= L36_3[0] * x12; a1 -= L36_3[1] * x13; a2 -= L36_3[2] * x14; a3 -= L36_3[3] * x15; a0 -= L36_4[0] * x16; a1 -= L36_4[1] * x17; a2 -= L36_4[2] * x18; a3 -= L36_4[3] * x19; a0 -= L36_5[0] * x20; a1 -= L36_5[1] * x21; a2 -= L36_5[2] * x22; a3 -= L36_5[3] * x23; a0 -= L36_6[0] * x24; a1 -= L36_6[1] * x25; a2 -= L36_6[2] * x26; a3 -= L36_6[3] * x27; a0 -= L36_7[0] * x28; a1 -= L36_7[1] * x29; a2 -= L36_7[2] * x30; a3 -= L36_7[3] * x31; a0 -= L36_8[0] * x32; a1 -= L36_8[1] * x33; a2 -= L36_8[2] * x34; a3 -= L36_8[3] * x35; x36 = (a0 + a1) + (a2 + a3); }
        asm volatile("" ::: "memory");
        const float rr38 = X[38 * XS] * scp[38]; const f32x4 L38_0 = *(const LAS f32x4*)(LmV + 38 * LS + 0); const f32x4 L38_1 = *(const LAS f32x4*)(LmV + 38 * LS + 4); const f32x4 L37_2 = *(const LAS f32x4*)(LmV + 37 * LS + 8); const f32x4 L37_3 = *(const LAS f32x4*)(LmV + 37 * LS + 12); const f32x4 L37_4 = *(const LAS f32x4*)(LmV + 37 * LS + 16); const f32x4 L37_5 = *(const LAS f32x4*)(LmV + 37 * LS + 20); const f32x4 L37_6 = *(const LAS f32x4*)(LmV + 37 * LS + 24); const f32x4 L37_7 = *(const LAS f32x4*)(LmV + 37 * LS + 28); const f32x4 L37_8 = *(const LAS f32x4*)(LmV + 37 * LS + 32); const f32x4 L37_9 = *(const LAS f32x4*)(LmV + 37 * LS + 36);
        float x37; { float a0 = rr37, a1 = 0.f, a2 = 0.f, a3 = 0.f; a0 -= L37_0[0] * x0; a1 -= L37_0[1] * x1; a2 -= L37_0[2] * x2; a3 -= L37_0[3] * x3; a0 -= L37_1[0] * x4; a1 -= L37_1[1] * x5; a2 -= L37_1[2] * x6; a3 -= L37_1[3] * x7; a0 -= L37_2[0] * x8; a1 -= L37_2[1] * x9; a2 -= L37_2[2] * x10; a3 -= L37_2[3] * x11; a0 -= L37_3[0] * x12; a1 -= L37_3[1] * x13; a2 -= L37_3[2] * x14; a3 -= L37_3[3] * x15; a0 -= L37_4[0] * x16; a1 -= L37_4[1] * x17; a2 -= L37_4[2] * x18; a3 -= L37_4[3] * x19; a0 -= L37_5[0] * x20; a1 -= L37_5[1] * x21; a2 -= L37_5[2] * x22; a3 -= L37_5[3] * x23; a0 -= L37_6[0] * x24; a1 -= L37_6[1] * x25; a2 -= L37_6[2] * x26; a3 -= L37_6[3] * x27; a0 -= L37_7[0] * x28; a1 -= L37_7[1] * x29; a2 -= L37_7[2] * x30; a3 -= L37_7[3] * x31; a0 -= L37_8[0] * x32; a1 -= L37_8[1] * x33; a2 -= L37_8[2] * x34; a3 -= L37_8[3] * x35; a0 -= L37_9[0] * x36; x37 = (a0 + a1) + (a2 + a3); }
        asm volatile("" ::: "memory");
        const float rr39 = X[39 * XS] * scp[39]; const f32x4 L39_0 = *(const LAS f32x4*)(LmV + 39 * LS + 0); const f32x4 L39_1 = *(const LAS f32x4*)(LmV + 39 * LS + 4); const f32x4 L38_2 = *(const LAS f32x4*)(LmV + 38 * LS + 8); const f32x4 L38_3 = *(const LAS f32x4*)(LmV + 38 * LS + 12); const f32x4 L38_4 = *(const LAS f32x4*)(LmV + 38 * LS + 16); const f32x4 L38_5 = *(const LAS f32x4*)(LmV + 38 * LS + 20); const f32x4 L38_6 = *(const LAS f32x4*)(LmV + 38 * LS + 24); const f32x4 L38_7 = *(const LAS f32x4*)(LmV + 38 * LS + 28); const f32x4 L38_8 = *(const LAS f32x4*)(LmV + 38 * LS + 32); const f32x4 L38_9 = *(const LAS f32x4*)(LmV + 38 * LS + 36);
        float x38; { float a0 = rr38, a1 = 0.f, a2 = 0.f, a3 = 0.f; a0 -= L38_0[0] * x0; a1 -= L38_0[1] * x1; a2 -= L38_0[2] * x2; a3 -= L38_0[3] * x3; a0 -= L38_1[0] * x4; a1 -= L38_1[1] * x5; a2 -= L38_1[2] * x6; a3 -= L38_1[3] * x7; a0 -= L38_2[0] * x8; a1 -= L38_2[1] * x9; a2 -= L38_2[2] * x10; a3 -= L38_2[3] * x11; a0 -= L38_3[0] * x12; a1 -= L38_3[1] * x13; a2 -= L38_3[2] * x14; a3 -= L38_3[3] * x15; a0 -= L38_4[0] * x16; a1 -= L38_4[1] * x17; a2 -= L38_4[2] * x18; a3 -= L38_4[3] * x19; a0 -= L38_5[0] * x20; a1 -= L38_5[1] * x21; a2 -= L38_5[2] * x22; a3 -= L38_5[3] * x23; a0 -= L38_6[0] * x24; a1 -= L38_6[1] * x25; a2 -= L38_6[2] * x26; a3 -= L38_6[3] * x27; a0 -= L38_7[0] * x28; a1 -= L38_7[1] * x29; a2 -= L38_7[2] * x30; a3 -= L38_7[3] * x31; a0 -= L38_8[0] * x32; a1 -= L38_8[1] * x33; a2 -= L38_8[2] * x34; a3 -= L38_8[3] * x35; a0 -= L38_9[0] * x36; a1 -= L38_9[1] * x37; x38 = (a0 + a1) + (a2 + a3); }
        asm volatile("" ::: "memory");
        const float rr40 = X[40 * XS] * scp[40]; const f32x4 L40_0 = *(const LAS f32x4*)(LmV + 40 * LS + 0); const f32x4 L40_1 = *(const LAS f32x4*)(LmV + 40 * LS + 4); const f32x4 L39_2 = *(const LAS f32x4*)(LmV + 39 * LS + 8); const f32x4 L39_3 = *(const LAS f32x4*)(LmV + 39 * LS + 12); const f32x4 L39_4 = *(const LAS f32x4*)(LmV + 39 * LS + 16); const f32x4 L39_5 = *(const LAS f32x4*)(LmV + 39 * LS + 20); const f32x4 L39_6 = *(const LAS f32x4*)(LmV + 39 * LS + 24); const f32x4 L39_7 = *(const LAS f32x4*)(LmV + 39 * LS + 28); const f32x4 L39_8 = *(const LAS f32x4*)(LmV + 39 * LS + 32); const f32x4 L39_9 = *(const LAS f32x4*)(LmV + 39 * LS + 36);
        float x39; { float a0 = rr39, a1 = 0.f, a2 = 0.f, a3 = 0.f; a0 -= L39_0[0] * x0; a1 -= L39_0[1] * x1; a2 -= L39_0[2] * x2; a3 -= L39_0[3] * x3; a0 -= L39_1[0] * x4; a1 -= L39_1[1] * x5; a2 -= L39_1[2] * x6; a3 -= L39_1[3] * x7; a0 -= L39_2[0] * x8; a1 -= L39_2[1] * x9; a2 -= L39_2[2] * x10; a3 -= L39_2[3] * x11; a0 -= L39_3[0] * x12; a1 -= L39_3[1] * x13; a2 -= L39_3[2] * x14; a3 -= L39_3[3] * x15; a0 -= L39_4[0] * x16; a1 -= L39_4[1] * x17; a2 -= L39_4[2] * x18; a3 -= L39_4[3] * x19; a0 -= L39_5[0] * x20; a1 -= L39_5[1] * x21; a2 -= L39_5[2] * x22; a3 -= L39_5[3] * x23; a0 -= L39_6[0] * x24; a1 -= L39_6[1] * x25; a2 -= L39_6[2] * x26; a3 -= L39_6[3] * x27; a0 -= L39_7[0] * x28; a1 -= L39_7[1] * x29; a2 -= L39_7[2] * x30; a3 -= L39_7[3] * x31; a0 -= L39_8[0] * x32; a1 -= L39_8[1] * x33; a2 -= L39_8[2] * x34; a3 -= L39_8[3] * x35; a0 -= L39_9[0] * x36; a1 -= L39_9[1] * x37; a2 -= L39_9[2] * x38; x39 = (a0 + a1) + (a2 + a3); }
        asm volatile("" ::: "memory");
        const float rr41 = X[41 * XS] * scp[41]; const f32x4 L41_0 = *(const LAS f32x4*)(LmV + 41 * LS + 0); const f32x4 L41_1 = *(const LAS f32x4*)(LmV + 41 * LS + 4); const f32x4 L40_2 = *(const LAS f32x4*)(LmV + 40 * LS + 8); const f32x4 L40_3 = *(const LAS f32x4*)(LmV + 40 * LS + 12); const f32x4 L40_4 = *(const LAS f32x4*)(LmV + 40 * LS + 16); const f32x4 L40_5 = *(const LAS f32x4*)(LmV + 40 * LS + 20); const f32x4 L40_6 = *(const LAS f32x4*)(LmV + 40 * LS + 24); const f32x4 L40_7 = *(const LAS f32x4*)(LmV + 40 * LS + 28); const f32x4 L40_8 = *(const LAS f32x4*)(LmV + 40 * LS + 32); const f32x4 L40_9 = *(const LAS f32x4*)(LmV + 40 * LS + 36);
        float x40; { float a0 = rr40, a1 = 0.f, a2 = 0.f, a3 = 0.f; a0 -= L40_0[0] * x0; a1 -= L40_0[1] * x1; a2 -= L40_0[2] * x2; a3 -= L40_0[3] * x3; a0 -= L40_1[0] * x4; a1 -= L40_1[1] * x5; a2 -= L40_1[2] * x6; a3 -= L40_1[3] * x7; a0 -= L40_2[0] * x8; a1 -= L40_2[1] * x9; a2 -= L40_2[2] * x10; a3 -= L40_2[3] * x11; a0 -= L40_3[0] * x12; a1 -= L40_3[1] * x13; a2 -= L40_3[2] * x14; a3 -= L40_3[3] * x15; a0 -= L40_4[0] * x16; a1 -= L40_4[1] * x17; a2 -= L40_4[2] * x18; a3 -= L40_4[3] * x19; a0 -= L40_5[0] * x20; a1 -= L40_5[1] * x21; a2 -= L40_5[2] * x22; a3 -= L40_5[3] * x23; a0 -= L40_6[0] * x24; a1 -= L40_6[1] * x25; a2 -= L40_6[2] * x26; a3 -= L40_6[3] * x27; a0 -= L40_7[0] * x28; a1 -= L40_7[1] * x29; a2 -= L40_7[2] * x30; a3 -= L40_7[3] * x31; a0 -= L40_8[0] * x32; a1 -= L40_8[1] * x33; a2 -= L40_8[2] * x34; a3 -= L40_8[3] * x35; a0 -= L40_9[0] * x36; a1 -= L40_9[1] * x37; a2 -= L40_9[2] * x38; a3 -= L40_9[3] * x39; x40 = (a0 + a1) + (a2 + a3); }
        asm volatile("" ::: "memory");
        const float rr42 = X[42 * XS] * scp[42]; const f32x4 L42_0 = *(const LAS f32x4*)(LmV + 42 * LS + 0); const f32x4 L42_1 = *(const LAS f32x4*)(LmV + 42 * LS + 4); const f32x4 L41_2 = *(const LAS f32x4*)(LmV + 41 * LS + 8); const f32x4 L41_3 = *(const LAS f32x4*)(LmV + 41 * LS + 12); const f32x4 L41_4 = *(const LAS f32x4*)(LmV + 41 * LS + 16); const f32x4 L41_5 = *(const LAS f32x4*)(LmV + 41 * LS + 20); const f32x4 L41_6 = *(const LAS f32x4*)(LmV + 41 * LS + 24); const f32x4 L41_7 = *(const LAS f32x4*)(LmV + 41 * LS + 28); const f32x4 L41_8 = *(const LAS f32x4*)(LmV + 41 * LS + 32); const f32x4 L41_9 = *(const LAS f32x4*)(LmV + 41 * LS + 36); const f32x4 L41_10 = *(const LAS f32x4*)(LmV + 41 * LS + 40);
        float x41; { float a0 = rr41, a1 = 0.f, a2 = 0.f, a3 = 0.f; a0 -= L41_0[0] * x0; a1 -= L41_0[1] * x1; a2 -= L41_0[2] * x2; a3 -= L41_0[3] * x3; a0 -= L41_1[0] * x4; a1 -= L41_1[1] * x5; a2 -= L41_1[2] * x6; a3 -= L41_1[3] * x7; a0 -= L41_2[0] * x8; a1 -= L41_2[1] * x9; a2 -= L41_2[2] * x10; a3 -= L41_2[3] * x11; a0 -= L41_3[0] * x12; a1 -= L41_3[1] * x13; a2 -= L41_3[2] * x14; a3 -= L41_3[3] * x15; a0 -= L41_4[0] * x16; a1 -= L41_4[1] * x17; a2 -= L41_4[2] * x18; a3 -= L41_4[3] * x19; a0 -= L41_5[0] * x20; a1 -= L41_5[1] * x21; a2 -= L41_5[2] * x22; a3 -= L41_5[3] * x23; a0 -= L41_6[0] * x24; a1 -= L41_6[1] * x25; a2 -= L41_6[2] * x26; a3 -= L41_6[3] * x27; a0 -= L41_7[0] * x28; a1 -= L41_7[1] * x29; a2 -= L41_7[2] * x30; a3 -= L41_7[3] * x31; a0 -= L41_8[0] * x32; a1 -= L41_8[1] * x33; a2 -= L41_8[2] * x34; a3 -= L41_8[3] * x35; a0 -= L41_9[0] * x36; a1 -= L41_9[1] * x37; a2 -= L41_9[2] * x38; a3 -= L41_9[3] * x39; a0 -= L41_10[0] * x40; x41 = (a0 + a1) + (a2 + a3); }
        asm volatile("" ::: "memory");
        const float rr43 = X[43 * XS] * scp[43]; const f32x4 L43_0 = *(const LAS f32x4*)(LmV + 43 * LS + 0); const f32x4 L43_1 = *(const LAS f32x4*)(LmV + 43 * LS + 4); const f32x4 L42_2 = *(const LAS f32x4*)(LmV + 42 * LS + 8); const f32x4 L42_3 = *(const LAS f32x4*)(LmV + 42 * LS + 12); const f32x4 L42_4 = *(const LAS f32x4*)(LmV + 42 * LS + 16); const f32x4 L42_5 = *(const LAS f32x4*)(LmV + 42 * LS + 20); const f32x4 L42_6 = *(const LAS f32x4*)(LmV + 42 * LS + 24); const f32x4 L42_7 = *(const LAS f32x4*)(LmV + 42 * LS + 28); const f32x4 L42_8 = *(const LAS f32x4*)(LmV + 42 * LS + 32); const f32x4 L42_9 = *(const LAS f32x4*)(LmV + 42 * LS + 36); const f32x4 L42_10 = *(const LAS f32x4*)(LmV + 42 * LS + 40);
        float x42; { float a0 = rr42, a1 = 0.f, a2 = 0.f, a3 = 0.f; a0 -= L42_0[0] * x0; a1 -= L42_0[1] * x1; a2 -= L42_0[2] * x2; a3 -= L42_0[3] * x3; a0 -= L42_1[0] * x4; a1 -= L42_1[1] * x5; a2 -= L42_1[2] * x6; a3 -= L42_1[3] * x7; a0 -= L42_2[0] * x8; a1 -= L42_2[1] * x9; a2 -= L42_2[2] * x10; a3 -= L42_2[3] * x11; a0 -= L42_3[0] * x12; a1 -= L42_3[1] * x13; a2 -= L42_3[2] * x14; a3 -= L42_3[3] * x15; a0 -= L42_4[0] * x16; a1 -= L42_4[1] * x17; a2 -= L42_4[2] * x18; a3 -= L42_4[3] * x19; a0 -= L42_5[0] * x20; a1 -= L42_5[1] * x21; a2 -= L42_5[2] * x22; a3 -= L42_5[3] * x23; a0 -= L42_6[0] * x24; a1 -= L42_6[1] * x25; a2 -= L42_6[2] * x26; a3 -= L42_6[3] * x27; a0 -= L42_7[0] * x28; a1 -= L42_7[1] * x29; a2 -= L42_7[2] * x30; a3 -= L42_7[3] * x31; a0 -= L42_8[0] * x32; a1 -= L42_8[1] * x33; a2 -= L42_8[2] * x34; a3 -= L42_8[3] * x35; a0 -= L42_9[0] * x36; a1 -= L42_9[1] * x37; a2 -= L42_9[2] * x38; a3 -= L42_9[3] * x39; a0 -= L42_10[0] * x40; a1 -= L42_10[1] * x41; x42 = (a0 + a1) + (a2 + a3); }
        asm volatile("" ::: "memory");
        const float rr44 = X[44 * XS] * scp[44]; const f32x4 L44_0 = *(const LAS f32x4*)(LmV + 44 * LS + 0); const f32x4 L44_1 = *(const LAS f32x4*)(LmV + 44 * LS + 4); const f32x4 L43_2 = *(const LAS f32x4*)(LmV + 43 * LS + 8); const f32x4 L43_3 = *(const LAS f32x4*)(LmV + 43 * LS + 12); const f32x4 L43_4 = *(const LAS f32x4*)(LmV + 43 * LS + 16); const f32x4 L43_5 = *(const LAS f32x4*)(LmV + 43 * LS + 20); const f32x4 L43_6 = *(const LAS f32x4*)(LmV + 43 * LS + 24); const f32x4 L43_7 = *(const LAS f32x4*)(LmV + 43 * LS + 28); const f32x4 L43_8 = *(const LAS f32x4*)(LmV + 43 * LS + 32); const f32x4 L43_9 = *(const LAS f32x4*)(LmV + 43 * LS + 36); const f32x4 L43_10 = *(const LAS f32x4*)(LmV + 43 * LS + 40);
        float x43; { float a0 = rr43, a1 = 0.f, a2 = 0.f, a3 = 0.f; a0 -= L43_0[0] * x0; a1 -= L43_0[1] * x1; a2 -= L43_0[2] * x2; a3 -= L43_0[3] * x3; a0 -= L43_1[0] * x4; a1 -= L43_1[1] * x5; a2 -= L43_1[2] * x6; a3 -= L43_1[3] * x7; a0 -= L43_2[0] * x8; a1 -= L43_2[1] * x9; a2 -= L43_2[2] * x10; a3 -= L43_2[3] * x11; a0 -= L43_3[0] * x12; a1 -= L43_3[1] * x13; a2 -= L43_3[2] * x14; a3 -= L43_3[3] * x15; a0 -= L43_4[0] * x16; a1 -= L43_4[1] * x17; a2 -= L43_4[2] * x18; a3 -= L43_4[3] * x19; a0 -= L43_5[0] * x20; a1 -= L43_5[1] * x21; a2 -= L43_5[2] * x22; a3 -= L43_5[3] * x23; a0 -= L43_6[0] * x24; a1 -= L43_6[1] * x25; a2 -= L43_6[2] * x26; a3 -= L43_6[3] * x27; a0 -= L43_7[0] * x28; a1 -= L43_7[1] * x29; a2 -= L43_7[2] * x30; a3 -= L43_7[3] * x31; a0 -= L43_8[0] * x32; a1 -= L43_8[1] * x33; a2 -= L43_8[2] * x34; a3 -= L43_8[3] * x35; a0 -= L43_9[0] * x36; a1 -= L43_9[1] * x37; a2 -= L43_9[2] * x38; a3 -= L43_9[3] * x39; a0 -= L43_10[0] * x40; a1 -= L43_10[1] * x41; a2 -= L43_10[2] * x42; x43 = (a0 + a1) + (a2 + a3); }
        asm volatile("" ::: "memory");
        const float rr45 = X[45 * XS] * scp[45]; const f32x4 L45_0 = *(const LAS f32x4*)(LmV + 45 * LS + 0); const f32x4 L45_1 = *(const LAS f32x4*)(LmV + 45 * LS + 4); const f32x4 L44_2 = *(const LAS f32x4*)(LmV + 44 * LS + 8); const f32x4 L44_3 = *(const LAS f32x4*)(LmV + 44 * LS + 12); const f32x4 L44_4 = *(const LAS f32x4*)(LmV + 44 * LS + 16); const f32x4 L44_5 = *(const LAS f32x4*)(LmV + 44 * LS + 20); const f32x4 L44_6 = *(const LAS f32x4*)(LmV + 44 * LS + 24); const f32x4 L44_7 = *(const LAS f32x4*)(LmV + 44 * LS + 28); const f32x4 L44_8 = *(const LAS f32x4*)(LmV + 44 * LS + 32); const f32x4 L44_9 = *(const LAS f32x4*)(LmV + 44 * LS + 36); const f32x4 L44_10 = *(const LAS f32x4*)(LmV + 44 * LS + 40);
        float x44; { float a0 = rr44, a1 = 0.f, a2 = 0.f, a3 = 0.f; a0 -= L44_0[0] * x0; a1 -= L44_0[1] * x1; a2 -= L44_0[2] * x2; a3 -= L44_0[3] * x3; a0 -= L44_1[0] * x4; a1 -= L44_1[1] * x5; a2 -= L44_1[2] * x6; a3 -= L44_1[3] * x7; a0 -= L44_2[0] * x8; a1 -= L44_2[1] * x9; a2 -= L44_2[2] * x10; a3 -= L44_2[3] * x11; a0 -= L44_3[0] * x12; a1 -= L44_3[1] * x13; a2 -= L44_3[2] * x14; a3 -= L44_3[3] * x15; a0 -= L44_4[0] * x16; a1 -= L44_4[1] * x17; a2 -= L44_4[2] * x18; a3 -= L44_4[3] * x19; a0 -= L44_5[0] * x20; a1 -= L44_5[1] * x21; a2 -= L44_5[2] * x22; a3 -= L44_5[3] * x23; a0 -= L44_6[0] * x24; a1 -= L44_6[1] * x25; a2 -= L44_6[2] * x26; a3 -= L44_6[3] * x27; a0 -= L44_7[0] * x28; a1 -= L44_7[1] * x29; a2 -= L44_7[2] * x30; a3 -= L44_7[3] * x31; a0 -= L44_8[0] * x32; a1 -= L44_8[1] * x33; a2 -= L44_8[2] * x34; a3 -= L44_8[3] * x35; a0 -= L44_9[0] * x36; a1 -= L44_9[1] * x37; a2 -= L44_9[2] * x38; a3 -= L44_9[3] * x39; a0 -= L44_10[0] * x40; a1 -= L44_10[1] * x41; a2 -= L44_10[2] * x42; a3 -= L44_10[3] * x43; x44 = (a0 + a1) + (a2 + a3); }
        asm volatile("" ::: "memory");
        const float rr46 = X[46 * XS] * scp[46]; const f32x4 L46_0 = *(const LAS f32x4*)(LmV + 46 * LS + 0); const f32x4 L46_1 = *(const LAS f32x4*)(LmV + 46 * LS + 4); const f32x4 L45_2 = *(const LAS f32x4*)(LmV + 45 * LS + 8); const f32x4 L45_3 = *(const LAS f32x4*)(LmV + 45 * LS + 12); const f32x4 L45_4 = *(const LAS f32x4*)(LmV + 45 * LS + 16); const f32x4 L45_5 = *(const LAS f32x4*)(LmV + 45 * LS + 20); const f32x4 L45_6 = *(const LAS f32x4*)(LmV + 45 * LS + 24); const f32x4 L45_7 = *(const LAS f32x4*)(LmV + 45 * LS + 28); const f32x4 L45_8 = *(const LAS f32x4*)(LmV + 45 * LS + 32); const f32x4 L45_9 = *(const LAS f32x4*)(LmV + 45 * LS + 36); const f32x4 L45_10 = *(const LAS f32x4*)(LmV + 45 * LS + 40); const f32x4 L45_11 = *(const LAS f32x4*)(LmV + 45 * LS + 44);
        float x45; { float a0 = rr45, a1 = 0.f, a2 = 0.f, a3 = 0.f; a0 -= L45_0[0] * x0; a1 -= L45_0[1] * x1; a2 -= L45_0[2] * x2; a3 -= L45_0[3] * x3; a0 -= L45_1[0] * x4; a1 -= L45_1[1] * x5; a2 -= L45_1[2] * x6; a3 -= L45_1[3] * x7; a0 -= L45_2[0] * x8; a1 -= L45_2[1] * x9; a2 -= L45_2[2] * x10; a3 -= L45_2[3] * x11; a0 -= L45_3[0] * x12; a1 -= L45_3[1] * x13; a2 -= L45_3[2] * x14; a3 -= L45_3[3] * x15; a0 -= L45_4[0] * x16; a1 -= L45_4[1] * x17; a2 -= L45_4[2] * x18; a3 -= L45_4[3] * x19; a0 -= L45_5[0] * x20; a1 -= L45_5[1] * x21; a2 -= L45_5[2] * x22; a3 -= L45_5[3] * x23; a0 -= L45_6[0] * x24; a1 -= L45_6[1] * x25; a2 -= L45_6[2] * x26; a3 -= L45_6[3] * x27; a0 -= L45_7[0] * x28; a1 -= L45_7[1] * x29; a2 -= L45_7[2] * x30; a3 -= L45_7[3] * x31; a0 -= L45_8[0] * x32; a1 -= L45_8[1] * x33; a2 -= L45_8[2] * x34; a3 -= L45_8[3] * x35; a0 -= L45_9[0] * x36; a1 -= L45_9[1] * x37; a2 -= L45_9[2] * x38; a3 -= L45_9[3] * x39; a0 -= L45_10[0] * x40; a1 -= L45_10[1] * x41; a2 -= L45_10[2] * x42; a3 -= L45_10[3] * x43; a0 -= L45_11[0] * x44; x45 = (a0 + a1) + (a2 + a3); }
        asm volatile("" ::: "memory");
        const float rr47 = X[47 * XS] * scp[47]; const f32x4 L47_0 = *(const LAS f32x4*)(LmV + 47 * LS + 0); const f32x4 L47_1 = *(const LAS f32x4*)(LmV + 47 * LS + 4); const f32x4 L46_2 = *(const LAS f32x4*)(LmV + 46 * LS + 8); const f32x4 L46_3 = *(const LAS f32x4*)(LmV + 46 * LS + 12); const f32x4 L46_4 = *(const LAS f32x4*)(LmV + 46 * LS + 16); const f32x4 L46_5 = *(const LAS f32x4*)(LmV + 46 * LS + 20); const f32x4 L46_6 = *(const LAS f32x4*)(LmV + 46 * LS + 24); const f32x4 L46_7 = *(const LAS f32x4*)(LmV + 46 * LS + 28); const f32x4 L46_8 = *(const LAS f32x4*)(LmV + 46 * LS + 32); const f32x4 L46_9 = *(const LAS f32x4*)(LmV + 46 * LS + 36); const f32x4 L46_10 = *(const LAS f32x4*)(LmV + 46 * LS + 40); const f32x4 L46_11 = *(const LAS f32x4*)(LmV + 46 * LS + 44);
        float x46; { float a0 = rr46, a1 = 0.f, a2 = 0.f, a3 = 0.f; a0 -= L46_0[0] * x0; a1 -= L46_0[1] * x1; a2 -= L46_0[2] * x2; a3 -= L46_0[3] * x3; a0 -= L46_1[0] * x4; a1 -= L46_1[1] * x5; a2 -= L46_1[2] * x6; a3 -= L46_1[3] * x7; a0 -= L46_2[0] * x8; a1 -= L46_2[1] * x9; a2 -= L46_2[2] * x10; a3 -= L46_2[3] * x11; a0 -= L46_3[0] * x12; a1 -= L46_3[1] * x13; a2 -= L46_3[2] * x14; a3 -= L46_3[3] * x15; a0 -= L46_4[0] * x16; a1 -= L46_4[1] * x17; a2 -= L46_4[2] * x18; a3 -= L46_4[3] * x19; a0 -= L46_5[0] * x20; a1 -= L46_5[1] * x21; a2 -= L46_5[2] * x22; a3 -= L46_5[3] * x23; a0 -= L46_6[0] * x24; a1 -= L46_6[1] * x25; a2 -= L46_6[2] * x26; a3 -= L46_6[3] * x27; a0 -= L46_7[0] * x28; a1 -= L46_7[1] * x29; a2 -= L46_7[2] * x30; a3 -= L46_7[3] * x31; a0 -= L46_8[0] * x32; a1 -= L46_8[1] * x33; a2 -= L46_8[2] * x34; a3 -= L46_8[3] * x35; a0 -= L46_9[0] * x36; a1 -= L46_9[1] * x37; a2 -= L46_9[2] * x38; a3 -= L46_9[3] * x39; a0 -= L46_10[0] * x40; a1 -= L46_10[1] * x41; a2 -= L46_10[2] * x42; a3 -= L46_10[3] * x43; a0 -= L46_11[0] * x44; a1 -= L46_11[1] * x45; x46 = (a0 + a1) + (a2 + a3); }
        asm volatile("" ::: "memory");
        const float rr48 = X[48 * XS] * scp[48]; const f32x4 L48_0 = *(const LAS f32x4*)(LmV + 48 * LS + 0); const f32x4 L48_1 = *(const LAS f32x4*)(LmV + 48 * LS + 4); const f32x4 L47_2 = *(const LAS f32x4*)(LmV + 47 * LS + 8); const f32x4 L47_3 = *(const LAS f32x4*)(LmV + 47 * LS + 12); const f32x4 L47_4 = *(const LAS f32x4*)(LmV + 47 * LS + 16); const f32x4 L47_5 = *(const LAS f32x4*)(LmV + 47 * LS + 20); const f32x4 L47_6 = *(const LAS f32x4*)(LmV + 47 * LS + 24); const f32x4 L47_7 = *(const LAS f32x4*)(LmV + 47 * LS + 28); const f32x4 L47_8 = *(const LAS f32x4*)(LmV + 47 * LS + 32); const f32x4 L47_9 = *(const LAS f32x4*)(LmV + 47 * LS + 36); const f32x4 L47_10 = *(const LAS f32x4*)(LmV + 47 * LS + 40); const f32x4 L47_11 = *(const LAS f32x4*)(LmV + 47 * LS + 44);
        float x47; { float a0 = rr47, a1 = 0.f, a2 = 0.f, a3 = 0.f; a0 -= L47_0[0] * x0; a1 -= L47_0[1] * x1; a2 -= L47_0[2] * x2; a3 -= L47_0[3] * x3; a0 -= L47_1[0] * x4; a1 -= L47_1[1] * x5; a2 -= L47_1[2] * x6; a3 -= L47_1[3] * x7; a0 -= L47_2[0] * x8; a1 -= L47_2[1] * x9; a2 -= L47_2[2] * x10; a3 -= L47_2[3] * x11; a0 -= L47_3[0] * x12; a1 -= L47_3[1] * x13; a2 -= L47_3[2] * x14; a3 -= L47_3[3] * x15; a0 -= L47_4[0] * x16; a1 -= L47_4[1] * x17; a2 -= L47_4[2] * x18; a3 -= L47_4[3] * x19; a0 -= L47_5[0] * x20; a1 -= L47_5[1] * x21; a2 -= L47_5[2] * x22; a3 -= L47_5[3] * x23; a0 -= L47_6[0] * x24; a1 -= L47_6[1] * x25; a2 -= L47_6[2] * x26; a3 -= L47_6[3] * x27; a0 -= L47_7[0] * x28; a1 -= L47_7[1] * x29; a2 -= L47_7[2] * x30; a3 -= L47_7[3] * x31; a0 -= L47_8[0] * x32; a1 -= L47_8[1] * x33; a2 -= L47_8[2] * x34; a3 -= L47_8[3] * x35; a0 -= L47_9[0] * x36; a1 -= L47_9[1] * x37; a2 -= L47_9[2] * x38; a3 -= L47_9[3] * x39; a0 -= L47_10[0] * x40; a1 -= L47_10[1] * x41; a2 -= L47_10[2] * x42; a3 -= L47_10[3] * x43; a0 -= L47_11[0] * x44; a1 -= L47_11[1] * x45; a2 -= L47_11[2] * x46; x47 = (a0 + a1) + (a2 + a3); }
        asm volatile("" ::: "memory");
        const float rr49 = X[49 * XS] * scp[49]; const f32x4 L49_0 = *(const LAS f32x4*)(LmV + 49 * LS + 0); const f32x4 L49_1 = *(const LAS f32x4*)(LmV + 49 * LS + 4); const f32x4 L48_2 = *(const LAS f32x4*)(LmV + 48 * LS + 8); const f32x4 L48_3 = *(const LAS f32x4*)(LmV + 48 * LS + 12); const f32x4 L48_4 = *(const LAS f32x4*)(LmV + 48 * LS + 16); const f32x4 L48_5 = *(const LAS f32x4*)(LmV + 48 * LS + 20); const f32x4 L48_6 = *(const LAS f32x4*)(LmV + 48 * LS + 24); const f32x4 L48_7 = *(const LAS f32x4*)(LmV + 48 * LS + 28); const f32x4 L48_8 = *(const LAS f32x4*)(LmV + 48 * LS + 32); const f32x4 L48_9 = *(const LAS f32x4*)(LmV + 48 * LS + 36); const f32x4 L48_10 = *(const LAS f32x4*)(LmV + 48 * LS + 40); const f32x4 L48_11 = *(const LAS f32x4*)(LmV + 48 * LS + 44);
        float x48; { float a0 = rr48, a1 = 0.f, a2 = 0.f, a3 = 0.f; a0 -= L48_0[0] * x0; a1 -= L48_0[1] * x1; a2 -= L48_0[2] * x2; a3 -= L48_0[3] * x3; a0 -= L48_1[0] * x4; a1 -= L48_1[1] * x5; a2 -= L48_1[2] * x6; a3 -= L48_1[3] * x7; a0 -= L48_2[0] * x8; a1 -= L48_2[1] * x9; a2 -= L48_2[2] * x10; a3 -= L48_2[3] * x11; a0 -= L48_3[0] * x12; a1 -= L48_3[1] * x13; a2 -= L48_3[2] * x14; a3 -= L48_3[3] * x15; a0 -= L48_4[0] * x16; a1 -= L48_4[1] * x17; a2 -= L48_4[2] * x18; a3 -= L48_4[3] * x19; a0 -= L48_5[0] * x20; a1 -= L48_5[1] * x21; a2 -= L48_5[2] * x22; a3 -= L48_5[3] * x23; a0 -= L48_6[0] * x24; a1 -= L48_6[1] * x25; a2 -= L48_6[2] * x26; a3 -= L48_6[3] * x27; a0 -= L48_7[0] * x28; a1 -= L48_7[1] * x29; a2 -= L48_7[2] * x30; a3 -= L48_7[3] * x31; a0 -= L48_8[0] * x32; a1 -= L48_8[1] * x33; a2 -= L48_8[2] * x34; a3 -= L48_8[3] * x35; a0 -= L48_9[0] * x36; a1 -= L48_9[1] * x37; a2 -= L48_9[2] * x38; a3 -= L48_9[3] * x39; a0 -= L48_10[0] * x40; a1 -= L48_10[1] * x41; a2 -= L48_10[2] * x42; a3 -= L48_10[3] * x43; a0 -= L48_11[0] * x44; a1 -= L48_11[1] * x45; a2 -= L48_11[2] * x46; a3 -= L48_11[3] * x47; x48 = (a0 + a1) + (a2 + a3); }
        asm volatile("" ::: "memory");
        const float rr50 = X[50 * XS] * scp[50]; const f32x4 L50_0 = *(const LAS f32x4*)(LmV + 50 * LS + 0); const f32x4 L50_1 = *(const LAS f32x4*)(LmV + 50 * LS + 4); const f32x4 L49_2 = *(const LAS f32x4*)(LmV + 49 * LS + 8); const f32x4 L49_3 = *(const LAS f32x4*)(LmV + 49 * LS + 12); const f32x4 L49_4 = *(const LAS f32x4*)(LmV + 49 * LS + 16); const f32x4 L49_5 = *(const LAS f32x4*)(LmV + 49 * LS + 20); const f32x4 L49_6 = *(const LAS f32x4*)(LmV + 49 * LS + 24); const f32x4 L49_7 = *(const LAS f32x4*)(LmV + 49 * LS + 28); const f32x4 L49_8 = *(const LAS f32x4*)(LmV + 49 * LS + 32); const f32x4 L49_9 = *(const LAS f32x4*)(LmV + 49 * LS + 36); const f32x4 L49_10 = *(const LAS f32x4*)(LmV + 49 * LS + 40); const f32x4 L49_11 = *(const LAS f32x4*)(LmV + 49 * LS + 44); const f32x4 L49_12 = *(const LAS f32x4*)(LmV + 49 * LS + 48);
        float x49; { float a0 = rr49, a1 = 0.f, a2 = 0.f, a3 = 0.f; a0 -= L49_0[0] * x0; a1 -= L49_0[1] * x1; a2 -= L49_0[2] * x2; a3 -= L49_0[3] * x3; a0 -= L49_1[0] * x4; a1 -= L49_1[1] * x5; a2 -= L49_1[2] * x6; a3 -= L49_1[3] * x7; a0 -= L49_2[0] * x8; a1 -= L49_2[1] * x9; a2 -= L49_2[2] * x10; a3 -= L49_2[3] * x11; a0 -= L49_3[0] * x12; a1 -= L49_3[1] * x13; a2 -= L49_3[2] * x14; a3 -= L49_3[3] * x15; a0 -= L49_4[0] * x16; a1 -= L49_4[1] * x17; a2 -= L49_4[2] * x18; a3 -= L49_4[3] * x19; a0 -= L49_5[0] * x20; a1 -= L49_5[1] * x21; a2 -= L49_5[2] * x22; a3 -= L49_5[3] * x23; a0 -= L49_6[0] * x24; a1 -= L49_6[1] * x25; a2 -= L49_6[2] * x26; a3 -= L49_6[3] * x27; a0 -= L49_7[0] * x28; a1 -= L49_7[1] * x29; a2 -= L49_7[2] * x30; a3 -= L49_7[3] * x31; a0 -= L49_8[0] * x32; a1 -= L49_8[1] * x33; a2 -= L49_8[2] * x34; a3 -= L49_8[3] * x35; a0 -= L49_9[0] * x36; a1 -= L49_9[1] * x37; a2 -= L49_9[2] * x38; a3 -= L49_9[3] * x39; a0 -= L49_10[0] * x40; a1 -= L49_10[1] * x41; a2 -= L49_10[2] * x42; a3 -= L49_10[3] * x43; a0 -= L49_11[0] * x44; a1 -= L49_11[1] * x45; a2 -= L49_11[2] * x46; a3 -= L49_11[3] * x47; a0 -= L49_12[0] * x48; x49 = (a0 + a1) + (a2 + a3); }
        asm volatile("" ::: "memory");
        const float rr51 = X[51 * XS] * scp[51]; const f32x4 L51_0 = *(const LAS f32x4*)(LmV + 51 * LS + 0); const f32x4 L51_1 = *(const LAS f32x4*)(LmV + 51 * LS + 4); const f32x4 L50_2 = *(const LAS f32x4*)(LmV + 50 * LS + 8); const f32x4 L50_3 = *(const LAS f32x4*)(LmV + 50 * LS + 12); const f32x4 L50_4 = *(const LAS f32x4*)(LmV + 50 * LS + 16); const f32x4 L50_5 = *(const LAS f32x4*)(LmV + 50 * LS + 20); const f32x4 L50_6 = *(const LAS f32x4*)(LmV + 50 * LS + 24); const f32x4 L50_7 = *(const LAS f32x4*)(LmV + 50 * LS + 28); const f32x4 L50_8 = *(const LAS f32x4*)(LmV + 50 * LS + 32); const f32x4 L50_9 = *(const LAS f32x4*)(LmV + 50 * LS + 36); const f32x4 L50_10 = *(const LAS f32x4*)(LmV + 50 * LS + 40); const f32x4 L50_11 = *(const LAS f32x4*)(LmV + 50 * LS + 44); const f32x4 L50_12 = *(const LAS f32x4*)(LmV + 50 * LS + 48);
        float x50; { float a0 = rr50, a1 = 0.f, a2 = 0.f, a3 = 0.f; a0 -= L50_0[0] * x0; a1 -= L50_0[1] * x1; a2 -= L50_0[2] * x2; a3 -= L50_0[3] * x3; a0 -= L50_1[0] * x4; a1 -= L50_1[1] * x5; a2 -= L50_1[2] * x6; a3 -= L50_1[3] * x7; a0 -= L50_2[0] * x8; a1 -= L50_2[1] * x9; a2 -= L50_2[2] * x10; a3 -= L50_2[3] * x11; a0 -= L50_3[0] * x12; a1 -= L50_3[1] * x13; a2 -= L50_3[2] * x14; a3 -= L50_3[3] * x15; a0 -= L50_4[0] * x16; a1 -= L50_4[1] * x17; a2 -= L50_4[2] * x18; a3 -= L50_4[3] * x19; a0 -= L50_5[0] * x20; a1 -= L50_5[1] * x21; a2 -= L50_5[2] * x22; a3 -= L50_5[3] * x23; a0 -= L50_6[0] * x24; a1 -= L50_6[1] * x25; a2 -= L50_6[2] * x26; a3 -= L50_6[3] * x27; a0 -= L50_7[0] * x28; a1 -= L50_7[1] * x29; a2 -= L50_7[2] * x30; a3 -= L50_7[3] * x31; a0 -= L50_8[0] * x32; a1 -= L50_8[1] * x33; a2 -= L50_8[2] * x34; a3 -= L50_8[3] * x35; a0 -= L50_9[0] * x36; a1 -= L50_9[1] * x37; a2 -= L50_9[2] * x38; a3 -= L50_9[3] * x39; a0 -= L50_10[0] * x40; a1 -= L50_10[1] * x41; a2 -= L50_10[2] * x42; a3 -= L50_10[3] * x43; a0 -= L50_11[0] * x44; a1 -= L50_11[1] * x45; a2 -= L50_11[2] * x46; a3 -= L50_11[3] * x47; a0 -= L50_12[0] * x48; a1 -= L50_12[1] * x49; x50 = (a0 + a1) + (a2 + a3); }
        asm volatile("" ::: "memory");
        const float rr52 = X[52 * XS] * scp[52]; const f32x4 L52_0 = *(const LAS f32x4*)(LmV + 52 * LS + 0); const f32x4 L52_1 = *(const LAS f32x4*)(LmV + 52 * LS + 4); const f32x4 L51_2 = *(const LAS f32x4*)(LmV + 51 * LS + 8); const f32x4 L51_3 = *(const LAS f32x4*)(LmV + 51 * LS + 12); const f32x4 L51_4 = *(const LAS f32x4*)(LmV + 51 * LS + 16); const f32x4 L51_5 = *(const LAS f32x4*)(LmV + 51 * LS + 20); const f32x4 L51_6 = *(const LAS f32x4*)(LmV + 51 * LS + 24); const f32x4 L51_7 = *(const LAS f32x4*)(LmV + 51 * LS + 28); const f32x4 L51_8 = *(const LAS f32x4*)(LmV + 51 * LS + 32); const f32x4 L51_9 = *(const LAS f32x4*)(LmV + 51 * LS + 36); const f32x4 L51_10 = *(const LAS f32x4*)(LmV + 51 * LS + 40); const f32x4 L51_11 = *(const LAS f32x4*)(LmV + 51 * LS + 44); const f32x4 L51_12 = *(const LAS f32x4*)(LmV + 51 * LS + 48);
        float x51; { float a0 = rr51, a1 = 0.f, a2 = 0.f, a3 = 0.f; a0 -= L51_0[0] * x0; a1 -= L51_0[1] * x1; a2 -= L51_0[2] * x2; a3 -= L51_0[3] * x3; a0 -= L51_1[0] * x4; a1 -= L51_1[1] * x5; a2 -= L51_1[2] * x6; a3 -= L51_1[3] * x7; a0 -= L51_2[0] * x8; a1 -= L51_2[1] * x9; a2 -= L51_2[2] * x10; a3 -= L51_2[3] * x11; a0 -= L51_3[0] * x12; a1 -= L51_3[1] * x13; a2 -= L51_3[2] * x14; a3 -= L51_3[3] * x15; a0 -= L51_4[0] * x16; a1 -= L51_4[1] * x17; a2 -= L51_4[2] * x18; a3 -= L51_4[3] * x19; a0 -= L51_5[0] * x20; a1 -= L51_5[1] * x21; a2 -= L51_5[2] * x22; a3 -= L51_5[3] * x23; a0 -= L51_6[0] * x24; a1 -= L51_6[1] * x25; a2 -= L51_6[2] * x26; a3 -= L51_6[3] * x27; a0 -= L51_7[0] * x28; a1 -= L51_7[1] * x29; a2 -= L51_7[2] * x30; a3 -= L51_7[3] * x31; a0 -= L51_8[0] * x32; a1 -= L51_8[1] * x33; a2 -= L51_8[2] * x34; a3 -= L51_8[3] * x35; a0 -= L51_9[0] * x36; a1 -= L51_9[1] * x37; a2 -= L51_9[2] * x38; a3 -= L51_9[3] * x39; a0 -= L51_10[0] * x40; a1 -= L51_10[1] * x41; a2 -= L51_10[2] * x42; a3 -= L51_10[3] * x43; a0 -= L51_11[0] * x44; a1 -= L51_11[1] * x45; a2 -= L51_11[2] * x46; a3 -= L51_11[3] * x47; a0 -= L51_12[0] * x48; a1 -= L51_12[1] * x49; a2 -= L51_12[2] * x50; x51 = (a0 + a1) + (a2 + a3); }
        asm volatile("" ::: "memory");
        const float rr53 = X[53 * XS] * scp[53]; const f32x4 L53_0 = *(const LAS f32x4*)(LmV + 53 * LS + 0); const f32x4 L53_1 = *(const LAS f32x4*)(LmV + 53 * LS + 4); const f32x4 L52_2 = *(const LAS f32x4*)(LmV + 52 * LS + 8); const f32x4 L52_3 = *(const LAS f32x4*)(LmV + 52 * LS + 12); const f32x4 L52_4 = *(const LAS f32x4*)(LmV + 52 * LS + 16); const f32x4 L52_5 = *(const LAS f32x4*)(LmV + 52 * LS + 20); const f32x4 L52_6 = *(const LAS f32x4*)(LmV + 52 * LS + 24); const f32x4 L52_7 = *(const LAS f32x4*)(LmV + 52 * LS + 28); const f32x4 L52_8 = *(const LAS f32x4*)(LmV + 52 * LS + 32); const f32x4 L52_9 = *(const LAS f32x4*)(LmV + 52 * LS + 36); const f32x4 L52_10 = *(const LAS f32x4*)(LmV + 52 * LS + 40); const f32x4 L52_11 = *(const LAS f32x4*)(LmV + 52 * LS + 44); const f32x4 L52_12 = *(const LAS f32x4*)(LmV + 52 * LS + 48);
        float x52; { float a0 = rr52, a1 = 0.f, a2 = 0.f, a3 = 0.f; a0 -= L52_0[0] * x0; a1 -= L52_0[1] * x1; a2 -= L52_0[2] * x2; a3 -= L52_0[3] * x3; a0 -= L52_1[0] * x4; a1 -= L52_1[1] * x5; a2 -= L52_1[2] * x6; a3 -= L52_1[3] * x7; a0 -= L52_2[0] * x8; a1 -= L52_2[1] * x9; a2 -= L52_2[2] * x10; a3 -= L52_2[3] * x11; a0 -= L52_3[0] * x12; a1 -= L52_3[1] * x13; a2 -= L52_3[2] * x14; a3 -= L52_3[3] * x15; a0 -= L52_4[0] * x16; a1 -= L52_4[1] * x17; a2 -= L52_4[2] * x18; a3 -= L52_4[3] * x19; a0 -= L52_5[0] * x20; a1 -= L52_5[1] * x21; a2 -= L52_5[2] * x22; a3 -= L52_5[3] * x23; a0 -= L52_6[0] * x24; a1 -= L52_6[1] * x25; a2 -= L52_6[2] * x26; a3 -= L52_6[3] * x27; a0 -= L52_7[0] * x28; a1 -= L52_7[1] * x29; a2 -= L52_7[2] * x30; a3 -= L52_7[3] * x31; a0 -= L52_8[0] * x32; a1 -= L52_8[1] * x33; a2 -= L52_8[2] * x34; a3 -= L52_8[3] * x35; a0 -= L52_9[0] * x36; a1 -= L52_9[1] * x37; a2 -= L52_9[2] * x38; a3 -= L52_9[3] * x39; a0 -= L52_10[0] * x40; a1 -= L52_10[1] * x41; a2 -= L52_10[2] * x42; a3 -= L52_10[3] * x43; a0 -= L52_11[0] * x44; a1 -= L52_11[1] * x45; a2 -= L52_11[2] * x46; a3 -= L52_11[3] * x47; a0 -= L52_12[0] * x48; a1 -= L52_12[1] * x49; a2 -= L52_12[2] * x50; a3 -= L52_12[3] * x51; x52 = (a0 + a1) + (a2 + a3); }
        asm volatile("" ::: "memory");
        const float rr54 = X[54 * XS] * scp[54]; const f32x4 L54_0 = *(const LAS f32x4*)(LmV + 54 * LS + 0); const f32x4 L54_1 = *(const LAS f32x4*)(LmV + 54 * LS + 4); const f32x4 L53_2 = *(const LAS f32x4*)(LmV + 53 * LS + 8); const f32x4 L53_3 = *(const LAS f32x4*)(LmV + 53 * LS + 12); const f32x4 L53_4 = *(const LAS f32x4*)(LmV + 53 * LS + 16); const f32x4 L53_5 = *(const LAS f32x4*)(LmV + 53 * LS + 20); const f32x4 L53_6 = *(const LAS f32x4*)(LmV + 53 * LS + 24); const f32x4 L53_7 = *(const LAS f32x4*)(LmV + 53 * LS + 28); const f32x4 L53_8 = *(const LAS f32x4*)(LmV + 53 * LS + 32); const f32x4 L53_9 = *(const LAS f32x4*)(LmV + 53 * LS + 36); const f32x4 L53_10 = *(const LAS f32x4*)(LmV + 53 * LS + 40); const f32x4 L53_11 = *(const LAS f32x4*)(LmV + 53 * LS + 44); const f32x4 L53_12 = *(const LAS f32x4*)(LmV + 53 * LS + 48); const f32x4 L53_13 = *(const LAS f32x4*)(LmV + 53 * LS + 52);
        float x53; { float a0 = rr53, a1 = 0.f, a2 = 0.f, a3 = 0.f; a0 -= L53_0[0] * x0; a1 -= L53_0[1] * x1; a2 -= L53_0[2] * x2; a3 -= L53_0[3] * x3; a0 -= L53_1[0] * x4; a1 -= L53_1[1] * x5; a2 -= L53_1[2] * x6; a3 -= L53_1[3] * x7; a0 -= L53_2[0] * x8; a1 -= L53_2[1] * x9; a2 -= L53_2[2] * x10; a3 -= L53_2[3] * x11; a0 -= L53_3[0] * x12; a1 -= L53_3[1] * x13; a2 -= L53_3[2] * x14; a3 -= L53_3[3] * x15; a0 -= L53_4[0] * x16; a1 -= L53_4[1] * x17; a2 -= L53_4[2] * x18; a3 -= L53_4[3] * x19; a0 -= L53_5[0] * x20; a1 -= L53_5[1] * x21; a2 -= L53_5[2] * x22; a3 -= L53_5[3] * x23; a0 -= L53_6[0] * x24; a1 -= L53_6[1] * x25; a2 -= L53_6[2] * x26; a3 -= L53_6[3] * x27; a0 -= L53_7[0] * x28; a1 -= L53_7[1] * x29; a2 -= L53_7[2] * x30; a3 -= L53_7[3] * x31; a0 -= L53_8[0] * x32; a1 -= L53_8[1] * x33; a2 -= L53_8[2] * x34; a3 -= L53_8[3] * x35; a0 -= L53_9[0] * x36; a1 -= L53_9[1] * x37; a2 -= L53_9[2] * x38; a3 -= L53_9[3] * x39; a0 -= L53_10[0] * x40; a1 -= L53_10[1] * x41; a2 -= L53_10[2] * x42; a3 -= L53_10[3] * x43; a0 -= L53_11[0] * x44; a1 -= L53_11[1] * x45; a2 -= L53_11[2] * x46; a3 -= L53_11[3] * x47; a0 -= L53_12[0] * x48; a1 -= L53_12[1] * x49; a2 -= L53_12[2] * x50; a3 -= L53_12[3] * x51; a0 -= L53_13[0] * x52; x53 = (a0 + a1) + (a2 + a3); }
        asm volatile("" ::: "memory");
        const float rr55 = X[55 * XS] * scp[55]; const f32x4 L55_0 = *(const LAS f32x4*)(LmV + 55 * LS + 0); const f32x4 L55_1 = *(const LAS f32x4*)(LmV + 55 * LS + 4); const f32x4 L54_2 = *(const LAS f32x4*)(LmV + 54 * LS + 8); const f32x4 L54_3 = *(const LAS f32x4*)(LmV + 54 * LS + 12); const f32x4 L54_4 = *(const LAS f32x4*)(LmV + 54 * LS + 16); const f32x4 L54_5 = *(const LAS f32x4*)(LmV + 54 * LS + 20); const f32x4 L54_6 = *(const LAS f32x4*)(LmV + 54 * LS + 24); const f32x4 L54_7 = *(const LAS f32x4*)(LmV + 54 * LS + 28); const f32x4 L54_8 = *(const LAS f32x4*)(LmV + 54 * LS + 32); const f32x4 L54_9 = *(const LAS f32x4*)(LmV + 54 * LS + 36); const f32x4 L54_10 = *(const LAS f32x4*)(LmV + 54 * LS + 40); const f32x4 L54_11 = *(const LAS f32x4*)(LmV + 54 * LS + 44); const f32x4 L54_12 = *(const LAS f32x4*)(LmV + 54 * LS + 48); const f32x4 L54_13 = *(const LAS f32x4*)(LmV + 54 * LS + 52);
        float x54; { float a0 = rr54, a1 = 0.f, a2 = 0.f, a3 = 0.f; a0 -= L54_0[0] * x0; a1 -= L54_0[1] * x1; a2 -= L54_0[2] * x2; a3 -= L54_0[3] * x3; a0 -= L54_1[0] * x4; a1 -= L54_1[1] * x5; a2 -= L54_1[2] * x6; a3 -= L54_1[3] * x7; a0 -= L54_2[0] * x8; a1 -= L54_2[1] * x9; a2 -= L54_2[2] * x10; a3 -= L54_2[3] * x11; a0 -= L54_3[0] * x12; a1 -= L54_3[1] * x13; a2 -= L54_3[2] * x14; a3 -= L54_3[3] * x15; a0 -= L54_4[0] * x16; a1 -= L54_4[1] * x17; a2 -= L54_4[2] * x18; a3 -= L54_4[3] * x19; a0 -= L54_5[0] * x20; a1 -= L54_5[1] * x21; a2 -= L54_5[2] * x22; a3 -= L54_5[3] * x23; a0 -= L54_6[0] * x24; a1 -= L54_6[1] * x25; a2 -= L54_6[2] * x26; a3 -= L54_6[3] * x27; a0 -= L54_7[0] * x28; a1 -= L54_7[1] * x29; a2 -= L54_7[2] * x30; a3 -= L54_7[3] * x31; a0 -= L54_8[0] * x32; a1 -= L54_8[1] * x33; a2 -= L54_8[2] * x34; a3 -= L54_8[3] * x35; a0 -= L54_9[0] * x36; a1 -= L54_9[1] * x37; a2 -= L54_9[2] * x38; a3 -= L54_9[3] * x39; a0 -= L54_10[0] * x40; a1 -= L54_10[1] * x41; a2 -= L54_10[2] * x42; a3 -= L54_10[3] * x43; a0 -= L54_11[0] * x44; a1 -= L54_11[1] * x45; a2 -= L54_11[2] * x46; a3 -= L54_11[3] * x47; a0 -= L54_12[0] * x48; a1 -= L54_12[1] * x49; a2 -= L54_12[2] * x50; a3 -= L54_12[3] * x51; a0 -= L54_13[0] * x52; a1 -= L54_13[1] * x53; x54 = (a0 + a1) + (a2 + a3); }
        asm volatile("" ::: "memory");
        const float rr56 = X[56 * XS] * scp[56]; const f32x4 L56_0 = *(const LAS f32x4*)(LmV + 56 * LS + 0); const f32x4 L56_1 = *(const LAS f32x4*)(LmV + 56 * LS + 4); const f32x4 L55_2 = *(const LAS f32x4*)(LmV + 55 * LS + 8); const f32x4 L55_3 = *(const LAS f32x4*)(LmV + 55 * LS + 12); const f32x4 L55_4 = *(const LAS f32x4*)(LmV + 55 * LS + 16); const f32x4 L55_5 = *(const LAS f32x4*)(LmV + 55 * LS + 20); const f32x4 L55_6 = *(const LAS f32x4*)(LmV + 55 * LS + 24); const f32x4 L55_7 = *(const LAS f32x4*)(LmV + 55 * LS + 28); const f32x4 L55_8 = *(const LAS f32x4*)(LmV + 55 * LS + 32); const f32x4 L55_9 = *(const LAS f32x4*)(LmV + 55 * LS + 36); const f32x4 L55_10 = *(const LAS f32x4*)(LmV + 55 * LS + 40); const f32x4 L55_11 = *(const LAS f32x4*)(LmV + 55 * LS + 44); const f32x4 L55_12 = *(const LAS f32x4*)(LmV + 55 * LS + 48); const f32x4 L55_13 = *(const LAS f32x4*)(LmV + 55 * LS + 52);
        float x55; { float a0 = rr55, a1 = 0.f, a2 = 0.f, a3 = 0.f; a0 -= L55_0[0] * x0; a1 -= L55_0[1] * x1; a2 -= L55_0[2] * x2; a3 -= L55_0[3] * x3; a0 -= L55_1[0] * x4; a1 -= L55_1[1] * x5; a2 -= L55_1[2] * x6; a3 -= L55_1[3] * x7; a0 -= L55_2[0] * x8; a1 -= L55_2[1] * x9; a2 -= L55_2[2] * x10; a3 -= L55_2[3] * x11; a0 -= L55_3[0] * x12; a1 -= L55_3[1] * x13; a2 -= L55_3[2] * x14; a3 -= L55_3[3] * x15; a0 -= L55_4[0] * x16; a1 -= L55_4[1] * x17; a2 -= L55_4[2] * x18; a3 -= L55_4[3] * x19; a0 -= L55_5[0] * x20; a1 -= L55_5[1] * x21; a2 -= L55_5[2] * x22; a3 -= L55_5[3] * x23; a0 -= L55_6[0] * x24; a1 -= L55_6[1] * x25; a2 -= L55_6[2] * x26; a3 -= L55_6[3] * x27; a0 -= L55_7[0] * x28; a1 -= L55_7[1] * x29; a2 -= L55_7[2] * x30; a3 -= L55_7[3] * x31; a0 -= L55_8[0] * x32; a1 -= L55_8[1] * x33; a2 -= L55_8[2] * x34; a3 -= L55_8[3] * x35; a0 -= L55_9[0] * x36; a1 -= L55_9[1] * x37; a2 -= L55_9[2] * x38; a3 -= L55_9[3] * x39; a0 -= L55_10[0] * x40; a1 -= L55_10[1] * x41; a2 -= L55_10[2] * x42; a3 -= L55_10[3] * x43; a0 -= L55_11[0] * x44; a1 -= L55_11[1] * x45; a2 -= L55_11[2] * x46; a3 -= L55_11[3] * x47; a0 -= L55_12[0] * x48; a1 -= L55_12[1] * x49; a2 -= L55_12[2] * x50; a3 -= L55_12[3] * x51; a0 -= L55_13[0] * x52; a1 -= L55_13[1] * x53; a2 -= L55_13[2] * x54; x55 = (a0 + a1) + (a2 + a3); }
        asm volatile("" ::: "memory");
        const float rr57 = X[57 * XS] * scp[57]; const f32x4 L57_0 = *(const LAS f32x4*)(LmV + 57 * LS + 0); const f32x4 L57_1 = *(const LAS f32x4*)(LmV + 57 * LS + 4); const f32x4 L56_2 = *(const LAS f32x4*)(LmV + 56 * LS + 8); const f32x4 L56_3 = *(const LAS f32x4*)(LmV + 56 * LS + 12); const f32x4 L56_4 = *(const LAS f32x4*)(LmV + 56 * LS + 16); const f32x4 L56_5 = *(const LAS f32x4*)(LmV + 56 * LS + 20); const f32x4 L56_6 = *(const LAS f32x4*)(LmV + 56 * LS + 24); const f32x4 L56_7 = *(const LAS f32x4*)(LmV + 56 * LS + 28); const f32x4 L56_8 = *(const LAS f32x4*)(LmV + 56 * LS + 32); const f32x4 L56_9 = *(const LAS f32x4*)(LmV + 56 * LS + 36); const f32x4 L56_10 = *(const LAS f32x4*)(LmV + 56 * LS + 40); const f32x4 L56_11 = *(const LAS f32x4*)(LmV + 56 * LS + 44); const f32x4 L56_12 = *(const LAS f32x4*)(LmV + 56 * LS + 48); const f32x4 L56_13 = *(const LAS f32x4*)(LmV + 56 * LS + 52);
        float x56; { float a0 = rr56, a1 = 0.f, a2 = 0.f, a3 = 0.f; a0 -= L56_0[0] * x0; a1 -= L56_0[1] * x1; a2 -= L56_0[2] * x2; a3 -= L56_0[3] * x3; a0 -= L56_1[0] * x4; a1 -= L56_1[1] * x5; a2 -= L56_1[2] * x6; a3 -= L56_1[3] * x7; a0 -= L56_2[0] * x8; a1 -= L56_2[1] * x9; a2 -= L56_2[2] * x10; a3 -= L56_2[3] * x11; a0 -= L56_3[0] * x12; a1 -= L56_3[1] * x13; a2 -= L56_3[2] * x14; a3 -= L56_3[3] * x15; a0 -= L56_4[0] * x16; a1 -= L56_4[1] * x17; a2 -= L56_4[2] * x18; a3 -= L56_4[3] * x19; a0 -= L56_5[0] * x20; a1 -= L56_5[1] * x21; a2 -= L56_5[2] * x22; a3 -= L56_5[3] * x23; a0 -= L56_6[0] * x24; a1 -= L56_6[1] * x25; a2 -= L56_6[2] * x26; a3 -= L56_6[3] * x27; a0 -= L56_7[0] * x28; a1 -= L56_7[1] * x29; a2 -= L56_7[2] * x30; a3 -= L56_7[3] * x31; a0 -= L56_8[0] * x32; a1 -= L56_8[1] * x33; a2 -= L56_8[2] * x34; a3 -= L56_8[3] * x35; a0 -= L56_9[0] * x36; a1 -= L56_9[1] * x37; a2 -= L56_9[2] * x38; a3 -= L56_9[3] * x39; a0 -= L56_10[0] * x40; a1 -= L56_10[1] * x41; a2 -= L56_10[2] * x42; a3 -= L56_10[3] * x43; a0 -= L56_11[0] * x44; a1 -= L56_11[1] * x45; a2 -= L56_11[2] * x46; a3 -= L56_11[3] * x47; a0 -= L56_12[0] * x48; a1 -= L56_12[1] * x49; a2 -= L56_12[2] * x50; a3 -= L56_12[3] * x51; a0 -= L56_13[0] * x52; a1 -= L56_13[1] * x53; a2 -= L56_13[2] * x54; a3 -= L56_13[3] * x55; x56 = (a0 + a1) + (a2 + a3); }
        asm volatile("" ::: "memory");
        const float rr58 = X[58 * XS] * scp[58]; const f32x4 L58_0 = *(const LAS f32x4*)(LmV + 58 * LS + 0); const f32x4 L58_1 = *(const LAS f32x4*)(LmV + 58 * LS + 4); const f32x4 L57_2 = *(const LAS f32x4*)(LmV + 57 * LS + 8); const f32x4 L57_3 = *(const LAS f32x4*)(LmV + 57 * LS + 12); const f32x4 L57_4 = *(const LAS f32x4*)(LmV + 57 * LS + 16); const f32x4 L57_5 = *(const LAS f32x4*)(LmV + 57 * LS + 20); const f32x4 L57_6 = *(const LAS f32x4*)(LmV + 57 * LS + 24); const f32x4 L57_7 = *(const LAS f32x4*)(LmV + 57 * LS + 28); const f32x4 L57_8 = *(const LAS f32x4*)(LmV + 57 * LS + 32); const f32x4 L57_9 = *(const LAS f32x4*)(LmV + 57 * LS + 36); const f32x4 L57_10 = *(const LAS f32x4*)(LmV + 57 * LS + 40); const f32x4 L57_11 = *(const LAS f32x4*)(LmV + 57 * LS + 44); const f32x4 L57_12 = *(const LAS f32x4*)(LmV + 57 * LS + 48); const f32x4 L57_13 = *(const LAS f32x4*)(LmV + 57 * LS + 52); const f32x4 L57_14 = *(const LAS f32x4*)(LmV + 57 * LS + 56);
        float x57; { float a0 = rr57, a1 = 0.f, a2 = 0.f, a3 = 0.f; a0 -= L57_0[0] * x0; a1 -= L57_0[1] * x1; a2 -= L57_0[2] * x2; a3 -= L57_0[3] * x3; a0 -= L57_1[0] * x4; a1 -= L57_1[1] * x5; a2 -= L57_1[2] * x6; a3 -= L57_1[3] * x7; a0 -= L57_2[0] * x8; a1 -= L57_2[1] * x9; a2 -= L57_2[2] * x10; a3 -= L57_2[3] * x11; a0 -= L57_3[0] * x12; a1 -= L57_3[1] * x13; a2 -= L57_3[2] * x14; a3 -= L57_3[3] * x15; a0 -= L57_4[0] * x16; a1 -= L57_4[1] * x17; a2 -= L57_4[2] * x18; a3 -= L57_4[3] * x19; a0 -= L57_5[0] * x20; a1 -= L57_5[1] * x21; a2 -= L57_5[2] * x22; a3 -= L57_5[3] * x23; a0 -= L57_6[0] * x24; a1 -= L57_6[1] * x25; a2 -= L57_6[2] * x26; a3 -= L57_6[3] * x27; a0 -= L57_7[0] * x28; a1 -= L57_7[1] * x29; a2 -= L57_7[2] * x30; a3 -= L57_7[3] * x31; a0 -= L57_8[0] * x32; a1 -= L57_8[1] * x33; a2 -= L57_8[2] * x34; a3 -= L57_8[3] * x35; a0 -= L57_9[0] * x36; a1 -= L57_9[1] * x37; a2 -= L57_9[2] * x38; a3 -= L57_9[3] * x39; a0 -= L57_10[0] * x40; a1 -= L57_10[1] * x41; a2 -= L57_10[2] * x42; a3 -= L57_10[3] * x43; a0 -= L57_11[0] * x44; a1 -= L57_11[1] * x45; a2 -= L57_11[2] * x46; a3 -= L57_11[3] * x47; a0 -= L57_12[0] * x48; a1 -= L57_12[1] * x49; a2 -= L57_12[2] * x50; a3 -= L57_12[3] * x51; a0 -= L57_13[0] * x52; a1 -= L57_13[1] * x53; a2 -= L57_13[2] * x54; a3 -= L57_13[3] * x55; a0 -= L57_14[0] * x56; x57 = (a0 + a1) + (a2 + a3); }
        asm volatile("" ::: "memory");
        const float rr59 = X[59 * XS] * scp[59]; const f32x4 L59_0 = *(const LAS f32x4*)(LmV + 59 * LS + 0); const f32x4 L59_1 = *(const LAS f32x4*)(LmV + 59 * LS + 4); const f32x4 L58_2 = *(const LAS f32x4*)(LmV + 58 * LS + 8); const f32x4 L58_3 = *(const LAS f32x4*)(LmV + 58 * LS + 12); const f32x4 L58_4 = *(const LAS f32x4*)(LmV + 58 * LS + 16); const f32x4 L58_5 = *(const LAS f32x4*)(LmV + 58 * LS + 20); const f32x4 L58_6 = *(const LAS f32x4*)(LmV + 58 * LS + 24); const f32x4 L58_7 = *(const LAS f32x4*)(LmV + 58 * LS + 28); const f32x4 L58_8 = *(const LAS f32x4*)(LmV + 58 * LS + 32); const f32x4 L58_9 = *(const LAS f32x4*)(LmV + 58 * LS + 36); const f32x4 L58_10 = *(const LAS f32x4*)(LmV + 58 * LS + 40); const f32x4 L58_11 = *(const LAS f32x4*)(LmV + 58 * LS + 44); const f32x4 L58_12 = *(const LAS f32x4*)(LmV + 58 * LS + 48); const f32x4 L58_13 = *(const LAS f32x4*)(LmV + 58 * LS + 52); const f32x4 L58_14 = *(const LAS f32x4*)(LmV + 58 * LS + 56);
        float x58; { float a0 = rr58, a1 = 0.f, a2 = 0.f, a3 = 0.f; a0 -= L58_0[0] * x0; a1 -= L58_0[1] * x1; a2 -= L58_0[2] * x2; a3 -= L58_0[3] * x3; a0 -= L58_1[0] * x4; a1 -= L58_1[1] * x5; a2 -= L58_1[2] * x6; a3 -= L58_1[3] * x7; a0 -= L58_2[0] * x8; a1 -= L58_2[1] * x9; a2 -= L58_2[2] * x10; a3 -= L58_2[3] * x11; a0 -= L58_3[0] * x12; a1 -= L58_3[1] * x13; a2 -= L58_3[2] * x14; a3 -= L58_3[3] * x15; a0 -= L58_4[0] * x16; a1 -= L58_4[1] * x17; a2 -= L58_4[2] * x18; a3 -= L58_4[3] * x19; a0 -= L58_5[0] * x20; a1 -= L58_5[1] * x21; a2 -= L58_5[2] * x22; a3 -= L58_5[3] * x23; a0 -= L58_6[0] * x24; a1 -= L58_6[1] * x25; a2 -= L58_6[2] * x26; a3 -= L58_6[3] * x27; a0 -= L58_7[0] * x28; a1 -= L58_7[1] * x29; a2 -= L58_7[2] * x30; a3 -= L58_7[3] * x31; a0 -= L58_8[0] * x32; a1 -= L58_8[1] * x33; a2 -= L58_8[2] * x34; a3 -= L58_8[3] * x35; a0 -= L58_9[0] * x36; a1 -= L58_9[1] * x37; a2 -= L58_9[2] * x38; a3 -= L58_9[3] * x39; a0 -= L58_10[0] * x40; a1 -= L58_10[1] * x41; a2 -= L58_10[2] * x42; a3 -= L58_10[3] * x43; a0 -= L58_11[0] * x44; a1 -= L58_11[1] * x45; a2 -= L58_11[2] * x46; a3 -= L58_11[3] * x47; a0 -= L58_12[0] * x48; a1 -= L58_12[1] * x49; a2 -= L58_12[2] * x50; a3 -= L58_12[3] * x51; a0 -= L58_13[0] * x52; a1 -= L58_13[1] * x53; a2 -= L58_13[2] * x54; a3 -= L58_13[3] * x55; a0 -= L58_14[0] * x56; a1 -= L58_14[1] * x57; x58 = (a0 + a1) + (a2 + a3); }
        asm volatile("" ::: "memory");
        const float rr60 = X[60 * XS] * scp[60]; const f32x4 L60_0 = *(const LAS f32x4*)(LmV + 60 * LS + 0); const f32x4 L60_1 = *(const LAS f32x4*)(LmV + 60 * LS + 4); const f32x4 L59_2 = *(const LAS f32x4*)(LmV + 59 * LS + 8); const f32x4 L59_3 = *(const LAS f32x4*)(LmV + 59 * LS + 12); const f32x4 L59_4 = *(const LAS f32x4*)(LmV + 59 * LS + 16); const f32x4 L59_5 = *(const LAS f32x4*)(LmV + 59 * LS + 20); const f32x4 L59_6 = *(const LAS f32x4*)(LmV + 59 * LS + 24); const f32x4 L59_7 = *(const LAS f32x4*)(LmV + 59 * LS + 28); const f32x4 L59_8 = *(const LAS f32x4*)(LmV + 59 * LS + 32); const f32x4 L59_9 = *(const LAS f32x4*)(LmV + 59 * LS + 36); const f32x4 L59_10 = *(const LAS f32x4*)(LmV + 59 * LS + 40); const f32x4 L59_11 = *(const LAS f32x4*)(LmV + 59 * LS + 44); const f32x4 L59_12 = *(const LAS f32x4*)(LmV + 59 * LS + 48); const f32x4 L59_13 = *(const LAS f32x4*)(LmV + 59 * LS + 52); const f32x4 L59_14 = *(const LAS f32x4*)(LmV + 59 * LS + 56);
        float x59; { float a0 = rr59, a1 = 0.f, a2 = 0.f, a3 = 0.f; a0 -= L59_0[0] * x0; a1 -= L59_0[1] * x1; a2 -= L59_0[2] * x2; a3 -= L59_0[3] * x3; a0 -= L59_1[0] * x4; a1 -= L59_1[1] * x5; a2 -= L59_1[2] * x6; a3 -= L59_1[3] * x7; a0 -= L59_2[0] * x8; a1 -= L59_2[1] * x9; a2 -= L59_2[2] * x10; a3 -= L59_2[3] * x11; a0 -= L59_3[0] * x12; a1 -= L59_3[1] * x13; a2 -= L59_3[2] * x14; a3 -= L59_3[3] * x15; a0 -= L59_4[0] * x16; a1 -= L59_4[1] * x17; a2 -= L59_4[2] * x18; a3 -= L59_4[3] * x19; a0 -= L59_5[0] * x20; a1 -= L59_5[1] * x21; a2 -= L59_5[2] * x22; a3 -= L59_5[3] * x23; a0 -= L59_6[0] * x24; a1 -= L59_6[1] * x25; a2 -= L59_6[2] * x26; a3 -= L59_6[3] * x27; a0 -= L59_7[0] * x28; a1 -= L59_7[1] * x29; a2 -= L59_7[2] * x30; a3 -= L59_7[3] * x31; a0 -= L59_8[0] * x32; a1 -= L59_8[1] * x33; a2 -= L59_8[2] * x34; a3 -= L59_8[3] * x35; a0 -= L59_9[0] * x36; a1 -= L59_9[1] * x37; a2 -= L59_9[2] * x38; a3 -= L59_9[3] * x39; a0 -= L59_10[0] * x40; a1 -= L59_10[1] * x41; a2 -= L59_10[2] * x42; a3 -= L59_10[3] * x43; a0 -= L59_11[0] * x44; a1 -= L59_11[1] * x45; a2 -= L59_11[2] * x46; a3 -= L59_11[3] * x47; a0 -= L59_12[0] * x48; a1 -= L59_12[1] * x49; a2 -= L59_12[2] * x50; a3 -= L59_12[3] * x51; a0 -= L59_13[0] * x52; a1 -= L59_13[1] * x53; a2 -= L59_13[2] * x54; a3 -= L59_13[3] * x55; a0 -= L59_14[0] * x56; a1 -= L59_14[1] * x57; a2 -= L59_14[2] * x58; x59 = (a0 + a1) + (a2 + a3); }
        asm volatile("" ::: "memory");
        const float rr61 = X[61 * XS] * scp[61]; const f32x4 L61_0 = *(const LAS f32x4*)(LmV + 61 * LS + 0); const f32x4 L61_1 = *(const LAS f32x4*)(LmV + 61 * LS + 4); const f32x4 L60_2 = *(const LAS f32x4*)(LmV + 60 * LS + 8); const f32x4 L60_3 = *(const LAS f32x4*)(LmV + 60 * LS + 12); const f32x4 L60_4 = *(const LAS f32x4*)(LmV + 60 * LS + 16); const f32x4 L60_5 = *(const LAS f32x4*)(LmV + 60 * LS + 20); const f32x4 L60_6 = *(const LAS f32x4*)(LmV + 60 * LS + 24); const f32x4 L60_7 = *(const LAS f32x4*)(LmV + 60 * LS + 28); const f32x4 L60_8 = *(const LAS f32x4*)(LmV + 60 * LS + 32); const f32x4 L60_9 = *(const LAS f32x4*)(LmV + 60 * LS + 36); const f32x4 L60_10 = *(const LAS f32x4*)(LmV + 60 * LS + 40); const f32x4 L60_11 = *(const LAS f32x4*)(LmV + 60 * LS + 44); const f32x4 L60_12 = *(const LAS f32x4*)(LmV + 60 * LS + 48); const f32x4 L60_13 = *(const LAS f32x4*)(LmV + 60 * LS + 52); const f32x4 L60_14 = *(const LAS f32x4*)(LmV + 60 * LS + 56);
        float x60; { float a0 = rr60, a1 = 0.f, a2 = 0.f, a3 = 0.f; a0 -= L60_0[0] * x0; a1 -= L60_0[1] * x1; a2 -= L60_0[2] * x2; a3 -= L60_0[3] * x3; a0 -= L60_1[0] * x4; a1 -= L60_1[1] * x5; a2 -= L60_1[2] * x6; a3 -= L60_1[3] * x7; a0 -= L60_2[0] * x8; a1 -= L60_2[1] * x9; a2 -= L60_2[2] * x10; a3 -= L60_2[3] * x11; a0 -= L60_3[0] * x12; a1 -= L60_3[1] * x13; a2 -= L60_3[2] * x14; a3 -= L60_3[3] * x15; a0 -= L60_4[0] * x16; a1 -= L60_4[1] * x17; a2 -= L60_4[2] * x18; a3 -= L60_4[3] * x19; a0 -= L60_5[0] * x20; a1 -= L60_5[1] * x21; a2 -= L60_5[2] * x22; a3 -= L60_5[3] * x23; a0 -= L60_6[0] * x24; a1 -= L60_6[1] * x25; a2 -= L60_6[2] * x26; a3 -= L60_6[3] * x27; a0 -= L60_7[0] * x28; a1 -= L60_7[1] * x29; a2 -= L60_7[2] * x30; a3 -= L60_7[3] * x31; a0 -= L60_8[0] * x32; a1 -= L60_8[1] * x33; a2 -= L60_8[2] * x34; a3 -= L60_8[3] * x35; a0 -= L60_9[0] * x36; a1 -= L60_9[1] * x37; a2 -= L60_9[2] * x38; a3 -= L60_9[3] * x39; a0 -= L60_10[0] * x40; a1 -= L60_10[1] * x41; a2 -= L60_10[2] * x42; a3 -= L60_10[3] * x43; a0 -= L60_11[0] * x44; a1 -= L60_11[1] * x45; a2 -= L60_11[2] * x46; a3 -= L60_11[3] * x47; a0 -= L60_12[0] * x48; a1 -= L60_12[1] * x49; a2 -= L60_12[2] * x50; a3 -= L60_12[3] * x51; a0 -= L60_13[0] * x52; a1 -= L60_13[1] * x53; a2 -= L60_13[2] * x54; a3 -= L60_13[3] * x55; a0 -= L60_14[0] * x56; a1 -= L60_14[1] * x57; a2 -= L60_14[2] * x58; a3 -= L60_14[3] * x59; x60 = (a0 + a1) + (a2 + a3); }
        asm volatile("" ::: "memory");
        const float rr62 = X[62 * XS] * scp[62]; const f32x4 L62_0 = *(const LAS f32x4*)(LmV + 62 * LS + 0); const f32x4 L62_1 = *(const LAS f32x4*)(LmV + 62 * LS + 4); const f32x4 L61_2 = *(const LAS f32x4*)(LmV + 61 * LS + 8); const f32x4 L61_3 = *(const LAS f32x4*)(LmV + 61 * LS + 12); const f32x4 L61_4 = *(const LAS f32x4*)(LmV + 61 * LS + 16); const f32x4 L61_5 = *(const LAS f32x4*)(LmV + 61 * LS + 20); const f32x4 L61_6 = *(const LAS f32x4*)(LmV + 61 * LS + 24); const f32x4 L61_7 = *(const LAS f32x4*)(LmV + 61 * LS + 28); const f32x4 L61_8 = *(const LAS f32x4*)(LmV + 61 * LS + 32); const f32x4 L61_9 = *(const LAS f32x4*)(LmV + 61 * LS + 36); const f32x4 L61_10 = *(const LAS f32x4*)(LmV + 61 * LS + 40); const f32x4 L61_11 = *(const LAS f32x4*)(LmV + 61 * LS + 44); const f32x4 L61_12 = *(const LAS f32x4*)(LmV + 61 * LS + 48); const f32x4 L61_13 = *(const LAS f32x4*)(LmV + 61 * LS + 52); const f32x4 L61_14 = *(const LAS f32x4*)(LmV + 61 * LS + 56); const f32x4 L61_15 = *(const LAS f32x4*)(LmV + 61 * LS + 60);
        float x61; { float a0 = rr61, a1 = 0.f, a2 = 0.f, a3 = 0.f; a0 -= L61_0[0] * x0; a1 -= L61_0[1] * x1; a2 -= L61_0[2] * x2; a3 -= L61_0[3] * x3; a0 -= L61_1[0] * x4; a1 -= L61_1[1] * x5; a2 -= L61_1[2] * x6; a3 -= L61_1[3] * x7; a0 -= L61_2[0] * x8; a1 -= L61_2[1] * x9; a2 -= L61_2[2] * x10; a3 -= L61_2[3] * x11; a0 -= L61_3[0] * x12; a1 -= L61_3[1] * x13; a2 -= L61_3[2] * x14; a3 -= L61_3[3] * x15; a0 -= L61_4[0] * x16; a1 -= L61_4[1] * x17; a2 -= L61_4[2] * x18; a3 -= L61_4[3] * x19; a0 -= L61_5[0] * x20; a1 -= L61_5[1] * x21; a2 -= L61_5[2] * x22; a3 -= L61_5[3] * x23; a0 -= L61_6[0] * x24; a1 -= L61_6[1] * x25; a2 -= L61_6[2] * x26; a3 -= L61_6[3] * x27; a0 -= L61_7[0] * x28; a1 -= L61_7[1] * x29; a2 -= L61_7[2] * x30; a3 -= L61_7[3] * x31; a0 -= L61_8[0] * x32; a1 -= L61_8[1] * x33; a2 -= L61_8[2] * x34; a3 -= L61_8[3] * x35; a0 -= L61_9[0] * x36; a1 -= L61_9[1] * x37; a2 -= L61_9[2] * x38; a3 -= L61_9[3] * x39; a0 -= L61_10[0] * x40; a1 -= L61_10[1] * x41; a2 -= L61_10[2] * x42; a3 -= L61_10[3] * x43; a0 -= L61_11[0] * x44; a1 -= L61_11[1] * x45; a2 -= L61_11[2] * x46; a3 -= L61_11[3] * x47; a0 -= L61_12[0] * x48; a1 -= L61_12[1] * x49; a2 -= L61_12[2] * x50; a3 -= L61_12[3] * x51; a0 -= L61_13[0] * x52; a1 -= L61_13[1] * x53; a2 -= L61_13[2] * x54; a3 -= L61_13[3] * x55; a0 -= L61_14[0] * x56; a1 -= L61_14[1] * x57; a2 -= L61_14[2] * x58; a3 -= L61_14[3] * x59; a0 -= L61_15[0] * x60; x61 = (a0 + a1) + (a2 + a3); }
        asm volatile("" ::: "memory");
        const float rr63 = X[63 * XS] * scp[63]; const f32x4 L63_0 = *(const LAS f32x4*)(LmV + 63 * LS + 0); const f32x4 L63_1 = *(const LAS f32x4*)(LmV + 63 * LS + 4); const f32x4 L62_2 = *(const LAS f32x4*)(LmV + 62 * LS + 8); const f32x4 L62_3 = *(const LAS f32x4*)(LmV + 62 * LS + 12); const f32x4 L62_4 = *(const LAS f32x4*)(LmV + 62 * LS + 16); const f32x4 L62_5 = *(const LAS f32x4*)(LmV + 62 * LS + 20); const f32x4 L62_6 = *(const LAS f32x4*)(LmV + 62 * LS + 24); const f32x4 L62_7 = *(const LAS f32x4*)(LmV + 62 * LS + 28); const f32x4 L62_8 = *(const LAS f32x4*)(LmV + 62 * LS + 32); const f32x4 L62_9 = *(const LAS f32x4*)(LmV + 62 * LS + 36); const f32x4 L62_10 = *(const LAS f32x4*)(LmV + 62 * LS + 40); const f32x4 L62_11 = *(const LAS f32x4*)(LmV + 62 * LS + 44); const f32x4 L62_12 = *(const LAS f32x4*)(LmV + 62 * LS + 48); const f32x4 L62_13 = *(const LAS f32x4*)(LmV + 62 * LS + 52); const f32x4 L62_14 = *(const LAS f32x4*)(LmV + 62 * LS + 56); const f32x4 L62_15 = *(const LAS f32x4*)(LmV + 62 * LS + 60);
        float x62; { float a0 = rr62, a1 = 0.f, a2 = 0.f, a3 = 0.f; a0 -= L62_0[0] * x0; a1 -= L62_0[1] * x1; a2 -= L62_0[2] * x2; a3 -= L62_0[3] * x3; a0 -= L62_1[0] * x4; a1 -= L62_1[1] * x5; a2 -= L62_1[2] * x6; a3 -= L62_1[3] * x7; a0 -= L62_2[0] * x8; a1 -= L62_2[1] * x9; a2 -= L62_2[2] * x10; a3 -= L62_2[3] * x11; a0 -= L62_3[0] * x12; a1 -= L62_3[1] * x13; a2 -= L62_3[2] * x14; a3 -= L62_3[3] * x15; a0 -= L62_4[0] * x16; a1 -= L62_4[1] * x17; a2 -= L62_4[2] * x18; a3 -= L62_4[3] * x19; a0 -= L62_5[0] * x20; a1 -= L62_5[1] * x21; a2 -= L62_5[2] * x22; a3 -= L62_5[3] * x23; a0 -= L62_6[0] * x24; a1 -= L62_6[1] * x25; a2 -= L62_6[2] * x26; a3 -= L62_6[3] * x27; a0 -= L62_7[0] * x28; a1 -= L62_7[1] * x29; a2 -= L62_7[2] * x30; a3 -= L62_7[3] * x31; a0 -= L62_8[0] * x32; a1 -= L62_8[1] * x33; a2 -= L62_8[2] * x34; a3 -= L62_8[3] * x35; a0 -= L62_9[0] * x36; a1 -= L62_9[1] * x37; a2 -= L62_9[2] * x38; a3 -= L62_9[3] * x39; a0 -= L62_10[0] * x40; a1 -= L62_10[1] * x41; a2 -= L62_10[2] * x42; a3 -= L62_10[3] * x43; a0 -= L62_11[0] * x44; a1 -= L62_11[1] * x45; a2 -= L62_11[2] * x46; a3 -= L62_11[3] * x47; a0 -= L62_12[0] * x48; a1 -= L62_12[1] * x49; a2 -= L62_12[2] * x50; a3 -= L62_12[3] * x51; a0 -= L62_13[0] * x52; a1 -= L62_13[1] * x53; a2 -= L62_13[2] * x54; a3 -= L62_13[3] * x55; a0 -= L62_14[0] * x56; a1 -= L62_14[1] * x57; a2 -= L62_14[2] * x58; a3 -= L62_14[3] * x59; a0 -= L62_15[0] * x60; a1 -= L62_15[1] * x61; x62 = (a0 + a1) + (a2 + a3); }
        asm volatile("" ::: "memory");
 const f32x4 L63_2 = *(const LAS f32x4*)(LmV + 63 * LS + 8); const f32x4 L63_3 = *(const LAS f32x4*)(LmV + 63 * LS + 12); const f32x4 L63_4 = *(const LAS f32x4*)(LmV + 63 * LS + 16); const f32x4 L63_5 = *(const LAS f32x4*)(LmV + 63 * LS + 20); const f32x4 L63_6 = *(const LAS f32x4*)(LmV + 63 * LS + 24); const f32x4 L63_7 = *(const LAS f32x4*)(LmV + 63 * LS + 28); const f32x4 L63_8 = *(const LAS f32x4*)(LmV + 63 * LS + 32); const f32x4 L63_9 = *(const LAS f32x4*)(LmV + 63 * LS + 36); const f32x4 L63_10 = *(const LAS f32x4*)(LmV + 63 * LS + 40); const f32x4 L63_11 = *(const LAS f32x4*)(LmV + 63 * LS + 44); const f32x4 L63_12 = *(const LAS f32x4*)(LmV + 63 * LS + 48); const f32x4 L63_13 = *(const LAS f32x4*)(LmV + 63 * LS + 52); const f32x4 L63_14 = *(const LAS f32x4*)(LmV + 63 * LS + 56); const f32x4 L63_15 = *(const LAS f32x4*)(LmV + 63 * LS + 60);
        float x63; { float a0 = rr63, a1 = 0.f, a2 = 0.f, a3 = 0.f; a0 -= L63_0[0] * x0; a1 -= L63_0[1] * x1; a2 -= L63_0[2] * x2; a3 -= L63_0[3] * x3; a0 -= L63_1[0] * x4; a1 -= L63_1[1] * x5; a2 -= L63_1[2] * x6; a3 -= L63_1[3] * x7; a0 -= L63_2[0] * x8; a1 -= L63_2[1] * x9; a2 -= L63_2[2] * x10; a3 -= L63_2[3] * x11; a0 -= L63_3[0] * x12; a1 -= L63_3[1] * x13; a2 -= L63_3[2] * x14; a3 -= L63_3[3] * x15; a0 -= L63_4[0] * x16; a1 -= L63_4[1] * x17; a2 -= L63_4[2] * x18; a3 -= L63_4[3] * x19; a0 -= L63_5[0] * x20; a1 -= L63_5[1] * x21; a2 -= L63_5[2] * x22; a3 -= L63_5[3] * x23; a0 -= L63_6[0] * x24; a1 -= L63_6[1] * x25; a2 -= L63_6[2] * x26; a3 -= L63_6[3] * x27; a0 -= L63_7[0] * x28; a1 -= L63_7[1] * x29; a2 -= L63_7[2] * x30; a3 -= L63_7[3] * x31; a0 -= L63_8[0] * x32; a1 -= L63_8[1] * x33; a2 -= L63_8[2] * x34; a3 -= L63_8[3] * x35; a0 -= L63_9[0] * x36; a1 -= L63_9[1] * x37; a2 -= L63_9[2] * x38; a3 -= L63_9[3] * x39; a0 -= L63_10[0] * x40; a1 -= L63_10[1] * x41; a2 -= L63_10[2] * x42; a3 -= L63_10[3] * x43; a0 -= L63_11[0] * x44; a1 -= L63_11[1] * x45; a2 -= L63_11[2] * x46; a3 -= L63_11[3] * x47; a0 -= L63_12[0] * x48; a1 -= L63_12[1] * x49; a2 -= L63_12[2] * x50; a3 -= L63_12[3] * x51; a0 -= L63_13[0] * x52; a1 -= L63_13[1] * x53; a2 -= L63_13[2] * x54; a3 -= L63_13[3] * x55; a0 -= L63_14[0] * x56; a1 -= L63_14[1] * x57; a2 -= L63_14[2] * x58; a3 -= L63_14[3] * x59; a0 -= L63_15[0] * x60; a1 -= L63_15[1] * x61; a2 -= L63_15[2] * x62; x63 = (a0 + a1) + (a2 + a3); }
        if (isv) {
            *(f32x4*)(UT + (size_t)c * 64 + 0) = (f32x4){x0, x1, x2, x3};
            *(f32x4*)(UT + (size_t)c * 64 + 4) = (f32x4){x4, x5, x6, x7};
            *(f32x4*)(UT + (size_t)c * 64 + 8) = (f32x4){x8, x9, x10, x11};
            *(f32x4*)(UT + (size_t)c * 64 + 12) = (f32x4){x12, x13, x14, x15};
            *(f32x4*)(UT + (size_t)c * 64 + 16) = (f32x4){x16, x17, x18, x19};
            *(f32x4*)(UT + (size_t)c * 64 + 20) = (f32x4){x20, x21, x22, x23};
            *(f32x4*)(UT + (size_t)c * 64 + 24) = (f32x4){x24, x25, x26, x27};
            *(f32x4*)(UT + (size_t)c * 64 + 28) = (f32x4){x28, x29, x30, x31};
            *(f32x4*)(UT + (size_t)c * 64 + 32) = (f32x4){x32, x33, x34, x35};
            *(f32x4*)(UT + (size_t)c * 64 + 36) = (f32x4){x36, x37, x38, x39};
            *(f32x4*)(UT + (size_t)c * 64 + 40) = (f32x4){x40, x41, x42, x43};
            *(f32x4*)(UT + (size_t)c * 64 + 44) = (f32x4){x44, x45, x46, x47};
            *(f32x4*)(UT + (size_t)c * 64 + 48) = (f32x4){x48, x49, x50, x51};
            *(f32x4*)(UT + (size_t)c * 64 + 52) = (f32x4){x52, x53, x54, x55};
            *(f32x4*)(UT + (size_t)c * 64 + 56) = (f32x4){x56, x57, x58, x59};
            *(f32x4*)(UT + (size_t)c * 64 + 60) = (f32x4){x60, x61, x62, x63};
        } else {
            WN[0 * 128 + (c - 128)] = (bf16)f2bf(-x0);
            WN[1 * 128 + (c - 128)] = (bf16)f2bf(-x1);
            WN[2 * 128 + (c - 128)] = (bf16)f2bf(-x2);
            WN[3 * 128 + (c - 128)] = (bf16)f2bf(-x3);
            WN[4 * 128 + (c - 128)] = (bf16)f2bf(-x4);
            WN[5 * 128 + (c - 128)] = (bf16)f2bf(-x5);
            WN[6 * 128 + (c - 128)] = (bf16)f2bf(-x6);
            WN[7 * 128 + (c - 128)] = (bf16)f2bf(-x7);
            WN[8 * 128 + (c - 128)] = (bf16)f2bf(-x8);
            WN[9 * 128 + (c - 128)] = (bf16)f2bf(-x9);
            WN[10 * 128 + (c - 128)] = (bf16)f2bf(-x10);
            WN[11 * 128 + (c - 128)] = (bf16)f2bf(-x11);
            WN[12 * 128 + (c - 128)] = (bf16)f2bf(-x12);
            WN[13 * 128 + (c - 128)] = (bf16)f2bf(-x13);
            WN[14 * 128 + (c - 128)] = (bf16)f2bf(-x14);
            WN[15 * 128 + (c - 128)] = (bf16)f2bf(-x15);
            WN[16 * 128 + (c - 128)] = (bf16)f2bf(-x16);
            WN[17 * 128 + (c - 128)] = (bf16)f2bf(-x17);
            WN[18 * 128 + (c - 128)] = (bf16)f2bf(-x18);
            WN[19 * 128 + (c - 128)] = (bf16)f2bf(-x19);
            WN[20 * 128 + (c - 128)] = (bf16)f2bf(-x20);
            WN[21 * 128 + (c - 128)] = (bf16)f2bf(-x21);
            WN[22 * 128 + (c - 128)] = (bf16)f2bf(-x22);
            WN[23 * 128 + (c - 128)] = (bf16)f2bf(-x23);
            WN[24 * 128 + (c - 128)] = (bf16)f2bf(-x24);
            WN[25 * 128 + (c - 128)] = (bf16)f2bf(-x25);
            WN[26 * 128 + (c - 128)] = (bf16)f2bf(-x26);
            WN[27 * 128 + (c - 128)] = (bf16)f2bf(-x27);
            WN[28 * 128 + (c - 128)] = (bf16)f2bf(-x28);
            WN[29 * 128 + (c - 128)] = (bf16)f2bf(-x29);
            WN[30 * 128 + (c - 128)] = (bf16)f2bf(-x30);
            WN[31 * 128 + (c - 128)] = (bf16)f2bf(-x31);
            WN[32 * 128 + (c - 128)] = (bf16)f2bf(-x32);
            WN[33 * 128 + (c - 128)] = (bf16)f2bf(-x33);
            WN[34 * 128 + (c - 128)] = (bf16)f2bf(-x34);
            WN[35 * 128 + (c - 128)] = (bf16)f2bf(-x35);
            WN[36 * 128 + (c - 128)] = (bf16)f2bf(-x36);
            WN[37 * 128 + (c - 128)] = (bf16)f2bf(-x37);
            WN[38 * 128 + (c - 128)] = (bf16)f2bf(-x38);
            WN[39 * 128 + (c - 128)] = (bf16)f2bf(-x39);
            WN[40 * 128 + (c - 128)] = (bf16)f2bf(-x40);
            WN[41 * 128 + (c - 128)] = (bf16)f2bf(-x41);
            WN[42 * 128 + (c - 128)] = (bf16)f2bf(-x42);
            WN[43 * 128 + (c - 128)] = (bf16)f2bf(-x43);
            WN[44 * 128 + (c - 128)] = (bf16)f2bf(-x44);
            WN[45 * 128 + (c - 128)] = (bf16)f2bf(-x45);
            WN[46 * 128 + (c - 128)] = (bf16)f2bf(-x46);
            WN[47 * 128 + (c - 128)] = (bf16)f2bf(-x47);
            WN[48 * 128 + (c - 128)] = (bf16)f2bf(-x48);
            WN[49 * 128 + (c - 128)] = (bf16)f2bf(-x49);
            WN[50 * 128 + (c - 128)] = (bf16)f2bf(-x50);
            WN[51 * 128 + (c - 128)] = (bf16)f2bf(-x51);
            WN[52 * 128 + (c - 128)] = (bf16)f2bf(-x52);
            WN[53 * 128 + (c - 128)] = (bf16)f2bf(-x53);
            WN[54 * 128 + (c - 128)] = (bf16)f2bf(-x54);
            WN[55 * 128 + (c - 128)] = (bf16)f2bf(-x55);
            WN[56 * 128 + (c - 128)] = (bf16)f2bf(-x56);
            WN[57 * 128 + (c - 128)] = (bf16)f2bf(-x57);
            WN[58 * 128 + (c - 128)] = (bf16)f2bf(-x58);
            WN[59 * 128 + (c - 128)] = (bf16)f2bf(-x59);
            WN[60 * 128 + (c - 128)] = (bf16)f2bf(-x60);
            WN[61 * 128 + (c - 128)] = (bf16)f2bf(-x61);
            WN[62 * 128 + (c - 128)] = (bf16)f2bf(-x62);
            WN[63 * 128 + (c - 128)] = (bf16)f2bf(-x63);
        }
    } else {
        const int t2 = tid - 256;
        { const int i = t2 >> 2, d0 = (t2 & 3) * 32; const float e = expf(gcs[i]);
#pragma unroll
          for (int q8 = 0; q8 < 4; ++q8) { const f32x4 a = *(const LAS f32x4*)(XQ + i * XS + d0 + 8 * q8), c = *(const LAS f32x4*)(XQ + i * XS + d0 + 8 * q8 + 4);
              v4u o; o.x = pk2(a[0] * e, a[1] * e); o.y = pk2(a[2] * e, a[3] * e); o.z = pk2(c[0] * e, c[1] * e); o.w = pk2(c[2] * e, c[3] * e);
              *(v4u*)(QG + (size_t)i * 128 + d0 + 8 * q8) = o; } }
        { const int d = t2 >> 1, i0 = (t2 & 1) * 32; const float gl = gcs[63];
#pragma unroll
          for (int q8 = 0; q8 < 4; ++q8) { float v[8];
#pragma unroll
              for (int e = 0; e < 8; ++e) { const int i = i0 + 8 * q8 + e; v[e] = XK[i * XS + d] * expf(gl - gcs[i]); }
              v4u o; o.x = pk2(v[0], v[1]); o.y = pk2(v[2], v[3]); o.z = pk2(v[4], v[5]); o.w = pk2(v[6], v[7]);
              *(v4u*)(KGT + (size_t)d * 64 + i0 + 8 * q8) = o; } }
        if (t2 == 0) GL[unit] = expf(gcs[63]);
    }
    __syncthreads();
}

__device__ __forceinline__ int sw256(int row, int ch) { return row * 256 + ((ch ^ (row & 15)) << 4); }
__device__ __forceinline__ int sw128(int row, int ch) { return row * 128 + ((ch ^ ((row >> 1) & 7)) << 4); }
__device__ __forceinline__ void gdnb_unit(const Params& P, LAS unsigned char* lds, int bh) {
    typedef float f32x4_ __attribute__((ext_vector_type(4)));
    const int tid = threadIdx.x, wid = __builtin_amdgcn_readfirstlane(tid >> 6), lane = tid & 63, fr = lane & 15, fq = lane >> 4;
    const int b = bh >> 2, h = bh & 3;
    const float* w_gnorm = P.in[14];
    const bf16* ZB = (const bf16*)(P.ws + WS_ZB); bf16* MIX = (bf16*)(P.ws + WS_MIX);
    LAS unsigned char* Wl = lds;
    LAS unsigned char* Ql = lds + 16384;
    LAS unsigned char* Kl = lds + 32768;
    LAS unsigned char* Ml = lds + 49152;
    LAS unsigned char* STl = lds + 57344;
    LAS unsigned char* VTl = lds + 90112;
    LAS float* OT = (LAS float*)(lds + 106496);
    f32x4_ S[8];
#pragma unroll
    for (int i = 0; i < 8; ++i) S[i] = (f32x4_){0.f, 0.f, 0.f, 0.f};
    const int e = 16 * wid + fr;
#pragma unroll
    for (int db = 0; db < 8; ++db) *(LAS v2u*)(STl + sw256(e, (16 * db + 4 * fq) >> 3) + ((4 * fq) & 7) * 2) = (v2u){0u, 0u};
    const int orow = tid >> 3, ocol = (tid & 7) * 16;
    LAS float* GNl = OT + 64 * XS;
    if (tid < 128) GNl[tid] = w_gnorm[tid];
    const size_t ubase = (size_t)bh * 32;
    v4u aW[2], aQ[2], aK[2], aM; f32x4_ utn[4]; float gln;
#define SCAN_LOAD(n_) do { const size_t un_ = ubase + (n_); \
        const v4u* WNp = (const v4u*)((const bf16*)(P.ws + WS_WN) + un_ * 8192); const v4u* QGp = (const v4u*)((const bf16*)(P.ws + WS_QG) + un_ * 8192); \
        const v4u* KGp = (const v4u*)((const bf16*)(P.ws + WS_KGT) + un_ * 8192); const v4u* QKp = (const v4u*)((const bf16*)(P.ws + WS_QKM) + un_ * 4096); \
        const float* UTp = (const float*)(P.ws + WS_UT) + un_ * 8192; gln = ((const float*)(P.ws + WS_GL))[un_]; \
        aW[0] = WNp[tid]; aW[1] = WNp[tid + 512]; aQ[0] = QGp[tid]; aQ[1] = QGp[tid + 512]; aK[0] = KGp[tid]; aK[1] = KGp[tid + 512]; aM = QKp[tid]; \
        _Pragma("unroll") for (int rb_ = 0; rb_ < 4; ++rb_) utn[rb_] = *(const f32x4_*)(UTp + (size_t)e * 64 + 16 * rb_ + 4 * fq); } while (0)
#define SCAN_STAGE() do { \
        _Pragma("unroll") for (int i_ = 0; i_ < 2; ++i_) { const int idx_ = tid + 512 * i_; \
            *(LAS v4u*)(Wl + sw256(idx_ >> 4, idx_ & 15)) = aW[i_]; *(LAS v4u*)(Ql + sw256(idx_ >> 4, idx_ & 15)) = aQ[i_]; *(LAS v4u*)(Kl + sw128(idx_ >> 3, idx_ & 7)) = aK[i_]; } \
        *(LAS v4u*)(Ml + sw128(tid >> 3, tid & 7)) = aM; } while (0)
    SCAN_LOAD(0);
    SCAN_STAGE();
    for (int n = 0; n < NCHUNK; ++n) {
        __syncthreads();
        f32x4_ vn[4];
#pragma unroll
        for (int rb = 0; rb < 4; ++rb) vn[rb] = utn[rb];
        const size_t mrow = (size_t)b * SEQ + n * GCH + orow;
        const v4u z0 = *(const v4u*)(ZB + mrow * 512 + h * 128 + ocol), z1 = *(const v4u*)(ZB + mrow * 512 + h * 128 + ocol + 8);
        const float gl = gln;
        if (n + 1 < NCHUNK) SCAN_LOAD(n + 1);
        __builtin_amdgcn_sched_barrier(0);
        bf16x8 sb[4];
#pragma unroll
        for (int ks = 0; ks < 4; ++ks) sb[ks] = *(const LAS bf16x8*)(STl + sw256(e, 4 * ks + fq));
#pragma unroll
        for (int rb = 0; rb < 4; ++rb) {
#pragma unroll
            for (int ks = 0; ks < 4; ++ks) { const bf16x8 a = *(const LAS bf16x8*)(Wl + sw256(16 * rb + fr, 4 * ks + fq)); vn[rb] = __builtin_amdgcn_mfma_f32_16x16x32_bf16(a, sb[ks], vn[rb], 0, 0, 0); }
            v2u o; o.x = pk2(vn[rb][0], vn[rb][1]); o.y = pk2(vn[rb][2], vn[rb][3]);
            *(LAS v2u*)(VTl + sw128(e, (16 * rb + 4 * fq) >> 3) + ((4 * fq) & 7) * 2) = o;
        }
        bf16x8 vb[2];
#pragma unroll
        for (int ks = 0; ks < 2; ++ks) vb[ks] = *(const LAS bf16x8*)(VTl + sw128(e, 4 * ks + fq));
#pragma unroll
        for (int rb = 0; rb < 4; ++rb) {
            f32x4_ oo = (f32x4_){0.f, 0.f, 0.f, 0.f};
#pragma unroll
            for (int ks = 0; ks < 4; ++ks) { const bf16x8 a = *(const LAS bf16x8*)(Ql + sw256(16 * rb + fr, 4 * ks + fq)); oo = __builtin_amdgcn_mfma_f32_16x16x32_bf16(a, sb[ks], oo, 0, 0, 0); }
#pragma unroll
            for (int ks = 0; ks < 2; ++ks) { const bf16x8 a = *(const LAS bf16x8*)(Ml + sw128(16 * rb + fr, 4 * ks + fq)); oo = __builtin_amdgcn_mfma_f32_16x16x32_bf16(a, vb[ks], oo, 0, 0, 0); }
#pragma unroll
            for (int j = 0; j < 4; ++j) OT[(16 * rb + 4 * fq + j) * XS + e] = oo[j];
        }
#pragma unroll
        for (int db = 0; db < 8; ++db) {
            S[db] = S[db] * gl;
#pragma unroll
            for (int ks = 0; ks < 2; ++ks) { const bf16x8 a = *(const LAS bf16x8*)(Kl + sw128(16 * db + fr, 4 * ks + fq)); S[db] = __builtin_amdgcn_mfma_f32_16x16x32_bf16(a, vb[ks], S[db], 0, 0, 0); }
            v2u o; o.x = pk2(S[db][0], S[db][1]); o.y = pk2(S[db][2], S[db][3]);
            *(LAS v2u*)(STl + sw256(e, (16 * db + 4 * fq) >> 3) + ((4 * fq) & 7) * 2) = o;
        }
        __syncthreads();
        if (n + 1 < NCHUNK) SCAN_STAGE();
        {
            f32x4_ ov[4]; float ss = 0.f;
#pragma unroll
            for (int i = 0; i < 4; ++i) { ov[i] = *(const LAS f32x4_*)(OT + orow * XS + ocol + 4 * i); ss += (ov[i][0] * ov[i][0] + ov[i][1] * ov[i][1]) + (ov[i][2] * ov[i][2] + ov[i][3] * ov[i][3]); }
            ss += __shfl_xor(ss, 1); ss += __shfl_xor(ss, 2); ss += __shfl_xor(ss, 4);
            const float rstd = 1.0f / sqrtf(ss * (1.0f / 128.0f) + RMS_EPS);
            f32x4_ gn4[4];
#pragma unroll
            for (int i = 0; i < 4; ++i) gn4[i] = *(const LAS f32x4_*)(GNl + ocol + 4 * i);
            const unsigned zw[8] = {z0.x, z0.y, z0.z, z0.w, z1.x, z1.y, z1.z, z1.w};
            unsigned ow[8];
#pragma unroll
            for (int i = 0; i < 8; ++i) { const float za = __builtin_bit_cast(float, zw[i] << 16), zb = __builtin_bit_cast(float, zw[i] & 0xffff0000u);
                const float va = ov[i >> 1][(2 * i) & 3] * rstd * gn4[i >> 1][(2 * i) & 3] * silu_f(za), vb_ = ov[i >> 1][(2 * i + 1) & 3] * rstd * gn4[i >> 1][(2 * i + 1) & 3] * silu_f(zb);
                ow[i] = pk2(va, vb_); }
            bf16* mp = MIX + mrow * DM + 512 + h * 128 + ocol;
            *(v4u*)mp = (v4u){ow[0], ow[1], ow[2], ow[3]}; *(v4u*)(mp + 8) = (v4u){ow[4], ow[5], ow[6], ow[7]};
        }
        asm volatile("" : "+v"(utn[0]), "+v"(utn[1]), "+v"(utn[2]), "+v"(utn[3]), "+v"(gln));
    }
#undef SCAN_LOAD
#undef SCAN_STAGE
    float* So = P.out + OSSM_P + (size_t)bh * 16384;
#pragma unroll
    for (int db = 0; db < 8; ++db)
#pragma unroll
        for (int j = 0; j < 4; ++j) So[(size_t)(16 * db + 4 * fq + j) * 128 + e] = S[db][j];
    __syncthreads();
}


__device__ __forceinline__ f32x4 sgemm_slice16(const bf16* A, int lda, const bf16* Bt, int ldb, int n0, int k0, int k1, int wid, int fr, int fq) {
    f32x4 acc = {0.f, 0.f, 0.f, 0.f};
    const bf16* ap = A + (size_t)(16 * wid + fr) * lda + 8 * fq;
    const bf16* bp = Bt + (size_t)(n0 + fr) * ldb + 8 * fq;
#pragma unroll 8
    for (int ks = k0; ks < k1; ks += 32) {
        const bf16x8 a = *(const bf16x8*)(ap + ks), b = *(const bf16x8*)(bp + ks);
        acc = __builtin_amdgcn_mfma_f32_16x16x32_bf16(b, a, acc, 0, 0, 0);
    }
    return acc;
}
__device__ __forceinline__ void sample_wo_slice(const Params& P, int slice) {
    const int tid = threadIdx.x, wid = __builtin_amdgcn_readfirstlane(tid >> 6), lane = tid & 63, fr = lane & 15, fq = lane >> 4;
    const bf16* MIX = (const bf16*)(P.ws + WS_MIX) + (size_t)MP * DM; const bf16* WOT = (const bf16*)(P.ws + WS_WOT);
    bf16* HB = (bf16*)(P.ws + WS_HB) + (size_t)MP * DM; float* SSQS = (float*)(P.ws + WS_SSQS);
    const f32x4 acc = sgemm_slice16(MIX, DM, WOT, DM, 16 * slice, 0, DM, wid, fr, fq);
    const int m = 16 * wid + fr, n = 16 * slice + 4 * fq;
    const f32x4 h = acc + *(const f32x4*)(P.in[1] + (size_t)m * DM + n);
    *(f32x4*)(P.out + OY_S + (size_t)m * DM + n) = h;
    v2u o; o.x = pk2(h[0], h[1]); o.y = pk2(h[2], h[3]); *(v2u*)(HB + (size_t)m * DM + n) = o;
    float s = (h[0] * h[0] + h[1] * h[1]) + (h[2] * h[2] + h[3] * h[3]);
    s += __shfl_xor(s, 16); s += __shfl_xor(s, 32);
    if (fq == 0) SSQS[m * 64 + slice] = s;
}
__device__ __forceinline__ void sample_up_slice(const Params& P, int slice) {
    const int tid = threadIdx.x, wid = __builtin_amdgcn_readfirstlane(tid >> 6), lane = tid & 63, fr = lane & 15, fq = lane >> 4;
    const bf16* HB = (const bf16*)(P.ws + WS_HB) + (size_t)MP * DM; const bf16* WUPT = (const bf16*)(P.ws + WS_WUPT);
    bf16* UB = (bf16*)(P.ws + WS_UB) + (size_t)MP * FF; const float* SSQS = (const float*)(P.ws + WS_SSQS);
    const int m = 16 * wid + fr, n = 16 * slice + 4 * fq;
    float ss = 0.f;
#pragma unroll
    for (int i = 0; i < 4; ++i) { const f32x4 t = *(const f32x4*)(SSQS + m * 64 + 16 * fq + 4 * i); ss += (t[0] + t[1]) + (t[2] + t[3]); }
    ss += __shfl_xor(ss, 16); ss += __shfl_xor(ss, 32);
    const float rstd = 1.0f / sqrtf(ss * (1.0f / DM) + RMS_EPS);
    const f32x4 acc = sgemm_slice16(HB, DM, WUPT, DM, 16 * slice, 0, DM, wid, fr, fq);
    float u[4];
#pragma unroll
    for (int j = 0; j < 4; ++j) { const float p = fmaxf(acc[j] * rstd, 0.f); u[j] = p * p; }
    v2u o; o.x = pk2(u[0], u[1]); o.y = pk2(u[2], u[3]); *(v2u*)(UB + (size_t)m * FF + n) = o;
}
__device__ __forceinline__ void sample_down_slice(const Params& P, int item) {
    const int tid = threadIdx.x, wid = __builtin_amdgcn_readfirstlane(tid >> 6), lane = tid & 63, fr = lane & 15, fq = lane >> 4;
    const bf16* UB = (const bf16*)(P.ws + WS_UB) + (size_t)MP * FF; const bf16* WDNT = (const bf16*)(P.ws + WS_WDNT);
    float* PART = (float*)(P.ws + WS_PART);
    const int slice = item & 63, q = item >> 6;
    const f32x4 acc = sgemm_slice16(UB, FF, WDNT, FF, 16 * slice, 1024 * q, 1024 * q + 1024, wid, fr, fq);
    const int m = 16 * wid + fr, n = 16 * slice + 4 * fq;
    *(f32x4*)(PART + ((size_t)q * DECB + m) * DM + n) = acc;
}

__device__ __forceinline__ void phase_final(const Params& P, const Ctx& C) {
    const float* ln_f = P.in[19]; const float* SSQ2 = (const float*)(P.ws + WS_SSQ2);
    const int gw = C.vcu * NWAVES + C.wave, NGW = C.G * NWAVES, lane = C.lane;
    f32x4 lw[4];
#pragma unroll
    for (int j = 0; j < 4; ++j) lw[j] = ((const f32x4*)ln_f)[lane + 64 * j];
    for (int m = gw; m < M_TOT; m += NGW) {
        if (m < MP) {
            const f32x4* sp = (const f32x4*)(SSQ2 + (size_t)m * 16);
            const f32x4 a = sp[0], b = sp[1], c = sp[2], d = sp[3];
            const float ss = ((a[0] + a[1]) + (a[2] + a[3])) + ((b[0] + b[1]) + (b[2] + b[3])) + ((c[0] + c[1]) + (c[2] + c[3])) + ((d[0] + d[1]) + (d[2] + d[3]));
            const float rstd = 1.0f / sqrtf(ss * (1.0f / DM) + RMS_EPS);
            float* yr = P.out + OY_P + (size_t)m * DM;
#pragma unroll
            for (int j = 0; j < 4; ++j) { f32x4 v = ((const f32x4*)yr)[lane + 64 * j]; v = v * rstd * lw[j]; ((f32x4*)yr)[lane + 64 * j] = v; }
        } else {
            const int r = m - MP; float* yr = P.out + OY_S + (size_t)r * DM; const float* PART = (const float*)(P.ws + WS_PART);
            f32x4 v[4]; float ss = 0.f;
#pragma unroll
            for (int j = 0; j < 4; ++j) { v[j] = ((const f32x4*)yr)[lane + 64 * j];
#pragma unroll
                for (int q = 0; q < 4; ++q) v[j] += ((const f32x4*)(PART + ((size_t)q * DECB + r) * DM))[lane + 64 * j];
                ss += (v[j][0] * v[j][0] + v[j][1] * v[j][1]) + (v[j][2] * v[j][2] + v[j][3] * v[j][3]); }
            ss = wave_sum(ss);
            const float rstd = 1.0f / sqrtf(ss * (1.0f / DM) + RMS_EPS);
#pragma unroll
            for (int j = 0; j < 4; ++j) ((f32x4*)yr)[lane + 64 * j] = v[j] * rstd * lw[j];
        }
    }
}

constexpr int NPHASES = 8;
__global__ void __launch_bounds__(NWAVES * 64, 2) fwd_kernel(Params P) {
    extern __shared__ __attribute__((aligned(16))) unsigned char shm[];
    LAS unsigned char* lds = (LAS unsigned char*)shm;
    Ctx C; C.tid = threadIdx.x; C.lane = C.tid & 63; C.wave = __builtin_amdgcn_readfirstlane(C.tid >> 6);
    C.G = gridDim.x; { const int bx = blockIdx.x; C.vcu = (C.G % 8 == 0) ? (bx % 8) * (C.G / 8) + bx / 8 : bx; }
    volatile LAS unsigned* MISC = (volatile LAS unsigned*)(lds + MISC_OFF);
    if (C.tid < 64) MISC[C.tid] = 0u;
    __syncthreads();
    unsigned* ctl = (unsigned*)(P.ws + WS_CTL);
    const int lo = P.ph_lo, hi = P.ph_hi;
    XcdBarrier bar; bar.bar = ctl + CW_BAR; bar.x = 0; bar.st = nullptr;
    if (hi - lo > 1) bar = xcd_barrier_post(ctl + CW_BAR, MISC + 8);
#ifndef REPEAT_MASK
#define REPEAT_MASK 0
#endif
#define NREP(k) (((REPEAT_MASK >> (k)) & 1) ? 2 : 1)
#ifndef SUBMASK
#define SUBMASK 15
#endif
#ifndef PHASE_MASK
#define PHASE_MASK 0xff
#endif
#define IN(k) (((PHASE_MASK >> (k)) & 1) && lo <= (k) && (k) < hi)
#define SEAM(k) do { if (IN(k) && IN((k) + 1)) xcd_barrier(bar); } while (0)
    unsigned char* ws = P.ws;

    if (IN(0)) { for (int rep = 0; rep < NREP(0); ++rep) phase_prep(P, C, lds); SEAM(0); }

    if (IN(1)) {
        if (C.wave == 0) for (int bh = C.vcu; bh < NB * NH; bh += C.G) kbias_seq(P, bh, C.lane);
        for (int rep = 0; rep < NREP(1); ++rep) {
        pg8::Gemm g{(const pg8::bf16_t*)(ws + WS_XN), (const pg8::bf16_t*)(ws + WS_W1T), M_PAD, N1, DM};
        pg8::StaticOrder S; S.init(M_PAD, N1, C.G, (int)blockIdx.x);
        pg8::EpiIn E{(pg8::bf16_t*)(ws + WS_QB), (float*)(ws + WS_QS), (pg8::bf16_t*)(ws + WS_CB), (pg8::bf16_t*)(ws + WS_ZB), P.out};
        pg8::gemm_phase<pg8::EpiIn, pg8::StaticOrder, true, true>(lds, g, S, E);
        }
        SEAM(1);
    }

    if (IN(2)) {
#if SUBMASK & 8
        for (int rep = 0; rep < NREP(5); ++rep) for (int u = C.vcu; u < NB * NH * NCHUNK; u += C.G) gdna_unit(P, lds, u);
#endif
        SEAM(2);
    }

    if (IN(3)) {
        for (int it = C.vcu; it < 256; it += C.G) { const int xg = it >> 5, slot = it & 31; if (slot < 4) { for (int rep = 0; rep < NREP(6); ++rep) gdnb_unit(P, lds, xg * 4 + slot); } }
        for (int it = C.vcu; it < 256; it += C.G) {
            const int xg = it >> 5, slot = it & 31;
            if (slot < 16) {
                const int bh = xg * 4 + (slot >> 2), x = slot & 3, b = bh >> 2, h = bh & 3;
                const bf16* Qh = (const bf16*)(ws + WS_QB) + (size_t)bh * SEQ * HD; const bf16* Kh = (const bf16*)(ws + WS_KB) + (size_t)bh * SEQ * HD; const bf16* Vh = (const bf16*)(ws + WS_VB) + (size_t)bh * SEQ * HD;
                const float* kbias = (const float*)(ws + WS_KBIAS) + (size_t)bh * SEQ;
                bf16* Orow0 = (bf16*)(ws + WS_MIX) + (size_t)b * SEQ * DM + h * HD;
#if SUBMASK & 1
                for (int rep = 0; rep < NREP(2); ++rep) {
                fox::fox_block((char*)shm, Qh, Kh, Vh, kbias, Orow0, 7 - x);
                fox::fox_block((char*)shm, Qh, Kh, Vh, kbias, Orow0, x); }
#endif
            } else {
                const int db = xg * 16 + (slot - 16);
#if SUBMASK & 2
                for (int rep = 0; rep < NREP(3); ++rep) decode_unit(P, lds, db);
#endif
#if SUBMASK & 4
                for (int rep = 0; rep < NREP(4); ++rep) for (int h = 0; h < NH; ++h) sgdn_unit(P, lds, db, h);
#endif
            }
        }
        SEAM(3);
    }

    if (IN(4)) {
        for (int rep = 0; rep < NREP(9); ++rep) for (int it = blockIdx.x; it < 64; it += C.G) sample_wo_slice(P, it);
        pg8::Gemm g{(const pg8::bf16_t*)(ws + WS_MIX), (const pg8::bf16_t*)(ws + WS_WOT), MP, DM, DM};
        pg8::StaticOrder S; S.init(MP, DM, C.G, (int)blockIdx.x);
        pg8::EpiRes E{P.in[0], P.in[1], P.out, (pg8::bf16_t*)(ws + WS_HB), (float*)(ws + WS_SSQ)};
        for (int rep = 0; rep < NREP(7); ++rep) pg8::gemm_phase<pg8::EpiRes, pg8::StaticOrder, true, true>(lds, g, S, E);
        SEAM(4);
    }

    if (IN(5)) {
        for (int rep = 0; rep < NREP(10); ++rep) for (int it = blockIdx.x; it < 256; it += C.G) sample_up_slice(P, it);
        pg8::Gemm g{(const pg8::bf16_t*)(ws + WS_HB), (const pg8::bf16_t*)(ws + WS_WUPT), MP, FF, DM};
        pg8::StaticOrder S; S.init(MP, FF, C.G, (int)blockIdx.x);
        pg8::EpiUp E{(pg8::bf16_t*)(ws + WS_UB), (const float*)(ws + WS_SSQ)};
        for (int rep = 0; rep < NREP(8); ++rep) pg8::gemm_phase<pg8::EpiUp, pg8::StaticOrder, true, true>(lds, g, S, E);
        SEAM(5);
    }

    if (IN(6)) {
        for (int rep = 0; rep < NREP(11); ++rep) for (int it = blockIdx.x; it < 256; it += C.G) sample_down_slice(P, it);
        pg8::Gemm g{(const pg8::bf16_t*)(ws + WS_UB), (const pg8::bf16_t*)(ws + WS_WDNT), MP, DM, FF};
        pg8::StaticOrder S; S.init(MP, DM, C.G, (int)blockIdx.x);
        pg8::EpiDown E{P.out, (float*)(ws + WS_SSQ2)};
        pg8::gemm_phase<pg8::EpiDown, pg8::StaticOrder, true, true>(lds, g, S, E);
        SEAM(6);
    }

    if (IN(7)) phase_final(P, C);
#undef IN
#undef SEAM
}

#ifndef N_LAUNCH_MODE
#define N_LAUNCH_MODE 1
#endif
extern "C" void kernel_launch(void* const* d_in, const int* in_sizes, int n_in, void* d_out, int out_size, void* d_ws, size_t ws_size, hipStream_t stream) {
    static int grid = 0;
    if (grid == 0) {
        if (n_in != 20 || out_size != (int)OUT_TOTAL || ws_size < WS_END) { fprintf(stderr, "kernel_launch: unexpected shapes (n_in %d, out %d, ws %zu); nothing launched\n", n_in, out_size, ws_size); grid = -1; return; }
        int dev = 0, cus = 0, per_cu = 0;
        if (hipGetDevice(&dev) != hipSuccess || hipDeviceGetAttribute(&cus, hipDeviceAttributeMultiprocessorCount, dev) != hipSuccess) { grid = -1; return; }
        if (hipFuncSetAttribute((const void*)fwd_kernel, hipFuncAttributeMaxDynamicSharedMemorySize, LDS_BYTES) != hipSuccess) { fprintf(stderr, "kernel_launch: hipFuncSetAttribute failed\n"); grid = -1; return; }
        if (hipOccupancyMaxActiveBlocksPerMultiprocessor(&per_cu, (const void*)fwd_kernel, NWAVES * 64, LDS_BYTES) != hipSuccess || per_cu < 1)
            fprintf(stderr, "kernel_launch: note: occupancy query reports %d workgroups per CU\n", per_cu);
        (void)hipGetLastError();
        grid = cus;
    }
    if (grid < 0) return;
    if (hipMemsetAsync((char*)d_ws + WS_CTL, 0, CTL_ZERO_BYTES, stream) != hipSuccess) return;
    Params p{};
    for (int i = 0; i < 20; ++i) p.in[i] = (const float*)d_in[i];
    p.out = (float*)d_out; p.ws = (unsigned char*)d_ws;
    if (N_LAUNCH_MODE == 1) {
        p.ph_lo = 0; p.ph_hi = NPHASES;
        hipLaunchKernelGGL(fwd_kernel, dim3(grid), dim3(NWAVES * 64), LDS_BYTES, stream, p);
    } else {
        for (int k = 0; k < NPHASES; ++k) { p.ph_lo = k; p.ph_hi = k + 1; hipLaunchKernelGGL(fwd_kernel, dim3(grid), dim3(NWAVES * 64), LDS_BYTES, stream, p); }
    }
}
```

```cpp
#include <hip/hip_runtime.h>
#include <hip/hip_bf16.h>
#include <cstdio>
#include <cstdint>

constexpr int DM = 1024, NB = 8, SEQ = 2048, DECB = 128, PAST = 2048, PAGE = 128, NPAGES = 16;
constexpr int NH = 4, HD = 128, CONVD = 1536, FF = 4096, INDIM = 3596, GCH = 64, NCHUNK = SEQ / GCH;
constexpr int MP = NB * SEQ;
constexpr int M_TOT = MP + DECB;
constexpr int M_PAD = 16640;
constexpr int N1 = 3584;
constexpr float RMS_EPS = 1e-6f, L2_EPS = 1e-6f;
constexpr float ATT_SCALE = 0.08838834764831845f;
constexpr size_t OY_P = 0, OY_S = 16777216, OK_P = 16908288, OV_P = 25296896, OLF_P = 33685504, OCONV_P = 33751040, OSSM_P = 33787904,
                 OK_S = 34312192, OV_S = 34377728, OLF_S = 34443264, OCONV_S = 34443776, OSSM_S = 35033600, OUT_TOTAL = 43422208;
constexpr size_t MiB = 1u << 20;
constexpr size_t WS_CTL = 0, CTL_ZERO_BYTES = 1 * MiB;
constexpr size_t WS_W1T = 2 * MiB, WS_WOT = 10 * MiB, WS_WUPT = 12 * MiB, WS_WDNT = 21 * MiB;
constexpr size_t WS_XN = 32 * MiB, WS_QB = 68 * MiB, WS_KB = 84 * MiB, WS_VB = 100 * MiB, WS_CB = 116 * MiB, WS_ZB = 166 * MiB;
constexpr size_t WS_MIX = 184 * MiB, WS_HB = 218 * MiB, WS_UB = 252 * MiB;
constexpr size_t WS_UT = 384 * MiB, WS_WN = 416 * MiB, WS_QG = 432 * MiB, WS_KGT = 448 * MiB, WS_QKM = 464 * MiB;
constexpr size_t WS_LF = 472 * MiB, WS_BETA = 473 * MiB, WS_G = 474 * MiB, WS_KBIAS = 475 * MiB, WS_QS = 476 * MiB, WS_SSQ = 477 * MiB, WS_SSQ2 = 479 * MiB, WS_GL = 481 * MiB, WS_SSQS = 482 * MiB, WS_PART = 483 * MiB;
constexpr size_t WS_HF = 32 * MiB;
static_assert(WS_HF + (size_t)MP * DM * 4 <= WS_CB, "h overlays dead buffers only");
constexpr size_t WS_END = 486 * MiB;
constexpr int CW_TMO = 0, CW_BAR = 4096;
constexpr size_t QKV_STRIDE = (WS_KB - WS_QB) / 2;
static_assert(WS_VB - WS_KB == WS_KB - WS_QB, "q/k/v copies equally spaced");

namespace pg8 {
#define PG8_LAS __attribute__((address_space(3)))
typedef unsigned short bf16_t;
typedef short bf16x8 __attribute__((ext_vector_type(8)));
typedef float f32x4 __attribute__((ext_vector_type(4)));
typedef unsigned u32x4 __attribute__((ext_vector_type(4)));
constexpr int BM = 256, BK = 64, HALF = 128, HTB = HALF * BK * 2  , STAGE_BYTES = 8 * HTB, NXCD = 8, WGM = 8;

__host__ __device__ __forceinline__ int lds_byte(int r, int c) { const int st = (r >> 4) * 2 + (c >> 5), rr = r & 15, cc = c & 31, ob = rr * 64 + cc * 2; return st * 1024 + (ob ^ (((ob >> 9) & 1) << 5)); }
__host__ __device__ __forceinline__ void stage_rc(int b, int& R, int& C) { const int st = b / 1024, sb = b % 1024, swz = sb ^ (((sb >> 9) & 1) << 5); R = (st >> 1) * 16 + swz / 64; C = (st & 1) * 32 + (swz % 64) / 2; }
__host__ __device__ __forceinline__ int perm32(int rho) { const int n = rho >> 4, i = rho & 15; return 8 * (i >> 2) + 4 * n + (i & 3); }

struct Unit { int pm, pn; };
struct Gemm { const bf16_t* A; const bf16_t* Bt; int M, N, K; };

struct StaticOrder {
    int nM, nN, nwg, G, c;
    __host__ __device__ void init(int M, int N, int G_, int c_) { nM = M / BM; nN = N / BM; nwg = nM * nN; G = G_; c = c_; }
    __host__ __device__ bool next(int i, Unit& u) const {
        const long L = (long)i * G + c; if (L >= nwg) return false;
        int wgid = (int)L; { const int q = nwg / NXCD, r = nwg % NXCD, xcd = wgid % NXCD, off = wgid / NXCD; wgid = (xcd < r ? xcd * (q + 1) : r * (q + 1) + (xcd - r) * q) + off; }
        const int nig = WGM * nN, gid = wgid / nig, fm = gid * WGM, gsz = (nM - fm) < WGM ? (nM - fm) : WGM;
        u.pm = fm + ((wgid % nig) % gsz); u.pn = (wgid % nig) / gsz; return true;
    }
    __device__ __forceinline__ void a_ready(const Unit&) const {}
    __device__ __forceinline__ void done(const Unit&) const {}
};
__device__ __forceinline__ unsigned cvt_pk_bf16(float lo, float hi) { unsigned r; asm volatile("v_cvt_pk_bf16_f32 %0, %1, %2" : "=v"(r) : "v"(lo), "v"(hi)); return r; }
typedef float f32x2 __attribute__((ext_vector_type(2)));
__device__ __forceinline__ u32x4 pack8_bf16(f32x4 v0, f32x4 v1) { u32x4 w; w.x = cvt_pk_bf16(v0[0], v0[1]); w.y = cvt_pk_bf16(v0[2], v0[3]); w.z = cvt_pk_bf16(v1[0], v1[1]); w.w = cvt_pk_bf16(v1[2], v1[3]); return w; }

struct EpiIn {
    static constexpr bool PERM = true, AFTER_DRAIN = false;
    bf16_t* QB;
    float* QS;
    bf16_t* CB;
    bf16_t* ZB;
    float* out;
    __device__ __forceinline__ void operator()(const f32x4 (&acc)[2][2][4][2], const Unit& u, int wr, int wc, int fr, int fq) const {
        const int pn = u.pn;
#pragma unroll
        for (int ai = 0; ai < 2; ++ai)
#pragma unroll
            for (int m = 0; m < 4; ++m) {
                const int row = u.pm * BM + ai * HALF + wr * 64 + m * 16 + fr;
                if (row >= M_TOT) continue;
#pragma unroll
                for (int bj = 0; bj < 2; ++bj) {
                    const int col = pn * BM + bj * HALF + wc * 32 + 8 * fq;
                    const f32x4 v0 = acc[ai][bj][m][0], v1 = acc[ai][bj][m][1];
                    if (pn < 6) {
                        const int seg = pn >> 1, c = col - seg * 512, h = c >> 7, d = c & 127;
                        if (row < MP) {
                            const int b = row >> 11, t = row & 2047;
                            const size_t idx = ((size_t)((b * NH + h) * SEQ + t)) * HD + d;
                            *(u32x4*)(QB + (size_t)seg * QKV_STRIDE + idx) = pack8_bf16(v0, v1);
                            if (seg != 0) { float* o = out + OK_P + (size_t)(seg - 1) * (OV_P - OK_P) + (size_t)row * 512 + c; *(f32x4*)o = v0; *(f32x4*)(o + 4) = v1; }
                        } else {
                            const int db = row - MP;
                            if (seg == 0) { float* o = QS + (size_t)db * 512 + c; *(f32x4*)o = v0; *(f32x4*)(o + 4) = v1; }
                            else { float* o = out + OK_S + (size_t)(seg - 1) * (OV_S - OK_S) + (size_t)db * 512 + c; *(f32x4*)o = v0; *(f32x4*)(o + 4) = v1; }
                        }
                    } else if (pn < 12) {
                        const int c = col - 1536;
                        *(u32x4*)(CB + (size_t)row * CONVD + c) = pack8_bf16(v0, v1);
                        if (row < MP) {
                            const int t = row & 2047;
                            if (t >= SEQ - 3) { float* o = out + OCONV_P + ((size_t)(row >> 11) * 3 + (t - (SEQ - 3))) * CONVD + c; *(f32x4*)o = v0; *(f32x4*)(o + 4) = v1; }
                        } else {
                            float* o = out + OCONV_S + ((size_t)(row - MP) * 3 + 2) * CONVD + c; *(f32x4*)o = v0; *(f32x4*)(o + 4) = v1;
                        }
                    } else {
                        const int c = col - 3072;
                        *(u32x4*)(ZB + (size_t)row * 512 + c) = pack8_bf16(v0, v1);
                    }
                }
            }
    }
};

struct EpiRes {
    static constexpr bool PERM = true, AFTER_DRAIN = false;
    const float* xp; float* HF; bf16_t* HB; float* SSQ;
    __device__ __forceinline__ void operator()(const f32x4 (&acc)[2][2][4][2], const Unit& u, int wr, int wc, int fr, int fq) const {
#pragma unroll
        for (int ai = 0; ai < 2; ++ai)
#pragma unroll
            for (int m = 0; m < 4; ++m) {
                const int row = u.pm * BM + ai * HALF + wr * 64 + m * 16 + fr;
                const bool ok = row < MP;
                const float* xr = xp + (size_t)(ok ? row : 0) * DM;
                float* hr = HF + (size_t)(ok ? row : 0) * DM;
                float s = 0.f;
#pragma unroll
                for (int bj = 0; bj < 2; ++bj) {
                    const int col = u.pn * BM + bj * HALF + wc * 32 + 8 * fq;
                    if (ok) {
                        const f32x4 v0 = acc[ai][bj][m][0] + *(const f32x4*)(xr + col), v1 = acc[ai][bj][m][1] + *(const f32x4*)(xr + col + 4);
                        *(f32x4*)(hr + col) = v0; *(f32x4*)(hr + col + 4) = v1;
                        *(u32x4*)(HB + (size_t)row * DM + col) = pack8_bf16(v0, v1);
                        s += (v0[0] * v0[0] + v0[1] * v0[1]) + (v0[2] * v0[2] + v0[3] * v0[3]) + (v1[0] * v1[0] + v1[1] * v1[1]) + (v1[2] * v1[2] + v1[3] * v1[3]);
                    }
                }
                s += __shfl_xor(s, 16); s += __shfl_xor(s, 32);
                if (ok && fq == 0) SSQ[(size_t)row * 16 + u.pn * 4 + wc] = s;
            }
    }
};

struct EpiUp {
    static constexpr bool PERM = true, AFTER_DRAIN = false;
    bf16_t* UB; const float* SSQ;
    __device__ __forceinline__ void operator()(const f32x4 (&acc)[2][2][4][2], const Unit& u, int wr, int wc, int fr, int fq) const {
#pragma unroll
        for (int ai = 0; ai < 2; ++ai)
#pragma unroll
            for (int m = 0; m < 4; ++m) {
                const int row = u.pm * BM + ai * HALF + wr * 64 + m * 16 + fr;
                if (row >= M_TOT) continue;
                const f32x4* sp = (const f32x4*)(SSQ + (size_t)row * 16);
                const f32x4 a = sp[0], b = sp[1], c = sp[2], d = sp[3];
                const float ss = ((a[0] + a[1]) + (a[2] + a[3])) + ((b[0] + b[1]) + (b[2] + b[3])) + ((c[0] + c[1]) + (c[2] + c[3])) + ((d[0] + d[1]) + (d[2] + d[3]));
                const float rstd = 1.0f / sqrtf(ss * (1.0f / DM) + RMS_EPS);
#pragma unroll
                for (int bj = 0; bj < 2; ++bj) {
                    const int col = u.pn * BM + bj * HALF + wc * 32 + 8 * fq;
                    f32x4 v0 = acc[ai][bj][m][0] * rstd, v1 = acc[ai][bj][m][1] * rstd;
#pragma unroll
                    for (int j = 0; j < 4; ++j) { const float p = fmaxf(v0[j], 0.f), q = fmaxf(v1[j], 0.f); v0[j] = p * p; v1[j] = q * q; }
                    *(u32x4*)(UB + (size_t)row * FF + col) = pack8_bf16(v0, v1);
                }
            }
    }
};

struct EpiDown {
    static constexpr bool PERM = true, AFTER_DRAIN = false;
    const float* HF; float* out; float* SSQ2;
    __device__ __forceinline__ void operator()(const f32x4 (&acc)[2][2][4][2], const Unit& u, int wr, int wc, int fr, int fq) const {
#pragma unroll
        for (int ai = 0; ai < 2; ++ai)
#pragma unroll
            for (int m = 0; m < 4; ++m) {
                const int row = u.pm * BM + ai * HALF + wr * 64 + m * 16 + fr;
                const bool ok = row < MP;
                const float* hr = HF + (size_t)(ok ? row : 0) * DM;
                float* yr = out + OY_P + (size_t)(ok ? row : 0) * DM;
                float s = 0.f;
#pragma unroll
                for (int bj = 0; bj < 2; ++bj) {
                    const int col = u.pn * BM + bj * HALF + wc * 32 + 8 * fq;
                    if (ok) {
                        const f32x4 v0 = acc[ai][bj][m][0] + *(const f32x4*)(hr + col), v1 = acc[ai][bj][m][1] + *(const f32x4*)(hr + col + 4);
                        *(f32x4*)(yr + col) = v0; *(f32x4*)(yr + col + 4) = v1;
                        s += (v0[0] * v0[0] + v0[1] * v0[1]) + (v0[2] * v0[2] + v0[3] * v0[3]) + (v1[0] * v1[0] + v1[1] * v1[1]) + (v1[2] * v1[2] + v1[3] * v1[3]);
                    }
                }
                s += __shfl_xor(s, 16); s += __shfl_xor(s, 32);
                if (ok && fq == 0) SSQ2[(size_t)row * 16 + u.pn * 4 + wc] = s;
            }
    }
};

template <class Epi, class Sched, bool ALIGN_EPI = false, bool SP2 = false>
__device__ __forceinline__ void gemm_phase(PG8_LAS unsigned char* lds, const Gemm g, const Sched& S, const Epi& E) {
    const int tid = threadIdx.x, wid = __builtin_amdgcn_readfirstlane(tid >> 6), lane = tid & 63, wr = wid >> 2, wc = wid & 3, fr = lane & 15, fq = lane >> 4;
    const int K = g.K, nt = K / BK;
    unsigned voffA[2], voffB[2];
#pragma unroll
    for (int i = 0; i < 2; ++i) { int R, C; stage_rc(tid * 16 + i * 8192, R, C); const int Rb = Epi::PERM ? ((R & ~31) + perm32(R & 31)) : R;
        voffA[i] = (unsigned)(R * K + C) * 2u; voffB[i] = (unsigned)(Rb * K + C) * 2u; }
    const size_t kstep = (size_t)(BK * 2);
    const size_t hstep = (size_t)HALF * K * 2;
    const size_t tstep = 2 * hstep;
    const unsigned ldsw = (unsigned)wid * 1024u;
    const int aoff = lds_byte(wr * 64 + fr, fq * 8), boff = lds_byte(wc * 32 + fr, fq * 8);
#define PG8_SA(b, h) (((b) * 2 + (h)) * HTB)
#define PG8_SB(b, h) ((4 + (b) * 2 + (h)) * HTB)
#define PG8_STAGE(bufoff, gbase, voff) do { _Pragma("unroll") for (int _i = 0; _i < 2; ++_i) \
        __builtin_amdgcn_global_load_lds((const unsigned*)((const char*)(gbase) + (voff)[_i]), (PG8_LAS unsigned*)(lds + (bufoff) + ldsw + _i * 8192), 16, 0, 0); } while (0)
#define PG8_LDA(dst, b, h) do { _Pragma("unroll") for (int m = 0; m < 4; ++m) _Pragma("unroll") for (int k = 0; k < 2; ++k) dst[m][k] = *(const PG8_LAS bf16x8*)(lds + PG8_SA(b, h) + aoff + m * 2048 + k * 1024); } while (0)
#define PG8_LDB(dst, b, h) do { _Pragma("unroll") for (int n = 0; n < 2; ++n) _Pragma("unroll") for (int k = 0; k < 2; ++k) dst[n][k] = *(const PG8_LAS bf16x8*)(lds + PG8_SB(b, h) + boff + n * 2048 + k * 1024); } while (0)
#define PG8_MMA(ai, bj, At, Bt) do { __builtin_amdgcn_s_setprio(1); _Pragma("unroll") for (int m = 0; m < 4; ++m) _Pragma("unroll") for (int n = 0; n < 2; ++n) _Pragma("unroll") for (int k = 0; k < 2; ++k) \
        acc[ai][bj][m][n] = __builtin_amdgcn_mfma_f32_16x16x32_bf16(Bt[n][k], At[m][k], acc[ai][bj][m][n], 0, 0, 0); __builtin_amdgcn_s_setprio(0); } while (0)
#define PG8_WAIT_V(n) asm volatile("s_waitcnt vmcnt(" #n ")" ::: "memory")
#define PG8_WAIT_L(n) asm volatile("s_waitcnt lgkmcnt(" #n ")" ::: "memory")
#define PG8_BAR __builtin_amdgcn_s_barrier()
#define PG8_SCHED __builtin_amdgcn_sched_barrier(0)
    Unit cur, nxt; int ui = 0;
    if (!S.next(0, cur)) return;
    f32x4 acc[2][2][4][2];
#pragma unroll
    for (int a = 0; a < 2; ++a)
#pragma unroll
        for (int b = 0; b < 2; ++b)
#pragma unroll
            for (int m = 0; m < 4; ++m)
#pragma unroll
                for (int n = 0; n < 2; ++n) acc[a][b][m][n] = (f32x4){0.f, 0.f, 0.f, 0.f};
    bf16x8 At[4][2], B0[2][2], B1[2][2];
    const char* cA = (const char*)g.A + (size_t)cur.pm * tstep; const char* cB = (const char*)g.Bt + (size_t)cur.pn * tstep;
    S.a_ready(cur);
    if constexpr (SP2) {
        PG8_STAGE(PG8_SB(0, 0), cB, voffB); PG8_STAGE(PG8_SB(0, 1), cB + hstep, voffB); PG8_STAGE(PG8_SA(0, 0), cA, voffA); PG8_STAGE(PG8_SA(0, 1), cA + hstep, voffA);
        if (wr == 1) PG8_BAR;
        PG8_WAIT_V(2); PG8_BAR;
        PG8_STAGE(PG8_SB(1, 0), cB + kstep, voffB); PG8_STAGE(PG8_SA(1, 0), cA + kstep, voffA); PG8_STAGE(PG8_SB(1, 1), cB + hstep + kstep, voffB);
        PG8_WAIT_V(6); PG8_BAR;
    } else {
        PG8_STAGE(PG8_SB(0, 0), cB, voffB); PG8_STAGE(PG8_SA(0, 0), cA, voffA); PG8_STAGE(PG8_SB(0, 1), cB + hstep, voffB); PG8_STAGE(PG8_SA(0, 1), cA + hstep, voffA);
        if (wr == 1) PG8_BAR;
        PG8_WAIT_V(4); PG8_BAR;
        PG8_STAGE(PG8_SB(1, 0), cB + kstep, voffB); PG8_STAGE(PG8_SA(1, 0), cA + kstep, voffA); PG8_STAGE(PG8_SB(1, 1), cB + hstep + kstep, voffB);
        PG8_WAIT_V(6); PG8_BAR;
    }
    for (;;) {
        const bool has_next = S.next(ui + 1, nxt);
        const char* nA = has_next ? (const char*)g.A + (size_t)nxt.pm * tstep : cA; const char* nB = has_next ? (const char*)g.Bt + (size_t)nxt.pn * tstep : cB;
        for (int t = 0; t < nt; t += 2) {
            const bool last = (t == nt - 2);
            const char* a1 = cA + (size_t)(t + 1) * kstep;
            const char* a2 = last ? nA : cA + (size_t)(t + 2) * kstep; const char* b2 = last ? nB : cB + (size_t)(t + 2) * kstep;
            const char* a3 = a2 + kstep; const char* b3 = b2 + kstep;
            if (last && has_next) S.a_ready(nxt);
            if constexpr (SP2) {
            PG8_LDB(B0, 0, 0); PG8_LDB(B1, 0, 1); PG8_SCHED; PG8_LDA(At, 0, 0); PG8_STAGE(PG8_SA(1, 1), a1 + hstep, voffA);
            PG8_WAIT_V(8); PG8_WAIT_L(0); PG8_BAR; PG8_MMA(0, 0, At, B0); PG8_MMA(0, 1, At, B1); PG8_BAR; PG8_SCHED;
            PG8_LDA(At, 0, 1); PG8_STAGE(PG8_SB(0, 0), b2, voffB); PG8_STAGE(PG8_SB(0, 1), b2 + hstep, voffB); PG8_STAGE(PG8_SA(0, 0), a2, voffA);
            PG8_WAIT_V(8); PG8_WAIT_L(0); PG8_BAR; PG8_MMA(1, 0, At, B0); PG8_MMA(1, 1, At, B1); PG8_BAR; PG8_SCHED;
            PG8_LDB(B0, 1, 0); PG8_LDB(B1, 1, 1); PG8_SCHED; PG8_LDA(At, 1, 0); PG8_STAGE(PG8_SA(0, 1), a2 + hstep, voffA);
            PG8_WAIT_V(8); PG8_WAIT_L(0); PG8_BAR; PG8_MMA(0, 0, At, B0); PG8_MMA(0, 1, At, B1); PG8_BAR; PG8_SCHED;
            PG8_LDA(At, 1, 1); PG8_STAGE(PG8_SB(1, 0), b3, voffB); PG8_STAGE(PG8_SB(1, 1), b3 + hstep, voffB); PG8_STAGE(PG8_SA(1, 0), a3, voffA);
            PG8_WAIT_V(8); PG8_WAIT_L(0); PG8_BAR; PG8_MMA(1, 0, At, B0); PG8_MMA(1, 1, At, B1); PG8_BAR; PG8_SCHED;
            } else {
            PG8_LDB(B0, 0, 0); PG8_SCHED; PG8_LDA(At, 0, 0); PG8_STAGE(PG8_SA(1, 1), a1 + hstep, voffA);
            PG8_WAIT_L(8); PG8_BAR; PG8_WAIT_L(0); PG8_MMA(0, 0, At, B0); PG8_BAR; PG8_SCHED;
            PG8_LDB(B1, 0, 1); PG8_STAGE(PG8_SB(0, 0), b2, voffB);
            PG8_BAR; PG8_WAIT_L(0); PG8_MMA(0, 1, At, B1); PG8_BAR;
            PG8_LDA(At, 0, 1); PG8_STAGE(PG8_SA(0, 0), a2, voffA);
            PG8_BAR; PG8_WAIT_L(0); PG8_MMA(1, 0, At, B0); PG8_BAR; PG8_SCHED;
            PG8_STAGE(PG8_SB(0, 1), b2 + hstep, voffB);
            PG8_WAIT_V(6); PG8_BAR; PG8_MMA(1, 1, At, B1); PG8_BAR;
            PG8_LDB(B0, 1, 0); PG8_SCHED; PG8_LDA(At, 1, 0); PG8_STAGE(PG8_SA(0, 1), a2 + hstep, voffA);
            PG8_WAIT_L(8); PG8_BAR; PG8_WAIT_L(0); PG8_MMA(0, 0, At, B0); PG8_BAR; PG8_SCHED;
            PG8_LDB(B1, 1, 1); PG8_STAGE(PG8_SB(1, 0), b3, voffB);
            PG8_BAR; PG8_WAIT_L(0); PG8_MMA(0, 1, At, B1); PG8_BAR;
            PG8_LDA(At, 1, 1); PG8_STAGE(PG8_SA(1, 0), a3, voffA);
            PG8_BAR; PG8_WAIT_L(0); PG8_MMA(1, 0, At, B0); PG8_BAR; PG8_SCHED;
            PG8_STAGE(PG8_SB(1, 1), b3 + hstep, voffB);
            PG8_WAIT_V(6); PG8_BAR; PG8_MMA(1, 1, At, B1); PG8_BAR;
            }
        }
        if constexpr (ALIGN_EPI) { if (wr == 0) PG8_BAR; }
        if constexpr (!Epi::AFTER_DRAIN) { E(acc, cur, wr, wc, fr, fq); S.done(cur); }
        if (!has_next) break;
#pragma unroll
        for (int a = 0; a < 2; ++a)
#pragma unroll
            for (int b = 0; b < 2; ++b)
#pragma unroll
                for (int m = 0; m < 4; ++m)
#pragma unroll
                    for (int n = 0; n < 2; ++n) acc[a][b][m][n] = (f32x4){0.f, 0.f, 0.f, 0.f};
        cur = nxt; cA = nA; cB = nB; ++ui;
        if constexpr (ALIGN_EPI) { if (wr == 1) PG8_BAR; }
    }
    PG8_WAIT_V(0);
    if constexpr (!ALIGN_EPI) { if (wr == 0) PG8_BAR; }
    PG8_BAR;
    if constexpr (Epi::AFTER_DRAIN) { E.fused(acc, cur, wr, wc, fr, fq, lds, wid, lane); S.done(cur); }
#undef PG8_SA
#undef PG8_SB
#undef PG8_STAGE
#undef PG8_LDA
#undef PG8_LDB
#undef PG8_MMA
#undef PG8_WAIT_V
#undef PG8_WAIT_L
#undef PG8_BAR
#undef PG8_SCHED
}
}

#define GAS __attribute__((address_space(1)))
#define LAS __attribute__((address_space(3)))
typedef unsigned short bf16;
typedef unsigned v4u __attribute__((ext_vector_type(4)));
typedef unsigned v2u __attribute__((ext_vector_type(2)));
typedef float f32x4 __attribute__((ext_vector_type(4)));
typedef float f32x2 __attribute__((ext_vector_type(2)));
typedef float f32x16 __attribute__((ext_vector_type(16)));
typedef short bf16x8 __attribute__((ext_vector_type(8)));
typedef short s16x4 __attribute__((ext_vector_type(4)));
#define LDS_WAIT() asm volatile("s_waitcnt lgkmcnt(0)" ::: "memory")
#define VM_WAIT() asm volatile("s_waitcnt vmcnt(0)" ::: "memory")
constexpr int NWAVES = 8;
constexpr int LDS_BYTES = 163840;
constexpr int MISC_OFF = 163840 - 256;

__device__ __forceinline__ unsigned f2bf(float f) { unsigned u = __builtin_bit_cast(unsigned, f); return (u + 0x7fffu + ((u >> 16) & 1u)) >> 16; }
__device__ __forceinline__ unsigned pk2(float lo, float hi) { return f2bf(lo) | (f2bf(hi) << 16); }
__device__ __forceinline__ float bf2f(unsigned short b) { return __builtin_bit_cast(float, ((unsigned)b) << 16); }
__device__ __forceinline__ float wave_sum(float v) {
#pragma unroll
    for (int o = 1; o < 64; o <<= 1) v += __shfl_xor(v, o);
    return v;
}
__device__ __forceinline__ float softplus_f(float x) { return fmaxf(x, 0.f) + log1pf(expf(-fabsf(x))); }
__device__ __forceinline__ float sigmoid_f(float x) { return 1.0f / (1.0f + expf(-x)); }
__device__ __forceinline__ float silu_f(float x) { return x * __builtin_amdgcn_rcpf(1.0f + __expf(-x)); }

struct Params {
    const float* in[20];
    float* out; unsigned char* ws;
    int ph_lo, ph_hi;
};
struct Ctx { int tid, lane, wave, vcu, G; };

#define XB_TMO      128
#define XB_XCNT(j)  (256  + 64 * (j))
#define XB_XSUB(j)  (1280 + 64 * (j))
#define XB_XGEN(j)  (2304 + 64 * (j))
#define XB_TOP      3328
#define XB_TOPGEN   3392
#define XCD_BAR_WORDS 3456
#define XB_SPIN_CAP (1u << 18)

__device__ __forceinline__ unsigned xb_ld(unsigned* p)              { return __hip_atomic_load(p, __ATOMIC_RELAXED, __HIP_MEMORY_SCOPE_AGENT); }
__device__ __forceinline__ unsigned xb_add(unsigned* p, unsigned v) { return __hip_atomic_fetch_add(p, v, __ATOMIC_RELAXED, __HIP_MEMORY_SCOPE_AGENT); }
__device__ __forceinline__ unsigned xb_xcc_id() { return (unsigned)__builtin_amdgcn_s_getreg((3 << 11) | 20) & 0xFu; }
#define XB_SPIN(cond, bar) do { unsigned _sp = 0; while (cond) { __builtin_amdgcn_s_sleep(1); \
    if ((++_sp & 255u) == 0u) { if (xb_ld(&(bar)[XB_TMO])) break; if (_sp > XB_SPIN_CAP) { atomicAdd(&(bar)[XB_TMO], 1u); break; } } } } while (0)

struct XcdBarrier {
    unsigned* bar; unsigned x;
    volatile LAS unsigned* st;
};

__device__ __forceinline__ XcdBarrier xcd_barrier_post(unsigned* bar, volatile LAS unsigned* st) {
    XcdBarrier b; b.bar = bar; b.x = xb_xcc_id(); b.st = st;
    if (threadIdx.x == 0) (void)xb_add(&bar[XB_XCNT(b.x)], 1u);
    return b;
}
__device__ __forceinline__ void xcd_barrier_complete(unsigned* bar, unsigned x, unsigned& nloc, unsigned& nx) {
    const unsigned G = gridDim.x * gridDim.y * gridDim.z;
    unsigned sum, cnt, mine, sp = 0u;
    for (;;) {
        sum = 0u; cnt = 0u; mine = 0u;
#pragma unroll
        for (unsigned j = 0; j < 16; ++j) { const unsigned c = xb_ld(&bar[XB_XCNT(j)]); sum += c; cnt += (c > 0u) ? 1u : 0u; mine = (j == x) ? c : mine; }
        if (sum == G) break;
        __builtin_amdgcn_s_sleep(1);
        if ((++sp & 255u) == 0u) { if (xb_ld(&bar[XB_TMO])) break; if (sp > XB_SPIN_CAP) { atomicAdd(&bar[XB_TMO], 1u); break; } }
    }
    nloc = mine > 0u ? mine : 1u; nx = cnt > 0u ? cnt : 1u;
}

__device__ __forceinline__ void xcd_barrier(const XcdBarrier& b) {
    asm volatile("s_waitcnt vmcnt(0)" ::: "memory");
    __syncthreads();
    if (threadIdx.x == 0) {
        unsigned* bar = b.bar;
        __builtin_amdgcn_s_waitcnt(0);
        unsigned nloc = b.st[0], nx = b.st[1];
        if (nloc == 0u) { xcd_barrier_complete(bar, b.x, nloc, nx); b.st[0] = nloc; b.st[1] = nx; }
        const unsigned old = xb_add(&bar[XB_XSUB(b.x)], 1u);
        const unsigned gen = old / nloc;
        if (old + 1u == (gen + 1u) * nloc) {
            __builtin_amdgcn_fence(__ATOMIC_RELEASE, "agent");
            asm volatile("s_waitcnt vmcnt(0)" ::: "memory");
            const unsigned og = xb_add(&bar[XB_TOP], 1u);
            const unsigned tg = og / nx;
            if (og + 1u == (tg + 1u) * nx) xb_add(&bar[XB_TOPGEN], 1u);
            else XB_SPIN(xb_ld(&bar[XB_TOPGEN]) == tg, bar);
            __builtin_amdgcn_fence(__ATOMIC_ACQUIRE, "agent");
            xb_add(&bar[XB_XGEN(b.x)], 1u);
            asm volatile("s_waitcnt vmcnt(0)" ::: "memory");
        } else {
            XB_SPIN(xb_ld(&bar[XB_XGEN(b.x)]) == gen, bar);
            __builtin_amdgcn_fence(__ATOMIC_ACQUIRE, "agent");
            asm volatile("s_waitcnt vmcnt(0)" ::: "memory");
        }
    }
    __syncthreads();
}

__device__ __forceinline__ void transpose_item(const float* W, int ldw, int c0, int K, int ncols, const float* scale, bf16* WT, int row_off, LAS float* scr, int item, int lane) {
    const int nblk = ncols / 32, kb = item / nblk, nb = item % nblk, k0 = 64 * kb, n0 = 32 * nb;
#pragma unroll 8
    for (int i = 0; i < 32; ++i) { const int kk = 2 * i + (lane >> 5); float w = W[(size_t)(k0 + kk) * ldw + c0 + n0 + (lane & 31)]; if (scale) w *= scale[k0 + kk]; scr[kk * 33 + (lane & 31)] = w; }
    LDS_WAIT(); asm volatile("" ::: "memory");
    const int c = lane & 7;
#pragma unroll
    for (int j = 0; j < 4; ++j) { const int n = (lane >> 3) + 8 * j; const LAS float* s = scr + (8 * c) * 33 + n;
        v4u o; o.x = pk2(s[0 * 33], s[1 * 33]); o.y = pk2(s[2 * 33], s[3 * 33]); o.z = pk2(s[4 * 33], s[5 * 33]); o.w = pk2(s[6 * 33], s[7 * 33]);
        *(GAS v4u*)(WT + (size_t)(row_off + n0 + n) * K + k0 + 8 * c) = o; }
    LDS_WAIT(); asm volatile("" ::: "memory");
}

__device__ __forceinline__ void phase_prep(const Params& P, const Ctx& C, LAS unsigned char* lds) {
    unsigned char* ws = P.ws;
    const float* xp = P.in[0]; const float* xs = P.in[1]; const float* ln1 = P.in[8]; const float* w_in = P.in[9]; const float* b_f = P.in[10];
    const float* a_log = P.in[12]; const float* dt_bias = P.in[13]; const float* w_o = P.in[15]; const float* ln2 = P.in[16]; const float* w_up = P.in[17]; const float* w_down = P.in[18];
    bf16* XN = (bf16*)(ws + WS_XN);
    float* LF = (float*)(ws + WS_LF); float* BETA = (float*)(ws + WS_BETA); float* Gg = (float*)(ws + WS_G);
    LAS float* WSm = (LAS float*)lds;
    LAS float* scr = (LAS float*)(lds + 49152 + C.wave * 8448);
    for (int idx = C.tid; idx < 12 * 1024; idx += NWAVES * 64) { const int k = idx / 12, c = idx % 12; const int col = c < 4 ? 1536 + c : 3588 + (c - 4); WSm[c * 1024 + k] = w_in[(size_t)k * INDIM + col]; }
    __syncthreads();
    const int gw = C.vcu * NWAVES + C.wave, NGW = C.G * NWAVES, lane = C.lane;
    f32x4 lw[4];
#pragma unroll
    for (int j = 0; j < 4; ++j) lw[j] = ((const f32x4*)ln1)[lane + 64 * j];
    for (int m = gw; m < M_TOT; m += NGW) {
        asm volatile("" ::: "memory");
        const float* xr = m < MP ? xp + (size_t)m * DM : xs + (size_t)(m - MP) * DM;
        f32x4 v[4]; float ss = 0.f;
#pragma unroll
        for (int j = 0; j < 4; ++j) { v[j] = ((const f32x4*)xr)[lane + 64 * j]; ss += (v[j][0] * v[j][0] + v[j][1] * v[j][1]) + (v[j][2] * v[j][2] + v[j][3] * v[j][3]); }
        ss = wave_sum(ss);
        const float rstd = 1.0f / sqrtf(ss * (1.0f / DM) + RMS_EPS);
#pragma unroll
        for (int j = 0; j < 4; ++j) { v[j] = v[j] * rstd * lw[j];
            v2u o; o.x = pk2(v[j][0], v[j][1]); o.y = pk2(v[j][2], v[j][3]);
            *(v2u*)(XN + (size_t)m * DM + 4 * lane + 256 * j) = o; }
        float mine = 0.f;
#pragma unroll
        for (int c = 0; c < 12; ++c) { float a = 0.f;
#pragma unroll
            for (int j = 0; j < 4; ++j) { const f32x4 w = *(const LAS f32x4*)(WSm + c * 1024 + 4 * lane + 256 * j); a += (v[j][0] * w[0] + v[j][1] * w[1]) + (v[j][2] * w[2] + v[j][3] * w[3]); }
            a = wave_sum(a); mine = (lane == c) ? a : mine; }
        const float bb = __shfl(mine, (lane + 4) & 63), aa = __shfl(mine, (lane + 8) & 63);
        if (lane < 4) {
            const float fa = mine;
            const float lf = -softplus_f(-(fa + b_f[lane]));
            const float beta = sigmoid_f(bb);
            const float g = -expf(a_log[lane]) * softplus_f(aa + dt_bias[lane]);
            LF[(size_t)m * 4 + lane] = lf; BETA[(size_t)m * 4 + lane] = beta; Gg[(size_t)m * 4 + lane] = g;
            if (m < MP) P.out[OLF_P + (size_t)m * 4 + lane] = lf; else P.out[OLF_S + (size_t)(m - MP) * 4 + lane] = lf;
        }
    }
    bf16* W1T = (bf16*)(ws + WS_W1T); bf16* WOT = (bf16*)(ws + WS_WOT); bf16* WUPT = (bf16*)(ws + WS_WUPT); bf16* WDNT = (bf16*)(ws + WS_WDNT);
    for (int it = gw; it < 16 * 48; it += NGW) transpose_item(w_in, INDIM, 0, DM, 1536, nullptr, W1T, 0, scr, it, lane);
    for (int it = gw; it < 16 * 48; it += NGW) transpose_item(w_in, INDIM, 1540, DM, 1536, nullptr, W1T, 1536, scr, it, lane);
    for (int it = gw; it < 16 * 16; it += NGW) transpose_item(w_in, INDIM, 3076, DM, 512, nullptr, W1T, 3072, scr, it, lane);
    for (int it = gw; it < 16 * 32; it += NGW) transpose_item(w_o, DM, 0, DM, DM, nullptr, WOT, 0, scr, it, lane);
    for (int it = gw; it < 16 * 128; it += NGW) transpose_item(w_up, FF, 0, DM, FF, ln2, WUPT, 0, scr, it, lane);
    for (int it = gw; it < 64 * 32; it += NGW) transpose_item(w_down, DM, 0, FF, DM, nullptr, WDNT, 0, scr, it, lane);
}

__device__ __forceinline__ void kbias_seq(const Params& P, int bh, int lane) {
    const float* LF = (const float*)(P.ws + WS_LF); float* KBIAS = (float*)(P.ws + WS_KBIAS);
    const int b = bh >> 2, h = bh & 3;
    const float* src = LF + ((size_t)b * SEQ + 32 * lane) * 4 + h;
    float s = 0.f;
    for (int i = 0; i < 32; ++i) s += src[i * 4];
    float x = s;
#pragma unroll
    for (int o = 1; o < 64; o <<= 1) { const float y = __shfl_up(x, o); if (lane >= o) x += y; }
    float run = x - s;
    float* dst = KBIAS + (size_t)bh * SEQ + 32 * lane;
    const float inv = -11.313708498984761f;
    for (int i = 0; i < 32; ++i) { run += src[i * 4]; dst[i] = run * inv; }
}


namespace fox {
constexpr int D = 128, NW = 8, QBLK = 32, KVBLK = 64, QB = NW * QBLK;
constexpr int SHM_V = KVBLK * D * 2, SHM_K = KVBLK * D * 2;
constexpr float SCALE = 0.08838834764831845f, THR = 8.f;
#define KSWZ(row, colB) ((row) * 256 + ((colB) ^ (((row) & 7) << 4)))
#define SBAR() __builtin_amdgcn_sched_barrier(0)
__device__ __forceinline__ int v_st(int k, int c) { const int kk = (k & ~0xC) | ((k & 4) << 1) | ((k & 8) >> 1); return ((kk >> 3) * 4 + (c >> 5)) * 512 + ((kk & 7) * 32 + (c & 31)) * 2; }
__device__ __forceinline__ int v_rd_base(int lane) { return ((lane & 3) << 3) | (((lane >> 2) & 3) << 6) | (((lane >> 4) & 1) << 5) | (((lane >> 5) & 1) << 8); }
constexpr int v_rd_off(int d0, int ks, int half) { return d0 * 512 + ks * 4096 + half * 2048; }
__device__ __forceinline__ int crow(int r, int hi) { return (r & 3) + 8 * (r >> 2) + 4 * hi; }
__device__ __forceinline__ unsigned cvtpk(float lo, float hi) { unsigned r; asm volatile("v_cvt_pk_bf16_f32 %0, %1, %2" : "=v"(r) : "v"(lo), "v"(hi)); return r; }
__device__ __forceinline__ void mask_tile(f32x16& p0, f32x16& p1, int dq, unsigned W) {
    const float NEG = -__builtin_inff();
#pragma unroll
    for (int r = 0; r < 16; ++r) {
        const int c = (r & 3) + 8 * (r >> 2);
        if ((unsigned)(dq - c) >= W) p0[r] = NEG;
        if ((unsigned)(dq - c - 32) >= W) p1[r] = NEG;
    }
}
__device__ __forceinline__ void partialSM(f32x16& p0, f32x16& p1, float& m_reg, float& mn, float& alpha) {
    float pmax = p0[0]; for (int r = 1; r < 16; ++r) pmax = fmaxf(pmax, p0[r]); for (int r = 0; r < 16; ++r) pmax = fmaxf(pmax, p1[r]);
    { auto rr = __builtin_amdgcn_permlane32_swap(__float_as_uint(pmax), __float_as_uint(pmax), false, false);
      pmax = fmaxf(__uint_as_float(rr[0]), __uint_as_float(rr[1])); }
    constexpr float C2 = 1.4426950408889634f * SCALE;
    if (__builtin_expect(__all((pmax - m_reg) * SCALE <= THR), 1)) { mn = m_reg; alpha = 1.f; }
    else { mn = fmaxf(m_reg, pmax); alpha = __builtin_amdgcn_exp2f((m_reg - mn) * C2); m_reg = mn; }
    const float mnL = -mn * C2;
    for (int r = 0; r < 16; ++r) p0[r] = fmaf(p0[r], C2, mnL); for (int r = 0; r < 16; ++r) p1[r] = fmaf(p1[r], C2, mnL);
    for (int r = 0; r < 16; ++r) p0[r] = __builtin_amdgcn_exp2f(p0[r]);
}
__device__ __forceinline__ void finishSM(f32x16& p0, f32x16& p1, float alpha, float& l_reg, bf16x8& pa0, bf16x8& pa1, bf16x8& pa2, bf16x8& pa3) {
    for (int r = 0; r < 16; ++r) p1[r] = __builtin_amdgcn_exp2f(p1[r]);
    float ps = 0; for (int r = 0; r < 16; ++r) ps += p0[r]; for (int r = 0; r < 16; ++r) ps += p1[r];
    { auto rr = __builtin_amdgcn_permlane32_swap(__float_as_uint(ps), __float_as_uint(ps), false, false);
      ps = __uint_as_float(rr[0]) + __uint_as_float(rr[1]); }
    l_reg = l_reg * alpha + ps;
#define PK4(P, B_, OUT) do { unsigned a0 = cvtpk(P[B_+0], P[B_+1]), a1 = cvtpk(P[B_+2], P[B_+3]);                          \
        unsigned b0 = cvtpk(P[B_+4], P[B_+5]), b1 = cvtpk(P[B_+6], P[B_+7]);                                             \
        auto r0 = __builtin_amdgcn_permlane32_swap(a0, b0, false, false); auto r1 = __builtin_amdgcn_permlane32_swap(a1, b1, false, false); \
        v4u w = {r0[0], r1[0], r0[1], r1[1]}; OUT = *reinterpret_cast<bf16x8*>(&w); } while (0)
    PK4(p0, 0, pa0); PK4(p0, 8, pa1); PK4(p1, 0, pa2); PK4(p1, 8, pa3);
#undef PK4
}
template <int KB>
__device__ __forceinline__ void qkt(f32x16& p0, f32x16& p1, const char* K_lds, const float* bias_l, int r32, int hi, const bf16x8* qr) {
#pragma unroll
    for (int g = 0; g < 4; ++g) { const f32x4 t0 = *(const f32x4*)(bias_l + 8 * g + 4 * hi), t1 = *(const f32x4*)(bias_l + 32 + 8 * g + 4 * hi);
#pragma unroll
        for (int i = 0; i < 4; ++i) { p0[4 * g + i] = t0[i]; p1[4 * g + i] = t1[i]; } }
    const char* kb[4];
#pragma unroll
    for (int dd = 0; dd < 4; ++dd) kb[dd] = K_lds + KB * SHM_K + KSWZ(r32, (dd * 16 + hi * 8) * 2);
#pragma unroll
    for (int d0 = 0; d0 < 8; ++d0) { const char* a = kb[d0 & 3] + (d0 >> 2) * 128;
        bf16x8 b0 = *reinterpret_cast<const bf16x8*>(a);
        bf16x8 b1 = *reinterpret_cast<const bf16x8*>(a + 32 * 256);
        p0 = __builtin_amdgcn_mfma_f32_32x32x16_bf16(b0, qr[d0], p0, 0, 0, 0);
        p1 = __builtin_amdgcn_mfma_f32_32x32x16_bf16(b1, qr[d0], p1, 0, 0, 0); }
}
template <int VB>
__device__ __forceinline__ void pv_tile(f32x16* o, int vb0, bf16x8 pa0, bf16x8 pa1, bf16x8 pa2, bf16x8 pa3) {
#define TRRD(dst, off) asm volatile("ds_read_b64_tr_b16 %0, %1 offset:%2" : "=&v"(dst) : "v"(vb0), "i"(off) : "memory")
#define PV_D0(d0) do { s16x4 l0, l1, l2, l3, h0, h1, h2, h3; constexpr int b_ = VB * SHM_V + v_rd_off(d0, 0, 0);   \
        TRRD(l0, b_); TRRD(h0, b_ + 2048); TRRD(l1, b_ + 4096); TRRD(h1, b_ + 6144); TRRD(l2, b_ + 8192); TRRD(h2, b_ + 10240); TRRD(l3, b_ + 12288); TRRD(h3, b_ + 14336); \
        asm volatile("s_waitcnt lgkmcnt(0)" ::: "memory"); SBAR();   \
        o[d0] = __builtin_amdgcn_mfma_f32_32x32x16_bf16(pa0, (bf16x8){l0[0], l0[1], l0[2], l0[3], h0[0], h0[1], h0[2], h0[3]}, o[d0], 0, 0, 0);   \
        o[d0] = __builtin_amdgcn_mfma_f32_32x32x16_bf16(pa1, (bf16x8){l1[0], l1[1], l1[2], l1[3], h1[0], h1[1], h1[2], h1[3]}, o[d0], 0, 0, 0);   \
        o[d0] = __builtin_amdgcn_mfma_f32_32x32x16_bf16(pa2, (bf16x8){l2[0], l2[1], l2[2], l2[3], h2[0], h2[1], h2[2], h2[3]}, o[d0], 0, 0, 0);   \
        o[d0] = __builtin_amdgcn_mfma_f32_32x32x16_bf16(pa3, (bf16x8){l3[0], l3[1], l3[2], l3[3], h3[0], h3[1], h3[2], h3[3]}, o[d0], 0, 0, 0); } while (0)
    PV_D0(0); PV_D0(1); PV_D0(2); PV_D0(3);
#undef PV_D0
#undef TRRD
}

__device__ __forceinline__ void fox_block(char* lds, const bf16* Qh, const bf16* Kh, const bf16* Vh, const float* kbias, bf16* Orow0, int qb) {
    const int tid = threadIdx.x, wid = __builtin_amdgcn_readfirstlane(tid >> 6), lane = tid & 63, r32 = lane & 31, hi = lane >> 5;
    const int P0 = qb * QB, qlo = P0 + wid * QBLK, qm = qlo + r32 - 4 * hi;
    char* V_lds = lds; char* K_lds = lds + SHM_V;
    float* bias_l = (float*)(lds + SHM_V + SHM_K);
    float* wsf = bias_l + 64 + wid * 64; float* li_l = wsf; float* al_l = wsf + 32;
    bf16x8 qr[8];
#pragma unroll
    for (int d0 = 0; d0 < 8; ++d0) qr[d0] = *reinterpret_cast<const bf16x8*>(Qh + (size_t)(qlo + r32) * D + d0 * 16 + hi * 8);
    float m_reg = -1e30f, l_reg = 0.f; f32x16 o[4] = {};
    const int sr = tid >> 4, sc = (tid & 15) * 8, vst0 = v_st(sr, sc), vst1 = v_st(32 + sr, sc), kws = KSWZ(sr, sc * 2);
    const int vb0 = (int)(uintptr_t)V_lds + v_rd_base(lane);
    const int ntiles = P0 / KVBLK + 4;
    for (int j = ntiles - 1; j >= 0; --j) {
        const int kb = j * KVBLK;
        __syncthreads();
        { const bf16x8 k0 = *reinterpret_cast<const bf16x8*>(Kh + (size_t)(kb + sr) * D + sc), k1 = *reinterpret_cast<const bf16x8*>(Kh + (size_t)(kb + 32 + sr) * D + sc);
          const bf16x8 v0 = *reinterpret_cast<const bf16x8*>(Vh + (size_t)(kb + sr) * D + sc), v1 = *reinterpret_cast<const bf16x8*>(Vh + (size_t)(kb + 32 + sr) * D + sc);
          *(bf16x8*)(K_lds + kws) = k0; *(bf16x8*)(K_lds + kws + 32 * 256) = k1; *(bf16x8*)(V_lds + vst0) = v0; *(bf16x8*)(V_lds + vst1) = v1;
          if (tid < 64) bias_l[tid] = kbias[kb + tid]; }
        __syncthreads();
        if (kb <= qlo + QBLK - 1) {
            f32x16 p0, p1; float mn, al; bf16x8 pa0, pa1, pa2, pa3;
            qkt<0>(p0, p1, K_lds, bias_l, r32, hi, qr);
            if (kb + KVBLK - 1 > qlo) mask_tile(p0, p1, qm - kb, 0x40000000u);
            partialSM(p0, p1, m_reg, mn, al);
            if (__any(al < 1.f)) { if (hi == 0) al_l[r32] = al; asm volatile("s_waitcnt lgkmcnt(0)" ::: "memory");
                for (int d_ = 0; d_ < 4; ++d_) for (int r = 0; r < 16; ++r) o[d_][r] *= al_l[crow(r, hi)]; }
            finishSM(p0, p1, al, l_reg, pa0, pa1, pa2, pa3); SBAR();
            pv_tile<0>(o, vb0, pa0, pa1, pa2, pa3);
        }
    }
    if (hi == 0) li_l[r32] = l_reg; asm volatile("s_waitcnt lgkmcnt(0)" ::: "memory");
    float rli[16];
#pragma unroll
    for (int r = 0; r < 16; ++r) rli[r] = __builtin_amdgcn_rcpf(li_l[crow(r, hi)]);
    bf16* Ow = Orow0 + (size_t)qlo * DM;
#pragma unroll
    for (int r = 0; r < 16; ++r) { const int orow = crow(r, hi);
#pragma unroll
        for (int d0 = 0; d0 < 4; ++d0) { const float v = o[d0][r] * rli[r];
            const float vn = __shfl_xor(v, 1);
            if ((r32 & 1) == 0) *(unsigned*)(Ow + (size_t)orow * DM + d0 * 32 + r32) = cvtpk(v, vn); } }
    __syncthreads();
}
}


__device__ __forceinline__ void dec_update(float& m, float& l, f32x4& acc, const float (&x)[4], const f32x4 (&v)[4], int n) {
    float mx = m;
#pragma unroll
    for (int u = 0; u < 4; ++u) if (u < n) mx = fmaxf(mx, x[u]);
    const float al = __expf(m - mx);
    float ps = 0.f; f32x4 a = acc * al;
#pragma unroll
    for (int u = 0; u < 4; ++u) if (u < n) { const float p = __expf(x[u] - mx); ps += p; a += v[u] * p; }
    l = l * al + ps; acc = a; m = mx;
}
__device__ __forceinline__ float red32(float s) {
#pragma unroll
    for (int o = 1; o < 32; o <<= 1) s += __shfl_xor(s, o);
    return s;
}
__device__ __forceinline__ void decode_unit(const Params& P, LAS unsigned char* lds, int db) {
    const int tid = threadIdx.x, wid = __builtin_amdgcn_readfirstlane(tid >> 6), lane = tid & 63, hi = lane >> 5;
    const float* cache_k = P.in[2]; const float* cache_v = P.in[3]; const float* cache_lf = P.in[4]; const int* page_table = (const int*)P.in[5];
    const float* LF = (const float*)(P.ws + WS_LF); const float* QS = (const float*)(P.ws + WS_QS);
    bf16* MIX = (bf16*)(P.ws + WS_MIX);
    LAS f32x4* lfs = (LAS f32x4*)lds;
    LAS f32x4* wt = lfs + 2048;
    LAS float* cm = (LAS float*)(wt + 8);
    LAS float* cl = cm + 32;
    LAS f32x4* cacc = (LAS f32x4*)(cl + 32);
    const int ptv = (lane < NPAGES) ? page_table[db * NPAGES + lane] : 0;
#pragma unroll
    for (int i = 0; i < 4; ++i) { const int j = tid + 512 * i; const int pg = __shfl(ptv, j >> 7);
        lfs[j] = *(const f32x4*)(cache_lf + ((size_t)pg * PAGE + (j & 127)) * 4); }
    __syncthreads();
    {
        const f32x4 a0 = lfs[4 * tid], a1 = lfs[4 * tid + 1], a2 = lfs[4 * tid + 2], a3 = lfs[4 * tid + 3];
        const f32x4 tot = (a0 + a1) + (a2 + a3);
        f32x4 x = tot;
#pragma unroll
        for (int o = 1; o < 64; o <<= 1) { f32x4 y; y[0] = __shfl_down(x[0], o); y[1] = __shfl_down(x[1], o); y[2] = __shfl_down(x[2], o); y[3] = __shfl_down(x[3], o); if (lane + o < 64) x += y; }
        if (lane == 0) wt[wid] = x;
        __syncthreads();
        f32x4 after = {0.f, 0.f, 0.f, 0.f};
        for (int w2 = wid + 1; w2 < NWAVES; ++w2) after += wt[w2];
        const f32x4 lfn = *(const f32x4*)(LF + (size_t)(MP + db) * 4);
        const f32x4 B3 = (x - tot) + after + lfn, B2 = B3 + a3, B1 = B2 + a2, B0 = B1 + a1;
        lfs[4 * tid] = B0; lfs[4 * tid + 1] = B1; lfs[4 * tid + 2] = B2; lfs[4 * tid + 3] = B3;
    }
    __syncthreads();
    const float* qs = QS + (size_t)db * 512;
    const f32x4 qa = *(const f32x4*)(qs + 4 * lane) * ATT_SCALE, qb = *(const f32x4*)(qs + 256 + 4 * lane) * ATT_SCALE;
    float m0 = -1e30f, l0 = 0.f, m1 = -1e30f, l1 = 0.f; f32x4 acc0 = {0.f, 0.f, 0.f, 0.f}, acc1 = {0.f, 0.f, 0.f, 0.f};
    f32x4 kaA[4], kbA[4], vaA[4], vbA[4], kaB[4], kbB[4], vaB[4], vbB[4];
#define DEC_LOAD(ka, kb, va, vb, j0_) do { _Pragma("unroll") for (int u = 0; u < 4; ++u) { const int j = (j0_) + 8 * u; const int pg = __builtin_amdgcn_readlane(ptv, j >> 7); \
            const size_t ro = ((size_t)pg * PAGE + (j & 127)) * 512 + 4 * lane; \
            ka[u] = *(const f32x4*)(cache_k + ro); kb[u] = *(const f32x4*)(cache_k + ro + 256); va[u] = *(const f32x4*)(cache_v + ro); vb[u] = *(const f32x4*)(cache_v + ro + 256); } } while (0)
#define DEC_PROC(ka, kb, va, vb, j0_) do { float x0[4], x1[4]; _Pragma("unroll") for (int u = 0; u < 4; ++u) { const int j = (j0_) + 8 * u; \
            float s0 = (qa[0] * ka[u][0] + qa[1] * ka[u][1]) + (qa[2] * ka[u][2] + qa[3] * ka[u][3]); \
            float s1 = (qb[0] * kb[u][0] + qb[1] * kb[u][1]) + (qb[2] * kb[u][2] + qb[3] * kb[u][3]); \
            s0 = red32(s0); s1 = red32(s1); const f32x4 bj = lfs[j]; \
            x0[u] = s0 + (hi ? bj[1] : bj[0]); x1[u] = s1 + (hi ? bj[3] : bj[2]); } \
        dec_update(m0, l0, acc0, x0, va, 4); dec_update(m1, l1, acc1, x1, vb, 4); } while (0)
    DEC_LOAD(kaA, kbA, vaA, vbA, wid);
    for (int j0 = wid; j0 < PAST; j0 += 64) {
        DEC_LOAD(kaB, kbB, vaB, vbB, j0 + 32);
        DEC_PROC(kaA, kbA, vaA, vbA, j0);
        if (j0 + 64 < PAST) DEC_LOAD(kaA, kbA, vaA, vbA, j0 + 64);
        DEC_PROC(kaB, kbB, vaB, vbB, j0 + 32);
    }
#undef DEC_LOAD
#undef DEC_PROC
    if (wid == 0) {
        f32x4 va[4], vb[4]; float x0[4], x1[4];
        const float* kn = P.out + OK_S + (size_t)db * 512; const float* vn = P.out + OV_S + (size_t)db * 512;
        const f32x4 ka = *(const f32x4*)(kn + 4 * lane), kb = *(const f32x4*)(kn + 256 + 4 * lane);
        va[0] = *(const f32x4*)(vn + 4 * lane); vb[0] = *(const f32x4*)(vn + 256 + 4 * lane);
#pragma unroll
        for (int u = 1; u < 4; ++u) { va[u] = va[0]; vb[u] = vb[0]; }
        x0[0] = red32((qa[0] * ka[0] + qa[1] * ka[1]) + (qa[2] * ka[2] + qa[3] * ka[3]));
        x1[0] = red32((qb[0] * kb[0] + qb[1] * kb[1]) + (qb[2] * kb[2] + qb[3] * kb[3]));
#pragma unroll
        for (int u = 1; u < 4; ++u) { x0[u] = x0[0]; x1[u] = x1[0]; }
        dec_update(m0, l0, acc0, x0, va, 1); dec_update(m1, l1, acc1, x1, vb, 1);
    }
    if ((lane & 31) == 0) { cm[wid * 4 + hi] = m0; cm[wid * 4 + 2 + hi] = m1; cl[wid * 4 + hi] = l0; cl[wid * 4 + 2 + hi] = l1; }
    cacc[(wid * 2 + 0) * 64 + lane] = acc0; cacc[(wid * 2 + 1) * 64 + lane] = acc1;
    __syncthreads();
    if (tid < 128) {
        const int ab = tid >> 6, l = tid & 63, head = 2 * ab + (l >> 5);
        float M = -1e30f;
#pragma unroll
        for (int w = 0; w < NWAVES; ++w) M = fmaxf(M, cm[w * 4 + head]);
        float L = 0.f; f32x4 O = {0.f, 0.f, 0.f, 0.f};
#pragma unroll
        for (int w = 0; w < NWAVES; ++w) { const float e = __expf(cm[w * 4 + head] - M); L += cl[w * 4 + head] * e; O += cacc[(w * 2 + ab) * 64 + l] * e; }
        const float inv = 1.0f / L;
        v2u o; o.x = pk2(O[0] * inv, O[1] * inv); o.y = pk2(O[2] * inv, O[3] * inv);
        *(v2u*)(MIX + (size_t)(MP + db) * DM + head * 128 + 4 * (l & 31)) = o;
    }
    __syncthreads();
}

__device__ __forceinline__ void sgdn_unit(const Params& P, LAS unsigned char* lds, int db, int h) {
    const int tid = threadIdx.x, wid = __builtin_amdgcn_readfirstlane(tid >> 6), lane = tid & 63;
    const float* state_conv = P.in[6]; const float* state_ssm = P.in[7]; const float* w_conv = P.in[11]; const float* w_gnorm = P.in[14];
    const float* BETA = (const float*)(P.ws + WS_BETA); const float* Gg = (const float*)(P.ws + WS_G);
    const bf16* ZB = (const bf16*)(P.ws + WS_ZB); bf16* MIX = (bf16*)(P.ws + WS_MIX);
    LAS float* xs = (LAS float*)lds;
    LAS float* red1 = xs + 384;
    LAS float* red2 = red1 + 1024;
    LAS float* ov = red2 + 1024;
    if (tid < 384) {
        const int seg = tid >> 7, d = tid & 127, ch = seg * 512 + h * 128 + d;
        const float* sc = state_conv + (size_t)db * 3 * CONVD + ch;
        float* oc = P.out + OCONV_S + (size_t)db * 3 * CONVD + ch;
        const float c0 = sc[0], c1 = sc[CONVD], c2 = sc[2 * CONVD], c3 = oc[2 * CONVD];
        const float a = c0 * w_conv[ch] + c1 * w_conv[CONVD + ch] + c2 * w_conv[2 * CONVD + ch] + c3 * w_conv[3 * CONVD + ch];
        xs[tid] = silu_f(a);
        oc[0] = c1; oc[CONVD] = c2;
    }
    __syncthreads();
    if (wid < 2) {
        const float a = xs[wid * 128 + lane], b = xs[wid * 128 + 64 + lane];
        const float ss = wave_sum(a * a + b * b);
        const float sc = (1.0f / sqrtf(ss + L2_EPS)) * (wid == 0 ? ATT_SCALE : 1.0f);
        xs[wid * 128 + lane] = a * sc; xs[wid * 128 + 64 + lane] = b * sc;
    }
    __syncthreads();
    const float gsc = expf(Gg[(size_t)(MP + db) * 4 + h]), bt = BETA[(size_t)(MP + db) * 4 + h];
    const float* Sp = state_ssm + ((size_t)(db * 4 + h) * 128 + 16 * wid) * 128 + 2 * lane;
    f32x2 s[16]; f32x2 ks = {0.f, 0.f};
#pragma unroll
    for (int r = 0; r < 16; ++r) { s[r] = *(const f32x2*)(Sp + (size_t)r * 128) * gsc; const float kd = xs[128 + 16 * wid + r]; ks += s[r] * kd; }
    *(LAS f32x2*)(red1 + wid * 128 + 2 * lane) = ks;
    __syncthreads();
    f32x2 kS = {0.f, 0.f};
#pragma unroll
    for (int w = 0; w < NWAVES; ++w) kS += *(const LAS f32x2*)(red1 + w * 128 + 2 * lane);
    const f32x2 vv = *(const LAS f32x2*)(xs + 256 + 2 * lane);
    const f32x2 delta = (vv - kS) * bt;
    float* So = P.out + OSSM_S + ((size_t)(db * 4 + h) * 128 + 16 * wid) * 128 + 2 * lane;
    f32x2 os = {0.f, 0.f};
#pragma unroll
    for (int r = 0; r < 16; ++r) { const float kd = xs[128 + 16 * wid + r], qd = xs[16 * wid + r]; s[r] += delta * kd; *(f32x2*)(So + (size_t)r * 128) = s[r]; os += s[r] * qd; }
    *(LAS f32x2*)(red2 + wid * 128 + 2 * lane) = os;
    __syncthreads();
    if (tid < 128) { float o = 0.f;
#pragma unroll
        for (int w = 0; w < NWAVES; ++w) o += red2[w * 128 + tid];
        ov[tid] = o; }
    __syncthreads();
    if (wid == 0) {
        const float a = ov[lane], b = ov[64 + lane];
        const float ss = wave_sum(a * a + b * b);
        const float rstd = 1.0f / sqrtf(ss * (1.0f / 128.0f) + RMS_EPS);
        const bf16* zr = ZB + (size_t)(MP + db) * 512 + h * 128;
        bf16* mr = MIX + (size_t)(MP + db) * DM + 512 + h * 128;
        mr[lane] = (bf16)f2bf(a * rstd * w_gnorm[lane] * silu_f(bf2f(zr[lane])));
        mr[64 + lane] = (bf16)f2bf(b * rstd * w_gnorm[64 + lane] * silu_f(bf2f(zr[64 + lane])));
    }
    __syncthreads();
}


constexpr int XS = 132, LS = 68;
__device__ __forceinline__ int sw256(int row, int ch) { return row * 256 + ((ch ^ (row & 15)) << 4); }
__device__ __forceinline__ int sw128(int row, int ch) { return row * 128 + ((ch ^ ((row >> 1) & 7)) << 4); }
__device__ __forceinline__ void gdna_unit(const Params& P, LAS unsigned char* lds, int unit) {
    const int tid = threadIdx.x, wid = __builtin_amdgcn_readfirstlane(tid >> 6), lane = tid & 63, fr = lane & 15, fq = lane >> 4;
    const int n = unit & 31, bh = unit >> 5, b = bh >> 2, h = bh & 3, m0 = b * SEQ + n * GCH;
    const float* w_conv = P.in[11];
    const bf16* CB = (const bf16*)(P.ws + WS_CB);
    const float* BETA = (const float*)(P.ws + WS_BETA); const float* Gg = (const float*)(P.ws + WS_G);
    float* UT = (float*)(P.ws + WS_UT) + (size_t)unit * 8192; bf16* WN = (bf16*)(P.ws + WS_WN) + (size_t)unit * 8192; bf16* QG = (bf16*)(P.ws + WS_QG) + (size_t)unit * 8192;
    bf16* KGT = (bf16*)(P.ws + WS_KGT) + (size_t)unit * 8192; bf16* QKM = (bf16*)(P.ws + WS_QKM) + (size_t)unit * 4096; float* GL = (float*)(P.ws + WS_GL);
    LAS float* XQ = (LAS float*)lds; LAS float* XK = XQ + 64 * XS; LAS float* XV = XK + 64 * XS;
    LAS unsigned char* RA = lds + 3 * 64 * XS * 4;
    LAS float* Lm = (LAS float*)RA;
    LAS unsigned char* KBf = RA + 17408;
    LAS unsigned char* QBf = RA + 17408 + 16384;
    LAS float* gcs = (LAS float*)(RA + 51456); LAS float* bts = gcs + 64; LAS float* sks = bts + 64;
    {
        v4u rv[7];
#pragma unroll
        for (int i = 0; i < 7; ++i) { const int c = tid + 512 * i; const int r = c / 48, w = c - r * 48, seg = w >> 4, ch = w & 15;
            rv[i] = (v4u){0u, 0u, 0u, 0u};
            if (c < 67 * 48 && (n > 0 || r >= 3)) rv[i] = *(const v4u*)(CB + (size_t)(m0 - 3 + r) * CONVD + seg * 512 + h * 128 + ch * 8); }
#pragma unroll
        for (int i = 0; i < 7; ++i) { const int c = tid + 512 * i; if (c < 67 * 48) *(LAS v4u*)(RA + c * 16) = rv[i]; }
    }
    if (wid == 7) {
        const float g = Gg[(size_t)(m0 + lane) * 4 + h]; float x = g;
#pragma unroll
        for (int o = 1; o < 64; o <<= 1) { const float y = __shfl_up(x, o); if (lane >= o) x += y; }
        { const float bt_ = BETA[(size_t)(m0 + lane) * 4 + h]; gcs[lane] = x; bts[lane] = bt_; sks[lane] = bt_ * expf(x); }
    }
    __syncthreads();
    if (tid < 384) {
        const int seg = tid >> 7, d = tid & 127, ch = seg * 512 + h * 128 + d;
        const float w0 = w_conv[ch], w1 = w_conv[CONVD + ch], w2 = w_conv[2 * CONVD + ch], w3 = w_conv[3 * CONVD + ch];
        const LAS bf16* src = (const LAS bf16*)RA + tid;
        float x0 = bf2f(src[0]), x1 = bf2f(src[384]), x2 = bf2f(src[768]);
        LAS float* X = XQ + seg * 64 * XS + d;
#pragma unroll 8
        for (int i = 0; i < 64; ++i) { const float x3 = bf2f(src[(i + 3) * 384]); X[i * XS] = silu_f((x0 * w0 + x1 * w1) + (x2 * w2 + x3 * w3)); x0 = x1; x1 = x2; x2 = x3; }
    }
    __syncthreads();
#pragma unroll
    for (int rr = 0; rr < 16; ++rr) { const int isq = rr < 8, i = 8 * wid + (rr & 7); LAS float* X = (isq ? XQ : XK) + i * XS + 2 * lane;
        f32x2 v = *(LAS f32x2*)X; const float ss = wave_sum(v[0] * v[0] + v[1] * v[1]);
        const float sc = (1.0f / sqrtf(ss + L2_EPS)) * (isq ? ATT_SCALE : 1.0f);
        v = v * sc; *(LAS f32x2*)X = v;
        *(LAS unsigned*)((isq ? QBf : KBf) + sw256(i, lane >> 2) + (lane & 3) * 4) = pk2(v[0], v[1]); }
    __syncthreads();
    {
        const int ti = wid >> 1, i = 16 * ti + fr; const float gi = gcs[i], bi = bts[i];
#pragma unroll
        for (int t2 = 0; t2 < 2; ++t2) {
            const int tj = 2 * (wid & 1) + t2;
            f32x4 akk = {0.f, 0.f, 0.f, 0.f}, aqk = {0.f, 0.f, 0.f, 0.f};
            if (tj <= ti) {
#pragma unroll
                for (int ks = 0; ks < 4; ++ks) {
                    const bf16x8 kj = *(const LAS bf16x8*)(KBf + sw256(16 * tj + fr, 4 * ks + fq));
                    const bf16x8 kiv = *(const LAS bf16x8*)(KBf + sw256(i, 4 * ks + fq)), qiv = *(const LAS bf16x8*)(QBf + sw256(i, 4 * ks + fq));
                    akk = __builtin_amdgcn_mfma_f32_16x16x32_bf16(kj, kiv, akk, 0, 0, 0);
                    aqk = __builtin_amdgcn_mfma_f32_16x16x32_bf16(kj, qiv, aqk, 0, 0, 0);
                }
            }
            f32x4 lv, qv; const f32x4 gj = *(const LAS f32x4*)(gcs + 16 * tj + 4 * fq);
#pragma unroll
            for (int jj = 0; jj < 4; ++jj) { const int j = 16 * tj + 4 * fq + jj; const float dec = (j <= i) ? expf(gi - gj[jj]) : 0.f;
                lv[jj] = (j < i) ? bi * akk[jj] * dec : 0.f; qv[jj] = (j <= i) ? aqk[jj] * dec : 0.f; }
            *(LAS f32x4*)(Lm + i * LS + 16 * tj + 4 * fq) = lv;
            v2u qo; qo.x = pk2(qv[0], qv[1]); qo.y = pk2(qv[2], qv[3]);
            *(v2u*)(QKM + (size_t)i * 64 + 16 * tj + 4 * fq) = qo;
        }
    }
    __syncthreads();
    if (tid < 256) {
        const int c = tid; const bool isv = c < 128; const LAS float* X = isv ? (XV + c) : (XK + (c - 128)); const LAS float* scp = isv ? bts : sks;
        int vz; asm volatile("v_mov_b32 %0, 0" : "=v"(vz));
        const LAS float* LmV = Lm + vz;
        const float x0 = X[0] * scp[0];
        const float rr1 = X[1 * XS] * scp[1]; const f32x4 T0_0 = *(const LAS f32x4*)(LmV + 1 * LS + 0); const float rr2 = X[2 * XS] * scp[2]; const f32x4 T1_0 = *(const LAS f32x4*)(LmV + 2 * LS + 0);
        float a0, a1, a2, a3;
        asm volatile("" ::: "memory"); const float rr3 = X[3 * XS] * scp[3]; const f32x4 T2_0 = *(const LAS f32x4*)(LmV + 3 * LS + 0);
        a0 = rr1; a1 = 0.f; a2 = 0.f; a3 = 0.f; a0 -= T0_0[0] * x0; const float x1 = (a0 + a1) + (a2 + a3);
        asm volatile("" ::: "memory"); const float rr4 = X[4 * XS] * scp[4]; const f32x4 T3_0 = *(const LAS f32x4*)(LmV + 4 * LS + 0);
        a0 = rr2; a1 = 0.f; a2 = 0.f; a3 = 0.f; a0 -= T1_0[0] * x0; a1 -= T1_0[1] * x1; const float x2 = (a0 + a1) + (a2 + a3);
        asm volatile("" ::: "memory"); const float rr5 = X[5 * XS] * scp[5]; const f32x4 T4_0 = *(const LAS f32x4*)(LmV + 5 * LS + 0); const f32x4 T4_1 = *(const LAS f32x4*)(LmV + 5 * LS + 4);
        a0 = rr3; a1 = 0.f; a2 = 0.f; a3 = 0.f; a0 -= T2_0[0] * x0; a1 -= T2_0[1] * x1; a2 -= T2_0[2] * x2; const float x3 = (a0 + a1) + (a2 + a3);
        asm volatile("" ::: "memory"); const float rr6 = X[6 * XS] * scp[6]; const f32x4 T5_0 = *(const LAS f32x4*)(LmV + 6 * LS + 0); const f32x4 T5_1 = *(const LAS f32x4*)(LmV + 6 * LS + 4);
        a0 = rr4; a1 = 0.f; a2 = 0.f; a3 = 0.f; a0 -= T3_0[0] * x0; a1 -= T3_0[1] * x1; a2 -= T3_0[2] * x2; a3 -= T3_0[3] * x3; const float x4 = (a0 + a1) + (a2 + a3);
        asm volatile("" ::: "memory"); const float rr7 = X[7 * XS] * scp[7]; const f32x4 T6_0 = *(const LAS f32x4*)(LmV + 7 * LS + 0); const f32x4 T6_1 = *(const LAS f32x4*)(LmV + 7 * LS + 4);
        a0 = rr5; a1 = 0.f; a2 = 0.f; a3 = 0.f; a0 -= T4_0[0] * x0; a1 -= T4_0[1] * x1; a2 -= T4_0[2] * x2; a3 -= T4_0[3] * x3; a0 -= T4_1[0] * x4; const float x5 = (a0 + a1) + (a2 + a3);
        asm volatile("" ::: "memory"); const float rr8 = X[8 * XS] * scp[8]; const f32x4 T7_0 = *(const LAS f32x4*)(LmV + 8 * LS + 0); const f32x4 T7_1 = *(const LAS f32x4*)(LmV + 8 * LS + 4);
        a0 = rr6; a1 = 0.f; a2 = 0.f; a3 = 0.f; a0 -= T5_0[0] * x0; a1 -= T5_0[1] * x1; a2 -= T5_0[2] * x2; a3 -= T5_0[3] * x3; a0 -= T5_1[0] * x4; a1 -= T5_1[1] * x5; const float x6 = (a0 + a1) + (a2 + a3);
        asm volatile("" ::: "memory"); const float rr9 = X[9 * XS] * scp[9]; const f32x4 T8_0 = *(const LAS f32x4*)(LmV + 9 * LS + 0); const f32x4 T8_1 = *(const LAS f32x4*)(LmV + 9 * LS + 4); const f32x4 T8_2 = *(const LAS f32x4*)(LmV + 9 * LS + 8);
        a0 = rr7; a1 = 0.f; a2 = 0.f; a3 = 0.f; a0 -= T6_0[0] * x0; a1 -= T6_0[1] * x1; a2 -= T6_0[2] * x2; a3 -= T6_0[3] * x3; a0 -= T6_1[0] * x4; a1 -= T6_1[1] * x5; a2 -= T6_1[2] * x6; const float x7 = (a0 + a1) + (a2 + a3);
        asm volatile("" ::: "memory"); const float rr10 = X[10 * XS] * scp[10]; const f32x4 T9_0 = *(const LAS f32x4*)(LmV + 10 * LS + 0); const f32x4 T9_1 = *(const LAS f32x4*)(LmV + 10 * LS + 4); const f32x4 T9_2 = *(const LAS f32x4*)(LmV + 10 * LS + 8);
        a0 = rr8; a1 = 0.f; a2 = 0.f; a3 = 0.f; a0 -= T7_0[0] * x0; a1 -= T7_0[1] * x1; a2 -= T7_0[2] * x2; a3 -= T7_0[3] * x3; a0 -= T7_1[0] * x4; a1 -= T7_1[1] * x5; a2 -= T7_1[2] * x6; a3 -= T7_1[3] * x7; const float x8 = (a0 + a1) + (a2 + a3);
        asm volatile("" ::: "memory"); const float rr11 = X[11 * XS] * scp[11]; const f32x4 T10_0 = *(const LAS f32x4*)(LmV + 11 * LS + 0); const f32x4 T10_1 = *(const LAS f32x4*)(LmV + 11 * LS + 4); const f32x4 T10_2 = *(const LAS f32x4*)(LmV + 11 * LS + 8);
        a0 = rr9; a1 = 0.f; a2 = 0.f; a3 = 0.f; a0 -= T8_0[0] * x0; a1 -= T8_0[1] * x1; a2 -= T8_0[2] * x2; a3 -= T8_0[3] * x3; a0 -= T8_1[0] * x4; a1 -= T8_1[1] * x5; a2 -= T8_1[2] * x6; a3 -= T8_1[3] * x7; a0 -= T8_2[0] * x8; const float x9 = (a0 + a1) + (a2 + a3);
        asm volatile("" ::: "memory"); const float rr12 = X[12 * XS] * scp[12]; const f32x4 T11_0 = *(const LAS f32x4*)(LmV + 12 * LS + 0); const f32x4 T11_1 = *(const LAS f32x4*)(LmV + 12 * LS + 4); const f32x4 T11_2 = *(const LAS f32x4*)(LmV + 12 * LS + 8);
        a0 = rr10; a1 = 0.f; a2 = 0.f; a3 = 0.f; a0 -= T9_0[0] * x0; a1 -= T9_0[1] * x1; a2 -= T9_0[2] * x2; a3 -= T9_0[3] * x3; a0 -= T9_1[0] * x4; a1 -= T9_1[1] * x5; a2 -= T9_1[2] * x6; a3 -= T9_1[3] * x7; a0 -= T9_2[0] * x8; a1 -= T9_2[1] * x9; const float x10 = (a0 + a1) + (a2 + a3);
        asm volatile("" ::: "memory"); const float rr13 = X[13 * XS] * scp[13]; const f32x4 T12_0 = *(const LAS f32x4*)(LmV + 13 * LS + 0); const f32x4 T12_1 = *(const LAS f32x4*)(LmV + 13 * LS + 4); const f32x4 T12_2 = *(const LAS f32x4*)(LmV + 13 * LS + 8); const f32x4 T12_3 = *(const LAS f32x4*)(LmV + 13 * LS + 12);
        a0 = rr11; a1 = 0.f; a2 = 0.f; a3 = 0.f; a0 -= T10_0[0] * x0; a1 -= T10_0[1] * x1; a2 -= T10_0[2] * x2; a3 -= T10_0[3] * x3; a0 -= T10_1[0] * x4; a1 -= T10_1[1] * x5; a2 -= T10_1[2] * x6; a3 -= T10_1[3] * x7; a0 -= T10_2[0] * x8; a1 -= T10_2[1] * x9; a2 -= T10_2[2] * x10; const float x11 = (a0 + a1) + (a2 + a3);
        asm volatile("" ::: "memory"); const float rr14 = X[14 * XS] * scp[14]; const f32x4 T13_0 = *(const LAS f32x4*)(LmV + 14 * LS + 0); const f32x4 T13_1 = *(const LAS f32x4*)(LmV + 14 * LS + 4); const f32x4 T13_2 = *(const LAS f32x4*)(LmV + 14 * LS + 8); const f32x4 T13_3 = *(const LAS f32x4*)(LmV + 14 * LS + 12);
        a0 = rr12; a1 = 0.f; a2 = 0.f; a3 = 0.f; a0 -= T11_0[0] * x0; a1 -= T11_0[1] * x1; a2 -= T11_0[2] * x2; a3 -= T11_0[3] * x3; a0 -= T11_1[0] * x4; a1 -= T11_1[1] * x5; a2 -= T11_1[2] * x6; a3 -= T11_1[3] * x7; a0 -= T11_2[0] * x8; a1 -= T11_2[1] * x9; a2 -= T11_2[2] * x10; a3 -= T11_2[3] * x11; const float x12 = (a0 + a1) + (a2 + a3);
        asm volatile("" ::: "memory"); const float rr15 = X[15 * XS] * scp[15]; const f32x4 T14_0 = *(const LAS f32x4*)(LmV + 15 * LS + 0); const f32x4 T14_1 = *(const LAS f32x4*)(LmV + 15 * LS + 4); const f32x4 T14_2 = *(const LAS f32x4*)(LmV + 15 * LS + 8); const f32x4 T14_3 = *(const LAS f32x4*)(LmV + 15 * LS + 12);
        a0 = rr13; a1 = 0.f; a2 = 0.f; a3 = 0.f; a0 -= T12_0[0] * x0; a1 -= T12_0[1] * x1; a2 -= T12_0[2] * x2; a3 -= T12_0[3] * x3; a0 -= T12_1[0] * x4; a1 -= T12_1[1] * x5; a2 -= T12_1[2] * x6; a3 -= T12_1[3] * x7; a0 -= T12_2[0] * x8; a1 -= T12_2[1] * x9; a2 -= T12_2[2] * x10; a3 -= T12_2[3] * x11; a0 -= T12_3[0] * x12; const float x13 = (a0 + a1) + (a2 + a3);
        asm volatile("" ::: "memory"); const float rr16 = X[16 * XS] * scp[16]; const f32x4 T15_0 = *(const LAS f32x4*)(LmV + 16 * LS + 0); const f32x4 T15_1 = *(const LAS f32x4*)(LmV + 16 * LS + 4); const f32x4 T15_2 = *(const LAS f32x4*)(LmV + 16 * LS + 8); const f32x4 T15_3 = *(const LAS f32x4*)(LmV + 16 * LS + 12);
        a0 = rr14; a1 = 0.f; a2 = 0.f; a3 = 0.f; a0 -= T13_0[0] * x0; a1 -= T13_0[1] * x1; a2 -= T13_0[2] * x2; a3 -= T13_0[3] * x3; a0 -= T13_1[0] * x4; a1 -= T13_1[1] * x5; a2 -= T13_1[2] * x6; a3 -= T13_1[3] * x7; a0 -= T13_2[0] * x8; a1 -= T13_2[1] * x9; a2 -= T13_2[2] * x10; a3 -= T13_2[3] * x11; a0 -= T13_3[0] * x12; a1 -= T13_3[1] * x13; const float x14 = (a0 + a1) + (a2 + a3);
        asm volatile("" ::: "memory"); const float rr17 = X[17 * XS] * scp[17]; const f32x4 T16_0 = *(const LAS f32x4*)(LmV + 17 * LS + 0); const f32x4 T16_1 = *(const LAS f32x4*)(LmV + 17 * LS + 4); const f32x4 T16_2 = *(const LAS f32x4*)(LmV + 17 * LS + 8); const f32x4 T16_3 = *(const LAS f32x4*)(LmV + 17 * LS + 12);
        a0 = rr15; a1 = 0.f; a2 = 0.f; a3 = 0.f; a0 -= T14_0[0] * x0; a1 -= T14_0[1] * x1; a2 -= T14_0[2] * x2; a3 -= T14_0[3] * x3; a0 -= T14_1[0] * x4; a1 -= T14_1[1] * x5; a2 -= T14_1[2] * x6; a3 -= T14_1[3] * x7; a0 -= T14_2[0] * x8; a1 -= T14_2[1] * x9; a2 -= T14_2[2] * x10; a3 -= T14_2[3] * x11; a0 -= T14_3[0] * x12; a1 -= T14_3[1] * x13; a2 -= T14_3[2] * x14; const float x15 = (a0 + a1) + (a2 + a3);
        asm volatile("" ::: "memory"); const f32x4 T17_0 = *(const LAS f32x4*)(LmV + 17 * LS + 16);
        a0 = rr16; a1 = 0.f; a2 = 0.f; a3 = 0.f; a0 -= T15_0[0] * x0; a1 -= T15_0[1] * x1; a2 -= T15_0[2] * x2; a3 -= T15_0[3] * x3; a0 -= T15_1[0] * x4; a1 -= T15_1[1] * x5; a2 -= T15_1[2] * x6; a3 -= T15_1[3] * x7; a0 -= T15_2[0] * x8; a1 -= T15_2[1] * x9; a2 -= T15_2[2] * x10; a3 -= T15_2[3] * x11; a0 -= T15_3[0] * x12; a1 -= T15_3[1] * x13; a2 -= T15_3[2] * x14; a3 -= T15_3[3] * x15; const float x16 = (a0 + a1) + (a2 + a3);
        asm volatile("" ::: "memory"); const float rr18 = X[18 * XS] * scp[18]; const f32x4 T18_0 = *(const LAS f32x4*)(LmV + 18 * LS + 0); const f32x4 T18_1 = *(const LAS f32x4*)(LmV + 18 * LS + 4); const f32x4 T18_2 = *(const LAS f32x4*)(LmV + 18 * LS + 8); const f32x4 T18_3 = *(const LAS f32x4*)(LmV + 18 * LS + 12);
        a0 = rr17; a1 = 0.f; a2 = 0.f; a3 = 0.f; a0 -= T16_0[0] * x0; a1 -= T16_0[1] * x1; a2 -= T16_0[2] * x2; a3 -= T16_0[3] * x3; a0 -= T16_1[0] * x4; a1 -= T16_1[1] * x5; a2 -= T16_1[2] * x6; a3 -= T16_1[3] * x7; a0 -= T16_2[0] * x8; a1 -= T16_2[1] * x9; a2 -= T16_2[2] * x10; a3 -= T16_2[3] * x11; a0 -= T16_3[0] * x12; a1 -= T16_3[1] * x13; a2 -= T16_3[2] * x14; a3 -= T16_3[3] * x15;
        asm volatile("" ::: "memory"); const f32x4 T19_0 = *(const LAS f32x4*)(LmV + 18 * LS + 16);
         a0 -= T17_0[0] * x16; const float x17 = (a0 + a1) + (a2 + a3);
        asm volatile("" ::: "memory"); const float rr19 = X[19 * XS] * scp[19]; const f32x4 T20_0 = *(const LAS f32x4*)(LmV + 19 * LS + 0); const f32x4 T20_1 = *(const LAS f32x4*)(LmV + 19 * LS + 4); const f32x4 T20_2 = *(const LAS f32x4*)(LmV + 19 * LS + 8); const f32x4 T20_3 = *(const LAS f32x4*)(LmV + 19 * LS + 12);
        a0 = rr18; a1 = 0.f; a2 = 0.f; a3 = 0.f; a0 -= T18_0[0] * x0; a1 -= T18_0[1] * x1; a2 -= T18_0[2] * x2; a3 -= T18_0[3] * x3; a0 -= T18_1[0] * x4; a1 -= T18_1[1] * x5; a2 -= T18_1[2] * x6; a3 -= T18_1[3] * x7; a0 -= T18_2[0] * x8; a1 -= T18_2[1] * x9; a2 -= T18_2[2] * x10; a3 -= T18_2[3] * x11; a0 -= T18_3[0] * x12; a1 -= T18_3[1] * x13; a2 -= T18_3[2] * x14; a3 -= T18_3[3] * x15;
        asm volatile("" ::: "memory"); const f32x4 T21_0 = *(const LAS f32x4*)(LmV + 19 * LS + 16);
         a0 -= T19_0[0] * x16; a1 -= T19_0[1] * x17; const float x18 = (a0 + a1) + (a2 + a3);
        asm volatile("" ::: "memory"); const float rr20 = X[20 * XS] * scp[20]; const f32x4 T22_0 = *(const LAS f32x4*)(LmV + 20 * LS + 0); const f32x4 T22_1 = *(const LAS f32x4*)(LmV + 20 * LS + 4); const f32x4 T22_2 = *(const LAS f32x4*)(LmV + 20 * LS + 8); const f32x4 T22_3 = *(const LAS f32x4*)(LmV + 20 * LS + 12);
        a0 = rr19; a1 = 0.f; a2 = 0.f; a3 = 0.f; a0 -= T20_0[0] * x0; a1 -= T20_0[1] * x1; a2 -= T20_0[2] * x2; a3 -= T20_0[3] * x3; a0 -= T20_1[0] * x4; a1 -= T20_1[1] * x5; a2 -= T20_1[2] * x6; a3 -= T20_1[3] * x7; a0 -= T20_2[0] * x8; a1 -= T20_2[1] * x9; a2 -= T20_2[2] * x10; a3 -= T20_2[3] * x11; a0 -= T20_3[0] * x12; a1 -= T20_3[1] * x13; a2 -= T20_3[2] * x14; a3 -= T20_3[3] * x15;
        asm volatile("" ::: "memory"); const f32x4 T23_0 = *(const LAS f32x4*)(LmV + 20 * LS + 16);
         a0 -= T21_0[0] * x16; a1 -= T21_0[1] * x17; a2 -= T21_0[2] * x18; const float x19 = (a0 + a1) + (a2 + a3);
        asm volatile("" ::: "memory"); const float rr21 = X[21 * XS] * scp[21]; const f32x4 T24_0 = *(const LAS f32x4*)(LmV + 21 * LS + 0); const f32x4 T24_1 = *(const LAS f32x4*)(LmV + 21 * LS + 4); const f32x4 T24_2 = *(const LAS f32x4*)(LmV + 21 * LS + 8); const f32x4 T24_3 = *(const LAS f32x4*)(LmV + 21 * LS + 12);
        a0 = rr20; a1 = 0.f; a2 = 0.f; a3 = 0.f; a0 -= T22_0[0] * x0; a1 -= T22_0[1] * x1; a2 -= T22_0[2] * x2; a3 -= T22_0[3] * x3; a0 -= T22_1[0] * x4; a1 -= T22_1[1] * x5; a2 -= T22_1[2] * x6; a3 -= T22_1[3] * x7; a0 -= T22_2[0] * x8; a1 -= T22_2[1] * x9; a2 -= T22_2[2] * x10; a3 -= T22_2[3] * x11; a0 -= T22_3[0] * x12; a1 -= T22_3[1] * x13; a2 -= T22_3[2] * x14; a3 -= T22_3[3] * x15;
        asm volatile("" ::: "memory"); const f32x4 T25_0 = *(const LAS f32x4*)(LmV + 21 * LS + 16); const f32x4 T25_1 = *(const LAS f32x4*)(LmV + 21 * LS + 20);
         a0 -= T23_0[0] * x16; a1 -= T23_0[1] * x17; a2 -= T23_0[2] * x18; a3 -= T23_0[3] * x19; const float x20 = (a0 + a1) + (a2 + a3);
        asm volatile("" ::: "memory"); const float rr22 = X[22 * XS] * scp[22]; const f32x4 T26_0 = *(const LAS f32x4*)(LmV + 22 * LS + 0); const f32x4 T26_1 = *(const LAS f32x4*)(LmV + 22 * LS + 4); const f32x4 T26_2 = *(const LAS f32x4*)(LmV + 22 * LS + 8); const f32x4 T26_3 = *(const LAS f32x4*)(LmV + 22 * LS + 12);
        a0 = rr21; a1 = 0.f; a2 = 0.f; a3 = 0.f; a0 -= T24_0[0] * x0; a1 -= T24_0[1] * x1; a2 -= T24_0[2] * x2; a3 -= T24_0[3] * x3; a0 -= T24_1[0] * x4; a1 -= T24_1[1] * x5; a2 -= T24_1[2] * x6; a3 -= T24_1[3] * x7; a0 -= T24_2[0] * x8; a1 -= T24_2[1] * x9; a2 -= T24_2[2] * x10; a3 -= T24_2[3] * x11; a0 -= T24_3[0] * x12; a1 -= T24_3[1] * x13; a2 -= T24_3[2] * x14; a3 -= T24_3[3] * x15;
        asm volatile("" ::: "memory"); const f32x4 T27_0 = *(const LAS f32x4*)(LmV + 22 * LS + 16); const f32x4 T27_1 = *(const LAS f32x4*)(LmV + 22 * LS + 20);
         a0 -= T25_0[0] * x16; a1 -= T25_0[1] * x17; a2 -= T25_0[2] * x18; a3 -= T25_0[3] * x19; a0 -= T25_1[0] * x20; const float x21 = (a0 + a1) + (a2 + a3);
        asm volatile("" ::: "memory"); const float rr23 = X[23 * XS] * scp[23]; const f32x4 T28_0 = *(const LAS f32x4*)(LmV + 23 * LS + 0); const f32x4 T28_1 = *(const LAS f32x4*)(LmV + 23 * LS + 4); const f32x4 T28_2 = *(const LAS f32x4*)(LmV + 23 * LS + 8); const f32x4 T28_3 = *(const LAS f32x4*)(LmV + 23 * LS + 12);
        a0 = rr22; a1 = 0.f; a2 = 0.f; a3 = 0.f; a0 -= T26_0[0] * x0; a1 -= T26_0[1] * x1; a2 -= T26_0[2] * x2; a3 -= T26_0[3] * x3; a0 -= T26_1[0] * x4; a1 -= T26_1[1] * x5; a2 -= T26_1[2] * x6; a3 -= T26_1[3] * x7; a0 -= T26_2[0] * x8; a1 -= T26_2[1] * x9; a2 -= T26_2[2] * x10; a3 -= T26_2[3] * x11; a0 -= T26_3[0] * x12; a1 -= T26_3[1] * x13; a2 -= T26_3[2] * x14; a3 -= T26_3[3] * x15;
        asm volatile("" ::: "memory"); const f32x4 T29_0 = *(const LAS f32x4*)(LmV + 23 * LS + 16); const f32x4 T29_1 = *(const LAS f32x4*)(LmV + 23 * LS + 20);
         a0 -= T27_0[0] * x16; a1 -= T27_0[1] * x17; a2 -= T27_0[2] * x18; a3 -= T27_0[3] * x19; a0 -= T27_1[0] * x20; a1 -= T27_1[1] * x21; const float x22 = (a0 + a1) + (a2 + a3);
        asm volatile("" ::: "memory"); const float rr24 = X[24 * XS] * scp[24]; const f32x4 T30_0 = *(const LAS f32x4*)(LmV + 24 * LS + 0); const f32x4 T30_1 = *(const LAS f32x4*)(LmV + 24 * LS + 4); const f32x4 T30_2 = *(const LAS f32x4*)(LmV + 24 * LS + 8); const f32x4 T30_3 = *(const LAS f32x4*)(LmV + 24 * LS + 12);
        a0 = rr23; a1 = 0.f; a2 = 0.f; a3 = 0.f; a0 -= T28_0[0] * x0; a1 -= T28_0[1] * x1; a2 -= T28_0[2] * x2; a3 -= T28_0[3] * x3; a0 -= T28_1[0] * x4; a1 -= T28_1[1] * x5; a2 -= T28_1[2] * x6; a3 -= T28_1[3] * x7; a0 -= T28_2[0] * x8; a1 -= T28_2[1] * x9; a2 -= T28_2[2] * x10; a3 -= T28_2[3] * x11; a0 -= T28_3[0] * x12; a1 -= T28_3[1] * x13; a2 -= T28_3[2] * x14; a3 -= T28_3[3] * x15;
        asm volatile("" ::: "memory"); const f32x4 T31_0 = *(const LAS f32x4*)(LmV + 24 * LS + 16); const f32x4 T31_1 = *(const LAS f32x4*)(LmV + 24 * LS + 20);
         a0 -= T29_0[0] * x16; a1 -= T29_0[1] * x17; a2 -= T29_0[2] * x18; a3 -= T29_0[3] * x19; a0 -= T29_1[0] * x20; a1 -= T29_1[1] * x21; a2 -= T29_1[2] * x22; const float x23 = (a0 + a1) + (a2 + a3);
        asm volatile("" ::: "memory"); const float rr25 = X[25 * XS] * scp[25]; const f32x4 T32_0 = *(const LAS f32x4*)(LmV + 25 * LS + 0); const f32x4 T32_1 = *(const LAS f32x4*)(LmV + 25 * LS + 4); const f32x4 T32_2 = *(const LAS f32x4*)(LmV + 25 * LS + 8); const f32x4 T32_3 = *(const LAS f32x4*)(LmV + 25 * LS + 12);
        a0 = rr24; a1 = 0.f; a2 = 0.f; a3 = 0.f; a0 -= T30_0[0] * x0; a1 -= T30_0[1] * x1; a2 -= T30_0[2] * x2; a3 -= T30_0[3] * x3; a0 -= T30_1[0] * x4; a1 -= T30_1[1] * x5; a2 -= T30_1[2] * x6; a3 -= T30_1[3] * x7; a0 -= T30_2[0] * x8; a1 -= T30_2[1] * x9; a2 -= T30_2[2] * x10; a3 -= T30_2[3] * x11; a0 -= T30_3[0] * x12; a1 -= T30_3[1] * x13; a2 -= T30_3[2] * x14; a3 -= T30_3[3] * x15;
        asm volatile("" ::: "memory"); const f32x4 T33_0 = *(const LAS f32x4*)(LmV + 25 * LS + 16); const f32x4 T33_1 = *(const LAS f32x4*)(LmV + 25 * LS + 20); const f32x4 T33_2 = *(const LAS f32x4*)(LmV + 25 * LS + 24);
         a0 -= T31_0[0] * x16; a1 -= T31_0[1] * x17; a2 -= T31_0[2] * x18; a3 -= T31_0[3] * x19; a0 -= T31_1[0] * x20; a1 -= T31_1[1] * x21; a2 -= T31_1[2] * x22; a3 -= T31_1[3] * x23; const float x24 = (a0 + a1) + (a2 + a3);
        asm volatile("" ::: "memory"); const float rr26 = X[26 * XS] * scp[26]; const f32x4 T34_0 = *(const LAS f32x4*)(LmV + 26 * LS + 0); const f32x4 T34_1 = *(const LAS f32x4*)(LmV + 26 * LS + 4); const f32x4 T34_2 = *(const LAS f32x4*)(LmV + 26 * LS + 8); const f32x4 T34_3 = *(const LAS f32x4*)(LmV + 26 * LS + 12);
        a0 = rr25; a1 = 0.f; a2 = 0.f; a3 = 0.f; a0 -= T32_0[0] * x0; a1 -= T32_0[1] * x1; a2 -= T32_0[2] * x2; a3 -= T32_0[3] * x3; a0 -= T32_1[0] * x4; a1 -= T32_1[1] * x5; a2 -= T32_1[2] * x6; a3 -= T32_1[3] * x7; a0 -= T32_2[0] * x8; a1 -= T32_2[1] * x9; a2 -= T32_2[2] * x10; a3 -= T32_2[3] * x11; a0 -= T32_3[0] * x12; a1 -= T32_3[1] * x13; a2 -= T32_3[2] * x14; a3 -= T32_3[3] * x15;
        asm volatile("" ::: "memory"); const f32x4 T35_0 = *(const LAS f32x4*)(LmV + 26 * LS + 16); const f32x4 T35_1 = *(const LAS f32x4*)(LmV + 26 * LS + 20); const f32x4 T35_2 = *(const LAS f32x4*)(LmV + 26 * LS + 24);
         a0 -= T33_0[0] * x16; a1 -= T33_0[1] * x17; a2 -= T33_0[2] * x18; a3 -= T33_0[3] * x19; a0 -= T33_1[0] * x20; a1 -= T33_1[1] * x21; a2 -= T33_1[2] * x22; a3 -= T33_1[3] * x23; a0 -= T33_2[0] * x24; const float x25 = (a0 + a1) + (a2 + a3);
        asm volatile("" ::: "memory"); const float rr27 = X[27 * XS] * scp[27]; const f32x4 T36_0 = *(const LAS f32x4*)(LmV + 27 * LS + 0); const f32x4 T36_1 = *(const LAS f32x4*)(LmV + 27 * LS + 4); const f32x4 T36_2 = *(const LAS f32x4*)(LmV + 27 * LS + 8); const f32x4 T36_3 = *(const LAS f32x4*)(LmV + 27 * LS + 12);
        a0 = rr26; a1 = 0.f; a2 = 0.f; a3 = 0.f; a0 -= T34_0[0] * x0; a1 -= T34_0[1] * x1; a2 -= T34_0[2] * x2; a3 -= T34_0[3] * x3; a0 -= T34_1[0] * x4; a1 -= T34_1[1] * x5; a2 -= T34_1[2] * x6; a3 -= T34_1[3] * x7; a0 -= T34_2[0] * x8; a1 -= T34_2[1] * x9; a2 -= T34_2[2] * x10; a3 -= T34_2[3] * x11; a0 -= T34_3[0] * x12; a1 -= T34_3[1] * x13; a2 -= T34_3[2] * x14; a3 -= T34_3[3] * x15;
        asm volatile("" ::: "memory"); const f32x4 T37_0 = *(const LAS f32x4*)(LmV + 27 * LS + 16); const f32x4 T37_1 = *(const LAS f32x4*)(LmV + 27 * LS + 20); const f32x4 T37_2 = *(const LAS f32x4*)(LmV + 27 * LS + 24);
         a0 -= T35_0[0] * x16; a1 -= T35_0[1] * x17; a2 -= T35_0[2] * x18; a3 -= T35_0[3] * x19; a0 -= T35_1[0] * x20; a1 -= T35_1[1] * x21; a2 -= T35_1[2] * x22; a3 -= T35_1[3] * x23; a0 -= T35_2[0] * x24; a1 -= T35_2[1] * x25; const float x26 = (a0 + a1) + (a2 + a3);
        asm volatile("" ::: "memory"); const float rr28 = X[28 * XS] * scp[28]; const f32x4 T38_0 = *(const LAS f32x4*)(LmV + 28 * LS + 0); const f32x4 T38_1 = *(const LAS f32x4*)(LmV + 28 * LS + 4); const f32x4 T38_2 = *(const LAS f32x4*)(LmV + 28 * LS + 8); const f32x4 T38_3 = *(const LAS f32x4*)(LmV + 28 * LS + 12);
        a0 = rr27; a1 = 0.f; a2 = 0.f; a3 = 0.f; a0 -= T36_0[0] * x0; a1 -= T36_0[1] * x1; a2 -= T36_0[2] * x2; a3 -= T36_0[3] * x3; a0 -= T36_1[0] * x4; a1 -= T36_1[1] * x5; a2 -= T36_1[2] * x6; a3 -= T36_1[3] * x7; a0 -= T36_2[0] * x8; a1 -= T36_2[1] * x9; a2 -= T36_2[2] * x10; a3 -= T36_2[3] * x11; a0 -= T36_3[0] * x12; a1 -= T36_3[1] * x13; a2 -= T36_3[2] * x14; a3 -= T36_3[3] * x15;
        asm volatile("" ::: "memory"); const f32x4 T39_0 = *(const LAS f32x4*)(LmV + 28 * LS + 16); const f32x4 T39_1 = *(const LAS f32x4*)(LmV + 28 * LS + 20); const f32x4 T39_2 = *(const LAS f32x4*)(LmV + 28 * LS + 24);
         a0 -= T37_0[0] * x16; a1 -= T37_0[1] * x17; a2 -= T37_0[2] * x18; a3 -= T37_0[3] * x19; a0 -= T37_1[0] * x20; a1 -= T37_1[1] * x21; a2 -= T37_1[2] * x22; a3 -= T37_1[3] * x23; a0 -= T37_2[0] * x24; a1 -= T37_2[1] * x25; a2 -= T37_2[2] * x26; const float x27 = (a0 + a1) + (a2 + a3);
        asm volatile("" ::: "memory"); const float rr29 = X[29 * XS] * scp[29]; const f32x4 T40_0 = *(const LAS f32x4*)(LmV + 29 * LS + 0); const f32x4 T40_1 = *(const LAS f32x4*)(LmV + 29 * LS + 4); const f32x4 T40_2 = *(const LAS f32x4*)(LmV + 29 * LS + 8); const f32x4 T40_3 = *(const LAS f32x4*)(LmV + 29 * LS + 12);
        a0 = rr28; a1 = 0.f; a2 = 0.f; a3 = 0.f; a0 -= T38_0[0] * x0; a1 -= T38_0[1] * x1; a2 -= T38_0[2] * x2; a3 -= T38_0[3] * x3; a0 -= T38_1[0] * x4; a1 -= T38_1[1] * x5; a2 -= T38_1[2] * x6; a3 -= T38_1[3] * x7; a0 -= T38_2[0] * x8; a1 -= T38_2[1] * x9; a2 -= T38_2[2] * x10; a3 -= T38_2[3] * x11; a0 -= T38_3[0] * x12; a1 -= T38_3[1] * x13; a2 -= T38_3[2] * x14; a3 -= T38_3[3] * x15;
        asm volatile("" ::: "memory"); const f32x4 T41_0 = *(const LAS f32x4*)(LmV + 29 * LS + 16); const f32x4 T41_1 = *(const LAS f32x4*)(LmV + 29 * LS + 20); const f32x4 T41_2 = *(const LAS f32x4*)(LmV + 29 * LS + 24); const f32x4 T41_3 = *(const LAS f32x4*)(LmV + 29 * LS + 28);
         a0 -= T39_0[0] * x16; a1 -= T39_0[1] * x17; a2 -= T39_0[2] * x18; a3 -= T39_0[3] * x19; a0 -= T39_1[0] * x20; a1 -= T39_1[1] * x21; a2 -= T39_1[2] * x22; a3 -= T39_1[3] * x23; a0 -= T39_2[0] * x24; a1 -= T39_2[1] * x25; a2 -= T39_2[2] * x26; a3 -= T39_2[3] * x27; const float x28 = (a0 + a1) + (a2 + a3);
        asm volatile("" ::: "memory"); const float rr30 = X[30 * XS] * scp[30]; const f32x4 T42_0 = *(const LAS f32x4*)(LmV + 30 * LS + 0); const f32x4 T42_1 = *(const LAS f32x4*)(LmV + 30 * LS + 4); const f32x4 T42_2 = *(const LAS f32x4*)(LmV + 30 * LS + 8); const f32x4 T42_3 = *(const LAS f32x4*)(LmV + 30 * LS + 12);
        a0 = rr29; a1 = 0.f; a2 = 0.f; a3 = 0.f; a0 -= T40_0[0] * x0; a1 -= T40_0[1] * x1; a2 -= T40_0[2] * x2; a3 -= T40_0[3] * x3; a0 -= T40_1[0] * x4; a1 -= T40_1[1] * x5; a2 -= T40_1[2] * x6; a3 -= T40_1[3] * x7; a0 -= T40_2[0] * x8; a1 -= T40_2[1] * x9; a2 -= T40_2[2] * x10; a3 -= T40_2[3] * x11; a0 -= T40_3[0] * x12; a1 -= T40_3[1] * x13; a2 -= T40_3[2] * x14; a3 -= T40_3[3] * x15;
        asm volatile("" ::: "memory"); const f32x4 T43_0 = *(const LAS f32x4*)(LmV + 30 * LS + 16); const f32x4 T43_1 = *(const LAS f32x4*)(LmV + 30 * LS + 20); const f32x4 T43_2 = *(const LAS f32x4*)(LmV + 30 * LS + 24); const f32x4 T43_3 = *(const LAS f32x4*)(LmV + 30 * LS + 28);
         a0 -= T41_0[0] * x16; a1 -= T41_0[1] * x17; a2 -= T41_0[2] * x18; a3 -= T41_0[3] * x19; a0 -= T41_1[0] * x20; a1 -= T41_1[1] * x21; a2 -= T41_1[2] * x22; a3 -= T41_1[3] * x23; a0 -= T41_2[0] * x24; a1 -= T41_2[1] * x25; a2 -= T41_2[2] * x26; a3 -= T41_2[3] * x27; a0 -= T41_3[0] * x28; const float x29 = (a0 + a1) + (a2 + a3);
        asm volatile("" ::: "memory"); const float rr31 = X[31 * XS] * scp[31]; const f32x4 T44_0 = *(const LAS f32x4*)(LmV + 31 * LS + 0); const f32x4 T44_1 = *(const LAS f32x4*)(LmV + 31 * LS + 4); const f32x4 T44_2 = *(const LAS f32x4*)(LmV + 31 * LS + 8); const f32x4 T44_3 = *(const LAS f32x4*)(LmV + 31 * LS + 12);
        a0 = rr30; a1 = 0.f; a2 = 0.f; a3 = 0.f; a0 -= T42_0[0] * x0; a1 -= T42_0[1] * x1; a2 -= T42_0[2] * x2; a3 -= T42_0[3] * x3; a0 -= T42_1[0] * x4; a1 -= T42_1[1] * x5; a2 -= T42_1[2] * x6; a3 -= T42_1[3] * x7; a0 -= T42_2[0] * x8; a1 -= T42_2[1] * x9; a2 -= T42_2[2] * x10; a3 -= T42_2[3] * x11; a0 -= T42_3[0] * x12; a1 -= T42_3[1] * x13; a2 -= T42_3[2] * x14; a3 -= T42_3[3] * x15;
        asm volatile("" ::: "memory"); const f32x4 T45_0 = *(const LAS f32x4*)(LmV + 31 * LS + 16); const f32x4 T45_1 = *(const LAS f32x4*)(LmV + 31 * LS + 20); const f32x4 T45_2 = *(const LAS f32x4*)(LmV + 31 * LS + 24); const f32x4 T45_3 = *(const LAS f32x4*)(LmV + 31 * LS + 28);
         a0 -= T43_0[0] * x16; a1 -= T43_0[1] * x17; a2 -= T43_0[2] * x18; a3 -= T43_0[3] * x19; a0 -= T43_1[0] * x20; a1 -= T43_1[1] * x21; a2 -= T43_1[2] * x22; a3 -= T43_1[3] * x23; a0 -= T43_2[0] * x24; a1 -= T43_2[1] * x25; a2 -= T43_2[2] * x26; a3 -= T43_2[3] * x27; a0 -= T43_3[0] * x28; a1 -= T43_3[1] * x29; const float x30 = (a0 + a1) + (a2 + a3);
        asm volatile("" ::: "memory"); const float rr32 = X[32 * XS] * scp[32]; const f32x4 T46_0 = *(const LAS f32x4*)(LmV + 32 * LS + 0); const f32x4 T46_1 = *(const LAS f32x4*)(LmV + 32 * LS + 4); const f32x4 T46_2 = *(const LAS f32x4*)(LmV + 32 * LS + 8); const f32x4 T46_3 = *(const LAS f32x4*)(LmV + 32 * LS + 12);
        a0 = rr31; a1 = 0.f; a2 = 0.f; a3 = 0.f; a0 -= T44_0[0] * x0; a1 -= T44_0[1] * x1; a2 -= T44_0[2] * x2; a3 -= T44_0[3] * x3; a0 -= T44_1[0] * x4; a1 -= T44_1[1] * x5; a2 -= T44_1[2] * x6; a3 -= T44_1[3] * x7; a0 -= T44_2[0] * x8; a1 -= T44_2[1] * x9; a2 -= T44_2[2] * x10; a3 -= T44_2[3] * x11; a0 -= T44_3[0] * x12; a1 -= T44_3[1] * x13; a2 -= T44_3[2] * x14; a3 -= T44_3[3] * x15;
        asm volatile("" ::: "memory"); const f32x4 T47_0 = *(const LAS f32x4*)(LmV + 32 * LS + 16); const f32x4 T47_1 = *(const LAS f32x4*)(LmV + 32 * LS + 20); const f32x4 T47_2 = *(const LAS f32x4*)(LmV + 32 * LS + 24); const f32x4 T47_3 = *(const LAS f32x4*)(LmV + 32 * LS + 28);
         a0 -= T45_0[0] * x16; a1 -= T45_0[1] * x17; a2 -= T45_0[2] * x18; a3 -= T45_0[3] * x19; a0 -= T45_1[0] * x20; a1 -= T45_1[1] * x21; a2 -= T45_1[2] * x22; a3 -= T45_1[3] * x23; a0 -= T45_2[0] * x24; a1 -= T45_2[1] * x25; a2 -= T45_2[2] * x26; a3 -= T45_2[3] * x27; a0 -= T45_3[0] * x28; a1 -= T45_3[1] * x29; a2 -= T45_3[2] * x30; const float x31 = (a0 + a1) + (a2 + a3);
        asm volatile("" ::: "memory"); const float rr33 = X[33 * XS] * scp[33]; const f32x4 T48_0 = *(const LAS f32x4*)(LmV + 33 * LS + 0); const f32x4 T48_1 = *(const LAS f32x4*)(LmV + 33 * LS + 4); const f32x4 T48_2 = *(const LAS f32x4*)(LmV + 33 * LS + 8); const f32x4 T48_3 = *(const LAS f32x4*)(LmV + 33 * LS + 12);
        a0 = rr32; a1 = 0.f; a2 = 0.f; a3 = 0.f; a0 -= T46_0[0] * x0; a1 -= T46_0[1] * x1; a2 -= T46_0[2] * x2; a3 -= T46_0[3] * x3; a0 -= T46_1[0] * x4; a1 -= T46_1[1] * x5; a2 -= T46_1[2] * x6; a3 -= T46_1[3] * x7; a0 -= T46_2[0] * x8; a1 -= T46_2[1] * x9; a2 -= T46_2[2] * x10; a3 -= T46_2[3] * x11; a0 -= T46_3[0] * x12; a1 -= T46_3[1] * x13; a2 -= T46_3[2] * x14; a3 -= T46_3[3] * x15;
        asm volatile("" ::: "memory"); const f32x4 T49_0 = *(const LAS f32x4*)(LmV + 33 * LS + 16); const f32x4 T49_1 = *(const LAS f32x4*)(LmV + 33 * LS + 20); const f32x4 T49_2 = *(const LAS f32x4*)(LmV + 33 * LS + 24); const f32x4 T49_3 = *(const LAS f32x4*)(LmV + 33 * LS + 28);
         a0 -= T47_0[0] * x16; a1 -= T47_0[1] * x17; a2 -= T47_0[2] * x18; a3 -= T47_0[3] * x19; a0 -= T47_1[0] * x20; a1 -= T47_1[1] * x21; a2 -= T47_1[2] * x22; a3 -= T47_1[3] * x23; a0 -= T47_2[0] * x24; a1 -= T47_2[1] * x25; a2 -= T47_2[2] * x26; a3 -= T47_2[3] * x27; a0 -= T47_3[0] * x28; a1 -= T47_3[1] * x29; a2 -= T47_3[2] * x30; a3 -= T47_3[3] * x31; const float x32 = (a0 + a1) + (a2 + a3);
        asm volatile("" ::: "memory"); const f32x4 T50_0 = *(const LAS f32x4*)(LmV + 33 * LS + 32);
        a0 = rr33; a1 = 0.f; a2 = 0.f; a3 = 0.f; a0 -= T48_0[0] * x0; a1 -= T48_0[1] * x1; a2 -= T48_0[2] * x2; a3 -= T48_0[3] * x3; a0 -= T48_1[0] * x4; a1 -= T48_1[1] * x5; a2 -= T48_1[2] * x6; a3 -= T48_1[3] * x7; a0 -= T48_2[0] * x8; a1 -= T48_2[1] * x9; a2 -= T48_2[2] * x10; a3 -= T48_2[3] * x11; a0 -= T48_3[0] * x12; a1 -= T48_3[1] * x13; a2 -= T48_3[2] * x14; a3 -= T48_3[3] * x15;
        asm volatile("" ::: "memory"); const float rr34 = X[34 * XS] * scp[34]; const f32x4 T51_0 = *(const LAS f32x4*)(LmV + 34 * LS + 0); const f32x4 T51_1 = *(const LAS f32x4*)(LmV + 34 * LS + 4); const f32x4 T51_2 = *(const LAS f32x4*)(LmV + 34 * LS + 8); const f32x4 T51_3 = *(const LAS f32x4*)(LmV + 34 * LS + 12);
         a0 -= T49_0[0] * x16; a1 -= T49_0[1] * x17; a2 -= T49_0[2] * x18; a3 -= T49_0[3] * x19; a0 -= T49_1[0] * x20; a1 -= T49_1[1] * x21; a2 -= T49_1[2] * x22; a3 -= T49_1[3] * x23; a0 -= T49_2[0] * x24; a1 -= T49_2[1] * x25; a2 -= T49_2[2] * x26; a3 -= T49_2[3] * x27; a0 -= T49_3[0] * x28; a1 -= T49_3[1] * x29; a2 -= T49_3[2] * x30; a3 -= T49_3[3] * x31;
        asm volatile("" ::: "memory"); const f32x4 T52_0 = *(const LAS f32x4*)(LmV + 34 * LS + 16); const f32x4 T52_1 = *(const LAS f32x4*)(LmV + 34 * LS + 20); const f32x4 T52_2 = *(const LAS f32x4*)(LmV + 34 * LS + 24); const f32x4 T52_3 = *(const LAS f32x4*)(LmV + 34 * LS + 28);
         a0 -= T50_0[0] * x32; const float x33 = (a0 + a1) + (a2 + a3);
        asm volatile("" ::: "memory"); const f32x4 T53_0 = *(const LAS f32x4*)(LmV + 34 * LS + 32);
        a0 = rr34; a1 = 0.f; a2 = 0.f; a3 = 0.f; a0 -= T51_0[0] * x0; a1 -= T51_0[1] * x1; a2 -= T51_0[2] * x2; a3 -= T51_0[3] * x3; a0 -= T51_1[0] * x4; a1 -= T51_1[1] * x5; a2 -= T51_1[2] * x6; a3 -= T51_1[3] * x7; a0 -= T51_2[0] * x8; a1 -= T51_2[1] * x9; a2 -= T51_2[2] * x10; a3 -= T51_2[3] * x11; a0 -= T51_3[0] * x12; a1 -= T51_3[1] * x13; a2 -= T51_3[2] * x14; a3 -= T51_3[3] * x15;
        asm volatile("" ::: "memory"); const float rr35 = X[35 * XS] * scp[35]; const f32x4 T54_0 = *(const LAS f32x4*)(LmV + 35 * LS + 0); const f32x4 T54_1 = *(const LAS f32x4*)(LmV + 35 * LS + 4); const f32x4 T54_2 = *(const LAS f32x4*)(LmV + 35 * LS + 8); const f32x4 T54_3 = *(const LAS f32x4*)(LmV + 35 * LS + 12);
         a0 -= T52_0[0] * x16; a1 -= T52_0[1] * x17; a2 -= T52_0[2] * x18; a3 -= T52_0[3] * x19; a0 -= T52_1[0] * x20; a1 -= T52_1[1] * x21; a2 -= T52_1[2] * x22; a3 -= T52_1[3] * x23; a0 -= T52_2[0] * x24; a1 -= T52_2[1] * x25; a2 -= T52_2[2] * x26; a3 -= T52_2[3] * x27; a0 -= T52_3[0] * x28; a1 -= T52_3[1] * x29; a2 -= T52_3[2] * x30; a3 -= T52_3[3] * x31;
        asm volatile("" ::: "memory"); const f32x4 T55_0 = *(const LAS f32x4*)(LmV + 35 * LS + 16); const f32x4 T55_1 = *(const LAS f32x4*)(LmV + 35 * LS + 20); const f32x4 T55_2 = *(const LAS f32x4*)(LmV + 35 * LS + 24); const f32x4 T55_3 = *(const LAS f32x4*)(LmV + 35 * LS + 28);
         a0 -= T53_0[0] * x32; a1 -= T53_0[1] * x33; const float x34 = (a0 + a1) + (a2 + a3);
        asm volatile("" ::: "memory"); const f32x4 T56_0 = *(const LAS f32x4*)(LmV + 35 * LS + 32);
        a0 = rr35; a1 = 0.f; a2 = 0.f; a3 = 0.f; a0 -= T54_0[0] * x0; a1 -= T54_0[1] * x1; a2 -= T54_0[2] * x2; a3 -= T54_0[3] * x3; a0 -= T54_1[0] * x4; a1 -= T54_1[1] * x5; a2 -= T54_1[2] * x6; a3 -= T54_1[3] * x7; a0 -= T54_2[0] * x8; a1 -= T54_2[1] * x9; a2 -= T54_2[2] * x10; a3 -= T54_2[3] * x11; a0 -= T54_3[0] * x12; a1 -= T54_3[1] * x13; a2 -= T54_3[2] * x14; a3 -= T54_3[3] * x15;
        asm volatile("" ::: "memory"); const float rr36 = X[36 * XS] * scp[36]; const f32x4 T57_0 = *(const LAS f32x4*)(LmV + 36 * LS + 0); const f32x4 T57_1 = *(const LAS f32x4*)(LmV + 36 * LS + 4); const f32x4 T57_2 = *(const LAS f32x4*)(LmV + 36 * LS + 8); const f32x4 T57_3 = *(const LAS f32x4*)(LmV + 36 * LS + 12);
         a0 -= T55_0[0] * x16; a1 -= T55_0[1] * x17; a2 -= T55_0[2] * x18; a3 -= T55_0[3] * x19; a0 -= T55_1[0] * x20; a1 -= T55_1[1] * x21; a2 -= T55_1[2] * x22; a3 -= T55_1[3] * x23; a0 -= T55_2[0] * x24; a1 -= T55_2[1] * x25; a2 -= T55_2[2] * x26; a3 -= T55_2[3] * x27; a0 -= T55_3[0] * x28; a1 -= T55_3[1] * x29; a2 -= T55_3[2] * x30; a3 -= T55_3[3] * x31;
        asm volatile("" ::: "memory"); const f32x4 T58_0 = *(const LAS f32x4*)(LmV + 36 * LS + 16); const f32x4 T58_1 = *(const LAS f32x4*)(LmV + 36 * LS + 20); const f32x4 T58_2 = *(const LAS f32x4*)(LmV + 36 * LS + 24); const f32x4 T58_3 = *(const LAS f32x4*)(LmV + 36 * LS + 28);
         a0 -= T56_0[0] * x32; a1 -= T56_0[1] * x33; a2 -= T56_0[2] * x34; const float x35 = (a0 + a1) + (a2 + a3);
        asm volatile("" ::: "memory"); const f32x4 T59_0 = *(const LAS f32x4*)(LmV + 36 * LS + 32);
        a0 = rr36; a1 = 0.f; a2 = 0.f; a3 = 0.f; a0 -= T57_0[0] * x0; a1 -= T57_0[1] * x1; a2 -= T57_0[2] * x2; a3 -= T57_0[3] * x3; a0 -= T57_1[0] * x4; a1 -= T57_1[1] * x5; a2 -= T57_1[2] * x6; a3 -= T57_1[3] * x7; a0 -= T57_2[0] * x8; a1 -= T57_2[1] * x9; a2 -= T57_2[2] * x10; a3 -= T57_2[3] * x11; a0 -= T57_3[0] * x12; a1 -= T57_3[1] * x13; a2 -= T57_3[2] * x14; a3 -= T57_3[3] * x15;
        asm volatile("" ::: "memory"); const float rr37 = X[37 * XS] * scp[37]; const f32x4 T60_0 = *(const LAS f32x4*)(LmV + 37 * LS + 0); const f32x4 T60_1 = *(const LAS f32x4*)(LmV + 37 * LS + 4); const f32x4 T60_2 = *(const LAS f32x4*)(LmV + 37 * LS + 8); const f32x4 T60_3 = *(const LAS f32x4*)(LmV + 37 * LS + 12);
         a0 -= T58_0[0] * x16; a1 -= T58_0[1] * x17; a2 -= T58_0[2] * x18; a3 -= T58_0[3] * x19; a0 -= T58_1[0] * x20; a1 -= T58_1[1] * x21; a2 -= T58_1[2] * x22; a3 -= T58_1[3] * x23; a0 -= T58_2[0] * x24; a1 -= T58_2[1] * x25; a2 -= T58_2[2] * x26; a3 -= T58_2[3] * x27; a0 -= T58_3[0] * x28; a1 -= T58_3[1] * x29; a2 -= T58_3[2] * x30; a3 -= T58_3[3] * x31;
        asm volatile("" ::: "memory"); const f32x4 T61_0 = *(const LAS f32x4*)(LmV + 37 * LS + 16); const f32x4 T61_1 = *(const LAS f32x4*)(LmV + 37 * LS + 20); const f32x4 T61_2 = *(const LAS f32x4*)(LmV + 37 * LS + 24); const f32x4 T61_3 = *(const LAS f32x4*)(LmV + 37 * LS + 28);
         a0 -= T59_0[0] * x32; a1 -= T59_0[1] * x33; a2 -= T59_0[2] * x34; a3 -= T59_0[3] * x35; const float x36 = (a0 + a1) + (a2 + a3);
        asm volatile("" ::: "memory"); const f32x4 T62_0 = *(const LAS f32x4*)(LmV + 37 * LS + 32); const f32x4 T62_1 = *(const LAS f32x4*)(LmV + 37 * LS + 36);
        a0 = rr37; a1 = 0.f; a2 = 0.f; a3 = 0.f; a0 -= T60_0[0] * x0; a1 -= T60_0[1] * x1; a2 -= T60_0[2] * x2; a3 -= T60_0[3] * x3; a0 -= T60_1[0] * x4; a1 -= T60_1[1] * x5; a2 -= T60_1[2] * x6; a3 -= T60_1[3] * x7; a0 -= T60_2[0] * x8; a1 -= T60_2[1] * x9; a2 -= T60_2[2] * x10; a3 -= T60_2[3] * x11; a0 -= T60_3[0] * x12; a1 -= T60_3[1] * x13; a2 -= T60_3[2] * x14; a3 -= T60_3[3] * x15;
        asm volatile("" ::: "memory"); const float rr38 = X[38 * XS] * scp[38]; const f32x4 T63_0 = *(const LAS f32x4*)(LmV + 38 * LS + 0); const f32x4 T63_1 = *(const LAS f32x4*)(LmV + 38 * LS + 4); const f32x4 T63_2 = *(const LAS f32x4*)(LmV + 38 * LS + 8); const f32x4 T63_3 = *(const LAS f32x4*)(LmV + 38 * LS + 12);
         a0 -= T61_0[0] * x16; a1 -= T61_0[1] * x17; a2 -= T61_0[2] * x18; a3 -= T61_0[3] * x19; a0 -= T61_1[0] * x20; a1 -= T61_1[1] * x21; a2 -= T61_1[2] * x22; a3 -= T61_1[3] * x23; a0 -= T61_2[0] * x24; a1 -= T61_2[1] * x25; a2 -= T61_2[2] * x26; a3 -= T61_2[3] * x27; a0 -= T61_3[0] * x28; a1 -= T61_3[1] * x29; a2 -= T61_3[2] * x30; a3 -= T61_3[3] * x31;
        asm volatile("" ::: "memory"); const f32x4 T64_0 = *(const LAS f32x4*)(LmV + 38 * LS + 16); const f32x4 T64_1 = *(const LAS f32x4*)(LmV + 38 * LS + 20); const f32x4 T64_2 = *(const LAS f32x4*)(LmV + 38 * LS + 24); const f32x4 T64_3 = *(const LAS f32x4*)(LmV + 38 * LS + 28);
         a0 -= T62_0[0] * x32; a1 -= T62_0[1] * x33; a2 -= T62_0[2] * x34; a3 -= T62_0[3] * x35; a0 -= T62_1[0] * x36; const float x37 = (a0 + a1) + (a2 + a3);
        asm volatile("" ::: "memory"); const f32x4 T65_0 = *(const LAS f32x4*)(LmV + 38 * LS + 32); const f32x4 T65_1 = *(const LAS f32x4*)(LmV + 38 * LS + 36);
        a0 = rr38; a1 = 0.f; a2 = 0.f; a3 = 0.f; a0 -= T63_0[0] * x0; a1 -= T63_0[1] * x1; a2 -= T63_0[2] * x2; a3 -= T63_0[3] * x3; a0 -= T63_1[0] * x4; a1 -= T63_1[1] * x5; a2 -= T63_1[2] * x6; a3 -= T63_1[3] * x7; a0 -= T63_2[0] * x8; a1 -= T63_2[1] * x9; a2 -= T63_2[2] * x10; a3 -= T63_2[3] * x11; a0 -= T63_3[0] * x12; a1 -= T63_3[1] * x13; a2 -= T63_3[2] * x14; a3 -= T63_3[3] * x15;
        asm volatile("" ::: "memory"); const float rr39 = X[39 * XS] * scp[39]; const f32x4 T66_0 = *(const LAS f32x4*)(LmV + 39 * LS + 0); const f32x4 T66_1 = *(const LAS f32x4*)(LmV + 39 * LS + 4); const f32x4 T66_2 = *(const LAS f32x4*)(LmV + 39 * LS + 8); const f32x4 T66_3 = *(const LAS f32x4*)(LmV + 39 * LS + 12);
         a0 -= T64_0[0] * x16; a1 -= T64_0[1] * x17; a2 -= T64_0[2] * x18; a3 -= T64_0[3] * x19; a0 -= T64_1[0] * x20; a1 -= T64_1[1] * x21; a2 -= T64_1[2] * x22; a3 -= T64_1[3] * x23; a0 -= T64_2[0] * x24; a1 -= T64_2[1] * x25; a2 -= T64_2[2] * x26; a3 -= T64_2[3] * x27; a0 -= T64_3[0] * x28; a1 -= T64_3[1] * x29; a2 -= T64_3[2] * x30; a3 -= T64_3[3] * x31;
        asm volatile("" ::: "memory"); const f32x4 T67_0 = *(const LAS f32x4*)(LmV + 39 * LS + 16); const f32x4 T67_1 = *(const LAS f32x4*)(LmV + 39 * LS + 20); const f32x4 T67_2 = *(const LAS f32x4*)(LmV + 39 * LS + 24); const f32x4 T67_3 = *(const LAS f32x4*)(LmV + 39 * LS + 28);
         a0 -= T65_0[0] * x32; a1 -= T65_0[1] * x33; a2 -= T65_0[2] * x34; a3 -= T65_0[3] * x35; a0 -= T65_1[0] * x36; a1 -= T65_1[1] * x37; const float x38 = (a0 + a1) + (a2 + a3);
        asm volatile("" ::: "memory"); const f32x4 T68_0 = *(const LAS f32x4*)(LmV + 39 * LS + 32); const f32x4 T68_1 = *(const LAS f32x4*)(LmV + 39 * LS + 36);
        a0 = rr39; a1 = 0.f; a2 = 0.f; a3 = 0.f; a0 -= T66_0[0] * x0; a1 -= T66_0[1] * x1; a2 -= T66_0[2] * x2; a3 -= T66_0[3] * x3; a0 -= T66_1[0] * x4; a1 -= T66_1[1] * x5; a2 -= T66_1[2] * x6; a3 -= T66_1[3] * x7; a0 -= T66_2[0] * x8; a1 -= T66_2[1] * x9; a2 -= T66_2[2] * x10; a3 -= T66_2[3] * x11; a0 -= T66_3[0] * x12; a1 -= T66_3[1] * x13; a2 -= T66_3[2] * x14; a3 -= T66_3[3] * x15;
        asm volatile("" ::: "memory"); const float rr40 = X[40 * XS] * scp[40]; const f32x4 T69_0 = *(const LAS f32x4*)(LmV + 40 * LS + 0); const f32x4 T69_1 = *(const LAS f32x4*)(LmV + 40 * LS + 4); const f32x4 T69_2 = *(const LAS f32x4*)(LmV + 40 * LS + 8); const f32x4 T69_3 = *(const LAS f32x4*)(LmV + 40 * LS + 12);
         a0 -= T67_0[0] * x16; a1 -= T67_0[1] * x17; a2 -= T67_0[2] * x18; a3 -= T67_0[3] * x19; a0 -= T67_1[0] * x20; a1 -= T67_1[1] * x21; a2 -= T67_1[2] * x22; a3 -= T67_1[3] * x23; a0 -= T67_2[0] * x24; a1 -= T67_2[1] * x25; a2 -= T67_2[2] * x26; a3 -= T67_2[3] * x27; a0 -= T67_3[0] * x28; a1 -= T67_3[1] * x29; a2 -= T67_3[2] * x30; a3 -= T67_3[3] * x31;
        asm volatile("" ::: "memory"); const f32x4 T70_0 = *(const LAS f32x4*)(LmV + 40 * LS + 16); const f32x4 T70_1 = *(const LAS f32x4*)(LmV + 40 * LS + 20); const f32x4 T70_2 = *(const LAS f32x4*)(LmV + 40 * LS + 24); const f32x4 T70_3 = *(const LAS f32x4*)(LmV + 40 * LS + 28);
         a0 -= T68_0[0] * x32; a1 -= T68_0[1] * x33; a2 -= T68_0[2] * x34; a3 -= T68_0[3] * x35; a0 -= T68_1[0] * x36; a1 -= T68_1[1] * x37; a2 -= T68_1[2] * x38; const float x39 = (a0 + a1) + (a2 + a3);
        asm volatile("" ::: "memory"); const f32x4 T71_0 = *(const LAS f32x4*)(LmV + 40 * LS + 32); const f32x4 T71_1 = *(const LAS f32x4*)(LmV + 40 * LS + 36);
        a0 = rr40; a1 = 0.f; a2 = 0.f; a3 = 0.f; a0 -= T69_0[0] * x0; a1 -= T69_0[1] * x1; a2 -= T69_0[2] * x2; a3 -= T69_0[3] * x3; a0 -= T69_1[0] * x4; a1 -= T69_1[1] * x5; a2 -= T69_1[2] * x6; a3 -= T69_1[3] * x7; a0 -= T69_2[0] * x8; a1 -= T69_2[1] * x9; a2 -= T69_2[2] * x10; a3 -= T69_2[3] * x11; a0 -= T69_3[0] * x12; a1 -= T69_3[1] * x13; a2 -= T69_3[2] * x14; a3 -= T69_3[3] * x15;
        asm volatile("" ::: "memory"); const float rr41 = X[41 * XS] * scp[41]; const f32x4 T72_0 = *(const LAS f32x4*)(LmV + 41 * LS + 0); const f32x4 T72_1 = *(const LAS f32x4*)(LmV + 41 * LS + 4); const f32x4 T72_2 = *(const LAS f32x4*)(LmV + 41 * LS + 8); const f32x4 T72_3 = *(const LAS f32x4*)(LmV + 41 * LS + 12);
         a0 -= T70_0[0] * x16; a1 -= T70_0[1] * x17; a2 -= T70_0[2] * x18; a3 -= T70_0[3] * x19; a0 -= T70_1[0] * x20; a1 -= T70_1[1] * x21; a2 -= T70_1[2] * x22; a3 -= T70_1[3] * x23; a0 -= T70_2[0] * x24; a1 -= T70_2[1] * x25; a2 -= T70_2[2] * x26; a3 -= T70_2[3] * x27; a0 -= T70_3[0] * x28; a1 -= T70_3[1] * x29; a2 -= T70_3[2] * x30; a3 -= T70_3[3] * x31;
        asm volatile("" ::: "memory"); const f32x4 T73_0 = *(const LAS f32x4*)(LmV + 41 * LS + 16); const f32x4 T73_1 = *(const LAS f32x4*)(LmV + 41 * LS + 20); const f32x4 T73_2 = *(const LAS f32x4*)(LmV + 41 * LS + 24); const f32x4 T73_3 = *(const LAS f32x4*)(LmV + 41 * LS + 28);
         a0 -= T71_0[0] * x32; a1 -= T71_0[1] * x33; a2 -= T71_0[2] * x34; a3 -= T71_0[3] * x35; a0 -= T71_1[0] * x36; a1 -= T71_1[1] * x37; a2 -= T71_1[2] * x38; a3 -= T71_1[3] * x39; const float x40 = (a0 + a1) + (a2 + a3);
        asm volatile("" ::: "memory"); const f32x4 T74_0 = *(const LAS f32x4*)(LmV + 41 * LS + 32); const f32x4 T74_1 = *(const LAS f32x4*)(LmV + 41 * LS + 36); const f32x4 T74_2 = *(const LAS f32x4*)(LmV + 41 * LS + 40);
        a0 = rr41; a1 = 0.f; a2 = 0.f; a3 = 0.f; a0 -= T72_0[0] * x0; a1 -= T72_0[1] * x1; a2 -= T72_0[2] * x2; a3 -= T72_0[3] * x3; a0 -= T72_1[0] * x4; a1 -= T72_1[1] * x5; a2 -= T72_1[2] * x6; a3 -= T72_1[3] * x7; a0 -= T72_2[0] * x8; a1 -= T72_2[1] * x9; a2 -= T72_2[2] * x10; a3 -= T72_2[3] * x11; a0 -= T72_3[0] * x12; a1 -= T72_3[1] * x13; a2 -= T72_3[2] * x14; a3 -= T72_3[3] * x15;
        asm volatile("" ::: "memory"); const float rr42 = X[42 * XS] * scp[42]; const f32x4 T75_0 = *(const LAS f32x4*)(LmV + 42 * LS + 0); const f32x4 T75_1 = *(const LAS f32x4*)(LmV + 42 * LS + 4); const f32x4 T75_2 = *(const LAS f32x4*)(LmV + 42 * LS + 8); const f32x4 T75_3 = *(const LAS f32x4*)(LmV + 42 * LS + 12);
         a0 -= T73_0[0] * x16; a1 -= T73_0[1] * x17; a2 -= T73_0[2] * x18; a3 -= T73_0[3] * x19; a0 -= T73_1[0] * x20; a1 -= T73_1[1] * x21; a2 -= T73_1[2] * x22; a3 -= T73_1[3] * x23; a0 -= T73_2[0] * x24; a1 -= T73_2[1] * x25; a2 -= T73_2[2] * x26; a3 -= T73_2[3] * x27; a0 -= T73_3[0] * x28; a1 -= T73_3[1] * x29; a2 -= T73_3[2] * x30; a3 -= T73_3[3] * x31;
        asm volatile("" ::: "memory"); const f32x4 T76_0 = *(const LAS f32x4*)(LmV + 42 * LS + 16); const f32x4 T76_1 = *(const LAS f32x4*)(LmV + 42 * LS + 20); const f32x4 T76_2 = *(const LAS f32x4*)(LmV + 42 * LS + 24); const f32x4 T76_3 = *(const LAS f32x4*)(LmV + 42 * LS + 28);
         a0 -= T74_0[0] * x32; a1 -= T74_0[1] * x33; a2 -= T74_0[2] * x34; a3 -= T74_0[3] * x35; a0 -= T74_1[0] * x36; a1 -= T74_1[1] * x37; a2 -= T74_1[2] * x38; a3 -= T74_1[3] * x39; a0 -= T74_2[0] * x40; const float x41 = (a0 + a1) + (a2 + a3);
        asm volatile("" ::: "memory"); const f32x4 T77_0 = *(const LAS f32x4*)(LmV + 42 * LS + 32); const f32x4 T77_1 = *(const LAS f32x4*)(LmV + 42 * LS + 36); const f32x4 T77_2 = *(const LAS f32x4*)(LmV + 42 * LS + 40);
        a0 = rr42; a1 = 0.f; a2 = 0.f; a3 = 0.f; a0 -= T75_0[0] * x0; a1 -= T75_0[1] * x1; a2 -= T75_0[2] * x2; a3 -= T75_0[3] * x3; a0 -= T75_1[0] * x4; a1 -= T75_1[1] * x5; a2 -= T75_1[2] * x6; a3 -= T75_1[3] * x7; a0 -= T75_2[0] * x8; a1 -= T75_2[1] * x9; a2 -= T75_2[2] * x10; a3 -= T75_2[3] * x11; a0 -= T75_3[0] * x12; a1 -= T75_3[1] * x13; a2 -= T75_3[2] * x14; a3 -= T75_3[3] * x15;
        asm volatile("" ::: "memory"); const float rr43 = X[43 * XS] * scp[43]; const f32x4 T78_0 = *(const LAS f32x4*)(LmV + 43 * LS + 0); const f32x4 T78_1 = *(const LAS f32x4*)(LmV + 43 * LS + 4); const f32x4 T78_2 = *(const LAS f32x4*)(LmV + 43 * LS + 8); const f32x4 T78_3 = *(const LAS f32x4*)(LmV + 43 * LS + 12);
         a0 -= T76_0[0] * x16; a1 -= T76_0[1] * x17; a2 -= T76_0[2] * x18; a3 -= T76_0[3] * x19; a0 -= T76_1[0] * x20; a1 -= T76_1[1] * x21; a2 -= T76_1[2] * x22; a3 -= T76_1[3] * x23; a0 -= T76_2[0] * x24; a1 -= T76_2[1] * x25; a2 -= T76_2[2] * x26; a3 -= T76_2[3] * x27; a0 -= T76_3[0] * x28; a1 -= T76_3[1] * x29; a2 -= T76_3[2] * x30; a3 -= T76_3[3] * x31;
        asm volatile("" ::: "memory"); const f32x4 T79_0 = *(const LAS f32x4*)(LmV + 43 * LS + 16); const f32x4 T79_1 = *(const LAS f32x4*)(LmV + 43 * LS + 20); const f32x4 T79_2 = *(const LAS f32x4*)(LmV + 43 * LS + 24); const f32x4 T79_3 = *(const LAS f32x4*)(LmV + 43 * LS + 28);
         a0 -= T77_0[0] * x32; a1 -= T77_0[1] * x33; a2 -= T77_0[2] * x34; a3 -= T77_0[3] * x35; a0 -= T77_1[0] * x36; a1 -= T77_1[1] * x37; a2 -= T77_1[2] * x38; a3 -= T77_1[3] * x39; a0 -= T77_2[0] * x40; a1 -= T77_2[1] * x41; const float x42 = (a0 + a1) + (a2 + a3);
        asm volatile("" ::: "memory"); const f32x4 T80_0 = *(const LAS f32x4*)(LmV + 43 * LS + 32); const f32x4 T80_1 = *(const LAS f32x4*)(LmV + 43 * LS + 36); const f32x4 T80_2 = *(const LAS f32x4*)(LmV + 43 * LS + 40);
        a0 = rr43; a1 = 0.f; a2 = 0.f; a3 = 0.f; a0 -= T78_0[0] * x0; a1 -= T78_0[1] * x1; a2 -= T78_0[2] * x2; a3 -= T78_0[3] * x3; a0 -= T78_1[0] * x4; a1 -= T78_1[1] * x5; a2 -= T78_1[2] * x6; a3 -= T78_1[3] * x7; a0 -= T78_2[0] * x8; a1 -= T78_2[1] * x9; a2 -= T78_2[2] * x10; a3 -= T78_2[3] * x11; a0 -= T78_3[0] * x12; a1 -= T78_3[1] * x13; a2 -= T78_3[2] * x14; a3 -= T78_3[3] * x15;
        asm volatile("" ::: "memory"); const float rr44 = X[44 * XS] * scp[44]; const f32x4 T81_0 = *(const LAS f32x4*)(LmV + 44 * LS + 0); const f32x4 T81_1 = *(const LAS f32x4*)(LmV + 44 * LS + 4); const f32x4 T81_2 = *(const LAS f32x4*)(LmV + 44 * LS + 8); const f32x4 T81_3 = *(const LAS f32x4*)(LmV + 44 * LS + 12);
         a0 -= T79_0[0] * x16; a1 -= T79_0[1] * x17; a2 -= T79_0[2] * x18; a3 -= T79_0[3] * x19; a0 -= T79_1[0] * x20; a1 -= T79_1[1] * x21; a2 -= T79_1[2] * x22; a3 -= T79_1[3] * x23; a0 -= T79_2[0] * x24; a1 -= T79_2[1] * x25; a2 -= T79_2[2] * x26; a3 -= T79_2[3] * x27; a0 -= T79_3[0] * x28; a1 -= T79_3[1] * x29; a2 -= T79_3[2] * x30; a3 -= T79_3[3] * x31;
        asm volatile("" ::: "memory"); const f32x4 T82_0 = *(const LAS f32x4*)(LmV + 44 * LS + 16); const f32x4 T82_1 = *(const LAS f32x4*)(LmV + 44 * LS + 20); const f32x4 T82_2 = *(const LAS f32x4*)(LmV + 44 * LS + 24); const f32x4 T82_3 = *(const LAS f32x4*)(LmV + 44 * LS + 28);
         a0 -= T80_0[0] * x32; a1 -= T80_0[1] * x33; a2 -= T80_0[2] * x34; a3 -= T80_0[3] * x35; a0 -= T80_1[0] * x36; a1 -= T80_1[1] * x37; a2 -= T80_1[2] * x38; a3 -= T80_1[3] * x39; a0 -= T80_2[0] * x40; a1 -= T80_2[1] * x41; a2 -= T80_2[2] * x42; const float x43 = (a0 + a1) + (a2 + a3);
        asm volatile("" ::: "memory"); const f32x4 T83_0 = *(const LAS f32x4*)(LmV + 44 * LS + 32); const f32x4 T83_1 = *(const LAS f32x4*)(LmV + 44 * LS + 36); const f32x4 T83_2 = *(const LAS f32x4*)(LmV + 44 * LS + 40);
        a0 = rr44; a1 = 0.f; a2 = 0.f; a3 = 0.f; a0 -= T81_0[0] * x0; a1 -= T81_0[1] * x1; a2 -= T81_0[2] * x2; a3 -= T81_0[3] * x3; a0 -= T81_1[0] * x4; a1 -= T81_1[1] * x5; a2 -= T81_1[2] * x6; a3 -= T81_1[3] * x7; a0 -= T81_2[0] * x8; a1 -= T81_2[1] * x9; a2 -= T81_2[2] * x10; a3 -= T81_2[3] * x11; a0 -= T81_3[0] * x12; a1 -= T81_3[1] * x13; a2 -= T81_3[2] * x14; a3 -= T81_3[3] * x15;
        asm volatile("" ::: "memory"); const float rr45 = X[45 * XS] * scp[45]; const f32x4 T84_0 = *(const LAS f32x4*)(LmV + 45 * LS + 0); const f32x4 T84_1 = *(const LAS f32x4*)(LmV + 45 * LS + 4); const f32x4 T84_2 = *(const LAS f32x4*)(LmV + 45 * LS + 8); const f32x4 T84_3 = *(const LAS f32x4*)(LmV + 45 * LS + 12);
         a0 -= T82_0[0] * x16; a1 -= T82_0[1] * x17; a2 -= T82_0[2] * x18; a3 -= T82_0[3] * x19; a0 -= T82_1[0] * x20; a1 -= T82_1[1] * x21; a2 -= T82_1[2] * x22; a3 -= T82_1[3] * x23; a0 -= T82_2[0] * x24; a1 -= T82_2[1] * x25; a2 -= T82_2[2] * x26; a3 -= T82_2[3] * x27; a0 -= T82_3[0] * x28; a1 -= T82_3[1] * x29; a2 -= T82_3[2] * x30; a3 -= T82_3[3] * x31;
        asm volatile("" ::: "memory"); const f32x4 T85_0 = *(const LAS f32x4*)(LmV + 45 * LS + 16); const f32x4 T85_1 = *(const LAS f32x4*)(LmV + 45 * LS + 20); const f32x4 T85_2 = *(const LAS f32x4*)(LmV + 45 * LS + 24); const f32x4 T85_3 = *(const LAS f32x4*)(LmV + 45 * LS + 28);
         a0 -= T83_0[0] * x32; a1 -= T83_0[1] * x33; a2 -= T83_0[2] * x34; a3 -= T83_0[3] * x35; a0 -= T83_1[0] * x36; a1 -= T83_1[1] * x37; a2 -= T83_1[2] * x38; a3 -= T83_1[3] * x39; a0 -= T83_2[0] * x40; a1 -= T83_2[1] * x41; a2 -= T83_2[2] * x42; a3 -= T83_2[3] * x43; const float x44 = (a0 + a1) + (a2 + a3);
        asm volatile("" ::: "memory"); const f32x4 T86_0 = *(const LAS f32x4*)(LmV + 45 * LS + 32); const f32x4 T86_1 = *(const LAS f32x4*)(LmV + 45 * LS + 36); const f32x4 T86_2 = *(const LAS f32x4*)(LmV + 45 * LS + 40); const f32x4 T86_3 = *(const LAS f32x4*)(LmV + 45 * LS + 44);
        a0 = rr45; a1 = 0.f; a2 = 0.f; a3 = 0.f; a0 -= T84_0[0] * x0; a1 -= T84_0[1] * x1; a2 -= T84_0[2] * x2; a3 -= T84_0[3] * x3; a0 -= T84_1[0] * x4; a1 -= T84_1[1] * x5; a2 -= T84_1[2] * x6; a3 -= T84_1[3] * x7; a0 -= T84_2[0] * x8; a1 -= T84_2[1] * x9; a2 -= T84_2[2] * x10; a3 -= T84_2[3] * x11; a0 -= T84_3[0] * x12; a1 -= T84_3[1] * x13; a2 -= T84_3[2] * x14; a3 -= T84_3[3] * x15;
        asm volatile("" ::: "memory"); const float rr46 = X[46 * XS] * scp[46]; const f32x4 T87_0 = *(const LAS f32x4*)(LmV + 46 * LS + 0); const f32x4 T87_1 = *(const LAS f32x4*)(LmV + 46 * LS + 4); const f32x4 T87_2 = *(const LAS f32x4*)(LmV + 46 * LS + 8); const f32x4 T87_3 = *(const LAS f32x4*)(LmV + 46 * LS + 12);
         a0 -= T85_0[0] * x16; a1 -= T85_0[1] * x17; a2 -= T85_0[2] * x18; a3 -= T85_0[3] * x19; a0 -= T85_1[0] * x20; a1 -= T85_1[1] * x21; a2 -= T85_1[2] * x22; a3 -= T85_1[3] * x23; a0 -= T85_2[0] * x24; a1 -= T85_2[1] * x25; a2 -= T85_2[2] * x26; a3 -= T85_2[3] * x27; a0 -= T85_3[0] * x28; a1 -= T85_3[1] * x29; a2 -= T85_3[2] * x30; a3 -= T85_3[3] * x31;
        asm volatile("" ::: "memory"); const f32x4 T88_0 = *(const LAS f32x4*)(LmV + 46 * LS + 16); const f32x4 T88_1 = *(const LAS f32x4*)(LmV + 46 * LS + 20); const f32x4 T88_2 = *(const LAS f32x4*)(LmV + 46 * LS + 24); const f32x4 T88_3 = *(const LAS f32x4*)(LmV + 46 * LS + 28);
         a0 -= T86_0[0] * x32; a1 -= T86_0[1] * x33; a2 -= T86_0[2] * x34; a3 -= T86_0[3] * x35; a0 -= T86_1[0] * x36; a1 -= T86_1[1] * x37; a2 -= T86_1[2] * x38; a3 -= T86_1[3] * x39; a0 -= T86_2[0] * x40; a1 -= T86_2[1] * x41; a2 -= T86_2[2] * x42; a3 -= T86_2[3] * x43; a0 -= T86_3[0] * x44; const float x45 = (a0 + a1) + (a2 + a3);
        asm volatile("" ::: "memory"); const f32x4 T89_0 = *(const LAS f32x4*)(LmV + 46 * LS + 32); const f32x4 T89_1 = *(const LAS f32x4*)(LmV + 46 * LS + 36); const f32x4 T89_2 = *(const LAS f32x4*)(LmV + 46 * LS + 40); const f32x4 T89_3 = *(const LAS f32x4*)(LmV + 46 * LS + 44);
        a0 = rr46; a1 = 0.f; a2 = 0.f; a3 = 0.f; a0 -= T87_0[0] * x0; a1 -= T87_0[1] * x1; a2 -= T87_0[2] * x2; a3 -= T87_0[3] * x3; a0 -= T87_1[0] * x4; a1 -= T87_1[1] * x5; a2 -= T87_1[2] * x6; a3 -= T87_1[3] * x7; a0 -= T87_2[0] * x8; a1 -= T87_2[1] * x9; a2 -= T87_2[2] * x10; a3 -= T87_2[3] * x11; a0 -= T87_3[0] * x12; a1 -= T87_3[1] * x13; a2 -= T87_3[2] * x14; a3 -= T87_3[3] * x15;
        asm volatile("" ::: "memory"); const float rr47 = X[47 * XS] * scp[47]; const f32x4 T90_0 = *(const LAS f32x4*)(LmV + 47 * LS + 0); const f32x4 T90_1 = *(const LAS f32x4*)(LmV + 47 * LS + 4); const f32x4 T90_2 = *(const LAS f32x4*)(LmV + 47 * LS + 8); const f32x4 T90_3 = *(const LAS f32x4*)(LmV + 47 * LS + 12);
         a0 -= T88_0[0] * x16; a1 -= T88_0[1] * x17; a2 -= T88_0[2] * x18; a3 -= T88_0[3] * x19; a0 -= T88_1[0] * x20; a1 -= T88_1[1] * x21; a2 -= T88_1[2] * x22; a3 -= T88_1[3] * x23; a0 -= T88_2[0] * x24; a1 -= T88_2[1] * x25; a2 -= T88_2[2] * x26; a3 -= T88_2[3] * x27; a0 -= T88_3[0] * x28; a1 -= T88_3[1] * x29; a2 -= T88_3[2] * x30; a3 -= T88_3[3] * x31;
        asm volatile("" ::: "memory"); const f32x4 T91_0 = *(const LAS f32x4*)(LmV + 47 * LS + 16); const f32x4 T91_1 = *(const LAS f32x4*)(LmV + 47 * LS + 20); const f32x4 T91_2 = *(const LAS f32x4*)(LmV + 47 * LS + 24); const f32x4 T91_3 = *(const LAS f32x4*)(LmV + 47 * LS + 28);
         a0 -= T89_0[0] * x32; a1 -= T89_0[1] * x33; a2 -= T89_0[2] * x34; a3 -= T89_0[3] * x35; a0 -= T89_1[0] * x36; a1 -= T89_1[1] * x37; a2 -= T89_1[2] * x38; a3 -= T89_1[3] * x39; a0 -= T89_2[0] * x40; a1 -= T89_2[1] * x41; a2 -= T89_2[2] * x42; a3 -= T89_2[3] * x43; a0 -= T89_3[0] * x44; a1 -= T89_3[1] * x45; const float x46 = (a0 + a1) + (a2 + a3);
        asm volatile("" ::: "memory"); const f32x4 T92_0 = *(const LAS f32x4*)(LmV + 47 * LS + 32); const f32x4 T92_1 = *(const LAS f32x4*)(LmV + 47 * LS + 36); const f32x4 T92_2 = *(const LAS f32x4*)(LmV + 47 * LS + 40); const f32x4 T92_3 = *(const LAS f32x4*)(LmV + 47 * LS + 44);
        a0 = rr47; a1 = 0.f; a2 = 0.f; a3 = 0.f; a0 -= T90_0[0] * x0; a1 -= T90_0[1] * x1; a2 -= T90_0[2] * x2; a3 -= T90_0[3] * x3; a0 -= T90_1[0] * x4; a1 -= T90_1[1] * x5; a2 -= T90_1[2] * x6; a3 -= T90_1[3] * x7; a0 -= T90_2[0] * x8; a1 -= T90_2[1] * x9; a2 -= T90_2[2] * x10; a3 -= T90_2[3] * x11; a0 -= T90_3[0] * x12; a1 -= T90_3[1] * x13; a2 -= T90_3[2] * x14; a3 -= T90_3[3] * x15;
        asm volatile("" ::: "memory"); const float rr48 = X[48 * XS] * scp[48]; const f32x4 T93_0 = *(const LAS f32x4*)(LmV + 48 * LS + 0); const f32x4 T93_1 = *(const LAS f32x4*)(LmV + 48 * LS + 4); const f32x4 T93_2 = *(const LAS f32x4*)(LmV + 48 * LS + 8); const f32x4 T93_3 = *(const LAS f32x4*)(LmV + 48 * LS + 12);
         a0 -= T91_0[0] * x16; a1 -= T91_0[1] * x17; a2 -= T91_0[2] * x18; a3 -= T91_0[3] * x19; a0 -= T91_1[0] * x20; a1 -= T91_1[1] * x21; a2 -= T91_1[2] * x22; a3 -= T91_1[3] * x23; a0 -= T91_2[0] * x24; a1 -= T91_2[1] * x25; a2 -= T91_2[2] * x26; a3 -= T91_2[3] * x27; a0 -= T91_3[0] * x28; a1 -= T91_3[1] * x29; a2 -= T91_3[2] * x30; a3 -= T91_3[3] * x31;
        asm volatile("" ::: "memory"); const f32x4 T94_0 = *(const LAS f32x4*)(LmV + 48 * LS + 16); const f32x4 T94_1 = *(const LAS f32x4*)(LmV + 48 * LS + 20); const f32x4 T94_2 = *(const LAS f32x4*)(LmV + 48 * LS + 24); const f32x4 T94_3 = *(const LAS f32x4*)(LmV + 48 * LS + 28);
         a0 -= T92_0[0] * x32; a1 -= T92_0[1] * x33; a2 -= T92_0[2] * x34; a3 -= T92_0[3] * x35; a0 -= T92_1[0] * x36; a1 -= T92_1[1] * x37; a2 -= T92_1[2] * x38; a3 -= T92_1[3] * x39; a0 -= T92_2[0] * x40; a1 -= T92_2[1] * x41; a2 -= T92_2[2] * x42; a3 -= T92_2[3] * x43; a0 -= T92_3[0] * x44; a1 -= T92_3[1] * x45; a2 -= T92_3[2] * x46; const float x47 = (a0 + a1) + (a2 + a3);
        asm volatile("" ::: "memory"); const f32x4 T95_0 = *(const LAS f32x4*)(LmV + 48 * LS + 32); const f32x4 T95_1 = *(const LAS f32x4*)(LmV + 48 * LS + 36); const f32x4 T95_2 = *(const LAS f32x4*)(LmV + 48 * LS + 40); const f32x4 T95_3 = *(const LAS f32x4*)(LmV + 48 * LS + 44);
        a0 = rr48; a1 = 0.f; a2 = 0.f; a3 = 0.f; a0 -= T93_0[0] * x0; a1 -= T93_0[1] * x1; a2 -= T93_0[2] * x2; a3 -= T93_0[3] * x3; a0 -= T93_1[0] * x4; a1 -= T93_1[1] * x5; a2 -= T93_1[2] * x6; a3 -= T93_1[3] * x7; a0 -= T93_2[0] * x8; a1 -= T93_2[1] * x9; a2 -= T93_2[2] * x10; a3 -= T93_2[3] * x11; a0 -= T93_3[0] * x12; a1 -= T93_3[1] * x13; a2 -= T93_3[2] * x14; a3 -= T93_3[3] * x15;
        asm volatile("" ::: "memory"); const float rr49 = X[49 * XS] * scp[49]; const f32x4 T96_0 = *(const LAS f32x4*)(LmV + 49 * LS + 0); const f32x4 T96_1 = *(const LAS f32x4*)(LmV + 49 * LS + 4); const f32x4 T96_2 = *(const LAS f32x4*)(LmV + 49 * LS + 8); const f32x4 T96_3 = *(const LAS f32x4*)(LmV + 49 * LS + 12);
         a0 -= T94_0[0] * x16; a1 -= T94_0[1] * x17; a2 -= T94_0[2] * x18; a3 -= T94_0[3] * x19; a0 -= T94_1[0] * x20; a1 -= T94_1[1] * x21; a2 -= T94_1[2] * x22; a3 -= T94_1[3] * x23; a0 -= T94_2[0] * x24; a1 -= T94_2[1] * x25; a2 -= T94_2[2] * x26; a3 -= T94_2[3] * x27; a0 -= T94_3[0] * x28; a1 -= T94_3[1] * x29; a2 -= T94_3[2] * x30; a3 -= T94_3[3] * x31;
        asm volatile("" ::: "memory"); const f32x4 T97_0 = *(const LAS f32x4*)(LmV + 49 * LS + 16); const f32x4 T97_1 = *(const LAS f32x4*)(LmV + 49 * LS + 20); const f32x4 T97_2 = *(const LAS f32x4*)(LmV + 49 * LS + 24); const f32x4 T97_3 = *(const LAS f32x4*)(LmV + 49 * LS + 28);
         a0 -= T95_0[0] * x32; a1 -= T95_0[1] * x33; a2 -= T95_0[2] * x34; a3 -= T95_0[3] * x35; a0 -= T95_1[0] * x36; a1 -= T95_1[1] * x37; a2 -= T95_1[2] * x38; a3 -= T95_1[3] * x39; a0 -= T95_2[0] * x40; a1 -= T95_2[1] * x41; a2 -= T95_2[2] * x42; a3 -= T95_2[3] * x43; a0 -= T95_3[0] * x44; a1 -= T95_3[1] * x45; a2 -= T95_3[2] * x46; a3 -= T95_3[3] * x47; const float x48 = (a0 + a1) + (a2 + a3);
        asm volatile("" ::: "memory"); const f32x4 T98_0 = *(const LAS f32x4*)(LmV + 49 * LS + 32); const f32x4 T98_1 = *(const LAS f32x4*)(LmV + 49 * LS + 36); const f32x4 T98_2 = *(const LAS f32x4*)(LmV + 49 * LS + 40); const f32x4 T98_3 = *(const LAS f32x4*)(LmV + 49 * LS + 44);
        a0 = rr49; a1 = 0.f; a2 = 0.f; a3 = 0.f; a0 -= T96_0[0] * x0; a1 -= T96_0[1] * x1; a2 -= T96_0[2] * x2; a3 -= T96_0[3] * x3; a0 -= T96_1[0] * x4; a1 -= T96_1[1] * x5; a2 -= T96_1[2] * x6; a3 -= T96_1[3] * x7; a0 -= T96_2[0] * x8; a1 -= T96_2[1] * x9; a2 -= T96_2[2] * x10; a3 -= T96_2[3] * x11; a0 -= T96_3[0] * x12; a1 -= T96_3[1] * x13; a2 -= T96_3[2] * x14; a3 -= T96_3[3] * x15;
        asm volatile("" ::: "memory"); const f32x4 T99_0 = *(const LAS f32x4*)(LmV + 49 * LS + 48);
         a0 -= T97_0[0] * x16; a1 -= T97_0[1] * x17; a2 -= T97_0[2] * x18; a3 -= T97_0[3] * x19; a0 -= T97_1[0] * x20; a1 -= T97_1[1] * x21; a2 -= T97_1[2] * x22; a3 -= T97_1[3] * x23; a0 -= T97_2[0] * x24; a1 -= T97_2[1] * x25; a2 -= T97_2[2] * x26; a3 -= T97_2[3] * x27; a0 -= T97_3[0] * x28; a1 -= T97_3[1] * x29; a2 -= T97_3[2] * x30; a3 -= T97_3[3] * x31;
        asm volatile("" ::: "memory"); const float rr50 = X[50 * XS] * scp[50]; const f32x4 T100_0 = *(const LAS f32x4*)(LmV + 50 * LS + 0); const f32x4 T100_1 = *(const LAS f32x4*)(LmV + 50 * LS + 4); const f32x4 T100_2 = *(const LAS f32x4*)(LmV + 50 * LS + 8); const f32x4 T100_3 = *(const LAS f32x4*)(LmV + 50 * LS + 12);
         a0 -= T98_0[0] * x32; a1 -= T98_0[1] * x33; a2 -= T98_0[2] * x34; a3 -= T98_0[3] * x35; a0 -= T98_1[0] * x36; a1 -= T98_1[1] * x37; a2 -= T98_1[2] * x38; a3 -= T98_1[3] * x39; a0 -= T98_2[0] * x40; a1 -= T98_2[1] * x41; a2 -= T98_2[2] * x42; a3 -= T98_2[3] * x43; a0 -= T98_3[0] * x44; a1 -= T98_3[1] * x45; a2 -= T98_3[2] * x46; a3 -= T98_3[3] * x47;
        asm volatile("" ::: "memory"); const f32x4 T101_0 = *(const LAS f32x4*)(LmV + 50 * LS + 16); const f32x4 T101_1 = *(const LAS f32x4*)(LmV + 50 * LS + 20); const f32x4 T101_2 = *(const LAS f32x4*)(LmV + 50 * LS + 24); const f32x4 T101_3 = *(const LAS f32x4*)(LmV + 50 * LS + 28);
         a0 -= T99_0[0] * x48; const float x49 = (a0 + a1) + (a2 + a3);
        asm volatile("" ::: "memory"); const f32x4 T102_0 = *(const LAS f32x4*)(LmV + 50 * LS + 32); const f32x4 T102_1 = *(const LAS f32x4*)(LmV + 50 * LS + 36); const f32x4 T102_2 = *(const LAS f32x4*)(LmV + 50 * LS + 40); const f32x4 T102_3 = *(const LAS f32x4*)(LmV + 50 * LS + 44);
        a0 = rr50; a1 = 0.f; a2 = 0.f; a3 = 0.f; a0 -= T100_0[0] * x0; a1 -= T100_0[1] * x1; a2 -= T100_0[2] * x2; a3 -= T100_0[3] * x3; a0 -= T100_1[0] * x4; a1 -= T100_1[1] * x5; a2 -= T100_1[2] * x6; a3 -= T100_1[3] * x7; a0 -= T100_2[0] * x8; a1 -= T100_2[1] * x9; a2 -= T100_2[2] * x10; a3 -= T100_2[3] * x11; a0 -= T100_3[0] * x12; a1 -= T100_3[1] * x13; a2 -= T100_3[2] * x14; a3 -= T100_3[3] * x15;
        asm volatile("" ::: "memory"); const f32x4 T103_0 = *(const LAS f32x4*)(LmV + 50 * LS + 48);
         a0 -= T101_0[0] * x16; a1 -= T101_0[1] * x17; a2 -= T101_0[2] * x18; a3 -= T101_0[3] * x19; a0 -= T101_1[0] * x20; a1 -= T101_1[1] * x21; a2 -= T101_1[2] * x22; a3 -= T101_1[3] * x23; a0 -= T101_2[0] * x24; a1 -= T101_2[1] * x25; a2 -= T101_2[2] * x26; a3 -= T101_2[3] * x27; a0 -= T101_3[0] * x28; a1 -= T101_3[1] * x29; a2 -= T101_3[2] * x30; a3 -= T101_3[3] * x31;
        asm volatile("" ::: "memory"); const float rr51 = X[51 * XS] * scp[51]; const f32x4 T104_0 = *(const LAS f32x4*)(LmV + 51 * LS + 0); const f32x4 T104_1 = *(const LAS f32x4*)(LmV + 51 * LS + 4); const f32x4 T104_2 = *(const LAS f32x4*)(LmV + 51 * LS + 8); const f32x4 T104_3 = *(const LAS f32x4*)(LmV + 51 * LS + 12);
         a0 -= T102_0[0] * x32; a1 -= T102_0[1] * x33; a2 -= T102_0[2] * x34; a3 -= T102_0[3] * x35; a0 -= T102_1[0] * x36; a1 -= T102_1[1] * x37; a2 -= T102_1[2] * x38; a3 -= T102_1[3] * x39; a0 -= T102_2[0] * x40; a1 -= T102_2[1] * x41; a2 -= T102_2[2] * x42; a3 -= T102_2[3] * x43; a0 -= T102_3[0] * x44; a1 -= T102_3[1] * x45; a2 -= T102_3[2] * x46; a3 -= T102_3[3] * x47;
        asm volatile("" ::: "memory"); const f32x4 T105_0 = *(const LAS f32x4*)(LmV + 51 * LS + 16); const f32x4 T105_1 = *(const LAS f32x4*)(LmV + 51 * LS + 20); const f32x4 T105_2 = *(const LAS f32x4*)(LmV + 51 * LS + 24); const f32x4 T105_3 = *(const LAS f32x4*)(LmV + 51 * LS + 28);
         a0 -= T103_0[0] * x48; a1 -= T103_0[1] * x49; const float x50 = (a0 + a1) + (a2 + a3);
        asm volatile("" ::: "memory"); const f32x4 T106_0 = *(const LAS f32x4*)(LmV + 51 * LS + 32); const f32x4 T106_1 = *(const LAS f32x4*)(LmV + 51 * LS + 36); const f32x4 T106_2 = *(const LAS f32x4*)(LmV + 51 * LS + 40); const f32x4 T106_3 = *(const LAS f32x4*)(LmV + 51 * LS + 44);
        a0 = rr51; a1 = 0.f; a2 = 0.f; a3 = 0.f; a0 -= T104_0[0] * x0; a1 -= T104_0[1] * x1; a2 -= T104_0[2] * x2; a3 -= T104_0[3] * x3; a0 -= T104_1[0] * x4; a1 -= T104_1[1] * x5; a2 -= T104_1[2] * x6; a3 -= T104_1[3] * x7; a0 -= T104_2[0] * x8; a1 -= T104_2[1] * x9; a2 -= T104_2[2] * x10; a3 -= T104_2[3] * x11; a0 -= T104_3[0] * x12; a1 -= T104_3[1] * x13; a2 -= T104_3[2] * x14; a3 -= T104_3[3] * x15;
        asm volatile("" ::: "memory"); const f32x4 T107_0 = *(const LAS f32x4*)(LmV + 51 * LS + 48);
         a0 -= T105_0[0] * x16; a1 -= T105_0[1] * x17; a2 -= T105_0[2] * x18; a3 -= T105_0[3] * x19; a0 -= T105_1[0] * x20; a1 -= T105_1[1] * x21; a2 -= T105_1[2] * x22; a3 -= T105_1[3] * x23; a0 -= T105_2[0] * x24; a1 -= T105_2[1] * x25; a2 -= T105_2[2] * x26; a3 -= T105_2[3] * x27; a0 -= T105_3[0] * x28; a1 -= T105_3[1] * x29; a2 -= T105_3[2] * x30; a3 -= T105_3[3] * x31;
        asm volatile("" ::: "memory"); const float rr52 = X[52 * XS] * scp[52]; const f32x4 T108_0 = *(const LAS f32x4*)(LmV + 52 * LS + 0); const f32x4 T108_1 = *(const LAS f32x4*)(LmV + 52 * LS + 4); const f32x4 T108_2 = *(const LAS f32x4*)(LmV + 52 * LS + 8); const f32x4 T108_3 = *(const LAS f32x4*)(LmV + 52 * LS + 12);
         a0 -= T106_0[0] * x32; a1 -= T106_0[1] * x33; a2 -= T106_0[2] * x34; a3 -= T106_0[3] * x35; a0 -= T106_1[0] * x36; a1 -= T106_1[1] * x37; a2 -= T106_1[2] * x38; a3 -= T106_1[3] * x39; a0 -= T106_2[0] * x40; a1 -= T106_2[1] * x41; a2 -= T106_2[2] * x42; a3 -= T106_2[3] * x43; a0 -= T106_3[0] * x44; a1 -= T106_3[1] * x45; a2 -= T106_3[2] * x46; a3 -= T106_3[3] * x47;
        asm volatile("" ::: "memory"); const f32x4 T109_0 = *(const LAS f32x4*)(LmV + 52 * LS + 16); const f32x4 T109_1 = *(const LAS f32x4*)(LmV + 52 * LS + 20); const f32x4 T109_2 = *(const LAS f32x4*)(LmV + 52 * LS + 24); const f32x4 T109_3 = *(const LAS f32x4*)(LmV + 52 * LS + 28);
         a0 -= T107_0[0] * x48; a1 -= T107_0[1] * x49; a2 -= T107_0[2] * x50; const float x51 = (a0 + a1) + (a2 + a3);
        asm volatile("" ::: "memory"); const f32x4 T110_0 = *(const LAS f32x4*)(LmV + 52 * LS + 32); const f32x4 T110_1 = *(const LAS f32x4*)(LmV + 52 * LS + 36); const f32x4 T110_2 = *(const LAS f32x4*)(LmV + 52 * LS + 40); const f32x4 T110_3 = *(const LAS f32x4*)(LmV + 52 * LS + 44);
        a0 = rr52; a1 = 0.f; a2 = 0.f; a3 = 0.f; a0 -= T108_0[0] * x0; a1 -= T108_0[1] * x1; a2 -= T108_0[2] * x2; a3 -= T108_0[3] * x3; a0 -= T108_1[0] * x4; a1 -= T108_1[1] * x5; a2 -= T108_1[2] * x6; a3 -= T108_1[3] * x7; a0 -= T108_2[0] * x8; a1 -= T108_2[1] * x9; a2 -= T108_2[2] * x10; a3 -= T108_2[3] * x11; a0 -= T108_3[0] * x12; a1 -= T108_3[1] * x13; a2 -= T108_3[2] * x14; a3 -= T108_3[3] * x15;
        asm volatile("" ::: "memory"); const f32x4 T111_0 = *(const LAS f32x4*)(LmV + 52 * LS + 48);
         a0 -= T109_0[0] * x16; a1 -= T109_0[1] * x17; a2 -= T109_0[2] * x18; a3 -= T109_0[3] * x19; a0 -= T109_1[0] * x20; a1 -= T109_1[1] * x21; a2 -= T109_1[2] * x22; a3 -= T109_1[3] * x23; a0 -= T109_2[0] * x24; a1 -= T109_2[1] * x25; a2 -= T109_2[2] * x26; a3 -= T109_2[3] * x27; a0 -= T109_3[0] * x28; a1 -= T109_3[1] * x29; a2 -= T109_3[2] * x30; a3 -= T109_3[3] * x31;
        asm volatile("" ::: "memory"); const float rr53 = X[53 * XS] * scp[53]; const f32x4 T112_0 = *(const LAS f32x4*)(LmV + 53 * LS + 0); const f32x4 T112_1 = *(const LAS f32x4*)(LmV + 53 * LS + 4); const f32x4 T112_2 = *(const LAS f32x4*)(LmV + 53 * LS + 8); const f32x4 T112_3 = *(const LAS f32x4*)(LmV + 53 * LS + 12);
         a0 -= T110_0[0] * x32; a1 -= T110_0[1] * x33; a2 -= T110_0[2] * x34; a3 -= T110_0[3] * x35; a0 -= T110_1[0] * x36; a1 -= T110_1[1] * x37; a2 -= T110_1[2] * x38; a3 -= T110_1[3] * x39; a0 -= T110_2[0] * x40; a1 -= T110_2[1] * x41; a2 -= T110_2[2] * x42; a3 -= T110_2[3] * x43; a0 -= T110_3[0] * x44; a1 -= T110_3[1] * x45; a2 -= T110_3[2] * x46; a3 -= T110_3[3] * x47;
        asm volatile("" ::: "memory"); const f32x4 T113_0 = *(const LAS f32x4*)(LmV + 53 * LS + 16); const f32x4 T113_1 = *(const LAS f32x4*)(LmV + 53 * LS + 20); const f32x4 T113_2 = *(const LAS f32x4*)(LmV + 53 * LS + 24); const f32x4 T113_3 = *(const LAS f32x4*)(LmV + 53 * LS + 28);
         a0 -= T111_0[0] * x48; a1 -= T111_0[1] * x49; a2 -= T111_0[2] * x50; a3 -= T111_0[3] * x51; const float x52 = (a0 + a1) + (a2 + a3);
        asm volatile("" ::: "memory"); const f32x4 T114_0 = *(const LAS f32x4*)(LmV + 53 * LS + 32); const f32x4 T114_1 = *(const LAS f32x4*)(LmV + 53 * LS + 36); const f32x4 T114_2 = *(const LAS f32x4*)(LmV + 53 * LS + 40); const f32x4 T114_3 = *(const LAS f32x4*)(LmV + 53 * LS + 44);
        a0 = rr53; a1 = 0.f; a2 = 0.f; a3 = 0.f; a0 -= T112_0[0] * x0; a1 -= T112_0[1] * x1; a2 -= T112_0[2] * x2; a3 -= T112_0[3] * x3; a0 -= T112_1[0] * x4; a1 -= T112_1[1] * x5; a2 -= T112_1[2] * x6; a3 -= T112_1[3] * x7; a0 -= T112_2[0] * x8; a1 -= T112_2[1] * x9; a2 -= T112_2[2] * x10; a3 -= T112_2[3] * x11; a0 -= T112_3[0] * x12; a1 -= T112_3[1] * x13; a2 -= T112_3[2] * x14; a3 -= T112_3[3] * x15;
        asm volatile("" ::: "memory"); const f32x4 T115_0 = *(const LAS f32x4*)(LmV + 53 * LS + 48); const f32x4 T115_1 = *(const LAS f32x4*)(LmV + 53 * LS + 52);
         a0 -= T113_0[0] * x16; a1 -= T113_0[1] * x17; a2 -= T113_0[2] * x18; a3 -= T113_0[3] * x19; a0 -= T113_1[0] * x20; a1 -= T113_1[1] * x21; a2 -= T113_1[2] * x22; a3 -= T113_1[3] * x23; a0 -= T113_2[0] * x24; a1 -= T113_2[1] * x25; a2 -= T113_2[2] * x26; a3 -= T113_2[3] * x27; a0 -= T113_3[0] * x28; a1 -= T113_3[1] * x29; a2 -= T113_3[2] * x30; a3 -= T113_3[3] * x31;
        asm volatile("" ::: "memory"); const float rr54 = X[54 * XS] * scp[54]; const f32x4 T116_0 = *(const LAS f32x4*)(LmV + 54 * LS + 0); const f32x4 T116_1 = *(const LAS f32x4*)(LmV + 54 * LS + 4); const f32x4 T116_2 = *(const LAS f32x4*)(LmV + 54 * LS + 8); const f32x4 T116_3 = *(const LAS f32x4*)(LmV + 54 * LS + 12);
         a0 -= T114_0[0] * x32; a1 -= T114_0[1] * x33; a2 -= T114_0[2] * x34; a3 -= T114_0[3] * x35; a0 -= T114_1[0] * x36; a1 -= T114_1[1] * x37; a2 -= T114_1[2] * x38; a3 -= T114_1[3] * x39; a0 -= T114_2[0] * x40; a1 -= T114_2[1] * x41; a2 -= T114_2[2] * x42; a3 -= T114_2[3] * x43; a0 -= T114_3[0] * x44; a1 -= T114_3[1] * x45; a2 -= T114_3[2] * x46; a3 -= T114_3[3] * x47;
        asm volatile("" ::: "memory"); const f32x4 T117_0 = *(const LAS f32x4*)(LmV + 54 * LS + 16); const f32x4 T117_1 = *(const LAS f32x4*)(LmV + 54 * LS + 20); const f32x4 T117_2 = *(const LAS f32x4*)(LmV + 54 * LS + 24); const f32x4 T117_3 = *(const LAS f32x4*)(LmV + 54 * LS + 28);
         a0 -= T115_0[0] * x48; a1 -= T115_0[1] * x49; a2 -= T115_0[2] * x50; a3 -= T115_0[3] * x51; a0 -= T115_1[0] * x52; const float x53 = (a0 + a1) + (a2 + a3);
        asm volatile("" ::: "memory"); const f32x4 T118_0 = *(const LAS f32x4*)(LmV + 54 * LS + 32); const f32x4 T118_1 = *(const LAS f32x4*)(LmV + 54 * LS + 36); const f32x4 T118_2 = *(const LAS f32x4*)(LmV + 54 * LS + 40); const f32x4 T118_3 = *(const LAS f32x4*)(LmV + 54 * LS + 44);
        a0 = rr54; a1 = 0.f; a2 = 0.f; a3 = 0.f; a0 -= T116_0[0] * x0; a1 -= T116_0[1] * x1; a2 -= T116_0[2] * x2; a3 -= T116_0[3] * x3; a0 -= T116_1[0] * x4; a1 -= T116_1[1] * x5; a2 -= T116_1[2] * x6; a3 -= T116_1[3] * x7; a0 -= T116_2[0] * x8; a1 -= T116_2[1] * x9; a2 -= T116_2[2] * x10; a3 -= T116_2[3] * x11; a0 -= T116_3[0] * x12; a1 -= T116_3[1] * x13; a2 -= T116_3[2] * x14; a3 -= T116_3[3] * x15;
        asm volatile("" ::: "memory"); const f32x4 T119_0 = *(const LAS f32x4*)(LmV + 54 * LS + 48); const f32x4 T119_1 = *(const LAS f32x4*)(LmV + 54 * LS + 52);
         a0 -= T117_0[0] * x16; a1 -= T117_0[1] * x17; a2 -= T117_0[2] * x18; a3 -= T117_0[3] * x19; a0 -= T117_1[0] * x20; a1 -= T117_1[1] * x21; a2 -= T117_1[2] * x22; a3 -= T117_1[3] * x23; a0 -= T117_2[0] * x24; a1 -= T117_2[1] * x25; a2 -= T117_2[2] * x26; a3 -= T117_2[3] * x27; a0 -= T117_3[0] * x28; a1 -= T117_3[1] * x29; a2 -= T117_3[2] * x30; a3 -= T117_3[3] * x31;
        asm volatile("" ::: "memory"); const float rr55 = X[55 * XS] * scp[55]; const f32x4 T120_0 = *(const LAS f32x4*)(LmV + 55 * LS + 0); const f32x4 T120_1 = *(const LAS f32x4*)(LmV + 55 * LS + 4); const f32x4 T120_2 = *(const LAS f32x4*)(LmV + 55 * LS + 8); const f32x4 T120_3 = *(const LAS f32x4*)(LmV + 55 * LS + 12);
         a0 -= T118_0[0] * x32; a1 -= T118_0[1] * x33; a2 -= T118_0[2] * x34; a3 -= T118_0[3] * x35; a0 -= T118_1[0] * x36; a1 -= T118_1[1] * x37; a2 -= T118_1[2] * x38; a3 -= T118_1[3] * x39; a0 -= T118_2[0] * x40; a1 -= T118_2[1] * x41; a2 -= T118_2[2] * x42; a3 -= T118_2[3] * x43; a0 -= T118_3[0] * x44; a1 -= T118_3[1] * x45; a2 -= T118_3[2] * x46; a3 -= T118_3[3] * x47;
        asm volatile("" ::: "memory"); const f32x4 T121_0 = *(const LAS f32x4*)(LmV + 55 * LS + 16); const f32x4 T121_1 = *(const LAS f32x4*)(LmV + 55 * LS + 20); const f32x4 T121_2 = *(const LAS f32x4*)(LmV + 55 * LS + 24); const f32x4 T121_3 = *(const LAS f32x4*)(LmV + 55 * LS + 28);
         a0 -= T119_0[0] * x48; a1 -= T119_0[1] * x49; a2 -= T119_0[2] * x50; a3 -= T119_0[3] * x51; a0 -= T119_1[0] * x52; a1 -= T119_1[1] * x53; const float x54 = (a0 + a1) + (a2 + a3);
        asm volatile("" ::: "memory"); const f32x4 T122_0 = *(const LAS f32x4*)(LmV + 55 * LS + 32); const f32x4 T122_1 = *(const LAS f32x4*)(LmV + 55 * LS + 36); const f32x4 T122_2 = *(const LAS f32x4*)(LmV + 55 * LS + 40); const f32x4 T122_3 = *(const LAS f32x4*)(LmV + 55 * LS + 44);
        a0 = rr55; a1 = 0.f; a2 = 0.f; a3 = 0.f; a0 -= T120_0[0] * x0; a1 -= T120_0[1] * x1; a2 -= T120_0[2] * x2; a3 -= T120_0[3] * x3; a0 -= T120_1[0] * x4; a1 -= T120_1[1] * x5; a2 -= T120_1[2] * x6; a3 -= T120_1[3] * x7; a0 -= T120_2[0] * x8; a1 -= T120_2[1] * x9; a2 -= T120_2[2] * x10; a3 -= T120_2[3] * x11; a0 -= T120_3[0] * x12; a1 -= T120_3[1] * x13; a2 -= T120_3[2] * x14; a3 -= T120_3[3] * x15;
        asm volatile("" ::: "memory"); const f32x4 T123_0 = *(const LAS f32x4*)(LmV + 55 * LS + 48); const f32x4 T123_1 = *(const LAS f32x4*)(LmV + 55 * LS + 52);
         a0 -= T121_0[0] * x16; a1 -= T121_0[1] * x17; a2 -= T121_0[2] * x18; a3 -= T121_0[3] * x19; a0 -= T121_1[0] * x20; a1 -= T121_1[1] * x21; a2 -= T121_1[2] * x22; a3 -= T121_1[3] * x23; a0 -= T121_2[0] * x24; a1 -= T121_2[1] * x25; a2 -= T121_2[2] * x26; a3 -= T121_2[3] * x27; a0 -= T121_3[0] * x28; a1 -= T121_3[1] * x29; a2 -= T121_3[2] * x30; a3 -= T121_3[3] * x31;
        asm volatile("" ::: "memory"); const float rr56 = X[56 * XS] * scp[56]; const f32x4 T124_0 = *(const LAS f32x4*)(LmV + 56 * LS + 0); const f32x4 T124_1 = *(const LAS f32x4*)(LmV + 56 * LS + 4); const f32x4 T124_2 = *(const LAS f32x4*)(LmV + 56 * LS + 8); const f32x4 T124_3 = *(const LAS f32x4*)(LmV + 56 * LS + 12);
         a0 -= T122_0[0] * x32; a1 -= T122_0[1] * x33; a2 -= T122_0[2] * x34; a3 -= T122_0[3] * x35; a0 -= T122_1[0] * x36; a1 -= T122_1[1] * x37; a2 -= T122_1[2] * x38; a3 -= T122_1[3] * x39; a0 -= T122_2[0] * x40; a1 -= T122_2[1] * x41; a2 -= T122_2[2] * x42; a3 -= T122_2[3] * x43; a0 -= T122_3[0] * x44; a1 -= T122_3[1] * x45; a2 -= T122_3[2] * x46; a3 -= T122_3[3] * x47;
        asm volatile("" ::: "memory"); const f32x4 T125_0 = *(const LAS f32x4*)(LmV + 56 * LS + 16); const f32x4 T125_1 = *(const LAS f32x4*)(LmV + 56 * LS + 20); const f32x4 T125_2 = *(const LAS f32x4*)(LmV + 56 * LS + 24); const f32x4 T125_3 = *(const LAS f32x4*)(LmV + 56 * LS + 28);
         a0 -= T123_0[0] * x48; a1 -= T123_0[1] * x49; a2 -= T123_0[2] * x50; a3 -= T123_0[3] * x51; a0 -= T123_1[0] * x52; a1 -= T123_1[1] * x53; a2 -= T123_1[2] * x54; const float x55 = (a0 + a1) + (a2 + a3);
        asm volatile("" ::: "memory"); const f32x4 T126_0 = *(const LAS f32x4*)(LmV + 56 * LS + 32); const f32x4 T126_1 = *(const LAS f32x4*)(LmV + 56 * LS + 36); const f32x4 T126_2 = *(const LAS f32x4*)(LmV + 56 * LS + 40); const f32x4 T126_3 = *(const LAS f32x4*)(LmV + 56 * LS + 44);
        a0 = rr56; a1 = 0.f; a2 = 0.f; a3 = 0.f; a0 -= T124_0[0] * x0; a1 -= T124_0[1] * x1; a2 -= T124_0[2] * x2; a3 -= T124_0[3] * x3; a0 -= T124_1[0] * x4; a1 -= T124_1[1] * x5; a2 -= T124_1[2] * x6; a3 -= T124_1[3] * x7; a0 -= T124_2[0] * x8; a1 -= T124_2[1] * x9; a2 -= T124_2[2] * x10; a3 -= T124_2[3] * x11; a0 -= T124_3[0] * x12; a1 -= T124_3[1] * x13; a2 -= T124_3[2] * x14; a3 -= T124_3[3] * x15;
        asm volatile("" ::: "memory"); const f32x4 T127_0 = *(const LAS f32x4*)(LmV + 56 * LS + 48); const f32x4 T127_1 = *(const LAS f32x4*)(LmV + 56 * LS + 52);
         a0 -= T125_0[0] * x16; a1 -= T125_0[1] * x17; a2 -= T125_0[2] * x18; a3 -= T125_0[3] * x19; a0 -= T125_1[0] * x20; a1 -= T125_1[1] * x21; a2 -= T125_1[2] * x22; a3 -= T125_1[3] * x23; a0 -= T125_2[0] * x24; a1 -= T125_2[1] * x25; a2 -= T125_2[2] * x26; a3 -= T125_2[3] * x27; a0 -= T125_3[0] * x28; a1 -= T125_3[1] * x29; a2 -= T125_3[2] * x30; a3 -= T125_3[3] * x31;
        asm volatile("" ::: "memory"); const float rr57 = X[57 * XS] * scp[57]; const f32x4 T128_0 = *(const LAS f32x4*)(LmV + 57 * LS + 0); const f32x4 T128_1 = *(const LAS f32x4*)(LmV + 57 * LS + 4); const f32x4 T128_2 = *(const LAS f32x4*)(LmV + 57 * LS + 8); const f32x4 T128_3 = *(const LAS f32x4*)(LmV + 57 * LS + 12);
         a0 -= T126_0[0] * x32; a1 -= T126_0[1] * x33; a2 -= T126_0[2] * x34; a3 -= T126_0[3] * x35; a0 -= T126_1[0] * x36; a1 -= T126_1[1] * x37; a2 -= T126_1[2] * x38; a3 -= T126_1[3] * x39; a0 -= T126_2[0] * x40; a1 -= T126_2[1] * x41; a2 -= T126_2[2] * x42; a3 -= T126_2[3] * x43; a0 -= T126_3[0] * x44; a1 -= T126_3[1] * x45; a2 -= T126_3[2] * x46; a3 -= T126_3[3] * x47;
        asm volatile("" ::: "memory"); const f32x4 T129_0 = *(const LAS f32x4*)(LmV + 57 * LS + 16); const f32x4 T129_1 = *(const LAS f32x4*)(LmV + 57 * LS + 20); const f32x4 T129_2 = *(const LAS f32x4*)(LmV + 57 * LS + 24); const f32x4 T129_3 = *(const LAS f32x4*)(LmV + 57 * LS + 28);
         a0 -= T127_0[0] * x48; a1 -= T127_0[1] * x49; a2 -= T127_0[2] * x50; a3 -= T127_0[3] * x51; a0 -= T127_1[0] * x52; a1 -= T127_1[1] * x53; a2 -= T127_1[2] * x54; a3 -= T127_1[3] * x55; const float x56 = (a0 + a1) + (a2 + a3);
        asm volatile("" ::: "memory"); const f32x4 T130_0 = *(const LAS f32x4*)(LmV + 57 * LS + 32); const f32x4 T130_1 = *(const LAS f32x4*)(LmV + 57 * LS + 36); const f32x4 T130_2 = *(const LAS f32x4*)(LmV + 57 * LS + 40); const f32x4 T130_3 = *(const LAS f32x4*)(LmV + 57 * LS + 44);
        a0 = rr57; a1 = 0.f; a2 = 0.f; a3 = 0.f; a0 -= T128_0[0] * x0; a1 -= T128_0[1] * x1; a2 -= T128_0[2] * x2; a3 -= T128_0[3] * x3; a0 -= T128_1[0] * x4; a1 -= T128_1[1] * x5; a2 -= T128_1[2] * x6; a3 -= T128_1[3] * x7; a0 -= T128_2[0] * x8; a1 -= T128_2[1] * x9; a2 -= T128_2[2] * x10; a3 -= T128_2[3] * x11; a0 -= T128_3[0] * x12; a1 -= T128_3[1] * x13; a2 -= T128_3[2] * x14; a3 -= T128_3[3] * x15;
        asm volatile("" ::: "memory"); const f32x4 T131_0 = *(const LAS f32x4*)(LmV + 57 * LS + 48); const f32x4 T131_1 = *(const LAS f32x4*)(LmV + 57 * LS + 52); const f32x4 T131_2 = *(const LAS f32x4*)(LmV + 57 * LS + 56);
         a0 -= T129_0[0] * x16; a1 -= T129_0[1] * x17; a2 -= T129_0[2] * x18; a3 -= T129_0[3] * x19; a0 -= T129_1[0] * x20; a1 -= T129_1[1] * x21; a2 -= T129_1[2] * x22; a3 -= T129_1[3] * x23; a0 -= T129_2[0] * x24; a1 -= T129_2[1] * x25; a2 -= T129_2[2] * x26; a3 -= T129_2[3] * x27; a0 -= T129_3[0] * x28; a1 -= T129_3[1] * x29; a2 -= T129_3[2] * x30; a3 -= T129_3[3] * x31;
        asm volatile("" ::: "memory"); const float rr58 = X[58 * XS] * scp[58]; const f32x4 T132_0 = *(const LAS f32x4*)(LmV + 58 * LS + 0); const f32x4 T132_1 = *(const LAS f32x4*)(LmV + 58 * LS + 4); const f32x4 T132_2 = *(const LAS f32x4*)(LmV + 58 * LS + 8); const f32x4 T132_3 = *(const LAS f32x4*)(LmV + 58 * LS + 12);
         a0 -= T130_0[0] * x32; a1 -= T130_0[1] * x33; a2 -= T130_0[2] * x34; a3 -= T130_0[3] * x35; a0 -= T130_1[0] * x36; a1 -= T130_1[1] * x37; a2 -= T130_1[2] * x38; a3 -= T130_1[3] * x39; a0 -= T130_2[0] * x40; a1 -= T130_2[1] * x41; a2 -= T130_2[2] * x42; a3 -= T130_2[3] * x43; a0 -= T130_3[0] * x44; a1 -= T130_3[1] * x45; a2 -= T130_3[2] * x46; a3 -= T130_3[3] * x47;
        asm volatile("" ::: "memory"); const f32x4 T133_0 = *(const LAS f32x4*)(LmV + 58 * LS + 16); const f32x4 T133_1 = *(const LAS f32x4*)(LmV + 58 * LS + 20); const f32x4 T133_2 = *(const LAS f32x4*)(LmV + 58 * LS + 24); const f32x4 T133_3 = *(const LAS f32x4*)(LmV + 58 * LS + 28);
         a0 -= T131_0[0] * x48; a1 -= T131_0[1] * x49; a2 -= T131_0[2] * x50; a3 -= T131_0[3] * x51; a0 -= T131_1[0] * x52; a1 -= T131_1[1] * x53; a2 -= T131_1[2] * x54; a3 -= T131_1[3] * x55; a0 -= T131_2[0] * x56; const float x57 = (a0 + a1) + (a2 + a3);
        asm volatile("" ::: "memory"); const f32x4 T134_0 = *(const LAS f32x4*)(LmV + 58 * LS + 32); const f32x4 T134_1 = *(const LAS f32x4*)(LmV + 58 * LS + 36); const f32x4 T134_2 = *(const LAS f32x4*)(LmV + 58 * LS + 40); const f32x4 T134_3 = *(const LAS f32x4*)(LmV + 58 * LS + 44);
        a0 = rr58; a1 = 0.f; a2 = 0.f; a3 = 0.f; a0 -= T132_0[0] * x0; a1 -= T132_0[1] * x1; a2 -= T132_0[2] * x2; a3 -= T132_0[3] * x3; a0 -= T132_1[0] * x4; a1 -= T132_1[1] * x5; a2 -= T132_1[2] * x6; a3 -= T132_1[3] * x7; a0 -= T132_2[0] * x8; a1 -= T132_2[1] * x9; a2 -= T132_2[2] * x10; a3 -= T132_2[3] * x11; a0 -= T132_3[0] * x12; a1 -= T132_3[1] * x13; a2 -= T132_3[2] * x14; a3 -= T132_3[3] * x15;
        asm volatile("" ::: "memory"); const f32x4 T135_0 = *(const LAS f32x4*)(LmV + 58 * LS + 48); const f32x4 T135_1 = *(const LAS f32x4*)(LmV + 58 * LS + 52); const f32x4 T135_2 = *(const LAS f32x4*)(LmV + 58 * LS + 56);
         a0 -= T133_0[0] * x16; a1 -= T133_0[1] * x17; a2 -= T133_0[2] * x18; a3 -= T133_0[3] * x19; a0 -= T133_1[0] * x20; a1 -= T133_1[1] * x21; a2 -= T133_1[2] * x22; a3 -= T133_1[3] * x23; a0 -= T133_2[0] * x24; a1 -= T133_2[1] * x25; a2 -= T133_2[2] * x26; a3 -= T133_2[3] * x27; a0 -= T133_3[0] * x28; a1 -= T133_3[1] * x29; a2 -= T133_3[2] * x30; a3 -= T133_3[3] * x31;
        asm volatile("" ::: "memory"); const float rr59 = X[59 * XS] * scp[59]; const f32x4 T136_0 = *(const LAS f32x4*)(LmV + 59 * LS + 0); const f32x4 T136_1 = *(const LAS f32x4*)(LmV + 59 * LS + 4); const f32x4 T136_2 = *(const LAS f32x4*)(LmV + 59 * LS + 8); const f32x4 T136_3 = *(const LAS f32x4*)(LmV + 59 * LS + 12);
         a0 -= T134_0[0] * x32; a1 -= T134_0[1] * x33; a2 -= T134_0[2] * x34; a3 -= T134_0[3] * x35; a0 -= T134_1[0] * x36; a1 -= T134_1[1] * x37; a2 -= T134_1[2] * x38; a3 -= T134_1[3] * x39; a0 -= T134_2[0] * x40; a1 -= T134_2[1] * x41; a2 -= T134_2[2] * x42; a3 -= T134_2[3] * x43; a0 -= T134_3[0] * x44; a1 -= T134_3[1] * x45; a2 -= T134_3[2] * x46; a3 -= T134_3[3] * x47;
        asm volatile("" ::: "memory"); const f32x4 T137_0 = *(const LAS f32x4*)(LmV + 59 * LS + 16); const f32x4 T137_1 = *(const LAS f32x4*)(LmV + 59 * LS + 20); const f32x4 T137_2 = *(const LAS f32x4*)(LmV + 59 * LS + 24); const f32x4 T137_3 = *(const LAS f32x4*)(LmV + 59 * LS + 28);
         a0 -= T135_0[0] * x48; a1 -= T135_0[1] * x49; a2 -= T135_0[2] * x50; a3 -= T135_0[3] * x51; a0 -= T135_1[0] * x52; a1 -= T135_1[1] * x53; a2 -= T135_1[2] * x54; a3 -= T135_1[3] * x55; a0 -= T135_2[0] * x56; a1 -= T135_2[1] * x57; const float x58 = (a0 + a1) + (a2 + a3);
        asm volatile("" ::: "memory"); const f32x4 T138_0 = *(const LAS f32x4*)(LmV + 59 * LS + 32); const f32x4 T138_1 = *(const LAS f32x4*)(LmV + 59 * LS + 36); const f32x4 T138_2 = *(const LAS f32x4*)(LmV + 59 * LS + 40); const f32x4 T138_3 = *(const LAS f32x4*)(LmV + 59 * LS + 44);
        a0 = rr59; a1 = 0.f; a2 = 0.f; a3 = 0.f; a0 -= T136_0[0] * x0; a1 -= T136_0[1] * x1; a2 -= T136_0[2] * x2; a3 -= T136_0[3] * x3; a0 -= T136_1[0] * x4; a1 -= T136_1[1] * x5; a2 -= T136_1[2] * x6; a3 -= T136_1[3] * x7; a0 -= T136_2[0] * x8; a1 -= T136_2[1] * x9; a2 -= T136_2[2] * x10; a3 -= T136_2[3] * x11; a0 -= T136_3[0] * x12; a1 -= T136_3[1] * x13; a2 -= T136_3[2] * x14; a3 -= T136_3[3] * x15;
        asm volatile("" ::: "memory"); const f32x4 T139_0 = *(const LAS f32x4*)(LmV + 59 * LS + 48); const f32x4 T139_1 = *(const LAS f32x4*)(LmV + 59 * LS + 52); const f32x4 T139_2 = *(const LAS f32x4*)(LmV + 59 * LS + 56);
         a0 -= T137_0[0] * x16; a1 -= T137_0[1] * x17; a2 -= T137_0[2] * x18; a3 -= T137_0[3] * x19; a0 -= T137_1[0] * x20; a1 -= T137_1[1] * x21; a2 -= T137_1[2] * x22; a3 -= T137_1[3] * x23; a0 -= T137_2[0] * x24; a1 -= T137_2[1] * x25; a2 -= T137_2[2] * x26; a3 -= T137_2[3] * x27; a0 -= T137_3[0] * x28; a1 -= T137_3[1] * x29; a2 -= T137_3[2] * x30; a3 -= T137_3[3] * x31;
        asm volatile("" ::: "memory"); const float rr60 = X[60 * XS] * scp[60]; const f32x4 T140_0 = *(const LAS f32x4*)(LmV + 60 * LS + 0); const f32x4 T140_1 = *(const LAS f32x4*)(LmV + 60 * LS + 4); const f32x4 T140_2 = *(const LAS f32x4*)(LmV + 60 * LS + 8); const f32x4 T140_3 = *(const LAS f32x4*)(LmV + 60 * LS + 12);
         a0 -= T138_0[0] * x32; a1 -= T138_0[1] * x33; a2 -= T138_0[2] * x34; a3 -= T138_0[3] * x35; a0 -= T138_1[0] * x36; a1 -= T138_1[1] * x37; a2 -= T138_1[2] * x38; a3 -= T138_1[3] * x39; a0 -= T138_2[0] * x40; a1 -= T138_2[1] * x41; a2 -= T138_2[2] * x42; a3 -= T138_2[3] * x43; a0 -= T138_3[0] * x44; a1 -= T138_3[1] * x45; a2 -= T138_3[2] * x46; a3 -= T138_3[3] * x47;
        asm volatile("" ::: "memory"); const f32x4 T141_0 = *(const LAS f32x4*)(LmV + 60 * LS + 16); const f32x4 T141_1 = *(const LAS f32x4*)(LmV + 60 * LS + 20); const f32x4 T141_2 = *(const LAS f32x4*)(LmV + 60 * LS + 24); const f32x4 T141_3 = *(const LAS f32x4*)(LmV + 60 * LS + 28);
         a0 -= T139_0[0] * x48; a1 -= T139_0[1] * x49; a2 -= T139_0[2] * x50; a3 -= T139_0[3] * x51; a0 -= T139_1[0] * x52; a1 -= T139_1[1] * x53; a2 -= T139_1[2] * x54; a3 -= T139_1[3] * x55; a0 -= T139_2[0] * x56; a1 -= T139_2[1] * x57; a2 -= T139_2[2] * x58; const float x59 = (a0 + a1) + (a2 + a3);
        asm volatile("" ::: "memory"); const f32x4 T142_0 = *(const LAS f32x4*)(LmV + 60 * LS + 32); const f32x4 T142_1 = *(const LAS f32x4*)(LmV + 60 * LS + 36); const f32x4 T142_2 = *(const LAS f32x4*)(LmV + 60 * LS + 40); const f32x4 T142_3 = *(const LAS f32x4*)(LmV + 60 * LS + 44);
        a0 = rr60; a1 = 0.f; a2 = 0.f; a3 = 0.f; a0 -= T140_0[0] * x0; a1 -= T140_0[1] * x1; a2 -= T140_0[2] * x2; a3 -= T140_0[3] * x3; a0 -= T140_1[0] * x4; a1 -= T140_1[1] * x5; a2 -= T140_1[2] * x6; a3 -= T140_1[3] * x7; a0 -= T140_2[0] * x8; a1 -= T140_2[1] * x9; a2 -= T140_2[2] * x10; a3 -= T140_2[3] * x11; a0 -= T140_3[0] * x12; a1 -= T140_3[1] * x13; a2 -= T140_3[2] * x14; a3 -= T140_3[3] * x15;
        asm volatile("" ::: "memory"); const f32x4 T143_0 = *(const LAS f32x4*)(LmV + 60 * LS + 48); const f32x4 T143_1 = *(const LAS f32x4*)(LmV + 60 * LS + 52); const f32x4 T143_2 = *(const LAS f32x4*)(LmV + 60 * LS + 56);
         a0 -= T141_0[0] * x16; a1 -= T141_0[1] * x17; a2 -= T141_0[2] * x18; a3 -= T141_0[3] * x19; a0 -= T141_1[0] * x20; a1 -= T141_1[1] * x21; a2 -= T141_1[2] * x22; a3 -= T141_1[3] * x23; a0 -= T141_2[0] * x24; a1 -= T141_2[1] * x25; a2 -= T141_2[2] * x26; a3 -= T141_2[3] * x27; a0 -= T141_3[0] * x28; a1 -= T141_3[1] * x29; a2 -= T141_3[2] * x30; a3 -= T141_3[3] * x31;
        asm volatile("" ::: "memory"); const float rr61 = X[61 * XS] * scp[61]; const f32x4 T144_0 = *(const LAS f32x4*)(LmV + 61 * LS + 0); const f32x4 T144_1 = *(const LAS f32x4*)(LmV + 61 * LS + 4); const f32x4 T144_2 = *(const LAS f32x4*)(LmV + 61 * LS + 8); const f32x4 T144_3 = *(const LAS f32x4*)(LmV + 61 * LS + 12);
         a0 -= T142_0[0] * x32; a1 -= T142_0[1] * x33; a2 -= T142_0[2] * x34; a3 -= T142_0[3] * x35; a0 -= T142_1[0] * x36; a1 -= T142_1[1] * x37; a2 -= T142_1[2] * x38; a3 -= T142_1[3] * x39; a0 -= T142_2[0] * x40; a1 -= T142_2[1] * x41; a2 -= T142_2[2] * x42; a3 -= T142_2[3] * x43; a0 -= T142_3[0] * x44; a1 -= T142_3[1] * x45; a2 -= T142_3[2] * x46; a3 -= T142_3[3] * x47;
        asm volatile("" ::: "memory"); const f32x4 T145_0 = *(const LAS f32x4*)(LmV + 61 * LS + 16); const f32x4 T145_1 = *(const LAS f32x4*)(LmV + 61 * LS + 20); const f32x4 T145_2 = *(const LAS f32x4*)(LmV + 61 * LS + 24); const f32x4 T145_3 = *(const LAS f32x4*)(LmV + 61 * LS + 28);
         a0 -= T143_0[0] * x48; a1 -= T143_0[1] * x49; a2 -= T143_0[2] * x50; a3 -= T143_0[3] * x51; a0 -= T143_1[0] * x52; a1 -= T143_1[1] * x53; a2 -= T143_1[2] * x54; a3 -= T143_1[3] * x55; a0 -= T143_2[0] * x56; a1 -= T143_2[1] * x57; a2 -= T143_2[2] * x58; a3 -= T143_2[3] * x59; const float x60 = (a0 + a1) + (a2 + a3);
        asm volatile("" ::: "memory"); const f32x4 T146_0 = *(const LAS f32x4*)(LmV + 61 * LS + 32); const f32x4 T146_1 = *(const LAS f32x4*)(LmV + 61 * LS + 36); const f32x4 T146_2 = *(const LAS f32x4*)(LmV + 61 * LS + 40); const f32x4 T146_3 = *(const LAS f32x4*)(LmV + 61 * LS + 44);
        a0 = rr61; a1 = 0.f; a2 = 0.f; a3 = 0.f; a0 -= T144_0[0] * x0; a1 -= T144_0[1] * x1; a2 -= T144_0[2] * x2; a3 -= T144_0[3] * x3; a0 -= T144_1[0] * x4; a1 -= T144_1[1] * x5; a2 -= T144_1[2] * x6; a3 -= T144_1[3] * x7; a0 -= T144_2[0] * x8; a1 -= T144_2[1] * x9; a2 -= T144_2[2] * x10; a3 -= T144_2[3] * x11; a0 -= T144_3[0] * x12; a1 -= T144_3[1] * x13; a2 -= T144_3[2] * x14; a3 -= T144_3[3] * x15;
        asm volatile("" ::: "memory"); const f32x4 T147_0 = *(const LAS f32x4*)(LmV + 61 * LS + 48); const f32x4 T147_1 = *(const LAS f32x4*)(LmV + 61 * LS + 52); const f32x4 T147_2 = *(const LAS f32x4*)(LmV + 61 * LS + 56); const f32x4 T147_3 = *(const LAS f32x4*)(LmV + 61 * LS + 60);
         a0 -= T145_0[0] * x16; a1 -= T145_0[1] * x17; a2 -= T145_0[2] * x18; a3 -= T145_0[3] * x19; a0 -= T145_1[0] * x20; a1 -= T145_1[1] * x21; a2 -= T145_1[2] * x22; a3 -= T145_1[3] * x23; a0 -= T145_2[0] * x24; a1 -= T145_2[1] * x25; a2 -= T145_2[2] * x26; a3 -= T145_2[3] * x27; a0 -= T145_3[0] * x28; a1 -= T145_3[1] * x29; a2 -= T145_3[2] * x30; a3 -= T145_3[3] * x31;
        asm volatile("" ::: "memory"); const float rr62 = X[62 * XS] * scp[62]; const f32x4 T148_0 = *(const LAS f32x4*)(LmV + 62 * LS + 0); const f32x4 T148_1 = *(const LAS f32x4*)(LmV + 62 * LS + 4); const f32x4 T148_2 = *(const LAS f32x4*)(LmV + 62 * LS + 8); const f32x4 T148_3 = *(const LAS f32x4*)(LmV + 62 * LS + 12);
         a0 -= T146_0[0] * x32; a1 -= T146_0[1] * x33; a2 -= T146_0[2] * x34; a3 -= T146_0[3] * x35; a0 -= T146_1[0] * x36; a1 -= T146_1[1] * x37; a2 -= T146_1[2] * x38; a3 -= T146_1[3] * x39; a0 -= T146_2[0] * x40; a1 -= T146_2[1] * x41; a2 -= T146_2[2] * x42; a3 -= T146_2[3] * x43; a0 -= T146_3[0] * x44; a1 -= T146_3[1] * x45; a2 -= T146_3[2] * x46; a3 -= T146_3[3] * x47;
        asm volatile("" ::: "memory"); const f32x4 T149_0 = *(const LAS f32x4*)(LmV + 62 * LS + 16); const f32x4 T149_1 = *(const LAS f32x4*)(LmV + 62 * LS + 20); const f32x4 T149_2 = *(const LAS f32x4*)(LmV + 62 * LS + 24); const f32x4 T149_3 = *(const LAS f32x4*)(LmV + 62 * LS + 28);
         a0 -= T147_0[0] * x48; a1 -= T147_0[1] * x49; a2 -= T147_0[2] * x50; a3 -= T147_0[3] * x51; a0 -= T147_1[0] * x52; a1 -= T147_1[1] * x53; a2 -= T147_1[2] * x54; a3 -= T147_1[3] * x55; a0 -= T147_2[0] * x56; a1 -= T147_2[1] * x57; a2 -= T147_2[2] * x58; a3 -= T147_2[3] * x59; a0 -= T147_3[0] * x60; const float x61 = (a0 + a1) + (a2 + a3);
        asm volatile("" ::: "memory"); const f32x4 T150_0 = *(const LAS f32x4*)(LmV + 62 * LS + 32); const f32x4 T150_1 = *(const LAS f32x4*)(LmV + 62 * LS + 36); const f32x4 T150_2 = *(const LAS f32x4*)(LmV + 62 * LS + 40); const f32x4 T150_3 = *(const LAS f32x4*)(LmV + 62 * LS + 44);
        a0 = rr62; a1 = 0.f; a2 = 0.f; a3 = 0.f; a0 -= T148_0[0] * x0; a1 -= T148_0[1] * x1; a2 -= T148_0[2] * x2; a3 -= T148_0[3] * x3; a0 -= T148_1[0] * x4; a1 -= T148_1[1] * x5; a2 -= T148_1[2] * x6; a3 -= T148_1[3] * x7; a0 -= T148_2[0] * x8; a1 -= T148_2[1] * x9; a2 -= T148_2[2] * x10; a3 -= T148_2[3] * x11; a0 -= T148_3[0] * x12; a1 -= T148_3[1] * x13; a2 -= T148_3[2] * x14; a3 -= T148_3[3] * x15;
        asm volatile("" ::: "memory"); const f32x4 T151_0 = *(const LAS f32x4*)(LmV + 62 * LS + 48); const f32x4 T151_1 = *(const LAS f32x4*)(LmV + 62 * LS + 52); const f32x4 T151_2 = *(const LAS f32x4*)(LmV + 62 * LS + 56); const f32x4 T151_3 = *(const LAS f32x4*)(LmV + 62 * LS + 60);
         a0 -= T149_0[0] * x16; a1 -= T149_0[1] * x17; a2 -= T149_0[2] * x18; a3 -= T149_0[3] * x19; a0 -= T149_1[0] * x20; a1 -= T149_1[1] * x21; a2 -= T149_1[2] * x22; a3 -= T149_1[3] * x23; a0 -= T149_2[0] * x24; a1 -= T149_2[1] * x25; a2 -= T149_2[2] * x26; a3 -= T149_2[3] * x27; a0 -= T149_3[0] * x28; a1 -= T149_3[1] * x29; a2 -= T149_3[2] * x30; a3 -= T149_3[3] * x31;
        asm volatile("" ::: "memory"); const float rr63 = X[63 * XS] * scp[63]; const f32x4 T152_0 = *(const LAS f32x4*)(LmV + 63 * LS + 0); const f32x4 T152_1 = *(const LAS f32x4*)(LmV + 63 * LS + 4); const f32x4 T152_2 = *(const LAS f32x4*)(LmV + 63 * LS + 8); const f32x4 T152_3 = *(const LAS f32x4*)(LmV + 63 * LS + 12);
         a0 -= T150_0[0] * x32; a1 -= T150_0[1] * x33; a2 -= T150_0[2] * x34; a3 -= T150_0[3] * x35; a0 -= T150_1[0] * x36; a1 -= T150_1[1] * x37; a2 -= T150_1[2] * x38; a3 -= T150_1[3] * x39; a0 -= T150_2[0] * x40; a1 -= T150_2[1] * x41; a2 -= T150_2[2] * x42; a3 -= T150_2[3] * x43; a0 -= T150_3[0] * x44; a1 -= T150_3[1] * x45; a2 -= T150_3[2] * x46; a3 -= T150_3[3] * x47;
        asm volatile("" ::: "memory"); const f32x4 T153_0 = *(const LAS f32x4*)(LmV + 63 * LS + 16); const f32x4 T153_1 = *(const LAS f32x4*)(LmV + 63 * LS + 20); const f32x4 T153_2 = *(const LAS f32x4*)(LmV + 63 * LS + 24); const f32x4 T153_3 = *(const LAS f32x4*)(LmV + 63 * LS + 28);
         a0 -= T151_0[0] * x48; a1 -= T151_0[1] * x49; a2 -= T151_0[2] * x50; a3 -= T151_0[3] * x51; a0 -= T151_1[0] * x52; a1 -= T151_1[1] * x53; a2 -= T151_1[2] * x54; a3 -= T151_1[3] * x55; a0 -= T151_2[0] * x56; a1 -= T151_2[1] * x57; a2 -= T151_2[2] * x58; a3 -= T151_2[3] * x59; a0 -= T151_3[0] * x60; a1 -= T151_3[1] * x61; const float x62 = (a0 + a1) + (a2 + a3);
        asm volatile("" ::: "memory"); const f32x4 T154_0 = *(const LAS f32x4*)(LmV + 63 * LS + 32); const f32x4 T154_1 = *(const LAS f32x4*)(LmV + 63 * LS + 36); const f32x4 T154_2 = *(const LAS f32x4*)(LmV + 63 * LS + 40); const f32x4 T154_3 = *(const LAS f32x4*)(LmV + 63 * LS + 44);
        a0 = rr63; a1 = 0.f; a2 = 0.f; a3 = 0.f; a0 -= T152_0[0] * x0; a1 -= T152_0[1] * x1; a2 -= T152_0[2] * x2; a3 -= T152_0[3] * x3; a0 -= T152_1[0] * x4; a1 -= T152_1[1] * x5; a2 -= T152_1[2] * x6; a3 -= T152_1[3] * x7; a0 -= T152_2[0] * x8; a1 -= T152_2[1] * x9; a2 -= T152_2[2] * x10; a3 -= T152_2[3] * x11; a0 -= T152_3[0] * x12; a1 -= T152_3[1] * x13; a2 -= T152_3[2] * x14; a3 -= T152_3[3] * x15;
        asm volatile("" ::: "memory"); const f32x4 T155_0 = *(const LAS f32x4*)(LmV + 63 * LS + 48); const f32x4 T155_1 = *(const LAS f32x4*)(LmV + 63 * LS + 52); const f32x4 T155_2 = *(const LAS f32x4*)(LmV + 63 * LS + 56); const f32x4 T155_3 = *(const LAS f32x4*)(LmV + 63 * LS + 60);
         a0 -= T153_0[0] * x16; a1 -= T153_0[1] * x17; a2 -= T153_0[2] * x18; a3 -= T153_0[3] * x19; a0 -= T153_1[0] * x20; a1 -= T153_1[1] * x21; a2 -= T153_1[2] * x22; a3 -= T153_1[3] * x23; a0 -= T153_2[0] * x24; a1 -= T153_2[1] * x25; a2 -= T153_2[2] * x26; a3 -= T153_2[3] * x27; a0 -= T153_3[0] * x28; a1 -= T153_3[1] * x29; a2 -= T153_3[2] * x30; a3 -= T153_3[3] * x31;
        asm volatile("" ::: "memory");
         a0 -= T154_0[0] * x32; a1 -= T154_0[1] * x33; a2 -= T154_0[2] * x34; a3 -= T154_0[3] * x35; a0 -= T154_1[0] * x36; a1 -= T154_1[1] * x37; a2 -= T154_1[2] * x38; a3 -= T154_1[3] * x39; a0 -= T154_2[0] * x40; a1 -= T154_2[1] * x41; a2 -= T154_2[2] * x42; a3 -= T154_2[3] * x43; a0 -= T154_3[0] * x44; a1 -= T154_3[1] * x45; a2 -= T154_3[2] * x46; a3 -= T154_3[3] * x47;
        asm volatile("" ::: "memory");
         a0 -= T155_0[0] * x48; a1 -= T155_0[1] * x49; a2 -= T155_0[2] * x50; a3 -= T155_0[3] * x51; a0 -= T155_1[0] * x52; a1 -= T155_1[1] * x53; a2 -= T155_1[2] * x54; a3 -= T155_1[3] * x55; a0 -= T155_2[0] * x56; a1 -= T155_2[1] * x57; a2 -= T155_2[2] * x58; a3 -= T155_2[3] * x59; a0 -= T155_3[0] * x60; a1 -= T155_3[1] * x61; a2 -= T155_3[2] * x62; const float x63 = (a0 + a1) + (a2 + a3);
        int c2 = tid; asm volatile("" : "+v"(c2));
        if (isv) {
            *(f32x4*)(UT + (size_t)c2 * 64 + 0) = (f32x4){x0, x1, x2, x3};
            *(f32x4*)(UT + (size_t)c2 * 64 + 4) = (f32x4){x4, x5, x6, x7};
            *(f32x4*)(UT + (size_t)c2 * 64 + 8) = (f32x4){x8, x9, x10, x11};
            *(f32x4*)(UT + (size_t)c2 * 64 + 12) = (f32x4){x12, x13, x14, x15};
            *(f32x4*)(UT + (size_t)c2 * 64 + 16) = (f32x4){x16, x17, x18, x19};
            *(f32x4*)(UT + (size_t)c2 * 64 + 20) = (f32x4){x20, x21, x22, x23};
            *(f32x4*)(UT + (size_t)c2 * 64 + 24) = (f32x4){x24, x25, x26, x27};
            *(f32x4*)(UT + (size_t)c2 * 64 + 28) = (f32x4){x28, x29, x30, x31};
            *(f32x4*)(UT + (size_t)c2 * 64 + 32) = (f32x4){x32, x33, x34, x35};
            *(f32x4*)(UT + (size_t)c2 * 64 + 36) = (f32x4){x36, x37, x38, x39};
            *(f32x4*)(UT + (size_t)c2 * 64 + 40) = (f32x4){x40, x41, x42, x43};
            *(f32x4*)(UT + (size_t)c2 * 64 + 44) = (f32x4){x44, x45, x46, x47};
            *(f32x4*)(UT + (size_t)c2 * 64 + 48) = (f32x4){x48, x49, x50, x51};
            *(f32x4*)(UT + (size_t)c2 * 64 + 52) = (f32x4){x52, x53, x54, x55};
            *(f32x4*)(UT + (size_t)c2 * 64 + 56) = (f32x4){x56, x57, x58, x59};
            *(f32x4*)(UT + (size_t)c2 * 64 + 60) = (f32x4){x60, x61, x62, x63};
        } else {
            WN[0 * 128 + (c2 - 128)] = (bf16)f2bf(-x0);
            WN[1 * 128 + (c2 - 128)] = (bf16)f2bf(-x1);
            WN[2 * 128 + (c2 - 128)] = (bf16)f2bf(-x2);
            WN[3 * 128 + (c2 - 128)] = (bf16)f2bf(-x3);
            WN[4 * 128 + (c2 - 128)] = (bf16)f2bf(-x4);
            WN[5 * 128 + (c2 - 128)] = (bf16)f2bf(-x5);
            WN[6 * 128 + (c2 - 128)] = (bf16)f2bf(-x6);
            WN[7 * 128 + (c2 - 128)] = (bf16)f2bf(-x7);
            WN[8 * 128 + (c2 - 128)] = (bf16)f2bf(-x8);
            WN[9 * 128 + (c2 - 128)] = (bf16)f2bf(-x9);
            WN[10 * 128 + (c2 - 128)] = (bf16)f2bf(-x10);
            WN[11 * 128 + (c2 - 128)] = (bf16)f2bf(-x11);
            WN[12 * 128 + (c2 - 128)] = (bf16)f2bf(-x12);
            WN[13 * 128 + (c2 - 128)] = (bf16)f2bf(-x13);
            WN[14 * 128 + (c2 - 128)] = (bf16)f2bf(-x14);
            WN[15 * 128 + (c2 - 128)] = (bf16)f2bf(-x15);
            WN[16 * 128 + (c2 - 128)] = (bf16)f2bf(-x16);
            WN[17 * 128 + (c2 - 128)] = (bf16)f2bf(-x17);
            WN[18 * 128 + (c2 - 128)] = (bf16)f2bf(-x18);
            WN[19 * 128 + (c2 - 128)] = (bf16)f2bf(-x19);
            WN[20 * 128 + (c2 - 128)] = (bf16)f2bf(-x20);
            WN[21 * 128 + (c2 - 128)] = (bf16)f2bf(-x21);
            WN[22 * 128 + (c2 - 128)] = (bf16)f2bf(-x22);
            WN[23 * 128 + (c2 - 128)] = (bf16)f2bf(-x23);
            WN[24 * 128 + (c2 - 128)] = (bf16)f2bf(-x24);
            WN[25 * 128 + (c2 - 128)] = (bf16)f2bf(-x25);
            WN[26 * 128 + (c2 - 128)] = (bf16)f2bf(-x26);
            WN[27 * 128 + (c2 - 128)] = (bf16)f2bf(-x27);
            WN[28 * 128 + (c2 - 128)] = (bf16)f2bf(-x28);
            WN[29 * 128 + (c2 - 128)] = (bf16)f2bf(-x29);
            WN[30 * 128 + (c2 - 128)] = (bf16)f2bf(-x30);
            WN[31 * 128 + (c2 - 128)] = (bf16)f2bf(-x31);
            WN[32 * 128 + (c2 - 128)] = (bf16)f2bf(-x32);
            WN[33 * 128 + (c2 - 128)] = (bf16)f2bf(-x33);
            WN[34 * 128 + (c2 - 128)] = (bf16)f2bf(-x34);
            WN[35 * 128 + (c2 - 128)] = (bf16)f2bf(-x35);
            WN[36 * 128 + (c2 - 128)] = (bf16)f2bf(-x36);
            WN[37 * 128 + (c2 - 128)] = (bf16)f2bf(-x37);
            WN[38 * 128 + (c2 - 128)] = (bf16)f2bf(-x38);
            WN[39 * 128 + (c2 - 128)] = (bf16)f2bf(-x39);
            WN[40 * 128 + (c2 - 128)] = (bf16)f2bf(-x40);
            WN[41 * 128 + (c2 - 128)] = (bf16)f2bf(-x41);
            WN[42 * 128 + (c2 - 128)] = (bf16)f2bf(-x42);
            WN[43 * 128 + (c2 - 128)] = (bf16)f2bf(-x43);
            WN[44 * 128 + (c2 - 128)] = (bf16)f2bf(-x44);
            WN[45 * 128 + (c2 - 128)] = (bf16)f2bf(-x45);
            WN[46 * 128 + (c2 - 128)] = (bf16)f2bf(-x46);
            WN[47 * 128 + (c2 - 128)] = (bf16)f2bf(-x47);
            WN[48 * 128 + (c2 - 128)] = (bf16)f2bf(-x48);
            WN[49 * 128 + (c2 - 128)] = (bf16)f2bf(-x49);
            WN[50 * 128 + (c2 - 128)] = (bf16)f2bf(-x50);
            WN[51 * 128 + (c2 - 128)] = (bf16)f2bf(-x51);
            WN[52 * 128 + (c2 - 128)] = (bf16)f2bf(-x52);
            WN[53 * 128 + (c2 - 128)] = (bf16)f2bf(-x53);
            WN[54 * 128 + (c2 - 128)] = (bf16)f2bf(-x54);
            WN[55 * 128 + (c2 - 128)] = (bf16)f2bf(-x55);
            WN[56 * 128 + (c2 - 128)] = (bf16)f2bf(-x56);
            WN[57 * 128 + (c2 - 128)] = (bf16)f2bf(-x57);
            WN[58 * 128 + (c2 - 128)] = (bf16)f2bf(-x58);
            WN[59 * 128 + (c2 - 128)] = (bf16)f2bf(-x59);
            WN[60 * 128 + (c2 - 128)] = (bf16)f2bf(-x60);
            WN[61 * 128 + (c2 - 128)] = (bf16)f2bf(-x61);
            WN[62 * 128 + (c2 - 128)] = (bf16)f2bf(-x62);
            WN[63 * 128 + (c2 - 128)] = (bf16)f2bf(-x63);
        }
    } else {
        const int t2 = tid - 256;
        { const int i = t2 >> 2, d0 = (t2 & 3) * 32; const float e = expf(gcs[i]);
#pragma unroll
          for (int q8 = 0; q8 < 4; ++q8) { const f32x4 a = *(const LAS f32x4*)(XQ + i * XS + d0 + 8 * q8), c = *(const LAS f32x4*)(XQ + i * XS + d0 + 8 * q8 + 4);
              v4u o; o.x = pk2(a[0] * e, a[1] * e); o.y = pk2(a[2] * e, a[3] * e); o.z = pk2(c[0] * e, c[1] * e); o.w = pk2(c[2] * e, c[3] * e);
              *(v4u*)(QG + (size_t)i * 128 + d0 + 8 * q8) = o; } }
        { const int d = t2 >> 1, i0 = (t2 & 1) * 32; const float gl = gcs[63];
#pragma unroll
          for (int q8 = 0; q8 < 4; ++q8) { float v[8];
#pragma unroll
              for (int e = 0; e < 8; ++e) { const int i = i0 + 8 * q8 + e; v[e] = XK[i * XS + d] * expf(gl - gcs[i]); }
              v4u o; o.x = pk2(v[0], v[1]); o.y = pk2(v[2], v[3]); o.z = pk2(v[4], v[5]); o.w = pk2(v[6], v[7]);
              *(v4u*)(KGT + (size_t)d * 64 + i0 + 8 * q8) = o; } }
        if (t2 == 0) GL[unit] = expf(gcs[63]);
    }
    __syncthreads();
}

__device__ __forceinline__ void gdnb_unit(const Params& P, LAS unsigned char* lds, int bh) {
    typedef float f32x4_ __attribute__((ext_vector_type(4)));
    const int tid = threadIdx.x, wid = __builtin_amdgcn_readfirstlane(tid >> 6), lane = tid & 63, fr = lane & 15, fq = lane >> 4;
    const int b = bh >> 2, h = bh & 3;
    const float* w_gnorm = P.in[14];
    const bf16* ZB = (const bf16*)(P.ws + WS_ZB); bf16* MIX = (bf16*)(P.ws + WS_MIX);
    LAS unsigned char* Wl = lds;
    LAS unsigned char* Ql = lds + 16384;
    LAS unsigned char* Kl = lds + 32768;
    LAS unsigned char* Ml = lds + 49152;
    LAS unsigned char* STl = lds + 57344;
    LAS unsigned char* VTl = lds + 90112;
    LAS float* OT = (LAS float*)(lds + 106496);
    f32x4_ S[8];
#pragma unroll
    for (int i = 0; i < 8; ++i) S[i] = (f32x4_){0.f, 0.f, 0.f, 0.f};
    const int e = 16 * wid + fr;
#pragma unroll
    for (int db = 0; db < 8; ++db) *(LAS v2u*)(STl + sw256(e, (16 * db + 4 * fq) >> 3) + ((4 * fq) & 7) * 2) = (v2u){0u, 0u};
    const int orow = tid >> 3, ocol = (tid & 7) * 16;
    LAS float* GNl = OT + 64 * XS;
    if (tid < 128) GNl[tid] = w_gnorm[tid];
    const size_t ubase = (size_t)bh * 32;
    v4u aW[2], aQ[2], aK[2], aM; f32x4_ utn[4]; float gln;
#define SCAN_LOAD(n_) do { const size_t un_ = ubase + (n_); \
        const v4u* WNp = (const v4u*)((const bf16*)(P.ws + WS_WN) + un_ * 8192); const v4u* QGp = (const v4u*)((const bf16*)(P.ws + WS_QG) + un_ * 8192); \
        const v4u* KGp = (const v4u*)((const bf16*)(P.ws + WS_KGT) + un_ * 8192); const v4u* QKp = (const v4u*)((const bf16*)(P.ws + WS_QKM) + un_ * 4096); \
        const float* UTp = (const float*)(P.ws + WS_UT) + un_ * 8192; gln = ((const float*)(P.ws + WS_GL))[un_]; \
        aW[0] = WNp[tid]; aW[1] = WNp[tid + 512]; aQ[0] = QGp[tid]; aQ[1] = QGp[tid + 512]; aK[0] = KGp[tid]; aK[1] = KGp[tid + 512]; aM = QKp[tid]; \
        _Pragma("unroll") for (int rb_ = 0; rb_ < 4; ++rb_) utn[rb_] = *(const f32x4_*)(UTp + (size_t)e * 64 + 16 * rb_ + 4 * fq); } while (0)
#define SCAN_STAGE() do { \
        _Pragma("unroll") for (int i_ = 0; i_ < 2; ++i_) { const int idx_ = tid + 512 * i_; \
            *(LAS v4u*)(Wl + sw256(idx_ >> 4, idx_ & 15)) = aW[i_]; *(LAS v4u*)(Ql + sw256(idx_ >> 4, idx_ & 15)) = aQ[i_]; *(LAS v4u*)(Kl + sw128(idx_ >> 3, idx_ & 7)) = aK[i_]; } \
        *(LAS v4u*)(Ml + sw128(tid >> 3, tid & 7)) = aM; } while (0)
    SCAN_LOAD(0);
    SCAN_STAGE();
    for (int n = 0; n < NCHUNK; ++n) {
        __syncthreads();
        f32x4_ vn[4];
#pragma unroll
        for (int rb = 0; rb < 4; ++rb) vn[rb] = utn[rb];
        const size_t mrow = (size_t)b * SEQ + n * GCH + orow;
        const v4u z0 = *(const v4u*)(ZB + mrow * 512 + h * 128 + ocol), z1 = *(const v4u*)(ZB + mrow * 512 + h * 128 + ocol + 8);
        const float gl = gln;
        if (n + 1 < NCHUNK) SCAN_LOAD(n + 1);
        __builtin_amdgcn_sched_barrier(0);
        bf16x8 sb[4];
#pragma unroll
        for (int ks = 0; ks < 4; ++ks) sb[ks] = *(const LAS bf16x8*)(STl + sw256(e, 4 * ks + fq));
#pragma unroll
        for (int rb = 0; rb < 4; ++rb) {
#pragma unroll
            for (int ks = 0; ks < 4; ++ks) { const bf16x8 a = *(const LAS bf16x8*)(Wl + sw256(16 * rb + fr, 4 * ks + fq)); vn[rb] = __builtin_amdgcn_mfma_f32_16x16x32_bf16(a, sb[ks], vn[rb], 0, 0, 0); }
            v2u o; o.x = pk2(vn[rb][0], vn[rb][1]); o.y = pk2(vn[rb][2], vn[rb][3]);
            *(LAS v2u*)(VTl + sw128(e, (16 * rb + 4 * fq) >> 3) + ((4 * fq) & 7) * 2) = o;
        }
        bf16x8 vb[2];
#pragma unroll
        for (int ks = 0; ks < 2; ++ks) vb[ks] = *(const LAS bf16x8*)(VTl + sw128(e, 4 * ks + fq));
#pragma unroll
        for (int rb = 0; rb < 4; ++rb) {
            f32x4_ oo = (f32x4_){0.f, 0.f, 0.f, 0.f};
#pragma unroll
            for (int ks = 0; ks < 4; ++ks) { const bf16x8 a = *(const LAS bf16x8*)(Ql + sw256(16 * rb + fr, 4 * ks + fq)); oo = __builtin_amdgcn_mfma_f32_16x16x32_bf16(a, sb[ks], oo, 0, 0, 0); }
#pragma unroll
            for (int ks = 0; ks < 2; ++ks) { const bf16x8 a = *(const LAS bf16x8*)(Ml + sw128(16 * rb + fr, 4 * ks + fq)); oo = __builtin_amdgcn_mfma_f32_16x16x32_bf16(a, vb[ks], oo, 0, 0, 0); }
#pragma unroll
            for (int j = 0; j < 4; ++j) OT[(16 * rb + 4 * fq + j) * XS + e] = oo[j];
        }
#pragma unroll
        for (int db = 0; db < 8; ++db) {
            S[db] = S[db] * gl;
#pragma unroll
            for (int ks = 0; ks < 2; ++ks) { const bf16x8 a = *(const LAS bf16x8*)(Kl + sw128(16 * db + fr, 4 * ks + fq)); S[db] = __builtin_amdgcn_mfma_f32_16x16x32_bf16(a, vb[ks], S[db], 0, 0, 0); }
            v2u o; o.x = pk2(S[db][0], S[db][1]); o.y = pk2(S[db][2], S[db][3]);
            *(LAS v2u*)(STl + sw256(e, (16 * db + 4 * fq) >> 3) + ((4 * fq) & 7) * 2) = o;
        }
        __syncthreads();
        if (n + 1 < NCHUNK) SCAN_STAGE();
        {
            f32x4_ ov[4]; float ss = 0.f;
#pragma unroll
            for (int i = 0; i < 4; ++i) { ov[i] = *(const LAS f32x4_*)(OT + orow * XS + ocol + 4 * i); ss += (ov[i][0] * ov[i][0] + ov[i][1] * ov[i][1]) + (ov[i][2] * ov[i][2] + ov[i][3] * ov[i][3]); }
            ss += __shfl_xor(ss, 1); ss += __shfl_xor(ss, 2); ss += __shfl_xor(ss, 4);
            const float rstd = 1.0f / sqrtf(ss * (1.0f / 128.0f) + RMS_EPS);
            f32x4_ gn4[4];
#pragma unroll
            for (int i = 0; i < 4; ++i) gn4[i] = *(const LAS f32x4_*)(GNl + ocol + 4 * i);
            const unsigned zw[8] = {z0.x, z0.y, z0.z, z0.w, z1.x, z1.y, z1.z, z1.w};
            unsigned ow[8];
#pragma unroll
            for (int i = 0; i < 8; ++i) { const float za = __builtin_bit_cast(float, zw[i] << 16), zb = __builtin_bit_cast(float, zw[i] & 0xffff0000u);
                const float va = ov[i >> 1][(2 * i) & 3] * rstd * gn4[i >> 1][(2 * i) & 3] * silu_f(za), vb_ = ov[i >> 1][(2 * i + 1) & 3] * rstd * gn4[i >> 1][(2 * i + 1) & 3] * silu_f(zb);
                ow[i] = pk2(va, vb_); }
            bf16* mp = MIX + mrow * DM + 512 + h * 128 + ocol;
            *(v4u*)mp = (v4u){ow[0], ow[1], ow[2], ow[3]}; *(v4u*)(mp + 8) = (v4u){ow[4], ow[5], ow[6], ow[7]};
        }
        asm volatile("" : "+v"(utn[0]), "+v"(utn[1]), "+v"(utn[2]), "+v"(utn[3]), "+v"(gln));
    }
#undef SCAN_LOAD
#undef SCAN_STAGE
    float* So = P.out + OSSM_P + (size_t)bh * 16384;
#pragma unroll
    for (int db = 0; db < 8; ++db)
#pragma unroll
        for (int j = 0; j < 4; ++j) So[(size_t)(16 * db + 4 * fq + j) * 128 + e] = S[db][j];
    __syncthreads();
}


__device__ __forceinline__ f32x4 sgemm_slice16(const bf16* A, int lda, const bf16* Bt, int ldb, int n0, int k0, int k1, int wid, int fr, int fq) {
    f32x4 acc = {0.f, 0.f, 0.f, 0.f};
    const bf16* ap = A + (size_t)(16 * wid + fr) * lda + 8 * fq;
    const bf16* bp = Bt + (size_t)(n0 + fr) * ldb + 8 * fq;
#pragma unroll 16
    for (int ks = k0; ks < k1; ks += 32) {
        const bf16x8 a = *(const bf16x8*)(ap + ks), b = *(const bf16x8*)(bp + ks);
        acc = __builtin_amdgcn_mfma_f32_16x16x32_bf16(b, a, acc, 0, 0, 0);
    }
    return acc;
}
__device__ __forceinline__ void sample_wo_slice(const Params& P, int slice) {
    const int tid = threadIdx.x, wid = __builtin_amdgcn_readfirstlane(tid >> 6), lane = tid & 63, fr = lane & 15, fq = lane >> 4;
    const bf16* MIX = (const bf16*)(P.ws + WS_MIX) + (size_t)MP * DM; const bf16* WOT = (const bf16*)(P.ws + WS_WOT);
    bf16* HB = (bf16*)(P.ws + WS_HB) + (size_t)MP * DM; float* SSQS = (float*)(P.ws + WS_SSQS);
    const f32x4 acc = sgemm_slice16(MIX, DM, WOT, DM, 16 * slice, 0, DM, wid, fr, fq);
    const int m = 16 * wid + fr, n = 16 * slice + 4 * fq;
    const f32x4 h = acc + *(const f32x4*)(P.in[1] + (size_t)m * DM + n);
    *(f32x4*)(P.out + OY_S + (size_t)m * DM + n) = h;
    v2u o; o.x = pk2(h[0], h[1]); o.y = pk2(h[2], h[3]); *(v2u*)(HB + (size_t)m * DM + n) = o;
    float s = (h[0] * h[0] + h[1] * h[1]) + (h[2] * h[2] + h[3] * h[3]);
    s += __shfl_xor(s, 16); s += __shfl_xor(s, 32);
    if (fq == 0) SSQS[m * 64 + slice] = s;
}
__device__ __forceinline__ void sample_up_slice(const Params& P, int slice) {
    const int tid = threadIdx.x, wid = __builtin_amdgcn_readfirstlane(tid >> 6), lane = tid & 63, fr = lane & 15, fq = lane >> 4;
    const bf16* HB = (const bf16*)(P.ws + WS_HB) + (size_t)MP * DM; const bf16* WUPT = (const bf16*)(P.ws + WS_WUPT);
    bf16* UB = (bf16*)(P.ws + WS_UB) + (size_t)MP * FF; const float* SSQS = (const float*)(P.ws + WS_SSQS);
    const int m = 16 * wid + fr, n = 16 * slice + 4 * fq;
    float ss = 0.f;
#pragma unroll
    for (int i = 0; i < 4; ++i) { const f32x4 t = *(const f32x4*)(SSQS + m * 64 + 16 * fq + 4 * i); ss += (t[0] + t[1]) + (t[2] + t[3]); }
    ss += __shfl_xor(ss, 16); ss += __shfl_xor(ss, 32);
    const float rstd = 1.0f / sqrtf(ss * (1.0f / DM) + RMS_EPS);
    const f32x4 acc = sgemm_slice16(HB, DM, WUPT, DM, 16 * slice, 0, DM, wid, fr, fq);
    float u[4];
#pragma unroll
    for (int j = 0; j < 4; ++j) { const float p = fmaxf(acc[j] * rstd, 0.f); u[j] = p * p; }
    v2u o; o.x = pk2(u[0], u[1]); o.y = pk2(u[2], u[3]); *(v2u*)(UB + (size_t)m * FF + n) = o;
}
__device__ __forceinline__ void sample_down_slice(const Params& P, int item) {
    const int tid = threadIdx.x, wid = __builtin_amdgcn_readfirstlane(tid >> 6), lane = tid & 63, fr = lane & 15, fq = lane >> 4;
    const bf16* UB = (const bf16*)(P.ws + WS_UB) + (size_t)MP * FF; const bf16* WDNT = (const bf16*)(P.ws + WS_WDNT);
    float* PART = (float*)(P.ws + WS_PART);
    const int slice = item & 63, q = item >> 6;
    const f32x4 acc = sgemm_slice16(UB, FF, WDNT, FF, 16 * slice, 1024 * q, 1024 * q + 1024, wid, fr, fq);
    const int m = 16 * wid + fr, n = 16 * slice + 4 * fq;
    *(f32x4*)(PART + ((size_t)q * DECB + m) * DM + n) = acc;
}

__device__ __forceinline__ void phase_final(const Params& P, const Ctx& C) {
    const float* ln_f = P.in[19]; const float* SSQ2 = (const float*)(P.ws + WS_SSQ2);
    const int gw = C.vcu * NWAVES + C.wave, NGW = C.G * NWAVES, lane = C.lane;
    f32x4 lw[4];
#pragma unroll
    for (int j = 0; j < 4; ++j) lw[j] = ((const f32x4*)ln_f)[lane + 64 * j];
    for (int m = gw; m < M_TOT; m += NGW) {
        if (m < MP) {
            const f32x4* sp = (const f32x4*)(SSQ2 + (size_t)m * 16);
            const f32x4 a = sp[0], b = sp[1], c = sp[2], d = sp[3];
            const float ss = ((a[0] + a[1]) + (a[2] + a[3])) + ((b[0] + b[1]) + (b[2] + b[3])) + ((c[0] + c[1]) + (c[2] + c[3])) + ((d[0] + d[1]) + (d[2] + d[3]));
            const float rstd = 1.0f / sqrtf(ss * (1.0f / DM) + RMS_EPS);
            float* yr = P.out + OY_P + (size_t)m * DM;
#pragma unroll
            for (int j = 0; j < 4; ++j) { f32x4 v = ((const f32x4*)yr)[lane + 64 * j]; v = v * rstd * lw[j]; ((f32x4*)yr)[lane + 64 * j] = v; }
        } else {
            const int r = m - MP; float* yr = P.out + OY_S + (size_t)r * DM; const float* PART = (const float*)(P.ws + WS_PART);
            f32x4 v[4]; float ss = 0.f;
#pragma unroll
            for (int j = 0; j < 4; ++j) { v[j] = ((const f32x4*)yr)[lane + 64 * j];
#pragma unroll
                for (int q = 0; q < 4; ++q) v[j] += ((const f32x4*)(PART + ((size_t)q * DECB + r) * DM))[lane + 64 * j];
                ss += (v[j][0] * v[j][0] + v[j][1] * v[j][1]) + (v[j][2] * v[j][2] + v[j][3] * v[j][3]); }
            ss = wave_sum(ss);
            const float rstd = 1.0f / sqrtf(ss * (1.0f / DM) + RMS_EPS);
#pragma unroll
            for (int j = 0; j < 4; ++j) ((f32x4*)yr)[lane + 64 * j] = v[j] * rstd * lw[j];
        }
    }
}

constexpr int NPHASES = 8;
__global__ void __launch_bounds__(NWAVES * 64, 2) fwd_kernel(Params P) {
    extern __shared__ __attribute__((aligned(16))) unsigned char shm[];
    LAS unsigned char* lds = (LAS unsigned char*)shm;
    Ctx C; C.tid = threadIdx.x; C.lane = C.tid & 63; C.wave = __builtin_amdgcn_readfirstlane(C.tid >> 6);
    C.G = gridDim.x; { const int bx = blockIdx.x; C.vcu = (C.G % 8 == 0) ? (bx % 8) * (C.G / 8) + bx / 8 : bx; }
    volatile LAS unsigned* MISC = (volatile LAS unsigned*)(lds + MISC_OFF);
    if (C.tid < 64) MISC[C.tid] = 0u;
    __syncthreads();
    unsigned* ctl = (unsigned*)(P.ws + WS_CTL);
    const int lo = P.ph_lo, hi = P.ph_hi;
    XcdBarrier bar; bar.bar = ctl + CW_BAR; bar.x = 0; bar.st = nullptr;
    if (hi - lo > 1) bar = xcd_barrier_post(ctl + CW_BAR, MISC + 8);
#ifndef REPEAT_MASK
#define REPEAT_MASK 0
#endif
#define NREP(k) (((REPEAT_MASK >> (k)) & 1) ? 2 : 1)
#ifndef SUBMASK
#define SUBMASK 15
#endif
#ifndef PHASE_MASK
#define PHASE_MASK 0xff
#endif
#define IN(k) (((PHASE_MASK >> (k)) & 1) && lo <= (k) && (k) < hi)
#define SEAM(k) do { if (IN(k) && IN((k) + 1)) xcd_barrier(bar); } while (0)
    unsigned char* ws = P.ws;

    if (IN(0)) { for (int rep = 0; rep < NREP(0); ++rep) phase_prep(P, C, lds); SEAM(0); }

    if (IN(1)) {
        if (C.wave == 0) for (int bh = C.vcu; bh < NB * NH; bh += C.G) kbias_seq(P, bh, C.lane);
        for (int rep = 0; rep < NREP(1); ++rep) {
        pg8::Gemm g{(const pg8::bf16_t*)(ws + WS_XN), (const pg8::bf16_t*)(ws + WS_W1T), M_PAD, N1, DM};
        pg8::StaticOrder S; S.init(M_PAD, N1, C.G, (int)blockIdx.x);
        pg8::EpiIn E{(pg8::bf16_t*)(ws + WS_QB), (float*)(ws + WS_QS), (pg8::bf16_t*)(ws + WS_CB), (pg8::bf16_t*)(ws + WS_ZB), P.out};
        pg8::gemm_phase<pg8::EpiIn, pg8::StaticOrder, true, true>(lds, g, S, E);
        }
        SEAM(1);
    }

    if (IN(2)) {
#if SUBMASK & 8
        for (int u = C.vcu; u < NREP(5) * NB * NH * NCHUNK; u += C.G) gdna_unit(P, lds, u & (NB * NH * NCHUNK - 1));
#endif
        SEAM(2);
    }

    if (IN(3)) {
        for (int it = C.vcu; it < 256; it += C.G) { const int xg = it >> 5, slot = it & 31; if (slot < 4) { for (int rep = 0; rep < NREP(6); ++rep) gdnb_unit(P, lds, xg * 4 + slot); } }
#if SUBMASK & 1
        for (int it = C.vcu; it < 256; it += C.G) {
            const int xg = it >> 5, slot = it & 31;
            if (slot < 4 || slot >= 16) continue;
            const int j = slot - 4, bh = xg * 4 + j / 3, g = j % 3, b = bh >> 2, h = bh & 3;
            const bf16* Qh = (const bf16*)(ws + WS_QB) + (size_t)bh * SEQ * HD; const bf16* Kh = (const bf16*)(ws + WS_KB) + (size_t)bh * SEQ * HD; const bf16* Vh = (const bf16*)(ws + WS_VB) + (size_t)bh * SEQ * HD;
            const float* kbias = (const float*)(ws + WS_KBIAS) + (size_t)bh * SEQ;
            bf16* Orow0 = (bf16*)(ws + WS_MIX) + (size_t)b * SEQ * DM + h * HD;
            const int nblk = (g == 2 ? 4 : 2) * NREP(2);
            for (int k2 = 0; k2 < nblk; ++k2) { const int k = k2 & 3; const int qb = g == 0 ? ((k & 1) == 0 ? 7 : 3) : (g == 1 ? ((k & 1) == 0 ? 6 : 4) : (k == 0 ? 5 : 3 - k)); fox::fox_block((char*)shm, Qh, Kh, Vh, kbias, Orow0, qb); }
        }
#endif
#if SUBMASK & 2
        for (int it = C.vcu; it < NREP(3) * 256; it += C.G) { const int xg = (it & 255) >> 5, slot = it & 31; if (slot >= 16) decode_unit(P, lds, xg * 16 + (slot - 16)); }
#endif
#if SUBMASK & 4
        for (int it = C.vcu; it < 256; it += C.G) { const int xg = it >> 5, slot = it & 31; if (slot >= 16) for (int h = 0; h < NH; ++h) sgdn_unit(P, lds, xg * 16 + (slot - 16), h); }
#endif
        SEAM(3);
    }

    if (IN(4)) {
        for (int rep = 0; rep < NREP(9); ++rep) for (int it = blockIdx.x; it < 64; it += C.G) sample_wo_slice(P, it);
        pg8::Gemm g{(const pg8::bf16_t*)(ws + WS_MIX), (const pg8::bf16_t*)(ws + WS_WOT), MP, DM, DM};
        pg8::StaticOrder S; S.init(MP, DM, C.G, (int)blockIdx.x);
        pg8::EpiRes E{P.in[0], (float*)(ws + WS_HF), (pg8::bf16_t*)(ws + WS_HB), (float*)(ws + WS_SSQ)};
        pg8::gemm_phase<pg8::EpiRes, pg8::StaticOrder, true, true>(lds, g, S, E);
#if (REPEAT_MASK >> 7) & 1
        pg8::gemm_phase<pg8::EpiRes, pg8::StaticOrder, true, true>(lds, g, S, E);
#endif
        SEAM(4);
    }

    if (IN(5)) {
        for (int rep = 0; rep < NREP(10); ++rep) for (int it = blockIdx.x; it < 256; it += C.G) sample_up_slice(P, it);
        pg8::Gemm g{(const pg8::bf16_t*)(ws + WS_HB), (const pg8::bf16_t*)(ws + WS_WUPT), MP, FF, DM};
        pg8::StaticOrder S; S.init(MP, FF, C.G, (int)blockIdx.x);
        pg8::EpiUp E{(pg8::bf16_t*)(ws + WS_UB), (const float*)(ws + WS_SSQ)};
        pg8::gemm_phase<pg8::EpiUp, pg8::StaticOrder, true, true>(lds, g, S, E);
#if (REPEAT_MASK >> 8) & 1
        pg8::gemm_phase<pg8::EpiUp, pg8::StaticOrder, true, true>(lds, g, S, E);
#endif
        SEAM(5);
    }

    if (IN(6)) {
        for (int rep = 0; rep < NREP(11); ++rep) for (int it = blockIdx.x; it < 256; it += C.G) sample_down_slice(P, it);
        pg8::Gemm g{(const pg8::bf16_t*)(ws + WS_UB), (const pg8::bf16_t*)(ws + WS_WDNT), MP, DM, FF};
        pg8::StaticOrder S; S.init(MP, DM, C.G, (int)blockIdx.x);
        pg8::EpiDown E{(const float*)(ws + WS_HF), P.out, (float*)(ws + WS_SSQ2)};
        pg8::gemm_phase<pg8::EpiDown, pg8::StaticOrder, true, true>(lds, g, S, E);
#if (REPEAT_MASK >> 12) & 1
        pg8::gemm_phase<pg8::EpiDown, pg8::StaticOrder, true, true>(lds, g, S, E);
#endif
        SEAM(6);
    }

    if (IN(7)) phase_final(P, C);
#undef IN
#undef SEAM
}

#ifndef N_LAUNCH_MODE
#define N_LAUNCH_MODE 1
#endif
extern "C" void kernel_launch(void* const* d_in, const int* in_sizes, int n_in, void* d_out, int out_size, void* d_ws, size_t ws_size, hipStream_t stream) {
    static int grid = 0;
    if (grid == 0) {
        if (n_in != 20 || out_size != (int)OUT_TOTAL || ws_size < WS_END) { fprintf(stderr, "kernel_launch: unexpected shapes (n_in %d, out %d, ws %zu); nothing launched\n", n_in, out_size, ws_size); grid = -1; return; }
        int dev = 0, cus = 0, per_cu = 0;
        if (hipGetDevice(&dev) != hipSuccess || hipDeviceGetAttribute(&cus, hipDeviceAttributeMultiprocessorCount, dev) != hipSuccess) { grid = -1; return; }
        if (hipFuncSetAttribute((const void*)fwd_kernel, hipFuncAttributeMaxDynamicSharedMemorySize, LDS_BYTES) != hipSuccess) { fprintf(stderr, "kernel_launch: hipFuncSetAttribute failed\n"); grid = -1; return; }
        if (hipOccupancyMaxActiveBlocksPerMultiprocessor(&per_cu, (const void*)fwd_kernel, NWAVES * 64, LDS_BYTES) != hipSuccess || per_cu < 1)
            fprintf(stderr, "kernel_launch: note: occupancy query reports %d workgroups per CU\n", per_cu);
        (void)hipGetLastError();
        grid = cus;
    }
    if (grid < 0) return;
    if (hipMemsetAsync((char*)d_ws + WS_CTL, 0, CTL_ZERO_BYTES, stream) != hipSuccess) return;
    Params p{};
    for (int i = 0; i < 20; ++i) p.in[i] = (const float*)d_in[i];
    p.out = (float*)d_out; p.ws = (unsigned char*)d_ws;
    if (N_LAUNCH_MODE == 1) {
        p.ph_lo = 0; p.ph_hi = NPHASES;
        hipLaunchKernelGGL(fwd_kernel, dim3(grid), dim3(NWAVES * 64), LDS_BYTES, stream, p);
    } else {
        for (int k = 0; k < NPHASES; ++k) { p.ph_lo = k; p.ph_hi = k + 1; hipLaunchKernelGGL(fwd_kernel, dim3(grid), dim3(NWAVES * 64), LDS_BYTES, stream, p); }
    }
}
```

```cpp
#include <hip/hip_runtime.h>
#include <hip/hip_bf16.h>
#include <cstdio>
#include <cstdint>

constexpr int DM = 1024, NB = 8, SEQ = 2048, DECB = 128, PAST = 2048, PAGE = 128, NPAGES = 16;
constexpr int NH = 4, HD = 128, CONVD = 1536, FF = 4096, INDIM = 3596, GCH = 64, NCHUNK = SEQ / GCH;
constexpr int MP = NB * SEQ;
constexpr int M_TOT = MP + DECB;
constexpr int M_PAD = 16640;
constexpr int N1 = 3584;
constexpr float RMS_EPS = 1e-6f, L2_EPS = 1e-6f;
constexpr float ATT_SCALE = 0.08838834764831845f;
constexpr size_t OY_P = 0, OY_S = 16777216, OK_P = 16908288, OV_P = 25296896, OLF_P = 33685504, OCONV_P = 33751040, OSSM_P = 33787904,
                 OK_S = 34312192, OV_S = 34377728, OLF_S = 34443264, OCONV_S = 34443776, OSSM_S = 35033600, OUT_TOTAL = 43422208;
constexpr size_t MiB = 1u << 20;
constexpr size_t WS_CTL = 0, CTL_ZERO_BYTES = 1 * MiB;
constexpr size_t WS_W1T = 2 * MiB, WS_WOT = 10 * MiB, WS_WUPT = 12 * MiB, WS_WDNT = 21 * MiB;
constexpr size_t WS_XN = 32 * MiB, WS_QB = 68 * MiB, WS_KB = 84 * MiB, WS_VB = 100 * MiB, WS_CB = 116 * MiB, WS_ZB = 166 * MiB;
constexpr size_t WS_MIX = 184 * MiB, WS_HB = 218 * MiB, WS_UB = 252 * MiB;
constexpr size_t WS_UT = 384 * MiB, WS_WN = 416 * MiB, WS_QG = 432 * MiB, WS_KGT = 448 * MiB, WS_QKM = 464 * MiB;
constexpr size_t WS_LF = 472 * MiB, WS_BETA = 473 * MiB, WS_G = 474 * MiB, WS_KBIAS = 475 * MiB, WS_QS = 476 * MiB, WS_SSQ = 477 * MiB, WS_SSQ2 = 479 * MiB, WS_GL = 481 * MiB, WS_SSQS = 482 * MiB, WS_PART = 483 * MiB;
constexpr size_t WS_HF = 32 * MiB;
static_assert(WS_HF + (size_t)MP * DM * 4 <= WS_CB, "h overlays dead buffers only");
constexpr size_t WS_END = 486 * MiB;
constexpr int CW_TMO = 0, CW_BAR = 4096;
constexpr size_t QKV_STRIDE = (WS_KB - WS_QB) / 2;
static_assert(WS_VB - WS_KB == WS_KB - WS_QB, "q/k/v copies equally spaced");

namespace pg8 {
#define PG8_LAS __attribute__((address_space(3)))
typedef unsigned short bf16_t;
typedef short bf16x8 __attribute__((ext_vector_type(8)));
typedef float f32x4 __attribute__((ext_vector_type(4)));
typedef unsigned u32x4 __attribute__((ext_vector_type(4)));
constexpr int BM = 256, BK = 64, HALF = 128, HTB = HALF * BK * 2  , STAGE_BYTES = 8 * HTB, NXCD = 8, WGM = 8;

__host__ __device__ __forceinline__ int lds_byte(int r, int c) { const int st = (r >> 4) * 2 + (c >> 5), rr = r & 15, cc = c & 31, ob = rr * 64 + cc * 2; return st * 1024 + (ob ^ (((ob >> 9) & 1) << 5)); }
__host__ __device__ __forceinline__ void stage_rc(int b, int& R, int& C) { const int st = b / 1024, sb = b % 1024, swz = sb ^ (((sb >> 9) & 1) << 5); R = (st >> 1) * 16 + swz / 64; C = (st & 1) * 32 + (swz % 64) / 2; }
__host__ __device__ __forceinline__ int perm32(int rho) { const int n = rho >> 4, i = rho & 15; return 8 * (i >> 2) + 4 * n + (i & 3); }

struct Unit { int pm, pn; };
struct Gemm { const bf16_t* A; const bf16_t* Bt; int M, N, K; };

struct StaticOrder {
    int nM, nN, nwg, G, c;
    __host__ __device__ void init(int M, int N, int G_, int c_) { nM = M / BM; nN = N / BM; nwg = nM * nN; G = G_; c = c_; }
    __host__ __device__ bool next(int i, Unit& u) const {
        const long L = (long)i * G + c; if (L >= nwg) return false;
        int wgid = (int)L; { const int q = nwg / NXCD, r = nwg % NXCD, xcd = wgid % NXCD, off = wgid / NXCD; wgid = (xcd < r ? xcd * (q + 1) : r * (q + 1) + (xcd - r) * q) + off; }
        const int nig = WGM * nN, gid = wgid / nig, fm = gid * WGM, gsz = (nM - fm) < WGM ? (nM - fm) : WGM;
        u.pm = fm + ((wgid % nig) % gsz); u.pn = (wgid % nig) / gsz; return true;
    }
    __device__ __forceinline__ void a_ready(const Unit&) const {}
    __device__ __forceinline__ void done(const Unit&) const {}
};
__device__ __forceinline__ unsigned cvt_pk_bf16(float lo, float hi) { unsigned r; asm volatile("v_cvt_pk_bf16_f32 %0, %1, %2" : "=v"(r) : "v"(lo), "v"(hi)); return r; }
typedef float f32x2 __attribute__((ext_vector_type(2)));
__device__ __forceinline__ u32x4 pack8_bf16(f32x4 v0, f32x4 v1) { u32x4 w; w.x = cvt_pk_bf16(v0[0], v0[1]); w.y = cvt_pk_bf16(v0[2], v0[3]); w.z = cvt_pk_bf16(v1[0], v1[1]); w.w = cvt_pk_bf16(v1[2], v1[3]); return w; }

struct EpiIn {
    static constexpr bool PERM = true, AFTER_DRAIN = false;
    bf16_t* QB;
    float* QS;
    bf16_t* CB;
    bf16_t* ZB;
    float* out;
    __device__ __forceinline__ void operator()(const f32x4 (&acc)[2][2][4][2], const Unit& u, int wr, int wc, int fr, int fq) const {
        const int pn = u.pn;
#pragma unroll
        for (int ai = 0; ai < 2; ++ai)
#pragma unroll
            for (int m = 0; m < 4; ++m) {
                const int row = u.pm * BM + ai * HALF + wr * 64 + m * 16 + fr;
                if (row >= M_TOT) continue;
#pragma unroll
                for (int bj = 0; bj < 2; ++bj) {
                    const int col = pn * BM + bj * HALF + wc * 32 + 8 * fq;
                    const f32x4 v0 = acc[ai][bj][m][0], v1 = acc[ai][bj][m][1];
                    if (pn < 6) {
                        const int seg = pn >> 1, c = col - seg * 512, h = c >> 7, d = c & 127;
                        if (row < MP) {
                            const int b = row >> 11, t = row & 2047;
                            const size_t idx = ((size_t)((b * NH + h) * SEQ + t)) * HD + d;
                            *(u32x4*)(QB + (size_t)seg * QKV_STRIDE + idx) = pack8_bf16(v0, v1);
                            if (seg != 0) { float* o = out + OK_P + (size_t)(seg - 1) * (OV_P - OK_P) + (size_t)row * 512 + c; *(f32x4*)o = v0; *(f32x4*)(o + 4) = v1; }
                        } else {
                            const int db = row - MP;
                            if (seg == 0) { float* o = QS + (size_t)db * 512 + c; *(f32x4*)o = v0; *(f32x4*)(o + 4) = v1; }
                            else { float* o = out + OK_S + (size_t)(seg - 1) * (OV_S - OK_S) + (size_t)db * 512 + c; *(f32x4*)o = v0; *(f32x4*)(o + 4) = v1; }
                        }
                    } else if (pn < 12) {
                        const int c = col - 1536;
                        *(u32x4*)(CB + (size_t)row * CONVD + c) = pack8_bf16(v0, v1);
                        if (row < MP) {
                            const int t = row & 2047;
                            if (t >= SEQ - 3) { float* o = out + OCONV_P + ((size_t)(row >> 11) * 3 + (t - (SEQ - 3))) * CONVD + c; *(f32x4*)o = v0; *(f32x4*)(o + 4) = v1; }
                        } else {
                            float* o = out + OCONV_S + ((size_t)(row - MP) * 3 + 2) * CONVD + c; *(f32x4*)o = v0; *(f32x4*)(o + 4) = v1;
                        }
                    } else {
                        const int c = col - 3072;
                        *(u32x4*)(ZB + (size_t)row * 512 + c) = pack8_bf16(v0, v1);
                    }
                }
            }
    }
};

struct EpiRes {
    static constexpr bool PERM = true, AFTER_DRAIN = false;
    const float* xp; float* HF; bf16_t* HB; float* SSQ;
    __device__ __forceinline__ void operator()(const f32x4 (&acc)[2][2][4][2], const Unit& u, int wr, int wc, int fr, int fq) const {
#pragma unroll
        for (int ai = 0; ai < 2; ++ai)
#pragma unroll
            for (int m = 0; m < 4; ++m) {
                const int row = u.pm * BM + ai * HALF + wr * 64 + m * 16 + fr;
                const bool ok = row < MP;
                const float* xr = xp + (size_t)(ok ? row : 0) * DM;
                float* hr = HF + (size_t)(ok ? row : 0) * DM;
                float s = 0.f;
#pragma unroll
                for (int bj = 0; bj < 2; ++bj) {
                    const int col = u.pn * BM + bj * HALF + wc * 32 + 8 * fq;
                    if (ok) {
                        const f32x4 v0 = acc[ai][bj][m][0] + *(const f32x4*)(xr + col), v1 = acc[ai][bj][m][1] + *(const f32x4*)(xr + col + 4);
                        *(f32x4*)(hr + col) = v0; *(f32x4*)(hr + col + 4) = v1;
                        *(u32x4*)(HB + (size_t)row * DM + col) = pack8_bf16(v0, v1);
                        s += (v0[0] * v0[0] + v0[1] * v0[1]) + (v0[2] * v0[2] + v0[3] * v0[3]) + (v1[0] * v1[0] + v1[1] * v1[1]) + (v1[2] * v1[2] + v1[3] * v1[3]);
                    }
                }
                s += __shfl_xor(s, 16); s += __shfl_xor(s, 32);
                if (ok && fq == 0) SSQ[(size_t)row * 16 + u.pn * 4 + wc] = s;
            }
    }
};

struct EpiUp {
    static constexpr bool PERM = true, AFTER_DRAIN = false;
    bf16_t* UB; const float* SSQ;
    __device__ __forceinline__ void operator()(const f32x4 (&acc)[2][2][4][2], const Unit& u, int wr, int wc, int fr, int fq) const {
#pragma unroll
        for (int ai = 0; ai < 2; ++ai)
#pragma unroll
            for (int m = 0; m < 4; ++m) {
                const int row = u.pm * BM + ai * HALF + wr * 64 + m * 16 + fr;
                if (row >= M_TOT) continue;
                const f32x4* sp = (const f32x4*)(SSQ + (size_t)row * 16);
                const f32x4 a = sp[0], b = sp[1], c = sp[2], d = sp[3];
                const float ss = ((a[0] + a[1]) + (a[2] + a[3])) + ((b[0] + b[1]) + (b[2] + b[3])) + ((c[0] + c[1]) + (c[2] + c[3])) + ((d[0] + d[1]) + (d[2] + d[3]));
                const float rstd = 1.0f / sqrtf(ss * (1.0f / DM) + RMS_EPS);
#pragma unroll
                for (int bj = 0; bj < 2; ++bj) {
                    const int col = u.pn * BM + bj * HALF + wc * 32 + 8 * fq;
                    f32x4 v0 = acc[ai][bj][m][0] * rstd, v1 = acc[ai][bj][m][1] * rstd;
#pragma unroll
                    for (int j = 0; j < 4; ++j) { const float p = fmaxf(v0[j], 0.f), q = fmaxf(v1[j], 0.f); v0[j] = p * p; v1[j] = q * q; }
                    *(u32x4*)(UB + (size_t)row * FF + col) = pack8_bf16(v0, v1);
                }
            }
    }
};

struct EpiDown {
    static constexpr bool PERM = true, AFTER_DRAIN = false;
    const float* HF; float* out; float* SSQ2;
    __device__ __forceinline__ void operator()(const f32x4 (&acc)[2][2][4][2], const Unit& u, int wr, int wc, int fr, int fq) const {
#pragma unroll
        for (int ai = 0; ai < 2; ++ai)
#pragma unroll
            for (int m = 0; m < 4; ++m) {
                const int row = u.pm * BM + ai * HALF + wr * 64 + m * 16 + fr;
                const bool ok = row < MP;
                const float* hr = HF + (size_t)(ok ? row : 0) * DM;
                float* yr = out + OY_P + (size_t)(ok ? row : 0) * DM;
                float s = 0.f;
#pragma unroll
                for (int bj = 0; bj < 2; ++bj) {
                    const int col = u.pn * BM + bj * HALF + wc * 32 + 8 * fq;
                    if (ok) {
                        const f32x4 v0 = acc[ai][bj][m][0] + *(const f32x4*)(hr + col), v1 = acc[ai][bj][m][1] + *(const f32x4*)(hr + col + 4);
                        *(f32x4*)(yr + col) = v0; *(f32x4*)(yr + col + 4) = v1;
                        s += (v0[0] * v0[0] + v0[1] * v0[1]) + (v0[2] * v0[2] + v0[3] * v0[3]) + (v1[0] * v1[0] + v1[1] * v1[1]) + (v1[2] * v1[2] + v1[3] * v1[3]);
                    }
                }
                s += __shfl_xor(s, 16); s += __shfl_xor(s, 32);
                if (ok && fq == 0) SSQ2[(size_t)row * 16 + u.pn * 4 + wc] = s;
            }
    }
};

template <class Epi, class Sched, bool ALIGN_EPI = false, bool SP2 = false>
__device__ __forceinline__ void gemm_phase(PG8_LAS unsigned char* lds, const Gemm g, const Sched& S, const Epi& E) {
    const int tid = threadIdx.x, wid = __builtin_amdgcn_readfirstlane(tid >> 6), lane = tid & 63, wr = wid >> 2, wc = wid & 3, fr = lane & 15, fq = lane >> 4;
    const int K = g.K, nt = K / BK;
    unsigned voffA[2], voffB[2];
#pragma unroll
    for (int i = 0; i < 2; ++i) { int R, C; stage_rc(tid * 16 + i * 8192, R, C); const int Rb = Epi::PERM ? ((R & ~31) + perm32(R & 31)) : R;
        voffA[i] = (unsigned)(R * K + C) * 2u; voffB[i] = (unsigned)(Rb * K + C) * 2u; }
    const size_t kstep = (size_t)(BK * 2);
    const size_t hstep = (size_t)HALF * K * 2;
    const size_t tstep = 2 * hstep;
    const unsigned ldsw = (unsigned)wid * 1024u;
    const int aoff = lds_byte(wr * 64 + fr, fq * 8), boff = lds_byte(wc * 32 + fr, fq * 8);
#define PG8_SA(b, h) (((b) * 2 + (h)) * HTB)
#define PG8_SB(b, h) ((4 + (b) * 2 + (h)) * HTB)
#define PG8_STAGE(bufoff, gbase, voff) do { _Pragma("unroll") for (int _i = 0; _i < 2; ++_i) \
        __builtin_amdgcn_global_load_lds((const unsigned*)((const char*)(gbase) + (voff)[_i]), (PG8_LAS unsigned*)(lds + (bufoff) + ldsw + _i * 8192), 16, 0, 0); } while (0)
#define PG8_LDA(dst, b, h) do { _Pragma("unroll") for (int m = 0; m < 4; ++m) _Pragma("unroll") for (int k = 0; k < 2; ++k) dst[m][k] = *(const PG8_LAS bf16x8*)(lds + PG8_SA(b, h) + aoff + m * 2048 + k * 1024); } while (0)
#define PG8_LDB(dst, b, h) do { _Pragma("unroll") for (int n = 0; n < 2; ++n) _Pragma("unroll") for (int k = 0; k < 2; ++k) dst[n][k] = *(const PG8_LAS bf16x8*)(lds + PG8_SB(b, h) + boff + n * 2048 + k * 1024); } while (0)
#define PG8_MMA(ai, bj, At, Bt) do { __builtin_amdgcn_s_setprio(1); _Pragma("unroll") for (int m = 0; m < 4; ++m) _Pragma("unroll") for (int n = 0; n < 2; ++n) _Pragma("unroll") for (int k = 0; k < 2; ++k) \
        acc[ai][bj][m][n] = __builtin_amdgcn_mfma_f32_16x16x32_bf16(Bt[n][k], At[m][k], acc[ai][bj][m][n], 0, 0, 0); __builtin_amdgcn_s_setprio(0); } while (0)
#define PG8_WAIT_V(n) asm volatile("s_waitcnt vmcnt(" #n ")" ::: "memory")
#define PG8_WAIT_L(n) asm volatile("s_waitcnt lgkmcnt(" #n ")" ::: "memory")
#define PG8_BAR __builtin_amdgcn_s_barrier()
#define PG8_SCHED __builtin_amdgcn_sched_barrier(0)
    Unit cur, nxt; int ui = 0;
    if (!S.next(0, cur)) return;
    f32x4 acc[2][2][4][2];
#pragma unroll
    for (int a = 0; a < 2; ++a)
#pragma unroll
        for (int b = 0; b < 2; ++b)
#pragma unroll
            for (int m = 0; m < 4; ++m)
#pragma unroll
                for (int n = 0; n < 2; ++n) acc[a][b][m][n] = (f32x4){0.f, 0.f, 0.f, 0.f};
    bf16x8 At[4][2], B0[2][2], B1[2][2];
    const char* cA = (const char*)g.A + (size_t)cur.pm * tstep; const char* cB = (const char*)g.Bt + (size_t)cur.pn * tstep;
    S.a_ready(cur);
    if constexpr (SP2) {
        PG8_STAGE(PG8_SB(0, 0), cB, voffB); PG8_STAGE(PG8_SB(0, 1), cB + hstep, voffB); PG8_STAGE(PG8_SA(0, 0), cA, voffA); PG8_STAGE(PG8_SA(0, 1), cA + hstep, voffA);
        if (wr == 1) PG8_BAR;
        PG8_WAIT_V(2); PG8_BAR;
        PG8_STAGE(PG8_SB(1, 0), cB + kstep, voffB); PG8_STAGE(PG8_SA(1, 0), cA + kstep, voffA); PG8_STAGE(PG8_SB(1, 1), cB + hstep + kstep, voffB);
        PG8_WAIT_V(6); PG8_BAR;
    } else {
        PG8_STAGE(PG8_SB(0, 0), cB, voffB); PG8_STAGE(PG8_SA(0, 0), cA, voffA); PG8_STAGE(PG8_SB(0, 1), cB + hstep, voffB); PG8_STAGE(PG8_SA(0, 1), cA + hstep, voffA);
        if (wr == 1) PG8_BAR;
        PG8_WAIT_V(4); PG8_BAR;
        PG8_STAGE(PG8_SB(1, 0), cB + kstep, voffB); PG8_STAGE(PG8_SA(1, 0), cA + kstep, voffA); PG8_STAGE(PG8_SB(1, 1), cB + hstep + kstep, voffB);
        PG8_WAIT_V(6); PG8_BAR;
    }
    for (;;) {
        const bool has_next = S.next(ui + 1, nxt);
        const char* nA = has_next ? (const char*)g.A + (size_t)nxt.pm * tstep : cA; const char* nB = has_next ? (const char*)g.Bt + (size_t)nxt.pn * tstep : cB;
        for (int t = 0; t < nt; t += 2) {
            const bool last = (t == nt - 2);
            const char* a1 = cA + (size_t)(t + 1) * kstep;
            const char* a2 = last ? nA : cA + (size_t)(t + 2) * kstep; const char* b2 = last ? nB : cB + (size_t)(t + 2) * kstep;
            const char* a3 = a2 + kstep; const char* b3 = b2 + kstep;
            if (last && has_next) S.a_ready(nxt);
            if constexpr (SP2) {
            PG8_LDB(B0, 0, 0); PG8_LDB(B1, 0, 1); PG8_SCHED; PG8_LDA(At, 0, 0); PG8_STAGE(PG8_SA(1, 1), a1 + hstep, voffA);
            PG8_WAIT_V(8); PG8_WAIT_L(0); PG8_BAR; PG8_MMA(0, 0, At, B0); PG8_MMA(0, 1, At, B1); PG8_BAR; PG8_SCHED;
            PG8_LDA(At, 0, 1); PG8_STAGE(PG8_SB(0, 0), b2, voffB); PG8_STAGE(PG8_SB(0, 1), b2 + hstep, voffB); PG8_STAGE(PG8_SA(0, 0), a2, voffA);
            PG8_WAIT_V(8); PG8_WAIT_L(0); PG8_BAR; PG8_MMA(1, 0, At, B0); PG8_MMA(1, 1, At, B1); PG8_BAR; PG8_SCHED;
            PG8_LDB(B0, 1, 0); PG8_LDB(B1, 1, 1); PG8_SCHED; PG8_LDA(At, 1, 0); PG8_STAGE(PG8_SA(0, 1), a2 + hstep, voffA);
            PG8_WAIT_V(8); PG8_WAIT_L(0); PG8_BAR; PG8_MMA(0, 0, At, B0); PG8_MMA(0, 1, At, B1); PG8_BAR; PG8_SCHED;
            PG8_LDA(At, 1, 1); PG8_STAGE(PG8_SB(1, 0), b3, voffB); PG8_STAGE(PG8_SB(1, 1), b3 + hstep, voffB); PG8_STAGE(PG8_SA(1, 0), a3, voffA);
            PG8_WAIT_V(8); PG8_WAIT_L(0); PG8_BAR; PG8_MMA(1, 0, At, B0); PG8_MMA(1, 1, At, B1); PG8_BAR; PG8_SCHED;
            } else {
            PG8_LDB(B0, 0, 0); PG8_SCHED; PG8_LDA(At, 0, 0); PG8_STAGE(PG8_SA(1, 1), a1 + hstep, voffA);
            PG8_WAIT_L(8); PG8_BAR; PG8_WAIT_L(0); PG8_MMA(0, 0, At, B0); PG8_BAR; PG8_SCHED;
            PG8_LDB(B1, 0, 1); PG8_STAGE(PG8_SB(0, 0), b2, voffB);
            PG8_BAR; PG8_WAIT_L(0); PG8_MMA(0, 1, At, B1); PG8_BAR;
            PG8_LDA(At, 0, 1); PG8_STAGE(PG8_SA(0, 0), a2, voffA);
            PG8_BAR; PG8_WAIT_L(0); PG8_MMA(1, 0, At, B0); PG8_BAR; PG8_SCHED;
            PG8_STAGE(PG8_SB(0, 1), b2 + hstep, voffB);
            PG8_WAIT_V(6); PG8_BAR; PG8_MMA(1, 1, At, B1); PG8_BAR;
            PG8_LDB(B0, 1, 0); PG8_SCHED; PG8_LDA(At, 1, 0); PG8_STAGE(PG8_SA(0, 1), a2 + hstep, voffA);
            PG8_WAIT_L(8); PG8_BAR; PG8_WAIT_L(0); PG8_MMA(0, 0, At, B0); PG8_BAR; PG8_SCHED;
            PG8_LDB(B1, 1, 1); PG8_STAGE(PG8_SB(1, 0), b3, voffB);
            PG8_BAR; PG8_WAIT_L(0); PG8_MMA(0, 1, At, B1); PG8_BAR;
            PG8_LDA(At, 1, 1); PG8_STAGE(PG8_SA(1, 0), a3, voffA);
            PG8_BAR; PG8_WAIT_L(0); PG8_MMA(1, 0, At, B0); PG8_BAR; PG8_SCHED;
            PG8_STAGE(PG8_SB(1, 1), b3 + hstep, voffB);
            PG8_WAIT_V(6); PG8_BAR; PG8_MMA(1, 1, At, B1); PG8_BAR;
            }
        }
        if constexpr (ALIGN_EPI) { if (wr == 0) PG8_BAR; }
        if constexpr (!Epi::AFTER_DRAIN) { E(acc, cur, wr, wc, fr, fq); S.done(cur); }
        if (!has_next) break;
#pragma unroll
        for (int a = 0; a < 2; ++a)
#pragma unroll
            for (int b = 0; b < 2; ++b)
#pragma unroll
                for (int m = 0; m < 4; ++m)
#pragma unroll
                    for (int n = 0; n < 2; ++n) acc[a][b][m][n] = (f32x4){0.f, 0.f, 0.f, 0.f};
        cur = nxt; cA = nA; cB = nB; ++ui;
        if constexpr (ALIGN_EPI) { if (wr == 1) PG8_BAR; }
    }
    PG8_WAIT_V(0);
    if constexpr (!ALIGN_EPI) { if (wr == 0) PG8_BAR; }
    PG8_BAR;
    if constexpr (Epi::AFTER_DRAIN) { E.fused(acc, cur, wr, wc, fr, fq, lds, wid, lane); S.done(cur); }
#undef PG8_SA
#undef PG8_SB
#undef PG8_STAGE
#undef PG8_LDA
#undef PG8_LDB
#undef PG8_MMA
#undef PG8_WAIT_V
#undef PG8_WAIT_L
#undef PG8_BAR
#undef PG8_SCHED
}
}

#define GAS __attribute__((address_space(1)))
#define LAS __attribute__((address_space(3)))
typedef unsigned short bf16;
typedef unsigned v4u __attribute__((ext_vector_type(4)));
typedef unsigned v2u __attribute__((ext_vector_type(2)));
typedef float f32x4 __attribute__((ext_vector_type(4)));
typedef float f32x2 __attribute__((ext_vector_type(2)));
typedef float f32x16 __attribute__((ext_vector_type(16)));
typedef short bf16x8 __attribute__((ext_vector_type(8)));
typedef short s16x4 __attribute__((ext_vector_type(4)));
#define LDS_WAIT() asm volatile("s_waitcnt lgkmcnt(0)" ::: "memory")
#define VM_WAIT() asm volatile("s_waitcnt vmcnt(0)" ::: "memory")
constexpr int NWAVES = 8;
constexpr int LDS_BYTES = 163840;
constexpr int MISC_OFF = 163840 - 256;

__device__ __forceinline__ unsigned f2bf(float f) { unsigned u = __builtin_bit_cast(unsigned, f); return (u + 0x7fffu + ((u >> 16) & 1u)) >> 16; }
__device__ __forceinline__ unsigned pk2(float lo, float hi) { return f2bf(lo) | (f2bf(hi) << 16); }
__device__ __forceinline__ float bf2f(unsigned short b) { return __builtin_bit_cast(float, ((unsigned)b) << 16); }
__device__ __forceinline__ float wave_sum(float v) {
#pragma unroll
    for (int o = 1; o < 64; o <<= 1) v += __shfl_xor(v, o);
    return v;
}
__device__ __forceinline__ float softplus_f(float x) { return fmaxf(x, 0.f) + log1pf(expf(-fabsf(x))); }
__device__ __forceinline__ float sigmoid_f(float x) { return 1.0f / (1.0f + expf(-x)); }
__device__ __forceinline__ float silu_f(float x) { return x * __builtin_amdgcn_rcpf(1.0f + __expf(-x)); }

struct Params {
    const float* in[20];
    float* out; unsigned char* ws;
    int ph_lo, ph_hi;
};
struct Ctx { int tid, lane, wave, vcu, G; };
#ifndef PROBE_K
#define PROBE_K -1
#endif
#define GSTAMP(id) do { if (PROBE_K >= 10 && unit == 0 && threadIdx.x == 0) { const unsigned long long t_ = __builtin_amdgcn_s_memrealtime(); unsigned* c_ = (unsigned*)(P.ws + WS_CTL); __hip_atomic_store(c_ + 512 + 2 * (id), (unsigned)t_, __ATOMIC_RELAXED, __HIP_MEMORY_SCOPE_AGENT); __hip_atomic_store(c_ + 513 + 2 * (id), (unsigned)(t_ >> 32), __ATOMIC_RELAXED, __HIP_MEMORY_SCOPE_AGENT); } } while (0)

#define XB_TMO      128
#define XB_XCNT(j)  (256  + 64 * (j))
#define XB_XSUB(j)  (1280 + 64 * (j))
#define XB_XGEN(j)  (2304 + 64 * (j))
#define XB_TOP      3328
#define XB_TOPGEN   3392
#define XCD_BAR_WORDS 3456
#define XB_SPIN_CAP (1u << 18)

__device__ __forceinline__ unsigned xb_ld(unsigned* p)              { return __hip_atomic_load(p, __ATOMIC_RELAXED, __HIP_MEMORY_SCOPE_AGENT); }
__device__ __forceinline__ unsigned xb_add(unsigned* p, unsigned v) { return __hip_atomic_fetch_add(p, v, __ATOMIC_RELAXED, __HIP_MEMORY_SCOPE_AGENT); }
__device__ __forceinline__ unsigned xb_xcc_id() { return (unsigned)__builtin_amdgcn_s_getreg((3 << 11) | 20) & 0xFu; }
#define XB_SPIN(cond, bar) do { unsigned _sp = 0; while (cond) { __builtin_amdgcn_s_sleep(1); \
    if ((++_sp & 255u) == 0u) { if (xb_ld(&(bar)[XB_TMO])) break; if (_sp > XB_SPIN_CAP) { atomicAdd(&(bar)[XB_TMO], 1u); break; } } } } while (0)

struct XcdBarrier {
    unsigned* bar; unsigned x;
    volatile LAS unsigned* st;
};

__device__ __forceinline__ XcdBarrier xcd_barrier_post(unsigned* bar, volatile LAS unsigned* st) {
    XcdBarrier b; b.bar = bar; b.x = xb_xcc_id(); b.st = st;
    if (threadIdx.x == 0) (void)xb_add(&bar[XB_XCNT(b.x)], 1u);
    return b;
}
__device__ __forceinline__ void xcd_barrier_complete(unsigned* bar, unsigned x, unsigned& nloc, unsigned& nx) {
    const unsigned G = gridDim.x * gridDim.y * gridDim.z;
    unsigned sum, cnt, mine, sp = 0u;
    for (;;) {
        sum = 0u; cnt = 0u; mine = 0u;
#pragma unroll
        for (unsigned j = 0; j < 16; ++j) { const unsigned c = xb_ld(&bar[XB_XCNT(j)]); sum += c; cnt += (c > 0u) ? 1u : 0u; mine = (j == x) ? c : mine; }
        if (sum == G) break;
        __builtin_amdgcn_s_sleep(1);
        if ((++sp & 255u) == 0u) { if (xb_ld(&bar[XB_TMO])) break; if (sp > XB_SPIN_CAP) { atomicAdd(&bar[XB_TMO], 1u); break; } }
    }
    nloc = mine > 0u ? mine : 1u; nx = cnt > 0u ? cnt : 1u;
}

__device__ __forceinline__ void xcd_barrier(const XcdBarrier& b) {
    asm volatile("s_waitcnt vmcnt(0)" ::: "memory");
    __syncthreads();
    if (threadIdx.x == 0) {
        unsigned* bar = b.bar;
        __builtin_amdgcn_s_waitcnt(0);
        unsigned nloc = b.st[0], nx = b.st[1];
        if (nloc == 0u) { xcd_barrier_complete(bar, b.x, nloc, nx); b.st[0] = nloc; b.st[1] = nx; }
        const unsigned old = xb_add(&bar[XB_XSUB(b.x)], 1u);
        const unsigned gen = old / nloc;
        if (old + 1u == (gen + 1u) * nloc) {
            __builtin_amdgcn_fence(__ATOMIC_RELEASE, "agent");
            asm volatile("s_waitcnt vmcnt(0)" ::: "memory");
            const unsigned og = xb_add(&bar[XB_TOP], 1u);
            const unsigned tg = og / nx;
            if (og + 1u == (tg + 1u) * nx) xb_add(&bar[XB_TOPGEN], 1u);
            else XB_SPIN(xb_ld(&bar[XB_TOPGEN]) == tg, bar);
            __builtin_amdgcn_fence(__ATOMIC_ACQUIRE, "agent");
            xb_add(&bar[XB_XGEN(b.x)], 1u);
            asm volatile("s_waitcnt vmcnt(0)" ::: "memory");
        } else {
            XB_SPIN(xb_ld(&bar[XB_XGEN(b.x)]) == gen, bar);
            __builtin_amdgcn_fence(__ATOMIC_ACQUIRE, "agent");
            asm volatile("s_waitcnt vmcnt(0)" ::: "memory");
        }
    }
    __syncthreads();
}

__device__ __forceinline__ void transpose_item(const float* W, int ldw, int c0, int K, int ncols, const float* scale, bf16* WT, int row_off, LAS float* scr, int item, int lane) {
    const int nblk = ncols / 32, kb = item / nblk, nb = item % nblk, k0 = 64 * kb, n0 = 32 * nb;
    float wv[32];
#pragma unroll
    for (int i = 0; i < 32; ++i) { const int kk = 2 * i + (lane >> 5); wv[i] = W[(size_t)(k0 + kk) * ldw + c0 + n0 + (lane & 31)]; }
#pragma unroll
    for (int i = 0; i < 32; ++i) { const int kk = 2 * i + (lane >> 5); float w = wv[i]; if (scale) w *= scale[k0 + kk]; scr[kk * 33 + (lane & 31)] = w; }
    LDS_WAIT(); asm volatile("" ::: "memory");
    const int c = lane & 7;
#pragma unroll
    for (int j = 0; j < 4; ++j) { const int n = (lane >> 3) + 8 * j; const LAS float* s = scr + (8 * c) * 33 + n;
        v4u o; o.x = pk2(s[0 * 33], s[1 * 33]); o.y = pk2(s[2 * 33], s[3 * 33]); o.z = pk2(s[4 * 33], s[5 * 33]); o.w = pk2(s[6 * 33], s[7 * 33]);
        *(GAS v4u*)(WT + (size_t)(row_off + n0 + n) * K + k0 + 8 * c) = o; }
    LDS_WAIT(); asm volatile("" ::: "memory");
}

__device__ __forceinline__ void phase_prep(const Params& P, const Ctx& C, LAS unsigned char* lds) {
    unsigned char* ws = P.ws;
    const float* xp = P.in[0]; const float* xs = P.in[1]; const float* ln1 = P.in[8]; const float* w_in = P.in[9]; const float* b_f = P.in[10];
    const float* a_log = P.in[12]; const float* dt_bias = P.in[13]; const float* w_o = P.in[15]; const float* ln2 = P.in[16]; const float* w_up = P.in[17]; const float* w_down = P.in[18];
    bf16* XN = (bf16*)(ws + WS_XN);
    float* LF = (float*)(ws + WS_LF); float* BETA = (float*)(ws + WS_BETA); float* Gg = (float*)(ws + WS_G);
    LAS float* WSm = (LAS float*)lds;
    LAS float* scr = (LAS float*)(lds + 49152 + C.wave * 8448);
    {
        float gv[24];
#pragma unroll
        for (int i = 0; i < 24; ++i) { const int idx = C.tid + 512 * i; const int k = idx / 12, c = idx % 12; const int col = c < 4 ? 1536 + c : 3588 + (c - 4); gv[i] = w_in[(size_t)k * INDIM + col]; }
#pragma unroll
        for (int i = 0; i < 24; ++i) { const int idx = C.tid + 512 * i; const int k = idx / 12, c = idx % 12; WSm[c * 1024 + k] = gv[i]; }
    }
    __syncthreads();
    const int gw = C.vcu * NWAVES + C.wave, NGW = C.G * NWAVES, lane = C.lane;
    f32x4 lw[4];
#pragma unroll
    for (int j = 0; j < 4; ++j) lw[j] = ((const f32x4*)ln1)[lane + 64 * j];
    f32x4 vnx[4];
    if (gw < M_TOT) { const float* xr0 = gw < MP ? xp + (size_t)gw * DM : xs + (size_t)(gw - MP) * DM;
#pragma unroll
        for (int j = 0; j < 4; ++j) vnx[j] = ((const f32x4*)xr0)[lane + 64 * j]; }
    for (int m = gw; m < M_TOT; m += NGW) {
        asm volatile("" ::: "memory");
        f32x4 v[4]; float ss = 0.f;
#pragma unroll
        for (int j = 0; j < 4; ++j) { v[j] = vnx[j]; ss += (v[j][0] * v[j][0] + v[j][1] * v[j][1]) + (v[j][2] * v[j][2] + v[j][3] * v[j][3]); }
        { const int mn = m + NGW; if (mn < M_TOT) { const float* xr1 = mn < MP ? xp + (size_t)mn * DM : xs + (size_t)(mn - MP) * DM;
#pragma unroll
            for (int j = 0; j < 4; ++j) vnx[j] = ((const f32x4*)xr1)[lane + 64 * j]; } }
        ss = wave_sum(ss);
        const float rstd = 1.0f / sqrtf(ss * (1.0f / DM) + RMS_EPS);
#pragma unroll
        for (int j = 0; j < 4; ++j) { v[j] = v[j] * rstd * lw[j];
            v2u o; o.x = pk2(v[j][0], v[j][1]); o.y = pk2(v[j][2], v[j][3]);
            *(v2u*)(XN + (size_t)m * DM + 4 * lane + 256 * j) = o; }
        float mine = 0.f;
#pragma unroll
        for (int c = 0; c < 12; ++c) { float a = 0.f;
#pragma unroll
            for (int j = 0; j < 4; ++j) { const f32x4 w = *(const LAS f32x4*)(WSm + c * 1024 + 4 * lane + 256 * j); a += (v[j][0] * w[0] + v[j][1] * w[1]) + (v[j][2] * w[2] + v[j][3] * w[3]); }
            a = wave_sum(a); mine = (lane == c) ? a : mine; }
        const float bb = __shfl(mine, (lane + 4) & 63), aa = __shfl(mine, (lane + 8) & 63);
        if (lane < 4) {
            const float fa = mine;
            const float lf = -softplus_f(-(fa + b_f[lane]));
            const float beta = sigmoid_f(bb);
            const float g = -expf(a_log[lane]) * softplus_f(aa + dt_bias[lane]);
            LF[(size_t)m * 4 + lane] = lf; BETA[(size_t)m * 4 + lane] = beta; Gg[(size_t)m * 4 + lane] = g;
            if (m < MP) P.out[OLF_P + (size_t)m * 4 + lane] = lf; else P.out[OLF_S + (size_t)(m - MP) * 4 + lane] = lf;
        }
    }
    bf16* W1T = (bf16*)(ws + WS_W1T); bf16* WOT = (bf16*)(ws + WS_WOT); bf16* WUPT = (bf16*)(ws + WS_WUPT); bf16* WDNT = (bf16*)(ws + WS_WDNT);
    for (int it = gw; it < 16 * 48; it += NGW) transpose_item(w_in, INDIM, 0, DM, 1536, nullptr, W1T, 0, scr, it, lane);
    for (int it = gw; it < 16 * 48; it += NGW) transpose_item(w_in, INDIM, 1540, DM, 1536, nullptr, W1T, 1536, scr, it, lane);
    for (int it = gw; it < 16 * 16; it += NGW) transpose_item(w_in, INDIM, 3076, DM, 512, nullptr, W1T, 3072, scr, it, lane);
    for (int it = gw; it < 16 * 32; it += NGW) transpose_item(w_o, DM, 0, DM, DM, nullptr, WOT, 0, scr, it, lane);
    for (int it = gw; it < 16 * 128; it += NGW) transpose_item(w_up, FF, 0, DM, FF, ln2, WUPT, 0, scr, it, lane);
    for (int it = gw; it < 64 * 32; it += NGW) transpose_item(w_down, DM, 0, FF, DM, nullptr, WDNT, 0, scr, it, lane);
}

__device__ __forceinline__ void kbias_seq(const Params& P, int bh, int lane) {
    const float* LF = (const float*)(P.ws + WS_LF); float* KBIAS = (float*)(P.ws + WS_KBIAS);
    const int b = bh >> 2, h = bh & 3;
    const float* src = LF + ((size_t)b * SEQ + 32 * lane) * 4 + h;
    float s = 0.f;
    for (int i = 0; i < 32; ++i) s += src[i * 4];
    float x = s;
#pragma unroll
    for (int o = 1; o < 64; o <<= 1) { const float y = __shfl_up(x, o); if (lane >= o) x += y; }
    float run = x - s;
    float* dst = KBIAS + (size_t)bh * SEQ + 32 * lane;
    const float inv = -11.313708498984761f;
    for (int i = 0; i < 32; ++i) { run += src[i * 4]; dst[i] = run * inv; }
}


namespace fox {
constexpr int D = 128, NW = 8, QBLK = 32, KVBLK = 64, QB = NW * QBLK;
constexpr int SHM_V = KVBLK * D * 2, SHM_K = KVBLK * D * 2;
constexpr float SCALE = 0.08838834764831845f, THR = 8.f;
#define KSWZ(row, colB) ((row) * 256 + ((colB) ^ (((row) & 7) << 4)))
#define SBAR() __builtin_amdgcn_sched_barrier(0)
__device__ __forceinline__ int v_st(int k, int c) { const int kk = (k & ~0xC) | ((k & 4) << 1) | ((k & 8) >> 1); return ((kk >> 3) * 4 + (c >> 5)) * 512 + ((kk & 7) * 32 + (c & 31)) * 2; }
__device__ __forceinline__ int v_rd_base(int lane) { return ((lane & 3) << 3) | (((lane >> 2) & 3) << 6) | (((lane >> 4) & 1) << 5) | (((lane >> 5) & 1) << 8); }
constexpr int v_rd_off(int d0, int ks, int half) { return d0 * 512 + ks * 4096 + half * 2048; }
__device__ __forceinline__ int crow(int r, int hi) { return (r & 3) + 8 * (r >> 2) + 4 * hi; }
__device__ __forceinline__ unsigned cvtpk(float lo, float hi) { unsigned r; asm volatile("v_cvt_pk_bf16_f32 %0, %1, %2" : "=v"(r) : "v"(lo), "v"(hi)); return r; }
__device__ __forceinline__ void mask_tile(f32x16& p0, f32x16& p1, int dq, unsigned W) {
    const float NEG = -__builtin_inff();
#pragma unroll
    for (int r = 0; r < 16; ++r) {
        const int c = (r & 3) + 8 * (r >> 2);
        if ((unsigned)(dq - c) >= W) p0[r] = NEG;
        if ((unsigned)(dq - c - 32) >= W) p1[r] = NEG;
    }
}
__device__ __forceinline__ void partialSM(f32x16& p0, f32x16& p1, float& m_reg, float& mn, float& alpha) {
    float pmax = p0[0]; for (int r = 1; r < 16; ++r) pmax = fmaxf(pmax, p0[r]); for (int r = 0; r < 16; ++r) pmax = fmaxf(pmax, p1[r]);
    { auto rr = __builtin_amdgcn_permlane32_swap(__float_as_uint(pmax), __float_as_uint(pmax), false, false);
      pmax = fmaxf(__uint_as_float(rr[0]), __uint_as_float(rr[1])); }
    constexpr float C2 = 1.4426950408889634f * SCALE;
    if (__builtin_expect(__all((pmax - m_reg) * SCALE <= THR), 1)) { mn = m_reg; alpha = 1.f; }
    else { mn = fmaxf(m_reg, pmax); alpha = __builtin_amdgcn_exp2f((m_reg - mn) * C2); m_reg = mn; }
    const float mnL = -mn * C2;
    for (int r = 0; r < 16; ++r) p0[r] = fmaf(p0[r], C2, mnL); for (int r = 0; r < 16; ++r) p1[r] = fmaf(p1[r], C2, mnL);
    for (int r = 0; r < 16; ++r) p0[r] = __builtin_amdgcn_exp2f(p0[r]);
}
__device__ __forceinline__ void finishSM(f32x16& p0, f32x16& p1, float alpha, float& l_reg, bf16x8& pa0, bf16x8& pa1, bf16x8& pa2, bf16x8& pa3) {
    for (int r = 0; r < 16; ++r) p1[r] = __builtin_amdgcn_exp2f(p1[r]);
    float ps = 0; for (int r = 0; r < 16; ++r) ps += p0[r]; for (int r = 0; r < 16; ++r) ps += p1[r];
    { auto rr = __builtin_amdgcn_permlane32_swap(__float_as_uint(ps), __float_as_uint(ps), false, false);
      ps = __uint_as_float(rr[0]) + __uint_as_float(rr[1]); }
    l_reg = l_reg * alpha + ps;
#define PK4(P, B_, OUT) do { unsigned a0 = cvtpk(P[B_+0], P[B_+1]), a1 = cvtpk(P[B_+2], P[B_+3]);                          \
        unsigned b0 = cvtpk(P[B_+4], P[B_+5]), b1 = cvtpk(P[B_+6], P[B_+7]);                                             \
        auto r0 = __builtin_amdgcn_permlane32_swap(a0, b0, false, false); auto r1 = __builtin_amdgcn_permlane32_swap(a1, b1, false, false); \
        v4u w = {r0[0], r1[0], r0[1], r1[1]}; OUT = *reinterpret_cast<bf16x8*>(&w); } while (0)
    PK4(p0, 0, pa0); PK4(p0, 8, pa1); PK4(p1, 0, pa2); PK4(p1, 8, pa3);
#undef PK4
}
template <int KB>
__device__ __forceinline__ void qkt(f32x16& p0, f32x16& p1, const char* K_lds, const float* bias_l, int r32, int hi, const bf16x8* qr) {
#pragma unroll
    for (int g = 0; g < 4; ++g) { const f32x4 t0 = *(const f32x4*)(bias_l + 8 * g + 4 * hi), t1 = *(const f32x4*)(bias_l + 32 + 8 * g + 4 * hi);
#pragma unroll
        for (int i = 0; i < 4; ++i) { p0[4 * g + i] = t0[i]; p1[4 * g + i] = t1[i]; } }
    const char* kb[4];
#pragma unroll
    for (int dd = 0; dd < 4; ++dd) kb[dd] = K_lds + KB * SHM_K + KSWZ(r32, (dd * 16 + hi * 8) * 2);
#pragma unroll
    for (int d0 = 0; d0 < 8; ++d0) { const char* a = kb[d0 & 3] + (d0 >> 2) * 128;
        bf16x8 b0 = *reinterpret_cast<const bf16x8*>(a);
        bf16x8 b1 = *reinterpret_cast<const bf16x8*>(a + 32 * 256);
        p0 = __builtin_amdgcn_mfma_f32_32x32x16_bf16(b0, qr[d0], p0, 0, 0, 0);
        p1 = __builtin_amdgcn_mfma_f32_32x32x16_bf16(b1, qr[d0], p1, 0, 0, 0); }
}
template <int VB>
__device__ __forceinline__ void pv_tile(f32x16* o, int vb0, bf16x8 pa0, bf16x8 pa1, bf16x8 pa2, bf16x8 pa3) {
#define TRRD(dst, off) asm volatile("ds_read_b64_tr_b16 %0, %1 offset:%2" : "=&v"(dst) : "v"(vb0), "i"(off) : "memory")
#define PV_D0(d0) do { s16x4 l0, l1, l2, l3, h0, h1, h2, h3; constexpr int b_ = VB * SHM_V + v_rd_off(d0, 0, 0);   \
        TRRD(l0, b_); TRRD(h0, b_ + 2048); TRRD(l1, b_ + 4096); TRRD(h1, b_ + 6144); TRRD(l2, b_ + 8192); TRRD(h2, b_ + 10240); TRRD(l3, b_ + 12288); TRRD(h3, b_ + 14336); \
        asm volatile("s_waitcnt lgkmcnt(0)" ::: "memory"); SBAR();   \
        o[d0] = __builtin_amdgcn_mfma_f32_32x32x16_bf16(pa0, (bf16x8){l0[0], l0[1], l0[2], l0[3], h0[0], h0[1], h0[2], h0[3]}, o[d0], 0, 0, 0);   \
        o[d0] = __builtin_amdgcn_mfma_f32_32x32x16_bf16(pa1, (bf16x8){l1[0], l1[1], l1[2], l1[3], h1[0], h1[1], h1[2], h1[3]}, o[d0], 0, 0, 0);   \
        o[d0] = __builtin_amdgcn_mfma_f32_32x32x16_bf16(pa2, (bf16x8){l2[0], l2[1], l2[2], l2[3], h2[0], h2[1], h2[2], h2[3]}, o[d0], 0, 0, 0);   \
        o[d0] = __builtin_amdgcn_mfma_f32_32x32x16_bf16(pa3, (bf16x8){l3[0], l3[1], l3[2], l3[3], h3[0], h3[1], h3[2], h3[3]}, o[d0], 0, 0, 0); } while (0)
    PV_D0(0); PV_D0(1); PV_D0(2); PV_D0(3);
#undef PV_D0
#undef TRRD
}

__device__ __forceinline__ void fox_block(char* lds, const bf16* Qh, const bf16* Kh, const bf16* Vh, const float* kbias, bf16* Orow0, int qb) {
    const int tid = threadIdx.x, wid = __builtin_amdgcn_readfirstlane(tid >> 6), lane = tid & 63, r32 = lane & 31, hi = lane >> 5;
    const int P0 = qb * QB, qlo = P0 + wid * QBLK, qm = qlo + r32 - 4 * hi;
    char* V_lds = lds; char* K_lds = lds + SHM_V;
    float* bias_l = (float*)(lds + SHM_V + SHM_K);
    float* wsf = bias_l + 64 + wid * 64; float* li_l = wsf; float* al_l = wsf + 32;
    bf16x8 qr[8];
#pragma unroll
    for (int d0 = 0; d0 < 8; ++d0) qr[d0] = *reinterpret_cast<const bf16x8*>(Qh + (size_t)(qlo + r32) * D + d0 * 16 + hi * 8);
    float m_reg = -1e30f, l_reg = 0.f; f32x16 o[4] = {};
    const int sr = tid >> 4, sc = (tid & 15) * 8, vst0 = v_st(sr, sc), vst1 = v_st(32 + sr, sc), kws = KSWZ(sr, sc * 2);
    const int vb0 = (int)(uintptr_t)V_lds + v_rd_base(lane);
    const int ntiles = P0 / KVBLK + 4;
    for (int j = ntiles - 1; j >= 0; --j) {
        const int kb = j * KVBLK;
        __syncthreads();
        { const bf16x8 k0 = *reinterpret_cast<const bf16x8*>(Kh + (size_t)(kb + sr) * D + sc), k1 = *reinterpret_cast<const bf16x8*>(Kh + (size_t)(kb + 32 + sr) * D + sc);
          const bf16x8 v0 = *reinterpret_cast<const bf16x8*>(Vh + (size_t)(kb + sr) * D + sc), v1 = *reinterpret_cast<const bf16x8*>(Vh + (size_t)(kb + 32 + sr) * D + sc);
          *(bf16x8*)(K_lds + kws) = k0; *(bf16x8*)(K_lds + kws + 32 * 256) = k1; *(bf16x8*)(V_lds + vst0) = v0; *(bf16x8*)(V_lds + vst1) = v1;
          if (tid < 64) bias_l[tid] = kbias[kb + tid]; }
        __syncthreads();
        if (kb <= qlo + QBLK - 1) {
            f32x16 p0, p1; float mn, al; bf16x8 pa0, pa1, pa2, pa3;
            qkt<0>(p0, p1, K_lds, bias_l, r32, hi, qr);
            if (kb + KVBLK - 1 > qlo) mask_tile(p0, p1, qm - kb, 0x40000000u);
            partialSM(p0, p1, m_reg, mn, al);
            if (__any(al < 1.f)) { if (hi == 0) al_l[r32] = al; asm volatile("s_waitcnt lgkmcnt(0)" ::: "memory");
                for (int d_ = 0; d_ < 4; ++d_) for (int r = 0; r < 16; ++r) o[d_][r] *= al_l[crow(r, hi)]; }
            finishSM(p0, p1, al, l_reg, pa0, pa1, pa2, pa3); SBAR();
            pv_tile<0>(o, vb0, pa0, pa1, pa2, pa3);
        }
    }
    if (hi == 0) li_l[r32] = l_reg; asm volatile("s_waitcnt lgkmcnt(0)" ::: "memory");
    float rli[16];
#pragma unroll
    for (int r = 0; r < 16; ++r) rli[r] = __builtin_amdgcn_rcpf(li_l[crow(r, hi)]);
    bf16* Ow = Orow0 + (size_t)qlo * DM;
#pragma unroll
    for (int r = 0; r < 16; ++r) { const int orow = crow(r, hi);
#pragma unroll
        for (int d0 = 0; d0 < 4; ++d0) { const float v = o[d0][r] * rli[r];
            const float vn = __shfl_xor(v, 1);
            if ((r32 & 1) == 0) *(unsigned*)(Ow + (size_t)orow * DM + d0 * 32 + r32) = cvtpk(v, vn); } }
    __syncthreads();
}
}


__device__ __forceinline__ void dec_update(float& m, float& l, f32x4& acc, const float (&x)[4], const f32x4 (&v)[4], int n) {
    float mx = m;
#pragma unroll
    for (int u = 0; u < 4; ++u) if (u < n) mx = fmaxf(mx, x[u]);
    const float al = __expf(m - mx);
    float ps = 0.f; f32x4 a = acc * al;
#pragma unroll
    for (int u = 0; u < 4; ++u) if (u < n) { const float p = __expf(x[u] - mx); ps += p; a += v[u] * p; }
    l = l * al + ps; acc = a; m = mx;
}
__device__ __forceinline__ float red32(float s) {
#pragma unroll
    for (int o = 1; o < 32; o <<= 1) s += __shfl_xor(s, o);
    return s;
}
__device__ __forceinline__ void decode_unit(const Params& P, LAS unsigned char* lds, int db) {
    const int tid = threadIdx.x, wid = __builtin_amdgcn_readfirstlane(tid >> 6), lane = tid & 63, hi = lane >> 5;
    const float* cache_k = P.in[2]; const float* cache_v = P.in[3]; const float* cache_lf = P.in[4]; const int* page_table = (const int*)P.in[5];
    const float* LF = (const float*)(P.ws + WS_LF); const float* QS = (const float*)(P.ws + WS_QS);
    bf16* MIX = (bf16*)(P.ws + WS_MIX);
    LAS f32x4* lfs = (LAS f32x4*)lds;
    LAS f32x4* wt = lfs + 2048;
    LAS float* cm = (LAS float*)(wt + 8);
    LAS float* cl = cm + 32;
    LAS f32x4* cacc = (LAS f32x4*)(cl + 32);
    const int ptv = (lane < NPAGES) ? page_table[db * NPAGES + lane] : 0;
#pragma unroll
    for (int i = 0; i < 4; ++i) { const int j = tid + 512 * i; const int pg = __shfl(ptv, j >> 7);
        lfs[j] = *(const f32x4*)(cache_lf + ((size_t)pg * PAGE + (j & 127)) * 4); }
    __syncthreads();
    {
        const f32x4 a0 = lfs[4 * tid], a1 = lfs[4 * tid + 1], a2 = lfs[4 * tid + 2], a3 = lfs[4 * tid + 3];
        const f32x4 tot = (a0 + a1) + (a2 + a3);
        f32x4 x = tot;
#pragma unroll
        for (int o = 1; o < 64; o <<= 1) { f32x4 y; y[0] = __shfl_down(x[0], o); y[1] = __shfl_down(x[1], o); y[2] = __shfl_down(x[2], o); y[3] = __shfl_down(x[3], o); if (lane + o < 64) x += y; }
        if (lane == 0) wt[wid] = x;
        __syncthreads();
        f32x4 after = {0.f, 0.f, 0.f, 0.f};
        for (int w2 = wid + 1; w2 < NWAVES; ++w2) after += wt[w2];
        const f32x4 lfn = *(const f32x4*)(LF + (size_t)(MP + db) * 4);
        const f32x4 B3 = (x - tot) + after + lfn, B2 = B3 + a3, B1 = B2 + a2, B0 = B1 + a1;
        lfs[4 * tid] = B0; lfs[4 * tid + 1] = B1; lfs[4 * tid + 2] = B2; lfs[4 * tid + 3] = B3;
    }
    __syncthreads();
    const float* qs = QS + (size_t)db * 512;
    const f32x4 qa = *(const f32x4*)(qs + 4 * lane) * ATT_SCALE, qb = *(const f32x4*)(qs + 256 + 4 * lane) * ATT_SCALE;
    float m0 = -1e30f, l0 = 0.f, m1 = -1e30f, l1 = 0.f; f32x4 acc0 = {0.f, 0.f, 0.f, 0.f}, acc1 = {0.f, 0.f, 0.f, 0.f};
    f32x4 kaA[4], kbA[4], vaA[4], vbA[4], kaB[4], kbB[4], vaB[4], vbB[4];
#define DEC_LOAD(ka, kb, va, vb, j0_) do { _Pragma("unroll") for (int u = 0; u < 4; ++u) { const int j = (j0_) + 8 * u; const int pg = __builtin_amdgcn_readlane(ptv, j >> 7); \
            const size_t ro = ((size_t)pg * PAGE + (j & 127)) * 512 + 4 * lane; \
            ka[u] = *(const f32x4*)(cache_k + ro); kb[u] = *(const f32x4*)(cache_k + ro + 256); va[u] = *(const f32x4*)(cache_v + ro); vb[u] = *(const f32x4*)(cache_v + ro + 256); } } while (0)
#define DEC_PROC(ka, kb, va, vb, j0_) do { float x0[4], x1[4]; _Pragma("unroll") for (int u = 0; u < 4; ++u) { const int j = (j0_) + 8 * u; \
            float s0 = (qa[0] * ka[u][0] + qa[1] * ka[u][1]) + (qa[2] * ka[u][2] + qa[3] * ka[u][3]); \
            float s1 = (qb[0] * kb[u][0] + qb[1] * kb[u][1]) + (qb[2] * kb[u][2] + qb[3] * kb[u][3]); \
            s0 = red32(s0); s1 = red32(s1); const f32x4 bj = lfs[j]; \
            x0[u] = s0 + (hi ? bj[1] : bj[0]); x1[u] = s1 + (hi ? bj[3] : bj[2]); } \
        dec_update(m0, l0, acc0, x0, va, 4); dec_update(m1, l1, acc1, x1, vb, 4); } while (0)
    DEC_LOAD(kaA, kbA, vaA, vbA, wid);
    for (int j0 = wid; j0 < PAST; j0 += 64) {
        DEC_LOAD(kaB, kbB, vaB, vbB, j0 + 32);
        DEC_PROC(kaA, kbA, vaA, vbA, j0);
        if (j0 + 64 < PAST) DEC_LOAD(kaA, kbA, vaA, vbA, j0 + 64);
        DEC_PROC(kaB, kbB, vaB, vbB, j0 + 32);
    }
#undef DEC_LOAD
#undef DEC_PROC
    if (wid == 0) {
        f32x4 va[4], vb[4]; float x0[4], x1[4];
        const float* kn = P.out + OK_S + (size_t)db * 512; const float* vn = P.out + OV_S + (size_t)db * 512;
        const f32x4 ka = *(const f32x4*)(kn + 4 * lane), kb = *(const f32x4*)(kn + 256 + 4 * lane);
        va[0] = *(const f32x4*)(vn + 4 * lane); vb[0] = *(const f32x4*)(vn + 256 + 4 * lane);
#pragma unroll
        for (int u = 1; u < 4; ++u) { va[u] = va[0]; vb[u] = vb[0]; }
        x0[0] = red32((qa[0] * ka[0] + qa[1] * ka[1]) + (qa[2] * ka[2] + qa[3] * ka[3]));
        x1[0] = red32((qb[0] * kb[0] + qb[1] * kb[1]) + (qb[2] * kb[2] + qb[3] * kb[3]));
#pragma unroll
        for (int u = 1; u < 4; ++u) { x0[u] = x0[0]; x1[u] = x1[0]; }
        dec_update(m0, l0, acc0, x0, va, 1); dec_update(m1, l1, acc1, x1, vb, 1);
    }
    if ((lane & 31) == 0) { cm[wid * 4 + hi] = m0; cm[wid * 4 + 2 + hi] = m1; cl[wid * 4 + hi] = l0; cl[wid * 4 + 2 + hi] = l1; }
    cacc[(wid * 2 + 0) * 64 + lane] = acc0; cacc[(wid * 2 + 1) * 64 + lane] = acc1;
    __syncthreads();
    if (tid < 128) {
        const int ab = tid >> 6, l = tid & 63, head = 2 * ab + (l >> 5);
        float M = -1e30f;
#pragma unroll
        for (int w = 0; w < NWAVES; ++w) M = fmaxf(M, cm[w * 4 + head]);
        float L = 0.f; f32x4 O = {0.f, 0.f, 0.f, 0.f};
#pragma unroll
        for (int w = 0; w < NWAVES; ++w) { const float e = __expf(cm[w * 4 + head] - M); L += cl[w * 4 + head] * e; O += cacc[(w * 2 + ab) * 64 + l] * e; }
        const float inv = 1.0f / L;
        v2u o; o.x = pk2(O[0] * inv, O[1] * inv); o.y = pk2(O[2] * inv, O[3] * inv);
        *(v2u*)(MIX + (size_t)(MP + db) * DM + head * 128 + 4 * (l & 31)) = o;
    }
    __syncthreads();
}

__device__ __forceinline__ void sgdn_unit(const Params& P, LAS unsigned char* lds, int db) {
    const int tid = threadIdx.x, wid = __builtin_amdgcn_readfirstlane(tid >> 6), lane = tid & 63;
    const float* state_conv = P.in[6]; const float* state_ssm = P.in[7]; const float* w_conv = P.in[11]; const float* w_gnorm = P.in[14];
    const float* BETA = (const float*)(P.ws + WS_BETA); const float* Gg = (const float*)(P.ws + WS_G);
    const bf16* ZB = (const bf16*)(P.ws + WS_ZB); bf16* MIX = (bf16*)(P.ws + WS_MIX);
    LAS float* xs = (LAS float*)lds;
    LAS float* red1 = xs + 1536;
    LAS float* red2 = red1 + 4096;
    LAS float* ov = red2 + 4096;
#pragma unroll
    for (int i = 0; i < 3; ++i) {
        const int ch = tid + 512 * i;
        const float* sc = state_conv + (size_t)db * 3 * CONVD + ch;
        float* oc = P.out + OCONV_S + (size_t)db * 3 * CONVD + ch;
        const float c0 = sc[0], c1 = sc[CONVD], c2 = sc[2 * CONVD], c3 = oc[2 * CONVD];
        const float a = (c0 * w_conv[ch] + c1 * w_conv[CONVD + ch]) + (c2 * w_conv[2 * CONVD + ch] + c3 * w_conv[3 * CONVD + ch]);
        xs[ch] = silu_f(a);
        oc[0] = c1; oc[CONVD] = c2;
    }
    __syncthreads();
    {
        const float a = xs[wid * 128 + lane], b = xs[wid * 128 + 64 + lane];
        const float ss = wave_sum(a * a + b * b);
        const float sc = (1.0f / sqrtf(ss + L2_EPS)) * (wid < 4 ? ATT_SCALE : 1.0f);
        xs[wid * 128 + lane] = a * sc; xs[wid * 128 + 64 + lane] = b * sc;
    }
    __syncthreads();
#pragma unroll
    for (int hp = 0; hp < 2; ++hp) {
        f32x2 s[2][16];
#pragma unroll
        for (int hh = 0; hh < 2; ++hh) { const int h = 2 * hp + hh;
            const float gsc = __expf(Gg[(size_t)(MP + db) * 4 + h]);
            const float* Sp = state_ssm + ((size_t)(db * 4 + h) * 128 + 16 * wid) * 128 + 2 * lane;
            f32x2 ks = {0.f, 0.f};
#pragma unroll
            for (int r = 0; r < 16; ++r) { s[hh][r] = *(const f32x2*)(Sp + (size_t)r * 128) * gsc; const float kd = xs[512 + h * 128 + 16 * wid + r]; ks += s[hh][r] * kd; }
            *(LAS f32x2*)(red1 + (h * 8 + wid) * 128 + 2 * lane) = ks;
        }
        __syncthreads();
#pragma unroll
        for (int hh = 0; hh < 2; ++hh) { const int h = 2 * hp + hh;
            const float bt = BETA[(size_t)(MP + db) * 4 + h];
            f32x2 kS = {0.f, 0.f};
#pragma unroll
            for (int w = 0; w < NWAVES; ++w) kS += *(const LAS f32x2*)(red1 + (h * 8 + w) * 128 + 2 * lane);
            const f32x2 vv = *(const LAS f32x2*)(xs + 1024 + h * 128 + 2 * lane);
            const f32x2 delta = (vv - kS) * bt;
            float* So = P.out + OSSM_S + ((size_t)(db * 4 + h) * 128 + 16 * wid) * 128 + 2 * lane;
            f32x2 os = {0.f, 0.f};
#pragma unroll
            for (int r = 0; r < 16; ++r) { const float kd = xs[512 + h * 128 + 16 * wid + r], qd = xs[h * 128 + 16 * wid + r]; const f32x2 sn = s[hh][r] + delta * kd; *(f32x2*)(So + (size_t)r * 128) = sn; os += sn * qd; }
            *(LAS f32x2*)(red2 + (h * 8 + wid) * 128 + 2 * lane) = os;
        }
    }
    __syncthreads();
    { const int h = tid >> 7, e = tid & 127; float o = 0.f;
#pragma unroll
        for (int w = 0; w < NWAVES; ++w) o += red2[(h * 8 + w) * 128 + e];
        ov[tid] = o; }
    __syncthreads();
    if (wid < 4) {
        const int h = wid;
        const float a = ov[h * 128 + lane], b = ov[h * 128 + 64 + lane];
        const float ss = wave_sum(a * a + b * b);
        const float rstd = 1.0f / sqrtf(ss * (1.0f / 128.0f) + RMS_EPS);
        const bf16* zr = ZB + (size_t)(MP + db) * 512 + h * 128;
        bf16* mr = MIX + (size_t)(MP + db) * DM + 512 + h * 128;
        mr[lane] = (bf16)f2bf(a * rstd * w_gnorm[lane] * silu_f(bf2f(zr[lane])));
        mr[64 + lane] = (bf16)f2bf(b * rstd * w_gnorm[64 + lane] * silu_f(bf2f(zr[64 + lane])));
    }
    __syncthreads();
}


#ifndef GSTAMP
#define GSTAMP(id)
#endif
constexpr int XS = 132, LS = 64;
__device__ __forceinline__ int sw256(int row, int ch) { return row * 256 + ((ch ^ (row & 15)) << 4); }
__device__ __forceinline__ int sw128(int row, int ch) { return row * 128 + ((ch ^ ((row >> 1) & 7)) << 4); }
#define GDNA_LOAD(unit_) do { const int n_ = (unit_) & 31, bh_ = (unit_) >> 5, h_ = bh_ & 3, m0_ = (bh_ >> 2) * SEQ + n_ * GCH; \
        _Pragma("unroll") for (int i = 0; i < 7; ++i) { const int c = tid + 512 * i; const int r = c / 48, w = c - r * 48, seg = w >> 4, ch = w & 15; \
            rv[i] = (v4u){0u, 0u, 0u, 0u}; \
            if (c < 67 * 48 && (n_ > 0 || r >= 3)) rv[i] = *(const v4u*)(CB + (size_t)(m0_ - 3 + r) * CONVD + seg * 512 + h_ * 128 + ch * 8); } \
        gpre = Gg[(size_t)(m0_ + lane) * 4 + h_]; bpre = BETA[(size_t)(m0_ + lane) * 4 + h_]; } while (0)
__device__ __forceinline__ void gdna_units(const Params& P, LAS unsigned char* lds, int u_first, int u_step, int u_end) {
    const int tid = threadIdx.x, wid = __builtin_amdgcn_readfirstlane(tid >> 6), lane = tid & 63, fr = lane & 15, fq = lane >> 4;
    const bf16* CB = (const bf16*)(P.ws + WS_CB);
    const float* BETA = (const float*)(P.ws + WS_BETA); const float* Gg = (const float*)(P.ws + WS_G);
    v4u rv[7]; float gpre, bpre;
    if (u_first < u_end) GDNA_LOAD(u_first & (NB * NH * NCHUNK - 1));
    for (int uu = u_first; uu < u_end; uu += u_step) {
    const int unit = uu & (NB * NH * NCHUNK - 1);
    const int n = unit & 31, bh = unit >> 5, b = bh >> 2, h = bh & 3, m0 = b * SEQ + n * GCH;
    const float* w_conv = P.in[11];
    float* UT = (float*)(P.ws + WS_UT) + (size_t)unit * 8192; bf16* WN = (bf16*)(P.ws + WS_WN) + (size_t)unit * 8192; bf16* QG = (bf16*)(P.ws + WS_QG) + (size_t)unit * 8192;
    bf16* KGT = (bf16*)(P.ws + WS_KGT) + (size_t)unit * 8192; bf16* QKM = (bf16*)(P.ws + WS_QKM) + (size_t)unit * 4096; float* GL = (float*)(P.ws + WS_GL);
    LAS float* XQ = (LAS float*)lds; LAS float* XK = XQ + 64 * XS; LAS float* XV = XK + 64 * XS;
    LAS unsigned char* RA = lds + 3 * 64 * XS * 4;
    LAS float* Lm = (LAS float*)RA;
    LAS unsigned char* KBf = RA + 16384;
    LAS unsigned char* QBf = RA + 16384 + 16384;
    LAS unsigned char* Nb = RA + 49152;
    LAS unsigned char* Lb = RA + 51456;
    LAS float* gcs = (LAS float*)(RA + 51456 + 8192); LAS float* bts = gcs + 64; LAS float* sks = bts + 64;
#pragma unroll
    for (int i = 0; i < 7; ++i) { const int c = tid + 512 * i; if (c < 67 * 48) *(LAS v4u*)(RA + c * 16) = rv[i]; }
    if (wid == 7) {
        float x = gpre;
#pragma unroll
        for (int o = 1; o < 64; o <<= 1) { const float y = __shfl_up(x, o); if (lane >= o) x += y; }
        gcs[lane] = x; bts[lane] = bpre; sks[lane] = bpre * __expf(x);
    }
    __syncthreads(); GSTAMP(5);
#pragma unroll
    for (int it = 0; it < 3; ++it) {
        const int item = tid + 512 * it, p = item % 192, rg = item / 192, seg = p >> 6, dp = (p & 63) * 2, ch = seg * 512 + h * 128 + dp;
        const f32x2 w0 = *(const f32x2*)(w_conv + ch), w1 = *(const f32x2*)(w_conv + CONVD + ch), w2 = *(const f32x2*)(w_conv + 2 * CONVD + ch), w3 = *(const f32x2*)(w_conv + 3 * CONVD + ch);
        const LAS unsigned* src = (const LAS unsigned*)(RA + ((8 * rg) * 384 + seg * 128 + dp) * 2);
        unsigned rw[11];
#pragma unroll
        for (int i = 0; i < 11; ++i) rw[i] = src[i * 192];
        LAS float* X = XQ + seg * 64 * XS + (8 * rg) * XS + dp;
#pragma unroll
        for (int i = 0; i < 8; ++i) {
            f32x2 a;
            a[0] = (__builtin_bit_cast(float, rw[i] << 16) * w0[0] + __builtin_bit_cast(float, rw[i + 1] << 16) * w1[0]) + (__builtin_bit_cast(float, rw[i + 2] << 16) * w2[0] + __builtin_bit_cast(float, rw[i + 3] << 16) * w3[0]);
            a[1] = (__builtin_bit_cast(float, rw[i] & 0xffff0000u) * w0[1] + __builtin_bit_cast(float, rw[i + 1] & 0xffff0000u) * w1[1]) + (__builtin_bit_cast(float, rw[i + 2] & 0xffff0000u) * w2[1] + __builtin_bit_cast(float, rw[i + 3] & 0xffff0000u) * w3[1]);
            a[0] = silu_f(a[0]); a[1] = silu_f(a[1]);
            *(LAS f32x2*)(X + i * XS) = a;
        }
    }
    __syncthreads(); GSTAMP(6);
    if (uu + u_step < u_end) GDNA_LOAD((uu + u_step) & (NB * NH * NCHUNK - 1));
#pragma unroll
    for (int it = 0; it < 2; ++it) {
        const int item = tid + 512 * it, R = item >> 3, s8 = item & 7, isq = R < 64, i = R & 63;
        LAS float* X = (isq ? XQ : XK) + i * XS + 16 * s8;
        f32x4 v[4]; float ss = 0.f;
#pragma unroll
        for (int q = 0; q < 4; ++q) { v[q] = *(const LAS f32x4*)(X + 4 * q); ss += (v[q][0] * v[q][0] + v[q][1] * v[q][1]) + (v[q][2] * v[q][2] + v[q][3] * v[q][3]); }
        ss += __shfl_xor(ss, 1); ss += __shfl_xor(ss, 2); ss += __shfl_xor(ss, 4);
        const float sc = (1.0f / sqrtf(ss + L2_EPS)) * (isq ? ATT_SCALE : 1.0f);
#pragma unroll
        for (int q = 0; q < 4; ++q) { v[q] = v[q] * sc; *(LAS f32x4*)(X + 4 * q) = v[q]; }
        LAS unsigned char* Bf = isq ? QBf : KBf;
        *(LAS v4u*)(Bf + sw256(i, 2 * s8)) = (v4u){pk2(v[0][0], v[0][1]), pk2(v[0][2], v[0][3]), pk2(v[1][0], v[1][1]), pk2(v[1][2], v[1][3])};
        *(LAS v4u*)(Bf + sw256(i, 2 * s8 + 1)) = (v4u){pk2(v[2][0], v[2][1]), pk2(v[2][2], v[2][3]), pk2(v[3][0], v[3][1]), pk2(v[3][2], v[3][3])};
    }
    __syncthreads(); GSTAMP(7);
    {
        const int ti = wid >> 1, i = 16 * ti + fr; const float gi = gcs[i], bi = bts[i];
#pragma unroll
        for (int t2 = 0; t2 < 2; ++t2) {
            const int tj = 2 * (wid & 1) + t2;
            f32x4 akk = {0.f, 0.f, 0.f, 0.f}, aqk = {0.f, 0.f, 0.f, 0.f};
            if (tj <= ti) {
#pragma unroll
                for (int ks = 0; ks < 4; ++ks) {
                    const bf16x8 kj = *(const LAS bf16x8*)(KBf + sw256(16 * tj + fr, 4 * ks + fq));
                    const bf16x8 kiv = *(const LAS bf16x8*)(KBf + sw256(i, 4 * ks + fq)), qiv = *(const LAS bf16x8*)(QBf + sw256(i, 4 * ks + fq));
                    akk = __builtin_amdgcn_mfma_f32_16x16x32_bf16(kj, kiv, akk, 0, 0, 0);
                    aqk = __builtin_amdgcn_mfma_f32_16x16x32_bf16(kj, qiv, aqk, 0, 0, 0);
                }
            }
            f32x4 lv, qv; const f32x4 gj = *(const LAS f32x4*)(gcs + 16 * tj + 4 * fq);
#pragma unroll
            for (int jj = 0; jj < 4; ++jj) { const int j = 16 * tj + 4 * fq + jj; const float dec = (j <= i) ? __expf(gi - gj[jj]) : 0.f;
                lv[jj] = (j < i) ? bi * akk[jj] * dec : 0.f; qv[jj] = (j <= i) ? aqk[jj] * dec : 0.f; }
            *(LAS f32x4*)(Lm + i * LS + 16 * tj + 4 * fq) = lv;
            *(LAS v2u*)(Lb + sw128(i, (16 * tj + 4 * fq) >> 3) + ((4 * fq) & 7) * 2) = (v2u){pk2(-lv[0], -lv[1]), pk2(-lv[2], -lv[3])};
            v2u qo; qo.x = pk2(qv[0], qv[1]); qo.y = pk2(qv[2], qv[3]);
            *(v2u*)(QKM + (size_t)i * 64 + 16 * tj + 4 * fq) = qo;
        }
    }
    __syncthreads(); GSTAMP(8);
    if (tid < 64) {
        const int bb = tid >> 4, c = tid & 15; const LAS float* Lp = Lm + (16 * bb) * LS + 16 * bb;
        float y[16];
#pragma unroll
        for (int r = 0; r < 16; ++r) { float a = (r == c) ? 1.f : 0.f;
#pragma unroll
            for (int j = 0; j < r; ++j) a -= Lp[r * LS + j] * y[j];
            y[r] = a; }
#pragma unroll
        for (int r = 0; r < 16; ++r) *(LAS bf16*)(Nb + ((bb * 16 + r) * 16 + c) * 2) = (bf16)f2bf(y[r] - ((r == c) ? 1.f : 0.f));
    } else if (tid >= 256) {
        const int t2 = tid - 256;
        { const int i = t2 >> 2, d0 = (t2 & 3) * 32; const float e = __expf(gcs[i]);
#pragma unroll
          for (int q8 = 0; q8 < 4; ++q8) { const f32x4 a = *(const LAS f32x4*)(XQ + i * XS + d0 + 8 * q8), c = *(const LAS f32x4*)(XQ + i * XS + d0 + 8 * q8 + 4);
              v4u o; o.x = pk2(a[0] * e, a[1] * e); o.y = pk2(a[2] * e, a[3] * e); o.z = pk2(c[0] * e, c[1] * e); o.w = pk2(c[2] * e, c[3] * e);
              *(v4u*)(QG + (size_t)i * 128 + d0 + 8 * q8) = o; } }
        { const int d = t2 >> 1, i0 = (t2 & 1) * 32; const float gl = gcs[63];
#pragma unroll
          for (int q8 = 0; q8 < 4; ++q8) { float v[8];
#pragma unroll
              for (int e = 0; e < 8; ++e) { const int i = i0 + 8 * q8 + e; v[e] = XK[i * XS + d] * __expf(gl - gcs[i]); }
              v4u o; o.x = pk2(v[0], v[1]); o.y = pk2(v[2], v[3]); o.z = pk2(v[4], v[5]); o.w = pk2(v[6], v[7]);
              *(v4u*)(KGT + (size_t)d * 64 + i0 + 8 * q8) = o; } }
        if (t2 == 0) GL[unit] = __expf(gcs[63]);
    }
    __syncthreads();
    {
        LAS unsigned char* Xt = KBf + wid * 4096;
        const bool isv = wid < 4;
        f32x4 xacc[2];
#pragma unroll
        for (int bb = 0; bb < 4; ++bb) {
            const f32x4 scv = *(const LAS f32x4*)((isv ? bts : sks) + 16 * bb + 4 * fq);
            bf16x8 nf = (bf16x8){0, 0, 0, 0, 0, 0, 0, 0};
            if (fq < 2) nf = *(const LAS bf16x8*)(Nb + (bb * 16 + fr) * 32 + fq * 16);
#pragma unroll
            for (int t = 0; t < 2; ++t) {
                const int colw = 16 * t + fr, col = 32 * wid + colw;
                const LAS float* Xs = isv ? (XV + col) : (XK + (col - 128));
#pragma unroll
                for (int j = 0; j < 4; ++j) xacc[t][j] = Xs[(16 * bb + 4 * fq + j) * XS] * scv[j];
#pragma unroll
                for (int ks = 0; ks < 2; ++ks) if (32 * ks < 16 * bb) {
                    bf16x8 a = *(const LAS bf16x8*)(Lb + sw128(16 * bb + fr, 4 * ks + fq));
                    bf16x8 xb = *(const LAS bf16x8*)(Xt + sw128(colw, 4 * ks + fq));
                    if (32 * ks + 8 * fq >= 16 * bb) { a = (bf16x8){0, 0, 0, 0, 0, 0, 0, 0}; xb = a; }
                    xacc[t] = __builtin_amdgcn_mfma_f32_16x16x32_bf16(a, xb, xacc[t], 0, 0, 0);
                }
                LAS unsigned char* xp = Xt + sw128(colw, (16 * bb + 4 * fq) >> 3) + ((4 * fq) & 7) * 2;
                *(LAS v2u*)xp = (v2u){pk2(xacc[t][0], xacc[t][1]), pk2(xacc[t][2], xacc[t][3])};
                bf16x8 rb = (bf16x8){0, 0, 0, 0, 0, 0, 0, 0};
                if (fq < 2) rb = *(const LAS bf16x8*)(Xt + sw128(colw, 2 * bb + fq));
                xacc[t] = __builtin_amdgcn_mfma_f32_16x16x32_bf16(nf, rb, xacc[t], 0, 0, 0);
                *(LAS v2u*)xp = (v2u){pk2(xacc[t][0], xacc[t][1]), pk2(xacc[t][2], xacc[t][3])};
                if (isv) *(f32x4*)(UT + (size_t)col * 64 + 16 * bb + 4 * fq) = xacc[t];
                else {
#pragma unroll
                    for (int j = 0; j < 4; ++j) WN[(size_t)(16 * bb + 4 * fq + j) * 128 + (col - 128)] = (bf16)f2bf(-xacc[t][j]);
                }
            }
        }
    }
    __syncthreads(); GSTAMP(10);
    }
}
#undef GDNA_LOAD

__device__ __forceinline__ void gdnb_unit(const Params& P, LAS unsigned char* lds, int bh) {
    typedef float f32x4_ __attribute__((ext_vector_type(4)));
    const int tid = threadIdx.x, wid = __builtin_amdgcn_readfirstlane(tid >> 6), lane = tid & 63, fr = lane & 15, fq = lane >> 4;
    const int b = bh >> 2, h = bh & 3;
    const float* w_gnorm = P.in[14];
    const bf16* ZB = (const bf16*)(P.ws + WS_ZB); bf16* MIX = (bf16*)(P.ws + WS_MIX);
    LAS unsigned char* Wl = lds;
    LAS unsigned char* Ql = lds + 16384;
    LAS unsigned char* Kl = lds + 32768;
    LAS unsigned char* Ml = lds + 49152;
    LAS unsigned char* STl = lds + 57344;
    LAS unsigned char* VTl = lds + 90112;
    LAS float* OT = (LAS float*)(lds + 106496);
    f32x4_ S[8];
#pragma unroll
    for (int i = 0; i < 8; ++i) S[i] = (f32x4_){0.f, 0.f, 0.f, 0.f};
    const int e = 16 * wid + fr;
#pragma unroll
    for (int db = 0; db < 8; ++db) *(LAS v2u*)(STl + sw256(e, (16 * db + 4 * fq) >> 3) + ((4 * fq) & 7) * 2) = (v2u){0u, 0u};
    const int orow = tid >> 3, ocol = (tid & 7) * 16;
    LAS float* GNl = OT + 64 * XS;
    if (tid < 128) GNl[tid] = w_gnorm[tid];
    const size_t ubase = (size_t)bh * 32;
    v4u aW[2], aQ[2], aK[2], aM; f32x4_ utn[4]; float gln;
#define SCAN_LOAD(n_) do { const size_t un_ = ubase + (n_); \
        const v4u* WNp = (const v4u*)((const bf16*)(P.ws + WS_WN) + un_ * 8192); const v4u* QGp = (const v4u*)((const bf16*)(P.ws + WS_QG) + un_ * 8192); \
        const v4u* KGp = (const v4u*)((const bf16*)(P.ws + WS_KGT) + un_ * 8192); const v4u* QKp = (const v4u*)((const bf16*)(P.ws + WS_QKM) + un_ * 4096); \
        const float* UTp = (const float*)(P.ws + WS_UT) + un_ * 8192; gln = ((const float*)(P.ws + WS_GL))[un_]; \
        aW[0] = WNp[tid]; aW[1] = WNp[tid + 512]; aQ[0] = QGp[tid]; aQ[1] = QGp[tid + 512]; aK[0] = KGp[tid]; aK[1] = KGp[tid + 512]; aM = QKp[tid]; \
        _Pragma("unroll") for (int rb_ = 0; rb_ < 4; ++rb_) utn[rb_] = *(const f32x4_*)(UTp + (size_t)e * 64 + 16 * rb_ + 4 * fq); } while (0)
#define SCAN_STAGE() do { \
        _Pragma("unroll") for (int i_ = 0; i_ < 2; ++i_) { const int idx_ = tid + 512 * i_; \
            *(LAS v4u*)(Wl + sw256(idx_ >> 4, idx_ & 15)) = aW[i_]; *(LAS v4u*)(Ql + sw256(idx_ >> 4, idx_ & 15)) = aQ[i_]; *(LAS v4u*)(Kl + sw128(idx_ >> 3, idx_ & 7)) = aK[i_]; } \
        *(LAS v4u*)(Ml + sw128(tid >> 3, tid & 7)) = aM; } while (0)
    SCAN_LOAD(0);
    SCAN_STAGE();
    for (int n = 0; n < NCHUNK; ++n) {
        __syncthreads();
        f32x4_ vn[4];
#pragma unroll
        for (int rb = 0; rb < 4; ++rb) vn[rb] = utn[rb];
        const size_t mrow = (size_t)b * SEQ + n * GCH + orow;
        const v4u z0 = *(const v4u*)(ZB + mrow * 512 + h * 128 + ocol), z1 = *(const v4u*)(ZB + mrow * 512 + h * 128 + ocol + 8);
        const float gl = gln;
        if (n + 1 < NCHUNK) SCAN_LOAD(n + 1);
        __builtin_amdgcn_sched_barrier(0);
        bf16x8 sb[4];
#pragma unroll
        for (int ks = 0; ks < 4; ++ks) sb[ks] = *(const LAS bf16x8*)(STl + sw256(e, 4 * ks + fq));
#pragma unroll
        for (int rb = 0; rb < 4; ++rb) {
#pragma unroll
            for (int ks = 0; ks < 4; ++ks) { const bf16x8 a = *(const LAS bf16x8*)(Wl + sw256(16 * rb + fr, 4 * ks + fq)); vn[rb] = __builtin_amdgcn_mfma_f32_16x16x32_bf16(a, sb[ks], vn[rb], 0, 0, 0); }
            v2u o; o.x = pk2(vn[rb][0], vn[rb][1]); o.y = pk2(vn[rb][2], vn[rb][3]);
            *(LAS v2u*)(VTl + sw128(e, (16 * rb + 4 * fq) >> 3) + ((4 * fq) & 7) * 2) = o;
        }
        bf16x8 vb[2];
#pragma unroll
        for (int ks = 0; ks < 2; ++ks) vb[ks] = *(const LAS bf16x8*)(VTl + sw128(e, 4 * ks + fq));
#pragma unroll
        for (int rb = 0; rb < 4; ++rb) {
            f32x4_ oo = (f32x4_){0.f, 0.f, 0.f, 0.f};
#pragma unroll
            for (int ks = 0; ks < 4; ++ks) { const bf16x8 a = *(const LAS bf16x8*)(Ql + sw256(16 * rb + fr, 4 * ks + fq)); oo = __builtin_amdgcn_mfma_f32_16x16x32_bf16(a, sb[ks], oo, 0, 0, 0); }
#pragma unroll
            for (int ks = 0; ks < 2; ++ks) { const bf16x8 a = *(const LAS bf16x8*)(Ml + sw128(16 * rb + fr, 4 * ks + fq)); oo = __builtin_amdgcn_mfma_f32_16x16x32_bf16(a, vb[ks], oo, 0, 0, 0); }
#pragma unroll
            for (int j = 0; j < 4; ++j) OT[(16 * rb + 4 * fq + j) * XS + e] = oo[j];
        }
#pragma unroll
        for (int db = 0; db < 8; ++db) {
            S[db] = S[db] * gl;
#pragma unroll
            for (int ks = 0; ks < 2; ++ks) { const bf16x8 a = *(const LAS bf16x8*)(Kl + sw128(16 * db + fr, 4 * ks + fq)); S[db] = __builtin_amdgcn_mfma_f32_16x16x32_bf16(a, vb[ks], S[db], 0, 0, 0); }
            v2u o; o.x = pk2(S[db][0], S[db][1]); o.y = pk2(S[db][2], S[db][3]);
            *(LAS v2u*)(STl + sw256(e, (16 * db + 4 * fq) >> 3) + ((4 * fq) & 7) * 2) = o;
        }
        __syncthreads();
        if (n + 1 < NCHUNK) SCAN_STAGE();
        {
            f32x4_ ov[4]; float ss = 0.f;
#pragma unroll
            for (int i = 0; i < 4; ++i) { ov[i] = *(const LAS f32x4_*)(OT + orow * XS + ocol + 4 * i); ss += (ov[i][0] * ov[i][0] + ov[i][1] * ov[i][1]) + (ov[i][2] * ov[i][2] + ov[i][3] * ov[i][3]); }
            ss += __shfl_xor(ss, 1); ss += __shfl_xor(ss, 2); ss += __shfl_xor(ss, 4);
            const float rstd = 1.0f / sqrtf(ss * (1.0f / 128.0f) + RMS_EPS);
            f32x4_ gn4[4];
#pragma unroll
            for (int i = 0; i < 4; ++i) gn4[i] = *(const LAS f32x4_*)(GNl + ocol + 4 * i);
            const unsigned zw[8] = {z0.x, z0.y, z0.z, z0.w, z1.x, z1.y, z1.z, z1.w};
            unsigned ow[8];
#pragma unroll
            for (int i = 0; i < 8; ++i) { const float za = __builtin_bit_cast(float, zw[i] << 16), zb = __builtin_bit_cast(float, zw[i] & 0xffff0000u);
                const float va = ov[i >> 1][(2 * i) & 3] * rstd * gn4[i >> 1][(2 * i) & 3] * silu_f(za), vb_ = ov[i >> 1][(2 * i + 1) & 3] * rstd * gn4[i >> 1][(2 * i + 1) & 3] * silu_f(zb);
                ow[i] = pk2(va, vb_); }
            bf16* mp = MIX + mrow * DM + 512 + h * 128 + ocol;
            *(v4u*)mp = (v4u){ow[0], ow[1], ow[2], ow[3]}; *(v4u*)(mp + 8) = (v4u){ow[4], ow[5], ow[6], ow[7]};
        }
        asm volatile("" : "+v"(utn[0]), "+v"(utn[1]), "+v"(utn[2]), "+v"(utn[3]), "+v"(gln));
    }
#undef SCAN_LOAD
#undef SCAN_STAGE
    float* So = P.out + OSSM_P + (size_t)bh * 16384;
#pragma unroll
    for (int db = 0; db < 8; ++db)
#pragma unroll
        for (int j = 0; j < 4; ++j) So[(size_t)(16 * db + 4 * fq + j) * 128 + e] = S[db][j];
    __syncthreads();
}


__device__ __forceinline__ f32x4 sgemm_slice16(const bf16* A, int lda, const bf16* Bt, int ldb, int n0, int k0, int k1, int wid, int fr, int fq) {
    f32x4 acc = {0.f, 0.f, 0.f, 0.f};
    const bf16* ap = A + (size_t)(16 * wid + fr) * lda + 8 * fq;
    const bf16* bp = Bt + (size_t)(n0 + fr) * ldb + 8 * fq;
#pragma unroll 16
    for (int ks = k0; ks < k1; ks += 32) {
        const bf16x8 a = *(const bf16x8*)(ap + ks), b = *(const bf16x8*)(bp + ks);
        acc = __builtin_amdgcn_mfma_f32_16x16x32_bf16(b, a, acc, 0, 0, 0);
    }
    return acc;
}
__device__ __forceinline__ void sample_wo_slice(const Params& P, int slice) {
    const int tid = threadIdx.x, wid = __builtin_amdgcn_readfirstlane(tid >> 6), lane = tid & 63, fr = lane & 15, fq = lane >> 4;
    const bf16* MIX = (const bf16*)(P.ws + WS_MIX) + (size_t)MP * DM; const bf16* WOT = (const bf16*)(P.ws + WS_WOT);
    bf16* HB = (bf16*)(P.ws + WS_HB) + (size_t)MP * DM; float* SSQS = (float*)(P.ws + WS_SSQS);
    const f32x4 acc = sgemm_slice16(MIX, DM, WOT, DM, 16 * slice, 0, DM, wid, fr, fq);
    const int m = 16 * wid + fr, n = 16 * slice + 4 * fq;
    const f32x4 h = acc + *(const f32x4*)(P.in[1] + (size_t)m * DM + n);
    *(f32x4*)(P.out + OY_S + (size_t)m * DM + n) = h;
    v2u o; o.x = pk2(h[0], h[1]); o.y = pk2(h[2], h[3]); *(v2u*)(HB + (size_t)m * DM + n) = o;
    float s = (h[0] * h[0] + h[1] * h[1]) + (h[2] * h[2] + h[3] * h[3]);
    s += __shfl_xor(s, 16); s += __shfl_xor(s, 32);
    if (fq == 0) SSQS[m * 64 + slice] = s;
}
__device__ __forceinline__ void sample_up_slice(const Params& P, int slice) {
    const int tid = threadIdx.x, wid = __builtin_amdgcn_readfirstlane(tid >> 6), lane = tid & 63, fr = lane & 15, fq = lane >> 4;
    const bf16* HB = (const bf16*)(P.ws + WS_HB) + (size_t)MP * DM; const bf16* WUPT = (const bf16*)(P.ws + WS_WUPT);
    bf16* UB = (bf16*)(P.ws + WS_UB) + (size_t)MP * FF; const float* SSQS = (const float*)(P.ws + WS_SSQS);
    const int m = 16 * wid + fr, n = 16 * slice + 4 * fq;
    float ss = 0.f;
#pragma unroll
    for (int i = 0; i < 4; ++i) { const f32x4 t = *(const f32x4*)(SSQS + m * 64 + 16 * fq + 4 * i); ss += (t[0] + t[1]) + (t[2] + t[3]); }
    ss += __shfl_xor(ss, 16); ss += __shfl_xor(ss, 32);
    const float rstd = 1.0f / sqrtf(ss * (1.0f / DM) + RMS_EPS);
    const f32x4 acc = sgemm_slice16(HB, DM, WUPT, DM, 16 * slice, 0, DM, wid, fr, fq);
    float u[4];
#pragma unroll
    for (int j = 0; j < 4; ++j) { const float p = fmaxf(acc[j] * rstd, 0.f); u[j] = p * p; }
    v2u o; o.x = pk2(u[0], u[1]); o.y = pk2(u[2], u[3]); *(v2u*)(UB + (size_t)m * FF + n) = o;
}
__device__ __forceinline__ void sample_down_slice(const Params& P, int item) {
    const int tid = threadIdx.x, wid = __builtin_amdgcn_readfirstlane(tid >> 6), lane = tid & 63, fr = lane & 15, fq = lane >> 4;
    const bf16* UB = (const bf16*)(P.ws + WS_UB) + (size_t)MP * FF; const bf16* WDNT = (const bf16*)(P.ws + WS_WDNT);
    float* PART = (float*)(P.ws + WS_PART);
    const int slice = item & 63, q = item >> 6;
    const f32x4 acc = sgemm_slice16(UB, FF, WDNT, FF, 16 * slice, 1024 * q, 1024 * q + 1024, wid, fr, fq);
    const int m = 16 * wid + fr, n = 16 * slice + 4 * fq;
    *(f32x4*)(PART + ((size_t)q * DECB + m) * DM + n) = acc;
}

__device__ __forceinline__ void phase_final(const Params& P, const Ctx& C) {
    const float* ln_f = P.in[19]; const float* SSQ2 = (const float*)(P.ws + WS_SSQ2);
    const int gw = C.vcu * NWAVES + C.wave, NGW = C.G * NWAVES, lane = C.lane;
    f32x4 lw[4];
#pragma unroll
    for (int j = 0; j < 4; ++j) lw[j] = ((const f32x4*)ln_f)[lane + 64 * j];
    for (int m = gw; m < M_TOT; m += NGW) {
        if (m < MP) {
            const f32x4* sp = (const f32x4*)(SSQ2 + (size_t)m * 16);
            const f32x4 a = sp[0], b = sp[1], c = sp[2], d = sp[3];
            const float ss = ((a[0] + a[1]) + (a[2] + a[3])) + ((b[0] + b[1]) + (b[2] + b[3])) + ((c[0] + c[1]) + (c[2] + c[3])) + ((d[0] + d[1]) + (d[2] + d[3]));
            const float rstd = 1.0f / sqrtf(ss * (1.0f / DM) + RMS_EPS);
            float* yr = P.out + OY_P + (size_t)m * DM;
#pragma unroll
            for (int j = 0; j < 4; ++j) { f32x4 v = ((const f32x4*)yr)[lane + 64 * j]; v = v * rstd * lw[j]; ((f32x4*)yr)[lane + 64 * j] = v; }
        } else {
            const int r = m - MP; float* yr = P.out + OY_S + (size_t)r * DM; const float* PART = (const float*)(P.ws + WS_PART);
            f32x4 v[4]; float ss = 0.f;
#pragma unroll
            for (int j = 0; j < 4; ++j) { v[j] = ((const f32x4*)yr)[lane + 64 * j];
#pragma unroll
                for (int q = 0; q < 4; ++q) v[j] += ((const f32x4*)(PART + ((size_t)q * DECB + r) * DM))[lane + 64 * j];
                ss += (v[j][0] * v[j][0] + v[j][1] * v[j][1]) + (v[j][2] * v[j][2] + v[j][3] * v[j][3]); }
            ss = wave_sum(ss);
            const float rstd = 1.0f / sqrtf(ss * (1.0f / DM) + RMS_EPS);
#pragma unroll
            for (int j = 0; j < 4; ++j) ((f32x4*)yr)[lane + 64 * j] = v[j] * rstd * lw[j];
        }
    }
}

constexpr int NPHASES = 8;
__global__ void __launch_bounds__(NWAVES * 64, 2) fwd_kernel(Params P) {
    extern __shared__ __attribute__((aligned(16))) unsigned char shm[];
    LAS unsigned char* lds = (LAS unsigned char*)shm;
    Ctx C; C.tid = threadIdx.x; C.lane = C.tid & 63; C.wave = __builtin_amdgcn_readfirstlane(C.tid >> 6);
    C.G = gridDim.x; { const int bx = blockIdx.x; C.vcu = (C.G % 8 == 0) ? (bx % 8) * (C.G / 8) + bx / 8 : bx; }
    volatile LAS unsigned* MISC = (volatile LAS unsigned*)(lds + MISC_OFF);
    if (C.tid < 64) MISC[C.tid] = 0u;
    __syncthreads();
    unsigned* ctl = (unsigned*)(P.ws + WS_CTL);
    const int lo = P.ph_lo, hi = P.ph_hi;
    XcdBarrier bar; bar.bar = ctl + CW_BAR; bar.x = 0; bar.st = nullptr;
    if (hi - lo > 1) bar = xcd_barrier_post(ctl + CW_BAR, MISC + 8);
#ifndef REPEAT_MASK
#define REPEAT_MASK 0
#endif
#define NREP(k) (((REPEAT_MASK >> (k)) & 1) ? 2 : 1)
#ifndef SUBMASK
#define SUBMASK 15
#endif
#ifndef PHASE_MASK
#define PHASE_MASK 0xff
#endif
#define IN(k) (((PHASE_MASK >> (k)) & 1) && lo <= (k) && (k) < hi)
#if 0
#define PROBE_K -1
#endif
#define PROBE_MULT 4
#define STAMP(j) do { if (PROBE_K >= 0 && blockIdx.x == 0 && C.tid == 0) { const unsigned long long t_ = __builtin_amdgcn_s_memrealtime(); MISC[16 + 2 * (j)] = (unsigned)t_; MISC[17 + 2 * (j)] = (unsigned)(t_ >> 32); } } while (0)
#define RSTAMP(id, who) do { if (PROBE_K >= 10 && C.vcu == (who) && C.tid == 0) { const unsigned long long t_ = __builtin_amdgcn_s_memrealtime(); __hip_atomic_store(ctl + 512 + 2 * (id), (unsigned)t_, __ATOMIC_RELAXED, __HIP_MEMORY_SCOPE_AGENT); __hip_atomic_store(ctl + 513 + 2 * (id), (unsigned)(t_ >> 32), __ATOMIC_RELAXED, __HIP_MEMORY_SCOPE_AGENT); } } while (0)
#define SEAM(k) do { if (IN(k) && IN((k) + 1)) xcd_barrier(bar); STAMP((k) + 1); } while (0)
    unsigned char* ws = P.ws;
    STAMP(0);

    if (IN(0)) { for (int rep = 0; rep < NREP(0); ++rep) phase_prep(P, C, lds); SEAM(0); }

    if (IN(1)) {
        if (C.wave == 0) for (int bh = C.vcu; bh < NB * NH; bh += C.G) kbias_seq(P, bh, C.lane);
        for (int rep = 0; rep < NREP(1); ++rep) {
        pg8::Gemm g{(const pg8::bf16_t*)(ws + WS_XN), (const pg8::bf16_t*)(ws + WS_W1T), M_PAD, N1, DM};
        pg8::StaticOrder S; S.init(M_PAD, N1, C.G, (int)blockIdx.x);
        pg8::EpiIn E{(pg8::bf16_t*)(ws + WS_QB), (float*)(ws + WS_QS), (pg8::bf16_t*)(ws + WS_CB), (pg8::bf16_t*)(ws + WS_ZB), P.out};
        pg8::gemm_phase<pg8::EpiIn, pg8::StaticOrder, true, true>(lds, g, S, E);
        }
        SEAM(1);
    }

    if (IN(2)) {
#if SUBMASK & 8
        gdna_units(P, lds, C.vcu, C.G, NREP(5) * NB * NH * NCHUNK);
#endif
        SEAM(2);
    }

    if (IN(3)) {
        for (int it = C.vcu; it < 256; it += C.G) { const int xg = it >> 5, slot = it & 31; if (slot < 4) { for (int rep = 0; rep < NREP(6); ++rep) gdnb_unit(P, lds, xg * 4 + slot); } }
        RSTAMP(0, 0);
#if SUBMASK & 1
        for (int it = C.vcu; it < 256; it += C.G) {
            const int xg = it >> 5, slot = it & 31;
            if (slot < 4 || slot >= 16) continue;
            const int j = slot - 4, bh = xg * 4 + j / 3, g = j % 3, b = bh >> 2, h = bh & 3;
            const bf16* Qh = (const bf16*)(ws + WS_QB) + (size_t)bh * SEQ * HD; const bf16* Kh = (const bf16*)(ws + WS_KB) + (size_t)bh * SEQ * HD; const bf16* Vh = (const bf16*)(ws + WS_VB) + (size_t)bh * SEQ * HD;
            const float* kbias = (const float*)(ws + WS_KBIAS) + (size_t)bh * SEQ;
            bf16* Orow0 = (bf16*)(ws + WS_MIX) + (size_t)b * SEQ * DM + h * HD;
            const int nblk = (g == 2 ? 4 : 2) * NREP(2);
            for (int k2 = 0; k2 < nblk; ++k2) { const int k = k2 & 3; const int qb = g == 0 ? ((k & 1) == 0 ? 7 : 3) : (g == 1 ? ((k & 1) == 0 ? 6 : 4) : (k == 0 ? 5 : 3 - k)); fox::fox_block((char*)shm, Qh, Kh, Vh, kbias, Orow0, qb); }
        }
        RSTAMP(1, 4); RSTAMP(2, 6);
#endif
#if SUBMASK & 2
        for (int it = C.vcu; it < NREP(3) * 256; it += C.G) { const int xg = (it & 255) >> 5, slot = it & 31; if (slot >= 16) decode_unit(P, lds, xg * 16 + (slot - 16)); }
        RSTAMP(3, 16);
#endif
#if SUBMASK & 4
        for (int it = C.vcu; it < 256; it += C.G) { const int xg = it >> 5, slot = it & 31; if (slot >= 16) sgdn_unit(P, lds, xg * 16 + (slot - 16)); }
        RSTAMP(4, 16);
#endif
        SEAM(3);
    }

    if (IN(4)) {
        for (int rep = 0; rep < NREP(9); ++rep) for (int it = blockIdx.x; it < 64; it += C.G) sample_wo_slice(P, it);
        pg8::Gemm g{(const pg8::bf16_t*)(ws + WS_MIX), (const pg8::bf16_t*)(ws + WS_WOT), MP, DM, DM};
        pg8::StaticOrder S; S.init(MP, DM, C.G, (int)blockIdx.x);
        pg8::EpiRes E{P.in[0], (float*)(ws + WS_HF), (pg8::bf16_t*)(ws + WS_HB), (float*)(ws + WS_SSQ)};
        pg8::gemm_phase<pg8::EpiRes, pg8::StaticOrder, true, true>(lds, g, S, E);
#if (REPEAT_MASK >> 7) & 1
        pg8::gemm_phase<pg8::EpiRes, pg8::StaticOrder, true, true>(lds, g, S, E);
#endif
        SEAM(4);
    }

    if (IN(5)) {
        for (int rep = 0; rep < NREP(10); ++rep) for (int it = blockIdx.x; it < 256; it += C.G) sample_up_slice(P, it);
        pg8::Gemm g{(const pg8::bf16_t*)(ws + WS_HB), (const pg8::bf16_t*)(ws + WS_WUPT), MP, FF, DM};
        pg8::StaticOrder S; S.init(MP, FF, C.G, (int)blockIdx.x);
        pg8::EpiUp E{(pg8::bf16_t*)(ws + WS_UB), (const float*)(ws + WS_SSQ)};
        pg8::gemm_phase<pg8::EpiUp, pg8::StaticOrder, true, true>(lds, g, S, E);
#if (REPEAT_MASK >> 8) & 1
        pg8::gemm_phase<pg8::EpiUp, pg8::StaticOrder, true, true>(lds, g, S, E);
#endif
        SEAM(5);
    }

    if (IN(6)) {
        for (int rep = 0; rep < NREP(11); ++rep) for (int it = blockIdx.x; it < 256; it += C.G) sample_down_slice(P, it);
        pg8::Gemm g{(const pg8::bf16_t*)(ws + WS_UB), (const pg8::bf16_t*)(ws + WS_WDNT), MP, DM, FF};
        pg8::StaticOrder S; S.init(MP, DM, C.G, (int)blockIdx.x);
        pg8::EpiDown E{(const float*)(ws + WS_HF), P.out, (float*)(ws + WS_SSQ2)};
        pg8::gemm_phase<pg8::EpiDown, pg8::StaticOrder, true, true>(lds, g, S, E);
#if (REPEAT_MASK >> 12) & 1
        pg8::gemm_phase<pg8::EpiDown, pg8::StaticOrder, true, true>(lds, g, S, E);
#endif
        SEAM(6);
    }

    if (IN(7)) phase_final(P, C);
    if (PROBE_K >= 0 && blockIdx.x == 0 && C.tid == 0) {
        STAMP(8);
        unsigned long long t0, t1;
        if (PROBE_K >= 10) { const int sb_ = (PROBE_K - 10 >= 5) ? 2 : 3; t0 = ((unsigned long long)MISC[17 + 2 * sb_] << 32) | MISC[16 + 2 * sb_];
            t1 = ((unsigned long long)__hip_atomic_load(ctl + 513 + 2 * (PROBE_K - 10), __ATOMIC_RELAXED, __HIP_MEMORY_SCOPE_AGENT) << 32) | __hip_atomic_load(ctl + 512 + 2 * (PROBE_K - 10), __ATOMIC_RELAXED, __HIP_MEMORY_SCOPE_AGENT); }
        else { t0 = ((unsigned long long)MISC[17 + 2 * (PROBE_K < 10 ? PROBE_K : 0)] << 32) | MISC[16 + 2 * (PROBE_K < 10 ? PROBE_K : 0)]; t1 = ((unsigned long long)MISC[19 + 2 * (PROBE_K < 10 ? PROBE_K : 0)] << 32) | MISC[18 + 2 * (PROBE_K < 10 ? PROBE_K : 0)]; }
        const unsigned long long until = __builtin_amdgcn_s_memrealtime() + PROBE_MULT * (t1 - t0);
        while (__builtin_amdgcn_s_memrealtime() < until) __builtin_amdgcn_s_sleep(8);
    }
#undef IN
#undef SEAM
}

#ifndef N_LAUNCH_MODE
#define N_LAUNCH_MODE 1
#endif
extern "C" void kernel_launch(void* const* d_in, const int* in_sizes, int n_in, void* d_out, int out_size, void* d_ws, size_t ws_size, hipStream_t stream) {
    static int grid = 0;
    if (grid == 0) {
        if (n_in != 20 || out_size != (int)OUT_TOTAL || ws_size < WS_END) { fprintf(stderr, "kernel_launch: unexpected shapes (n_in %d, out %d, ws %zu); nothing launched\n", n_in, out_size, ws_size); grid = -1; return; }
        int dev = 0, cus = 0, per_cu = 0;
        if (hipGetDevice(&dev) != hipSuccess || hipDeviceGetAttribute(&cus, hipDeviceAttributeMultiprocessorCount, dev) != hipSuccess) { grid = -1; return; }
        if (hipFuncSetAttribute((const void*)fwd_kernel, hipFuncAttributeMaxDynamicSharedMemorySize, LDS_BYTES) != hipSuccess) { fprintf(stderr, "kernel_launch: hipFuncSetAttribute failed\n"); grid = -1; return; }
        if (hipOccupancyMaxActiveBlocksPerMultiprocessor(&per_cu, (const void*)fwd_kernel, NWAVES * 64, LDS_BYTES) != hipSuccess || per_cu < 1)
            fprintf(stderr, "kernel_launch: note: occupancy query reports %d workgroups per CU\n", per_cu);
        (void)hipGetLastError();
        grid = cus;
    }
    if (grid < 0) return;
    if (hipMemsetAsync((char*)d_ws + WS_CTL, 0, CTL_ZERO_BYTES, stream) != hipSuccess) return;
    Params p{};
    for (int i = 0; i < 20; ++i) p.in[i] = (const float*)d_in[i];
    p.out = (float*)d_out; p.ws = (unsigned char*)d_ws;
    if (N_LAUNCH_MODE == 1) {
        p.ph_lo = 0; p.ph_hi = NPHASES;
        hipLaunchKernelGGL(fwd_kernel, dim3(grid), dim3(NWAVES * 64), LDS_BYTES, stream, p);
    } else {
        for (int k = 0; k < NPHASES; ++k) { p.ph_lo = k; p.ph_hi = k + 1; hipLaunchKernelGGL(fwd_kernel, dim3(grid), dim3(NWAVES * 64), LDS_BYTES, stream, p); }
    }
}
```

```cpp
#include <hip/hip_runtime.h>
#include <hip/hip_bf16.h>
#include <cstdio>
#include <cstdint>

constexpr int DM = 1024, NB = 8, SEQ = 2048, DECB = 128, PAST = 2048, PAGE = 128, NPAGES = 16;
constexpr int NH = 4, HD = 128, CONVD = 1536, FF = 4096, INDIM = 3596, GCH = 64, NCHUNK = SEQ / GCH;
constexpr int MP = NB * SEQ;
constexpr int M_TOT = MP + DECB;
constexpr int M_PAD = 16640;
constexpr int N1 = 3584;
constexpr float RMS_EPS = 1e-6f, L2_EPS = 1e-6f;
constexpr float ATT_SCALE = 0.08838834764831845f;
constexpr size_t OY_P = 0, OY_S = 16777216, OK_P = 16908288, OV_P = 25296896, OLF_P = 33685504, OCONV_P = 33751040, OSSM_P = 33787904,
                 OK_S = 34312192, OV_S = 34377728, OLF_S = 34443264, OCONV_S = 34443776, OSSM_S = 35033600, OUT_TOTAL = 43422208;
constexpr size_t MiB = 1u << 20;
constexpr size_t WS_CTL = 0, CTL_ZERO_BYTES = 1 * MiB;
constexpr size_t WS_W1T = 2 * MiB, WS_WOT = 10 * MiB, WS_WUPT = 12 * MiB, WS_WDNT = 21 * MiB;
constexpr size_t WS_XN = 32 * MiB, WS_QB = 68 * MiB, WS_KB = 84 * MiB, WS_VB = 100 * MiB, WS_CB = 116 * MiB, WS_ZB = 166 * MiB;
constexpr size_t WS_MIX = 184 * MiB, WS_HB = 218 * MiB, WS_UB = 252 * MiB;
constexpr size_t WS_UT = 384 * MiB, WS_WN = 416 * MiB, WS_QG = 432 * MiB, WS_KGT = 448 * MiB, WS_QKM = 464 * MiB;
constexpr size_t WS_LF = 472 * MiB, WS_BETA = 473 * MiB, WS_G = 474 * MiB, WS_KBIAS = 475 * MiB, WS_QS = 476 * MiB, WS_SSQ = 477 * MiB, WS_SSQ2 = 479 * MiB, WS_GL = 481 * MiB, WS_SSQS = 482 * MiB, WS_PART = 483 * MiB;
constexpr size_t WS_HF = 32 * MiB;
static_assert(WS_HF + (size_t)MP * DM * 4 <= WS_CB, "h overlays dead buffers only");
constexpr size_t WS_END = 486 * MiB;
constexpr int CW_TMO = 0, CW_BAR = 4096;
constexpr size_t QKV_STRIDE = (WS_KB - WS_QB) / 2;
static_assert(WS_VB - WS_KB == WS_KB - WS_QB, "q/k/v copies equally spaced");

namespace pg8 {
#define PG8_LAS __attribute__((address_space(3)))
typedef unsigned short bf16_t;
typedef short bf16x8 __attribute__((ext_vector_type(8)));
typedef float f32x4 __attribute__((ext_vector_type(4)));
typedef unsigned u32x4 __attribute__((ext_vector_type(4)));
constexpr int BM = 256, BK = 64, HALF = 128, HTB = HALF * BK * 2  , STAGE_BYTES = 8 * HTB, NXCD = 8, WGM = 8;

__host__ __device__ __forceinline__ int lds_byte(int r, int c) { const int st = (r >> 4) * 2 + (c >> 5), rr = r & 15, cc = c & 31, ob = rr * 64 + cc * 2; return st * 1024 + (ob ^ (((ob >> 9) & 1) << 5)); }
__host__ __device__ __forceinline__ void stage_rc(int b, int& R, int& C) { const int st = b / 1024, sb = b % 1024, swz = sb ^ (((sb >> 9) & 1) << 5); R = (st >> 1) * 16 + swz / 64; C = (st & 1) * 32 + (swz % 64) / 2; }
__host__ __device__ __forceinline__ int perm32(int rho) { const int n = rho >> 4, i = rho & 15; return 8 * (i >> 2) + 4 * n + (i & 3); }

struct Unit { int pm, pn; };
struct Gemm { const bf16_t* A; const bf16_t* Bt; int M, N, K; };

struct StaticOrder {
    int nM, nN, nwg, G, c;
    __host__ __device__ void init(int M, int N, int G_, int c_) { nM = M / BM; nN = N / BM; nwg = nM * nN; G = G_; c = c_; }
    __host__ __device__ bool next(int i, Unit& u) const {
        const long L = (long)i * G + c; if (L >= nwg) return false;
        int wgid = (int)L; { const int q = nwg / NXCD, r = nwg % NXCD, xcd = wgid % NXCD, off = wgid / NXCD; wgid = (xcd < r ? xcd * (q + 1) : r * (q + 1) + (xcd - r) * q) + off; }
        const int nig = WGM * nN, gid = wgid / nig, fm = gid * WGM, gsz = (nM - fm) < WGM ? (nM - fm) : WGM;
        u.pm = fm + ((wgid % nig) % gsz); u.pn = (wgid % nig) / gsz; return true;
    }
    __device__ __forceinline__ void a_ready(const Unit&) const {}
    __device__ __forceinline__ void done(const Unit&) const {}
};
__device__ __forceinline__ unsigned cvt_pk_bf16(float lo, float hi) { unsigned r; asm volatile("v_cvt_pk_bf16_f32 %0, %1, %2" : "=v"(r) : "v"(lo), "v"(hi)); return r; }
typedef float f32x2 __attribute__((ext_vector_type(2)));
__device__ __forceinline__ u32x4 pack8_bf16(f32x4 v0, f32x4 v1) { u32x4 w; w.x = cvt_pk_bf16(v0[0], v0[1]); w.y = cvt_pk_bf16(v0[2], v0[3]); w.z = cvt_pk_bf16(v1[0], v1[1]); w.w = cvt_pk_bf16(v1[2], v1[3]); return w; }

struct EpiIn {
    static constexpr bool PERM = true, AFTER_DRAIN = false;
    bf16_t* QB;
    float* QS;
    bf16_t* CB;
    bf16_t* ZB;
    float* out;
    __device__ __forceinline__ void operator()(const f32x4 (&acc)[2][2][4][2], const Unit& u, int wr, int wc, int fr, int fq) const {
        const int pn = u.pn;
#pragma unroll
        for (int ai = 0; ai < 2; ++ai)
#pragma unroll
            for (int m = 0; m < 4; ++m) {
                const int row = u.pm * BM + ai * HALF + wr * 64 + m * 16 + fr;
                if (row >= M_TOT) continue;
#pragma unroll
                for (int bj = 0; bj < 2; ++bj) {
                    const int col = pn * BM + bj * HALF + wc * 32 + 8 * fq;
                    const f32x4 v0 = acc[ai][bj][m][0], v1 = acc[ai][bj][m][1];
                    if (pn < 6) {
                        const int seg = pn >> 1, c = col - seg * 512, h = c >> 7, d = c & 127;
                        if (row < MP) {
                            const int b = row >> 11, t = row & 2047;
                            const size_t idx = ((size_t)((b * NH + h) * SEQ + t)) * HD + d;
                            *(u32x4*)(QB + (size_t)seg * QKV_STRIDE + idx) = pack8_bf16(v0, v1);
                            if (seg != 0) { float* o = out + OK_P + (size_t)(seg - 1) * (OV_P - OK_P) + (size_t)row * 512 + c; *(f32x4*)o = v0; *(f32x4*)(o + 4) = v1; }
                        } else {
                            const int db = row - MP;
                            if (seg == 0) { float* o = QS + (size_t)db * 512 + c; *(f32x4*)o = v0; *(f32x4*)(o + 4) = v1; }
                            else { float* o = out + OK_S + (size_t)(seg - 1) * (OV_S - OK_S) + (size_t)db * 512 + c; *(f32x4*)o = v0; *(f32x4*)(o + 4) = v1; }
                        }
                    } else if (pn < 12) {
                        const int c = col - 1536;
                        *(u32x4*)(CB + (size_t)row * CONVD + c) = pack8_bf16(v0, v1);
                        if (row < MP) {
                            const int t = row & 2047;
                            if (t >= SEQ - 3) { float* o = out + OCONV_P + ((size_t)(row >> 11) * 3 + (t - (SEQ - 3))) * CONVD + c; *(f32x4*)o = v0; *(f32x4*)(o + 4) = v1; }
                        } else {
                            float* o = out + OCONV_S + ((size_t)(row - MP) * 3 + 2) * CONVD + c; *(f32x4*)o = v0; *(f32x4*)(o + 4) = v1;
                        }
                    } else {
                        const int c = col - 3072;
                        *(u32x4*)(ZB + (size_t)row * 512 + c) = pack8_bf16(v0, v1);
                    }
                }
            }
    }
};

struct EpiRes {
    static constexpr bool PERM = true, AFTER_DRAIN = false;
    const float* xp; float* HF; bf16_t* HB; float* SSQ;
    __device__ __forceinline__ void operator()(const f32x4 (&acc)[2][2][4][2], const Unit& u, int wr, int wc, int fr, int fq) const {
#pragma unroll
        for (int ai = 0; ai < 2; ++ai)
#pragma unroll
            for (int m = 0; m < 4; ++m) {
                const int row = u.pm * BM + ai * HALF + wr * 64 + m * 16 + fr;
                const bool ok = row < MP;
                const float* xr = xp + (size_t)(ok ? row : 0) * DM;
                float* hr = HF + (size_t)(ok ? row : 0) * DM;
                float s = 0.f;
#pragma unroll
                for (int bj = 0; bj < 2; ++bj) {
                    const int col = u.pn * BM + bj * HALF + wc * 32 + 8 * fq;
                    if (ok) {
                        const f32x4 v0 = acc[ai][bj][m][0] + *(const f32x4*)(xr + col), v1 = acc[ai][bj][m][1] + *(const f32x4*)(xr + col + 4);
                        *(f32x4*)(hr + col) = v0; *(f32x4*)(hr + col + 4) = v1;
                        *(u32x4*)(HB + (size_t)row * DM + col) = pack8_bf16(v0, v1);
                        s += (v0[0] * v0[0] + v0[1] * v0[1]) + (v0[2] * v0[2] + v0[3] * v0[3]) + (v1[0] * v1[0] + v1[1] * v1[1]) + (v1[2] * v1[2] + v1[3] * v1[3]);
                    }
                }
                s += __shfl_xor(s, 16); s += __shfl_xor(s, 32);
                if (ok && fq == 0) SSQ[(size_t)row * 16 + u.pn * 4 + wc] = s;
            }
    }
};

struct EpiUp {
    static constexpr bool PERM = true, AFTER_DRAIN = false;
    bf16_t* UB; const float* SSQ;
    __device__ __forceinline__ void operator()(const f32x4 (&acc)[2][2][4][2], const Unit& u, int wr, int wc, int fr, int fq) const {
#pragma unroll
        for (int ai = 0; ai < 2; ++ai)
#pragma unroll
            for (int m = 0; m < 4; ++m) {
                const int row = u.pm * BM + ai * HALF + wr * 64 + m * 16 + fr;
                if (row >= M_TOT) continue;
                const f32x4* sp = (const f32x4*)(SSQ + (size_t)row * 16);
                const f32x4 a = sp[0], b = sp[1], c = sp[2], d = sp[3];
                const float ss = ((a[0] + a[1]) + (a[2] + a[3])) + ((b[0] + b[1]) + (b[2] + b[3])) + ((c[0] + c[1]) + (c[2] + c[3])) + ((d[0] + d[1]) + (d[2] + d[3]));
                const float rstd = 1.0f / sqrtf(ss * (1.0f / DM) + RMS_EPS);
#pragma unroll
                for (int bj = 0; bj < 2; ++bj) {
                    const int col = u.pn * BM + bj * HALF + wc * 32 + 8 * fq;
                    f32x4 v0 = acc[ai][bj][m][0] * rstd, v1 = acc[ai][bj][m][1] * rstd;
#pragma unroll
                    for (int j = 0; j < 4; ++j) { const float p = fmaxf(v0[j], 0.f), q = fmaxf(v1[j], 0.f); v0[j] = p * p; v1[j] = q * q; }
                    *(u32x4*)(UB + (size_t)row * FF + col) = pack8_bf16(v0, v1);
                }
            }
    }
};

struct EpiDown {
    static constexpr bool PERM = true, AFTER_DRAIN = false;
    const float* HF; float* out; float* SSQ2;
    __device__ __forceinline__ void operator()(const f32x4 (&acc)[2][2][4][2], const Unit& u, int wr, int wc, int fr, int fq) const {
#pragma unroll
        for (int ai = 0; ai < 2; ++ai)
#pragma unroll
            for (int m = 0; m < 4; ++m) {
                const int row = u.pm * BM + ai * HALF + wr * 64 + m * 16 + fr;
                const bool ok = row < MP;
                const float* hr = HF + (size_t)(ok ? row : 0) * DM;
                float* yr = out + OY_P + (size_t)(ok ? row : 0) * DM;
                float s = 0.f;
#pragma unroll
                for (int bj = 0; bj < 2; ++bj) {
                    const int col = u.pn * BM + bj * HALF + wc * 32 + 8 * fq;
                    if (ok) {
                        const f32x4 v0 = acc[ai][bj][m][0] + *(const f32x4*)(hr + col), v1 = acc[ai][bj][m][1] + *(const f32x4*)(hr + col + 4);
                        *(f32x4*)(yr + col) = v0; *(f32x4*)(yr + col + 4) = v1;
                        s += (v0[0] * v0[0] + v0[1] * v0[1]) + (v0[2] * v0[2] + v0[3] * v0[3]) + (v1[0] * v1[0] + v1[1] * v1[1]) + (v1[2] * v1[2] + v1[3] * v1[3]);
                    }
                }
                s += __shfl_xor(s, 16); s += __shfl_xor(s, 32);
                if (ok && fq == 0) SSQ2[(size_t)row * 16 + u.pn * 4 + wc] = s;
            }
    }
};

template <class Epi, class Sched, bool ALIGN_EPI = false, bool SP2 = false>
__device__ __forceinline__ void gemm_phase(PG8_LAS unsigned char* lds, const Gemm g, const Sched& S, const Epi& E) {
    const int tid = threadIdx.x, wid = __builtin_amdgcn_readfirstlane(tid >> 6), lane = tid & 63, wr = wid >> 2, wc = wid & 3, fr = lane & 15, fq = lane >> 4;
    const int K = g.K, nt = K / BK;
    unsigned voffA[2], voffB[2];
#pragma unroll
    for (int i = 0; i < 2; ++i) { int R, C; stage_rc(tid * 16 + i * 8192, R, C); const int Rb = Epi::PERM ? ((R & ~31) + perm32(R & 31)) : R;
        voffA[i] = (unsigned)(R * K + C) * 2u; voffB[i] = (unsigned)(Rb * K + C) * 2u; }
    const size_t kstep = (size_t)(BK * 2);
    const size_t hstep = (size_t)HALF * K * 2;
    const size_t tstep = 2 * hstep;
    const unsigned ldsw = (unsigned)wid * 1024u;
    const int aoff = lds_byte(wr * 64 + fr, fq * 8), boff = lds_byte(wc * 32 + fr, fq * 8);
#define PG8_SA(b, h) (((b) * 2 + (h)) * HTB)
#define PG8_SB(b, h) ((4 + (b) * 2 + (h)) * HTB)
#define PG8_STAGE(bufoff, gbase, voff) do { _Pragma("unroll") for (int _i = 0; _i < 2; ++_i) \
        __builtin_amdgcn_global_load_lds((const unsigned*)((const char*)(gbase) + (voff)[_i]), (PG8_LAS unsigned*)(lds + (bufoff) + ldsw + _i * 8192), 16, 0, 0); } while (0)
#define PG8_LDA(dst, b, h) do { _Pragma("unroll") for (int m = 0; m < 4; ++m) _Pragma("unroll") for (int k = 0; k < 2; ++k) dst[m][k] = *(const PG8_LAS bf16x8*)(lds + PG8_SA(b, h) + aoff + m * 2048 + k * 1024); } while (0)
#define PG8_LDB(dst, b, h) do { _Pragma("unroll") for (int n = 0; n < 2; ++n) _Pragma("unroll") for (int k = 0; k < 2; ++k) dst[n][k] = *(const PG8_LAS bf16x8*)(lds + PG8_SB(b, h) + boff + n * 2048 + k * 1024); } while (0)
#define PG8_MMA(ai, bj, At, Bt) do { __builtin_amdgcn_s_setprio(1); _Pragma("unroll") for (int m = 0; m < 4; ++m) _Pragma("unroll") for (int n = 0; n < 2; ++n) _Pragma("unroll") for (int k = 0; k < 2; ++k) \
        acc[ai][bj][m][n] = __builtin_amdgcn_mfma_f32_16x16x32_bf16(Bt[n][k], At[m][k], acc[ai][bj][m][n], 0, 0, 0); __builtin_amdgcn_s_setprio(0); } while (0)
#define PG8_WAIT_V(n) asm volatile("s_waitcnt vmcnt(" #n ")" ::: "memory")
#define PG8_WAIT_L(n) asm volatile("s_waitcnt lgkmcnt(" #n ")" ::: "memory")
#define PG8_BAR __builtin_amdgcn_s_barrier()
#define PG8_SCHED __builtin_amdgcn_sched_barrier(0)
    Unit cur, nxt; int ui = 0;
    if (!S.next(0, cur)) return;
    f32x4 acc[2][2][4][2];
#pragma unroll
    for (int a = 0; a < 2; ++a)
#pragma unroll
        for (int b = 0; b < 2; ++b)
#pragma unroll
            for (int m = 0; m < 4; ++m)
#pragma unroll
                for (int n = 0; n < 2; ++n) acc[a][b][m][n] = (f32x4){0.f, 0.f, 0.f, 0.f};
    bf16x8 At[4][2], B0[2][2], B1[2][2];
    const char* cA = (const char*)g.A + (size_t)cur.pm * tstep; const char* cB = (const char*)g.Bt + (size_t)cur.pn * tstep;
    S.a_ready(cur);
    if constexpr (SP2) {
        PG8_STAGE(PG8_SB(0, 0), cB, voffB); PG8_STAGE(PG8_SB(0, 1), cB + hstep, voffB); PG8_STAGE(PG8_SA(0, 0), cA, voffA); PG8_STAGE(PG8_SA(0, 1), cA + hstep, voffA);
        if (wr == 1) PG8_BAR;
        PG8_WAIT_V(2); PG8_BAR;
        PG8_STAGE(PG8_SB(1, 0), cB + kstep, voffB); PG8_STAGE(PG8_SA(1, 0), cA + kstep, voffA); PG8_STAGE(PG8_SB(1, 1), cB + hstep + kstep, voffB);
        PG8_WAIT_V(6); PG8_BAR;
    } else {
        PG8_STAGE(PG8_SB(0, 0), cB, voffB); PG8_STAGE(PG8_SA(0, 0), cA, voffA); PG8_STAGE(PG8_SB(0, 1), cB + hstep, voffB); PG8_STAGE(PG8_SA(0, 1), cA + hstep, voffA);
        if (wr == 1) PG8_BAR;
        PG8_WAIT_V(4); PG8_BAR;
        PG8_STAGE(PG8_SB(1, 0), cB + kstep, voffB); PG8_STAGE(PG8_SA(1, 0), cA + kstep, voffA); PG8_STAGE(PG8_SB(1, 1), cB + hstep + kstep, voffB);
        PG8_WAIT_V(6); PG8_BAR;
    }
    for (;;) {
        const bool has_next = S.next(ui + 1, nxt);
        const char* nA = has_next ? (const char*)g.A + (size_t)nxt.pm * tstep : cA; const char* nB = has_next ? (const char*)g.Bt + (size_t)nxt.pn * tstep : cB;
        for (int t = 0; t < nt; t += 2) {
            const bool last = (t == nt - 2);
            const char* a1 = cA + (size_t)(t + 1) * kstep;
            const char* a2 = last ? nA : cA + (size_t)(t + 2) * kstep; const char* b2 = last ? nB : cB + (size_t)(t + 2) * kstep;
            const char* a3 = a2 + kstep; const char* b3 = b2 + kstep;
            if (last && has_next) S.a_ready(nxt);
            if constexpr (SP2) {
            PG8_LDB(B0, 0, 0); PG8_LDB(B1, 0, 1); PG8_SCHED; PG8_LDA(At, 0, 0); PG8_STAGE(PG8_SA(1, 1), a1 + hstep, voffA);
            PG8_WAIT_V(8); PG8_WAIT_L(0); PG8_BAR; PG8_MMA(0, 0, At, B0); PG8_MMA(0, 1, At, B1); PG8_BAR; PG8_SCHED;
            PG8_LDA(At, 0, 1); PG8_STAGE(PG8_SB(0, 0), b2, voffB); PG8_STAGE(PG8_SB(0, 1), b2 + hstep, voffB); PG8_STAGE(PG8_SA(0, 0), a2, voffA);
            PG8_WAIT_V(8); PG8_WAIT_L(0); PG8_BAR; PG8_MMA(1, 0, At, B0); PG8_MMA(1, 1, At, B1); PG8_BAR; PG8_SCHED;
            PG8_LDB(B0, 1, 0); PG8_LDB(B1, 1, 1); PG8_SCHED; PG8_LDA(At, 1, 0); PG8_STAGE(PG8_SA(0, 1), a2 + hstep, voffA);
            PG8_WAIT_V(8); PG8_WAIT_L(0); PG8_BAR; PG8_MMA(0, 0, At, B0); PG8_MMA(0, 1, At, B1); PG8_BAR; PG8_SCHED;
            PG8_LDA(At, 1, 1); PG8_STAGE(PG8_SB(1, 0), b3, voffB); PG8_STAGE(PG8_SB(1, 1), b3 + hstep, voffB); PG8_STAGE(PG8_SA(1, 0), a3, voffA);
            PG8_WAIT_V(8); PG8_WAIT_L(0); PG8_BAR; PG8_MMA(1, 0, At, B0); PG8_MMA(1, 1, At, B1); PG8_BAR; PG8_SCHED;
            } else {
            PG8_LDB(B0, 0, 0); PG8_SCHED; PG8_LDA(At, 0, 0); PG8_STAGE(PG8_SA(1, 1), a1 + hstep, voffA);
            PG8_WAIT_L(8); PG8_BAR; PG8_WAIT_L(0); PG8_MMA(0, 0, At, B0); PG8_BAR; PG8_SCHED;
            PG8_LDB(B1, 0, 1); PG8_STAGE(PG8_SB(0, 0), b2, voffB);
            PG8_BAR; PG8_WAIT_L(0); PG8_MMA(0, 1, At, B1); PG8_BAR;
            PG8_LDA(At, 0, 1); PG8_STAGE(PG8_SA(0, 0), a2, voffA);
            PG8_BAR; PG8_WAIT_L(0); PG8_MMA(1, 0, At, B0); PG8_BAR; PG8_SCHED;
            PG8_STAGE(PG8_SB(0, 1), b2 + hstep, voffB);
            PG8_WAIT_V(6); PG8_BAR; PG8_MMA(1, 1, At, B1); PG8_BAR;
            PG8_LDB(B0, 1, 0); PG8_SCHED; PG8_LDA(At, 1, 0); PG8_STAGE(PG8_SA(0, 1), a2 + hstep, voffA);
            PG8_WAIT_L(8); PG8_BAR; PG8_WAIT_L(0); PG8_MMA(0, 0, At, B0); PG8_BAR; PG8_SCHED;
            PG8_LDB(B1, 1, 1); PG8_STAGE(PG8_SB(1, 0), b3, voffB);
            PG8_BAR; PG8_WAIT_L(0); PG8_MMA(0, 1, At, B1); PG8_BAR;
            PG8_LDA(At, 1, 1); PG8_STAGE(PG8_SA(1, 0), a3, voffA);
            PG8_BAR; PG8_WAIT_L(0); PG8_MMA(1, 0, At, B0); PG8_BAR; PG8_SCHED;
            PG8_STAGE(PG8_SB(1, 1), b3 + hstep, voffB);
            PG8_WAIT_V(6); PG8_BAR; PG8_MMA(1, 1, At, B1); PG8_BAR;
            }
        }
        if constexpr (ALIGN_EPI) { if (wr == 0) PG8_BAR; }
        if constexpr (!Epi::AFTER_DRAIN) { E(acc, cur, wr, wc, fr, fq); S.done(cur); }
        if (!has_next) break;
#pragma unroll
        for (int a = 0; a < 2; ++a)
#pragma unroll
            for (int b = 0; b < 2; ++b)
#pragma unroll
                for (int m = 0; m < 4; ++m)
#pragma unroll
                    for (int n = 0; n < 2; ++n) acc[a][b][m][n] = (f32x4){0.f, 0.f, 0.f, 0.f};
        cur = nxt; cA = nA; cB = nB; ++ui;
        if constexpr (ALIGN_EPI) { if (wr == 1) PG8_BAR; }
    }
    PG8_WAIT_V(0);
    if constexpr (!ALIGN_EPI) { if (wr == 0) PG8_BAR; }
    PG8_BAR;
    if constexpr (Epi::AFTER_DRAIN) { E.fused(acc, cur, wr, wc, fr, fq, lds, wid, lane); S.done(cur); }
#undef PG8_SA
#undef PG8_SB
#undef PG8_STAGE
#undef PG8_LDA
#undef PG8_LDB
#undef PG8_MMA
#undef PG8_WAIT_V
#undef PG8_WAIT_L
#undef PG8_BAR
#undef PG8_SCHED
}
}

#define GAS __attribute__((address_space(1)))
#define LAS __attribute__((address_space(3)))
typedef unsigned short bf16;
typedef unsigned v4u __attribute__((ext_vector_type(4)));
typedef unsigned v2u __attribute__((ext_vector_type(2)));
typedef float f32x4 __attribute__((ext_vector_type(4)));
typedef float f32x2 __attribute__((ext_vector_type(2)));
typedef float f32x16 __attribute__((ext_vector_type(16)));
typedef short bf16x8 __attribute__((ext_vector_type(8)));
typedef short s16x4 __attribute__((ext_vector_type(4)));
#define LDS_WAIT() asm volatile("s_waitcnt lgkmcnt(0)" ::: "memory")
#define VM_WAIT() asm volatile("s_waitcnt vmcnt(0)" ::: "memory")
constexpr int NWAVES = 8;
constexpr int LDS_BYTES = 163840;
constexpr int MISC_OFF = 163840 - 256;

__device__ __forceinline__ unsigned f2bf(float f) { unsigned u = __builtin_bit_cast(unsigned, f); return (u + 0x7fffu + ((u >> 16) & 1u)) >> 16; }
__device__ __forceinline__ unsigned pk2(float lo, float hi) { return f2bf(lo) | (f2bf(hi) << 16); }
__device__ __forceinline__ float bf2f(unsigned short b) { return __builtin_bit_cast(float, ((unsigned)b) << 16); }
__device__ __forceinline__ float wave_sum(float v) {
#pragma unroll
    for (int o = 1; o < 64; o <<= 1) v += __shfl_xor(v, o);
    return v;
}
__device__ __forceinline__ float softplus_f(float x) { return fmaxf(x, 0.f) + log1pf(expf(-fabsf(x))); }
__device__ __forceinline__ float sigmoid_f(float x) { return 1.0f / (1.0f + expf(-x)); }
__device__ __forceinline__ float silu_f(float x) { return x * __builtin_amdgcn_rcpf(1.0f + __expf(-x)); }

struct Params {
    const float* in[20];
    float* out; unsigned char* ws;
    int ph_lo, ph_hi;
};
struct Ctx { int tid, lane, wave, vcu, G; };
#ifndef PROBE_K
#define PROBE_K -1
#endif
#define GSTAMP(id) do { if (PROBE_K >= 10 && unit == 0 && threadIdx.x == 0) { const unsigned long long t_ = __builtin_amdgcn_s_memrealtime(); unsigned* c_ = (unsigned*)(P.ws + WS_CTL); __hip_atomic_store(c_ + 512 + 2 * (id), (unsigned)t_, __ATOMIC_RELAXED, __HIP_MEMORY_SCOPE_AGENT); __hip_atomic_store(c_ + 513 + 2 * (id), (unsigned)(t_ >> 32), __ATOMIC_RELAXED, __HIP_MEMORY_SCOPE_AGENT); } } while (0)

#define XB_TMO      128
#define XB_XCNT(j)  (256  + 64 * (j))
#define XB_XSUB(j)  (1280 + 64 * (j))
#define XB_XGEN(j)  (2304 + 64 * (j))
#define XB_TOP      3328
#define XB_TOPGEN   3392
#define XCD_BAR_WORDS 3456
#define XB_SPIN_CAP (1u << 18)

__device__ __forceinline__ unsigned xb_ld(unsigned* p)              { return __hip_atomic_load(p, __ATOMIC_RELAXED, __HIP_MEMORY_SCOPE_AGENT); }
__device__ __forceinline__ unsigned xb_add(unsigned* p, unsigned v) { return __hip_atomic_fetch_add(p, v, __ATOMIC_RELAXED, __HIP_MEMORY_SCOPE_AGENT); }
__device__ __forceinline__ unsigned xb_xcc_id() { return (unsigned)__builtin_amdgcn_s_getreg((3 << 11) | 20) & 0xFu; }
#define XB_SPIN(cond, bar) do { unsigned _sp = 0; while (cond) { __builtin_amdgcn_s_sleep(1); \
    if ((++_sp & 255u) == 0u) { if (xb_ld(&(bar)[XB_TMO])) break; if (_sp > XB_SPIN_CAP) { atomicAdd(&(bar)[XB_TMO], 1u); break; } } } } while (0)

struct XcdBarrier {
    unsigned* bar; unsigned x;
    volatile LAS unsigned* st;
};

__device__ __forceinline__ XcdBarrier xcd_barrier_post(unsigned* bar, volatile LAS unsigned* st) {
    XcdBarrier b; b.bar = bar; b.x = xb_xcc_id(); b.st = st;
    if (threadIdx.x == 0) (void)xb_add(&bar[XB_XCNT(b.x)], 1u);
    return b;
}
__device__ __forceinline__ void xcd_barrier_complete(unsigned* bar, unsigned x, unsigned& nloc, unsigned& nx) {
    const unsigned G = gridDim.x * gridDim.y * gridDim.z;
    unsigned sum, cnt, mine, sp = 0u;
    for (;;) {
        sum = 0u; cnt = 0u; mine = 0u;
#pragma unroll
        for (unsigned j = 0; j < 16; ++j) { const unsigned c = xb_ld(&bar[XB_XCNT(j)]); sum += c; cnt += (c > 0u) ? 1u : 0u; mine = (j == x) ? c : mine; }
        if (sum == G) break;
        __builtin_amdgcn_s_sleep(1);
        if ((++sp & 255u) == 0u) { if (xb_ld(&bar[XB_TMO])) break; if (sp > XB_SPIN_CAP) { atomicAdd(&bar[XB_TMO], 1u); break; } }
    }
    nloc = mine > 0u ? mine : 1u; nx = cnt > 0u ? cnt : 1u;
}

__device__ __forceinline__ void xcd_barrier(const XcdBarrier& b) {
    asm volatile("s_waitcnt vmcnt(0)" ::: "memory");
    __syncthreads();
    if (threadIdx.x == 0) {
        unsigned* bar = b.bar;
        __builtin_amdgcn_s_waitcnt(0);
        unsigned nloc = b.st[0], nx = b.st[1];
        if (nloc == 0u) { xcd_barrier_complete(bar, b.x, nloc, nx); b.st[0] = nloc; b.st[1] = nx; }
        const unsigned old = xb_add(&bar[XB_XSUB(b.x)], 1u);
        const unsigned gen = old / nloc;
        if (old + 1u == (gen + 1u) * nloc) {
            __builtin_amdgcn_fence(__ATOMIC_RELEASE, "agent");
            asm volatile("s_waitcnt vmcnt(0)" ::: "memory");
            const unsigned og = xb_add(&bar[XB_TOP], 1u);
            const unsigned tg = og / nx;
            if (og + 1u == (tg + 1u) * nx) xb_add(&bar[XB_TOPGEN], 1u);
            else XB_SPIN(xb_ld(&bar[XB_TOPGEN]) == tg, bar);
            __builtin_amdgcn_fence(__ATOMIC_ACQUIRE, "agent");
            xb_add(&bar[XB_XGEN(b.x)], 1u);
            asm volatile("s_waitcnt vmcnt(0)" ::: "memory");
        } else {
            XB_SPIN(xb_ld(&bar[XB_XGEN(b.x)]) == gen, bar);
            __builtin_amdgcn_fence(__ATOMIC_ACQUIRE, "agent");
            asm volatile("s_waitcnt vmcnt(0)" ::: "memory");
        }
    }
    __syncthreads();
}

__device__ __forceinline__ void transpose_item(const float* W, int ldw, int c0, int K, int ncols, const float* scale, bf16* WT, int row_off, LAS float* scr, int item, int lane) {
    const int nblk = ncols / 32, kb = item / nblk, nb = item % nblk, k0 = 64 * kb, n0 = 32 * nb;
    float wv[32];
#pragma unroll
    for (int i = 0; i < 32; ++i) { const int kk = 2 * i + (lane >> 5); wv[i] = W[(size_t)(k0 + kk) * ldw + c0 + n0 + (lane & 31)]; }
#pragma unroll
    for (int i = 0; i < 32; ++i) { const int kk = 2 * i + (lane >> 5); float w = wv[i]; if (scale) w *= scale[k0 + kk]; scr[kk * 33 + (lane & 31)] = w; }
    LDS_WAIT(); asm volatile("" ::: "memory");
    const int c = lane & 7;
#pragma unroll
    for (int j = 0; j < 4; ++j) { const int n = (lane >> 3) + 8 * j; const LAS float* s = scr + (8 * c) * 33 + n;
        v4u o; o.x = pk2(s[0 * 33], s[1 * 33]); o.y = pk2(s[2 * 33], s[3 * 33]); o.z = pk2(s[4 * 33], s[5 * 33]); o.w = pk2(s[6 * 33], s[7 * 33]);
        *(GAS v4u*)(WT + (size_t)(row_off + n0 + n) * K + k0 + 8 * c) = o; }
    LDS_WAIT(); asm volatile("" ::: "memory");
}

__device__ __forceinline__ void phase_prep(const Params& P, const Ctx& C, LAS unsigned char* lds) {
    unsigned char* ws = P.ws;
    const float* xp = P.in[0]; const float* xs = P.in[1]; const float* ln1 = P.in[8]; const float* w_in = P.in[9]; const float* b_f = P.in[10];
    const float* a_log = P.in[12]; const float* dt_bias = P.in[13]; const float* w_o = P.in[15]; const float* ln2 = P.in[16]; const float* w_up = P.in[17]; const float* w_down = P.in[18];
    bf16* XN = (bf16*)(ws + WS_XN);
    float* LF = (float*)(ws + WS_LF); float* BETA = (float*)(ws + WS_BETA); float* Gg = (float*)(ws + WS_G);
    LAS float* WSm = (LAS float*)lds;
    LAS float* scr = (LAS float*)(lds + 49152 + C.wave * 8448);
    {
        float gv[24];
#pragma unroll
        for (int i = 0; i < 24; ++i) { const int idx = C.tid + 512 * i; const int k = idx / 12, c = idx % 12; const int col = c < 4 ? 1536 + c : 3588 + (c - 4); gv[i] = w_in[(size_t)k * INDIM + col]; }
#pragma unroll
        for (int i = 0; i < 24; ++i) { const int idx = C.tid + 512 * i; const int k = idx / 12, c = idx % 12; WSm[c * 1024 + k] = gv[i]; }
    }
    __syncthreads();
    const int gw = C.vcu * NWAVES + C.wave, NGW = C.G * NWAVES, lane = C.lane;
    f32x4 lw[4];
#pragma unroll
    for (int j = 0; j < 4; ++j) lw[j] = ((const f32x4*)ln1)[lane + 64 * j];
    f32x4 vnx[4];
    if (gw < M_TOT) { const float* xr0 = gw < MP ? xp + (size_t)gw * DM : xs + (size_t)(gw - MP) * DM;
#pragma unroll
        for (int j = 0; j < 4; ++j) vnx[j] = ((const f32x4*)xr0)[lane + 64 * j]; }
    for (int m = gw; m < M_TOT; m += NGW) {
        asm volatile("" ::: "memory");
        f32x4 v[4]; float ss = 0.f;
#pragma unroll
        for (int j = 0; j < 4; ++j) { v[j] = vnx[j]; ss += (v[j][0] * v[j][0] + v[j][1] * v[j][1]) + (v[j][2] * v[j][2] + v[j][3] * v[j][3]); }
        { const int mn = m + NGW; if (mn < M_TOT) { const float* xr1 = mn < MP ? xp + (size_t)mn * DM : xs + (size_t)(mn - MP) * DM;
#pragma unroll
            for (int j = 0; j < 4; ++j) vnx[j] = ((const f32x4*)xr1)[lane + 64 * j]; } }
        ss = wave_sum(ss);
        const float rstd = 1.0f / sqrtf(ss * (1.0f / DM) + RMS_EPS);
#pragma unroll
        for (int j = 0; j < 4; ++j) { v[j] = v[j] * rstd * lw[j];
            v2u o; o.x = pk2(v[j][0], v[j][1]); o.y = pk2(v[j][2], v[j][3]);
            *(v2u*)(XN + (size_t)m * DM + 4 * lane + 256 * j) = o; }
        float mine = 0.f;
#pragma unroll
        for (int c = 0; c < 12; ++c) { float a = 0.f;
#pragma unroll
            for (int j = 0; j < 4; ++j) { const f32x4 w = *(const LAS f32x4*)(WSm + c * 1024 + 4 * lane + 256 * j); a += (v[j][0] * w[0] + v[j][1] * w[1]) + (v[j][2] * w[2] + v[j][3] * w[3]); }
            a = wave_sum(a); mine = (lane == c) ? a : mine; }
        const float bb = __shfl(mine, (lane + 4) & 63), aa = __shfl(mine, (lane + 8) & 63);
        if (lane < 4) {
            const float fa = mine;
            const float lf = -softplus_f(-(fa + b_f[lane]));
            const float beta = sigmoid_f(bb);
            const float g = -expf(a_log[lane]) * softplus_f(aa + dt_bias[lane]);
            LF[(size_t)m * 4 + lane] = lf; BETA[(size_t)m * 4 + lane] = beta; Gg[(size_t)m * 4 + lane] = g;
            if (m < MP) P.out[OLF_P + (size_t)m * 4 + lane] = lf; else P.out[OLF_S + (size_t)(m - MP) * 4 + lane] = lf;
        }
    }
    bf16* W1T = (bf16*)(ws + WS_W1T); bf16* WOT = (bf16*)(ws + WS_WOT); bf16* WUPT = (bf16*)(ws + WS_WUPT); bf16* WDNT = (bf16*)(ws + WS_WDNT);
    for (int it = gw; it < 16 * 48; it += NGW) transpose_item(w_in, INDIM, 0, DM, 1536, nullptr, W1T, 0, scr, it, lane);
    for (int it = gw; it < 16 * 48; it += NGW) transpose_item(w_in, INDIM, 1540, DM, 1536, nullptr, W1T, 1536, scr, it, lane);
    for (int it = gw; it < 16 * 16; it += NGW) transpose_item(w_in, INDIM, 3076, DM, 512, nullptr, W1T, 3072, scr, it, lane);
    for (int it = gw; it < 16 * 32; it += NGW) transpose_item(w_o, DM, 0, DM, DM, nullptr, WOT, 0, scr, it, lane);
    for (int it = gw; it < 16 * 128; it += NGW) transpose_item(w_up, FF, 0, DM, FF, ln2, WUPT, 0, scr, it, lane);
    for (int it = gw; it < 64 * 32; it += NGW) transpose_item(w_down, DM, 0, FF, DM, nullptr, WDNT, 0, scr, it, lane);
}

__device__ __forceinline__ void kbias_seq(const Params& P, int bh, int lane) {
    const float* LF = (const float*)(P.ws + WS_LF); float* KBIAS = (float*)(P.ws + WS_KBIAS);
    const int b = bh >> 2, h = bh & 3;
    const float* src = LF + ((size_t)b * SEQ + 32 * lane) * 4 + h;
    float s = 0.f;
    for (int i = 0; i < 32; ++i) s += src[i * 4];
    float x = s;
#pragma unroll
    for (int o = 1; o < 64; o <<= 1) { const float y = __shfl_up(x, o); if (lane >= o) x += y; }
    float run = x - s;
    float* dst = KBIAS + (size_t)bh * SEQ + 32 * lane;
    const float inv = -11.313708498984761f;
    for (int i = 0; i < 32; ++i) { run += src[i * 4]; dst[i] = run * inv; }
}


namespace fox {
constexpr int D = 128, NW = 8, QBLK = 32, KVBLK = 64, QB = NW * QBLK;
constexpr int SHM_V = KVBLK * D * 2, SHM_K = KVBLK * D * 2;
constexpr float SCALE = 0.08838834764831845f, THR = 8.f;
#define KSWZ(row, colB) ((row) * 256 + ((colB) ^ (((row) & 7) << 4)))
#define SBAR() __builtin_amdgcn_sched_barrier(0)
__device__ __forceinline__ int v_st(int k, int c) { const int kk = (k & ~0xC) | ((k & 4) << 1) | ((k & 8) >> 1); return ((kk >> 3) * 4 + (c >> 5)) * 512 + ((kk & 7) * 32 + (c & 31)) * 2; }
__device__ __forceinline__ int v_rd_base(int lane) { return ((lane & 3) << 3) | (((lane >> 2) & 3) << 6) | (((lane >> 4) & 1) << 5) | (((lane >> 5) & 1) << 8); }
constexpr int v_rd_off(int d0, int ks, int half) { return d0 * 512 + ks * 4096 + half * 2048; }
__device__ __forceinline__ int crow(int r, int hi) { return (r & 3) + 8 * (r >> 2) + 4 * hi; }
__device__ __forceinline__ unsigned cvtpk(float lo, float hi) { unsigned r; asm volatile("v_cvt_pk_bf16_f32 %0, %1, %2" : "=v"(r) : "v"(lo), "v"(hi)); return r; }
__device__ __forceinline__ void mask_tile(f32x16& p0, f32x16& p1, int dq, unsigned W) {
    const float NEG = -__builtin_inff();
#pragma unroll
    for (int r = 0; r < 16; ++r) {
        const int c = (r & 3) + 8 * (r >> 2);
        if ((unsigned)(dq - c) >= W) p0[r] = NEG;
        if ((unsigned)(dq - c - 32) >= W) p1[r] = NEG;
    }
}
__device__ __forceinline__ void partialSM(f32x16& p0, f32x16& p1, float& m_reg, float& mn, float& alpha) {
    float pmax = p0[0]; for (int r = 1; r < 16; ++r) pmax = fmaxf(pmax, p0[r]); for (int r = 0; r < 16; ++r) pmax = fmaxf(pmax, p1[r]);
    { auto rr = __builtin_amdgcn_permlane32_swap(__float_as_uint(pmax), __float_as_uint(pmax), false, false);
      pmax = fmaxf(__uint_as_float(rr[0]), __uint_as_float(rr[1])); }
    constexpr float C2 = 1.4426950408889634f * SCALE;
    if (__builtin_expect(__all((pmax - m_reg) * SCALE <= THR), 1)) { mn = m_reg; alpha = 1.f; }
    else { mn = fmaxf(m_reg, pmax); alpha = __builtin_amdgcn_exp2f((m_reg - mn) * C2); m_reg = mn; }
    const float mnL = -mn * C2;
    for (int r = 0; r < 16; ++r) p0[r] = fmaf(p0[r], C2, mnL); for (int r = 0; r < 16; ++r) p1[r] = fmaf(p1[r], C2, mnL);
    for (int r = 0; r < 16; ++r) p0[r] = __builtin_amdgcn_exp2f(p0[r]);
}
__device__ __forceinline__ void finishSM(f32x16& p0, f32x16& p1, float alpha, float& l_reg, bf16x8& pa0, bf16x8& pa1, bf16x8& pa2, bf16x8& pa3) {
    for (int r = 0; r < 16; ++r) p1[r] = __builtin_amdgcn_exp2f(p1[r]);
    float ps = 0; for (int r = 0; r < 16; ++r) ps += p0[r]; for (int r = 0; r < 16; ++r) ps += p1[r];
    { auto rr = __builtin_amdgcn_permlane32_swap(__float_as_uint(ps), __float_as_uint(ps), false, false);
      ps = __uint_as_float(rr[0]) + __uint_as_float(rr[1]); }
    l_reg = l_reg * alpha + ps;
#define PK4(P, B_, OUT) do { unsigned a0 = cvtpk(P[B_+0], P[B_+1]), a1 = cvtpk(P[B_+2], P[B_+3]);                          \
        unsigned b0 = cvtpk(P[B_+4], P[B_+5]), b1 = cvtpk(P[B_+6], P[B_+7]);                                             \
        auto r0 = __builtin_amdgcn_permlane32_swap(a0, b0, false, false); auto r1 = __builtin_amdgcn_permlane32_swap(a1, b1, false, false); \
        v4u w = {r0[0], r1[0], r0[1], r1[1]}; OUT = *reinterpret_cast<bf16x8*>(&w); } while (0)
    PK4(p0, 0, pa0); PK4(p0, 8, pa1); PK4(p1, 0, pa2); PK4(p1, 8, pa3);
#undef PK4
}
template <int KB>
__device__ __forceinline__ void qkt(f32x16& p0, f32x16& p1, const char* K_lds, const float* bias_l, int r32, int hi, const bf16x8* qr) {
#pragma unroll
    for (int g = 0; g < 4; ++g) { const f32x4 t0 = *(const f32x4*)(bias_l + 8 * g + 4 * hi), t1 = *(const f32x4*)(bias_l + 32 + 8 * g + 4 * hi);
#pragma unroll
        for (int i = 0; i < 4; ++i) { p0[4 * g + i] = t0[i]; p1[4 * g + i] = t1[i]; } }
    const char* kb[4];
#pragma unroll
    for (int dd = 0; dd < 4; ++dd) kb[dd] = K_lds + KB * SHM_K + KSWZ(r32, (dd * 16 + hi * 8) * 2);
#pragma unroll
    for (int d0 = 0; d0 < 8; ++d0) { const char* a = kb[d0 & 3] + (d0 >> 2) * 128;
        bf16x8 b0 = *reinterpret_cast<const bf16x8*>(a);
        bf16x8 b1 = *reinterpret_cast<const bf16x8*>(a + 32 * 256);
        p0 = __builtin_amdgcn_mfma_f32_32x32x16_bf16(b0, qr[d0], p0, 0, 0, 0);
        p1 = __builtin_amdgcn_mfma_f32_32x32x16_bf16(b1, qr[d0], p1, 0, 0, 0); }
}
template <int VB>
__device__ __forceinline__ void pv_tile(f32x16* o, int vb0, bf16x8 pa0, bf16x8 pa1, bf16x8 pa2, bf16x8 pa3) {
#define TRRD(dst, off) asm volatile("ds_read_b64_tr_b16 %0, %1 offset:%2" : "=&v"(dst) : "v"(vb0), "i"(off) : "memory")
#define PV_D0(d0) do { s16x4 l0, l1, l2, l3, h0, h1, h2, h3; constexpr int b_ = VB * SHM_V + v_rd_off(d0, 0, 0);   \
        TRRD(l0, b_); TRRD(h0, b_ + 2048); TRRD(l1, b_ + 4096); TRRD(h1, b_ + 6144); TRRD(l2, b_ + 8192); TRRD(h2, b_ + 10240); TRRD(l3, b_ + 12288); TRRD(h3, b_ + 14336); \
        asm volatile("s_waitcnt lgkmcnt(0)" ::: "memory"); SBAR();   \
        o[d0] = __builtin_amdgcn_mfma_f32_32x32x16_bf16(pa0, (bf16x8){l0[0], l0[1], l0[2], l0[3], h0[0], h0[1], h0[2], h0[3]}, o[d0], 0, 0, 0);   \
        o[d0] = __builtin_amdgcn_mfma_f32_32x32x16_bf16(pa1, (bf16x8){l1[0], l1[1], l1[2], l1[3], h1[0], h1[1], h1[2], h1[3]}, o[d0], 0, 0, 0);   \
        o[d0] = __builtin_amdgcn_mfma_f32_32x32x16_bf16(pa2, (bf16x8){l2[0], l2[1], l2[2], l2[3], h2[0], h2[1], h2[2], h2[3]}, o[d0], 0, 0, 0);   \
        o[d0] = __builtin_amdgcn_mfma_f32_32x32x16_bf16(pa3, (bf16x8){l3[0], l3[1], l3[2], l3[3], h3[0], h3[1], h3[2], h3[3]}, o[d0], 0, 0, 0); } while (0)
    PV_D0(0); PV_D0(1); PV_D0(2); PV_D0(3);
#undef PV_D0
#undef TRRD
}

__device__ __forceinline__ void fox_block(char* lds, const bf16* Qh, const bf16* Kh, const bf16* Vh, const float* kbias, bf16* Orow0, int qb) {
    const int tid = threadIdx.x, wid = __builtin_amdgcn_readfirstlane(tid >> 6), lane = tid & 63, r32 = lane & 31, hi = lane >> 5;
    const int P0 = qb * QB, qlo = P0 + wid * QBLK, qm = qlo + r32 - 4 * hi;
    char* V_lds = lds; char* K_lds = lds + 2 * SHM_V;
    float* bias_l = (float*)(lds + 2 * SHM_V + 2 * SHM_K);
    float* wsf = bias_l + 128 + wid * 64; float* li_l = wsf; float* al_l = wsf + 32;
    bf16x8 qr[8];
#pragma unroll
    for (int d0 = 0; d0 < 8; ++d0) qr[d0] = *reinterpret_cast<const bf16x8*>(Qh + (size_t)(qlo + r32) * D + d0 * 16 + hi * 8);
    float m_reg = -1e30f, l_reg = 0.f; f32x16 o[4] = {};
    const int sr = tid >> 4, sc = (tid & 15) * 8, vst0 = v_st(sr, sc), vst1 = v_st(32 + sr, sc), kws = KSWZ(sr, sc * 2);
    const int vb0 = (int)(uintptr_t)V_lds + v_rd_base(lane);
    const int ntiles = P0 / KVBLK + 4;
    float* bias2 = bias_l;
    bf16x8 gk0, gk1, gv0, gv1; float gb = 0.f;
#define FOX_LOAD(kb_) do { gk0 = *reinterpret_cast<const bf16x8*>(Kh + (size_t)((kb_) + sr) * D + sc); gk1 = *reinterpret_cast<const bf16x8*>(Kh + (size_t)((kb_) + 32 + sr) * D + sc); \
        gv0 = *reinterpret_cast<const bf16x8*>(Vh + (size_t)((kb_) + sr) * D + sc); gv1 = *reinterpret_cast<const bf16x8*>(Vh + (size_t)((kb_) + 32 + sr) * D + sc); if (tid < 64) gb = kbias[(kb_) + tid]; } while (0)
#define FOX_WRITE(B_) do { *(bf16x8*)(K_lds + (B_) * SHM_K + kws) = gk0; *(bf16x8*)(K_lds + (B_) * SHM_K + kws + 32 * 256) = gk1; *(bf16x8*)(V_lds + (B_) * SHM_V + vst0) = gv0; *(bf16x8*)(V_lds + (B_) * SHM_V + vst1) = gv1; \
        if (tid < 64) bias2[(B_) * 64 + tid] = gb; } while (0)
#define FOX_TILE(B_, kb_) do { if ((kb_) <= qlo + QBLK - 1) { f32x16 p0, p1; float mn, al; bf16x8 pa0, pa1, pa2, pa3; \
            qkt<B_>(p0, p1, K_lds, bias2 + (B_) * 64, r32, hi, qr); \
            if ((kb_) + KVBLK - 1 > qlo) mask_tile(p0, p1, qm - (kb_), 0x40000000u); \
            partialSM(p0, p1, m_reg, mn, al); \
            if (__any(al < 1.f)) { if (hi == 0) al_l[r32] = al; asm volatile("s_waitcnt lgkmcnt(0)" ::: "memory"); \
                for (int d_ = 0; d_ < 4; ++d_) for (int r = 0; r < 16; ++r) o[d_][r] *= al_l[crow(r, hi)]; } \
            finishSM(p0, p1, al, l_reg, pa0, pa1, pa2, pa3); SBAR(); \
            pv_tile<B_>(o, vb0, pa0, pa1, pa2, pa3); } } while (0)
    __syncthreads();
    FOX_LOAD((ntiles - 1) * KVBLK); FOX_WRITE(0);
    __syncthreads();
    for (int j = ntiles - 1; j >= 0; j -= 2) {
        FOX_LOAD((j - 1) * KVBLK); SBAR();
        FOX_TILE(0, j * KVBLK);
        FOX_WRITE(1);
        __syncthreads();
        if (j >= 2) { FOX_LOAD((j - 2) * KVBLK); SBAR(); }
        FOX_TILE(1, (j - 1) * KVBLK);
        if (j >= 2) FOX_WRITE(0);
        __syncthreads();
    }
#undef FOX_LOAD
#undef FOX_WRITE
#undef FOX_TILE
    if (hi == 0) li_l[r32] = l_reg; asm volatile("s_waitcnt lgkmcnt(0)" ::: "memory");
    float rli[16];
#pragma unroll
    for (int r = 0; r < 16; ++r) rli[r] = __builtin_amdgcn_rcpf(li_l[crow(r, hi)]);
    bf16* Ow = Orow0 + (size_t)qlo * DM;
#pragma unroll
    for (int r = 0; r < 16; ++r) { const int orow = crow(r, hi);
#pragma unroll
        for (int d0 = 0; d0 < 4; ++d0) { const float v = o[d0][r] * rli[r];
            const float vn = __shfl_xor(v, 1);
            if ((r32 & 1) == 0) *(unsigned*)(Ow + (size_t)orow * DM + d0 * 32 + r32) = cvtpk(v, vn); } }
    __syncthreads();
}
}


__device__ __forceinline__ void dec_update(float& m, float& l, f32x4& acc, const float (&x)[4], const f32x4 (&v)[4], int n) {
    float mx = m;
#pragma unroll
    for (int u = 0; u < 4; ++u) if (u < n) mx = fmaxf(mx, x[u]);
    const float al = __expf(m - mx);
    float ps = 0.f; f32x4 a = acc * al;
#pragma unroll
    for (int u = 0; u < 4; ++u) if (u < n) { const float p = __expf(x[u] - mx); ps += p; a += v[u] * p; }
    l = l * al + ps; acc = a; m = mx;
}
__device__ __forceinline__ float red32(float s) {
#pragma unroll
    for (int o = 1; o < 32; o <<= 1) s += __shfl_xor(s, o);
    return s;
}
__device__ __forceinline__ void decode_unit(const Params& P, LAS unsigned char* lds, int db) {
    const int tid = threadIdx.x, wid = __builtin_amdgcn_readfirstlane(tid >> 6), lane = tid & 63, hi = lane >> 5;
    const float* cache_k = P.in[2]; const float* cache_v = P.in[3]; const float* cache_lf = P.in[4]; const int* page_table = (const int*)P.in[5];
    const float* LF = (const float*)(P.ws + WS_LF); const float* QS = (const float*)(P.ws + WS_QS);
    bf16* MIX = (bf16*)(P.ws + WS_MIX);
    LAS f32x4* lfs = (LAS f32x4*)lds;
    LAS f32x4* wt = lfs + 2048;
    LAS float* cm = (LAS float*)(wt + 8);
    LAS float* cl = cm + 32;
    LAS f32x4* cacc = (LAS f32x4*)(cl + 32);
    const int ptv = (lane < NPAGES) ? page_table[db * NPAGES + lane] : 0;
#pragma unroll
    for (int i = 0; i < 4; ++i) { const int j = tid + 512 * i; const int pg = __shfl(ptv, j >> 7);
        lfs[j] = *(const f32x4*)(cache_lf + ((size_t)pg * PAGE + (j & 127)) * 4); }
    __syncthreads();
    {
        const f32x4 a0 = lfs[4 * tid], a1 = lfs[4 * tid + 1], a2 = lfs[4 * tid + 2], a3 = lfs[4 * tid + 3];
        const f32x4 tot = (a0 + a1) + (a2 + a3);
        f32x4 x = tot;
#pragma unroll
        for (int o = 1; o < 64; o <<= 1) { f32x4 y; y[0] = __shfl_down(x[0], o); y[1] = __shfl_down(x[1], o); y[2] = __shfl_down(x[2], o); y[3] = __shfl_down(x[3], o); if (lane + o < 64) x += y; }
        if (lane == 0) wt[wid] = x;
        __syncthreads();
        f32x4 after = {0.f, 0.f, 0.f, 0.f};
        for (int w2 = wid + 1; w2 < NWAVES; ++w2) after += wt[w2];
        const f32x4 lfn = *(const f32x4*)(LF + (size_t)(MP + db) * 4);
        const f32x4 B3 = (x - tot) + after + lfn, B2 = B3 + a3, B1 = B2 + a2, B0 = B1 + a1;
        lfs[4 * tid] = B0; lfs[4 * tid + 1] = B1; lfs[4 * tid + 2] = B2; lfs[4 * tid + 3] = B3;
    }
    __syncthreads();
    const float* qs = QS + (size_t)db * 512;
    const f32x4 qa = *(const f32x4*)(qs + 4 * lane) * ATT_SCALE, qb = *(const f32x4*)(qs + 256 + 4 * lane) * ATT_SCALE;
    float m0 = -1e30f, l0 = 0.f, m1 = -1e30f, l1 = 0.f; f32x4 acc0 = {0.f, 0.f, 0.f, 0.f}, acc1 = {0.f, 0.f, 0.f, 0.f};
    f32x4 kaA[4], kbA[4], vaA[4], vbA[4], kaB[4], kbB[4], vaB[4], vbB[4];
#define DEC_LOAD(ka, kb, va, vb, j0_) do { _Pragma("unroll") for (int u = 0; u < 4; ++u) { const int j = (j0_) + 8 * u; const int pg = __builtin_amdgcn_readlane(ptv, j >> 7); \
            const size_t ro = ((size_t)pg * PAGE + (j & 127)) * 512 + 4 * lane; \
            ka[u] = __builtin_nontemporal_load((const f32x4*)(cache_k + ro)); kb[u] = __builtin_nontemporal_load((const f32x4*)(cache_k + ro + 256)); va[u] = __builtin_nontemporal_load((const f32x4*)(cache_v + ro)); vb[u] = __builtin_nontemporal_load((const f32x4*)(cache_v + ro + 256)); } } while (0)
#define DEC_PROC(ka, kb, va, vb, j0_) do { float x0[4], x1[4]; _Pragma("unroll") for (int u = 0; u < 4; ++u) { const int j = (j0_) + 8 * u; \
            float s0 = (qa[0] * ka[u][0] + qa[1] * ka[u][1]) + (qa[2] * ka[u][2] + qa[3] * ka[u][3]); \
            float s1 = (qb[0] * kb[u][0] + qb[1] * kb[u][1]) + (qb[2] * kb[u][2] + qb[3] * kb[u][3]); \
            s0 = red32(s0); s1 = red32(s1); const f32x4 bj = lfs[j]; \
            x0[u] = s0 + (hi ? bj[1] : bj[0]); x1[u] = s1 + (hi ? bj[3] : bj[2]); } \
        dec_update(m0, l0, acc0, x0, va, 4); dec_update(m1, l1, acc1, x1, vb, 4); } while (0)
    DEC_LOAD(kaA, kbA, vaA, vbA, wid);
    for (int j0 = wid; j0 < PAST; j0 += 64) {
        DEC_LOAD(kaB, kbB, vaB, vbB, j0 + 32);
        DEC_PROC(kaA, kbA, vaA, vbA, j0);
        if (j0 + 64 < PAST) DEC_LOAD(kaA, kbA, vaA, vbA, j0 + 64);
        DEC_PROC(kaB, kbB, vaB, vbB, j0 + 32);
    }
#undef DEC_LOAD
#undef DEC_PROC
    if (wid == 0) {
        f32x4 va[4], vb[4]; float x0[4], x1[4];
        const float* kn = P.out + OK_S + (size_t)db * 512; const float* vn = P.out + OV_S + (size_t)db * 512;
        const f32x4 ka = *(const f32x4*)(kn + 4 * lane), kb = *(const f32x4*)(kn + 256 + 4 * lane);
        va[0] = *(const f32x4*)(vn + 4 * lane); vb[0] = *(const f32x4*)(vn + 256 + 4 * lane);
#pragma unroll
        for (int u = 1; u < 4; ++u) { va[u] = va[0]; vb[u] = vb[0]; }
        x0[0] = red32((qa[0] * ka[0] + qa[1] * ka[1]) + (qa[2] * ka[2] + qa[3] * ka[3]));
        x1[0] = red32((qb[0] * kb[0] + qb[1] * kb[1]) + (qb[2] * kb[2] + qb[3] * kb[3]));
#pragma unroll
        for (int u = 1; u < 4; ++u) { x0[u] = x0[0]; x1[u] = x1[0]; }
        dec_update(m0, l0, acc0, x0, va, 1); dec_update(m1, l1, acc1, x1, vb, 1);
    }
    if ((lane & 31) == 0) { cm[wid * 4 + hi] = m0; cm[wid * 4 + 2 + hi] = m1; cl[wid * 4 + hi] = l0; cl[wid * 4 + 2 + hi] = l1; }
    cacc[(wid * 2 + 0) * 64 + lane] = acc0; cacc[(wid * 2 + 1) * 64 + lane] = acc1;
    __syncthreads();
    if (tid < 128) {
        const int ab = tid >> 6, l = tid & 63, head = 2 * ab + (l >> 5);
        float M = -1e30f;
#pragma unroll
        for (int w = 0; w < NWAVES; ++w) M = fmaxf(M, cm[w * 4 + head]);
        float L = 0.f; f32x4 O = {0.f, 0.f, 0.f, 0.f};
#pragma unroll
        for (int w = 0; w < NWAVES; ++w) { const float e = __expf(cm[w * 4 + head] - M); L += cl[w * 4 + head] * e; O += cacc[(w * 2 + ab) * 64 + l] * e; }
        const float inv = 1.0f / L;
        v2u o; o.x = pk2(O[0] * inv, O[1] * inv); o.y = pk2(O[2] * inv, O[3] * inv);
        *(v2u*)(MIX + (size_t)(MP + db) * DM + head * 128 + 4 * (l & 31)) = o;
    }
    __syncthreads();
}

__device__ __forceinline__ void sgdn_unit(const Params& P, LAS unsigned char* lds, int db) {
    const int tid = threadIdx.x, wid = __builtin_amdgcn_readfirstlane(tid >> 6), lane = tid & 63;
    const float* state_conv = P.in[6]; const float* state_ssm = P.in[7]; const float* w_conv = P.in[11]; const float* w_gnorm = P.in[14];
    const float* BETA = (const float*)(P.ws + WS_BETA); const float* Gg = (const float*)(P.ws + WS_G);
    const bf16* ZB = (const bf16*)(P.ws + WS_ZB); bf16* MIX = (bf16*)(P.ws + WS_MIX);
    LAS float* xs = (LAS float*)lds;
    LAS float* red1 = xs + 1536;
    LAS float* red2 = red1 + 4096;
    LAS float* ov = red2 + 4096;
#pragma unroll
    for (int i = 0; i < 3; ++i) {
        const int ch = tid + 512 * i;
        const float* sc = state_conv + (size_t)db * 3 * CONVD + ch;
        float* oc = P.out + OCONV_S + (size_t)db * 3 * CONVD + ch;
        const float c0 = sc[0], c1 = sc[CONVD], c2 = sc[2 * CONVD], c3 = oc[2 * CONVD];
        const float a = (c0 * w_conv[ch] + c1 * w_conv[CONVD + ch]) + (c2 * w_conv[2 * CONVD + ch] + c3 * w_conv[3 * CONVD + ch]);
        xs[ch] = silu_f(a);
        oc[0] = c1; oc[CONVD] = c2;
    }
    __syncthreads();
    {
        const float a = xs[wid * 128 + lane], b = xs[wid * 128 + 64 + lane];
        const float ss = wave_sum(a * a + b * b);
        const float sc = (1.0f / sqrtf(ss + L2_EPS)) * (wid < 4 ? ATT_SCALE : 1.0f);
        xs[wid * 128 + lane] = a * sc; xs[wid * 128 + 64 + lane] = b * sc;
    }
    __syncthreads();
#pragma unroll
    for (int hp = 0; hp < 2; ++hp) {
        f32x2 s[2][16];
#pragma unroll
        for (int hh = 0; hh < 2; ++hh) { const int h = 2 * hp + hh;
            const float gsc = __expf(Gg[(size_t)(MP + db) * 4 + h]);
            const float* Sp = state_ssm + ((size_t)(db * 4 + h) * 128 + 16 * wid) * 128 + 2 * lane;
            f32x2 ks = {0.f, 0.f};
#pragma unroll
            for (int r = 0; r < 16; ++r) { s[hh][r] = *(const f32x2*)(Sp + (size_t)r * 128) * gsc; const float kd = xs[512 + h * 128 + 16 * wid + r]; ks += s[hh][r] * kd; }
            *(LAS f32x2*)(red1 + (h * 8 + wid) * 128 + 2 * lane) = ks;
        }
        __syncthreads();
#pragma unroll
        for (int hh = 0; hh < 2; ++hh) { const int h = 2 * hp + hh;
            const float bt = BETA[(size_t)(MP + db) * 4 + h];
            f32x2 kS = {0.f, 0.f};
#pragma unroll
            for (int w = 0; w < NWAVES; ++w) kS += *(const LAS f32x2*)(red1 + (h * 8 + w) * 128 + 2 * lane);
            const f32x2 vv = *(const LAS f32x2*)(xs + 1024 + h * 128 + 2 * lane);
            const f32x2 delta = (vv - kS) * bt;
            float* So = P.out + OSSM_S + ((size_t)(db * 4 + h) * 128 + 16 * wid) * 128 + 2 * lane;
            f32x2 os = {0.f, 0.f};
#pragma unroll
            for (int r = 0; r < 16; ++r) { const float kd = xs[512 + h * 128 + 16 * wid + r], qd = xs[h * 128 + 16 * wid + r]; const f32x2 sn = s[hh][r] + delta * kd; *(f32x2*)(So + (size_t)r * 128) = sn; os += sn * qd; }
            *(LAS f32x2*)(red2 + (h * 8 + wid) * 128 + 2 * lane) = os;
        }
    }
    __syncthreads();
    { const int h = tid >> 7, e = tid & 127; float o = 0.f;
#pragma unroll
        for (int w = 0; w < NWAVES; ++w) o += red2[(h * 8 + w) * 128 + e];
        ov[tid] = o; }
    __syncthreads();
    if (wid < 4) {
        const int h = wid;
        const float a = ov[h * 128 + lane], b = ov[h * 128 + 64 + lane];
        const float ss = wave_sum(a * a + b * b);
        const float rstd = 1.0f / sqrtf(ss * (1.0f / 128.0f) + RMS_EPS);
        const bf16* zr = ZB + (size_t)(MP + db) * 512 + h * 128;
        bf16* mr = MIX + (size_t)(MP + db) * DM + 512 + h * 128;
        mr[lane] = (bf16)f2bf(a * rstd * w_gnorm[lane] * silu_f(bf2f(zr[lane])));
        mr[64 + lane] = (bf16)f2bf(b * rstd * w_gnorm[64 + lane] * silu_f(bf2f(zr[64 + lane])));
    }
    __syncthreads();
}


#ifndef GSTAMP
#define GSTAMP(id)
#endif
constexpr int XS = 132, LS = 64;
__device__ __forceinline__ int sw256(int row, int ch) { return row * 256 + ((ch ^ (row & 15)) << 4); }
__device__ __forceinline__ int sw128(int row, int ch) { return row * 128 + ((ch ^ ((row >> 1) & 7)) << 4); }
#define GDNA_LOAD(unit_) do { const int n_ = (unit_) & 31, bh_ = (unit_) >> 5, h_ = bh_ & 3, m0_ = (bh_ >> 2) * SEQ + n_ * GCH; \
        _Pragma("unroll") for (int i = 0; i < 7; ++i) { const int c = tid + 512 * i; const int r = c / 48, w = c - r * 48, seg = w >> 4, ch = w & 15; \
            rv[i] = (v4u){0u, 0u, 0u, 0u}; \
            if (c < 67 * 48 && (n_ > 0 || r >= 3)) rv[i] = *(const v4u*)(CB + (size_t)(m0_ - 3 + r) * CONVD + seg * 512 + h_ * 128 + ch * 8); } \
        gpre = Gg[(size_t)(m0_ + lane) * 4 + h_]; bpre = BETA[(size_t)(m0_ + lane) * 4 + h_]; } while (0)
__device__ __forceinline__ void gdna_units(const Params& P, LAS unsigned char* lds, int u_first, int u_step, int u_end) {
    const int tid = threadIdx.x, wid = __builtin_amdgcn_readfirstlane(tid >> 6), lane = tid & 63, fr = lane & 15, fq = lane >> 4;
    const bf16* CB = (const bf16*)(P.ws + WS_CB);
    const float* BETA = (const float*)(P.ws + WS_BETA); const float* Gg = (const float*)(P.ws + WS_G);
    v4u rv[7]; float gpre, bpre;
    if (u_first < u_end) GDNA_LOAD(u_first & (NB * NH * NCHUNK - 1));
    for (int uu = u_first; uu < u_end; uu += u_step) {
    const int unit = uu & (NB * NH * NCHUNK - 1);
    const int n = unit & 31, bh = unit >> 5, b = bh >> 2, h = bh & 3, m0 = b * SEQ + n * GCH;
    const float* w_conv = P.in[11];
    float* UT = (float*)(P.ws + WS_UT) + (size_t)unit * 8192; bf16* WN = (bf16*)(P.ws + WS_WN) + (size_t)unit * 8192; bf16* QG = (bf16*)(P.ws + WS_QG) + (size_t)unit * 8192;
    bf16* KGT = (bf16*)(P.ws + WS_KGT) + (size_t)unit * 8192; bf16* QKM = (bf16*)(P.ws + WS_QKM) + (size_t)unit * 4096; float* GL = (float*)(P.ws + WS_GL);
    LAS float* XQ = (LAS float*)lds; LAS float* XK = XQ + 64 * XS; LAS float* XV = XK + 64 * XS;
    LAS unsigned char* RA = lds + 3 * 64 * XS * 4;
    LAS float* Lm = (LAS float*)RA;
    LAS unsigned char* KBf = RA + 16384;
    LAS unsigned char* QBf = RA + 16384 + 16384;
    LAS unsigned char* Nb = RA + 49152;
    LAS unsigned char* Lb = RA + 51456;
    LAS float* gcs = (LAS float*)(RA + 51456 + 8192); LAS float* bts = gcs + 64; LAS float* sks = bts + 64;
#pragma unroll
    for (int i = 0; i < 7; ++i) { const int c = tid + 512 * i; if (c < 67 * 48) *(LAS v4u*)(RA + c * 16) = rv[i]; }
    if (wid == 7) {
        float x = gpre;
#pragma unroll
        for (int o = 1; o < 64; o <<= 1) { const float y = __shfl_up(x, o); if (lane >= o) x += y; }
        gcs[lane] = x; bts[lane] = bpre; sks[lane] = bpre * __expf(x);
    }
    __syncthreads(); GSTAMP(5);
#pragma unroll
    for (int it = 0; it < 3; ++it) {
        const int item = tid + 512 * it, p = item % 192, rg = item / 192, seg = p >> 6, dp = (p & 63) * 2, ch = seg * 512 + h * 128 + dp;
        const f32x2 w0 = *(const f32x2*)(w_conv + ch), w1 = *(const f32x2*)(w_conv + CONVD + ch), w2 = *(const f32x2*)(w_conv + 2 * CONVD + ch), w3 = *(const f32x2*)(w_conv + 3 * CONVD + ch);
        const LAS unsigned* src = (const LAS unsigned*)(RA + ((8 * rg) * 384 + seg * 128 + dp) * 2);
        unsigned rw[11];
#pragma unroll
        for (int i = 0; i < 11; ++i) rw[i] = src[i * 192];
        LAS float* X = XQ + seg * 64 * XS + (8 * rg) * XS + dp;
#pragma unroll
        for (int i = 0; i < 8; ++i) {
            f32x2 a;
            a[0] = (__builtin_bit_cast(float, rw[i] << 16) * w0[0] + __builtin_bit_cast(float, rw[i + 1] << 16) * w1[0]) + (__builtin_bit_cast(float, rw[i + 2] << 16) * w2[0] + __builtin_bit_cast(float, rw[i + 3] << 16) * w3[0]);
            a[1] = (__builtin_bit_cast(float, rw[i] & 0xffff0000u) * w0[1] + __builtin_bit_cast(float, rw[i + 1] & 0xffff0000u) * w1[1]) + (__builtin_bit_cast(float, rw[i + 2] & 0xffff0000u) * w2[1] + __builtin_bit_cast(float, rw[i + 3] & 0xffff0000u) * w3[1]);
            a[0] = silu_f(a[0]); a[1] = silu_f(a[1]);
            *(LAS f32x2*)(X + i * XS) = a;
        }
    }
    __syncthreads(); GSTAMP(6);
    if (uu + u_step < u_end) GDNA_LOAD((uu + u_step) & (NB * NH * NCHUNK - 1));
#pragma unroll
    for (int it = 0; it < 2; ++it) {
        const int item = tid + 512 * it, R = item >> 3, s8 = item & 7, isq = R < 64, i = R & 63;
        LAS float* X = (isq ? XQ : XK) + i * XS + 16 * s8;
        f32x4 v[4]; float ss = 0.f;
#pragma unroll
        for (int q = 0; q < 4; ++q) { v[q] = *(const LAS f32x4*)(X + 4 * q); ss += (v[q][0] * v[q][0] + v[q][1] * v[q][1]) + (v[q][2] * v[q][2] + v[q][3] * v[q][3]); }
        ss += __shfl_xor(ss, 1); ss += __shfl_xor(ss, 2); ss += __shfl_xor(ss, 4);
        const float sc = (1.0f / sqrtf(ss + L2_EPS)) * (isq ? ATT_SCALE : 1.0f);
#pragma unroll
        for (int q = 0; q < 4; ++q) { v[q] = v[q] * sc; *(LAS f32x4*)(X + 4 * q) = v[q]; }
        LAS unsigned char* Bf = isq ? QBf : KBf;
        *(LAS v4u*)(Bf + sw256(i, 2 * s8)) = (v4u){pk2(v[0][0], v[0][1]), pk2(v[0][2], v[0][3]), pk2(v[1][0], v[1][1]), pk2(v[1][2], v[1][3])};
        *(LAS v4u*)(Bf + sw256(i, 2 * s8 + 1)) = (v4u){pk2(v[2][0], v[2][1]), pk2(v[2][2], v[2][3]), pk2(v[3][0], v[3][1]), pk2(v[3][2], v[3][3])};
    }
    __syncthreads(); GSTAMP(7);
    {
        const int ti = wid >> 1, i = 16 * ti + fr; const float gi = gcs[i], bi = bts[i];
#pragma unroll
        for (int t2 = 0; t2 < 2; ++t2) {
            const int tj = 2 * (wid & 1) + t2;
            f32x4 akk = {0.f, 0.f, 0.f, 0.f}, aqk = {0.f, 0.f, 0.f, 0.f};
            if (tj <= ti) {
#pragma unroll
                for (int ks = 0; ks < 4; ++ks) {
                    const bf16x8 kj = *(const LAS bf16x8*)(KBf + sw256(16 * tj + fr, 4 * ks + fq));
                    const bf16x8 kiv = *(const LAS bf16x8*)(KBf + sw256(i, 4 * ks + fq)), qiv = *(const LAS bf16x8*)(QBf + sw256(i, 4 * ks + fq));
                    akk = __builtin_amdgcn_mfma_f32_16x16x32_bf16(kj, kiv, akk, 0, 0, 0);
                    aqk = __builtin_amdgcn_mfma_f32_16x16x32_bf16(kj, qiv, aqk, 0, 0, 0);
                }
            }
            f32x4 lv, qv; const f32x4 gj = *(const LAS f32x4*)(gcs + 16 * tj + 4 * fq);
#pragma unroll
            for (int jj = 0; jj < 4; ++jj) { const int j = 16 * tj + 4 * fq + jj; const float dec = (j <= i) ? __expf(gi - gj[jj]) : 0.f;
                lv[jj] = (j < i) ? bi * akk[jj] * dec : 0.f; qv[jj] = (j <= i) ? aqk[jj] * dec : 0.f; }
            *(LAS f32x4*)(Lm + i * LS + 16 * tj + 4 * fq) = lv;
            *(LAS v2u*)(Lb + sw128(i, (16 * tj + 4 * fq) >> 3) + ((4 * fq) & 7) * 2) = (v2u){pk2(-lv[0], -lv[1]), pk2(-lv[2], -lv[3])};
            v2u qo; qo.x = pk2(qv[0], qv[1]); qo.y = pk2(qv[2], qv[3]);
            *(v2u*)(QKM + (size_t)i * 64 + 16 * tj + 4 * fq) = qo;
        }
    }
    __syncthreads(); GSTAMP(8);
    if (tid < 64) {
        const int bb = tid >> 4, c = tid & 15; const LAS float* Lp = Lm + (16 * bb) * LS + 16 * bb;
        float y[16];
#pragma unroll
        for (int r = 0; r < 16; ++r) { float a = (r == c) ? 1.f : 0.f;
#pragma unroll
            for (int j = 0; j < r; ++j) a -= Lp[r * LS + j] * y[j];
            y[r] = a; }
#pragma unroll
        for (int r = 0; r < 16; ++r) *(LAS bf16*)(Nb + ((bb * 16 + r) * 16 + c) * 2) = (bf16)f2bf(y[r] - ((r == c) ? 1.f : 0.f));
    } else if (tid >= 256) {
        const int t2 = tid - 256;
        { const int i = t2 >> 2, d0 = (t2 & 3) * 32; const float e = __expf(gcs[i]);
#pragma unroll
          for (int q8 = 0; q8 < 4; ++q8) { const f32x4 a = *(const LAS f32x4*)(XQ + i * XS + d0 + 8 * q8), c = *(const LAS f32x4*)(XQ + i * XS + d0 + 8 * q8 + 4);
              v4u o; o.x = pk2(a[0] * e, a[1] * e); o.y = pk2(a[2] * e, a[3] * e); o.z = pk2(c[0] * e, c[1] * e); o.w = pk2(c[2] * e, c[3] * e);
              *(v4u*)(QG + (size_t)i * 128 + d0 + 8 * q8) = o; } }
        { const int d = t2 >> 1, i0 = (t2 & 1) * 32; const float gl = gcs[63];
#pragma unroll
          for (int q8 = 0; q8 < 4; ++q8) { float v[8];
#pragma unroll
              for (int e = 0; e < 8; ++e) { const int i = i0 + 8 * q8 + e; v[e] = XK[i * XS + d] * __expf(gl - gcs[i]); }
              v4u o; o.x = pk2(v[0], v[1]); o.y = pk2(v[2], v[3]); o.z = pk2(v[4], v[5]); o.w = pk2(v[6], v[7]);
              *(v4u*)(KGT + (size_t)d * 64 + i0 + 8 * q8) = o; } }
        if (t2 == 0) GL[unit] = __expf(gcs[63]);
    }
    __syncthreads();
    {
        LAS unsigned char* Xt = KBf + wid * 4096;
        const bool isv = wid < 4;
        f32x4 xacc[2];
#pragma unroll
        for (int bb = 0; bb < 4; ++bb) {
            const f32x4 scv = *(const LAS f32x4*)((isv ? bts : sks) + 16 * bb + 4 * fq);
            bf16x8 nf = (bf16x8){0, 0, 0, 0, 0, 0, 0, 0};
            if (fq < 2) nf = *(const LAS bf16x8*)(Nb + (bb * 16 + fr) * 32 + fq * 16);
#pragma unroll
            for (int t = 0; t < 2; ++t) {
                const int colw = 16 * t + fr, col = 32 * wid + colw;
                const LAS float* Xs = isv ? (XV + col) : (XK + (col - 128));
#pragma unroll
                for (int j = 0; j < 4; ++j) xacc[t][j] = Xs[(16 * bb + 4 * fq + j) * XS] * scv[j];
#pragma unroll
                for (int ks = 0; ks < 2; ++ks) if (32 * ks < 16 * bb) {
                    bf16x8 a = *(const LAS bf16x8*)(Lb + sw128(16 * bb + fr, 4 * ks + fq));
                    bf16x8 xb = *(const LAS bf16x8*)(Xt + sw128(colw, 4 * ks + fq));
                    if (32 * ks + 8 * fq >= 16 * bb) { a = (bf16x8){0, 0, 0, 0, 0, 0, 0, 0}; xb = a; }
                    xacc[t] = __builtin_amdgcn_mfma_f32_16x16x32_bf16(a, xb, xacc[t], 0, 0, 0);
                }
                LAS unsigned char* xp = Xt + sw128(colw, (16 * bb + 4 * fq) >> 3) + ((4 * fq) & 7) * 2;
                *(LAS v2u*)xp = (v2u){pk2(xacc[t][0], xacc[t][1]), pk2(xacc[t][2], xacc[t][3])};
                bf16x8 rb = (bf16x8){0, 0, 0, 0, 0, 0, 0, 0};
                if (fq < 2) rb = *(const LAS bf16x8*)(Xt + sw128(colw, 2 * bb + fq));
                xacc[t] = __builtin_amdgcn_mfma_f32_16x16x32_bf16(nf, rb, xacc[t], 0, 0, 0);
                *(LAS v2u*)xp = (v2u){pk2(xacc[t][0], xacc[t][1]), pk2(xacc[t][2], xacc[t][3])};
                if (isv) *(f32x4*)(UT + (size_t)col * 64 + 16 * bb + 4 * fq) = xacc[t];
                else {
#pragma unroll
                    for (int j = 0; j < 4; ++j) WN[(size_t)(16 * bb + 4 * fq + j) * 128 + (col - 128)] = (bf16)f2bf(-xacc[t][j]);
                }
            }
        }
    }
    __syncthreads(); GSTAMP(10);
    }
}
#undef GDNA_LOAD

__device__ __forceinline__ void gdnb_unit(const Params& P, LAS unsigned char* lds, int bh) {
    typedef float f32x4_ __attribute__((ext_vector_type(4)));
    const int tid = threadIdx.x, wid = __builtin_amdgcn_readfirstlane(tid >> 6), lane = tid & 63, fr = lane & 15, fq = lane >> 4;
    const int b = bh >> 2, h = bh & 3;
    const float* w_gnorm = P.in[14];
    const bf16* ZB = (const bf16*)(P.ws + WS_ZB); bf16* MIX = (bf16*)(P.ws + WS_MIX);
    LAS unsigned char* Wl = lds;
    LAS unsigned char* Ql = lds + 16384;
    LAS unsigned char* Kl = lds + 32768;
    LAS unsigned char* Ml = lds + 49152;
    LAS unsigned char* STl = lds + 57344;
    LAS unsigned char* VTl = lds + 90112;
    LAS float* OT = (LAS float*)(lds + 106496);
    f32x4_ S[8];
#pragma unroll
    for (int i = 0; i < 8; ++i) S[i] = (f32x4_){0.f, 0.f, 0.f, 0.f};
    const int e = 16 * wid + fr;
#pragma unroll
    for (int db = 0; db < 8; ++db) *(LAS v2u*)(STl + sw256(e, (16 * db + 4 * fq) >> 3) + ((4 * fq) & 7) * 2) = (v2u){0u, 0u};
    const int orow = tid >> 3, ocol = (tid & 7) * 16;
    LAS float* GNl = OT + 64 * XS;
    if (tid < 128) GNl[tid] = w_gnorm[tid];
    const size_t ubase = (size_t)bh * 32;
    v4u aW[2], aQ[2], aK[2], aM; f32x4_ utn[4]; float gln;
#define SCAN_LOAD(n_) do { const size_t un_ = ubase + (n_); \
        const v4u* WNp = (const v4u*)((const bf16*)(P.ws + WS_WN) + un_ * 8192); const v4u* QGp = (const v4u*)((const bf16*)(P.ws + WS_QG) + un_ * 8192); \
        const v4u* KGp = (const v4u*)((const bf16*)(P.ws + WS_KGT) + un_ * 8192); const v4u* QKp = (const v4u*)((const bf16*)(P.ws + WS_QKM) + un_ * 4096); \
        const float* UTp = (const float*)(P.ws + WS_UT) + un_ * 8192; gln = ((const float*)(P.ws + WS_GL))[un_]; \
        aW[0] = WNp[tid]; aW[1] = WNp[tid + 512]; aQ[0] = QGp[tid]; aQ[1] = QGp[tid + 512]; aK[0] = KGp[tid]; aK[1] = KGp[tid + 512]; aM = QKp[tid]; \
        _Pragma("unroll") for (int rb_ = 0; rb_ < 4; ++rb_) utn[rb_] = *(const f32x4_*)(UTp + (size_t)e * 64 + 16 * rb_ + 4 * fq); } while (0)
#define SCAN_STAGE() do { \
        _Pragma("unroll") for (int i_ = 0; i_ < 2; ++i_) { const int idx_ = tid + 512 * i_; \
            *(LAS v4u*)(Wl + sw256(idx_ >> 4, idx_ & 15)) = aW[i_]; *(LAS v4u*)(Ql + sw256(idx_ >> 4, idx_ & 15)) = aQ[i_]; *(LAS v4u*)(Kl + sw128(idx_ >> 3, idx_ & 7)) = aK[i_]; } \
        *(LAS v4u*)(Ml + sw128(tid >> 3, tid & 7)) = aM; } while (0)
    SCAN_LOAD(0);
    SCAN_STAGE();
    for (int n = 0; n < NCHUNK; ++n) {
        __syncthreads();
        f32x4_ vn[4];
#pragma unroll
        for (int rb = 0; rb < 4; ++rb) vn[rb] = utn[rb];
        const size_t mrow = (size_t)b * SEQ + n * GCH + orow;
        const v4u z0 = *(const v4u*)(ZB + mrow * 512 + h * 128 + ocol), z1 = *(const v4u*)(ZB + mrow * 512 + h * 128 + ocol + 8);
        const float gl = gln;
        if (n + 1 < NCHUNK) SCAN_LOAD(n + 1);
        __builtin_amdgcn_sched_barrier(0);
        bf16x8 sb[4];
#pragma unroll
        for (int ks = 0; ks < 4; ++ks) sb[ks] = *(const LAS bf16x8*)(STl + sw256(e, 4 * ks + fq));
#pragma unroll
        for (int rb = 0; rb < 4; ++rb) {
#pragma unroll
            for (int ks = 0; ks < 4; ++ks) { const bf16x8 a = *(const LAS bf16x8*)(Wl + sw256(16 * rb + fr, 4 * ks + fq)); vn[rb] = __builtin_amdgcn_mfma_f32_16x16x32_bf16(a, sb[ks], vn[rb], 0, 0, 0); }
            v2u o; o.x = pk2(vn[rb][0], vn[rb][1]); o.y = pk2(vn[rb][2], vn[rb][3]);
            *(LAS v2u*)(VTl + sw128(e, (16 * rb + 4 * fq) >> 3) + ((4 * fq) & 7) * 2) = o;
        }
        bf16x8 vb[2];
#pragma unroll
        for (int ks = 0; ks < 2; ++ks) vb[ks] = *(const LAS bf16x8*)(VTl + sw128(e, 4 * ks + fq));
#pragma unroll
        for (int rb = 0; rb < 4; ++rb) {
            f32x4_ oo = (f32x4_){0.f, 0.f, 0.f, 0.f};
#pragma unroll
            for (int ks = 0; ks < 4; ++ks) { const bf16x8 a = *(const LAS bf16x8*)(Ql + sw256(16 * rb + fr, 4 * ks + fq)); oo = __builtin_amdgcn_mfma_f32_16x16x32_bf16(a, sb[ks], oo, 0, 0, 0); }
#pragma unroll
            for (int ks = 0; ks < 2; ++ks) { const bf16x8 a = *(const LAS bf16x8*)(Ml + sw128(16 * rb + fr, 4 * ks + fq)); oo = __builtin_amdgcn_mfma_f32_16x16x32_bf16(a, vb[ks], oo, 0, 0, 0); }
#pragma unroll
            for (int j = 0; j < 4; ++j) OT[(16 * rb + 4 * fq + j) * XS + e] = oo[j];
        }
#pragma unroll
        for (int db = 0; db < 8; ++db) {
            S[db] = S[db] * gl;
#pragma unroll
            for (int ks = 0; ks < 2; ++ks) { const bf16x8 a = *(const LAS bf16x8*)(Kl + sw128(16 * db + fr, 4 * ks + fq)); S[db] = __builtin_amdgcn_mfma_f32_16x16x32_bf16(a, vb[ks], S[db], 0, 0, 0); }
            v2u o; o.x = pk2(S[db][0], S[db][1]); o.y = pk2(S[db][2], S[db][3]);
            *(LAS v2u*)(STl + sw256(e, (16 * db + 4 * fq) >> 3) + ((4 * fq) & 7) * 2) = o;
        }
        __syncthreads();
        if (n + 1 < NCHUNK) SCAN_STAGE();
        {
            f32x4_ ov[4]; float ss = 0.f;
#pragma unroll
            for (int i = 0; i < 4; ++i) { ov[i] = *(const LAS f32x4_*)(OT + orow * XS + ocol + 4 * i); ss += (ov[i][0] * ov[i][0] + ov[i][1] * ov[i][1]) + (ov[i][2] * ov[i][2] + ov[i][3] * ov[i][3]); }
            ss += __shfl_xor(ss, 1); ss += __shfl_xor(ss, 2); ss += __shfl_xor(ss, 4);
            const float rstd = 1.0f / sqrtf(ss * (1.0f / 128.0f) + RMS_EPS);
            f32x4_ gn4[4];
#pragma unroll
            for (int i = 0; i < 4; ++i) gn4[i] = *(const LAS f32x4_*)(GNl + ocol + 4 * i);
            const unsigned zw[8] = {z0.x, z0.y, z0.z, z0.w, z1.x, z1.y, z1.z, z1.w};
            unsigned ow[8];
#pragma unroll
            for (int i = 0; i < 8; ++i) { const float za = __builtin_bit_cast(float, zw[i] << 16), zb = __builtin_bit_cast(float, zw[i] & 0xffff0000u);
                const float va = ov[i >> 1][(2 * i) & 3] * rstd * gn4[i >> 1][(2 * i) & 3] * silu_f(za), vb_ = ov[i >> 1][(2 * i + 1) & 3] * rstd * gn4[i >> 1][(2 * i + 1) & 3] * silu_f(zb);
                ow[i] = pk2(va, vb_); }
            bf16* mp = MIX + mrow * DM + 512 + h * 128 + ocol;
            *(v4u*)mp = (v4u){ow[0], ow[1], ow[2], ow[3]}; *(v4u*)(mp + 8) = (v4u){ow[4], ow[5], ow[6], ow[7]};
        }
        asm volatile("" : "+v"(utn[0]), "+v"(utn[1]), "+v"(utn[2]), "+v"(utn[3]), "+v"(gln));
    }
#undef SCAN_LOAD
#undef SCAN_STAGE
    float* So = P.out + OSSM_P + (size_t)bh * 16384;
#pragma unroll
    for (int db = 0; db < 8; ++db)
#pragma unroll
        for (int j = 0; j < 4; ++j) So[(size_t)(16 * db + 4 * fq + j) * 128 + e] = S[db][j];
    __syncthreads();
}


__device__ __forceinline__ f32x4 sgemm_slice16(const bf16* A, int lda, const bf16* Bt, int ldb, int n0, int k0, int k1, int wid, int fr, int fq) {
    f32x4 acc = {0.f, 0.f, 0.f, 0.f};
    const bf16* ap = A + (size_t)(16 * wid + fr) * lda + 8 * fq;
    const bf16* bp = Bt + (size_t)(n0 + fr) * ldb + 8 * fq;
#pragma unroll 16
    for (int ks = k0; ks < k1; ks += 32) {
        const bf16x8 a = *(const bf16x8*)(ap + ks), b = *(const bf16x8*)(bp + ks);
        acc = __builtin_amdgcn_mfma_f32_16x16x32_bf16(b, a, acc, 0, 0, 0);
    }
    return acc;
}
__device__ __forceinline__ void sample_wo_slice(const Params& P, int slice) {
    const int tid = threadIdx.x, wid = __builtin_amdgcn_readfirstlane(tid >> 6), lane = tid & 63, fr = lane & 15, fq = lane >> 4;
    const bf16* MIX = (const bf16*)(P.ws + WS_MIX) + (size_t)MP * DM; const bf16* WOT = (const bf16*)(P.ws + WS_WOT);
    bf16* HB = (bf16*)(P.ws + WS_HB) + (size_t)MP * DM; float* SSQS = (float*)(P.ws + WS_SSQS);
    const f32x4 acc = sgemm_slice16(MIX, DM, WOT, DM, 16 * slice, 0, DM, wid, fr, fq);
    const int m = 16 * wid + fr, n = 16 * slice + 4 * fq;
    const f32x4 h = acc + *(const f32x4*)(P.in[1] + (size_t)m * DM + n);
    *(f32x4*)(P.out + OY_S + (size_t)m * DM + n) = h;
    v2u o; o.x = pk2(h[0], h[1]); o.y = pk2(h[2], h[3]); *(v2u*)(HB + (size_t)m * DM + n) = o;
    float s = (h[0] * h[0] + h[1] * h[1]) + (h[2] * h[2] + h[3] * h[3]);
    s += __shfl_xor(s, 16); s += __shfl_xor(s, 32);
    if (fq == 0) SSQS[m * 64 + slice] = s;
}
__device__ __forceinline__ void sample_up_slice(const Params& P, int slice) {
    const int tid = threadIdx.x, wid = __builtin_amdgcn_readfirstlane(tid >> 6), lane = tid & 63, fr = lane & 15, fq = lane >> 4;
    const bf16* HB = (const bf16*)(P.ws + WS_HB) + (size_t)MP * DM; const bf16* WUPT = (const bf16*)(P.ws + WS_WUPT);
    bf16* UB = (bf16*)(P.ws + WS_UB) + (size_t)MP * FF; const float* SSQS = (const float*)(P.ws + WS_SSQS);
    const int m = 16 * wid + fr, n = 16 * slice + 4 * fq;
    float ss = 0.f;
#pragma unroll
    for (int i = 0; i < 4; ++i) { const f32x4 t = *(const f32x4*)(SSQS + m * 64 + 16 * fq + 4 * i); ss += (t[0] + t[1]) + (t[2] + t[3]); }
    ss += __shfl_xor(ss, 16); ss += __shfl_xor(ss, 32);
    const float rstd = 1.0f / sqrtf(ss * (1.0f / DM) + RMS_EPS);
    const f32x4 acc = sgemm_slice16(HB, DM, WUPT, DM, 16 * slice, 0, DM, wid, fr, fq);
    float u[4];
#pragma unroll
    for (int j = 0; j < 4; ++j) { const float p = fmaxf(acc[j] * rstd, 0.f); u[j] = p * p; }
    v2u o; o.x = pk2(u[0], u[1]); o.y = pk2(u[2], u[3]); *(v2u*)(UB + (size_t)m * FF + n) = o;
}
__device__ __forceinline__ void sample_down_slice(const Params& P, int item) {
    const int tid = threadIdx.x, wid = __builtin_amdgcn_readfirstlane(tid >> 6), lane = tid & 63, fr = lane & 15, fq = lane >> 4;
    const bf16* UB = (const bf16*)(P.ws + WS_UB) + (size_t)MP * FF; const bf16* WDNT = (const bf16*)(P.ws + WS_WDNT);
    float* PART = (float*)(P.ws + WS_PART);
    const int slice = item & 63, q = item >> 6;
    const f32x4 acc = sgemm_slice16(UB, FF, WDNT, FF, 16 * slice, 1024 * q, 1024 * q + 1024, wid, fr, fq);
    const int m = 16 * wid + fr, n = 16 * slice + 4 * fq;
    *(f32x4*)(PART + ((size_t)q * DECB + m) * DM + n) = acc;
}

__device__ __forceinline__ void phase_final(const Params& P, const Ctx& C) {
    const float* ln_f = P.in[19]; const float* SSQ2 = (const float*)(P.ws + WS_SSQ2);
    const int gw = C.vcu * NWAVES + C.wave, NGW = C.G * NWAVES, lane = C.lane;
    f32x4 lw[4];
#pragma unroll
    for (int j = 0; j < 4; ++j) lw[j] = ((const f32x4*)ln_f)[lane + 64 * j];
    for (int m = gw; m < M_TOT; m += NGW) {
        if (m < MP) {
            const f32x4* sp = (const f32x4*)(SSQ2 + (size_t)m * 16);
            const f32x4 a = sp[0], b = sp[1], c = sp[2], d = sp[3];
            const float ss = ((a[0] + a[1]) + (a[2] + a[3])) + ((b[0] + b[1]) + (b[2] + b[3])) + ((c[0] + c[1]) + (c[2] + c[3])) + ((d[0] + d[1]) + (d[2] + d[3]));
            const float rstd = 1.0f / sqrtf(ss * (1.0f / DM) + RMS_EPS);
            float* yr = P.out + OY_P + (size_t)m * DM;
#pragma unroll
            for (int j = 0; j < 4; ++j) { f32x4 v = ((const f32x4*)yr)[lane + 64 * j]; v = v * rstd * lw[j]; ((f32x4*)yr)[lane + 64 * j] = v; }
        } else {
            const int r = m - MP; float* yr = P.out + OY_S + (size_t)r * DM; const float* PART = (const float*)(P.ws + WS_PART);
            f32x4 v[4]; float ss = 0.f;
#pragma unroll
            for (int j = 0; j < 4; ++j) { v[j] = ((const f32x4*)yr)[lane + 64 * j];
#pragma unroll
                for (int q = 0; q < 4; ++q) v[j] += ((const f32x4*)(PART + ((size_t)q * DECB + r) * DM))[lane + 64 * j];
                ss += (v[j][0] * v[j][0] + v[j][1] * v[j][1]) + (v[j][2] * v[j][2] + v[j][3] * v[j][3]); }
            ss = wave_sum(ss);
            const float rstd = 1.0f / sqrtf(ss * (1.0f / DM) + RMS_EPS);
#pragma unroll
            for (int j = 0; j < 4; ++j) ((f32x4*)yr)[lane + 64 * j] = v[j] * rstd * lw[j];
        }
    }
}

constexpr int NPHASES = 8;
__global__ void __launch_bounds__(NWAVES * 64, 2) fwd_kernel(Params P) {
    extern __shared__ __attribute__((aligned(16))) unsigned char shm[];
    LAS unsigned char* lds = (LAS unsigned char*)shm;
    Ctx C; C.tid = threadIdx.x; C.lane = C.tid & 63; C.wave = __builtin_amdgcn_readfirstlane(C.tid >> 6);
    C.G = gridDim.x; { const int bx = blockIdx.x; C.vcu = (C.G % 8 == 0) ? (bx % 8) * (C.G / 8) + bx / 8 : bx; }
    volatile LAS unsigned* MISC = (volatile LAS unsigned*)(lds + MISC_OFF);
    if (C.tid < 64) MISC[C.tid] = 0u;
    __syncthreads();
    unsigned* ctl = (unsigned*)(P.ws + WS_CTL);
    const int lo = P.ph_lo, hi = P.ph_hi;
    XcdBarrier bar; bar.bar = ctl + CW_BAR; bar.x = 0; bar.st = nullptr;
    if (hi - lo > 1) bar = xcd_barrier_post(ctl + CW_BAR, MISC + 8);
#ifndef REPEAT_MASK
#define REPEAT_MASK 0
#endif
#define NREP(k) (((REPEAT_MASK >> (k)) & 1) ? 2 : 1)
#ifndef SUBMASK
#define SUBMASK 15
#endif
#ifndef PHASE_MASK
#define PHASE_MASK 0xff
#endif
#define IN(k) (((PHASE_MASK >> (k)) & 1) && lo <= (k) && (k) < hi)
#if 0
#define PROBE_K -1
#endif
#define PROBE_MULT 4
#define STAMP(j) do { if (PROBE_K >= 0 && blockIdx.x == 0 && C.tid == 0) { const unsigned long long t_ = __builtin_amdgcn_s_memrealtime(); MISC[16 + 2 * (j)] = (unsigned)t_; MISC[17 + 2 * (j)] = (unsigned)(t_ >> 32); } } while (0)
#define RSTAMP(id, who) do { if (PROBE_K >= 10 && C.vcu == (who) && C.tid == 0) { const unsigned long long t_ = __builtin_amdgcn_s_memrealtime(); __hip_atomic_store(ctl + 512 + 2 * (id), (unsigned)t_, __ATOMIC_RELAXED, __HIP_MEMORY_SCOPE_AGENT); __hip_atomic_store(ctl + 513 + 2 * (id), (unsigned)(t_ >> 32), __ATOMIC_RELAXED, __HIP_MEMORY_SCOPE_AGENT); } } while (0)
#define SEAM(k) do { if (IN(k) && IN((k) + 1)) xcd_barrier(bar); STAMP((k) + 1); } while (0)
    unsigned char* ws = P.ws;
    STAMP(0);

    if (IN(0)) { for (int rep = 0; rep < NREP(0); ++rep) phase_prep(P, C, lds); SEAM(0); }

    if (IN(1)) {
        if (C.wave == 0) for (int bh = C.vcu; bh < NB * NH; bh += C.G) kbias_seq(P, bh, C.lane);
        for (int rep = 0; rep < NREP(1); ++rep) {
        pg8::Gemm g{(const pg8::bf16_t*)(ws + WS_XN), (const pg8::bf16_t*)(ws + WS_W1T), M_PAD, N1, DM};
        pg8::StaticOrder S; S.init(M_PAD, N1, C.G, (int)blockIdx.x);
        pg8::EpiIn E{(pg8::bf16_t*)(ws + WS_QB), (float*)(ws + WS_QS), (pg8::bf16_t*)(ws + WS_CB), (pg8::bf16_t*)(ws + WS_ZB), P.out};
        pg8::gemm_phase<pg8::EpiIn, pg8::StaticOrder, true, true>(lds, g, S, E);
        }
        SEAM(1);
    }

    if (IN(2)) {
#if SUBMASK & 8
        gdna_units(P, lds, C.vcu, C.G, NREP(5) * NB * NH * NCHUNK);
#endif
        SEAM(2);
    }

    if (IN(3)) {
        for (int it = C.vcu; it < 256; it += C.G) { const int xg = it >> 5, slot = it & 31; if (slot < 4) { for (int rep = 0; rep < NREP(6); ++rep) gdnb_unit(P, lds, xg + 8 * slot); } }
        RSTAMP(0, 0);
#if SUBMASK & 1
        for (int it = C.vcu; it < 256; it += C.G) {
            const int xg = it >> 5, slot = it & 31;
            if (slot < 4 || slot >= 16) continue;
            const int j = slot - 4, bh = xg * 4 + j / 3, g = j % 3, b = bh >> 2, h = bh & 3;
            const bf16* Qh = (const bf16*)(ws + WS_QB) + (size_t)bh * SEQ * HD; const bf16* Kh = (const bf16*)(ws + WS_KB) + (size_t)bh * SEQ * HD; const bf16* Vh = (const bf16*)(ws + WS_VB) + (size_t)bh * SEQ * HD;
            const float* kbias = (const float*)(ws + WS_KBIAS) + (size_t)bh * SEQ;
            bf16* Orow0 = (bf16*)(ws + WS_MIX) + (size_t)b * SEQ * DM + h * HD;
            const int nblk = (g == 2 ? 4 : 2) * NREP(2);
            for (int k2 = 0; k2 < nblk; ++k2) { const int k = k2 & 3; const int qb = g == 0 ? ((k & 1) == 0 ? 7 : 3) : (g == 1 ? ((k & 1) == 0 ? 6 : 4) : (k == 0 ? 5 : 3 - k)); fox::fox_block((char*)shm, Qh, Kh, Vh, kbias, Orow0, qb); }
        }
        RSTAMP(1, 4); RSTAMP(2, 6);
#endif
#if SUBMASK & 2
        for (int it = C.vcu; it < NREP(3) * 256; it += C.G) { const int xg = (it & 255) >> 5, slot = it & 31; if (slot >= 16) decode_unit(P, lds, xg * 16 + (slot - 16)); }
        RSTAMP(3, 16);
#endif
#if SUBMASK & 4
        for (int it = C.vcu; it < 256; it += C.G) { const int xg = it >> 5, slot = it & 31; if (slot >= 16) sgdn_unit(P, lds, xg * 16 + (slot - 16)); }
        RSTAMP(4, 16);
#endif
        SEAM(3);
    }

    if (IN(4)) {
        for (int rep = 0; rep < NREP(9); ++rep) for (int it = blockIdx.x; it < 64; it += C.G) sample_wo_slice(P, it);
        pg8::Gemm g{(const pg8::bf16_t*)(ws + WS_MIX), (const pg8::bf16_t*)(ws + WS_WOT), MP, DM, DM};
        pg8::StaticOrder S; S.init(MP, DM, C.G, (int)blockIdx.x);
        pg8::EpiRes E{P.in[0], (float*)(ws + WS_HF), (pg8::bf16_t*)(ws + WS_HB), (float*)(ws + WS_SSQ)};
        pg8::gemm_phase<pg8::EpiRes, pg8::StaticOrder, true, true>(lds, g, S, E);
#if (REPEAT_MASK >> 7) & 1
        pg8::gemm_phase<pg8::EpiRes, pg8::StaticOrder, true, true>(lds, g, S, E);
#endif
        SEAM(4);
    }

    if (IN(5)) {
        for (int rep = 0; rep < NREP(10); ++rep) for (int it = blockIdx.x; it < 256; it += C.G) sample_up_slice(P, it);
        pg8::Gemm g{(const pg8::bf16_t*)(ws + WS_HB), (const pg8::bf16_t*)(ws + WS_WUPT), MP, FF, DM};
        pg8::StaticOrder S; S.init(MP, FF, C.G, (int)blockIdx.x);
        pg8::EpiUp E{(pg8::bf16_t*)(ws + WS_UB), (const float*)(ws + WS_SSQ)};
        pg8::gemm_phase<pg8::EpiUp, pg8::StaticOrder, true, true>(lds, g, S, E);
#if (REPEAT_MASK >> 8) & 1
        pg8::gemm_phase<pg8::EpiUp, pg8::StaticOrder, true, true>(lds, g, S, E);
#endif
        SEAM(5);
    }

    if (IN(6)) {
        for (int rep = 0; rep < NREP(11); ++rep) for (int it = blockIdx.x; it < 256; it += C.G) sample_down_slice(P, it);
        pg8::Gemm g{(const pg8::bf16_t*)(ws + WS_UB), (const pg8::bf16_t*)(ws + WS_WDNT), MP, DM, FF};
        pg8::StaticOrder S; S.init(MP, DM, C.G, (int)blockIdx.x);
        pg8::EpiDown E{(const float*)(ws + WS_HF), P.out, (float*)(ws + WS_SSQ2)};
        pg8::gemm_phase<pg8::EpiDown, pg8::StaticOrder, true, true>(lds, g, S, E);
#if (REPEAT_MASK >> 12) & 1
        pg8::gemm_phase<pg8::EpiDown, pg8::StaticOrder, true, true>(lds, g, S, E);
#endif
        SEAM(6);
    }

    if (IN(7)) phase_final(P, C);
    if (PROBE_K >= 0 && blockIdx.x == 0 && C.tid == 0) {
        STAMP(8);
        unsigned long long t0, t1;
        if (PROBE_K >= 10) { const int sb_ = (PROBE_K - 10 >= 5) ? 2 : 3; t0 = ((unsigned long long)MISC[17 + 2 * sb_] << 32) | MISC[16 + 2 * sb_];
            t1 = ((unsigned long long)__hip_atomic_load(ctl + 513 + 2 * (PROBE_K - 10), __ATOMIC_RELAXED, __HIP_MEMORY_SCOPE_AGENT) << 32) | __hip_atomic_load(ctl + 512 + 2 * (PROBE_K - 10), __ATOMIC_RELAXED, __HIP_MEMORY_SCOPE_AGENT); }
        else { t0 = ((unsigned long long)MISC[17 + 2 * (PROBE_K < 10 ? PROBE_K : 0)] << 32) | MISC[16 + 2 * (PROBE_K < 10 ? PROBE_K : 0)]; t1 = ((unsigned long long)MISC[19 + 2 * (PROBE_K < 10 ? PROBE_K : 0)] << 32) | MISC[18 + 2 * (PROBE_K < 10 ? PROBE_K : 0)]; }
        const unsigned long long until = __builtin_amdgcn_s_memrealtime() + PROBE_MULT * (t1 - t0);
        while (__builtin_amdgcn_s_memrealtime() < until) __builtin_amdgcn_s_sleep(8);
    }
#undef IN
#undef SEAM
}

#ifndef N_LAUNCH_MODE
#define N_LAUNCH_MODE 1
#endif
extern "C" void kernel_launch(void* const* d_in, const int* in_sizes, int n_in, void* d_out, int out_size, void* d_ws, size_t ws_size, hipStream_t stream) {
    static int grid = 0;
    if (grid == 0) {
        if (n_in != 20 || out_size != (int)OUT_TOTAL || ws_size < WS_END) { fprintf(stderr, "kernel_launch: unexpected shapes (n_in %d, out %d, ws %zu); nothing launched\n", n_in, out_size, ws_size); grid = -1; return; }
        int dev = 0, cus = 0, per_cu = 0;
        if (hipGetDevice(&dev) != hipSuccess || hipDeviceGetAttribute(&cus, hipDeviceAttributeMultiprocessorCount, dev) != hipSuccess) { grid = -1; return; }
        if (hipFuncSetAttribute((const void*)fwd_kernel, hipFuncAttributeMaxDynamicSharedMemorySize, LDS_BYTES) != hipSuccess) { fprintf(stderr, "kernel_launch: hipFuncSetAttribute failed\n"); grid = -1; return; }
        if (hipOccupancyMaxActiveBlocksPerMultiprocessor(&per_cu, (const void*)fwd_kernel, NWAVES * 64, LDS_BYTES) != hipSuccess || per_cu < 1)
            fprintf(stderr, "kernel_launch: note: occupancy query reports %d workgroups per CU\n", per_cu);
        (void)hipGetLastError();
        grid = cus;
    }
    if (grid < 0) return;
    if (hipMemsetAsync((char*)d_ws + WS_CTL, 0, CTL_ZERO_BYTES, stream) != hipSuccess) return;
    Params p{};
    for (int i = 0; i < 20; ++i) p.in[i] = (const float*)d_in[i];
    p.out = (float*)d_out; p.ws = (unsigned char*)d_ws;
    if (N_LAUNCH_MODE == 1) {
        p.ph_lo = 0; p.ph_hi = NPHASES;
        hipLaunchKernelGGL(fwd_kernel, dim3(grid), dim3(NWAVES * 64), LDS_BYTES, stream, p);
    } else {
        for (int k = 0; k < NPHASES; ++k) { p.ph_lo = k; p.ph_hi = k + 1; hipLaunchKernelGGL(fwd_kernel, dim3(grid), dim3(NWAVES * 64), LDS_BYTES, stream, p); }
    }
}
```

```cpp
#include <hip/hip_runtime.h>
#include <hip/hip_bf16.h>
#include <cstdio>
#include <cstdint>

constexpr int DM = 1024, NB = 8, SEQ = 2048, DECB = 128, PAST = 2048, PAGE = 128, NPAGES = 16;
constexpr int NH = 4, HD = 128, CONVD = 1536, FF = 4096, INDIM = 3596, GCH = 64, NCHUNK = SEQ / GCH;
constexpr int MP = NB * SEQ;
constexpr int M_TOT = MP + DECB;
constexpr int M_PAD = 16640;
constexpr int N1 = 3584;
constexpr float RMS_EPS = 1e-6f, L2_EPS = 1e-6f;
constexpr float ATT_SCALE = 0.08838834764831845f;
constexpr size_t OY_P = 0, OY_S = 16777216, OK_P = 16908288, OV_P = 25296896, OLF_P = 33685504, OCONV_P = 33751040, OSSM_P = 33787904,
                 OK_S = 34312192, OV_S = 34377728, OLF_S = 34443264, OCONV_S = 34443776, OSSM_S = 35033600, OUT_TOTAL = 43422208;
constexpr size_t MiB = 1u << 20;
constexpr size_t WS_CTL = 0, CTL_ZERO_BYTES = 1 * MiB;
constexpr size_t WS_W1T = 2 * MiB, WS_WOT = 10 * MiB, WS_WUPT = 12 * MiB, WS_WDNT = 21 * MiB;
constexpr size_t WS_XN = 32 * MiB, WS_QB = 68 * MiB, WS_KB = 84 * MiB, WS_VB = 100 * MiB, WS_CB = 116 * MiB, WS_ZB = 166 * MiB;
constexpr size_t WS_MIX = 184 * MiB, WS_HB = 218 * MiB, WS_UB = 252 * MiB;
constexpr size_t WS_UT = 384 * MiB, WS_WN = 416 * MiB, WS_QG = 432 * MiB, WS_KGT = 448 * MiB, WS_QKM = 464 * MiB;
constexpr size_t WS_LF = 472 * MiB, WS_BETA = 473 * MiB, WS_G = 474 * MiB, WS_KBIAS = 475 * MiB, WS_QS = 476 * MiB, WS_SSQ = 477 * MiB, WS_SSQ2 = 479 * MiB, WS_GL = 481 * MiB, WS_SSQS = 482 * MiB, WS_PART = 483 * MiB;
constexpr size_t WS_HF = 32 * MiB;
static_assert(WS_HF + (size_t)MP * DM * 4 <= WS_CB, "h overlays dead buffers only");
constexpr size_t WS_END = 486 * MiB;
constexpr int CW_TMO = 0, CW_BAR = 4096;
constexpr size_t QKV_STRIDE = (WS_KB - WS_QB) / 2;
static_assert(WS_VB - WS_KB == WS_KB - WS_QB, "q/k/v copies equally spaced");

namespace pg8 {
#define PG8_LAS __attribute__((address_space(3)))
typedef unsigned short bf16_t;
typedef short bf16x8 __attribute__((ext_vector_type(8)));
typedef float f32x4 __attribute__((ext_vector_type(4)));
typedef unsigned u32x4 __attribute__((ext_vector_type(4)));
constexpr int BM = 256, BK = 64, HALF = 128, HTB = HALF * BK * 2  , STAGE_BYTES = 8 * HTB, NXCD = 8, WGM = 8;

__host__ __device__ __forceinline__ int lds_byte(int r, int c) { const int st = (r >> 4) * 2 + (c >> 5), rr = r & 15, cc = c & 31, ob = rr * 64 + cc * 2; return st * 1024 + (ob ^ (((ob >> 9) & 1) << 5)); }
__host__ __device__ __forceinline__ void stage_rc(int b, int& R, int& C) { const int st = b / 1024, sb = b % 1024, swz = sb ^ (((sb >> 9) & 1) << 5); R = (st >> 1) * 16 + swz / 64; C = (st & 1) * 32 + (swz % 64) / 2; }
__host__ __device__ __forceinline__ int perm32(int rho) { const int n = rho >> 4, i = rho & 15; return 8 * (i >> 2) + 4 * n + (i & 3); }

struct Unit { int pm, pn; };
struct Gemm { const bf16_t* A; const bf16_t* Bt; int M, N, K; };

struct StaticOrder {
    int nM, nN, nwg, G, c;
    __host__ __device__ void init(int M, int N, int G_, int c_) { nM = M / BM; nN = N / BM; nwg = nM * nN; G = G_; c = c_; }
    __host__ __device__ bool next(int i, Unit& u) const {
        const long L = (long)i * G + c; if (L >= nwg) return false;
        int wgid = (int)L; { const int q = nwg / NXCD, r = nwg % NXCD, xcd = wgid % NXCD, off = wgid / NXCD; wgid = (xcd < r ? xcd * (q + 1) : r * (q + 1) + (xcd - r) * q) + off; }
        const int nig = WGM * nN, gid = wgid / nig, fm = gid * WGM, gsz = (nM - fm) < WGM ? (nM - fm) : WGM;
        u.pm = fm + ((wgid % nig) % gsz); u.pn = (wgid % nig) / gsz; return true;
    }
    __device__ __forceinline__ void a_ready(const Unit&) const {}
    __device__ __forceinline__ void done(const Unit&) const {}
};
__device__ __forceinline__ unsigned cvt_pk_bf16(float lo, float hi) { unsigned r; asm volatile("v_cvt_pk_bf16_f32 %0, %1, %2" : "=v"(r) : "v"(lo), "v"(hi)); return r; }
typedef float f32x2 __attribute__((ext_vector_type(2)));
__device__ __forceinline__ u32x4 pack8_bf16(f32x4 v0, f32x4 v1) { u32x4 w; w.x = cvt_pk_bf16(v0[0], v0[1]); w.y = cvt_pk_bf16(v0[2], v0[3]); w.z = cvt_pk_bf16(v1[0], v1[1]); w.w = cvt_pk_bf16(v1[2], v1[3]); return w; }

struct EpiIn {
    static constexpr bool PERM = true, AFTER_DRAIN = false;
    bf16_t* QB;
    float* QS;
    bf16_t* CB;
    bf16_t* ZB;
    float* out;
    __device__ __forceinline__ void operator()(const f32x4 (&acc)[2][2][4][2], const Unit& u, int wr, int wc, int fr, int fq) const {
        const int pn = u.pn;
#pragma unroll
        for (int ai = 0; ai < 2; ++ai)
#pragma unroll
            for (int m = 0; m < 4; ++m) {
                const int row = u.pm * BM + ai * HALF + wr * 64 + m * 16 + fr;
                if (row >= M_TOT) continue;
#pragma unroll
                for (int bj = 0; bj < 2; ++bj) {
                    const int col = pn * BM + bj * HALF + wc * 32 + 8 * fq;
                    const f32x4 v0 = acc[ai][bj][m][0], v1 = acc[ai][bj][m][1];
                    if (pn < 6) {
                        const int seg = pn >> 1, c = col - seg * 512, h = c >> 7, d = c & 127;
                        if (row < MP) {
                            const int b = row >> 11, t = row & 2047;
                            const size_t idx = ((size_t)((b * NH + h) * SEQ + t)) * HD + d;
                            *(u32x4*)(QB + (size_t)seg * QKV_STRIDE + idx) = pack8_bf16(v0, v1);
                            if (seg != 0) { float* o = out + OK_P + (size_t)(seg - 1) * (OV_P - OK_P) + (size_t)row * 512 + c; *(f32x4*)o = v0; *(f32x4*)(o + 4) = v1; }
                        } else {
                            const int db = row - MP;
                            if (seg == 0) { float* o = QS + (size_t)db * 512 + c; *(f32x4*)o = v0; *(f32x4*)(o + 4) = v1; }
                            else { float* o = out + OK_S + (size_t)(seg - 1) * (OV_S - OK_S) + (size_t)db * 512 + c; *(f32x4*)o = v0; *(f32x4*)(o + 4) = v1; }
                        }
                    } else if (pn < 12) {
                        const int c = col - 1536;
                        *(u32x4*)(CB + (size_t)row * CONVD + c) = pack8_bf16(v0, v1);
                        if (row < MP) {
                            const int t = row & 2047;
                            if (t >= SEQ - 3) { float* o = out + OCONV_P + ((size_t)(row >> 11) * 3 + (t - (SEQ - 3))) * CONVD + c; *(f32x4*)o = v0; *(f32x4*)(o + 4) = v1; }
                        } else {
                            float* o = out + OCONV_S + ((size_t)(row - MP) * 3 + 2) * CONVD + c; *(f32x4*)o = v0; *(f32x4*)(o + 4) = v1;
                        }
                    } else {
                        const int c = col - 3072;
                        *(u32x4*)(ZB + (size_t)row * 512 + c) = pack8_bf16(v0, v1);
                    }
                }
            }
    }
};

struct EpiRes {
    static constexpr bool PERM = true, AFTER_DRAIN = false;
    const float* xp; float* HF; bf16_t* HB; float* SSQ;
    __device__ __forceinline__ void operator()(const f32x4 (&acc)[2][2][4][2], const Unit& u, int wr, int wc, int fr, int fq) const {
#pragma unroll
        for (int ai = 0; ai < 2; ++ai)
#pragma unroll
            for (int m = 0; m < 4; ++m) {
                const int row = u.pm * BM + ai * HALF + wr * 64 + m * 16 + fr;
                const bool ok = row < MP;
                const float* xr = xp + (size_t)(ok ? row : 0) * DM;
                float* hr = HF + (size_t)(ok ? row : 0) * DM;
                float s = 0.f;
#pragma unroll
                for (int bj = 0; bj < 2; ++bj) {
                    const int col = u.pn * BM + bj * HALF + wc * 32 + 8 * fq;
                    if (ok) {
                        const f32x4 v0 = acc[ai][bj][m][0] + *(const f32x4*)(xr + col), v1 = acc[ai][bj][m][1] + *(const f32x4*)(xr + col + 4);
                        *(f32x4*)(hr + col) = v0; *(f32x4*)(hr + col + 4) = v1;
                        *(u32x4*)(HB + (size_t)row * DM + col) = pack8_bf16(v0, v1);
                        s += (v0[0] * v0[0] + v0[1] * v0[1]) + (v0[2] * v0[2] + v0[3] * v0[3]) + (v1[0] * v1[0] + v1[1] * v1[1]) + (v1[2] * v1[2] + v1[3] * v1[3]);
                    }
                }
                s += __shfl_xor(s, 16); s += __shfl_xor(s, 32);
                if (ok && fq == 0) SSQ[(size_t)row * 16 + u.pn * 4 + wc] = s;
            }
    }
};

struct EpiUp {
    static constexpr bool PERM = true, AFTER_DRAIN = false;
    bf16_t* UB; const float* SSQ;
    __device__ __forceinline__ void operator()(const f32x4 (&acc)[2][2][4][2], const Unit& u, int wr, int wc, int fr, int fq) const {
#pragma unroll
        for (int ai = 0; ai < 2; ++ai)
#pragma unroll
            for (int m = 0; m < 4; ++m) {
                const int row = u.pm * BM + ai * HALF + wr * 64 + m * 16 + fr;
                if (row >= M_TOT) continue;
                const f32x4* sp = (const f32x4*)(SSQ + (size_t)row * 16);
                const f32x4 a = sp[0], b = sp[1], c = sp[2], d = sp[3];
                const float ss = ((a[0] + a[1]) + (a[2] + a[3])) + ((b[0] + b[1]) + (b[2] + b[3])) + ((c[0] + c[1]) + (c[2] + c[3])) + ((d[0] + d[1]) + (d[2] + d[3]));
                const float rstd = 1.0f / sqrtf(ss * (1.0f / DM) + RMS_EPS);
#pragma unroll
                for (int bj = 0; bj < 2; ++bj) {
                    const int col = u.pn * BM + bj * HALF + wc * 32 + 8 * fq;
                    f32x4 v0 = acc[ai][bj][m][0] * rstd, v1 = acc[ai][bj][m][1] * rstd;
#pragma unroll
                    for (int j = 0; j < 4; ++j) { const float p = fmaxf(v0[j], 0.f), q = fmaxf(v1[j], 0.f); v0[j] = p * p; v1[j] = q * q; }
                    *(u32x4*)(UB + (size_t)row * FF + col) = pack8_bf16(v0, v1);
                }
            }
    }
};

struct EpiDown {
    static constexpr bool PERM = true, AFTER_DRAIN = false;
    const float* HF; float* out; float* SSQ2;
    __device__ __forceinline__ void operator()(const f32x4 (&acc)[2][2][4][2], const Unit& u, int wr, int wc, int fr, int fq) const {
#pragma unroll
        for (int ai = 0; ai < 2; ++ai)
#pragma unroll
            for (int m = 0; m < 4; ++m) {
                const int row = u.pm * BM + ai * HALF + wr * 64 + m * 16 + fr;
                const bool ok = row < MP;
                const float* hr = HF + (size_t)(ok ? row : 0) * DM;
                float* yr = out + OY_P + (size_t)(ok ? row : 0) * DM;
                float s = 0.f;
#pragma unroll
                for (int bj = 0; bj < 2; ++bj) {
                    const int col = u.pn * BM + bj * HALF + wc * 32 + 8 * fq;
                    if (ok) {
                        const f32x4 v0 = acc[ai][bj][m][0] + *(const f32x4*)(hr + col), v1 = acc[ai][bj][m][1] + *(const f32x4*)(hr + col + 4);
                        *(f32x4*)(yr + col) = v0; *(f32x4*)(yr + col + 4) = v1;
                        s += (v0[0] * v0[0] + v0[1] * v0[1]) + (v0[2] * v0[2] + v0[3] * v0[3]) + (v1[0] * v1[0] + v1[1] * v1[1]) + (v1[2] * v1[2] + v1[3] * v1[3]);
                    }
                }
                s += __shfl_xor(s, 16); s += __shfl_xor(s, 32);
                if (ok && fq == 0) SSQ2[(size_t)row * 16 + u.pn * 4 + wc] = s;
            }
    }
};

template <class Epi, class Sched, bool ALIGN_EPI = false, bool SP2 = false>
__device__ __forceinline__ void gemm_phase(PG8_LAS unsigned char* lds, const Gemm g, const Sched& S, const Epi& E) {
    const int tid = threadIdx.x, wid = __builtin_amdgcn_readfirstlane(tid >> 6), lane = tid & 63, wr = wid >> 2, wc = wid & 3, fr = lane & 15, fq = lane >> 4;
    const int K = g.K, nt = K / BK;
    unsigned voffA[2], voffB[2];
#pragma unroll
    for (int i = 0; i < 2; ++i) { int R, C; stage_rc(tid * 16 + i * 8192, R, C); const int Rb = Epi::PERM ? ((R & ~31) + perm32(R & 31)) : R;
        voffA[i] = (unsigned)(R * K + C) * 2u; voffB[i] = (unsigned)(Rb * K + C) * 2u; }
    const size_t kstep = (size_t)(BK * 2);
    const size_t hstep = (size_t)HALF * K * 2;
    const size_t tstep = 2 * hstep;
    const unsigned ldsw = (unsigned)wid * 1024u;
    const int aoff = lds_byte(wr * 64 + fr, fq * 8), boff = lds_byte(wc * 32 + fr, fq * 8);
#define PG8_SA(b, h) (((b) * 2 + (h)) * HTB)
#define PG8_SB(b, h) ((4 + (b) * 2 + (h)) * HTB)
#define PG8_STAGE(bufoff, gbase, voff) do { _Pragma("unroll") for (int _i = 0; _i < 2; ++_i) \
        __builtin_amdgcn_global_load_lds((const unsigned*)((const char*)(gbase) + (voff)[_i]), (PG8_LAS unsigned*)(lds + (bufoff) + ldsw + _i * 8192), 16, 0, 0); } while (0)
#define PG8_LDA(dst, b, h) do { _Pragma("unroll") for (int m = 0; m < 4; ++m) _Pragma("unroll") for (int k = 0; k < 2; ++k) dst[m][k] = *(const PG8_LAS bf16x8*)(lds + PG8_SA(b, h) + aoff + m * 2048 + k * 1024); } while (0)
#define PG8_LDB(dst, b, h) do { _Pragma("unroll") for (int n = 0; n < 2; ++n) _Pragma("unroll") for (int k = 0; k < 2; ++k) dst[n][k] = *(const PG8_LAS bf16x8*)(lds + PG8_SB(b, h) + boff + n * 2048 + k * 1024); } while (0)
#define PG8_MMA(ai, bj, At, Bt) do { __builtin_amdgcn_s_setprio(1); _Pragma("unroll") for (int m = 0; m < 4; ++m) _Pragma("unroll") for (int n = 0; n < 2; ++n) _Pragma("unroll") for (int k = 0; k < 2; ++k) \
        acc[ai][bj][m][n] = __builtin_amdgcn_mfma_f32_16x16x32_bf16(Bt[n][k], At[m][k], acc[ai][bj][m][n], 0, 0, 0); __builtin_amdgcn_s_setprio(0); } while (0)
#define PG8_WAIT_V(n) asm volatile("s_waitcnt vmcnt(" #n ")" ::: "memory")
#define PG8_WAIT_L(n) asm volatile("s_waitcnt lgkmcnt(" #n ")" ::: "memory")
#define PG8_BAR __builtin_amdgcn_s_barrier()
#define PG8_SCHED __builtin_amdgcn_sched_barrier(0)
    Unit cur, nxt; int ui = 0;
    if (!S.next(0, cur)) return;
    f32x4 acc[2][2][4][2];
#pragma unroll
    for (int a = 0; a < 2; ++a)
#pragma unroll
        for (int b = 0; b < 2; ++b)
#pragma unroll
            for (int m = 0; m < 4; ++m)
#pragma unroll
                for (int n = 0; n < 2; ++n) acc[a][b][m][n] = (f32x4){0.f, 0.f, 0.f, 0.f};
    bf16x8 At[4][2], B0[2][2], B1[2][2];
    const char* cA = (const char*)g.A + (size_t)cur.pm * tstep; const char* cB = (const char*)g.Bt + (size_t)cur.pn * tstep;
    S.a_ready(cur);
    if constexpr (SP2) {
        PG8_STAGE(PG8_SB(0, 0), cB, voffB); PG8_STAGE(PG8_SB(0, 1), cB + hstep, voffB); PG8_STAGE(PG8_SA(0, 0), cA, voffA); PG8_STAGE(PG8_SA(0, 1), cA + hstep, voffA);
        if (wr == 1) PG8_BAR;
        PG8_WAIT_V(2); PG8_BAR;
        PG8_STAGE(PG8_SB(1, 0), cB + kstep, voffB); PG8_STAGE(PG8_SA(1, 0), cA + kstep, voffA); PG8_STAGE(PG8_SB(1, 1), cB + hstep + kstep, voffB);
        PG8_WAIT_V(6); PG8_BAR;
    } else {
        PG8_STAGE(PG8_SB(0, 0), cB, voffB); PG8_STAGE(PG8_SA(0, 0), cA, voffA); PG8_STAGE(PG8_SB(0, 1), cB + hstep, voffB); PG8_STAGE(PG8_SA(0, 1), cA + hstep, voffA);
        if (wr == 1) PG8_BAR;
        PG8_WAIT_V(4); PG8_BAR;
        PG8_STAGE(PG8_SB(1, 0), cB + kstep, voffB); PG8_STAGE(PG8_SA(1, 0), cA + kstep, voffA); PG8_STAGE(PG8_SB(1, 1), cB + hstep + kstep, voffB);
        PG8_WAIT_V(6); PG8_BAR;
    }
    for (;;) {
        const bool has_next = S.next(ui + 1, nxt);
        const char* nA = has_next ? (const char*)g.A + (size_t)nxt.pm * tstep : cA; const char* nB = has_next ? (const char*)g.Bt + (size_t)nxt.pn * tstep : cB;
        for (int t = 0; t < nt; t += 2) {
            const bool last = (t == nt - 2);
            const char* a1 = cA + (size_t)(t + 1) * kstep;
            const char* a2 = last ? nA : cA + (size_t)(t + 2) * kstep; const char* b2 = last ? nB : cB + (size_t)(t + 2) * kstep;
            const char* a3 = a2 + kstep; const char* b3 = b2 + kstep;
            if (last && has_next) S.a_ready(nxt);
            if constexpr (SP2) {
            PG8_LDB(B0, 0, 0); PG8_LDB(B1, 0, 1); PG8_SCHED; PG8_LDA(At, 0, 0); PG8_STAGE(PG8_SA(1, 1), a1 + hstep, voffA);
            PG8_WAIT_V(8); PG8_WAIT_L(0); PG8_BAR; PG8_MMA(0, 0, At, B0); PG8_MMA(0, 1, At, B1); PG8_BAR; PG8_SCHED;
            PG8_LDA(At, 0, 1); PG8_STAGE(PG8_SB(0, 0), b2, voffB); PG8_STAGE(PG8_SB(0, 1), b2 + hstep, voffB); PG8_STAGE(PG8_SA(0, 0), a2, voffA);
            PG8_WAIT_V(8); PG8_WAIT_L(0); PG8_BAR; PG8_MMA(1, 0, At, B0); PG8_MMA(1, 1, At, B1); PG8_BAR; PG8_SCHED;
            PG8_LDB(B0, 1, 0); PG8_LDB(B1, 1, 1); PG8_SCHED; PG8_LDA(At, 1, 0); PG8_STAGE(PG8_SA(0, 1), a2 + hstep, voffA);
            PG8_WAIT_V(8); PG8_WAIT_L(0); PG8_BAR; PG8_MMA(0, 0, At, B0); PG8_MMA(0, 1, At, B1); PG8_BAR; PG8_SCHED;
            PG8_LDA(At, 1, 1); PG8_STAGE(PG8_SB(1, 0), b3, voffB); PG8_STAGE(PG8_SB(1, 1), b3 + hstep, voffB); PG8_STAGE(PG8_SA(1, 0), a3, voffA);
            PG8_WAIT_V(8); PG8_WAIT_L(0); PG8_BAR; PG8_MMA(1, 0, At, B0); PG8_MMA(1, 1, At, B1); PG8_BAR; PG8_SCHED;
            } else {
            PG8_LDB(B0, 0, 0); PG8_SCHED; PG8_LDA(At, 0, 0); PG8_STAGE(PG8_SA(1, 1), a1 + hstep, voffA);
            PG8_WAIT_L(8); PG8_BAR; PG8_WAIT_L(0); PG8_MMA(0, 0, At, B0); PG8_BAR; PG8_SCHED;
            PG8_LDB(B1, 0, 1); PG8_STAGE(PG8_SB(0, 0), b2, voffB);
            PG8_BAR; PG8_WAIT_L(0); PG8_MMA(0, 1, At, B1); PG8_BAR;
            PG8_LDA(At, 0, 1); PG8_STAGE(PG8_SA(0, 0), a2, voffA);
            PG8_BAR; PG8_WAIT_L(0); PG8_MMA(1, 0, At, B0); PG8_BAR; PG8_SCHED;
            PG8_STAGE(PG8_SB(0, 1), b2 + hstep, voffB);
            PG8_WAIT_V(6); PG8_BAR; PG8_MMA(1, 1, At, B1); PG8_BAR;
            PG8_LDB(B0, 1, 0); PG8_SCHED; PG8_LDA(At, 1, 0); PG8_STAGE(PG8_SA(0, 1), a2 + hstep, voffA);
            PG8_WAIT_L(8); PG8_BAR; PG8_WAIT_L(0); PG8_MMA(0, 0, At, B0); PG8_BAR; PG8_SCHED;
            PG8_LDB(B1, 1, 1); PG8_STAGE(PG8_SB(1, 0), b3, voffB);
            PG8_BAR; PG8_WAIT_L(0); PG8_MMA(0, 1, At, B1); PG8_BAR;
            PG8_LDA(At, 1, 1); PG8_STAGE(PG8_SA(1, 0), a3, voffA);
            PG8_BAR; PG8_WAIT_L(0); PG8_MMA(1, 0, At, B0); PG8_BAR; PG8_SCHED;
            PG8_STAGE(PG8_SB(1, 1), b3 + hstep, voffB);
            PG8_WAIT_V(6); PG8_BAR; PG8_MMA(1, 1, At, B1); PG8_BAR;
            }
        }
        if constexpr (ALIGN_EPI) { if (wr == 0) PG8_BAR; }
        if constexpr (!Epi::AFTER_DRAIN) { E(acc, cur, wr, wc, fr, fq); S.done(cur); }
        if (!has_next) break;
#pragma unroll
        for (int a = 0; a < 2; ++a)
#pragma unroll
            for (int b = 0; b < 2; ++b)
#pragma unroll
                for (int m = 0; m < 4; ++m)
#pragma unroll
                    for (int n = 0; n < 2; ++n) acc[a][b][m][n] = (f32x4){0.f, 0.f, 0.f, 0.f};
        cur = nxt; cA = nA; cB = nB; ++ui;
        if constexpr (ALIGN_EPI) { if (wr == 1) PG8_BAR; }
    }
    PG8_WAIT_V(0);
    if constexpr (!ALIGN_EPI) { if (wr == 0) PG8_BAR; }
    PG8_BAR;
    if constexpr (Epi::AFTER_DRAIN) { E.fused(acc, cur, wr, wc, fr, fq, lds, wid, lane); S.done(cur); }
#undef PG8_SA
#undef PG8_SB
#undef PG8_STAGE
#undef PG8_LDA
#undef PG8_LDB
#undef PG8_MMA
#undef PG8_WAIT_V
#undef PG8_WAIT_L
#undef PG8_BAR
#undef PG8_SCHED
}
}

#define GAS __attribute__((address_space(1)))
#define LAS __attribute__((address_space(3)))
typedef unsigned short bf16;
typedef unsigned v4u __attribute__((ext_vector_type(4)));
typedef unsigned v2u __attribute__((ext_vector_type(2)));
typedef float f32x4 __attribute__((ext_vector_type(4)));
typedef float f32x2 __attribute__((ext_vector_type(2)));
typedef float f32x16 __attribute__((ext_vector_type(16)));
typedef short bf16x8 __attribute__((ext_vector_type(8)));
typedef short s16x4 __attribute__((ext_vector_type(4)));
#define LDS_WAIT() asm volatile("s_waitcnt lgkmcnt(0)" ::: "memory")
#define VM_WAIT() asm volatile("s_waitcnt vmcnt(0)" ::: "memory")
constexpr int NWAVES = 8;
constexpr int LDS_BYTES = 163840;
constexpr int MISC_OFF = 163840 - 256;

__device__ __forceinline__ unsigned f2bf(float f) { unsigned u = __builtin_bit_cast(unsigned, f); return (u + 0x7fffu + ((u >> 16) & 1u)) >> 16; }
__device__ __forceinline__ unsigned pk2(float lo, float hi) { return f2bf(lo) | (f2bf(hi) << 16); }
__device__ __forceinline__ float bf2f(unsigned short b) { return __builtin_bit_cast(float, ((unsigned)b) << 16); }
__device__ __forceinline__ float wave_sum(float v) {
#pragma unroll
    for (int o = 1; o < 64; o <<= 1) v += __shfl_xor(v, o);
    return v;
}
__device__ __forceinline__ float softplus_f(float x) { return fmaxf(x, 0.f) + log1pf(expf(-fabsf(x))); }
__device__ __forceinline__ float sigmoid_f(float x) { return 1.0f / (1.0f + expf(-x)); }
__device__ __forceinline__ float silu_f(float x) { return x * __builtin_amdgcn_rcpf(1.0f + __expf(-x)); }

struct Params {
    const float* in[20];
    float* out; unsigned char* ws;
    int ph_lo, ph_hi;
};
struct Ctx { int tid, lane, wave, vcu, G; };
#ifndef PROBE_K
#define PROBE_K -1
#endif
#define GSTAMP(id) do { if (PROBE_K >= 10 && unit == 0 && threadIdx.x == 0) { const unsigned long long t_ = __builtin_amdgcn_s_memrealtime(); unsigned* c_ = (unsigned*)(P.ws + WS_CTL); __hip_atomic_store(c_ + 512 + 2 * (id), (unsigned)t_, __ATOMIC_RELAXED, __HIP_MEMORY_SCOPE_AGENT); __hip_atomic_store(c_ + 513 + 2 * (id), (unsigned)(t_ >> 32), __ATOMIC_RELAXED, __HIP_MEMORY_SCOPE_AGENT); } } while (0)

#define XB_TMO      128
#define XB_XCNT(j)  (256  + 64 * (j))
#define XB_XSUB(j)  (1280 + 64 * (j))
#define XB_XGEN(j)  (2304 + 64 * (j))
#define XB_TOP      3328
#define XB_TOPGEN   3392
#define XCD_BAR_WORDS 3456
#define XB_SPIN_CAP (1u << 18)

__device__ __forceinline__ unsigned xb_ld(unsigned* p)              { return __hip_atomic_load(p, __ATOMIC_RELAXED, __HIP_MEMORY_SCOPE_AGENT); }
__device__ __forceinline__ unsigned xb_add(unsigned* p, unsigned v) { return __hip_atomic_fetch_add(p, v, __ATOMIC_RELAXED, __HIP_MEMORY_SCOPE_AGENT); }
__device__ __forceinline__ unsigned xb_xcc_id() { return (unsigned)__builtin_amdgcn_s_getreg((3 << 11) | 20) & 0xFu; }
#define XB_SPIN(cond, bar) do { unsigned _sp = 0; while (cond) { __builtin_amdgcn_s_sleep(1); \
    if ((++_sp & 255u) == 0u) { if (xb_ld(&(bar)[XB_TMO])) break; if (_sp > XB_SPIN_CAP) { atomicAdd(&(bar)[XB_TMO], 1u); break; } } } } while (0)

struct XcdBarrier {
    unsigned* bar; unsigned x;
    volatile LAS unsigned* st;
};

__device__ __forceinline__ XcdBarrier xcd_barrier_post(unsigned* bar, volatile LAS unsigned* st) {
    XcdBarrier b; b.bar = bar; b.x = xb_xcc_id(); b.st = st;
    if (threadIdx.x == 0) (void)xb_add(&bar[XB_XCNT(b.x)], 1u);
    return b;
}
__device__ __forceinline__ void xcd_barrier_complete(unsigned* bar, unsigned x, unsigned& nloc, unsigned& nx) {
    const unsigned G = gridDim.x * gridDim.y * gridDim.z;
    unsigned sum, cnt, mine, sp = 0u;
    for (;;) {
        sum = 0u; cnt = 0u; mine = 0u;
#pragma unroll
        for (unsigned j = 0; j < 16; ++j) { const unsigned c = xb_ld(&bar[XB_XCNT(j)]); sum += c; cnt += (c > 0u) ? 1u : 0u; mine = (j == x) ? c : mine; }
        if (sum == G) break;
        __builtin_amdgcn_s_sleep(1);
        if ((++sp & 255u) == 0u) { if (xb_ld(&bar[XB_TMO])) break; if (sp > XB_SPIN_CAP) { atomicAdd(&bar[XB_TMO], 1u); break; } }
    }
    nloc = mine > 0u ? mine : 1u; nx = cnt > 0u ? cnt : 1u;
}

__device__ __forceinline__ void xcd_barrier(const XcdBarrier& b) {
    asm volatile("s_waitcnt vmcnt(0)" ::: "memory");
    __syncthreads();
    if (threadIdx.x == 0) {
        unsigned* bar = b.bar;
        __builtin_amdgcn_s_waitcnt(0);
        unsigned nloc = b.st[0], nx = b.st[1];
        if (nloc == 0u) { xcd_barrier_complete(bar, b.x, nloc, nx); b.st[0] = nloc; b.st[1] = nx; }
        const unsigned old = xb_add(&bar[XB_XSUB(b.x)], 1u);
        const unsigned gen = old / nloc;
        if (old + 1u == (gen + 1u) * nloc) {
            __builtin_amdgcn_fence(__ATOMIC_RELEASE, "agent");
            asm volatile("s_waitcnt vmcnt(0)" ::: "memory");
            const unsigned og = xb_add(&bar[XB_TOP], 1u);
            const unsigned tg = og / nx;
            if (og + 1u == (tg + 1u) * nx) xb_add(&bar[XB_TOPGEN], 1u);
            else XB_SPIN(xb_ld(&bar[XB_TOPGEN]) == tg, bar);
            __builtin_amdgcn_fence(__ATOMIC_ACQUIRE, "agent");
            xb_add(&bar[XB_XGEN(b.x)], 1u);
            asm volatile("s_waitcnt vmcnt(0)" ::: "memory");
        } else {
            XB_SPIN(xb_ld(&bar[XB_XGEN(b.x)]) == gen, bar);
            __builtin_amdgcn_fence(__ATOMIC_ACQUIRE, "agent");
            asm volatile("s_waitcnt vmcnt(0)" ::: "memory");
        }
    }
    __syncthreads();
}

__device__ __forceinline__ void transpose_item(const float* W, int ldw, int c0, int K, int ncols, const float* scale, bf16* WT, int row_off, LAS float* scr, int item, int lane) {
    const int nblk = ncols / 32, kb = item / nblk, nb = item % nblk, k0 = 64 * kb, n0 = 32 * nb;
    float wv[32];
#pragma unroll
    for (int i = 0; i < 32; ++i) { const int kk = 2 * i + (lane >> 5); wv[i] = W[(size_t)(k0 + kk) * ldw + c0 + n0 + (lane & 31)]; }
#pragma unroll
    for (int i = 0; i < 32; ++i) { const int kk = 2 * i + (lane >> 5); float w = wv[i]; if (scale) w *= scale[k0 + kk]; scr[kk * 33 + (lane & 31)] = w; }
    LDS_WAIT(); asm volatile("" ::: "memory");
    const int c = lane & 7;
#pragma unroll
    for (int j = 0; j < 4; ++j) { const int n = (lane >> 3) + 8 * j; const LAS float* s = scr + (8 * c) * 33 + n;
        v4u o; o.x = pk2(s[0 * 33], s[1 * 33]); o.y = pk2(s[2 * 33], s[3 * 33]); o.z = pk2(s[4 * 33], s[5 * 33]); o.w = pk2(s[6 * 33], s[7 * 33]);
        *(GAS v4u*)(WT + (size_t)(row_off + n0 + n) * K + k0 + 8 * c) = o; }
    LDS_WAIT(); asm volatile("" ::: "memory");
}

__device__ __forceinline__ void late_weight_copies(const Params& P, LAS unsigned char* lds, int wave, int lane, int gw, int NGW) {
    const float* w_o = P.in[15]; const float* ln2 = P.in[16]; const float* w_up = P.in[17]; const float* w_down = P.in[18];
    bf16* WOT = (bf16*)(P.ws + WS_WOT); bf16* WUPT = (bf16*)(P.ws + WS_WUPT); bf16* WDNT = (bf16*)(P.ws + WS_WDNT);
    LAS float* scr = (LAS float*)(lds + wave * 8448);
    for (int it = gw; it < 16 * 32; it += NGW) transpose_item(w_o, DM, 0, DM, DM, nullptr, WOT, 0, scr, it, lane);
    for (int it = gw; it < 16 * 128; it += NGW) transpose_item(w_up, FF, 0, DM, FF, ln2, WUPT, 0, scr, it, lane);
    for (int it = gw; it < 64 * 32; it += NGW) transpose_item(w_down, DM, 0, FF, DM, nullptr, WDNT, 0, scr, it, lane);
}

__device__ __forceinline__ void phase_prep(const Params& P, const Ctx& C, LAS unsigned char* lds) {
    unsigned char* ws = P.ws;
    const float* xp = P.in[0]; const float* xs = P.in[1]; const float* ln1 = P.in[8]; const float* w_in = P.in[9]; const float* b_f = P.in[10];
    const float* a_log = P.in[12]; const float* dt_bias = P.in[13];
    bf16* XN = (bf16*)(ws + WS_XN);
    float* LF = (float*)(ws + WS_LF); float* BETA = (float*)(ws + WS_BETA); float* Gg = (float*)(ws + WS_G);
    LAS float* WSm = (LAS float*)lds;
    LAS float* scr = (LAS float*)(lds + 49152 + C.wave * 8448);
    {
        float gv[24];
#pragma unroll
        for (int i = 0; i < 24; ++i) { const int idx = C.tid + 512 * i; const int k = idx / 12, c = idx % 12; const int col = c < 4 ? 1536 + c : 3588 + (c - 4); gv[i] = w_in[(size_t)k * INDIM + col]; }
#pragma unroll
        for (int i = 0; i < 24; ++i) { const int idx = C.tid + 512 * i; const int k = idx / 12, c = idx % 12; WSm[c * 1024 + k] = gv[i]; }
    }
    __syncthreads();
    const int gw = C.vcu * NWAVES + C.wave, NGW = C.G * NWAVES, lane = C.lane;
    f32x4 lw[4];
#pragma unroll
    for (int j = 0; j < 4; ++j) lw[j] = ((const f32x4*)ln1)[lane + 64 * j];
    f32x4 vnx[4];
    if (gw < M_TOT) { const float* xr0 = gw < MP ? xp + (size_t)gw * DM : xs + (size_t)(gw - MP) * DM;
#pragma unroll
        for (int j = 0; j < 4; ++j) vnx[j] = ((const f32x4*)xr0)[lane + 64 * j]; }
    for (int m = gw; m < M_TOT; m += NGW) {
        asm volatile("" ::: "memory");
        f32x4 v[4]; float ss = 0.f;
#pragma unroll
        for (int j = 0; j < 4; ++j) { v[j] = vnx[j]; ss += (v[j][0] * v[j][0] + v[j][1] * v[j][1]) + (v[j][2] * v[j][2] + v[j][3] * v[j][3]); }
        { const int mn = m + NGW; if (mn < M_TOT) { const float* xr1 = mn < MP ? xp + (size_t)mn * DM : xs + (size_t)(mn - MP) * DM;
#pragma unroll
            for (int j = 0; j < 4; ++j) vnx[j] = ((const f32x4*)xr1)[lane + 64 * j]; } }
        ss = wave_sum(ss);
        const float rstd = 1.0f / sqrtf(ss * (1.0f / DM) + RMS_EPS);
#pragma unroll
        for (int j = 0; j < 4; ++j) { v[j] = v[j] * rstd * lw[j];
            v2u o; o.x = pk2(v[j][0], v[j][1]); o.y = pk2(v[j][2], v[j][3]);
            *(v2u*)(XN + (size_t)m * DM + 4 * lane + 256 * j) = o; }
        float mine = 0.f;
#pragma unroll
        for (int c = 0; c < 12; ++c) { float a = 0.f;
#pragma unroll
            for (int j = 0; j < 4; ++j) { const f32x4 w = *(const LAS f32x4*)(WSm + c * 1024 + 4 * lane + 256 * j); a += (v[j][0] * w[0] + v[j][1] * w[1]) + (v[j][2] * w[2] + v[j][3] * w[3]); }
            a = wave_sum(a); mine = (lane == c) ? a : mine; }
        const float bb = __shfl(mine, (lane + 4) & 63), aa = __shfl(mine, (lane + 8) & 63);
        if (lane < 4) {
            const float fa = mine;
            const float lf = -softplus_f(-(fa + b_f[lane]));
            const float beta = sigmoid_f(bb);
            const float g = -expf(a_log[lane]) * softplus_f(aa + dt_bias[lane]);
            LF[(size_t)m * 4 + lane] = lf; BETA[(size_t)m * 4 + lane] = beta; Gg[(size_t)m * 4 + lane] = g;
            if (m < MP) P.out[OLF_P + (size_t)m * 4 + lane] = lf; else P.out[OLF_S + (size_t)(m - MP) * 4 + lane] = lf;
        }
    }
    bf16* W1T = (bf16*)(ws + WS_W1T);
    for (int it = gw; it < 16 * 48; it += NGW) transpose_item(w_in, INDIM, 0, DM, 1536, nullptr, W1T, 0, scr, it, lane);
    for (int it = gw; it < 16 * 48; it += NGW) transpose_item(w_in, INDIM, 1540, DM, 1536, nullptr, W1T, 1536, scr, it, lane);
    for (int it = gw; it < 16 * 16; it += NGW) transpose_item(w_in, INDIM, 3076, DM, 512, nullptr, W1T, 3072, scr, it, lane);
    if (C.G != 256) late_weight_copies(P, lds + 49152, C.wave, lane, gw, NGW);
}

__device__ __forceinline__ void kbias_seq(const Params& P, int bh, int lane) {
    const float* LF = (const float*)(P.ws + WS_LF); float* KBIAS = (float*)(P.ws + WS_KBIAS);
    const int b = bh >> 2, h = bh & 3;
    const float* src = LF + ((size_t)b * SEQ + 32 * lane) * 4 + h;
    float s = 0.f;
    for (int i = 0; i < 32; ++i) s += src[i * 4];
    float x = s;
#pragma unroll
    for (int o = 1; o < 64; o <<= 1) { const float y = __shfl_up(x, o); if (lane >= o) x += y; }
    float run = x - s;
    float* dst = KBIAS + (size_t)bh * SEQ + 32 * lane;
    const float inv = -11.313708498984761f;
    for (int i = 0; i < 32; ++i) { run += src[i * 4]; dst[i] = run * inv; }
}


namespace fox {
constexpr int D = 128, NW = 8, QBLK = 32, KVBLK = 64, QB = NW * QBLK;
constexpr int SHM_V = KVBLK * D * 2, SHM_K = KVBLK * D * 2;
constexpr float SCALE = 0.08838834764831845f, THR = 8.f;
#define KSWZ(row, colB) ((row) * 256 + ((colB) ^ (((row) & 7) << 4)))
#define SBAR() __builtin_amdgcn_sched_barrier(0)
__device__ __forceinline__ int v_st(int k, int c) { const int kk = (k & ~0xC) | ((k & 4) << 1) | ((k & 8) >> 1); return ((kk >> 3) * 4 + (c >> 5)) * 512 + ((kk & 7) * 32 + (c & 31)) * 2; }
__device__ __forceinline__ int v_rd_base(int lane) { return ((lane & 3) << 3) | (((lane >> 2) & 3) << 6) | (((lane >> 4) & 1) << 5) | (((lane >> 5) & 1) << 8); }
constexpr int v_rd_off(int d0, int ks, int half) { return d0 * 512 + ks * 4096 + half * 2048; }
__device__ __forceinline__ int crow(int r, int hi) { return (r & 3) + 8 * (r >> 2) + 4 * hi; }
__device__ __forceinline__ unsigned cvtpk(float lo, float hi) { unsigned r; asm volatile("v_cvt_pk_bf16_f32 %0, %1, %2" : "=v"(r) : "v"(lo), "v"(hi)); return r; }
__device__ __forceinline__ void mask_tile(f32x16& p0, f32x16& p1, int dq, unsigned W) {
    const float NEG = -__builtin_inff();
#pragma unroll
    for (int r = 0; r < 16; ++r) {
        const int c = (r & 3) + 8 * (r >> 2);
        if ((unsigned)(dq - c) >= W) p0[r] = NEG;
        if ((unsigned)(dq - c - 32) >= W) p1[r] = NEG;
    }
}
__device__ __forceinline__ void partialSM(f32x16& p0, f32x16& p1, float& m_reg, float& mn, float& alpha) {
    float pmax = p0[0]; for (int r = 1; r < 16; ++r) pmax = fmaxf(pmax, p0[r]); for (int r = 0; r < 16; ++r) pmax = fmaxf(pmax, p1[r]);
    { auto rr = __builtin_amdgcn_permlane32_swap(__float_as_uint(pmax), __float_as_uint(pmax), false, false);
      pmax = fmaxf(__uint_as_float(rr[0]), __uint_as_float(rr[1])); }
    constexpr float C2 = 1.4426950408889634f * SCALE;
    if (__builtin_expect(__all((pmax - m_reg) * SCALE <= THR), 1)) { mn = m_reg; alpha = 1.f; }
    else { mn = fmaxf(m_reg, pmax); alpha = __builtin_amdgcn_exp2f((m_reg - mn) * C2); m_reg = mn; }
    const float mnL = -mn * C2;
    for (int r = 0; r < 16; ++r) p0[r] = fmaf(p0[r], C2, mnL); for (int r = 0; r < 16; ++r) p1[r] = fmaf(p1[r], C2, mnL);
    for (int r = 0; r < 16; ++r) p0[r] = __builtin_amdgcn_exp2f(p0[r]);
}
__device__ __forceinline__ void finishSM(f32x16& p0, f32x16& p1, float alpha, float& l_reg, bf16x8& pa0, bf16x8& pa1, bf16x8& pa2, bf16x8& pa3) {
    for (int r = 0; r < 16; ++r) p1[r] = __builtin_amdgcn_exp2f(p1[r]);
    float ps = 0; for (int r = 0; r < 16; ++r) ps += p0[r]; for (int r = 0; r < 16; ++r) ps += p1[r];
    { auto rr = __builtin_amdgcn_permlane32_swap(__float_as_uint(ps), __float_as_uint(ps), false, false);
      ps = __uint_as_float(rr[0]) + __uint_as_float(rr[1]); }
    l_reg = l_reg * alpha + ps;
#define PK4(P, B_, OUT) do { unsigned a0 = cvtpk(P[B_+0], P[B_+1]), a1 = cvtpk(P[B_+2], P[B_+3]);                          \
        unsigned b0 = cvtpk(P[B_+4], P[B_+5]), b1 = cvtpk(P[B_+6], P[B_+7]);                                             \
        auto r0 = __builtin_amdgcn_permlane32_swap(a0, b0, false, false); auto r1 = __builtin_amdgcn_permlane32_swap(a1, b1, false, false); \
        v4u w = {r0[0], r1[0], r0[1], r1[1]}; OUT = *reinterpret_cast<bf16x8*>(&w); } while (0)
    PK4(p0, 0, pa0); PK4(p0, 8, pa1); PK4(p1, 0, pa2); PK4(p1, 8, pa3);
#undef PK4
}
template <int KB>
__device__ __forceinline__ void qkt(f32x16& p0, f32x16& p1, const char* K_lds, const float* bias_l, int r32, int hi, const bf16x8* qr) {
#pragma unroll
    for (int g = 0; g < 4; ++g) { const f32x4 t0 = *(const f32x4*)(bias_l + 8 * g + 4 * hi), t1 = *(const f32x4*)(bias_l + 32 + 8 * g + 4 * hi);
#pragma unroll
        for (int i = 0; i < 4; ++i) { p0[4 * g + i] = t0[i]; p1[4 * g + i] = t1[i]; } }
    const char* kb[4];
#pragma unroll
    for (int dd = 0; dd < 4; ++dd) kb[dd] = K_lds + KB * SHM_K + KSWZ(r32, (dd * 16 + hi * 8) * 2);
#pragma unroll
    for (int d0 = 0; d0 < 8; ++d0) { const char* a = kb[d0 & 3] + (d0 >> 2) * 128;
        bf16x8 b0 = *reinterpret_cast<const bf16x8*>(a);
        bf16x8 b1 = *reinterpret_cast<const bf16x8*>(a + 32 * 256);
        p0 = __builtin_amdgcn_mfma_f32_32x32x16_bf16(b0, qr[d0], p0, 0, 0, 0);
        p1 = __builtin_amdgcn_mfma_f32_32x32x16_bf16(b1, qr[d0], p1, 0, 0, 0); }
}
template <int VB>
__device__ __forceinline__ void pv_tile(f32x16* o, int vb0, bf16x8 pa0, bf16x8 pa1, bf16x8 pa2, bf16x8 pa3) {
#define TRRD(dst, off) asm volatile("ds_read_b64_tr_b16 %0, %1 offset:%2" : "=&v"(dst) : "v"(vb0), "i"(off) : "memory")
#define PV_D0(d0) do { s16x4 l0, l1, l2, l3, h0, h1, h2, h3; constexpr int b_ = VB * SHM_V + v_rd_off(d0, 0, 0);   \
        TRRD(l0, b_); TRRD(h0, b_ + 2048); TRRD(l1, b_ + 4096); TRRD(h1, b_ + 6144); TRRD(l2, b_ + 8192); TRRD(h2, b_ + 10240); TRRD(l3, b_ + 12288); TRRD(h3, b_ + 14336); \
        asm volatile("s_waitcnt lgkmcnt(0)" ::: "memory"); SBAR();   \
        o[d0] = __builtin_amdgcn_mfma_f32_32x32x16_bf16(pa0, (bf16x8){l0[0], l0[1], l0[2], l0[3], h0[0], h0[1], h0[2], h0[3]}, o[d0], 0, 0, 0);   \
        o[d0] = __builtin_amdgcn_mfma_f32_32x32x16_bf16(pa1, (bf16x8){l1[0], l1[1], l1[2], l1[3], h1[0], h1[1], h1[2], h1[3]}, o[d0], 0, 0, 0);   \
        o[d0] = __builtin_amdgcn_mfma_f32_32x32x16_bf16(pa2, (bf16x8){l2[0], l2[1], l2[2], l2[3], h2[0], h2[1], h2[2], h2[3]}, o[d0], 0, 0, 0);   \
        o[d0] = __builtin_amdgcn_mfma_f32_32x32x16_bf16(pa3, (bf16x8){l3[0], l3[1], l3[2], l3[3], h3[0], h3[1], h3[2], h3[3]}, o[d0], 0, 0, 0); } while (0)
    PV_D0(0); PV_D0(1); PV_D0(2); PV_D0(3);
#undef PV_D0
#undef TRRD
}

__device__ __forceinline__ void fox_block(char* lds, const bf16* Qh, const bf16* Kh, const bf16* Vh, const float* kbias, bf16* Orow0, int qb) {
    const int tid = threadIdx.x, wid = __builtin_amdgcn_readfirstlane(tid >> 6), lane = tid & 63, r32 = lane & 31, hi = lane >> 5;
    const int P0 = qb * QB, qlo = P0 + wid * QBLK, qm = qlo + r32 - 4 * hi;
    char* V_lds = lds; char* K_lds = lds + 2 * SHM_V;
    float* bias_l = (float*)(lds + 2 * SHM_V + 2 * SHM_K);
    float* wsf = bias_l + 128 + wid * 64; float* li_l = wsf; float* al_l = wsf + 32;
    bf16x8 qr[8];
#pragma unroll
    for (int d0 = 0; d0 < 8; ++d0) qr[d0] = *reinterpret_cast<const bf16x8*>(Qh + (size_t)(qlo + r32) * D + d0 * 16 + hi * 8);
    float m_reg = -1e30f, l_reg = 0.f; f32x16 o[4] = {};
    const int sr = tid >> 4, sc = (tid & 15) * 8, vst0 = v_st(sr, sc), vst1 = v_st(32 + sr, sc), kws = KSWZ(sr, sc * 2);
    const int vb0 = (int)(uintptr_t)V_lds + v_rd_base(lane);
    const int ntiles = P0 / KVBLK + 4;
    float* bias2 = bias_l;
    bf16x8 gk0, gk1, gv0, gv1; float gb = 0.f;
#define FOX_LOAD(kb_) do { gk0 = *reinterpret_cast<const bf16x8*>(Kh + (size_t)((kb_) + sr) * D + sc); gk1 = *reinterpret_cast<const bf16x8*>(Kh + (size_t)((kb_) + 32 + sr) * D + sc); \
        gv0 = *reinterpret_cast<const bf16x8*>(Vh + (size_t)((kb_) + sr) * D + sc); gv1 = *reinterpret_cast<const bf16x8*>(Vh + (size_t)((kb_) + 32 + sr) * D + sc); if (tid < 64) gb = kbias[(kb_) + tid]; } while (0)
#define FOX_WRITE(B_) do { *(bf16x8*)(K_lds + (B_) * SHM_K + kws) = gk0; *(bf16x8*)(K_lds + (B_) * SHM_K + kws + 32 * 256) = gk1; *(bf16x8*)(V_lds + (B_) * SHM_V + vst0) = gv0; *(bf16x8*)(V_lds + (B_) * SHM_V + vst1) = gv1; \
        if (tid < 64) bias2[(B_) * 64 + tid] = gb; } while (0)
#define FOX_TILE(B_, kb_) do { if ((kb_) <= qlo + QBLK - 1) { f32x16 p0, p1; float mn, al; bf16x8 pa0, pa1, pa2, pa3; \
            qkt<B_>(p0, p1, K_lds, bias2 + (B_) * 64, r32, hi, qr); \
            if ((kb_) + KVBLK - 1 > qlo) mask_tile(p0, p1, qm - (kb_), 0x40000000u); \
            partialSM(p0, p1, m_reg, mn, al); \
            if (__any(al < 1.f)) { if (hi == 0) al_l[r32] = al; asm volatile("s_waitcnt lgkmcnt(0)" ::: "memory"); \
                for (int d_ = 0; d_ < 4; ++d_) for (int r = 0; r < 16; ++r) o[d_][r] *= al_l[crow(r, hi)]; } \
            finishSM(p0, p1, al, l_reg, pa0, pa1, pa2, pa3); SBAR(); \
            pv_tile<B_>(o, vb0, pa0, pa1, pa2, pa3); } } while (0)
    __syncthreads();
    FOX_LOAD((ntiles - 1) * KVBLK); FOX_WRITE(0);
    __syncthreads();
    for (int j = ntiles - 1; j >= 0; j -= 2) {
        FOX_LOAD((j - 1) * KVBLK); SBAR();
        FOX_TILE(0, j * KVBLK);
        FOX_WRITE(1);
        __syncthreads();
        if (j >= 2) { FOX_LOAD((j - 2) * KVBLK); SBAR(); }
        FOX_TILE(1, (j - 1) * KVBLK);
        if (j >= 2) FOX_WRITE(0);
        __syncthreads();
    }
#undef FOX_LOAD
#undef FOX_WRITE
#undef FOX_TILE
    if (hi == 0) li_l[r32] = l_reg; asm volatile("s_waitcnt lgkmcnt(0)" ::: "memory");
    float rli[16];
#pragma unroll
    for (int r = 0; r < 16; ++r) rli[r] = __builtin_amdgcn_rcpf(li_l[crow(r, hi)]);
    bf16* Ow = Orow0 + (size_t)qlo * DM;
#pragma unroll
    for (int r = 0; r < 16; ++r) { const int orow = crow(r, hi);
#pragma unroll
        for (int d0 = 0; d0 < 4; ++d0) { const float v = o[d0][r] * rli[r];
            const float vn = __shfl_xor(v, 1);
            if ((r32 & 1) == 0) *(unsigned*)(Ow + (size_t)orow * DM + d0 * 32 + r32) = cvtpk(v, vn); } }
    __syncthreads();
}
}


__device__ __forceinline__ void dec_update(float& m, float& l, f32x4& acc, const float (&x)[4], const f32x4 (&v)[4], int n) {
    float mx = m;
#pragma unroll
    for (int u = 0; u < 4; ++u) if (u < n) mx = fmaxf(mx, x[u]);
    const float al = __expf(m - mx);
    float ps = 0.f; f32x4 a = acc * al;
#pragma unroll
    for (int u = 0; u < 4; ++u) if (u < n) { const float p = __expf(x[u] - mx); ps += p; a += v[u] * p; }
    l = l * al + ps; acc = a; m = mx;
}
__device__ __forceinline__ float red32(float s) {
#pragma unroll
    for (int o = 1; o < 32; o <<= 1) s += __shfl_xor(s, o);
    return s;
}
__device__ __forceinline__ void decode_unit(const Params& P, LAS unsigned char* lds, int db) {
    const int tid = threadIdx.x, wid = __builtin_amdgcn_readfirstlane(tid >> 6), lane = tid & 63, hi = lane >> 5;
    const float* cache_k = P.in[2]; const float* cache_v = P.in[3]; const float* cache_lf = P.in[4]; const int* page_table = (const int*)P.in[5];
    const float* LF = (const float*)(P.ws + WS_LF); const float* QS = (const float*)(P.ws + WS_QS);
    bf16* MIX = (bf16*)(P.ws + WS_MIX);
    LAS f32x4* lfs = (LAS f32x4*)lds;
    LAS f32x4* wt = lfs + 2048;
    LAS float* cm = (LAS float*)(wt + 8);
    LAS float* cl = cm + 32;
    LAS f32x4* cacc = (LAS f32x4*)(cl + 32);
    const int ptv = (lane < NPAGES) ? page_table[db * NPAGES + lane] : 0;
#pragma unroll
    for (int i = 0; i < 4; ++i) { const int j = tid + 512 * i; const int pg = __shfl(ptv, j >> 7);
        lfs[j] = *(const f32x4*)(cache_lf + ((size_t)pg * PAGE + (j & 127)) * 4); }
    __syncthreads();
    {
        const f32x4 a0 = lfs[4 * tid], a1 = lfs[4 * tid + 1], a2 = lfs[4 * tid + 2], a3 = lfs[4 * tid + 3];
        const f32x4 tot = (a0 + a1) + (a2 + a3);
        f32x4 x = tot;
#pragma unroll
        for (int o = 1; o < 64; o <<= 1) { f32x4 y; y[0] = __shfl_down(x[0], o); y[1] = __shfl_down(x[1], o); y[2] = __shfl_down(x[2], o); y[3] = __shfl_down(x[3], o); if (lane + o < 64) x += y; }
        if (lane == 0) wt[wid] = x;
        __syncthreads();
        f32x4 after = {0.f, 0.f, 0.f, 0.f};
        for (int w2 = wid + 1; w2 < NWAVES; ++w2) after += wt[w2];
        const f32x4 lfn = *(const f32x4*)(LF + (size_t)(MP + db) * 4);
        const f32x4 B3 = (x - tot) + after + lfn, B2 = B3 + a3, B1 = B2 + a2, B0 = B1 + a1;
        lfs[4 * tid] = B0; lfs[4 * tid + 1] = B1; lfs[4 * tid + 2] = B2; lfs[4 * tid + 3] = B3;
    }
    __syncthreads();
    const float* qs = QS + (size_t)db * 512;
    const f32x4 qa = *(const f32x4*)(qs + 4 * lane) * ATT_SCALE, qb = *(const f32x4*)(qs + 256 + 4 * lane) * ATT_SCALE;
    float m0 = -1e30f, l0 = 0.f, m1 = -1e30f, l1 = 0.f; f32x4 acc0 = {0.f, 0.f, 0.f, 0.f}, acc1 = {0.f, 0.f, 0.f, 0.f};
    f32x4 kaA[4], kbA[4], vaA[4], vbA[4], kaB[4], kbB[4], vaB[4], vbB[4];
#define DEC_LOAD(ka, kb, va, vb, j0_) do { _Pragma("unroll") for (int u = 0; u < 4; ++u) { const int j = (j0_) + 8 * u; const int pg = __builtin_amdgcn_readlane(ptv, j >> 7); \
            const size_t ro = ((size_t)pg * PAGE + (j & 127)) * 512 + 4 * lane; \
            ka[u] = __builtin_nontemporal_load((const f32x4*)(cache_k + ro)); kb[u] = __builtin_nontemporal_load((const f32x4*)(cache_k + ro + 256)); va[u] = __builtin_nontemporal_load((const f32x4*)(cache_v + ro)); vb[u] = __builtin_nontemporal_load((const f32x4*)(cache_v + ro + 256)); } } while (0)
#define DEC_PROC(ka, kb, va, vb, j0_) do { float x0[4], x1[4]; _Pragma("unroll") for (int u = 0; u < 4; ++u) { const int j = (j0_) + 8 * u; \
            float s0 = (qa[0] * ka[u][0] + qa[1] * ka[u][1]) + (qa[2] * ka[u][2] + qa[3] * ka[u][3]); \
            float s1 = (qb[0] * kb[u][0] + qb[1] * kb[u][1]) + (qb[2] * kb[u][2] + qb[3] * kb[u][3]); \
            s0 = red32(s0); s1 = red32(s1); const f32x4 bj = lfs[j]; \
            x0[u] = s0 + (hi ? bj[1] : bj[0]); x1[u] = s1 + (hi ? bj[3] : bj[2]); } \
        dec_update(m0, l0, acc0, x0, va, 4); dec_update(m1, l1, acc1, x1, vb, 4); } while (0)
    DEC_LOAD(kaA, kbA, vaA, vbA, wid);
    for (int j0 = wid; j0 < PAST; j0 += 64) {
        DEC_LOAD(kaB, kbB, vaB, vbB, j0 + 32);
        DEC_PROC(kaA, kbA, vaA, vbA, j0);
        if (j0 + 64 < PAST) DEC_LOAD(kaA, kbA, vaA, vbA, j0 + 64);
        DEC_PROC(kaB, kbB, vaB, vbB, j0 + 32);
    }
#undef DEC_LOAD
#undef DEC_PROC
    if (wid == 0) {
        f32x4 va[4], vb[4]; float x0[4], x1[4];
        const float* kn = P.out + OK_S + (size_t)db * 512; const float* vn = P.out + OV_S + (size_t)db * 512;
        const f32x4 ka = *(const f32x4*)(kn + 4 * lane), kb = *(const f32x4*)(kn + 256 + 4 * lane);
        va[0] = *(const f32x4*)(vn + 4 * lane); vb[0] = *(const f32x4*)(vn + 256 + 4 * lane);
#pragma unroll
        for (int u = 1; u < 4; ++u) { va[u] = va[0]; vb[u] = vb[0]; }
        x0[0] = red32((qa[0] * ka[0] + qa[1] * ka[1]) + (qa[2] * ka[2] + qa[3] * ka[3]));
        x1[0] = red32((qb[0] * kb[0] + qb[1] * kb[1]) + (qb[2] * kb[2] + qb[3] * kb[3]));
#pragma unroll
        for (int u = 1; u < 4; ++u) { x0[u] = x0[0]; x1[u] = x1[0]; }
        dec_update(m0, l0, acc0, x0, va, 1); dec_update(m1, l1, acc1, x1, vb, 1);
    }
    if ((lane & 31) == 0) { cm[wid * 4 + hi] = m0; cm[wid * 4 + 2 + hi] = m1; cl[wid * 4 + hi] = l0; cl[wid * 4 + 2 + hi] = l1; }
    cacc[(wid * 2 + 0) * 64 + lane] = acc0; cacc[(wid * 2 + 1) * 64 + lane] = acc1;
    __syncthreads();
    if (tid < 128) {
        const int ab = tid >> 6, l = tid & 63, head = 2 * ab + (l >> 5);
        float M = -1e30f;
#pragma unroll
        for (int w = 0; w < NWAVES; ++w) M = fmaxf(M, cm[w * 4 + head]);
        float L = 0.f; f32x4 O = {0.f, 0.f, 0.f, 0.f};
#pragma unroll
        for (int w = 0; w < NWAVES; ++w) { const float e = __expf(cm[w * 4 + head] - M); L += cl[w * 4 + head] * e; O += cacc[(w * 2 + ab) * 64 + l] * e; }
        const float inv = 1.0f / L;
        v2u o; o.x = pk2(O[0] * inv, O[1] * inv); o.y = pk2(O[2] * inv, O[3] * inv);
        *(v2u*)(MIX + (size_t)(MP + db) * DM + head * 128 + 4 * (l & 31)) = o;
    }
    __syncthreads();
}

__device__ __forceinline__ void sgdn_unit(const Params& P, LAS unsigned char* lds, int db) {
    const int tid = threadIdx.x, wid = __builtin_amdgcn_readfirstlane(tid >> 6), lane = tid & 63;
    const float* state_conv = P.in[6]; const float* state_ssm = P.in[7]; const float* w_conv = P.in[11]; const float* w_gnorm = P.in[14];
    const float* BETA = (const float*)(P.ws + WS_BETA); const float* Gg = (const float*)(P.ws + WS_G);
    const bf16* ZB = (const bf16*)(P.ws + WS_ZB); bf16* MIX = (bf16*)(P.ws + WS_MIX);
    LAS float* xs = (LAS float*)lds;
    LAS float* red1 = xs + 1536;
    LAS float* red2 = red1 + 4096;
    LAS float* ov = red2 + 4096;
#pragma unroll
    for (int i = 0; i < 3; ++i) {
        const int ch = tid + 512 * i;
        const float* sc = state_conv + (size_t)db * 3 * CONVD + ch;
        float* oc = P.out + OCONV_S + (size_t)db * 3 * CONVD + ch;
        const float c0 = sc[0], c1 = sc[CONVD], c2 = sc[2 * CONVD], c3 = oc[2 * CONVD];
        const float a = (c0 * w_conv[ch] + c1 * w_conv[CONVD + ch]) + (c2 * w_conv[2 * CONVD + ch] + c3 * w_conv[3 * CONVD + ch]);
        xs[ch] = silu_f(a);
        oc[0] = c1; oc[CONVD] = c2;
    }
    __syncthreads();
    {
        const float a = xs[wid * 128 + lane], b = xs[wid * 128 + 64 + lane];
        const float ss = wave_sum(a * a + b * b);
        const float sc = (1.0f / sqrtf(ss + L2_EPS)) * (wid < 4 ? ATT_SCALE : 1.0f);
        xs[wid * 128 + lane] = a * sc; xs[wid * 128 + 64 + lane] = b * sc;
    }
    __syncthreads();
#pragma unroll
    for (int hp = 0; hp < 2; ++hp) {
        f32x2 s[2][16];
#pragma unroll
        for (int hh = 0; hh < 2; ++hh) { const int h = 2 * hp + hh;
            const float gsc = __expf(Gg[(size_t)(MP + db) * 4 + h]);
            const float* Sp = state_ssm + ((size_t)(db * 4 + h) * 128 + 16 * wid) * 128 + 2 * lane;
            f32x2 ks = {0.f, 0.f};
#pragma unroll
            for (int r = 0; r < 16; ++r) { s[hh][r] = *(const f32x2*)(Sp + (size_t)r * 128) * gsc; const float kd = xs[512 + h * 128 + 16 * wid + r]; ks += s[hh][r] * kd; }
            *(LAS f32x2*)(red1 + (h * 8 + wid) * 128 + 2 * lane) = ks;
        }
        __syncthreads();
#pragma unroll
        for (int hh = 0; hh < 2; ++hh) { const int h = 2 * hp + hh;
            const float bt = BETA[(size_t)(MP + db) * 4 + h];
            f32x2 kS = {0.f, 0.f};
#pragma unroll
            for (int w = 0; w < NWAVES; ++w) kS += *(const LAS f32x2*)(red1 + (h * 8 + w) * 128 + 2 * lane);
            const f32x2 vv = *(const LAS f32x2*)(xs + 1024 + h * 128 + 2 * lane);
            const f32x2 delta = (vv - kS) * bt;
            float* So = P.out + OSSM_S + ((size_t)(db * 4 + h) * 128 + 16 * wid) * 128 + 2 * lane;
            f32x2 os = {0.f, 0.f};
#pragma unroll
            for (int r = 0; r < 16; ++r) { const float kd = xs[512 + h * 128 + 16 * wid + r], qd = xs[h * 128 + 16 * wid + r]; const f32x2 sn = s[hh][r] + delta * kd; *(f32x2*)(So + (size_t)r * 128) = sn; os += sn * qd; }
            *(LAS f32x2*)(red2 + (h * 8 + wid) * 128 + 2 * lane) = os;
        }
    }
    __syncthreads();
    { const int h = tid >> 7, e = tid & 127; float o = 0.f;
#pragma unroll
        for (int w = 0; w < NWAVES; ++w) o += red2[(h * 8 + w) * 128 + e];
        ov[tid] = o; }
    __syncthreads();
    if (wid < 4) {
        const int h = wid;
        const float a = ov[h * 128 + lane], b = ov[h * 128 + 64 + lane];
        const float ss = wave_sum(a * a + b * b);
        const float rstd = 1.0f / sqrtf(ss * (1.0f / 128.0f) + RMS_EPS);
        const bf16* zr = ZB + (size_t)(MP + db) * 512 + h * 128;
        bf16* mr = MIX + (size_t)(MP + db) * DM + 512 + h * 128;
        mr[lane] = (bf16)f2bf(a * rstd * w_gnorm[lane] * silu_f(bf2f(zr[lane])));
        mr[64 + lane] = (bf16)f2bf(b * rstd * w_gnorm[64 + lane] * silu_f(bf2f(zr[64 + lane])));
    }
    __syncthreads();
}


#ifndef GSTAMP
#define GSTAMP(id)
#endif
constexpr int XS = 132, LS = 64;
__device__ __forceinline__ int sw256(int row, int ch) { return row * 256 + ((ch ^ (row & 15)) << 4); }
__device__ __forceinline__ int sw128(int row, int ch) { return row * 128 + ((ch ^ ((row >> 1) & 7)) << 4); }
#define GDNA_LOAD(unit_) do { const int n_ = (unit_) & 31, bh_ = (unit_) >> 5, h_ = bh_ & 3, m0_ = (bh_ >> 2) * SEQ + n_ * GCH; \
        _Pragma("unroll") for (int i = 0; i < 7; ++i) { const int c = tid + 512 * i; const int r = c / 48, w = c - r * 48, seg = w >> 4, ch = w & 15; \
            rv[i] = (v4u){0u, 0u, 0u, 0u}; \
            if (c < 67 * 48 && (n_ > 0 || r >= 3)) rv[i] = *(const v4u*)(CB + (size_t)(m0_ - 3 + r) * CONVD + seg * 512 + h_ * 128 + ch * 8); } \
        gpre = Gg[(size_t)(m0_ + lane) * 4 + h_]; bpre = BETA[(size_t)(m0_ + lane) * 4 + h_]; } while (0)
__device__ __forceinline__ void gdna_units(const Params& P, LAS unsigned char* lds, int u_first, int u_step, int u_end) {
    const int tid = threadIdx.x, wid = __builtin_amdgcn_readfirstlane(tid >> 6), lane = tid & 63, fr = lane & 15, fq = lane >> 4;
    const bf16* CB = (const bf16*)(P.ws + WS_CB);
    const float* BETA = (const float*)(P.ws + WS_BETA); const float* Gg = (const float*)(P.ws + WS_G);
    v4u rv[7]; float gpre, bpre;
    if (u_first < u_end) GDNA_LOAD(u_first & (NB * NH * NCHUNK - 1));
    for (int uu = u_first; uu < u_end; uu += u_step) {
    const int unit = uu & (NB * NH * NCHUNK - 1);
    const int n = unit & 31, bh = unit >> 5, b = bh >> 2, h = bh & 3, m0 = b * SEQ + n * GCH;
    const float* w_conv = P.in[11];
    float* UT = (float*)(P.ws + WS_UT) + (size_t)unit * 8192; bf16* WN = (bf16*)(P.ws + WS_WN) + (size_t)unit * 8192; bf16* QG = (bf16*)(P.ws + WS_QG) + (size_t)unit * 8192;
    bf16* KGT = (bf16*)(P.ws + WS_KGT) + (size_t)unit * 8192; bf16* QKM = (bf16*)(P.ws + WS_QKM) + (size_t)unit * 4096; float* GL = (float*)(P.ws + WS_GL);
    LAS float* XQ = (LAS float*)lds; LAS float* XK = XQ + 64 * XS; LAS float* XV = XK + 64 * XS;
    LAS unsigned char* RA = lds + 3 * 64 * XS * 4;
    LAS float* Lm = (LAS float*)RA;
    LAS unsigned char* KBf = RA + 16384;
    LAS unsigned char* QBf = RA + 16384 + 16384;
    LAS unsigned char* Nb = RA + 49152;
    LAS unsigned char* Lb = RA + 51456;
    LAS float* gcs = (LAS float*)(RA + 51456 + 8192); LAS float* bts = gcs + 64; LAS float* sks = bts + 64;
#pragma unroll
    for (int i = 0; i < 7; ++i) { const int c = tid + 512 * i; if (c < 67 * 48) *(LAS v4u*)(RA + c * 16) = rv[i]; }
    if (wid == 7) {
        float x = gpre;
#pragma unroll
        for (int o = 1; o < 64; o <<= 1) { const float y = __shfl_up(x, o); if (lane >= o) x += y; }
        gcs[lane] = x; bts[lane] = bpre; sks[lane] = bpre * __expf(x);
    }
    __syncthreads(); GSTAMP(5);
#pragma unroll
    for (int it = 0; it < 3; ++it) {
        const int item = tid + 512 * it, p = item % 192, rg = item / 192, seg = p >> 6, dp = (p & 63) * 2, ch = seg * 512 + h * 128 + dp;
        const f32x2 w0 = *(const f32x2*)(w_conv + ch), w1 = *(const f32x2*)(w_conv + CONVD + ch), w2 = *(const f32x2*)(w_conv + 2 * CONVD + ch), w3 = *(const f32x2*)(w_conv + 3 * CONVD + ch);
        const LAS unsigned* src = (const LAS unsigned*)(RA + ((8 * rg) * 384 + seg * 128 + dp) * 2);
        unsigned rw[11];
#pragma unroll
        for (int i = 0; i < 11; ++i) rw[i] = src[i * 192];
        LAS float* X = XQ + seg * 64 * XS + (8 * rg) * XS + dp;
#pragma unroll
        for (int i = 0; i < 8; ++i) {
            f32x2 a;
            a[0] = (__builtin_bit_cast(float, rw[i] << 16) * w0[0] + __builtin_bit_cast(float, rw[i + 1] << 16) * w1[0]) + (__builtin_bit_cast(float, rw[i + 2] << 16) * w2[0] + __builtin_bit_cast(float, rw[i + 3] << 16) * w3[0]);
            a[1] = (__builtin_bit_cast(float, rw[i] & 0xffff0000u) * w0[1] + __builtin_bit_cast(float, rw[i + 1] & 0xffff0000u) * w1[1]) + (__builtin_bit_cast(float, rw[i + 2] & 0xffff0000u) * w2[1] + __builtin_bit_cast(float, rw[i + 3] & 0xffff0000u) * w3[1]);
            a[0] = silu_f(a[0]); a[1] = silu_f(a[1]);
            *(LAS f32x2*)(X + i * XS) = a;
        }
    }
    __syncthreads(); GSTAMP(6);
    if (uu + u_step < u_end) GDNA_LOAD((uu + u_step) & (NB * NH * NCHUNK - 1));
#pragma unroll
    for (int it = 0; it < 2; ++it) {
        const int item = tid + 512 * it, R = item >> 3, s8 = item & 7, isq = R < 64, i = R & 63;
        LAS float* X = (isq ? XQ : XK) + i * XS + 16 * s8;
        f32x4 v[4]; float ss = 0.f;
#pragma unroll
        for (int q = 0; q < 4; ++q) { v[q] = *(const LAS f32x4*)(X + 4 * q); ss += (v[q][0] * v[q][0] + v[q][1] * v[q][1]) + (v[q][2] * v[q][2] + v[q][3] * v[q][3]); }
        ss += __shfl_xor(ss, 1); ss += __shfl_xor(ss, 2); ss += __shfl_xor(ss, 4);
        const float sc = (1.0f / sqrtf(ss + L2_EPS)) * (isq ? ATT_SCALE : 1.0f);
#pragma unroll
        for (int q = 0; q < 4; ++q) { v[q] = v[q] * sc; *(LAS f32x4*)(X + 4 * q) = v[q]; }
        LAS unsigned char* Bf = isq ? QBf : KBf;
        *(LAS v4u*)(Bf + sw256(i, 2 * s8)) = (v4u){pk2(v[0][0], v[0][1]), pk2(v[0][2], v[0][3]), pk2(v[1][0], v[1][1]), pk2(v[1][2], v[1][3])};
        *(LAS v4u*)(Bf + sw256(i, 2 * s8 + 1)) = (v4u){pk2(v[2][0], v[2][1]), pk2(v[2][2], v[2][3]), pk2(v[3][0], v[3][1]), pk2(v[3][2], v[3][3])};
    }
    __syncthreads(); GSTAMP(7);
    {
        const int ti = wid >> 1, i = 16 * ti + fr; const float gi = gcs[i], bi = bts[i];
#pragma unroll
        for (int t2 = 0; t2 < 2; ++t2) {
            const int tj = 2 * (wid & 1) + t2;
            f32x4 akk = {0.f, 0.f, 0.f, 0.f}, aqk = {0.f, 0.f, 0.f, 0.f};
            if (tj <= ti) {
#pragma unroll
                for (int ks = 0; ks < 4; ++ks) {
                    const bf16x8 kj = *(const LAS bf16x8*)(KBf + sw256(16 * tj + fr, 4 * ks + fq));
                    const bf16x8 kiv = *(const LAS bf16x8*)(KBf + sw256(i, 4 * ks + fq)), qiv = *(const LAS bf16x8*)(QBf + sw256(i, 4 * ks + fq));
                    akk = __builtin_amdgcn_mfma_f32_16x16x32_bf16(kj, kiv, akk, 0, 0, 0);
                    aqk = __builtin_amdgcn_mfma_f32_16x16x32_bf16(kj, qiv, aqk, 0, 0, 0);
                }
            }
            f32x4 lv, qv; const f32x4 gj = *(const LAS f32x4*)(gcs + 16 * tj + 4 * fq);
#pragma unroll
            for (int jj = 0; jj < 4; ++jj) { const int j = 16 * tj + 4 * fq + jj; const float dec = (j <= i) ? __expf(gi - gj[jj]) : 0.f;
                lv[jj] = (j < i) ? bi * akk[jj] * dec : 0.f; qv[jj] = (j <= i) ? aqk[jj] * dec : 0.f; }
            *(LAS f32x4*)(Lm + i * LS + 16 * tj + 4 * fq) = lv;
            *(LAS v2u*)(Lb + sw128(i, (16 * tj + 4 * fq) >> 3) + ((4 * fq) & 7) * 2) = (v2u){pk2(-lv[0], -lv[1]), pk2(-lv[2], -lv[3])};
            v2u qo; qo.x = pk2(qv[0], qv[1]); qo.y = pk2(qv[2], qv[3]);
            *(v2u*)(QKM + (size_t)i * 64 + 16 * tj + 4 * fq) = qo;
        }
    }
    __syncthreads(); GSTAMP(8);
    if (tid < 64) {
        const int bb = tid >> 4, c = tid & 15; const LAS float* Lp = Lm + (16 * bb) * LS + 16 * bb;
        float y[16];
#pragma unroll
        for (int r = 0; r < 16; ++r) { float a = (r == c) ? 1.f : 0.f;
#pragma unroll
            for (int j = 0; j < r; ++j) a -= Lp[r * LS + j] * y[j];
            y[r] = a; }
#pragma unroll
        for (int r = 0; r < 16; ++r) *(LAS bf16*)(Nb + ((bb * 16 + r) * 16 + c) * 2) = (bf16)f2bf(y[r] - ((r == c) ? 1.f : 0.f));
    } else if (tid >= 256) {
        const int t2 = tid - 256;
        { const int i = t2 >> 2, d0 = (t2 & 3) * 32; const float e = __expf(gcs[i]);
#pragma unroll
          for (int q8 = 0; q8 < 4; ++q8) { const f32x4 a = *(const LAS f32x4*)(XQ + i * XS + d0 + 8 * q8), c = *(const LAS f32x4*)(XQ + i * XS + d0 + 8 * q8 + 4);
              v4u o; o.x = pk2(a[0] * e, a[1] * e); o.y = pk2(a[2] * e, a[3] * e); o.z = pk2(c[0] * e, c[1] * e); o.w = pk2(c[2] * e, c[3] * e);
              *(v4u*)(QG + (size_t)i * 128 + d0 + 8 * q8) = o; } }
        { const int d = t2 >> 1, i0 = (t2 & 1) * 32; const float gl = gcs[63];
#pragma unroll
          for (int q8 = 0; q8 < 4; ++q8) { float v[8];
#pragma unroll
              for (int e = 0; e < 8; ++e) { const int i = i0 + 8 * q8 + e; v[e] = XK[i * XS + d] * __expf(gl - gcs[i]); }
              v4u o; o.x = pk2(v[0], v[1]); o.y = pk2(v[2], v[3]); o.z = pk2(v[4], v[5]); o.w = pk2(v[6], v[7]);
              *(v4u*)(KGT + (size_t)d * 64 + i0 + 8 * q8) = o; } }
        if (t2 == 0) GL[unit] = __expf(gcs[63]);
    }
    __syncthreads();
    {
        LAS unsigned char* Xt = KBf + wid * 4096;
        const bool isv = wid < 4;
        f32x4 xacc[2];
#pragma unroll
        for (int bb = 0; bb < 4; ++bb) {
            const f32x4 scv = *(const LAS f32x4*)((isv ? bts : sks) + 16 * bb + 4 * fq);
            bf16x8 nf = (bf16x8){0, 0, 0, 0, 0, 0, 0, 0};
            if (fq < 2) nf = *(const LAS bf16x8*)(Nb + (bb * 16 + fr) * 32 + fq * 16);
#pragma unroll
            for (int t = 0; t < 2; ++t) {
                const int colw = 16 * t + fr, col = 32 * wid + colw;
                const LAS float* Xs = isv ? (XV + col) : (XK + (col - 128));
#pragma unroll
                for (int j = 0; j < 4; ++j) xacc[t][j] = Xs[(16 * bb + 4 * fq + j) * XS] * scv[j];
#pragma unroll
                for (int ks = 0; ks < 2; ++ks) if (32 * ks < 16 * bb) {
                    bf16x8 a = *(const LAS bf16x8*)(Lb + sw128(16 * bb + fr, 4 * ks + fq));
                    bf16x8 xb = *(const LAS bf16x8*)(Xt + sw128(colw, 4 * ks + fq));
                    if (32 * ks + 8 * fq >= 16 * bb) { a = (bf16x8){0, 0, 0, 0, 0, 0, 0, 0}; xb = a; }
                    xacc[t] = __builtin_amdgcn_mfma_f32_16x16x32_bf16(a, xb, xacc[t], 0, 0, 0);
                }
                LAS unsigned char* xp = Xt + sw128(colw, (16 * bb + 4 * fq) >> 3) + ((4 * fq) & 7) * 2;
                *(LAS v2u*)xp = (v2u){pk2(xacc[t][0], xacc[t][1]), pk2(xacc[t][2], xacc[t][3])};
                bf16x8 rb = (bf16x8){0, 0, 0, 0, 0, 0, 0, 0};
                if (fq < 2) rb = *(const LAS bf16x8*)(Xt + sw128(colw, 2 * bb + fq));
                xacc[t] = __builtin_amdgcn_mfma_f32_16x16x32_bf16(nf, rb, xacc[t], 0, 0, 0);
                *(LAS v2u*)xp = (v2u){pk2(xacc[t][0], xacc[t][1]), pk2(xacc[t][2], xacc[t][3])};
                if (isv) *(f32x4*)(UT + (size_t)col * 64 + 16 * bb + 4 * fq) = xacc[t];
                else {
#pragma unroll
                    for (int j = 0; j < 4; ++j) WN[(size_t)(16 * bb + 4 * fq + j) * 128 + (col - 128)] = (bf16)f2bf(-xacc[t][j]);
                }
            }
        }
    }
    __syncthreads(); GSTAMP(10);
    }
}
#undef GDNA_LOAD

__device__ __forceinline__ void gdnb_unit(const Params& P, LAS unsigned char* lds, int bh) {
    typedef float f32x4_ __attribute__((ext_vector_type(4)));
    const int tid = threadIdx.x, wid = __builtin_amdgcn_readfirstlane(tid >> 6), lane = tid & 63, fr = lane & 15, fq = lane >> 4;
    const int b = bh >> 2, h = bh & 3;
    const float* w_gnorm = P.in[14];
    const bf16* ZB = (const bf16*)(P.ws + WS_ZB); bf16* MIX = (bf16*)(P.ws + WS_MIX);
    LAS unsigned char* Wl = lds;
    LAS unsigned char* Ql = lds + 16384;
    LAS unsigned char* Kl = lds + 32768;
    LAS unsigned char* Ml = lds + 49152;
    LAS unsigned char* STl = lds + 57344;
    LAS unsigned char* VTl = lds + 90112;
    LAS float* OT = (LAS float*)(lds + 106496);
    f32x4_ S[8];
#pragma unroll
    for (int i = 0; i < 8; ++i) S[i] = (f32x4_){0.f, 0.f, 0.f, 0.f};
    const int e = 16 * wid + fr;
#pragma unroll
    for (int db = 0; db < 8; ++db) *(LAS v2u*)(STl + sw256(e, (16 * db + 4 * fq) >> 3) + ((4 * fq) & 7) * 2) = (v2u){0u, 0u};
    const int orow = tid >> 3, ocol = (tid & 7) * 16;
    LAS float* GNl = OT + 64 * XS;
    if (tid < 128) GNl[tid] = w_gnorm[tid];
    const size_t ubase = (size_t)bh * 32;
    v4u aW[2], aQ[2], aK[2], aM; f32x4_ utn[4]; float gln;
#define SCAN_LOAD(n_) do { const size_t un_ = ubase + (n_); \
        const v4u* WNp = (const v4u*)((const bf16*)(P.ws + WS_WN) + un_ * 8192); const v4u* QGp = (const v4u*)((const bf16*)(P.ws + WS_QG) + un_ * 8192); \
        const v4u* KGp = (const v4u*)((const bf16*)(P.ws + WS_KGT) + un_ * 8192); const v4u* QKp = (const v4u*)((const bf16*)(P.ws + WS_QKM) + un_ * 4096); \
        const float* UTp = (const float*)(P.ws + WS_UT) + un_ * 8192; gln = ((const float*)(P.ws + WS_GL))[un_]; \
        aW[0] = WNp[tid]; aW[1] = WNp[tid + 512]; aQ[0] = QGp[tid]; aQ[1] = QGp[tid + 512]; aK[0] = KGp[tid]; aK[1] = KGp[tid + 512]; aM = QKp[tid]; \
        _Pragma("unroll") for (int rb_ = 0; rb_ < 4; ++rb_) utn[rb_] = *(const f32x4_*)(UTp + (size_t)e * 64 + 16 * rb_ + 4 * fq); } while (0)
#define SCAN_STAGE() do { \
        _Pragma("unroll") for (int i_ = 0; i_ < 2; ++i_) { const int idx_ = tid + 512 * i_; \
            *(LAS v4u*)(Wl + sw256(idx_ >> 4, idx_ & 15)) = aW[i_]; *(LAS v4u*)(Ql + sw256(idx_ >> 4, idx_ & 15)) = aQ[i_]; *(LAS v4u*)(Kl + sw128(idx_ >> 3, idx_ & 7)) = aK[i_]; } \
        *(LAS v4u*)(Ml + sw128(tid >> 3, tid & 7)) = aM; } while (0)
    SCAN_LOAD(0);
    SCAN_STAGE();
    for (int n = 0; n < NCHUNK; ++n) {
        __syncthreads();
        f32x4_ vn[4];
#pragma unroll
        for (int rb = 0; rb < 4; ++rb) vn[rb] = utn[rb];
        const size_t mrow = (size_t)b * SEQ + n * GCH + orow;
        const v4u z0 = *(const v4u*)(ZB + mrow * 512 + h * 128 + ocol), z1 = *(const v4u*)(ZB + mrow * 512 + h * 128 + ocol + 8);
        const float gl = gln;
        if (n + 1 < NCHUNK) SCAN_LOAD(n + 1);
        __builtin_amdgcn_sched_barrier(0);
        bf16x8 sb[4];
#pragma unroll
        for (int ks = 0; ks < 4; ++ks) sb[ks] = *(const LAS bf16x8*)(STl + sw256(e, 4 * ks + fq));
#pragma unroll
        for (int rb = 0; rb < 4; ++rb) {
#pragma unroll
            for (int ks = 0; ks < 4; ++ks) { const bf16x8 a = *(const LAS bf16x8*)(Wl + sw256(16 * rb + fr, 4 * ks + fq)); vn[rb] = __builtin_amdgcn_mfma_f32_16x16x32_bf16(a, sb[ks], vn[rb], 0, 0, 0); }
            v2u o; o.x = pk2(vn[rb][0], vn[rb][1]); o.y = pk2(vn[rb][2], vn[rb][3]);
            *(LAS v2u*)(VTl + sw128(e, (16 * rb + 4 * fq) >> 3) + ((4 * fq) & 7) * 2) = o;
        }
        bf16x8 vb[2];
#pragma unroll
        for (int ks = 0; ks < 2; ++ks) vb[ks] = *(const LAS bf16x8*)(VTl + sw128(e, 4 * ks + fq));
#pragma unroll
        for (int rb = 0; rb < 4; ++rb) {
            f32x4_ oo = (f32x4_){0.f, 0.f, 0.f, 0.f};
#pragma unroll
            for (int ks = 0; ks < 4; ++ks) { const bf16x8 a = *(const LAS bf16x8*)(Ql + sw256(16 * rb + fr, 4 * ks + fq)); oo = __builtin_amdgcn_mfma_f32_16x16x32_bf16(a, sb[ks], oo, 0, 0, 0); }
#pragma unroll
            for (int ks = 0; ks < 2; ++ks) { const bf16x8 a = *(const LAS bf16x8*)(Ml + sw128(16 * rb + fr, 4 * ks + fq)); oo = __builtin_amdgcn_mfma_f32_16x16x32_bf16(a, vb[ks], oo, 0, 0, 0); }
#pragma unroll
            for (int j = 0; j < 4; ++j) OT[(16 * rb + 4 * fq + j) * XS + e] = oo[j];
        }
#pragma unroll
        for (int db = 0; db < 8; ++db) {
            S[db] = S[db] * gl;
#pragma unroll
            for (int ks = 0; ks < 2; ++ks) { const bf16x8 a = *(const LAS bf16x8*)(Kl + sw128(16 * db + fr, 4 * ks + fq)); S[db] = __builtin_amdgcn_mfma_f32_16x16x32_bf16(a, vb[ks], S[db], 0, 0, 0); }
            v2u o; o.x = pk2(S[db][0], S[db][1]); o.y = pk2(S[db][2], S[db][3]);
            *(LAS v2u*)(STl + sw256(e, (16 * db + 4 * fq) >> 3) + ((4 * fq) & 7) * 2) = o;
        }
        __syncthreads();
        if (n + 1 < NCHUNK) SCAN_STAGE();
        {
            f32x4_ ov[4]; float ss = 0.f;
#pragma unroll
            for (int i = 0; i < 4; ++i) { ov[i] = *(const LAS f32x4_*)(OT + orow * XS + ocol + 4 * i); ss += (ov[i][0] * ov[i][0] + ov[i][1] * ov[i][1]) + (ov[i][2] * ov[i][2] + ov[i][3] * ov[i][3]); }
            ss += __shfl_xor(ss, 1); ss += __shfl_xor(ss, 2); ss += __shfl_xor(ss, 4);
            const float rstd = 1.0f / sqrtf(ss * (1.0f / 128.0f) + RMS_EPS);
            f32x4_ gn4[4];
#pragma unroll
            for (int i = 0; i < 4; ++i) gn4[i] = *(const LAS f32x4_*)(GNl + ocol + 4 * i);
            const unsigned zw[8] = {z0.x, z0.y, z0.z, z0.w, z1.x, z1.y, z1.z, z1.w};
            unsigned ow[8];
#pragma unroll
            for (int i = 0; i < 8; ++i) { const float za = __builtin_bit_cast(float, zw[i] << 16), zb = __builtin_bit_cast(float, zw[i] & 0xffff0000u);
                const float va = ov[i >> 1][(2 * i) & 3] * rstd * gn4[i >> 1][(2 * i) & 3] * silu_f(za), vb_ = ov[i >> 1][(2 * i + 1) & 3] * rstd * gn4[i >> 1][(2 * i + 1) & 3] * silu_f(zb);
                ow[i] = pk2(va, vb_); }
            bf16* mp = MIX + mrow * DM + 512 + h * 128 + ocol;
            *(v4u*)mp = (v4u){ow[0], ow[1], ow[2], ow[3]}; *(v4u*)(mp + 8) = (v4u){ow[4], ow[5], ow[6], ow[7]};
        }
        asm volatile("" : "+v"(utn[0]), "+v"(utn[1]), "+v"(utn[2]), "+v"(utn[3]), "+v"(gln));
    }
#undef SCAN_LOAD
#undef SCAN_STAGE
    float* So = P.out + OSSM_P + (size_t)bh * 16384;
#pragma unroll
    for (int db = 0; db < 8; ++db)
#pragma unroll
        for (int j = 0; j < 4; ++j) So[(size_t)(16 * db + 4 * fq + j) * 128 + e] = S[db][j];
    __syncthreads();
}


__device__ __forceinline__ f32x4 sgemm_slice16(const bf16* A, int lda, const bf16* Bt, int ldb, int n0, int k0, int k1, int wid, int fr, int fq) {
    f32x4 acc = {0.f, 0.f, 0.f, 0.f};
    const bf16* ap = A + (size_t)(16 * wid + fr) * lda + 8 * fq;
    const bf16* bp = Bt + (size_t)(n0 + fr) * ldb + 8 * fq;
#pragma unroll 16
    for (int ks = k0; ks < k1; ks += 32) {
        const bf16x8 a = *(const bf16x8*)(ap + ks), b = *(const bf16x8*)(bp + ks);
        acc = __builtin_amdgcn_mfma_f32_16x16x32_bf16(b, a, acc, 0, 0, 0);
    }
    return acc;
}
__device__ __forceinline__ void sample_wo_slice(const Params& P, int slice) {
    const int tid = threadIdx.x, wid = __builtin_amdgcn_readfirstlane(tid >> 6), lane = tid & 63, fr = lane & 15, fq = lane >> 4;
    const bf16* MIX = (const bf16*)(P.ws + WS_MIX) + (size_t)MP * DM; const bf16* WOT = (const bf16*)(P.ws + WS_WOT);
    bf16* HB = (bf16*)(P.ws + WS_HB) + (size_t)MP * DM; float* SSQS = (float*)(P.ws + WS_SSQS);
    const f32x4 acc = sgemm_slice16(MIX, DM, WOT, DM, 16 * slice, 0, DM, wid, fr, fq);
    const int m = 16 * wid + fr, n = 16 * slice + 4 * fq;
    const f32x4 h = acc + *(const f32x4*)(P.in[1] + (size_t)m * DM + n);
    *(f32x4*)(P.out + OY_S + (size_t)m * DM + n) = h;
    v2u o; o.x = pk2(h[0], h[1]); o.y = pk2(h[2], h[3]); *(v2u*)(HB + (size_t)m * DM + n) = o;
    float s = (h[0] * h[0] + h[1] * h[1]) + (h[2] * h[2] + h[3] * h[3]);
    s += __shfl_xor(s, 16); s += __shfl_xor(s, 32);
    if (fq == 0) SSQS[m * 64 + slice] = s;
}
__device__ __forceinline__ void sample_up_slice(const Params& P, int slice) {
    const int tid = threadIdx.x, wid = __builtin_amdgcn_readfirstlane(tid >> 6), lane = tid & 63, fr = lane & 15, fq = lane >> 4;
    const bf16* HB = (const bf16*)(P.ws + WS_HB) + (size_t)MP * DM; const bf16* WUPT = (const bf16*)(P.ws + WS_WUPT);
    bf16* UB = (bf16*)(P.ws + WS_UB) + (size_t)MP * FF; const float* SSQS = (const float*)(P.ws + WS_SSQS);
    const int m = 16 * wid + fr, n = 16 * slice + 4 * fq;
    float ss = 0.f;
#pragma unroll
    for (int i = 0; i < 4; ++i) { const f32x4 t = *(const f32x4*)(SSQS + m * 64 + 16 * fq + 4 * i); ss += (t[0] + t[1]) + (t[2] + t[3]); }
    ss += __shfl_xor(ss, 16); ss += __shfl_xor(ss, 32);
    const float rstd = 1.0f / sqrtf(ss * (1.0f / DM) + RMS_EPS);
    const f32x4 acc = sgemm_slice16(HB, DM, WUPT, DM, 16 * slice, 0, DM, wid, fr, fq);
    float u[4];
#pragma unroll
    for (int j = 0; j < 4; ++j) { const float p = fmaxf(acc[j] * rstd, 0.f); u[j] = p * p; }
    v2u o; o.x = pk2(u[0], u[1]); o.y = pk2(u[2], u[3]); *(v2u*)(UB + (size_t)m * FF + n) = o;
}
__device__ __forceinline__ void sample_down_slice(const Params& P, int item) {
    const int tid = threadIdx.x, wid = __builtin_amdgcn_readfirstlane(tid >> 6), lane = tid & 63, fr = lane & 15, fq = lane >> 4;
    const bf16* UB = (const bf16*)(P.ws + WS_UB) + (size_t)MP * FF; const bf16* WDNT = (const bf16*)(P.ws + WS_WDNT);
    float* PART = (float*)(P.ws + WS_PART);
    const int slice = item & 63, q = item >> 6;
    const f32x4 acc = sgemm_slice16(UB, FF, WDNT, FF, 16 * slice, 1024 * q, 1024 * q + 1024, wid, fr, fq);
    const int m = 16 * wid + fr, n = 16 * slice + 4 * fq;
    *(f32x4*)(PART + ((size_t)q * DECB + m) * DM + n) = acc;
}

__device__ __forceinline__ void phase_final(const Params& P, const Ctx& C) {
    const float* ln_f = P.in[19]; const float* SSQ2 = (const float*)(P.ws + WS_SSQ2);
    const int gw = C.vcu * NWAVES + C.wave, NGW = C.G * NWAVES, lane = C.lane;
    f32x4 lw[4];
#pragma unroll
    for (int j = 0; j < 4; ++j) lw[j] = ((const f32x4*)ln_f)[lane + 64 * j];
    for (int m = gw; m < M_TOT; m += NGW) {
        if (m < MP) {
            const f32x4* sp = (const f32x4*)(SSQ2 + (size_t)m * 16);
            const f32x4 a = sp[0], b = sp[1], c = sp[2], d = sp[3];
            const float ss = ((a[0] + a[1]) + (a[2] + a[3])) + ((b[0] + b[1]) + (b[2] + b[3])) + ((c[0] + c[1]) + (c[2] + c[3])) + ((d[0] + d[1]) + (d[2] + d[3]));
            const float rstd = 1.0f / sqrtf(ss * (1.0f / DM) + RMS_EPS);
            float* yr = P.out + OY_P + (size_t)m * DM;
#pragma unroll
            for (int j = 0; j < 4; ++j) { f32x4 v = ((const f32x4*)yr)[lane + 64 * j]; v = v * rstd * lw[j]; ((f32x4*)yr)[lane + 64 * j] = v; }
        } else {
            const int r = m - MP; float* yr = P.out + OY_S + (size_t)r * DM; const float* PART = (const float*)(P.ws + WS_PART);
            f32x4 v[4]; float ss = 0.f;
#pragma unroll
            for (int j = 0; j < 4; ++j) { v[j] = ((const f32x4*)yr)[lane + 64 * j];
#pragma unroll
                for (int q = 0; q < 4; ++q) v[j] += ((const f32x4*)(PART + ((size_t)q * DECB + r) * DM))[lane + 64 * j];
                ss += (v[j][0] * v[j][0] + v[j][1] * v[j][1]) + (v[j][2] * v[j][2] + v[j][3] * v[j][3]); }
            ss = wave_sum(ss);
            const float rstd = 1.0f / sqrtf(ss * (1.0f / DM) + RMS_EPS);
#pragma unroll
            for (int j = 0; j < 4; ++j) ((f32x4*)yr)[lane + 64 * j] = v[j] * rstd * lw[j];
        }
    }
}

constexpr int NPHASES = 8;
__global__ void __launch_bounds__(NWAVES * 64, 2) fwd_kernel(Params P) {
    extern __shared__ __attribute__((aligned(16))) unsigned char shm[];
    LAS unsigned char* lds = (LAS unsigned char*)shm;
    Ctx C; C.tid = threadIdx.x; C.lane = C.tid & 63; C.wave = __builtin_amdgcn_readfirstlane(C.tid >> 6);
    C.G = gridDim.x; { const int bx = blockIdx.x; C.vcu = (C.G % 8 == 0) ? (bx % 8) * (C.G / 8) + bx / 8 : bx; }
    volatile LAS unsigned* MISC = (volatile LAS unsigned*)(lds + MISC_OFF);
    if (C.tid < 64) MISC[C.tid] = 0u;
    __syncthreads();
    unsigned* ctl = (unsigned*)(P.ws + WS_CTL);
    const int lo = P.ph_lo, hi = P.ph_hi;
    XcdBarrier bar; bar.bar = ctl + CW_BAR; bar.x = 0; bar.st = nullptr;
    if (hi - lo > 1) bar = xcd_barrier_post(ctl + CW_BAR, MISC + 8);
#ifndef REPEAT_MASK
#define REPEAT_MASK 0
#endif
#define NREP(k) (((REPEAT_MASK >> (k)) & 1) ? 2 : 1)
#ifndef SUBMASK
#define SUBMASK 15
#endif
#ifndef PHASE_MASK
#define PHASE_MASK 0xff
#endif
#define IN(k) (((PHASE_MASK >> (k)) & 1) && lo <= (k) && (k) < hi)
#if 0
#define PROBE_K -1
#endif
#define PROBE_MULT 4
#define STAMP(j) do { if (PROBE_K >= 0 && blockIdx.x == 0 && C.tid == 0) { const unsigned long long t_ = __builtin_amdgcn_s_memrealtime(); MISC[16 + 2 * (j)] = (unsigned)t_; MISC[17 + 2 * (j)] = (unsigned)(t_ >> 32); } } while (0)
#define RSTAMP(id, who) do { if (PROBE_K >= 10 && C.vcu == (who) && C.tid == 0) { const unsigned long long t_ = __builtin_amdgcn_s_memrealtime(); __hip_atomic_store(ctl + 512 + 2 * (id), (unsigned)t_, __ATOMIC_RELAXED, __HIP_MEMORY_SCOPE_AGENT); __hip_atomic_store(ctl + 513 + 2 * (id), (unsigned)(t_ >> 32), __ATOMIC_RELAXED, __HIP_MEMORY_SCOPE_AGENT); } } while (0)
#define SEAM(k) do { if (IN(k) && IN((k) + 1)) xcd_barrier(bar); STAMP((k) + 1); } while (0)
    unsigned char* ws = P.ws;
    STAMP(0);

    if (IN(0)) { for (int rep = 0; rep < NREP(0); ++rep) phase_prep(P, C, lds); SEAM(0); }

    if (IN(1)) {
        if (C.wave == 0) for (int bh = C.vcu; bh < NB * NH; bh += C.G) kbias_seq(P, bh, C.lane);
        for (int rep = 0; rep < NREP(1); ++rep) {
        pg8::Gemm g{(const pg8::bf16_t*)(ws + WS_XN), (const pg8::bf16_t*)(ws + WS_W1T), M_PAD, N1, DM};
        pg8::StaticOrder S; S.init(M_PAD, N1, C.G, (int)blockIdx.x);
        pg8::EpiIn E{(pg8::bf16_t*)(ws + WS_QB), (float*)(ws + WS_QS), (pg8::bf16_t*)(ws + WS_CB), (pg8::bf16_t*)(ws + WS_ZB), P.out};
        pg8::gemm_phase<pg8::EpiIn, pg8::StaticOrder, true, true>(lds, g, S, E);
        }
        if (C.G == 256 && blockIdx.x >= 142) late_weight_copies(P, lds, C.wave, C.lane, ((int)blockIdx.x - 142) * NWAVES + C.wave, 114 * NWAVES);
        SEAM(1);
    }

    if (IN(2)) {
#if SUBMASK & 8
        gdna_units(P, lds, C.vcu, C.G, NREP(5) * NB * NH * NCHUNK);
#endif
        SEAM(2);
    }

    if (IN(3)) {
        for (int it = C.vcu; it < 256; it += C.G) { const int xg = it >> 5, slot = it & 31; if (slot < 4) { for (int rep = 0; rep < NREP(6); ++rep) gdnb_unit(P, lds, xg + 8 * slot); } }
        RSTAMP(0, 0);
#if SUBMASK & 1
        for (int it = C.vcu; it < 256; it += C.G) {
            const int xg = it >> 5, slot = it & 31;
            if (slot < 4 || slot >= 16) continue;
            const int j = slot - 4, bh = xg * 4 + j / 3, g = j % 3, b = bh >> 2, h = bh & 3;
            const bf16* Qh = (const bf16*)(ws + WS_QB) + (size_t)bh * SEQ * HD; const bf16* Kh = (const bf16*)(ws + WS_KB) + (size_t)bh * SEQ * HD; const bf16* Vh = (const bf16*)(ws + WS_VB) + (size_t)bh * SEQ * HD;
            const float* kbias = (const float*)(ws + WS_KBIAS) + (size_t)bh * SEQ;
            bf16* Orow0 = (bf16*)(ws + WS_MIX) + (size_t)b * SEQ * DM + h * HD;
            const int nblk = (g == 2 ? 4 : 2) * NREP(2);
            for (int k2 = 0; k2 < nblk; ++k2) { const int k = k2 & 3; const int qb = g == 0 ? ((k & 1) == 0 ? 7 : 3) : (g == 1 ? ((k & 1) == 0 ? 6 : 4) : (k == 0 ? 5 : 3 - k)); fox::fox_block((char*)shm, Qh, Kh, Vh, kbias, Orow0, qb); }
        }
        RSTAMP(1, 4); RSTAMP(2, 6);
#endif
#if SUBMASK & 2
        for (int it = C.vcu; it < NREP(3) * 256; it += C.G) { const int xg = (it & 255) >> 5, slot = it & 31; if (slot >= 16) decode_unit(P, lds, xg * 16 + (slot - 16)); }
        RSTAMP(3, 16);
#endif
#if SUBMASK & 4
        for (int it = C.vcu; it < 256; it += C.G) { const int xg = it >> 5, slot = it & 31; if (slot >= 16) sgdn_unit(P, lds, xg * 16 + (slot - 16)); }
        RSTAMP(4, 16);
#endif
        SEAM(3);
    }

    if (IN(4)) {
        for (int rep = 0; rep < NREP(9); ++rep) for (int it = blockIdx.x; it < 64; it += C.G) sample_wo_slice(P, it);
        pg8::Gemm g{(const pg8::bf16_t*)(ws + WS_MIX), (const pg8::bf16_t*)(ws + WS_WOT), MP, DM, DM};
        pg8::StaticOrder S; S.init(MP, DM, C.G, (int)blockIdx.x);
        pg8::EpiRes E{P.in[0], (float*)(ws + WS_HF), (pg8::bf16_t*)(ws + WS_HB), (float*)(ws + WS_SSQ)};
        pg8::gemm_phase<pg8::EpiRes, pg8::StaticOrder, true, true>(lds, g, S, E);
#if (REPEAT_MASK >> 7) & 1
        pg8::gemm_phase<pg8::EpiRes, pg8::StaticOrder, true, true>(lds, g, S, E);
#endif
        SEAM(4);
    }

    if (IN(5)) {
        for (int rep = 0; rep < NREP(10); ++rep) for (int it = blockIdx.x; it < 256; it += C.G) sample_up_slice(P, it);
        pg8::Gemm g{(const pg8::bf16_t*)(ws + WS_HB), (const pg8::bf16_t*)(ws + WS_WUPT), MP, FF, DM};
        pg8::StaticOrder S; S.init(MP, FF, C.G, (int)blockIdx.x);
        pg8::EpiUp E{(pg8::bf16_t*)(ws + WS_UB), (const float*)(ws + WS_SSQ)};
        pg8::gemm_phase<pg8::EpiUp, pg8::StaticOrder, true, true>(lds, g, S, E);
#if (REPEAT_MASK >> 8) & 1
        pg8::gemm_phase<pg8::EpiUp, pg8::StaticOrder, true, true>(lds, g, S, E);
#endif
        SEAM(5);
    }

    if (IN(6)) {
        for (int rep = 0; rep < NREP(11); ++rep) for (int it = blockIdx.x; it < 256; it += C.G) sample_down_slice(P, it);
        pg8::Gemm g{(const pg8::bf16_t*)(ws + WS_UB), (const pg8::bf16_t*)(ws + WS_WDNT), MP, DM, FF};
        pg8::StaticOrder S; S.init(MP, DM, C.G, (int)blockIdx.x);
        pg8::EpiDown E{(const float*)(ws + WS_HF), P.out, (float*)(ws + WS_SSQ2)};
        pg8::gemm_phase<pg8::EpiDown, pg8::StaticOrder, true, true>(lds, g, S, E);
#if (REPEAT_MASK >> 12) & 1
        pg8::gemm_phase<pg8::EpiDown, pg8::StaticOrder, true, true>(lds, g, S, E);
#endif
        SEAM(6);
    }

    if (IN(7)) phase_final(P, C);
    if (PROBE_K >= 0 && blockIdx.x == 0 && C.tid == 0) {
        STAMP(8);
        unsigned long long t0, t1;
        if (PROBE_K >= 10) { const int sb_ = (PROBE_K - 10 >= 5) ? 2 : 3; t0 = ((unsigned long long)MISC[17 + 2 * sb_] << 32) | MISC[16 + 2 * sb_];
            t1 = ((unsigned long long)__hip_atomic_load(ctl + 513 + 2 * (PROBE_K - 10), __ATOMIC_RELAXED, __HIP_MEMORY_SCOPE_AGENT) << 32) | __hip_atomic_load(ctl + 512 + 2 * (PROBE_K - 10), __ATOMIC_RELAXED, __HIP_MEMORY_SCOPE_AGENT); }
        else { t0 = ((unsigned long long)MISC[17 + 2 * (PROBE_K < 10 ? PROBE_K : 0)] << 32) | MISC[16 + 2 * (PROBE_K < 10 ? PROBE_K : 0)]; t1 = ((unsigned long long)MISC[19 + 2 * (PROBE_K < 10 ? PROBE_K : 0)] << 32) | MISC[18 + 2 * (PROBE_K < 10 ? PROBE_K : 0)]; }
        const unsigned long long until = __builtin_amdgcn_s_memrealtime() + PROBE_MULT * (t1 - t0);
        while (__builtin_amdgcn_s_memrealtime() < until) __builtin_amdgcn_s_sleep(8);
    }
#undef IN
#undef SEAM
}

#ifndef N_LAUNCH_MODE
#define N_LAUNCH_MODE 1
#endif
extern "C" void kernel_launch(void* const* d_in, const int* in_sizes, int n_in, void* d_out, int out_size, void* d_ws, size_t ws_size, hipStream_t stream) {
    static int grid = 0;
    if (grid == 0) {
        if (n_in != 20 || out_size != (int)OUT_TOTAL || ws_size < WS_END) { fprintf(stderr, "kernel_launch: unexpected shapes (n_in %d, out %d, ws %zu); nothing launched\n", n_in, out_size, ws_size); grid = -1; return; }
        int dev = 0, cus = 0, per_cu = 0;
        if (hipGetDevice(&dev) != hipSuccess || hipDeviceGetAttribute(&cus, hipDeviceAttributeMultiprocessorCount, dev) != hipSuccess) { grid = -1; return; }
        if (hipFuncSetAttribute((const void*)fwd_kernel, hipFuncAttributeMaxDynamicSharedMemorySize, LDS_BYTES) != hipSuccess) { fprintf(stderr, "kernel_launch: hipFuncSetAttribute failed\n"); grid = -1; return; }
        if (hipOccupancyMaxActiveBlocksPerMultiprocessor(&per_cu, (const void*)fwd_kernel, NWAVES * 64, LDS_BYTES) != hipSuccess || per_cu < 1)
            fprintf(stderr, "kernel_launch: note: occupancy query reports %d workgroups per CU\n", per_cu);
        (void)hipGetLastError();
        grid = cus;
    }
    if (grid < 0) return;
    if (hipMemsetAsync((char*)d_ws + WS_CTL, 0, CTL_ZERO_BYTES, stream) != hipSuccess) return;
    Params p{};
    for (int i = 0; i < 20; ++i) p.in[i] = (const float*)d_in[i];
    p.out = (float*)d_out; p.ws = (unsigned char*)d_ws;
    if (N_LAUNCH_MODE == 1) {
        p.ph_lo = 0; p.ph_hi = NPHASES;
        hipLaunchKernelGGL(fwd_kernel, dim3(grid), dim3(NWAVES * 64), LDS_BYTES, stream, p);
    } else {
        for (int k = 0; k < NPHASES; ++k) { p.ph_lo = k; p.ph_hi = k + 1; hipLaunchKernelGGL(fwd_kernel, dim3(grid), dim3(NWAVES * 64), LDS_BYTES, stream, p); }
    }
}
```
